# Optimizing an MI355X kernel written in HIP

```python
import math
import jax, jax.numpy as jnp
from jax import lax
import numpy as np

D_MODEL = 1024
BATCH = 2
SEQ = 16384
DEPTH = 2

MIX_WIDTH = D_MODEL
GM_GROUPS = 4
GM_CH = MIX_WIDTH // 2 // GM_GROUPS
GM_CHUNK = 128
GM_WIDTH = GM_GROUPS * GM_CH
ATT_HEADS = 8
ATT_HD = MIX_WIDTH // 2 // ATT_HEADS
ATT_WIDTH = ATT_HEADS * ATT_HD
DILATED_PATTERNS = ((128, 1), (512, 4), (2048, 16))
ATT_BLOCK = 128
DIL_PAD = ATT_BLOCK * 16
IN_EVEN = 2 * GM_WIDTH + 3 * ATT_WIDTH + MIX_WIDTH
RW_HEAD = 64
RW_HEADS = D_MODEL // RW_HEAD
RW_DECAY_LORA = 64
RW_AAA_LORA = 64
RMS_EPS = 1e-6
LNX_EPS = 64e-5
N_EVEN = (DEPTH + 1) // 2
N_ODD = DEPTH // 2

kernel_name = "hybrid_gmlp_dilated_alibi_rwkv7"


def rmsnorm(x, g):
    xf = x.astype(jnp.float32)
    y = xf * lax.rsqrt(jnp.mean(xf * xf, axis=-1, keepdims=True) + RMS_EPS)
    return (y * g.astype(jnp.float32)).astype(x.dtype)


def alibi_slopes(n_heads):
    s = 2.0 ** (-8.0 * np.arange(1, n_heads + 1) / n_heads)
    return jnp.asarray(s, dtype=jnp.float32)


def dilated_window_attention(q, k, v, window, dilation):
    B, S, H, hd = q.shape
    L = S // dilation
    nblk = L // ATT_BLOCK
    reach = window // dilation

    def blocks(t):
        return t.reshape(B, nblk, ATT_BLOCK, dilation, H, hd)

    def with_prev(t):
        prev = jnp.concatenate([jnp.zeros_like(t[:, :1]), t[:, :-1]], axis=1)
        return jnp.concatenate([prev, t], axis=2)

    qb = blocks(q)
    kc = with_prev(blocks(k))
    vc = with_prev(blocks(v))
    s = jnp.einsum('bnqrhc,bnkrhc->bnrhqk', qb, kc).astype(jnp.float32) / math.sqrt(hd)

    qi = jnp.arange(ATT_BLOCK)[:, None]
    kloc = jnp.arange(2 * ATT_BLOCK)[None, :] - ATT_BLOCK
    j = qi - kloc
    blk = jnp.arange(nblk)[:, None, None]
    valid = (j >= 0) & (j <= reach) & (blk * ATT_BLOCK + kloc[None] >= 0)
    bias = -alibi_slopes(H)[:, None, None] * (j * dilation).astype(jnp.float32)
    s = jnp.where(valid[None, :, None, None], s + bias[None, None, None], -jnp.inf)
    m = jnp.max(s, axis=-1, keepdims=True)
    p = jnp.exp(s - m)
    l = jnp.sum(p, axis=-1)
    o = jnp.einsum('bnrhqk,bnkrhc->bnqrhc', p, vc.astype(jnp.float32))
    l_t = l.transpose(0, 1, 4, 2, 3)
    o = (o / l_t[..., None]).reshape(B, S, H, hd)
    m_t = m[..., 0].transpose(0, 1, 4, 2, 3).reshape(B, S, H)
    return o, m_t, l_t.reshape(B, S, H)


def mixed_dilated_attention(q, k, v):
    B, S, H, hd = q.shape
    s_pad = -(-S // DIL_PAD) * DIL_PAD
    pad = ((0, 0), (0, s_pad - S), (0, 0), (0, 0))
    qp, kp, vp = jnp.pad(q, pad), jnp.pad(k, pad), jnp.pad(v, pad)
    outs = [dilated_window_attention(qp, kp, vp, w, d) for (w, d) in DILATED_PATTERNS]
    m_all = jnp.stack([o[1] for o in outs], axis=0)
    l_all = jnp.stack([o[2] for o in outs], axis=0)
    o_all = jnp.stack([o[0] for o in outs], axis=0)
    wts = l_all * jnp.exp(m_all - jnp.max(m_all, axis=0, keepdims=True))
    out = jnp.sum(wts[..., None] * o_all, axis=0) / jnp.sum(wts, axis=0)[..., None]
    return out[:, :S].astype(q.dtype)


def even_mixer(h, w_in, gm_norm, gm_ws, gm_b, w_out):
    B, S, _ = h.shape
    proj = h @ w_in
    splits = list(np.cumsum([GM_WIDTH, GM_WIDTH, ATT_WIDTH, ATT_WIDTH, ATT_WIDTH]))
    u, va, q, k, vb, z = jnp.split(proj, splits, axis=-1)
    u = jax.nn.gelu(u)
    va = rmsnorm(jax.nn.gelu(va).reshape(B, S, GM_GROUPS, GM_CH), gm_norm)
    vch = va.reshape(B, S // GM_CHUNK, GM_CHUNK, GM_GROUPS, GM_CH)
    ws = gm_ws * jnp.tril(jnp.ones((GM_CHUNK, GM_CHUNK), dtype=gm_ws.dtype))[None]
    spatial = jnp.einsum('gts,bnsgc->bntgc', ws, vch) + gm_b.T[:, :, None]
    a_out = u * spatial.reshape(B, S, GM_WIDTH)
    heads = lambda t: t.reshape(B, S, ATT_HEADS, ATT_HD)
    b_out = mixed_dilated_attention(heads(q), heads(k), heads(vb)).reshape(B, S, ATT_WIDTH)
    y = jnp.concatenate([a_out, b_out], axis=-1) * jax.nn.silu(z)
    return y @ w_out


def rwkv7_scan(r, w, k, v, kk, a):
    _, B, H, N = r.shape

    def step(state, inp):
        r_t, w_t, k_t, v_t, kk_t, a_t = inp
        sa = jnp.einsum('bhvk,bhk->bhv', state, -kk_t)
        state = (state * w_t[:, :, None, :]
                 + sa[..., None] * (kk_t * a_t)[:, :, None, :]
                 + v_t[..., None] * k_t[:, :, None, :])
        y_t = jnp.einsum('bhvk,bhk->bhv', state, r_t)
        return state, y_t

    state0 = jnp.zeros((B, H, N, N), dtype=jnp.float32)
    _, ys = lax.scan(step, state0, (r, w, k, v, kk, a))
    return ys


def odd_mixer(h, mu, w_r, w_k, w_v, w_g, w0, w1, w2, a0, a1, a2, k_k, k_a, r_k, lnx_w, lnx_b, w_o):
    B, S, D = h.shape
    f32 = jnp.float32
    xx = jnp.concatenate([jnp.zeros_like(h[:, :1]), h[:, :-1]], axis=1) - h
    xr, xw, xk, xv, xa, xg = [h + xx * mu[i] for i in range(6)]
    r = xr @ w_r
    k = xk @ w_k
    v = xv @ w_v
    g = xg @ w_g
    logw = -jax.nn.softplus(-(w0 + jnp.tanh(xw @ w1) @ w2).astype(f32)) - 0.5
    decay = jnp.exp(-jnp.exp(logw))
    a = jax.nn.sigmoid((a0 + (xa @ a1) @ a2).astype(f32))
    hs = lambda t: t.astype(f32).reshape(B, S, RW_HEADS, RW_HEAD)
    kk = hs(k * k_k)
    kk = kk * lax.rsqrt(jnp.maximum(jnp.sum(kk * kk, axis=-1, keepdims=True), 1e-24))
    k = k.astype(f32) * (1.0 + (a - 1.0) * k_a.astype(f32))
    rh, kh, vh, wh, ah = hs(r), hs(k), hs(v), hs(decay), hs(a)
    tm = lambda t: t.transpose(1, 0, 2, 3)
    ys = rwkv7_scan(tm(rh), tm(wh), tm(kh), tm(vh), tm(kk), tm(ah)).transpose(1, 0, 2, 3)
    mean = jnp.mean(ys, axis=-1, keepdims=True)
    var = jnp.mean((ys - mean) ** 2, axis=-1, keepdims=True)
    y = ((ys - mean) * lax.rsqrt(var + LNX_EPS)).reshape(B, S, D) * lnx_w.astype(f32) + lnx_b.astype(f32)
    bonus = jnp.sum(rh * kh * r_k.astype(f32), axis=-1, keepdims=True) * vh
    y = (y + bonus.reshape(B, S, D)).astype(h.dtype) * jax.nn.silu(g)
    return y @ w_o


def setup_inputs(seed: int = 0) -> dict:
    key = jax.random.key(seed)
    ks = iter(jax.random.split(key, 40))
    nrm = lambda shape, scale: scale * jax.random.normal(next(ks), shape, dtype=jnp.float32)
    D, Ne, No, H, N = D_MODEL, N_EVEN, N_ODD, RW_HEADS, RW_HEAD
    return {
        "x": nrm((BATCH, SEQ, D), 1.0),
        "ln_even": 1.0 + nrm((Ne, D), 0.02),
        "w_in_even": nrm((Ne, D, IN_EVEN), D ** -0.5),
        "gm_norm": 1.0 + nrm((Ne, GM_GROUPS, GM_CH), 0.02),
        "gm_ws": nrm((Ne, GM_GROUPS, GM_CHUNK, GM_CHUNK), 0.5 * GM_CHUNK ** -0.5),
        "gm_b": 1.0 + nrm((Ne, GM_GROUPS, GM_CHUNK), 0.1),
        "w_out_even": nrm((Ne, MIX_WIDTH, D), 0.5 * MIX_WIDTH ** -0.5),
        "ln_odd": 1.0 + nrm((No, D), 0.02),
        "rw_mu": jax.random.uniform(next(ks), (No, 6, D), dtype=jnp.float32),
        "rw_wr": nrm((No, D, D), D ** -0.5),
        "rw_wk": nrm((No, D, D), D ** -0.5),
        "rw_wv": nrm((No, D, D), D ** -0.5),
        "rw_wg": nrm((No, D, D), D ** -0.5),
        "rw_w0": jax.random.uniform(next(ks), (No, D), dtype=jnp.float32, minval=-5.0, maxval=1.0),
        "rw_w1": nrm((No, D, RW_DECAY_LORA), D ** -0.5),
        "rw_w2": nrm((No, RW_DECAY_LORA, D), 0.1 * RW_DECAY_LORA ** -0.5),
        "rw_a0": nrm((No, D), 0.1),
        "rw_a1": nrm((No, D, RW_AAA_LORA), D ** -0.5),
        "rw_a2": nrm((No, RW_AAA_LORA, D), 0.1 * RW_AAA_LORA ** -0.5),
        "rw_kk": 0.85 + nrm((No, D), 0.02),
        "rw_ka": 1.0 + nrm((No, D), 0.02),
        "rw_rk": nrm((No, H, N), 0.1),
        "rw_lnw": 1.0 + nrm((No, D), 0.02),
        "rw_lnb": nrm((No, D), 0.01),
        "rw_wo": nrm((No, D, D), 0.5 * D ** -0.5),
        "final_norm": 1.0 + nrm((D,), 0.02),
    }


def reference(x, ln_even, w_in_even, gm_norm, gm_ws, gm_b, w_out_even,
              ln_odd, rw_mu, rw_wr, rw_wk, rw_wv, rw_wg, rw_w0, rw_w1, rw_w2,
              rw_a0, rw_a1, rw_a2, rw_kk, rw_ka, rw_rk, rw_lnw, rw_lnb, rw_wo,
              final_norm):
    for layer in range(DEPTH):
        i = layer // 2
        if layer % 2 == 0:
            h = rmsnorm(x, ln_even[i])
            x = x + even_mixer(h, w_in_even[i], gm_norm[i], gm_ws[i], gm_b[i], w_out_even[i])
        else:
            h = rmsnorm(x, ln_odd[i])
            x = x + odd_mixer(h, rw_mu[i], rw_wr[i], rw_wk[i], rw_wv[i], rw_wg[i],
                              rw_w0[i], rw_w1[i], rw_w2[i], rw_a0[i], rw_a1[i], rw_a2[i],
                              rw_kk[i], rw_ka[i], rw_rk[i], rw_lnw[i], rw_lnb[i], rw_wo[i])
    return rmsnorm(x, final_norm)
```

```cpp
#include <hip/hip_runtime.h>
#include <hip/hip_cooperative_groups.h>
#include <stdint.h>
#include <cstdio>
namespace cg = cooperative_groups;

#ifndef MEGA
#define MEGA 1
#endif

typedef unsigned short bfu;
using bf16x8 = __attribute__((ext_vector_type(8))) short;
using f32x4 = __attribute__((ext_vector_type(4))) float;
#define DEVI __device__ __forceinline__

constexpr int T_TOK = 32768;
constexpr int SEQ = 16384;
constexpr int SMEM_BYTES = 49152;

struct Params {
  const float *x, *ln_even, *w_in, *gm_norm, *gm_ws, *gm_b, *w_out, *ln_odd, *mu, *wr, *wk, *wv, *wg, *w0, *w1, *w2,
      *a0, *a1, *a2, *k_k, *k_a, *r_k, *lnw, *lnb, *wo, *fnorm;
  float* out;
  bfu *WT_in, *WT_out, *WT_3, *WT_o, *W2T, *A2T;
  bfu *H, *U, *GVT, *Q, *K, *V, *SZ, *Y, *R, *K1, *V1, *SG, *EW, *AA, *YS, *TW, *TA;
};

DEVI float bf2f(unsigned b) { return __uint_as_float(b << 16); }
DEVI unsigned f2bf(float x) {
  unsigned u = __float_as_uint(x);
  u += 0x7fffu + ((u >> 16) & 1u);
  return u >> 16;
}
DEVI void unpack8(uint4 v, float* f) {
  f[0] = __uint_as_float(v.x << 16); f[1] = __uint_as_float(v.x & 0xffff0000u);
  f[2] = __uint_as_float(v.y << 16); f[3] = __uint_as_float(v.y & 0xffff0000u);
  f[4] = __uint_as_float(v.z << 16); f[5] = __uint_as_float(v.z & 0xffff0000u);
  f[6] = __uint_as_float(v.w << 16); f[7] = __uint_as_float(v.w & 0xffff0000u);
}
DEVI uint4 pack8(const float* f) {
  uint4 r;
  r.x = f2bf(f[0]) | (f2bf(f[1]) << 16);
  r.y = f2bf(f[2]) | (f2bf(f[3]) << 16);
  r.z = f2bf(f[4]) | (f2bf(f[5]) << 16);
  r.w = f2bf(f[6]) | (f2bf(f[7]) << 16);
  return r;
}
DEVI float sigmoid_(float x) { return 1.f / (1.f + __expf(-x)); }
DEVI float silu_(float x) { return x * sigmoid_(x); }
DEVI float tanh_(float y) { float t = __expf(2.f * y); return 1.f - 2.f / (1.f + t); }
DEVI float gelu_(float x) {
  float y = 0.7978845608028654f * (x + 0.044715f * x * x * x);
  return 0.5f * x * (1.f + tanh_(y));
}
DEVI float wave_sum(float v) {
#pragma unroll
  for (int o = 32; o > 0; o >>= 1) v += __shfl_xor(v, o);
  return v;
}
DEVI float wave_max(float v) {
#pragma unroll
  for (int o = 32; o > 0; o >>= 1) v = fmaxf(v, __shfl_xor(v, o));
  return v;
}
template <int CTRL>
DEVI float dppf(float x) {
  return __int_as_float(__builtin_amdgcn_update_dpp(0, __float_as_int(x), CTRL, 0xF, 0xF, true));
}
DEVI float reduce16(float x) {
  x += dppf<0xB1>(x);
  x += dppf<0x4E>(x);
  x += dppf<0x141>(x);
  x += dppf<0x140>(x);
  return x;
}

constexpr int LROW = 40;

template <class ALoad, class Epi>
DEVI void gemm_tile(char* smem, const ALoad& aload, const bfu* __restrict__ Bt, int ldb, int K, int m0, int n0,
                    const Epi& epi) {
  bfu* sA = (bfu*)smem;
  bfu* sB = sA + 2 * 128 * LROW;
  const int tid = threadIdx.x, lane = tid & 63, wid = tid >> 6, wr = wid >> 1, wc = wid & 1;
  const int fr = lane & 15, fq = lane >> 4;
  f32x4 acc[4][4];
#pragma unroll
  for (int i = 0; i < 4; ++i)
#pragma unroll
    for (int j = 0; j < 4; ++j) acc[i][j] = f32x4{0.f, 0.f, 0.f, 0.f};
  const int r0 = tid >> 2, kc = (tid & 3) * 8;
  uint4 ra[2], rb[2];
  const int nk = K >> 5;
#pragma unroll
  for (int i = 0; i < 2; ++i) {
    ra[i] = aload(m0 + r0 + 64 * i, kc);
    rb[i] = *(const uint4*)(Bt + (size_t)(n0 + r0 + 64 * i) * ldb + kc);
  }
#pragma unroll
  for (int i = 0; i < 2; ++i) {
    *(uint4*)(sA + (r0 + 64 * i) * LROW + kc) = ra[i];
    *(uint4*)(sB + (r0 + 64 * i) * LROW + kc) = rb[i];
  }
  __syncthreads();
  for (int kt = 0; kt < nk; ++kt) {
    const int cur = kt & 1;
    const bool more = (kt + 1 < nk);
    if (more) {
      const int k0 = (kt + 1) << 5;
#pragma unroll
      for (int i = 0; i < 2; ++i) {
        ra[i] = aload(m0 + r0 + 64 * i, k0 + kc);
        rb[i] = *(const uint4*)(Bt + (size_t)(n0 + r0 + 64 * i) * ldb + k0 + kc);
      }
    }
    const bfu* cA = sA + cur * 128 * LROW;
    const bfu* cB = sB + cur * 128 * LROW;
    bf16x8 af[4], bfv[4];
#pragma unroll
    for (int i = 0; i < 4; ++i) {
      af[i] = *(const bf16x8*)(cA + (wr * 64 + i * 16 + fr) * LROW + fq * 8);
      bfv[i] = *(const bf16x8*)(cB + (wc * 64 + i * 16 + fr) * LROW + fq * 8);
    }
#pragma unroll
    for (int i = 0; i < 4; ++i)
#pragma unroll
      for (int j = 0; j < 4; ++j) acc[i][j] = __builtin_amdgcn_mfma_f32_16x16x32_bf16(af[i], bfv[j], acc[i][j], 0, 0, 0);
    if (more) {
      bfu* nA = sA + (cur ^ 1) * 128 * LROW;
      bfu* nB = sB + (cur ^ 1) * 128 * LROW;
#pragma unroll
      for (int i = 0; i < 2; ++i) {
        *(uint4*)(nA + (r0 + 64 * i) * LROW + kc) = ra[i];
        *(uint4*)(nB + (r0 + 64 * i) * LROW + kc) = rb[i];
      }
    }
    __syncthreads();
  }
#pragma unroll
  for (int i = 0; i < 4; ++i)
#pragma unroll
    for (int j = 0; j < 4; ++j) epi(m0 + wr * 64 + i * 16 + fq * 4, n0 + wc * 64 + j * 16 + fr, acc[i][j]);
}

struct ALoadPlain {
  const bfu* A;
  int lda;
  DEVI uint4 operator()(int row, int k) const { return *(const uint4*)(A + (size_t)row * lda + k); }
};

DEVI void transpose_tile(char* smem, const float* __restrict__ src, int Ns, bfu* __restrict__ dst, int ldd, int noff,
                         int k0, int n0) {
  float(*tile)[65] = (float(*)[65])smem;
  const int tid = threadIdx.x;
  const int kr = tid >> 4, nc = (tid & 15) * 4;
#pragma unroll
  for (int p = 0; p < 4; ++p) {
    float4 v = *(const float4*)(src + (size_t)(k0 + kr + 16 * p) * Ns + n0 + nc);
    tile[kr + 16 * p][nc] = v.x;
    tile[kr + 16 * p][nc + 1] = v.y;
    tile[kr + 16 * p][nc + 2] = v.z;
    tile[kr + 16 * p][nc + 3] = v.w;
  }
  __syncthreads();
  const int nr = tid >> 3, kc = (tid & 7) * 8;
#pragma unroll
  for (int p = 0; p < 2; ++p) {
    const int n = nr + 32 * p;
    float f[8];
#pragma unroll
    for (int j = 0; j < 8; ++j) f[j] = tile[kc + j][n];
    *(uint4*)(dst + (size_t)(noff + n0 + n) * ldd + k0 + kc) = pack8(f);
  }
  __syncthreads();
}

DEVI void rms_row_bf16(const float* __restrict__ src, const float* __restrict__ g, bfu* __restrict__ dst, int lane) {
  float4 v[4];
  float ss = 0.f;
#pragma unroll
  for (int i = 0; i < 4; ++i) {
    v[i] = *(const float4*)(src + lane * 4 + 256 * i);
    ss += v[i].x * v[i].x + v[i].y * v[i].y + v[i].z * v[i].z + v[i].w * v[i].w;
  }
  ss = wave_sum(ss);
  const float rinv = rsqrtf(ss * (1.f / 1024.f) + 1e-6f);
#pragma unroll
  for (int i = 0; i < 4; ++i) {
    float4 gg = *(const float4*)(g + lane * 4 + 256 * i);
    uint2 o;
    o.x = f2bf(v[i].x * rinv * gg.x) | (f2bf(v[i].y * rinv * gg.y) << 16);
    o.y = f2bf(v[i].z * rinv * gg.z) | (f2bf(v[i].w * rinv * gg.w) << 16);
    *(uint2*)(dst + lane * 4 + 256 * i) = o;
  }
}

DEVI void phase0(const Params& p, char* smem, int bid, int nb) {
  constexpr int NT_IN = 16 * 56, NT_SQ = 256, NT_SM = 16;
  constexpr int c0 = NT_IN, c1 = c0 + NT_SQ, c2 = c1 + 4 * NT_SQ, c3 = c2 + NT_SM, c4 = c3 + NT_SM, c5 = c4 + NT_SQ,
                c6 = c5 + NT_SM, c7 = c6 + NT_SM, c8 = c7 + 2, c9 = c8 + T_TOK / 4;
  for (int it = bid; it < c9; it += nb) {
    if (it < c0) {
      transpose_tile(smem, p.w_in, 3584, p.WT_in, 1024, 0, (it / 56) * 64, (it % 56) * 64);
    } else if (it < c1) {
      int j = it - c0;
      transpose_tile(smem, p.w_out, 1024, p.WT_out, 1024, 0, (j >> 4) * 64, (j & 15) * 64);
    } else if (it < c2) {
      int j = it - c1;
      int w = j >> 8;
      j &= 255;
      const float* src = (w == 0) ? p.wr : (w == 1) ? p.wk : (w == 2) ? p.wv : p.wg;
      transpose_tile(smem, src, 1024, p.WT_3, 1024, w * 1024, (j >> 4) * 64, (j & 15) * 64);
    } else if (it < c3) {
      int j = it - c2;
      transpose_tile(smem, p.w1, 64, p.WT_3, 1024, 4096, j * 64, 0);
    } else if (it < c4) {
      int j = it - c3;
      transpose_tile(smem, p.a1, 64, p.WT_3, 1024, 4224, j * 64, 0);
    } else if (it < c5) {
      int j = it - c4;
      transpose_tile(smem, p.wo, 1024, p.WT_o, 1024, 0, (j >> 4) * 64, (j & 15) * 64);
    } else if (it < c6) {
      int j = it - c5;
      transpose_tile(smem, p.w2, 1024, p.W2T, 64, 0, 0, j * 64);
    } else if (it < c7) {
      int j = it - c6;
      transpose_tile(smem, p.a2, 1024, p.A2T, 64, 0, 0, j * 64);
    } else if (it < c8) {
      int j = it - c7;
      bfu* dst = p.WT_3 + (size_t)(j == 0 ? 4160 : 4288) * 1024;
      for (int e = threadIdx.x; e < 64 * 1024 / 8; e += 256) *(uint4*)(dst + e * 8) = uint4{0, 0, 0, 0};
    } else {
      int row = (it - c8) * 4 + (threadIdx.x >> 6);
      rms_row_bf16(p.x + (size_t)row * 1024, p.ln_even, p.H + (size_t)row * 1024, threadIdx.x & 63);
    }
  }
}

struct Epi1 {
  const Params* p;
  int nt;
  DEVI void operator()(int row, int col, f32x4 v) const {
    if (nt < 4) {
#pragma unroll
      for (int i = 0; i < 4; ++i) p->U[(size_t)(row + i) * 512 + col] = (bfu)f2bf(gelu_(v[i]));
    } else if (nt < 8) {
      const int g = nt - 4, chunk = row >> 7, s = row & 127, c = col & 127;
      uint2 o;
      o.x = f2bf(gelu_(v[0])) | (f2bf(gelu_(v[1])) << 16);
      o.y = f2bf(gelu_(v[2])) | (f2bf(gelu_(v[3])) << 16);
      *(uint2*)(p->GVT + ((size_t)((chunk * 4 + g) * 128 + c)) * 128 + s) = o;
    } else if (nt < 12) {
#pragma unroll
      for (int i = 0; i < 4; ++i) p->Q[(size_t)(row + i) * 512 + col - 1024] = (bfu)f2bf(v[i]);
    } else if (nt < 16) {
#pragma unroll
      for (int i = 0; i < 4; ++i) p->K[(size_t)(row + i) * 512 + col - 1536] = (bfu)f2bf(v[i]);
    } else if (nt < 20) {
#pragma unroll
      for (int i = 0; i < 4; ++i) p->V[(size_t)(row + i) * 512 + col - 2048] = (bfu)f2bf(v[i]);
    } else {
#pragma unroll
      for (int i = 0; i < 4; ++i) p->SZ[(size_t)(row + i) * 1024 + col - 2560] = (bfu)f2bf(silu_(v[i]));
    }
  }
};

DEVI void phase1(const Params& p, char* smem, int bid, int nb) {
  constexpr int NT = 28, MT = T_TOK / 128;
  ALoadPlain al{p.H, 1024};
  for (int it = bid; it < MT * NT; it += nb) {
    const int mt = it / NT, nt = it % NT;
    Epi1 epi{&p, nt};
    gemm_tile(smem, al, p.WT_in, 1024, 1024, mt * 128, nt * 128, epi);
  }
}

struct ALoadWs {
  const float* ws;
  const float* rinv;
  DEVI uint4 operator()(int t, int s0) const {
    float4 a = *(const float4*)(ws + t * 128 + s0);
    float4 b = *(const float4*)(ws + t * 128 + s0 + 4);
    float f[8] = {a.x, a.y, a.z, a.w, b.x, b.y, b.z, b.w};
#pragma unroll
    for (int j = 0; j < 8; ++j) f[j] = (s0 + j <= t) ? f[j] * rinv[s0 + j] : 0.f;
    return pack8(f);
  }
};
struct EpiGm {
  const Params* p;
  int chunk, g;
  DEVI void operator()(int t, int c, f32x4 v) const {
    const float gn = p->gm_norm[g * 128 + c];
#pragma unroll
    for (int i = 0; i < 4; ++i) {
      const float val = v[i] * gn + p->gm_b[g * 128 + t + i];
      const size_t tok = (size_t)chunk * 128 + t + i;
      const float u = bf2f(p->U[tok * 512 + g * 128 + c]);
      const float sz = bf2f(p->SZ[tok * 1024 + g * 128 + c]);
      p->Y[tok * 1024 + g * 128 + c] = (bfu)f2bf(u * val * sz);
    }
  }
};

DEVI void gmlp_item(const Params& p, char* smem, int item) {
  const int chunk = item >> 2, g = item & 3;
  const bfu* gv = p.GVT + (size_t)item * 128 * 128;
  float* rinv = (float*)(smem + 40960);
  const int tid = threadIdx.x;
  if (tid < 128) {
    float ss = 0.f;
    for (int c = 0; c < 128; ++c) {
      float v = bf2f(gv[c * 128 + tid]);
      ss += v * v;
    }
    rinv[tid] = rsqrtf(ss * (1.f / 128.f) + 1e-6f);
  }
  __syncthreads();
  ALoadWs al{p.gm_ws + (size_t)g * 128 * 128, rinv};
  EpiGm epi{&p, chunk, g};
  gemm_tile(smem, al, gv, 128, 128, 0, 0, epi);
}

DEVI void attn_naive_task(const Params& p, float* pbuf, int t, int h, int lane) {
  const int s = t & (SEQ - 1);
  float qv[64];
  {
    const uint4* qp = (const uint4*)(p.Q + (size_t)t * 512 + h * 64);
#pragma unroll
    for (int i = 0; i < 8; ++i) unpack8(qp[i], qv + 8 * i);
  }
  const float slope = exp2f(-(float)(h + 1));
  float sc[9];
  float m = -INFINITY;
#pragma unroll
  for (int pi = 0; pi < 3; ++pi) {
    const int d = (pi == 0) ? 1 : (pi == 1) ? 4 : 16;
#pragma unroll
    for (int rd = 0; rd < 3; ++rd) {
      const int j = lane + 64 * rd;
      const bool valid = (j <= 128) && (s - j * d >= 0);
      float val = -INFINITY;
      if (valid) {
        const uint4* kp = (const uint4*)(p.K + (size_t)(t - j * d) * 512 + h * 64);
        float dot = 0.f;
#pragma unroll
        for (int i = 0; i < 8; ++i) {
          float kf[8];
          unpack8(kp[i], kf);
#pragma unroll
          for (int e = 0; e < 8; ++e) dot += qv[8 * i + e] * kf[e];
        }
        val = dot * 0.125f - slope * (float)(j * d);
      }
      sc[pi * 3 + rd] = val;
      m = fmaxf(m, val);
    }
  }
  m = wave_max(m);
  float l = 0.f;
#pragma unroll
  for (int i = 0; i < 9; ++i) {
    const float e = (sc[i] == -INFINITY) ? 0.f : __expf(sc[i] - m);
    l += e;
    pbuf[i * 64 + lane] = e;
  }
  l = wave_sum(l);
  __builtin_amdgcn_s_waitcnt(0);
  __builtin_amdgcn_wave_barrier();
  float o = 0.f;
  for (int i = 0; i < 9; ++i) {
    const int d = (i < 3) ? 1 : (i < 6) ? 4 : 16;
    const int rd = i % 3;
    const int jmax = (rd == 2) ? 1 : 64;
    for (int jj = 0; jj < jmax; ++jj) {
      const float pe = pbuf[i * 64 + jj];
      if (pe != 0.f) {
        const int j = jj + 64 * rd;
        o += pe * bf2f(p.V[(size_t)(t - j * d) * 512 + h * 64 + lane]);
      }
    }
  }
  __builtin_amdgcn_wave_barrier();
  const size_t oi = (size_t)t * 1024 + 512 + h * 64 + lane;
  p.Y[oi] = (bfu)f2bf(o / l * bf2f(p.SZ[oi]));
}

DEVI void phase2(const Params& p, char* smem, int bid, int nb) {
  constexpr int NG = (T_TOK / 128) * 4;
  constexpr int NA = T_TOK * 8 / 4;
  for (int it = bid; it < NG + NA; it += nb) {
    if (it < NG) {
      gmlp_item(p, smem, it);
    } else {
      const int task = (it - NG) * 4 + (threadIdx.x >> 6);
      float* pbuf = (float*)smem + (threadIdx.x >> 6) * 576;
      attn_naive_task(p, pbuf, task >> 3, task & 7, threadIdx.x & 63);
    }
  }
}

struct Epi3 {
  const Params* p;
  DEVI void operator()(int row, int col, f32x4 v) const {
#pragma unroll
    for (int i = 0; i < 4; ++i) {
      const size_t idx = (size_t)(row + i) * 1024 + col;
      p->out[idx] = p->x[idx] + v[i];
    }
  }
};
DEVI void phase3(const Params& p, char* smem, int bid, int nb) {
  ALoadPlain al{p.Y, 1024};
  Epi3 epi{&p};
  for (int it = bid; it < (T_TOK / 128) * 8; it += nb) gemm_tile(smem, al, p.WT_out, 1024, 1024, (it >> 3) * 128, (it & 7) * 128, epi);
}
DEVI void phase3b(const Params& p, int bid, int nb) {
  for (int it = bid; it < T_TOK / 4; it += nb) {
    const int row = it * 4 + (threadIdx.x >> 6);
    rms_row_bf16(p.out + (size_t)row * 1024, p.ln_odd, p.H + (size_t)row * 1024, threadIdx.x & 63);
  }
}

struct ALoadMix {
  const bfu* H;
  const float* mu;
  DEVI uint4 operator()(int row, int k) const {
    float c[8], pv[8];
    unpack8(*(const uint4*)(H + (size_t)row * 1024 + k), c);
    if ((row & (SEQ - 1)) != 0) {
      unpack8(*(const uint4*)(H + (size_t)(row - 1) * 1024 + k), pv);
    } else {
#pragma unroll
      for (int j = 0; j < 8; ++j) pv[j] = 0.f;
    }
    float4 m0 = *(const float4*)(mu + k), m1 = *(const float4*)(mu + k + 4);
    float mm[8] = {m0.x, m0.y, m0.z, m0.w, m1.x, m1.y, m1.z, m1.w};
#pragma unroll
    for (int j = 0; j < 8; ++j) c[j] = c[j] + (pv[j] - c[j]) * mm[j];
    return pack8(c);
  }
};
struct Epi4 {
  const Params* p;
  int nt;
  DEVI void operator()(int row, int col, f32x4 v) const {
    if (nt < 8) {
#pragma unroll
      for (int i = 0; i < 4; ++i) p->R[(size_t)(row + i) * 1024 + col] = (bfu)f2bf(v[i]);
    } else if (nt < 16) {
#pragma unroll
      for (int i = 0; i < 4; ++i) p->K1[(size_t)(row + i) * 1024 + col - 1024] = (bfu)f2bf(v[i]);
    } else if (nt < 24) {
#pragma unroll
      for (int i = 0; i < 4; ++i) p->V1[(size_t)(row + i) * 1024 + col - 2048] = (bfu)f2bf(v[i]);
    } else if (nt < 32) {
#pragma unroll
      for (int i = 0; i < 4; ++i) p->SG[(size_t)(row + i) * 1024 + col - 3072] = (bfu)f2bf(silu_(v[i]));
    } else if (nt == 32) {
      const int c = col - 4096;
      if (c < 64) {
#pragma unroll
        for (int i = 0; i < 4; ++i) p->TW[(size_t)(row + i) * 64 + c] = (bfu)f2bf(tanh_(v[i]));
      }
    } else {
      const int c = col - 4224;
      if (c < 64) {
#pragma unroll
        for (int i = 0; i < 4; ++i) p->TA[(size_t)(row + i) * 64 + c] = (bfu)f2bf(v[i]);
      }
    }
  }
};
DEVI void phase4(const Params& p, char* smem, int bid, int nb) {
  constexpr int NT = 34;
  for (int it = bid; it < (T_TOK / 128) * NT; it += nb) {
    const int mt = it / NT, nt = it % NT;
    const int mi = (nt < 8) ? 0 : (nt < 16) ? 2 : (nt < 24) ? 3 : (nt < 32) ? 5 : (nt == 32) ? 1 : 4;
    ALoadMix al{p.H, p.mu + mi * 1024};
    Epi4 epi{&p, nt};
    gemm_tile(smem, al, p.WT_3, 1024, 1024, mt * 128, nt * 128, epi);
  }
}

struct Epi5w {
  const Params* p;
  DEVI void operator()(int row, int col, f32x4 v) const {
    const float w0 = p->w0[col];
#pragma unroll
    for (int i = 0; i < 4; ++i) p->EW[(size_t)(row + i) * 1024 + col] = (bfu)f2bf(0.6065306597126334f * sigmoid_(w0 + v[i]));
  }
};
struct Epi5a {
  const Params* p;
  DEVI void operator()(int row, int col, f32x4 v) const {
    const float a0 = p->a0[col];
#pragma unroll
    for (int i = 0; i < 4; ++i) p->AA[(size_t)(row + i) * 1024 + col] = (bfu)f2bf(sigmoid_(a0 + v[i]));
  }
};
DEVI void phase5(const Params& p, char* smem, int bid, int nb) {
  constexpr int N1 = (T_TOK / 128) * 8;
  for (int it = bid; it < 2 * N1; it += nb) {
    if (it < N1) {
      ALoadPlain al{p.TW, 64};
      Epi5w epi{&p};
      gemm_tile(smem, al, p.W2T, 64, 64, (it >> 3) * 128, (it & 7) * 128, epi);
    } else {
      const int j = it - N1;
      ALoadPlain al{p.TA, 64};
      Epi5a epi{&p};
      gemm_tile(smem, al, p.A2T, 64, 64, (j >> 3) * 128, (j & 7) * 128, epi);
    }
  }
}

constexpr int TC = 32;
DEVI void scan_item(const Params& p, char* smem, int item) {
  const int bh = item >> 2, rg = item & 3;
  const int b = bh >> 4, h = bh & 15;
  float* sR = (float*)smem;
  float* sW = sR + TC * 64;
  float* sK = sW + TC * 64;
  float* sKK = sK + TC * 64;
  float* sB = sKK + TC * 64;
  float* sV = sB + TC * 64;
  float* sY = sV + TC * 16;
  const int tid = threadIdx.x, lane = tid & 63, wid = tid >> 6;
  const int lt = tid >> 3, lc = (tid & 7) * 8;
  const size_t base = ((size_t)b * SEQ) * 1024 + h * 64;
  float kkw[8], kaw[8];
#pragma unroll
  for (int j = 0; j < 8; ++j) {
    kkw[j] = p.k_k[h * 64 + lc + j];
    kaw[j] = p.k_a[h * 64 + lc + j];
  }
  const int row = wid * 4 + (lane >> 4);
  const int ks = (lane & 15) * 4;
  float s0 = 0.f, s1 = 0.f, s2 = 0.f, s3 = 0.f;
  uint4 gr, gk, gw, ga, gv;
  gv = uint4{0, 0, 0, 0};
  auto issue = [&](int t0) {
    const size_t o = base + (size_t)(t0 + lt) * 1024 + lc;
    gr = *(const uint4*)(p.R + o);
    gk = *(const uint4*)(p.K1 + o);
    gw = *(const uint4*)(p.EW + o);
    ga = *(const uint4*)(p.AA + o);
    if (tid < 64) gv = *(const uint4*)(p.V1 + base + (size_t)(t0 + (tid >> 1)) * 1024 + rg * 16 + (tid & 1) * 8);
  };
  auto commit = [&]() {
    float r[8], k[8], w[8], a[8], kk[8];
    unpack8(gr, r);
    unpack8(gk, k);
    unpack8(gw, w);
    unpack8(ga, a);
    float ss = 0.f;
#pragma unroll
    for (int j = 0; j < 8; ++j) {
      kk[j] = k[j] * kkw[j];
      ss += kk[j] * kk[j];
    }
    ss += __shfl_xor(ss, 1);
    ss += __shfl_xor(ss, 2);
    ss += __shfl_xor(ss, 4);
    const float rn = rsqrtf(fmaxf(ss, 1e-24f));
#pragma unroll
    for (int j = 0; j < 8; ++j) {
      kk[j] *= rn;
      const float kp = k[j] * (1.f + (a[j] - 1.f) * kaw[j]);
      sR[lt * 64 + lc + j] = r[j];
      sW[lt * 64 + lc + j] = __expf(-w[j]);
      sK[lt * 64 + lc + j] = kp;
      sKK[lt * 64 + lc + j] = kk[j];
      sB[lt * 64 + lc + j] = kk[j] * a[j];
    }
    if (tid < 64) {
      float v[8];
      unpack8(gv, v);
#pragma unroll
      for (int j = 0; j < 8; ++j) sV[(tid >> 1) * 16 + (tid & 1) * 8 + j] = v[j];
    }
  };
  issue(0);
  commit();
  __syncthreads();
  for (int t0 = 0; t0 < SEQ; t0 += TC) {
    const bool more = (t0 + TC < SEQ);
    if (more) issue(t0 + TC);
    for (int tt = 0; tt < TC; ++tt) {
      const float4 kk4 = *(const float4*)(sKK + tt * 64 + ks);
      const float4 w4 = *(const float4*)(sW + tt * 64 + ks);
      const float4 b4 = *(const float4*)(sB + tt * 64 + ks);
      const float4 k4 = *(const float4*)(sK + tt * 64 + ks);
      const float4 r4 = *(const float4*)(sR + tt * 64 + ks);
      const float vv = sV[tt * 16 + row];
      float d = s0 * kk4.x + s1 * kk4.y + s2 * kk4.z + s3 * kk4.w;
      d = reduce16(d);
      const float sa = -d;
      s0 = s0 * w4.x + sa * b4.x + vv * k4.x;
      s1 = s1 * w4.y + sa * b4.y + vv * k4.y;
      s2 = s2 * w4.z + sa * b4.z + vv * k4.z;
      s3 = s3 * w4.w + sa * b4.w + vv * k4.w;
      float y = s0 * r4.x + s1 * r4.y + s2 * r4.z + s3 * r4.w;
      y = reduce16(y);
      if ((lane & 15) == 0) sY[tt * 16 + row] = y;
    }
    __syncthreads();
    if (tid < 64) {
      float f[8];
#pragma unroll
      for (int j = 0; j < 8; ++j) f[j] = sY[(tid >> 1) * 16 + (tid & 1) * 8 + j];
      *(uint4*)(p.YS + base + (size_t)(t0 + (tid >> 1)) * 1024 + rg * 16 + (tid & 1) * 8) = pack8(f);
    }
    if (more) commit();
    __syncthreads();
  }
}
DEVI void phase6(const Params& p, char* smem, int bid, int nb) {
  for (int it = bid; it < 128; it += nb) scan_item(p, smem, it);
}

DEVI void phase6b(const Params& p, int bid, int nb) {
  for (int it = bid; it < T_TOK * 16 / 4; it += nb) {
    const int task = it * 4 + (threadIdx.x >> 6);
    const int lane = threadIdx.x & 63;
    const int t = task >> 4, h = task & 15;
    const size_t idx = (size_t)t * 1024 + h * 64 + lane;
    const int c = h * 64 + lane;
    const float ys = bf2f(p.YS[idx]);
    const float mean = wave_sum(ys) * (1.f / 64.f);
    const float dv = ys - mean;
    const float var = wave_sum(dv * dv) * (1.f / 64.f);
    float y = dv * rsqrtf(var + 64e-5f) * p.lnw[c] + p.lnb[c];
    const float r = bf2f(p.R[idx]), k = bf2f(p.K1[idx]), a = bf2f(p.AA[idx]), v = bf2f(p.V1[idx]);
    const float kp = k * (1.f + (a - 1.f) * p.k_a[c]);
    const float bon = wave_sum(r * kp * p.r_k[c]);
    y = (y + bon * v) * bf2f(p.SG[idx]);
    p.YS[idx] = (bfu)f2bf(y);
  }
}

struct Epi7 {
  const Params* p;
  DEVI void operator()(int row, int col, f32x4 v) const {
#pragma unroll
    for (int i = 0; i < 4; ++i) {
      const size_t idx = (size_t)(row + i) * 1024 + col;
      p->out[idx] = p->out[idx] + v[i];
    }
  }
};
DEVI void phase7(const Params& p, char* smem, int bid, int nb) {
  ALoadPlain al{p.YS, 1024};
  Epi7 epi{&p};
  for (int it = bid; it < (T_TOK / 128) * 8; it += nb) gemm_tile(smem, al, p.WT_o, 1024, 1024, (it >> 3) * 128, (it & 7) * 128, epi);
}
DEVI void phase8(const Params& p, int bid, int nb) {
  for (int it = bid; it < T_TOK / 4; it += nb) {
    const int row = it * 4 + (threadIdx.x >> 6);
    const int lane = threadIdx.x & 63;
    float* src = p.out + (size_t)row * 1024;
    float4 v[4];
    float ss = 0.f;
#pragma unroll
    for (int i = 0; i < 4; ++i) {
      v[i] = *(const float4*)(src + lane * 4 + 256 * i);
      ss += v[i].x * v[i].x + v[i].y * v[i].y + v[i].z * v[i].z + v[i].w * v[i].w;
    }
    ss = wave_sum(ss);
    const float rinv = rsqrtf(ss * (1.f / 1024.f) + 1e-6f);
#pragma unroll
    for (int i = 0; i < 4; ++i) {
      float4 g = *(const float4*)(p.fnorm + lane * 4 + 256 * i);
      float4 o = {v[i].x * rinv * g.x, v[i].y * rinv * g.y, v[i].z * rinv * g.z, v[i].w * rinv * g.w};
      *(float4*)(src + lane * 4 + 256 * i) = o;
    }
  }
}

template <int PH>
DEVI void run_phase(const Params& p, char* smem, int bid, int nb) {
  if (PH == 0) phase0(p, smem, bid, nb);
  if (PH == 1) phase1(p, smem, bid, nb);
  if (PH == 2) phase2(p, smem, bid, nb);
  if (PH == 3) phase3(p, smem, bid, nb);
  if (PH == 4) phase3b(p, bid, nb);
  if (PH == 5) phase4(p, smem, bid, nb);
  if (PH == 6) phase5(p, smem, bid, nb);
  if (PH == 7) phase6(p, smem, bid, nb);
  if (PH == 8) phase6b(p, bid, nb);
  if (PH == 9) phase7(p, smem, bid, nb);
  if (PH == 10) phase8(p, bid, nb);
}

template <int PH>
__global__ void __launch_bounds__(256) phase_kernel(Params p) {
  __shared__ __attribute__((aligned(16))) char smem[SMEM_BYTES];
  run_phase<PH>(p, smem, blockIdx.x, gridDim.x);
}

__global__ void __launch_bounds__(256) mega_kernel(Params p) {
  __shared__ __attribute__((aligned(16))) char smem[SMEM_BYTES];
  cg::grid_group grid = cg::this_grid();
  const int bid = blockIdx.x, nb = gridDim.x;
  run_phase<0>(p, smem, bid, nb); grid.sync();
  run_phase<1>(p, smem, bid, nb); grid.sync();
  run_phase<2>(p, smem, bid, nb); grid.sync();
  run_phase<3>(p, smem, bid, nb); grid.sync();
  run_phase<4>(p, smem, bid, nb); grid.sync();
  run_phase<5>(p, smem, bid, nb); grid.sync();
  run_phase<6>(p, smem, bid, nb); grid.sync();
  run_phase<7>(p, smem, bid, nb); grid.sync();
  run_phase<8>(p, smem, bid, nb); grid.sync();
  run_phase<9>(p, smem, bid, nb); grid.sync();
  run_phase<10>(p, smem, bid, nb);
}

extern "C" void kernel_launch(void* const* d_in, const int* in_sizes, int n_in, void* d_out, int out_size, void* d_ws,
                              size_t ws_size, hipStream_t stream) {
  Params p{};
  const float** fp = (const float**)&p;
  for (int i = 0; i < 26; ++i) fp[i] = (const float*)d_in[i];
  p.out = (float*)d_out;
  char* w = (char*)d_ws;
  size_t off = 0;
  auto take = [&](size_t bytes) {
    char* r = w + off;
    off += (bytes + 255) & ~(size_t)255;
    return (bfu*)r;
  };
  p.WT_in = take((size_t)3584 * 1024 * 2);
  p.WT_out = take((size_t)1024 * 1024 * 2);
  p.WT_3 = take((size_t)4352 * 1024 * 2);
  p.WT_o = take((size_t)1024 * 1024 * 2);
  p.W2T = take((size_t)1024 * 64 * 2);
  p.A2T = take((size_t)1024 * 64 * 2);
  p.TW = take((size_t)T_TOK * 64 * 2);
  p.TA = take((size_t)T_TOK * 64 * 2);
  const size_t SLOT = (size_t)T_TOK * 1024 * 2;
  bfu* slot0 = take(SLOT);
  bfu* slots = take(6 * SLOT);
  p.H = slot0;
  p.AA = slot0;
  p.U = slots;
  p.GVT = slots + SLOT / 4;
  p.Q = slots + 2 * (SLOT / 4);
  p.K = slots + 3 * (SLOT / 4);
  p.V = slots + 4 * (SLOT / 4);
  p.SZ = slots + 5 * (SLOT / 4);
  p.Y = slots + 7 * (SLOT / 4);
  p.R = slots;
  p.K1 = slots + 1 * (SLOT / 2);
  p.V1 = slots + 2 * (SLOT / 2);
  p.SG = slots + 3 * (SLOT / 2);
  p.EW = slots + 4 * (SLOT / 2);
  p.YS = slots + 5 * (SLOT / 2);
#if MEGA
  static int grid_blocks = 0;
  if (!grid_blocks) {
    int dev = 0, cus = 0, per_cu = 0;
    hipGetDevice(&dev);
    hipDeviceGetAttribute(&cus, hipDeviceAttributeMultiprocessorCount, dev);
    hipOccupancyMaxActiveBlocksPerMultiprocessor(&per_cu, mega_kernel, 256, 0);
    grid_blocks = cus * per_cu;
  }
  void* args[] = {&p};
  hipError_t e = hipLaunchCooperativeKernel((void*)mega_kernel, dim3(grid_blocks), dim3(256), args, 0, stream);
  if (e != hipSuccess) fprintf(stderr, "cooperative launch failed: %s (grid %d)\n", hipGetErrorString(e), grid_blocks);
#else
  const int G = 2048;
  phase_kernel<0><<<G, 256, 0, stream>>>(p);
  phase_kernel<1><<<G, 256, 0, stream>>>(p);
  phase_kernel<2><<<G, 256, 0, stream>>>(p);
  phase_kernel<3><<<G, 256, 0, stream>>>(p);
  phase_kernel<4><<<G, 256, 0, stream>>>(p);
  phase_kernel<5><<<G, 256, 0, stream>>>(p);
  phase_kernel<6><<<G, 256, 0, stream>>>(p);
  phase_kernel<7><<<128, 256, 0, stream>>>(p);
  phase_kernel<8><<<G, 256, 0, stream>>>(p);
  phase_kernel<9><<<G, 256, 0, stream>>>(p);
  phase_kernel<10><<<G, 256, 0, stream>>>(p);
#endif
}
```

```cpp
#include <hip/hip_runtime.h>
#include <hip/hip_cooperative_groups.h>
#include <stdint.h>
#include <cstdio>
namespace cg = cooperative_groups;

#ifndef MEGA
#define MEGA 1
#endif

typedef unsigned short bfu;
using bf16x8 = __attribute__((ext_vector_type(8))) short;
using f32x4 = __attribute__((ext_vector_type(4))) float;
#define DEVI __device__ __forceinline__

constexpr int T_TOK = 32768;
constexpr int SEQ = 16384;
constexpr int SMEM_BYTES = 49152;

struct Params {
  const float *x, *ln_even, *w_in, *gm_norm, *gm_ws, *gm_b, *w_out, *ln_odd, *mu, *wr, *wk, *wv, *wg, *w0, *w1, *w2,
      *a0, *a1, *a2, *k_k, *k_a, *r_k, *lnw, *lnb, *wo, *fnorm;
  float* out;
  bfu *WT_in, *WT_out, *WT_3, *WT_o, *W2T, *A2T;
  bfu *H, *U, *GVT, *Q, *K, *VT, *SZ, *Y, *R, *K1, *V1, *SG, *EW, *AA, *YS, *TW, *TA;
};

DEVI float bf2f(unsigned b) { return __uint_as_float(b << 16); }
DEVI unsigned f2bf(float x) {
  unsigned u = __float_as_uint(x);
  u += 0x7fffu + ((u >> 16) & 1u);
  return u >> 16;
}
DEVI void unpack8(uint4 v, float* f) {
  f[0] = __uint_as_float(v.x << 16); f[1] = __uint_as_float(v.x & 0xffff0000u);
  f[2] = __uint_as_float(v.y << 16); f[3] = __uint_as_float(v.y & 0xffff0000u);
  f[4] = __uint_as_float(v.z << 16); f[5] = __uint_as_float(v.z & 0xffff0000u);
  f[6] = __uint_as_float(v.w << 16); f[7] = __uint_as_float(v.w & 0xffff0000u);
}
DEVI uint4 pack8(const float* f) {
  uint4 r;
  r.x = f2bf(f[0]) | (f2bf(f[1]) << 16);
  r.y = f2bf(f[2]) | (f2bf(f[3]) << 16);
  r.z = f2bf(f[4]) | (f2bf(f[5]) << 16);
  r.w = f2bf(f[6]) | (f2bf(f[7]) << 16);
  return r;
}
DEVI float sigmoid_(float x) { return 1.f / (1.f + __expf(-x)); }
DEVI float silu_(float x) { return x * sigmoid_(x); }
DEVI float tanh_(float y) { float t = __expf(2.f * y); return 1.f - 2.f / (1.f + t); }
DEVI float gelu_(float x) {
  float y = 0.7978845608028654f * (x + 0.044715f * x * x * x);
  return 0.5f * x * (1.f + tanh_(y));
}
DEVI float wave_sum(float v) {
#pragma unroll
  for (int o = 32; o > 0; o >>= 1) v += __shfl_xor(v, o);
  return v;
}
DEVI float wave_max(float v) {
#pragma unroll
  for (int o = 32; o > 0; o >>= 1) v = fmaxf(v, __shfl_xor(v, o));
  return v;
}
template <int CTRL>
DEVI float dppf(float x) {
  return __int_as_float(__builtin_amdgcn_update_dpp(0, __float_as_int(x), CTRL, 0xF, 0xF, true));
}
DEVI float reduce16(float x) {
  x += dppf<0xB1>(x);
  x += dppf<0x4E>(x);
  x += dppf<0x141>(x);
  x += dppf<0x140>(x);
  return x;
}

constexpr int LROW = 40;

template <class ALoad, class Epi>
DEVI void gemm_tile(char* smem, const ALoad& aload, const bfu* __restrict__ Bt, int ldb, int K, int m0, int n0,
                    const Epi& epi) {
  bfu* sA = (bfu*)smem;
  bfu* sB = sA + 2 * 128 * LROW;
  const int tid = threadIdx.x, lane = tid & 63, wid = tid >> 6, wr = wid >> 1, wc = wid & 1;
  const int fr = lane & 15, fq = lane >> 4;
  f32x4 acc[4][4];
#pragma unroll
  for (int i = 0; i < 4; ++i)
#pragma unroll
    for (int j = 0; j < 4; ++j) acc[i][j] = f32x4{0.f, 0.f, 0.f, 0.f};
  const int r0 = tid >> 2, kc = (tid & 3) * 8;
  uint4 ra[2], rb[2];
  const int nk = K >> 5;
#pragma unroll
  for (int i = 0; i < 2; ++i) {
    ra[i] = aload(m0 + r0 + 64 * i, kc);
    rb[i] = *(const uint4*)(Bt + (size_t)(n0 + r0 + 64 * i) * ldb + kc);
  }
#pragma unroll
  for (int i = 0; i < 2; ++i) {
    *(uint4*)(sA + (r0 + 64 * i) * LROW + kc) = ra[i];
    *(uint4*)(sB + (r0 + 64 * i) * LROW + kc) = rb[i];
  }
  __syncthreads();
  for (int kt = 0; kt < nk; ++kt) {
    const int cur = kt & 1;
    const bool more = (kt + 1 < nk);
    if (more) {
      const int k0 = (kt + 1) << 5;
#pragma unroll
      for (int i = 0; i < 2; ++i) {
        ra[i] = aload(m0 + r0 + 64 * i, k0 + kc);
        rb[i] = *(const uint4*)(Bt + (size_t)(n0 + r0 + 64 * i) * ldb + k0 + kc);
      }
    }
    const bfu* cA = sA + cur * 128 * LROW;
    const bfu* cB = sB + cur * 128 * LROW;
    bf16x8 af[4], bfv[4];
#pragma unroll
    for (int i = 0; i < 4; ++i) {
      af[i] = *(const bf16x8*)(cA + (wr * 64 + i * 16 + fr) * LROW + fq * 8);
      bfv[i] = *(const bf16x8*)(cB + (wc * 64 + i * 16 + fr) * LROW + fq * 8);
    }
#pragma unroll
    for (int i = 0; i < 4; ++i)
#pragma unroll
      for (int j = 0; j < 4; ++j) acc[i][j] = __builtin_amdgcn_mfma_f32_16x16x32_bf16(af[i], bfv[j], acc[i][j], 0, 0, 0);
    if (more) {
      bfu* nA = sA + (cur ^ 1) * 128 * LROW;
      bfu* nB = sB + (cur ^ 1) * 128 * LROW;
#pragma unroll
      for (int i = 0; i < 2; ++i) {
        *(uint4*)(nA + (r0 + 64 * i) * LROW + kc) = ra[i];
        *(uint4*)(nB + (r0 + 64 * i) * LROW + kc) = rb[i];
      }
    }
    __syncthreads();
  }
#pragma unroll
  for (int i = 0; i < 4; ++i)
#pragma unroll
    for (int j = 0; j < 4; ++j) epi(m0 + wr * 64 + i * 16 + fq * 4, n0 + wc * 64 + j * 16 + fr, acc[i][j]);
}

struct ALoadPlain {
  const bfu* A;
  int lda;
  DEVI uint4 operator()(int row, int k) const { return *(const uint4*)(A + (size_t)row * lda + k); }
};

DEVI void transpose_tile(char* smem, const float* __restrict__ src, int Ns, bfu* __restrict__ dst, int ldd, int noff,
                         int k0, int n0) {
  float(*tile)[65] = (float(*)[65])smem;
  const int tid = threadIdx.x;
  const int kr = tid >> 4, nc = (tid & 15) * 4;
#pragma unroll
  for (int p = 0; p < 4; ++p) {
    float4 v = *(const float4*)(src + (size_t)(k0 + kr + 16 * p) * Ns + n0 + nc);
    tile[kr + 16 * p][nc] = v.x;
    tile[kr + 16 * p][nc + 1] = v.y;
    tile[kr + 16 * p][nc + 2] = v.z;
    tile[kr + 16 * p][nc + 3] = v.w;
  }
  __syncthreads();
  const int nr = tid >> 3, kc = (tid & 7) * 8;
#pragma unroll
  for (int p = 0; p < 2; ++p) {
    const int n = nr + 32 * p;
    float f[8];
#pragma unroll
    for (int j = 0; j < 8; ++j) f[j] = tile[kc + j][n];
    *(uint4*)(dst + (size_t)(noff + n0 + n) * ldd + k0 + kc) = pack8(f);
  }
  __syncthreads();
}

DEVI void rms_row_bf16(const float* __restrict__ src, const float* __restrict__ g, bfu* __restrict__ dst, int lane) {
  float4 v[4];
  float ss = 0.f;
#pragma unroll
  for (int i = 0; i < 4; ++i) {
    v[i] = *(const float4*)(src + lane * 4 + 256 * i);
    ss += v[i].x * v[i].x + v[i].y * v[i].y + v[i].z * v[i].z + v[i].w * v[i].w;
  }
  ss = wave_sum(ss);
  const float rinv = rsqrtf(ss * (1.f / 1024.f) + 1e-6f);
#pragma unroll
  for (int i = 0; i < 4; ++i) {
    float4 gg = *(const float4*)(g + lane * 4 + 256 * i);
    uint2 o;
    o.x = f2bf(v[i].x * rinv * gg.x) | (f2bf(v[i].y * rinv * gg.y) << 16);
    o.y = f2bf(v[i].z * rinv * gg.z) | (f2bf(v[i].w * rinv * gg.w) << 16);
    *(uint2*)(dst + lane * 4 + 256 * i) = o;
  }
}

DEVI void phase0(const Params& p, char* smem, int bid, int nb) {
  constexpr int NT_IN = 16 * 56, NT_SQ = 256, NT_SM = 16;
  constexpr int c0 = NT_IN, c1 = c0 + NT_SQ, c2 = c1 + 4 * NT_SQ, c3 = c2 + NT_SM, c4 = c3 + NT_SM, c5 = c4 + NT_SQ,
                c6 = c5 + NT_SM, c7 = c6 + NT_SM, c8 = c7 + 2, c9 = c8 + T_TOK / 4;
  for (int it = bid; it < c9; it += nb) {
    if (it < c0) {
      transpose_tile(smem, p.w_in, 3584, p.WT_in, 1024, 0, (it / 56) * 64, (it % 56) * 64);
    } else if (it < c1) {
      int j = it - c0;
      transpose_tile(smem, p.w_out, 1024, p.WT_out, 1024, 0, (j >> 4) * 64, (j & 15) * 64);
    } else if (it < c2) {
      int j = it - c1;
      int w = j >> 8;
      j &= 255;
      const float* src = (w == 0) ? p.wr : (w == 1) ? p.wk : (w == 2) ? p.wv : p.wg;
      transpose_tile(smem, src, 1024, p.WT_3, 1024, w * 1024, (j >> 4) * 64, (j & 15) * 64);
    } else if (it < c3) {
      int j = it - c2;
      transpose_tile(smem, p.w1, 64, p.WT_3, 1024, 4096, j * 64, 0);
    } else if (it < c4) {
      int j = it - c3;
      transpose_tile(smem, p.a1, 64, p.WT_3, 1024, 4224, j * 64, 0);
    } else if (it < c5) {
      int j = it - c4;
      transpose_tile(smem, p.wo, 1024, p.WT_o, 1024, 0, (j >> 4) * 64, (j & 15) * 64);
    } else if (it < c6) {
      int j = it - c5;
      transpose_tile(smem, p.w2, 1024, p.W2T, 64, 0, 0, j * 64);
    } else if (it < c7) {
      int j = it - c6;
      transpose_tile(smem, p.a2, 1024, p.A2T, 64, 0, 0, j * 64);
    } else if (it < c8) {
      int j = it - c7;
      bfu* dst = p.WT_3 + (size_t)(j == 0 ? 4160 : 4288) * 1024;
      for (int e = threadIdx.x; e < 64 * 1024 / 8; e += 256) *(uint4*)(dst + e * 8) = uint4{0, 0, 0, 0};
    } else {
      int row = (it - c8) * 4 + (threadIdx.x >> 6);
      rms_row_bf16(p.x + (size_t)row * 1024, p.ln_even, p.H + (size_t)row * 1024, threadIdx.x & 63);
    }
  }
}

struct Epi1 {
  const Params* p;
  int nt;
  DEVI void operator()(int row, int col, f32x4 v) const {
    if (nt < 4) {
#pragma unroll
      for (int i = 0; i < 4; ++i) p->U[(size_t)(row + i) * 512 + col] = (bfu)f2bf(gelu_(v[i]));
    } else if (nt < 8) {
      const int g = nt - 4, chunk = row >> 7, s = row & 127, c = col & 127;
      uint2 o;
      o.x = f2bf(gelu_(v[0])) | (f2bf(gelu_(v[1])) << 16);
      o.y = f2bf(gelu_(v[2])) | (f2bf(gelu_(v[3])) << 16);
      *(uint2*)(p->GVT + ((size_t)((chunk * 4 + g) * 128 + c)) * 128 + s) = o;
    } else if (nt < 12) {
#pragma unroll
      for (int i = 0; i < 4; ++i) p->Q[(size_t)(row + i) * 512 + col - 1024] = (bfu)f2bf(v[i]);
    } else if (nt < 16) {
#pragma unroll
      for (int i = 0; i < 4; ++i) p->K[(size_t)(row + i) * 512 + col - 1536] = (bfu)f2bf(v[i]);
    } else if (nt < 20) {
      const int cc = col - 2048, hh = cc >> 6, dim = cc & 63;
      const int b = row >> 14, s = row & (SEQ - 1);
      bfu* base = p->VT + ((size_t)((b * 8 + hh) * 64 + dim)) * SEQ;
      uint2 o;
      o.x = f2bf(v[0]) | (f2bf(v[1]) << 16);
      o.y = f2bf(v[2]) | (f2bf(v[3]) << 16);
      *(uint2*)(base + s) = o;
      bfu* b1 = base + (size_t)16 * 64 * SEQ;
#pragma unroll
      for (int i = 0; i < 4; ++i) b1[i * (SEQ / 4) + (s >> 2)] = (bfu)f2bf(v[i]);
      bfu* b2 = base + (size_t)2 * 16 * 64 * SEQ;
#pragma unroll
      for (int i = 0; i < 4; ++i) b2[((s + i) & 15) * (SEQ / 16) + (s >> 4)] = (bfu)f2bf(v[i]);
    } else {
#pragma unroll
      for (int i = 0; i < 4; ++i) p->SZ[(size_t)(row + i) * 1024 + col - 2560] = (bfu)f2bf(silu_(v[i]));
    }
  }
};

DEVI void phase1(const Params& p, char* smem, int bid, int nb) {
  constexpr int NT = 28, MT = T_TOK / 128;
  ALoadPlain al{p.H, 1024};
  for (int it = bid; it < MT * NT; it += nb) {
    const int mt = it / NT, nt = it % NT;
    Epi1 epi{&p, nt};
    gemm_tile(smem, al, p.WT_in, 1024, 1024, mt * 128, nt * 128, epi);
  }
}

struct ALoadWs {
  const float* ws;
  const float* rinv;
  DEVI uint4 operator()(int t, int s0) const {
    float4 a = *(const float4*)(ws + t * 128 + s0);
    float4 b = *(const float4*)(ws + t * 128 + s0 + 4);
    float f[8] = {a.x, a.y, a.z, a.w, b.x, b.y, b.z, b.w};
#pragma unroll
    for (int j = 0; j < 8; ++j) f[j] = (s0 + j <= t) ? f[j] * rinv[s0 + j] : 0.f;
    return pack8(f);
  }
};
struct EpiGm {
  const Params* p;
  int chunk, g;
  DEVI void operator()(int t, int c, f32x4 v) const {
    const float gn = p->gm_norm[g * 128 + c];
#pragma unroll
    for (int i = 0; i < 4; ++i) {
      const float val = v[i] * gn + p->gm_b[g * 128 + t + i];
      const size_t tok = (size_t)chunk * 128 + t + i;
      const float u = bf2f(p->U[tok * 512 + g * 128 + c]);
      const float sz = bf2f(p->SZ[tok * 1024 + g * 128 + c]);
      p->Y[tok * 1024 + g * 128 + c] = (bfu)f2bf(u * val * sz);
    }
  }
};

DEVI void gmlp_item(const Params& p, char* smem, int item) {
  const int chunk = item >> 2, g = item & 3;
  const bfu* gv = p.GVT + (size_t)item * 128 * 128;
  float* rinv = (float*)(smem + 40960);
  const int tid = threadIdx.x;
  if (tid < 128) {
    float ss = 0.f;
    for (int c = 0; c < 128; ++c) {
      float v = bf2f(gv[c * 128 + tid]);
      ss += v * v;
    }
    rinv[tid] = rsqrtf(ss * (1.f / 128.f) + 1e-6f);
  }
  __syncthreads();
  ALoadWs al{p.gm_ws + (size_t)g * 128 * 128, rinv};
  EpiGm epi{&p, chunk, g};
  gemm_tile(smem, al, gv, 128, 128, 0, 0, epi);
}

DEVI void attn_item(const Params& p, char* smem, int item) {
  const int qb = item & 63, bh = item >> 6, b = bh >> 3, h = bh & 7;
  const int q0 = qb * 256;
  bfu* Ob = (bfu*)smem;
  float* Mb = (float*)(smem + 32768);
  float* Lb = Mb + 256;
  const int tid = threadIdx.x, lane = tid & 63, wid = tid >> 6;
  const int qi = lane & 15, g = lane >> 4;
  const float slope = exp2f(-(float)(h + 1));
  const size_t tokb = (size_t)b * SEQ;
#pragma unroll 1
  for (int pi = 0; pi < 3; ++pi) {
    const int dshift = 2 * pi, d = 1 << dshift;
    const bfu* VT = p.VT + (size_t)pi * ((size_t)16 * 64 * SEQ) + (size_t)bh * 64 * SEQ;
#pragma unroll 1
    for (int u = wid; u < 16; u += 4) {
      const int r = u & (d - 1), tile = u >> dshift;
      const int sq0 = (q0 >> dshift) + tile * 16;
      const int sk0 = sq0 - 144;
      const int posq = ((sq0 + qi) << dshift) + r;
      const bfu* qp = p.Q + (tokb + posq) * 512 + h * 64 + g * 8;
      const bf16x8 qf0 = *(const bf16x8*)qp, qf1 = *(const bf16x8*)(qp + 32);
      const bfu* kbase = p.K + (tokb + r) * 512 + h * 64 + g * 8;
      const bfu* vbase = VT + (size_t)qi * SEQ + r * (SEQ >> dshift);
      bf16x8 kf[2][2];
      uint2 vf[4][2];
      auto loadkv = [&](int it) {
#pragma unroll
        for (int tt = 0; tt < 2; ++tt) {
          int sk = sk0 + (2 * it + tt) * 16 + qi;
          sk = sk < 0 ? 0 : sk;
          const bfu* kp = kbase + ((size_t)sk << dshift) * 512;
          kf[tt][0] = *(const bf16x8*)kp;
          kf[tt][1] = *(const bf16x8*)(kp + 32);
        }
        int kidx0 = sk0 + 32 * it + 4 * g, kidx1 = kidx0 + 16;
        kidx0 = kidx0 < 0 ? 0 : kidx0;
        kidx1 = kidx1 < 0 ? 0 : kidx1;
#pragma unroll
        for (int m = 0; m < 4; ++m) {
          vf[m][0] = *(const uint2*)(vbase + (size_t)(16 * m) * SEQ + kidx0);
          vf[m][1] = *(const uint2*)(vbase + (size_t)(16 * m) * SEQ + kidx1);
        }
      };
      loadkv(0);
      float mrun = -1e30f, l = 0.f;
      f32x4 O[4];
#pragma unroll
      for (int m = 0; m < 4; ++m) O[m] = f32x4{0.f, 0.f, 0.f, 0.f};
#pragma unroll 1
      for (int it = 0; it < 5; ++it) {
        bf16x8 ck[2][2];
        uint2 cv[4][2];
#pragma unroll
        for (int a = 0; a < 2; ++a)
#pragma unroll
          for (int c = 0; c < 2; ++c) ck[a][c] = kf[a][c];
#pragma unroll
        for (int m = 0; m < 4; ++m) {
          cv[m][0] = vf[m][0];
          cv[m][1] = vf[m][1];
        }
        if (it < 4) loadkv(it + 1);
        f32x4 S[2];
#pragma unroll
        for (int tt = 0; tt < 2; ++tt) {
          f32x4 z = {0.f, 0.f, 0.f, 0.f};
          z = __builtin_amdgcn_mfma_f32_16x16x32_bf16(ck[tt][0], qf0, z, 0, 0, 0);
          z = __builtin_amdgcn_mfma_f32_16x16x32_bf16(ck[tt][1], qf1, z, 0, 0, 0);
          S[tt] = z;
        }
        float mx = -INFINITY;
#pragma unroll
        for (int tt = 0; tt < 2; ++tt)
#pragma unroll
          for (int e = 0; e < 4; ++e) {
            const int kk = (2 * it + tt) * 16 + 4 * g + e;
            const int j = 144 + qi - kk;
            const bool valid = (j >= 0) && (j <= 128) && (sk0 + kk >= 0);
            const float sv = valid ? S[tt][e] * 0.125f - slope * (float)(j << dshift) : -INFINITY;
            S[tt][e] = sv;
            mx = fmaxf(mx, sv);
          }
        mx = fmaxf(mx, __shfl_xor(mx, 16));
        mx = fmaxf(mx, __shfl_xor(mx, 32));
        const float mnew = fmaxf(mrun, mx);
        const float alpha = __expf(mrun - mnew);
        mrun = mnew;
        float ls = 0.f;
#pragma unroll
        for (int tt = 0; tt < 2; ++tt)
#pragma unroll
          for (int e = 0; e < 4; ++e) {
            const float pe = __expf(S[tt][e] - mnew);
            S[tt][e] = pe;
            ls += pe;
          }
        l = l * alpha + ls;
        uint4 pk;
        pk.x = f2bf(S[0][0]) | (f2bf(S[0][1]) << 16);
        pk.y = f2bf(S[0][2]) | (f2bf(S[0][3]) << 16);
        pk.z = f2bf(S[1][0]) | (f2bf(S[1][1]) << 16);
        pk.w = f2bf(S[1][2]) | (f2bf(S[1][3]) << 16);
        const bf16x8 pf = __builtin_bit_cast(bf16x8, pk);
#pragma unroll
        for (int m = 0; m < 4; ++m) {
          O[m] *= alpha;
          const uint4 vv = {cv[m][0].x, cv[m][0].y, cv[m][1].x, cv[m][1].y};
          O[m] = __builtin_amdgcn_mfma_f32_16x16x32_bf16(__builtin_bit_cast(bf16x8, vv), pf, O[m], 0, 0, 0);
        }
      }
      l += __shfl_xor(l, 16);
      l += __shfl_xor(l, 32);
      const float mx = mrun;
      const float il = 1.f / l;
      const int ql = ((tile * 16 + qi) << dshift) + r;
      float wo = 0.f, wn = 1.f;
      float mnew = mx, lnew = l;
      if (pi > 0) {
        const float mo = Mb[ql], lo = Lb[ql];
        mnew = fmaxf(mo, mx);
        wo = lo * __expf(mo - mnew);
        wn = l * __expf(mx - mnew);
        lnew = wo + wn;
        const float inv = 1.f / lnew;
        wo *= inv;
        wn *= inv;
      }
      wn *= il;
#pragma unroll
      for (int m = 0; m < 4; ++m) {
        bfu* op = Ob + ql * 64 + 16 * m + 4 * g;
        float o[4];
        if (pi > 0) {
          const uint2 ov = *(const uint2*)op;
          o[0] = wo * bf2f(ov.x & 0xffffu) + wn * O[m][0];
          o[1] = wo * bf2f(ov.x >> 16) + wn * O[m][1];
          o[2] = wo * bf2f(ov.y & 0xffffu) + wn * O[m][2];
          o[3] = wo * bf2f(ov.y >> 16) + wn * O[m][3];
        } else {
#pragma unroll
          for (int e = 0; e < 4; ++e) o[e] = wn * O[m][e];
        }
        if (pi < 2) {
          uint2 w;
          w.x = f2bf(o[0]) | (f2bf(o[1]) << 16);
          w.y = f2bf(o[2]) | (f2bf(o[3]) << 16);
          *(uint2*)op = w;
        } else {
          const size_t oi = (tokb + q0 + ql) * 1024 + 512 + h * 64 + 16 * m + 4 * g;
          const uint2 sz = *(const uint2*)(p.SZ + oi);
          uint2 w;
          w.x = f2bf(o[0] * bf2f(sz.x & 0xffffu)) | (f2bf(o[1] * bf2f(sz.x >> 16)) << 16);
          w.y = f2bf(o[2] * bf2f(sz.y & 0xffffu)) | (f2bf(o[3] * bf2f(sz.y >> 16)) << 16);
          *(uint2*)(p.Y + oi) = w;
        }
      }
      if (pi < 2 && g == 0) {
        Mb[ql] = mnew;
        Lb[ql] = lnew;
      }
    }
    __syncthreads();
  }
}

DEVI void phase2(const Params& p, char* smem, int bid, int nb) {
  constexpr int NG = (T_TOK / 128) * 4;
  constexpr int NA = 16 * 64;
  for (int it = bid; it < NG + NA; it += nb) {
    if (it < NA) {
      attn_item(p, smem, it);
    } else {
      gmlp_item(p, smem, it - NA);
    }
  }
}

struct Epi3 {
  const Params* p;
  DEVI void operator()(int row, int col, f32x4 v) const {
#pragma unroll
    for (int i = 0; i < 4; ++i) {
      const size_t idx = (size_t)(row + i) * 1024 + col;
      p->out[idx] = p->x[idx] + v[i];
    }
  }
};
DEVI void phase3(const Params& p, char* smem, int bid, int nb) {
  ALoadPlain al{p.Y, 1024};
  Epi3 epi{&p};
  for (int it = bid; it < (T_TOK / 128) * 8; it += nb) gemm_tile(smem, al, p.WT_out, 1024, 1024, (it >> 3) * 128, (it & 7) * 128, epi);
}
DEVI void phase3b(const Params& p, int bid, int nb) {
  for (int it = bid; it < T_TOK / 4; it += nb) {
    const int row = it * 4 + (threadIdx.x >> 6);
    rms_row_bf16(p.out + (size_t)row * 1024, p.ln_odd, p.H + (size_t)row * 1024, threadIdx.x & 63);
  }
}

struct ALoadMix {
  const bfu* H;
  const float* mu;
  DEVI uint4 operator()(int row, int k) const {
    float c[8], pv[8];
    unpack8(*(const uint4*)(H + (size_t)row * 1024 + k), c);
    if ((row & (SEQ - 1)) != 0) {
      unpack8(*(const uint4*)(H + (size_t)(row - 1) * 1024 + k), pv);
    } else {
#pragma unroll
      for (int j = 0; j < 8; ++j) pv[j] = 0.f;
    }
    float4 m0 = *(const float4*)(mu + k), m1 = *(const float4*)(mu + k + 4);
    float mm[8] = {m0.x, m0.y, m0.z, m0.w, m1.x, m1.y, m1.z, m1.w};
#pragma unroll
    for (int j = 0; j < 8; ++j) c[j] = c[j] + (pv[j] - c[j]) * mm[j];
    return pack8(c);
  }
};
struct Epi4 {
  const Params* p;
  int nt;
  DEVI void operator()(int row, int col, f32x4 v) const {
    if (nt < 8) {
#pragma unroll
      for (int i = 0; i < 4; ++i) p->R[(size_t)(row + i) * 1024 + col] = (bfu)f2bf(v[i]);
    } else if (nt < 16) {
#pragma unroll
      for (int i = 0; i < 4; ++i) p->K1[(size_t)(row + i) * 1024 + col - 1024] = (bfu)f2bf(v[i]);
    } else if (nt < 24) {
#pragma unroll
      for (int i = 0; i < 4; ++i) p->V1[(size_t)(row + i) * 1024 + col - 2048] = (bfu)f2bf(v[i]);
    } else if (nt < 32) {
#pragma unroll
      for (int i = 0; i < 4; ++i) p->SG[(size_t)(row + i) * 1024 + col - 3072] = (bfu)f2bf(silu_(v[i]));
    } else if (nt == 32) {
      const int c = col - 4096;
      if (c < 64) {
#pragma unroll
        for (int i = 0; i < 4; ++i) p->TW[(size_t)(row + i) * 64 + c] = (bfu)f2bf(tanh_(v[i]));
      }
    } else {
      const int c = col - 4224;
      if (c < 64) {
#pragma unroll
        for (int i = 0; i < 4; ++i) p->TA[(size_t)(row + i) * 64 + c] = (bfu)f2bf(v[i]);
      }
    }
  }
};
DEVI void phase4(const Params& p, char* smem, int bid, int nb) {
  constexpr int NT = 34;
  for (int it = bid; it < (T_TOK / 128) * NT; it += nb) {
    const int mt = it / NT, nt = it % NT;
    const int mi = (nt < 8) ? 0 : (nt < 16) ? 2 : (nt < 24) ? 3 : (nt < 32) ? 5 : (nt == 32) ? 1 : 4;
    ALoadMix al{p.H, p.mu + mi * 1024};
    Epi4 epi{&p, nt};
    gemm_tile(smem, al, p.WT_3, 1024, 1024, mt * 128, nt * 128, epi);
  }
}

struct Epi5w {
  const Params* p;
  DEVI void operator()(int row, int col, f32x4 v) const {
    const float w0 = p->w0[col];
#pragma unroll
    for (int i = 0; i < 4; ++i) p->EW[(size_t)(row + i) * 1024 + col] = (bfu)f2bf(0.6065306597126334f * sigmoid_(w0 + v[i]));
  }
};
struct Epi5a {
  const Params* p;
  DEVI void operator()(int row, int col, f32x4 v) const {
    const float a0 = p->a0[col];
#pragma unroll
    for (int i = 0; i < 4; ++i) p->AA[(size_t)(row + i) * 1024 + col] = (bfu)f2bf(sigmoid_(a0 + v[i]));
  }
};
DEVI void phase5(const Params& p, char* smem, int bid, int nb) {
  constexpr int N1 = (T_TOK / 128) * 8;
  for (int it = bid; it < 2 * N1; it += nb) {
    if (it < N1) {
      ALoadPlain al{p.TW, 64};
      Epi5w epi{&p};
      gemm_tile(smem, al, p.W2T, 64, 64, (it >> 3) * 128, (it & 7) * 128, epi);
    } else {
      const int j = it - N1;
      ALoadPlain al{p.TA, 64};
      Epi5a epi{&p};
      gemm_tile(smem, al, p.A2T, 64, 64, (j >> 3) * 128, (j & 7) * 128, epi);
    }
  }
}

constexpr int TC = 32;
DEVI void scan_item(const Params& p, char* smem, int item) {
  const int bh = item >> 2, rg = item & 3;
  const int b = bh >> 4, h = bh & 15;
  float* sR = (float*)smem;
  float* sW = sR + TC * 64;
  float* sK = sW + TC * 64;
  float* sKK = sK + TC * 64;
  float* sB = sKK + TC * 64;
  float* sV = sB + TC * 64;
  float* sY = sV + TC * 16;
  const int tid = threadIdx.x, lane = tid & 63, wid = tid >> 6;
  const int lt = tid >> 3, lc = (tid & 7) * 8;
  const size_t base = ((size_t)b * SEQ) * 1024 + h * 64;
  float kkw[8], kaw[8];
#pragma unroll
  for (int j = 0; j < 8; ++j) {
    kkw[j] = p.k_k[h * 64 + lc + j];
    kaw[j] = p.k_a[h * 64 + lc + j];
  }
  const int row = wid * 4 + (lane >> 4);
  const int ks = (lane & 15) * 4;
  float s0 = 0.f, s1 = 0.f, s2 = 0.f, s3 = 0.f;
  uint4 gr, gk, gw, ga, gv;
  gv = uint4{0, 0, 0, 0};
  auto issue = [&](int t0) {
    const size_t o = base + (size_t)(t0 + lt) * 1024 + lc;
    gr = *(const uint4*)(p.R + o);
    gk = *(const uint4*)(p.K1 + o);
    gw = *(const uint4*)(p.EW + o);
    ga = *(const uint4*)(p.AA + o);
    if (tid < 64) gv = *(const uint4*)(p.V1 + base + (size_t)(t0 + (tid >> 1)) * 1024 + rg * 16 + (tid & 1) * 8);
  };
  auto commit = [&]() {
    float r[8], k[8], w[8], a[8], kk[8];
    unpack8(gr, r);
    unpack8(gk, k);
    unpack8(gw, w);
    unpack8(ga, a);
    float ss = 0.f;
#pragma unroll
    for (int j = 0; j < 8; ++j) {
      kk[j] = k[j] * kkw[j];
      ss += kk[j] * kk[j];
    }
    ss += __shfl_xor(ss, 1);
    ss += __shfl_xor(ss, 2);
    ss += __shfl_xor(ss, 4);
    const float rn = rsqrtf(fmaxf(ss, 1e-24f));
#pragma unroll
    for (int j = 0; j < 8; ++j) {
      kk[j] *= rn;
      const float kp = k[j] * (1.f + (a[j] - 1.f) * kaw[j]);
      sR[lt * 64 + lc + j] = r[j];
      sW[lt * 64 + lc + j] = __expf(-w[j]);
      sK[lt * 64 + lc + j] = kp;
      sKK[lt * 64 + lc + j] = kk[j];
      sB[lt * 64 + lc + j] = kk[j] * a[j];
    }
    if (tid < 64) {
      float v[8];
      unpack8(gv, v);
#pragma unroll
      for (int j = 0; j < 8; ++j) sV[(tid >> 1) * 16 + (tid & 1) * 8 + j] = v[j];
    }
  };
  issue(0);
  commit();
  __syncthreads();
  for (int t0 = 0; t0 < SEQ; t0 += TC) {
    const bool more = (t0 + TC < SEQ);
    if (more) issue(t0 + TC);
    for (int tt = 0; tt < TC; ++tt) {
      const float4 kk4 = *(const float4*)(sKK + tt * 64 + ks);
      const float4 w4 = *(const float4*)(sW + tt * 64 + ks);
      const float4 b4 = *(const float4*)(sB + tt * 64 + ks);
      const float4 k4 = *(const float4*)(sK + tt * 64 + ks);
      const float4 r4 = *(const float4*)(sR + tt * 64 + ks);
      const float vv = sV[tt * 16 + row];
      float d = s0 * kk4.x + s1 * kk4.y + s2 * kk4.z + s3 * kk4.w;
      d = reduce16(d);
      const float sa = -d;
      s0 = s0 * w4.x + sa * b4.x + vv * k4.x;
      s1 = s1 * w4.y + sa * b4.y + vv * k4.y;
      s2 = s2 * w4.z + sa * b4.z + vv * k4.z;
      s3 = s3 * w4.w + sa * b4.w + vv * k4.w;
      float y = s0 * r4.x + s1 * r4.y + s2 * r4.z + s3 * r4.w;
      y = reduce16(y);
      if ((lane & 15) == 0) sY[tt * 16 + row] = y;
    }
    __syncthreads();
    if (tid < 64) {
      float f[8];
#pragma unroll
      for (int j = 0; j < 8; ++j) f[j] = sY[(tid >> 1) * 16 + (tid & 1) * 8 + j];
      *(uint4*)(p.YS + base + (size_t)(t0 + (tid >> 1)) * 1024 + rg * 16 + (tid & 1) * 8) = pack8(f);
    }
    if (more) commit();
    __syncthreads();
  }
}
DEVI void phase6(const Params& p, char* smem, int bid, int nb) {
  for (int it = bid; it < 128; it += nb) scan_item(p, smem, it);
}

DEVI void phase6b(const Params& p, int bid, int nb) {
  for (int it = bid; it < T_TOK * 16 / 4; it += nb) {
    const int task = it * 4 + (threadIdx.x >> 6);
    const int lane = threadIdx.x & 63;
    const int t = task >> 4, h = task & 15;
    const size_t idx = (size_t)t * 1024 + h * 64 + lane;
    const int c = h * 64 + lane;
    const float ys = bf2f(p.YS[idx]);
    const float mean = wave_sum(ys) * (1.f / 64.f);
    const float dv = ys - mean;
    const float var = wave_sum(dv * dv) * (1.f / 64.f);
    float y = dv * rsqrtf(var + 64e-5f) * p.lnw[c] + p.lnb[c];
    const float r = bf2f(p.R[idx]), k = bf2f(p.K1[idx]), a = bf2f(p.AA[idx]), v = bf2f(p.V1[idx]);
    const float kp = k * (1.f + (a - 1.f) * p.k_a[c]);
    const float bon = wave_sum(r * kp * p.r_k[c]);
    y = (y + bon * v) * bf2f(p.SG[idx]);
    p.YS[idx] = (bfu)f2bf(y);
  }
}

struct Epi7 {
  const Params* p;
  DEVI void operator()(int row, int col, f32x4 v) const {
#pragma unroll
    for (int i = 0; i < 4; ++i) {
      const size_t idx = (size_t)(row + i) * 1024 + col;
      p->out[idx] = p->out[idx] + v[i];
    }
  }
};
DEVI void phase7(const Params& p, char* smem, int bid, int nb) {
  ALoadPlain al{p.YS, 1024};
  Epi7 epi{&p};
  for (int it = bid; it < (T_TOK / 128) * 8; it += nb) gemm_tile(smem, al, p.WT_o, 1024, 1024, (it >> 3) * 128, (it & 7) * 128, epi);
}
DEVI void phase8(const Params& p, int bid, int nb) {
  for (int it = bid; it < T_TOK / 4; it += nb) {
    const int row = it * 4 + (threadIdx.x >> 6);
    const int lane = threadIdx.x & 63;
    float* src = p.out + (size_t)row * 1024;
    float4 v[4];
    float ss = 0.f;
#pragma unroll
    for (int i = 0; i < 4; ++i) {
      v[i] = *(const float4*)(src + lane * 4 + 256 * i);
      ss += v[i].x * v[i].x + v[i].y * v[i].y + v[i].z * v[i].z + v[i].w * v[i].w;
    }
    ss = wave_sum(ss);
    const float rinv = rsqrtf(ss * (1.f / 1024.f) + 1e-6f);
#pragma unroll
    for (int i = 0; i < 4; ++i) {
      float4 g = *(const float4*)(p.fnorm + lane * 4 + 256 * i);
      float4 o = {v[i].x * rinv * g.x, v[i].y * rinv * g.y, v[i].z * rinv * g.z, v[i].w * rinv * g.w};
      *(float4*)(src + lane * 4 + 256 * i) = o;
    }
  }
}

template <int PH>
DEVI void run_phase(const Params& p, char* smem, int bid, int nb) {
  if (PH == 0) phase0(p, smem, bid, nb);
  if (PH == 1) phase1(p, smem, bid, nb);
  if (PH == 2) phase2(p, smem, bid, nb);
  if (PH == 3) phase3(p, smem, bid, nb);
  if (PH == 4) phase3b(p, bid, nb);
  if (PH == 5) phase4(p, smem, bid, nb);
  if (PH == 6) phase5(p, smem, bid, nb);
  if (PH == 7) phase6(p, smem, bid, nb);
  if (PH == 8) phase6b(p, bid, nb);
  if (PH == 9) phase7(p, smem, bid, nb);
  if (PH == 10) phase8(p, bid, nb);
}

template <int PH>
__global__ void __launch_bounds__(256, 2) phase_kernel(Params p) {
  __shared__ __attribute__((aligned(16))) char smem[SMEM_BYTES];
  run_phase<PH>(p, smem, blockIdx.x, gridDim.x);
}

__global__ void __launch_bounds__(256, 2) mega_kernel(Params p) {
  __shared__ __attribute__((aligned(16))) char smem[SMEM_BYTES];
  cg::grid_group grid = cg::this_grid();
  const int bid = blockIdx.x, nb = gridDim.x;
  run_phase<0>(p, smem, bid, nb); grid.sync();
  run_phase<1>(p, smem, bid, nb); grid.sync();
  run_phase<2>(p, smem, bid, nb); grid.sync();
  run_phase<3>(p, smem, bid, nb); grid.sync();
  run_phase<4>(p, smem, bid, nb); grid.sync();
  run_phase<5>(p, smem, bid, nb); grid.sync();
  run_phase<6>(p, smem, bid, nb); grid.sync();
  run_phase<7>(p, smem, bid, nb); grid.sync();
  run_phase<8>(p, smem, bid, nb); grid.sync();
  run_phase<9>(p, smem, bid, nb); grid.sync();
  run_phase<10>(p, smem, bid, nb);
}

extern "C" void kernel_launch(void* const* d_in, const int* in_sizes, int n_in, void* d_out, int out_size, void* d_ws,
                              size_t ws_size, hipStream_t stream) {
  Params p{};
  const float** fp = (const float**)&p;
  for (int i = 0; i < 26; ++i) fp[i] = (const float*)d_in[i];
  p.out = (float*)d_out;
  char* w = (char*)d_ws;
  size_t off = 0;
  auto take = [&](size_t bytes) {
    char* r = w + off;
    off += (bytes + 255) & ~(size_t)255;
    return (bfu*)r;
  };
  p.WT_in = take((size_t)3584 * 1024 * 2);
  p.WT_out = take((size_t)1024 * 1024 * 2);
  p.WT_3 = take((size_t)4352 * 1024 * 2);
  p.WT_o = take((size_t)1024 * 1024 * 2);
  p.W2T = take((size_t)1024 * 64 * 2);
  p.A2T = take((size_t)1024 * 64 * 2);
  p.TW = take((size_t)T_TOK * 64 * 2);
  p.TA = take((size_t)T_TOK * 64 * 2);
  const size_t SLOT = (size_t)T_TOK * 1024 * 2;
  bfu* slot0 = take(SLOT);
  bfu* slots = take(6 * SLOT);
  p.H = slot0;
  p.AA = slot0;
  p.U = slots;
  p.GVT = slots + SLOT / 4;
  p.Q = slots + 2 * (SLOT / 4);
  p.K = slots + 3 * (SLOT / 4);
  p.VT = slots + 4 * (SLOT / 4);
  p.SZ = slots + 7 * (SLOT / 4);
  p.Y = slots + 9 * (SLOT / 4);
  p.R = slots;
  p.K1 = slots + 1 * (SLOT / 2);
  p.V1 = slots + 2 * (SLOT / 2);
  p.SG = slots + 3 * (SLOT / 2);
  p.EW = slots + 4 * (SLOT / 2);
  p.YS = slots + 5 * (SLOT / 2);
#if MEGA
  static int grid_blocks = 0;
  if (!grid_blocks) {
    int dev = 0, cus = 0, per_cu = 0;
    hipGetDevice(&dev);
    hipDeviceGetAttribute(&cus, hipDeviceAttributeMultiprocessorCount, dev);
    hipOccupancyMaxActiveBlocksPerMultiprocessor(&per_cu, mega_kernel, 256, 0);
    grid_blocks = cus * per_cu;
  }
  void* args[] = {&p};
  hipError_t e = hipLaunchCooperativeKernel((void*)mega_kernel, dim3(grid_blocks), dim3(256), args, 0, stream);
  if (e != hipSuccess) fprintf(stderr, "cooperative launch failed: %s (grid %d)\n", hipGetErrorString(e), grid_blocks);
#else
  const int G = 2048;
  phase_kernel<0><<<G, 256, 0, stream>>>(p);
  phase_kernel<1><<<G, 256, 0, stream>>>(p);
  phase_kernel<2><<<G, 256, 0, stream>>>(p);
  phase_kernel<3><<<G, 256, 0, stream>>>(p);
  phase_kernel<4><<<G, 256, 0, stream>>>(p);
  phase_kernel<5><<<G, 256, 0, stream>>>(p);
  phase_kernel<6><<<G, 256, 0, stream>>>(p);
  phase_kernel<7><<<128, 256, 0, stream>>>(p);
  phase_kernel<8><<<G, 256, 0, stream>>>(p);
  phase_kernel<9><<<G, 256, 0, stream>>>(p);
  phase_kernel<10><<<G, 256, 0, stream>>>(p);
#endif
}
```

```cpp
#include <hip/hip_runtime.h>
#include <hip/hip_cooperative_groups.h>
#include <stdint.h>
#include <cstdio>
namespace cg = cooperative_groups;

#ifndef MEGA
#define MEGA 1
#endif

typedef unsigned short bfu;
using bf16x8 = __attribute__((ext_vector_type(8))) short;
using f32x4 = __attribute__((ext_vector_type(4))) float;
#define DEVI __device__ __forceinline__

constexpr int T_TOK = 32768;
constexpr int SEQ = 16384;
constexpr int SMEM_BYTES = 49152;

struct Params {
  const float *x, *ln_even, *w_in, *gm_norm, *gm_ws, *gm_b, *w_out, *ln_odd, *mu, *wr, *wk, *wv, *wg, *w0, *w1, *w2,
      *a0, *a1, *a2, *k_k, *k_a, *r_k, *lnw, *lnb, *wo, *fnorm;
  float* out;
  bfu *WT_in, *WT_out, *WT_3, *WT_o, *W2T, *A2T;
  bfu *H, *U, *GVT, *Q, *K, *VT, *SZ, *Y, *R, *K1, *V1, *SG, *EW, *AA, *YS, *TW, *TA, *GT, *MRT;
  float *G15, *COEF;
};

DEVI float bf2f(unsigned b) { return __uint_as_float(b << 16); }
DEVI unsigned f2bf(float x) {
  unsigned u = __float_as_uint(x);
  u += 0x7fffu + ((u >> 16) & 1u);
  return u >> 16;
}
DEVI void unpack8(uint4 v, float* f) {
  f[0] = __uint_as_float(v.x << 16); f[1] = __uint_as_float(v.x & 0xffff0000u);
  f[2] = __uint_as_float(v.y << 16); f[3] = __uint_as_float(v.y & 0xffff0000u);
  f[4] = __uint_as_float(v.z << 16); f[5] = __uint_as_float(v.z & 0xffff0000u);
  f[6] = __uint_as_float(v.w << 16); f[7] = __uint_as_float(v.w & 0xffff0000u);
}
DEVI uint4 pack8(const float* f) {
  uint4 r;
  r.x = f2bf(f[0]) | (f2bf(f[1]) << 16);
  r.y = f2bf(f[2]) | (f2bf(f[3]) << 16);
  r.z = f2bf(f[4]) | (f2bf(f[5]) << 16);
  r.w = f2bf(f[6]) | (f2bf(f[7]) << 16);
  return r;
}
DEVI float sigmoid_(float x) { return 1.f / (1.f + __expf(-x)); }
DEVI float silu_(float x) { return x * sigmoid_(x); }
DEVI float tanh_(float y) { float t = __expf(2.f * y); return 1.f - 2.f / (1.f + t); }
DEVI float gelu_(float x) {
  float y = 0.7978845608028654f * (x + 0.044715f * x * x * x);
  return 0.5f * x * (1.f + tanh_(y));
}
DEVI float wave_sum(float v) {
#pragma unroll
  for (int o = 32; o > 0; o >>= 1) v += __shfl_xor(v, o);
  return v;
}
DEVI float wave_max(float v) {
#pragma unroll
  for (int o = 32; o > 0; o >>= 1) v = fmaxf(v, __shfl_xor(v, o));
  return v;
}
template <int CTRL>
DEVI float dppf(float x) {
  return __int_as_float(__builtin_amdgcn_update_dpp(0, __float_as_int(x), CTRL, 0xF, 0xF, true));
}
DEVI float reduce16(float x) {
  x += dppf<0xB1>(x);
  x += dppf<0x4E>(x);
  x += dppf<0x141>(x);
  x += dppf<0x140>(x);
  return x;
}

constexpr int LROW = 40;

template <class ALoad, class Epi>
DEVI void gemm_tile(char* smem, const ALoad& aload, const bfu* __restrict__ Bt, int ldb, int K, int m0, int n0,
                    const Epi& epi) {
  bfu* sA = (bfu*)smem;
  bfu* sB = sA + 2 * 128 * LROW;
  const int tid = threadIdx.x, lane = tid & 63, wid = tid >> 6, wr = wid >> 1, wc = wid & 1;
  const int fr = lane & 15, fq = lane >> 4;
  f32x4 acc[4][4];
#pragma unroll
  for (int i = 0; i < 4; ++i)
#pragma unroll
    for (int j = 0; j < 4; ++j) acc[i][j] = f32x4{0.f, 0.f, 0.f, 0.f};
  const int r0 = tid >> 2, kc = (tid & 3) * 8;
  uint4 ra[2], rb[2];
  const int nk = K >> 5;
#pragma unroll
  for (int i = 0; i < 2; ++i) {
    ra[i] = aload(m0 + r0 + 64 * i, kc);
    rb[i] = *(const uint4*)(Bt + (size_t)(n0 + r0 + 64 * i) * ldb + kc);
  }
#pragma unroll
  for (int i = 0; i < 2; ++i) {
    *(uint4*)(sA + (r0 + 64 * i) * LROW + kc) = ra[i];
    *(uint4*)(sB + (r0 + 64 * i) * LROW + kc) = rb[i];
  }
  __syncthreads();
  for (int kt = 0; kt < nk; ++kt) {
    const int cur = kt & 1;
    const bool more = (kt + 1 < nk);
    if (more) {
      const int k0 = (kt + 1) << 5;
#pragma unroll
      for (int i = 0; i < 2; ++i) {
        ra[i] = aload(m0 + r0 + 64 * i, k0 + kc);
        rb[i] = *(const uint4*)(Bt + (size_t)(n0 + r0 + 64 * i) * ldb + k0 + kc);
      }
    }
    const bfu* cA = sA + cur * 128 * LROW;
    const bfu* cB = sB + cur * 128 * LROW;
    bf16x8 af[4], bfv[4];
#pragma unroll
    for (int i = 0; i < 4; ++i) {
      af[i] = *(const bf16x8*)(cA + (wr * 64 + i * 16 + fr) * LROW + fq * 8);
      bfv[i] = *(const bf16x8*)(cB + (wc * 64 + i * 16 + fr) * LROW + fq * 8);
    }
#pragma unroll
    for (int i = 0; i < 4; ++i)
#pragma unroll
      for (int j = 0; j < 4; ++j) acc[i][j] = __builtin_amdgcn_mfma_f32_16x16x32_bf16(af[i], bfv[j], acc[i][j], 0, 0, 0);
    if (more) {
      bfu* nA = sA + (cur ^ 1) * 128 * LROW;
      bfu* nB = sB + (cur ^ 1) * 128 * LROW;
#pragma unroll
      for (int i = 0; i < 2; ++i) {
        *(uint4*)(nA + (r0 + 64 * i) * LROW + kc) = ra[i];
        *(uint4*)(nB + (r0 + 64 * i) * LROW + kc) = rb[i];
      }
    }
    __syncthreads();
  }
#pragma unroll
  for (int i = 0; i < 4; ++i)
#pragma unroll
    for (int j = 0; j < 4; ++j) epi(m0 + wr * 64 + i * 16 + fq * 4, n0 + wc * 64 + j * 16 + fr, acc[i][j]);
}

struct ALoadPlain {
  const bfu* A;
  int lda;
  DEVI uint4 operator()(int row, int k) const { return *(const uint4*)(A + (size_t)row * lda + k); }
};

DEVI void transpose_tile(char* smem, const float* __restrict__ src, int Ns, bfu* __restrict__ dst, int ldd, int noff,
                         int k0, int n0) {
  float(*tile)[65] = (float(*)[65])smem;
  const int tid = threadIdx.x;
  const int kr = tid >> 4, nc = (tid & 15) * 4;
#pragma unroll
  for (int p = 0; p < 4; ++p) {
    float4 v = *(const float4*)(src + (size_t)(k0 + kr + 16 * p) * Ns + n0 + nc);
    tile[kr + 16 * p][nc] = v.x;
    tile[kr + 16 * p][nc + 1] = v.y;
    tile[kr + 16 * p][nc + 2] = v.z;
    tile[kr + 16 * p][nc + 3] = v.w;
  }
  __syncthreads();
  const int nr = tid >> 3, kc = (tid & 7) * 8;
#pragma unroll
  for (int p = 0; p < 2; ++p) {
    const int n = nr + 32 * p;
    float f[8];
#pragma unroll
    for (int j = 0; j < 8; ++j) f[j] = tile[kc + j][n];
    *(uint4*)(dst + (size_t)(noff + n0 + n) * ldd + k0 + kc) = pack8(f);
  }
  __syncthreads();
}

DEVI void rms_row_bf16(const float* __restrict__ src, const float* __restrict__ g, bfu* __restrict__ dst, int lane) {
  float4 v[4];
  float ss = 0.f;
#pragma unroll
  for (int i = 0; i < 4; ++i) {
    v[i] = *(const float4*)(src + lane * 4 + 256 * i);
    ss += v[i].x * v[i].x + v[i].y * v[i].y + v[i].z * v[i].z + v[i].w * v[i].w;
  }
  ss = wave_sum(ss);
  const float rinv = rsqrtf(ss * (1.f / 1024.f) + 1e-6f);
#pragma unroll
  for (int i = 0; i < 4; ++i) {
    float4 gg = *(const float4*)(g + lane * 4 + 256 * i);
    uint2 o;
    o.x = f2bf(v[i].x * rinv * gg.x) | (f2bf(v[i].y * rinv * gg.y) << 16);
    o.y = f2bf(v[i].z * rinv * gg.z) | (f2bf(v[i].w * rinv * gg.w) << 16);
    *(uint2*)(dst + lane * 4 + 256 * i) = o;
  }
}

DEVI void phase0(const Params& p, char* smem, int bid, int nb) {
  constexpr int NT_IN = 16 * 56, NT_SQ = 256, NT_SM = 16;
  constexpr int c0 = NT_IN, c1 = c0 + NT_SQ, c2 = c1 + 4 * NT_SQ, c3 = c2 + NT_SM, c4 = c3 + NT_SM, c5 = c4 + NT_SQ,
                c6 = c5 + NT_SM, c7 = c6 + NT_SM, c8 = c7 + 2, c9 = c8 + T_TOK / 4;
  for (int it = bid; it < c9; it += nb) {
    if (it < c0) {
      transpose_tile(smem, p.w_in, 3584, p.WT_in, 1024, 0, (it / 56) * 64, (it % 56) * 64);
    } else if (it < c1) {
      int j = it - c0;
      transpose_tile(smem, p.w_out, 1024, p.WT_out, 1024, 0, (j >> 4) * 64, (j & 15) * 64);
    } else if (it < c2) {
      int j = it - c1;
      int w = j >> 8;
      j &= 255;
      const float* src = (w == 0) ? p.wr : (w == 1) ? p.wk : (w == 2) ? p.wv : p.wg;
      transpose_tile(smem, src, 1024, p.WT_3, 1024, w * 1024, (j >> 4) * 64, (j & 15) * 64);
    } else if (it < c3) {
      int j = it - c2;
      transpose_tile(smem, p.w1, 64, p.WT_3, 1024, 4096, j * 64, 0);
    } else if (it < c4) {
      int j = it - c3;
      transpose_tile(smem, p.a1, 64, p.WT_3, 1024, 4224, j * 64, 0);
    } else if (it < c5) {
      int j = it - c4;
      transpose_tile(smem, p.wo, 1024, p.WT_o, 1024, 0, (j >> 4) * 64, (j & 15) * 64);
    } else if (it < c6) {
      int j = it - c5;
      transpose_tile(smem, p.w2, 1024, p.W2T, 64, 0, 0, j * 64);
    } else if (it < c7) {
      int j = it - c6;
      transpose_tile(smem, p.a2, 1024, p.A2T, 64, 0, 0, j * 64);
    } else if (it < c8) {
      int j = it - c7;
      bfu* dst = p.WT_3 + (size_t)(j == 0 ? 4160 : 4288) * 1024;
      for (int e = threadIdx.x; e < 64 * 1024 / 8; e += 256) *(uint4*)(dst + e * 8) = uint4{0, 0, 0, 0};
    } else {
      int row = (it - c8) * 4 + (threadIdx.x >> 6);
      rms_row_bf16(p.x + (size_t)row * 1024, p.ln_even, p.H + (size_t)row * 1024, threadIdx.x & 63);
    }
  }
}

struct Epi1 {
  const Params* p;
  int nt;
  DEVI void operator()(int row, int col, f32x4 v) const {
    if (nt < 4) {
#pragma unroll
      for (int i = 0; i < 4; ++i) p->U[(size_t)(row + i) * 512 + col] = (bfu)f2bf(gelu_(v[i]));
    } else if (nt < 8) {
      const int g = nt - 4, chunk = row >> 7, s = row & 127, c = col & 127;
      uint2 o;
      o.x = f2bf(gelu_(v[0])) | (f2bf(gelu_(v[1])) << 16);
      o.y = f2bf(gelu_(v[2])) | (f2bf(gelu_(v[3])) << 16);
      *(uint2*)(p->GVT + ((size_t)((chunk * 4 + g) * 128 + c)) * 128 + s) = o;
    } else if (nt < 12) {
#pragma unroll
      for (int i = 0; i < 4; ++i) p->Q[(size_t)(row + i) * 512 + col - 1024] = (bfu)f2bf(v[i]);
    } else if (nt < 16) {
#pragma unroll
      for (int i = 0; i < 4; ++i) p->K[(size_t)(row + i) * 512 + col - 1536] = (bfu)f2bf(v[i]);
    } else if (nt < 20) {
      const int cc = col - 2048, hh = cc >> 6, dim = cc & 63;
      const int b = row >> 14, s = row & (SEQ - 1);
      bfu* base = p->VT + ((size_t)((b * 8 + hh) * 64 + dim)) * SEQ;
      uint2 o;
      o.x = f2bf(v[0]) | (f2bf(v[1]) << 16);
      o.y = f2bf(v[2]) | (f2bf(v[3]) << 16);
      *(uint2*)(base + s) = o;
      bfu* b1 = base + (size_t)16 * 64 * SEQ;
#pragma unroll
      for (int i = 0; i < 4; ++i) b1[i * (SEQ / 4) + (s >> 2)] = (bfu)f2bf(v[i]);
      bfu* b2 = base + (size_t)2 * 16 * 64 * SEQ;
#pragma unroll
      for (int i = 0; i < 4; ++i) b2[((s + i) & 15) * (SEQ / 16) + (s >> 4)] = (bfu)f2bf(v[i]);
    } else {
#pragma unroll
      for (int i = 0; i < 4; ++i) p->SZ[(size_t)(row + i) * 1024 + col - 2560] = (bfu)f2bf(silu_(v[i]));
    }
  }
};

DEVI void phase1(const Params& p, char* smem, int bid, int nb) {
  constexpr int NT = 28, MT = T_TOK / 128;
  ALoadPlain al{p.H, 1024};
  for (int it = bid; it < MT * NT; it += nb) {
    const int mt = it / NT, nt = it % NT;
    Epi1 epi{&p, nt};
    gemm_tile(smem, al, p.WT_in, 1024, 1024, mt * 128, nt * 128, epi);
  }
}

struct ALoadWs {
  const float* ws;
  const float* rinv;
  DEVI uint4 operator()(int t, int s0) const {
    float4 a = *(const float4*)(ws + t * 128 + s0);
    float4 b = *(const float4*)(ws + t * 128 + s0 + 4);
    float f[8] = {a.x, a.y, a.z, a.w, b.x, b.y, b.z, b.w};
#pragma unroll
    for (int j = 0; j < 8; ++j) f[j] = (s0 + j <= t) ? f[j] * rinv[s0 + j] : 0.f;
    return pack8(f);
  }
};
struct EpiGm {
  const Params* p;
  int chunk, g;
  DEVI void operator()(int t, int c, f32x4 v) const {
    const float gn = p->gm_norm[g * 128 + c];
#pragma unroll
    for (int i = 0; i < 4; ++i) {
      const float val = v[i] * gn + p->gm_b[g * 128 + t + i];
      const size_t tok = (size_t)chunk * 128 + t + i;
      const float u = bf2f(p->U[tok * 512 + g * 128 + c]);
      const float sz = bf2f(p->SZ[tok * 1024 + g * 128 + c]);
      p->Y[tok * 1024 + g * 128 + c] = (bfu)f2bf(u * val * sz);
    }
  }
};

DEVI void gmlp_item(const Params& p, char* smem, int item) {
  const int chunk = item >> 2, g = item & 3;
  const bfu* gv = p.GVT + (size_t)item * 128 * 128;
  float* rinv = (float*)(smem + 40960);
  const int tid = threadIdx.x;
  if (tid < 128) {
    float ss = 0.f;
    for (int c = 0; c < 128; ++c) {
      float v = bf2f(gv[c * 128 + tid]);
      ss += v * v;
    }
    rinv[tid] = rsqrtf(ss * (1.f / 128.f) + 1e-6f);
  }
  __syncthreads();
  ALoadWs al{p.gm_ws + (size_t)g * 128 * 128, rinv};
  EpiGm epi{&p, chunk, g};
  gemm_tile(smem, al, gv, 128, 128, 0, 0, epi);
}

DEVI void attn_item(const Params& p, char* smem, int item) {
  const int qb = item & 63, bh = item >> 6, b = bh >> 3, h = bh & 7;
  const int q0 = qb * 256;
  bfu* Ob = (bfu*)smem;
  float* Mb = (float*)(smem + 32768);
  float* Lb = Mb + 256;
  const int tid = threadIdx.x, lane = tid & 63, wid = tid >> 6;
  const int qi = lane & 15, g = lane >> 4;
  const float slope = exp2f(-(float)(h + 1));
  const size_t tokb = (size_t)b * SEQ;
#pragma unroll 1
  for (int pi = 0; pi < 3; ++pi) {
    const int dshift = 2 * pi, d = 1 << dshift;
    const bfu* VT = p.VT + (size_t)pi * ((size_t)16 * 64 * SEQ) + (size_t)bh * 64 * SEQ;
#pragma unroll 1
    for (int u = wid; u < 16; u += 4) {
      const int r = u & (d - 1), tile = u >> dshift;
      const int sq0 = (q0 >> dshift) + tile * 16;
      const int sk0 = sq0 - 144;
      const int posq = ((sq0 + qi) << dshift) + r;
      const bfu* qp = p.Q + (tokb + posq) * 512 + h * 64 + g * 8;
      const bf16x8 qf0 = *(const bf16x8*)qp, qf1 = *(const bf16x8*)(qp + 32);
      const bfu* kbase = p.K + (tokb + r) * 512 + h * 64 + g * 8;
      const bfu* vbase = VT + (size_t)qi * SEQ + r * (SEQ >> dshift);
      bf16x8 kf[2][2];
      uint2 vf[4][2];
      auto loadkv = [&](int it) {
#pragma unroll
        for (int tt = 0; tt < 2; ++tt) {
          int sk = sk0 + (2 * it + tt) * 16 + qi;
          sk = sk < 0 ? 0 : sk;
          const bfu* kp = kbase + ((size_t)sk << dshift) * 512;
          kf[tt][0] = *(const bf16x8*)kp;
          kf[tt][1] = *(const bf16x8*)(kp + 32);
        }
        int kidx0 = sk0 + 32 * it + 4 * g, kidx1 = kidx0 + 16;
        kidx0 = kidx0 < 0 ? 0 : kidx0;
        kidx1 = kidx1 < 0 ? 0 : kidx1;
#pragma unroll
        for (int m = 0; m < 4; ++m) {
          vf[m][0] = *(const uint2*)(vbase + (size_t)(16 * m) * SEQ + kidx0);
          vf[m][1] = *(const uint2*)(vbase + (size_t)(16 * m) * SEQ + kidx1);
        }
      };
      loadkv(0);
      float mrun = -1e30f, l = 0.f;
      f32x4 O[4];
#pragma unroll
      for (int m = 0; m < 4; ++m) O[m] = f32x4{0.f, 0.f, 0.f, 0.f};
#pragma unroll 1
      for (int it = 0; it < 5; ++it) {
        bf16x8 ck[2][2];
        uint2 cv[4][2];
#pragma unroll
        for (int a = 0; a < 2; ++a)
#pragma unroll
          for (int c = 0; c < 2; ++c) ck[a][c] = kf[a][c];
#pragma unroll
        for (int m = 0; m < 4; ++m) {
          cv[m][0] = vf[m][0];
          cv[m][1] = vf[m][1];
        }
        if (it < 4) loadkv(it + 1);
        f32x4 S[2];
#pragma unroll
        for (int tt = 0; tt < 2; ++tt) {
          f32x4 z = {0.f, 0.f, 0.f, 0.f};
          z = __builtin_amdgcn_mfma_f32_16x16x32_bf16(ck[tt][0], qf0, z, 0, 0, 0);
          z = __builtin_amdgcn_mfma_f32_16x16x32_bf16(ck[tt][1], qf1, z, 0, 0, 0);
          S[tt] = z;
        }
        float mx = -INFINITY;
#pragma unroll
        for (int tt = 0; tt < 2; ++tt)
#pragma unroll
          for (int e = 0; e < 4; ++e) {
            const int kk = (2 * it + tt) * 16 + 4 * g + e;
            const int j = 144 + qi - kk;
            const bool valid = (j >= 0) && (j <= 128) && (sk0 + kk >= 0);
            const float sv = valid ? S[tt][e] * 0.125f - slope * (float)(j << dshift) : -INFINITY;
            S[tt][e] = sv;
            mx = fmaxf(mx, sv);
          }
        mx = fmaxf(mx, __shfl_xor(mx, 16));
        mx = fmaxf(mx, __shfl_xor(mx, 32));
        const float mnew = fmaxf(mrun, mx);
        const float alpha = __expf(mrun - mnew);
        mrun = mnew;
        float ls = 0.f;
#pragma unroll
        for (int tt = 0; tt < 2; ++tt)
#pragma unroll
          for (int e = 0; e < 4; ++e) {
            const float pe = __expf(S[tt][e] - mnew);
            S[tt][e] = pe;
            ls += pe;
          }
        l = l * alpha + ls;
        uint4 pk;
        pk.x = f2bf(S[0][0]) | (f2bf(S[0][1]) << 16);
        pk.y = f2bf(S[0][2]) | (f2bf(S[0][3]) << 16);
        pk.z = f2bf(S[1][0]) | (f2bf(S[1][1]) << 16);
        pk.w = f2bf(S[1][2]) | (f2bf(S[1][3]) << 16);
        const bf16x8 pf = __builtin_bit_cast(bf16x8, pk);
#pragma unroll
        for (int m = 0; m < 4; ++m) {
          O[m] *= alpha;
          const uint4 vv = {cv[m][0].x, cv[m][0].y, cv[m][1].x, cv[m][1].y};
          O[m] = __builtin_amdgcn_mfma_f32_16x16x32_bf16(__builtin_bit_cast(bf16x8, vv), pf, O[m], 0, 0, 0);
        }
      }
      l += __shfl_xor(l, 16);
      l += __shfl_xor(l, 32);
      const float mx = mrun;
      const float il = 1.f / l;
      const int ql = ((tile * 16 + qi) << dshift) + r;
      float wo = 0.f, wn = 1.f;
      float mnew = mx, lnew = l;
      if (pi > 0) {
        const float mo = Mb[ql], lo = Lb[ql];
        mnew = fmaxf(mo, mx);
        wo = lo * __expf(mo - mnew);
        wn = l * __expf(mx - mnew);
        lnew = wo + wn;
        const float inv = 1.f / lnew;
        wo *= inv;
        wn *= inv;
      }
      wn *= il;
#pragma unroll
      for (int m = 0; m < 4; ++m) {
        bfu* op = Ob + ql * 64 + 16 * m + 4 * g;
        float o[4];
        if (pi > 0) {
          const uint2 ov = *(const uint2*)op;
          o[0] = wo * bf2f(ov.x & 0xffffu) + wn * O[m][0];
          o[1] = wo * bf2f(ov.x >> 16) + wn * O[m][1];
          o[2] = wo * bf2f(ov.y & 0xffffu) + wn * O[m][2];
          o[3] = wo * bf2f(ov.y >> 16) + wn * O[m][3];
        } else {
#pragma unroll
          for (int e = 0; e < 4; ++e) o[e] = wn * O[m][e];
        }
        if (pi < 2) {
          uint2 w;
          w.x = f2bf(o[0]) | (f2bf(o[1]) << 16);
          w.y = f2bf(o[2]) | (f2bf(o[3]) << 16);
          *(uint2*)op = w;
        } else {
          const size_t oi = (tokb + q0 + ql) * 1024 + 512 + h * 64 + 16 * m + 4 * g;
          const uint2 sz = *(const uint2*)(p.SZ + oi);
          uint2 w;
          w.x = f2bf(o[0] * bf2f(sz.x & 0xffffu)) | (f2bf(o[1] * bf2f(sz.x >> 16)) << 16);
          w.y = f2bf(o[2] * bf2f(sz.y & 0xffffu)) | (f2bf(o[3] * bf2f(sz.y >> 16)) << 16);
          *(uint2*)(p.Y + oi) = w;
        }
      }
      if (pi < 2 && g == 0) {
        Mb[ql] = mnew;
        Lb[ql] = lnew;
      }
    }
    __syncthreads();
  }
}

DEVI void phase2(const Params& p, char* smem, int bid, int nb) {
  constexpr int NG = (T_TOK / 128) * 4;
  constexpr int NA = 16 * 64;
  for (int it = bid; it < NG + NA; it += nb) {
    if (it < NA) {
      attn_item(p, smem, it);
    } else {
      gmlp_item(p, smem, it - NA);
    }
  }
}

struct Epi3 {
  const Params* p;
  DEVI void operator()(int row, int col, f32x4 v) const {
#pragma unroll
    for (int i = 0; i < 4; ++i) {
      const size_t idx = (size_t)(row + i) * 1024 + col;
      p->out[idx] = p->x[idx] + v[i];
    }
  }
};
DEVI void phase3(const Params& p, char* smem, int bid, int nb) {
  ALoadPlain al{p.Y, 1024};
  Epi3 epi{&p};
  for (int it = bid; it < (T_TOK / 128) * 8; it += nb) gemm_tile(smem, al, p.WT_out, 1024, 1024, (it >> 3) * 128, (it & 7) * 128, epi);
}
DEVI void phase3b(const Params& p, int bid, int nb) {
  for (int it = bid; it < T_TOK / 4; it += nb) {
    const int row = it * 4 + (threadIdx.x >> 6);
    rms_row_bf16(p.out + (size_t)row * 1024, p.ln_odd, p.H + (size_t)row * 1024, threadIdx.x & 63);
  }
}

struct ALoadMix {
  const bfu* H;
  const float* mu;
  DEVI uint4 operator()(int row, int k) const {
    float c[8], pv[8];
    unpack8(*(const uint4*)(H + (size_t)row * 1024 + k), c);
    if ((row & (SEQ - 1)) != 0) {
      unpack8(*(const uint4*)(H + (size_t)(row - 1) * 1024 + k), pv);
    } else {
#pragma unroll
      for (int j = 0; j < 8; ++j) pv[j] = 0.f;
    }
    float4 m0 = *(const float4*)(mu + k), m1 = *(const float4*)(mu + k + 4);
    float mm[8] = {m0.x, m0.y, m0.z, m0.w, m1.x, m1.y, m1.z, m1.w};
#pragma unroll
    for (int j = 0; j < 8; ++j) c[j] = c[j] + (pv[j] - c[j]) * mm[j];
    return pack8(c);
  }
};
struct Epi4 {
  const Params* p;
  int nt;
  DEVI void operator()(int row, int col, f32x4 v) const {
    if (nt < 8) {
#pragma unroll
      for (int i = 0; i < 4; ++i) p->R[(size_t)(row + i) * 1024 + col] = (bfu)f2bf(v[i]);
    } else if (nt < 16) {
#pragma unroll
      for (int i = 0; i < 4; ++i) p->K1[(size_t)(row + i) * 1024 + col - 1024] = (bfu)f2bf(v[i]);
    } else if (nt < 24) {
#pragma unroll
      for (int i = 0; i < 4; ++i) p->V1[(size_t)(row + i) * 1024 + col - 2048] = (bfu)f2bf(v[i]);
    } else if (nt < 32) {
#pragma unroll
      for (int i = 0; i < 4; ++i) p->SG[(size_t)(row + i) * 1024 + col - 3072] = (bfu)f2bf(silu_(v[i]));
    } else if (nt == 32) {
      const int c = col - 4096;
      if (c < 64) {
#pragma unroll
        for (int i = 0; i < 4; ++i) p->TW[(size_t)(row + i) * 64 + c] = (bfu)f2bf(tanh_(v[i]));
      }
    } else {
      const int c = col - 4224;
      if (c < 64) {
#pragma unroll
        for (int i = 0; i < 4; ++i) p->TA[(size_t)(row + i) * 64 + c] = (bfu)f2bf(v[i]);
      }
    }
  }
};
DEVI void phase4(const Params& p, char* smem, int bid, int nb) {
  constexpr int NT = 34;
  for (int it = bid; it < (T_TOK / 128) * NT; it += nb) {
    const int mt = it / NT, nt = it % NT;
    const int mi = (nt < 8) ? 0 : (nt < 16) ? 2 : (nt < 24) ? 3 : (nt < 32) ? 5 : (nt == 32) ? 1 : 4;
    ALoadMix al{p.H, p.mu + mi * 1024};
    Epi4 epi{&p, nt};
    gemm_tile(smem, al, p.WT_3, 1024, 1024, mt * 128, nt * 128, epi);
  }
}

struct Epi5w {
  const Params* p;
  DEVI void operator()(int row, int col, f32x4 v) const {
    const float w0 = p->w0[col];
#pragma unroll
    for (int i = 0; i < 4; ++i) p->EW[(size_t)(row + i) * 1024 + col] = (bfu)f2bf(0.6065306597126334f * sigmoid_(w0 + v[i]));
  }
};
struct Epi5a {
  const Params* p;
  DEVI void operator()(int row, int col, f32x4 v) const {
    const float a0 = p->a0[col];
#pragma unroll
    for (int i = 0; i < 4; ++i) p->AA[(size_t)(row + i) * 1024 + col] = (bfu)f2bf(sigmoid_(a0 + v[i]));
  }
};
DEVI void phase5(const Params& p, char* smem, int bid, int nb) {
  constexpr int N1 = (T_TOK / 128) * 8;
  for (int it = bid; it < 2 * N1; it += nb) {
    if (it < N1) {
      ALoadPlain al{p.TW, 64};
      Epi5w epi{&p};
      gemm_tile(smem, al, p.W2T, 64, 64, (it >> 3) * 128, (it & 7) * 128, epi);
    } else {
      const int j = it - N1;
      ALoadPlain al{p.TA, 64};
      Epi5a epi{&p};
      gemm_tile(smem, al, p.A2T, 64, 64, (j >> 3) * 128, (j & 7) * 128, epi);
    }
  }
}

DEVI void unpack4(uint2 v, float* f) {
  f[0] = __uint_as_float(v.x << 16); f[1] = __uint_as_float(v.x & 0xffff0000u);
  f[2] = __uint_as_float(v.y << 16); f[3] = __uint_as_float(v.y & 0xffff0000u);
}
DEVI uint2 pack4(const float* f) {
  uint2 r;
  r.x = f2bf(f[0]) | (f2bf(f[1]) << 16);
  r.y = f2bf(f[2]) | (f2bf(f[3]) << 16);
  return r;
}

DEVI void scanx_item(const Params& p, char* smem, int item) {
  const int bh = item & 31, c = item >> 5;
  const int b = bh >> 4, h = bh & 15;
  const size_t rowbase = ((size_t)b * SEQ + (size_t)c * 16) * 1024 + h * 64;
  float* sA = (float*)smem;
  float* sR = sA + 16 * 68;
  float* sBt = sR + 16 * 68;
  float* sKt = sBt + 16 * 68;
  float* sE = sKt + 16 * 68;
  float* sMab = sE + 16 * 64;
  float* sMak = sMab + 256;
  const int tid = threadIdx.x;
  const int tau = tid >> 4, c4 = (tid & 15) * 4;
  const size_t o = rowbase + (size_t)tau * 1024 + c4;
  float r[4], k[4], ew[4], a[4], vv[4];
  unpack4(*(const uint2*)(p.R + o), r);
  unpack4(*(const uint2*)(p.K1 + o), k);
  unpack4(*(const uint2*)(p.EW + o), ew);
  unpack4(*(const uint2*)(p.AA + o), a);
  unpack4(*(const uint2*)(p.V1 + o), vv);
  float kk[4], kp[4], bb[4];
  float ss = 0.f, cf = 0.f;
#pragma unroll
  for (int j = 0; j < 4; ++j) {
    const int ch = h * 64 + c4 + j;
    kk[j] = k[j] * p.k_k[ch];
    ss += kk[j] * kk[j];
    kp[j] = k[j] * (1.f + (a[j] - 1.f) * p.k_a[ch]);
    cf += r[j] * kp[j] * p.r_k[ch];
  }
  ss = reduce16(ss);
  cf = reduce16(cf);
  const float rn = rsqrtf(fmaxf(ss, 1e-24f));
#pragma unroll
  for (int j = 0; j < 4; ++j) {
    kk[j] *= rn;
    bb[j] = kk[j] * a[j];
    sE[tau * 64 + c4 + j] = ew[j];
  }
  if ((tid & 15) == 0) p.COEF[((size_t)b * SEQ + (size_t)c * 16 + tau) * 16 + h] = cf;
  __syncthreads();
  float Li[4] = {0.f, 0.f, 0.f, 0.f}, L15[4] = {0.f, 0.f, 0.f, 0.f};
#pragma unroll
  for (int i = 0; i < 16; ++i) {
    const float4 e = *(const float4*)(sE + i * 64 + c4);
    const float m = (i <= tau) ? 1.f : 0.f;
    Li[0] += m * e.x; Li[1] += m * e.y; Li[2] += m * e.z; Li[3] += m * e.w;
    L15[0] += e.x; L15[1] += e.y; L15[2] += e.z; L15[3] += e.w;
  }
  float rt[4], bhat[4], khat[4];
#pragma unroll
  for (int j = 0; j < 4; ++j) {
    const float ep = __expf(Li[j]), em = __expf(-Li[j]), eh = __expf(-(L15[j] - Li[j]));
    const float at = -kk[j] * __expf(-(Li[j] - ew[j]));
    rt[j] = r[j] * em;
    sA[tau * 68 + c4 + j] = at;
    sR[tau * 68 + c4 + j] = rt[j];
    sBt[tau * 68 + c4 + j] = bb[j] * ep;
    sKt[tau * 68 + c4 + j] = kp[j] * ep;
    bhat[j] = bb[j] * eh;
    khat[j] = kp[j] * eh;
  }
  *(uint2*)(p.R + o) = pack4(rt);
#pragma unroll
  for (int j = 0; j < 4; ++j) {
    const int lin = (c4 + j) * 16 + tau;
    const size_t off = rowbase + (size_t)(lin >> 6) * 1024 + (lin & 63);
    p.EW[off] = (bfu)f2bf(bhat[j]);
    p.K1[off] = (bfu)f2bf(khat[j]);
    p.V1[off] = (bfu)f2bf(vv[j]);
  }
  if (tau == 0) {
    float4 gq = {__expf(-L15[0]), __expf(-L15[1]), __expf(-L15[2]), __expf(-L15[3])};
    *(float4*)(p.G15 + (size_t)item * 64 + c4) = gq;
  }
  __syncthreads();
  {
    const int i = tid >> 4, tq = tid & 15;
    float mab = 0.f, mak = 0.f, mrb = 0.f, mrk = 0.f;
#pragma unroll
    for (int kq = 0; kq < 64; kq += 4) {
      const float4 bi = *(const float4*)(sBt + i * 68 + kq);
      const float4 ki = *(const float4*)(sKt + i * 68 + kq);
      const float4 aq = *(const float4*)(sA + tq * 68 + kq);
      const float4 rq = *(const float4*)(sR + tq * 68 + kq);
      mab += bi.x * aq.x + bi.y * aq.y + bi.z * aq.z + bi.w * aq.w;
      mak += ki.x * aq.x + ki.y * aq.y + ki.z * aq.z + ki.w * aq.w;
      mrb += bi.x * rq.x + bi.y * rq.y + bi.z * rq.z + bi.w * rq.w;
      mrk += ki.x * rq.x + ki.y * rq.y + ki.z * rq.z + ki.w * rq.w;
    }
    if (!(i < tq)) { mab = 0.f; mak = 0.f; }
    if (!(i <= tq)) { mrb = 0.f; mrk = 0.f; }
    sMab[i * 16 + tq] = mab;
    sMak[i * 16 + tq] = mak;
    bfu* mr = p.MRT + (size_t)item * 512 + tq * 32 + (i >> 2) * 8 + (i & 3);
    mr[0] = (bfu)f2bf(mrb);
    mr[4] = (bfu)f2bf(mrk);
  }
  __syncthreads();
  if (tid < 80) {
    float x[16];
#pragma unroll
    for (int t = 0; t < 16; ++t) {
      float accv = (tid < 64) ? sA[t * 68 + tid] : sMak[(tid - 64) * 16 + t];
#pragma unroll
      for (int i = 0; i < t; ++i) accv += x[i] * sMab[i * 16 + t];
      x[t] = accv;
    }
    if (tid < 64) {
#pragma unroll
      for (int t = 0; t < 16; ++t) p.AA[rowbase + (size_t)t * 1024 + tid] = (bfu)f2bf(x[t]);
    } else {
#pragma unroll
      for (int t = 0; t < 16; ++t) p.GT[(size_t)item * 256 + t * 16 + (tid - 64)] = (bfu)f2bf(x[t]);
    }
  }
  __syncthreads();
}
DEVI void phase6x(const Params& p, char* smem, int bid, int nb) {
  for (int it = bid; it < (SEQ / 16) * 32; it += nb) scanx_item(p, smem, it);
}

struct ScanOps {
  uint2 w[2][2], r[2][2], gt, vb, bk[4][2];
  uint4 mr;
  float4 g15[4];
};
DEVI void scans_load(const Params& p, ScanOps& o, int c, int b, int h, int vs, int q, int g) {
  const size_t rowbase = ((size_t)b * SEQ + (size_t)c * 16) * 1024 + h * 64;
  const size_t it = (size_t)c * 32 + b * 16 + h;
#pragma unroll
  for (int s = 0; s < 2; ++s) {
    o.w[s][0] = *(const uint2*)(p.AA + rowbase + (size_t)q * 1024 + 32 * s + 4 * g);
    o.w[s][1] = *(const uint2*)(p.AA + rowbase + (size_t)q * 1024 + 32 * s + 16 + 4 * g);
    o.r[s][0] = *(const uint2*)(p.R + rowbase + (size_t)q * 1024 + 32 * s + 4 * g);
    o.r[s][1] = *(const uint2*)(p.R + rowbase + (size_t)q * 1024 + 32 * s + 16 + 4 * g);
  }
  o.gt = *(const uint2*)(p.GT + it * 256 + q * 16 + 4 * g);
  o.mr = *(const uint4*)(p.MRT + it * 512 + q * 32 + g * 8);
  {
    const int v = vs * 16 + q;
    o.vb = *(const uint2*)(p.V1 + rowbase + (size_t)(v >> 2) * 1024 + (v & 3) * 16 + 4 * g);
  }
#pragma unroll
  for (int n = 0; n < 4; ++n) {
    const int ch = 16 * n + q;
    const size_t off = rowbase + (size_t)(ch >> 2) * 1024 + (ch & 3) * 16 + 4 * g;
    o.bk[n][0] = *(const uint2*)(p.EW + off);
    o.bk[n][1] = *(const uint2*)(p.K1 + off);
    o.g15[n] = *(const float4*)(p.G15 + it * 64 + 16 * n + 4 * g);
  }
}
DEVI bf16x8 mk8(uint2 a, uint2 b) {
  const uint4 v = {a.x, a.y, b.x, b.y};
  return __builtin_bit_cast(bf16x8, v);
}
DEVI uint2 packacc(f32x4 a) {
  uint2 r;
  r.x = f2bf(a[0]) | (f2bf(a[1]) << 16);
  r.y = f2bf(a[2]) | (f2bf(a[3]) << 16);
  return r;
}
DEVI void scans_item(const Params& p, int item) {
  const int bh = item >> 2, vs = item & 3, b = bh >> 4, h = bh & 15;
  const int lane = threadIdx.x & 63, q = lane & 15, g = lane >> 4;
  f32x4 acc[4];
#pragma unroll
  for (int n = 0; n < 4; ++n) acc[n] = f32x4{0.f, 0.f, 0.f, 0.f};
  const uint2 zero2 = {0u, 0u};
  ScanOps cur, nxt;
  scans_load(p, cur, 0, b, h, vs, q, g);
  bfu* yout = p.YS + ((size_t)b * SEQ) * 1024 + h * 64 + vs * 16 + q;
#pragma unroll 1
  for (int c = 0; c < SEQ / 16; ++c) {
    if (c + 1 < SEQ / 16) scans_load(p, nxt, c + 1, b, h, vs, q, g);
    const bf16x8 sB0 = mk8(packacc(acc[0]), packacc(acc[1]));
    const bf16x8 sB1 = mk8(packacc(acc[2]), packacc(acc[3]));
    f32x4 Z = {0.f, 0.f, 0.f, 0.f};
    Z = __builtin_amdgcn_mfma_f32_16x16x32_bf16(mk8(cur.gt, zero2), mk8(cur.vb, zero2), Z, 0, 0, 0);
    Z = __builtin_amdgcn_mfma_f32_16x16x32_bf16(mk8(cur.w[0][0], cur.w[0][1]), sB0, Z, 0, 0, 0);
    Z = __builtin_amdgcn_mfma_f32_16x16x32_bf16(mk8(cur.w[1][0], cur.w[1][1]), sB1, Z, 0, 0, 0);
    f32x4 Y = {0.f, 0.f, 0.f, 0.f};
    Y = __builtin_amdgcn_mfma_f32_16x16x32_bf16(mk8(cur.r[0][0], cur.r[0][1]), sB0, Y, 0, 0, 0);
    Y = __builtin_amdgcn_mfma_f32_16x16x32_bf16(mk8(cur.r[1][0], cur.r[1][1]), sB1, Y, 0, 0, 0);
    const bf16x8 zvB = mk8(packacc(Z), cur.vb);
    Y = __builtin_amdgcn_mfma_f32_16x16x32_bf16(__builtin_bit_cast(bf16x8, cur.mr), zvB, Y, 0, 0, 0);
#pragma unroll
    for (int n = 0; n < 4; ++n) {
      f32x4 sc = acc[n];
      sc[0] *= cur.g15[n].x; sc[1] *= cur.g15[n].y; sc[2] *= cur.g15[n].z; sc[3] *= cur.g15[n].w;
      acc[n] = __builtin_amdgcn_mfma_f32_16x16x32_bf16(mk8(cur.bk[n][0], cur.bk[n][1]), zvB, sc, 0, 0, 0);
    }
#pragma unroll
    for (int e = 0; e < 4; ++e) yout[(size_t)(c * 16 + 4 * g + e) * 1024] = (bfu)f2bf(Y[e]);
    cur = nxt;
  }
}
DEVI void phase6(const Params& p, char* smem, int bid, int nb) {
  if (threadIdx.x < 64)
    for (int it = bid; it < 128; it += nb) scans_item(p, it);
}

DEVI void phase6b(const Params& p, int bid, int nb) {
  for (int it = bid; it < T_TOK * 16 / 4; it += nb) {
    const int task = it * 4 + (threadIdx.x >> 6);
    const int lane = threadIdx.x & 63;
    const int t = task >> 4, h = task & 15;
    const size_t idx = (size_t)t * 1024 + h * 64 + lane;
    const int c = h * 64 + lane;
    const float ys = bf2f(p.YS[idx]);
    const float mean = wave_sum(ys) * (1.f / 64.f);
    const float dv = ys - mean;
    const float var = wave_sum(dv * dv) * (1.f / 64.f);
    float y = dv * rsqrtf(var + 64e-5f) * p.lnw[c] + p.lnb[c];
    const int tb = t & ~15, tau = t & 15;
    const float v = bf2f(p.V1[(size_t)(tb + (lane >> 2)) * 1024 + h * 64 + (lane & 3) * 16 + tau]);
    const float bon = p.COEF[(size_t)t * 16 + h];
    y = (y + bon * v) * bf2f(p.SG[idx]);
    p.YS[idx] = (bfu)f2bf(y);
  }
}

struct Epi7 {
  const Params* p;
  DEVI void operator()(int row, int col, f32x4 v) const {
#pragma unroll
    for (int i = 0; i < 4; ++i) {
      const size_t idx = (size_t)(row + i) * 1024 + col;
      p->out[idx] = p->out[idx] + v[i];
    }
  }
};
DEVI void phase7(const Params& p, char* smem, int bid, int nb) {
  ALoadPlain al{p.YS, 1024};
  Epi7 epi{&p};
  for (int it = bid; it < (T_TOK / 128) * 8; it += nb) gemm_tile(smem, al, p.WT_o, 1024, 1024, (it >> 3) * 128, (it & 7) * 128, epi);
}
DEVI void phase8(const Params& p, int bid, int nb) {
  for (int it = bid; it < T_TOK / 4; it += nb) {
    const int row = it * 4 + (threadIdx.x >> 6);
    const int lane = threadIdx.x & 63;
    float* src = p.out + (size_t)row * 1024;
    float4 v[4];
    float ss = 0.f;
#pragma unroll
    for (int i = 0; i < 4; ++i) {
      v[i] = *(const float4*)(src + lane * 4 + 256 * i);
      ss += v[i].x * v[i].x + v[i].y * v[i].y + v[i].z * v[i].z + v[i].w * v[i].w;
    }
    ss = wave_sum(ss);
    const float rinv = rsqrtf(ss * (1.f / 1024.f) + 1e-6f);
#pragma unroll
    for (int i = 0; i < 4; ++i) {
      float4 g = *(const float4*)(p.fnorm + lane * 4 + 256 * i);
      float4 o = {v[i].x * rinv * g.x, v[i].y * rinv * g.y, v[i].z * rinv * g.z, v[i].w * rinv * g.w};
      *(float4*)(src + lane * 4 + 256 * i) = o;
    }
  }
}

template <int PH>
DEVI void run_phase(const Params& p, char* smem, int bid, int nb) {
  if (PH == 0) phase0(p, smem, bid, nb);
  if (PH == 1) phase1(p, smem, bid, nb);
  if (PH == 2) phase2(p, smem, bid, nb);
  if (PH == 3) phase3(p, smem, bid, nb);
  if (PH == 4) phase3b(p, bid, nb);
  if (PH == 5) phase4(p, smem, bid, nb);
  if (PH == 6) phase5(p, smem, bid, nb);
  if (PH == 7) phase6x(p, smem, bid, nb);
  if (PH == 8) phase6(p, smem, bid, nb);
  if (PH == 9) phase6b(p, bid, nb);
  if (PH == 10) phase7(p, smem, bid, nb);
  if (PH == 11) phase8(p, bid, nb);
}

template <int PH>
__global__ void __launch_bounds__(256, 2) phase_kernel(Params p) {
  __shared__ __attribute__((aligned(16))) char smem[SMEM_BYTES];
  run_phase<PH>(p, smem, blockIdx.x, gridDim.x);
}

__global__ void __launch_bounds__(256, 2) mega_kernel(Params p) {
  __shared__ __attribute__((aligned(16))) char smem[SMEM_BYTES];
  cg::grid_group grid = cg::this_grid();
  const int bid = blockIdx.x, nb = gridDim.x;
  run_phase<0>(p, smem, bid, nb); grid.sync();
  run_phase<1>(p, smem, bid, nb); grid.sync();
  run_phase<2>(p, smem, bid, nb); grid.sync();
  run_phase<3>(p, smem, bid, nb); grid.sync();
  run_phase<4>(p, smem, bid, nb); grid.sync();
  run_phase<5>(p, smem, bid, nb); grid.sync();
  run_phase<6>(p, smem, bid, nb); grid.sync();
  run_phase<7>(p, smem, bid, nb); grid.sync();
  run_phase<8>(p, smem, bid, nb); grid.sync();
  run_phase<9>(p, smem, bid, nb); grid.sync();
  run_phase<10>(p, smem, bid, nb); grid.sync();
  run_phase<11>(p, smem, bid, nb);
}

extern "C" void kernel_launch(void* const* d_in, const int* in_sizes, int n_in, void* d_out, int out_size, void* d_ws,
                              size_t ws_size, hipStream_t stream) {
  Params p{};
  const float** fp = (const float**)&p;
  for (int i = 0; i < 26; ++i) fp[i] = (const float*)d_in[i];
  p.out = (float*)d_out;
  char* w = (char*)d_ws;
  size_t off = 0;
  auto take = [&](size_t bytes) {
    char* r = w + off;
    off += (bytes + 255) & ~(size_t)255;
    return (bfu*)r;
  };
  p.WT_in = take((size_t)3584 * 1024 * 2);
  p.WT_out = take((size_t)1024 * 1024 * 2);
  p.WT_3 = take((size_t)4352 * 1024 * 2);
  p.WT_o = take((size_t)1024 * 1024 * 2);
  p.W2T = take((size_t)1024 * 64 * 2);
  p.A2T = take((size_t)1024 * 64 * 2);
  p.TW = take((size_t)T_TOK * 64 * 2);
  p.TA = take((size_t)T_TOK * 64 * 2);
  const size_t SLOT = (size_t)T_TOK * 1024 * 2;
  bfu* slot0 = take(SLOT);
  bfu* slots = take(6 * SLOT);
  p.H = slot0;
  p.AA = slot0;
  p.U = slots;
  p.GVT = slots + SLOT / 4;
  p.Q = slots + 2 * (SLOT / 4);
  p.K = slots + 3 * (SLOT / 4);
  p.VT = slots + 4 * (SLOT / 4);
  p.SZ = slots + 7 * (SLOT / 4);
  p.Y = slots + 9 * (SLOT / 4);
  p.R = slots;
  p.K1 = slots + 1 * (SLOT / 2);
  p.V1 = slots + 2 * (SLOT / 2);
  p.SG = slots + 3 * (SLOT / 2);
  p.EW = slots + 4 * (SLOT / 2);
  p.YS = slots + 5 * (SLOT / 2);
  p.G15 = (float*)p.TW;
  p.GT = p.WT_in;
  p.MRT = take((size_t)(SEQ / 16) * 32 * 512 * 2);
  p.COEF = (float*)take((size_t)T_TOK * 16 * 4);
  if (off > ws_size) {
    fprintf(stderr, "workspace too small: need %zu have %zu\n", off, ws_size);
    return;
  }
#if MEGA
  static int grid_blocks = 0;
  if (!grid_blocks) {
    int dev = 0, cus = 0, per_cu = 0;
    hipGetDevice(&dev);
    hipDeviceGetAttribute(&cus, hipDeviceAttributeMultiprocessorCount, dev);
    hipOccupancyMaxActiveBlocksPerMultiprocessor(&per_cu, mega_kernel, 256, 0);
    grid_blocks = cus * per_cu;
  }
  void* args[] = {&p};
  hipError_t e = hipLaunchCooperativeKernel((void*)mega_kernel, dim3(grid_blocks), dim3(256), args, 0, stream);
  if (e != hipSuccess) fprintf(stderr, "cooperative launch failed: %s (grid %d)\n", hipGetErrorString(e), grid_blocks);
#else
  const int G = 2048;
  phase_kernel<0><<<G, 256, 0, stream>>>(p);
  phase_kernel<1><<<G, 256, 0, stream>>>(p);
  phase_kernel<2><<<G, 256, 0, stream>>>(p);
  phase_kernel<3><<<G, 256, 0, stream>>>(p);
  phase_kernel<4><<<G, 256, 0, stream>>>(p);
  phase_kernel<5><<<G, 256, 0, stream>>>(p);
  phase_kernel<6><<<G, 256, 0, stream>>>(p);
  phase_kernel<7><<<G, 256, 0, stream>>>(p);
  phase_kernel<8><<<128, 256, 0, stream>>>(p);
  phase_kernel<9><<<G, 256, 0, stream>>>(p);
  phase_kernel<10><<<G, 256, 0, stream>>>(p);
  phase_kernel<11><<<G, 256, 0, stream>>>(p);
#endif
}
```

```cpp
#include <hip/hip_runtime.h>
#include <hip/hip_cooperative_groups.h>
#include <stdint.h>
#include <cstdio>
namespace cg = cooperative_groups;

#ifndef MEGA
#define MEGA 1
#endif

typedef unsigned short bfu;
using bf16x8 = __attribute__((ext_vector_type(8))) short;
using f32x4 = __attribute__((ext_vector_type(4))) float;
#define DEVI __device__ __forceinline__

constexpr int GSTAGE_BYTES = 2 * 128 * 72 * 2;
constexpr int T_TOK = 32768;
constexpr int SEQ = 16384;
constexpr int SMEM_BYTES = 2 * GSTAGE_BYTES + 4096 + 512;

struct Params {
  const float *x, *ln_even, *w_in, *gm_norm, *gm_ws, *gm_b, *w_out, *ln_odd, *mu, *wr, *wk, *wv, *wg, *w0, *w1, *w2,
      *a0, *a1, *a2, *k_k, *k_a, *r_k, *lnw, *lnb, *wo, *fnorm;
  float* out;
  bfu *WT_in, *WT_out, *WT_3, *WT_o, *W2T, *A2T;
  bfu *H, *U, *GVT, *Q, *K, *VT, *SZ, *Y, *R, *K1, *V1, *SG, *EW, *AA, *YS, *TW, *TA, *GT, *MRT;
  float *G15, *COEF;
};

DEVI float bf2f(unsigned b) { return __uint_as_float(b << 16); }
DEVI unsigned f2bf(float x) {
  const __bf16 h = (__bf16)x;
  return (unsigned)__builtin_bit_cast(unsigned short, h);
}
typedef __bf16 bf16x2_t __attribute__((ext_vector_type(2)));
typedef float float2_t __attribute__((ext_vector_type(2)));
DEVI unsigned pkbf(float a, float b) {
  const float2_t f = {a, b};
  const bf16x2_t h = __builtin_convertvector(f, bf16x2_t);
  return __builtin_bit_cast(unsigned, h);
}
DEVI void unpack8(uint4 v, float* f) {
  f[0] = __uint_as_float(v.x << 16); f[1] = __uint_as_float(v.x & 0xffff0000u);
  f[2] = __uint_as_float(v.y << 16); f[3] = __uint_as_float(v.y & 0xffff0000u);
  f[4] = __uint_as_float(v.z << 16); f[5] = __uint_as_float(v.z & 0xffff0000u);
  f[6] = __uint_as_float(v.w << 16); f[7] = __uint_as_float(v.w & 0xffff0000u);
}
DEVI uint4 pack8(const float* f) {
  uint4 r;
  r.x = pkbf(f[0], f[1]);
  r.y = pkbf(f[2], f[3]);
  r.z = pkbf(f[4], f[5]);
  r.w = pkbf(f[6], f[7]);
  return r;
}
DEVI float sigmoid_(float x) { return 1.f / (1.f + __expf(-x)); }
DEVI float silu_(float x) { return x * sigmoid_(x); }
DEVI float tanh_(float y) { float t = __expf(2.f * y); return 1.f - 2.f / (1.f + t); }
DEVI float gelu_(float x) {
  float y = 0.7978845608028654f * (x + 0.044715f * x * x * x);
  return 0.5f * x * (1.f + tanh_(y));
}
DEVI float wave_sum(float v) {
#pragma unroll
  for (int o = 32; o > 0; o >>= 1) v += __shfl_xor(v, o);
  return v;
}
DEVI float wave_max(float v) {
#pragma unroll
  for (int o = 32; o > 0; o >>= 1) v = fmaxf(v, __shfl_xor(v, o));
  return v;
}
template <int CTRL>
DEVI float dppf(float x) {
  return __int_as_float(__builtin_amdgcn_update_dpp(0, __float_as_int(x), CTRL, 0xF, 0xF, true));
}
DEVI float reduce16(float x) {
  x += dppf<0xB1>(x);
  x += dppf<0x4E>(x);
  x += dppf<0x141>(x);
  x += dppf<0x140>(x);
  return x;
}

constexpr int LROW = 72;
constexpr int GSTAGE = 2 * 128 * LROW;

template <int DIST = 2, class ALoad, class Epi>
DEVI void gemm_tile(char* smem, const ALoad& aload, const bfu* __restrict__ Bt, int ldb, int K, int m0, int n0,
                    const Epi& epi) {
  bfu* sbase = (bfu*)smem;
  const int tid = threadIdx.x, lane = tid & 63, wid = tid >> 6, wr = wid >> 1, wc = wid & 1;
  const int fr = lane & 15, fq = lane >> 4;
  f32x4 acc[4][4];
#pragma unroll
  for (int i = 0; i < 4; ++i)
#pragma unroll
    for (int j = 0; j < 4; ++j) acc[i][j] = f32x4{0.f, 0.f, 0.f, 0.f};
  const int r0 = tid >> 3, kc = (tid & 7) * 8;
  const int nk = K >> 6;
  struct GRegs { typename ALoad::Raw a0, a1, a2, a3; uint4 b0, b1, b2, b3; };
  GRegs g0, g1;
  const bfu* Bp = Bt + (size_t)(n0 + r0) * ldb + kc;
  const size_t ldb32 = (size_t)ldb * 32;
#define GEMM_ISSUE(R, KT)                                   \
  {                                                         \
    const int k0_ = ((KT) << 6);                            \
    R.a0 = aload.load(m0 + r0, k0_ + kc);                   \
    R.a1 = aload.load(m0 + r0 + 32, k0_ + kc);              \
    R.a2 = aload.load(m0 + r0 + 64, k0_ + kc);              \
    R.a3 = aload.load(m0 + r0 + 96, k0_ + kc);              \
    R.b0 = *(const uint4*)(Bp + k0_);                       \
    R.b1 = *(const uint4*)(Bp + ldb32 + k0_);               \
    R.b2 = *(const uint4*)(Bp + 2 * ldb32 + k0_);           \
    R.b3 = *(const uint4*)(Bp + 3 * ldb32 + k0_);           \
  }
#define GEMM_COMMIT(R, S, KT)                               \
  {                                                         \
    const int k1_ = ((KT) << 6) + kc;                       \
    bfu* A_ = sbase + (S) * GSTAGE + r0 * LROW + kc;        \
    bfu* B_ = A_ + 128 * LROW;                              \
    *(uint4*)(A_) = aload.finish(R.a0, m0 + r0, k1_);                   \
    \
    *(uint4*)(A_ + 32 * LROW) = aload.finish(R.a1, m0 + r0 + 32, k1_);  \
    \
    *(uint4*)(A_ + 64 * LROW) = aload.finish(R.a2, m0 + r0 + 64, k1_);  \
    \
    *(uint4*)(A_ + 96 * LROW) = aload.finish(R.a3, m0 + r0 + 96, k1_);  \
    \
    *(uint4*)(B_) = R.b0;                                   \
    *(uint4*)(B_ + 32 * LROW) = R.b1;                       \
    *(uint4*)(B_ + 64 * LROW) = R.b2;                       \
    *(uint4*)(B_ + 96 * LROW) = R.b3;                       \
  }
#define GEMM_COMPUTE(S)                                                                          \
  {                                                                                              \
    const bfu* cA = sbase + (S) * GSTAGE;                                                        \
    const bfu* cB = cA + 128 * LROW;                                                             \
    _Pragma("unroll") for (int ks = 0; ks < 2; ++ks) {                                           \
      bf16x8 af[4], bfv[4];                                                                      \
      _Pragma("unroll") for (int i = 0; i < 4; ++i) {                                            \
        af[i] = *(const bf16x8*)(cA + (wr * 64 + i * 16 + fr) * LROW + ks * 32 + fq * 8);        \
        bfv[i] = *(const bf16x8*)(cB + (wc * 64 + i * 16 + fr) * LROW + ks * 32 + fq * 8);       \
      }                                                                                          \
      _Pragma("unroll") for (int i = 0; i < 4; ++i) _Pragma("unroll") for (int j = 0; j < 4; ++j) \
          acc[i][j] = __builtin_amdgcn_mfma_f32_16x16x32_bf16(af[i], bfv[j], acc[i][j], 0, 0, 0); \
    }                                                                                            \
  }
  const int nkm1 = nk - 1;
  if (DIST == 2) {
    GEMM_ISSUE(g0, 0);
    GEMM_ISSUE(g1, (1 < nkm1 ? 1 : nkm1));
    GEMM_COMMIT(g0, 0, 0);
    GEMM_ISSUE(g0, (2 < nkm1 ? 2 : nkm1));
    __syncthreads();
    if (nk == 1) {
      GEMM_COMPUTE(0);
      __syncthreads();
    } else {
      for (int kt = 0; kt < nk; kt += 2) {
        GEMM_COMMIT(g1, 1, (kt + 1 < nkm1 ? kt + 1 : nkm1));
        GEMM_ISSUE(g1, (kt + 3 < nkm1 ? kt + 3 : nkm1));
        GEMM_COMPUTE(0);
        __syncthreads();
        GEMM_COMMIT(g0, 0, (kt + 2 < nkm1 ? kt + 2 : nkm1));
        GEMM_ISSUE(g0, (kt + 4 < nkm1 ? kt + 4 : nkm1));
        GEMM_COMPUTE(1);
        __syncthreads();
      }
    }
  } else {
    GEMM_ISSUE(g0, 0);
    GEMM_COMMIT(g0, 0, 0);
    GEMM_ISSUE(g0, (1 < nkm1 ? 1 : nkm1));
    __syncthreads();
    for (int kt = 0; kt < nk; kt += 2) {
      GEMM_COMMIT(g0, 1, (kt + 1 < nkm1 ? kt + 1 : nkm1));
      GEMM_ISSUE(g0, (kt + 2 < nkm1 ? kt + 2 : nkm1));
      GEMM_COMPUTE(0);
      __syncthreads();
      GEMM_COMMIT(g0, 0, (kt + 2 < nkm1 ? kt + 2 : nkm1));
      GEMM_ISSUE(g0, (kt + 3 < nkm1 ? kt + 3 : nkm1));
      GEMM_COMPUTE(1);
      __syncthreads();
    }
  }
#pragma unroll
  for (int i = 0; i < 4; ++i)
#pragma unroll
    for (int j = 0; j < 4; ++j) epi(m0 + wr * 64 + i * 16 + fq * 4, n0 + wc * 64 + j * 16 + fr, acc[i][j]);
}

struct TileSched {
  int bid, nb, MT, NT, SM, SN, j, snc;
  bool swz;
  DEVI TileSched(int bid_, int nb_, int MT_, int NT_, int SM_, int SN_)
      : bid(bid_), nb(nb_), MT(MT_), NT(NT_), SM(SM_), SN(SN_), j(0) {
    swz = (nb == 8 * SM * SN);
    snc = (NT + SN - 1) / SN;
  }
  DEVI int next(int& mt, int& nt) {
    if (swz) {
      const int xcd = bid & 7, local = bid >> 3;
      const int s = j * 8 + xcd;
      ++j;
      const int sm = s / snc, sn = s - sm * snc;
      if (sm * SM >= MT) return 0;
      mt = sm * SM + local / SN;
      nt = sn * SN + local % SN;
      return (mt < MT && nt < NT) ? 1 : 2;
    } else {
      const int it = bid + j * nb;
      ++j;
      if (it >= MT * NT) return 0;
      mt = it / NT;
      nt = it - mt * NT;
      return 1;
    }
  }
};

struct ALoadPlain {
  typedef uint4 Raw;
  static constexpr bool kFat = false;
  const bfu* A;
  int lda;
  DEVI Raw load(int row, int k) const { return *(const uint4*)(A + (size_t)row * lda + k); }
  DEVI uint4 finish(const Raw& r, int, int) const { return r; }
};

DEVI void transpose_tile(char* smem, const float* __restrict__ src, int Ns, bfu* __restrict__ dst, int ldd, int noff,
                         int k0, int n0) {
  float(*tile)[65] = (float(*)[65])smem;
  const int tid = threadIdx.x;
  const int kr = tid >> 4, nc = (tid & 15) * 4;
#pragma unroll
  for (int p = 0; p < 4; ++p) {
    float4 v = *(const float4*)(src + (size_t)(k0 + kr + 16 * p) * Ns + n0 + nc);
    tile[kr + 16 * p][nc] = v.x;
    tile[kr + 16 * p][nc + 1] = v.y;
    tile[kr + 16 * p][nc + 2] = v.z;
    tile[kr + 16 * p][nc + 3] = v.w;
  }
  __syncthreads();
  const int nr = tid >> 3, kc = (tid & 7) * 8;
#pragma unroll
  for (int p = 0; p < 2; ++p) {
    const int n = nr + 32 * p;
    float f[8];
#pragma unroll
    for (int j = 0; j < 8; ++j) f[j] = tile[kc + j][n];
    *(uint4*)(dst + (size_t)(noff + n0 + n) * ldd + k0 + kc) = pack8(f);
  }
  __syncthreads();
}

DEVI void rms_row_bf16(const float* __restrict__ src, const float* __restrict__ g, bfu* __restrict__ dst, int lane) {
  float4 v[4];
  float ss = 0.f;
#pragma unroll
  for (int i = 0; i < 4; ++i) {
    v[i] = *(const float4*)(src + lane * 4 + 256 * i);
    ss += v[i].x * v[i].x + v[i].y * v[i].y + v[i].z * v[i].z + v[i].w * v[i].w;
  }
  ss = wave_sum(ss);
  const float rinv = rsqrtf(ss * (1.f / 1024.f) + 1e-6f);
#pragma unroll
  for (int i = 0; i < 4; ++i) {
    float4 gg = *(const float4*)(g + lane * 4 + 256 * i);
    uint2 o;
    o.x = pkbf(v[i].x * rinv * gg.x, v[i].y * rinv * gg.y);
    o.y = pkbf(v[i].z * rinv * gg.z, v[i].w * rinv * gg.w);
    *(uint2*)(dst + lane * 4 + 256 * i) = o;
  }
}

DEVI void phase0(const Params& p, char* smem, int bid, int nb) {
  constexpr int NT_IN = 16 * 56, NT_SQ = 256, NT_SM = 16;
  constexpr int c0 = NT_IN, c1 = c0 + NT_SQ, c2 = c1 + 4 * NT_SQ, c3 = c2 + NT_SM, c4 = c3 + NT_SM, c5 = c4 + NT_SQ,
                c6 = c5 + NT_SM, c7 = c6 + NT_SM, c8 = c7 + 2, c9 = c8 + T_TOK / 4;
  for (int it = bid; it < c9; it += nb) {
    if (it < c0) {
      transpose_tile(smem, p.w_in, 3584, p.WT_in, 1024, 0, (it / 56) * 64, (it % 56) * 64);
    } else if (it < c1) {
      int j = it - c0;
      transpose_tile(smem, p.w_out, 1024, p.WT_out, 1024, 0, (j >> 4) * 64, (j & 15) * 64);
    } else if (it < c2) {
      int j = it - c1;
      int w = j >> 8;
      j &= 255;
      const float* src = (w == 0) ? p.wr : (w == 1) ? p.wk : (w == 2) ? p.wv : p.wg;
      transpose_tile(smem, src, 1024, p.WT_3, 1024, w * 1024, (j >> 4) * 64, (j & 15) * 64);
    } else if (it < c3) {
      int j = it - c2;
      transpose_tile(smem, p.w1, 64, p.WT_3, 1024, 4096, j * 64, 0);
    } else if (it < c4) {
      int j = it - c3;
      transpose_tile(smem, p.a1, 64, p.WT_3, 1024, 4224, j * 64, 0);
    } else if (it < c5) {
      int j = it - c4;
      transpose_tile(smem, p.wo, 1024, p.WT_o, 1024, 0, (j >> 4) * 64, (j & 15) * 64);
    } else if (it < c6) {
      int j = it - c5;
      transpose_tile(smem, p.w2, 1024, p.W2T, 64, 0, 0, j * 64);
    } else if (it < c7) {
      int j = it - c6;
      transpose_tile(smem, p.a2, 1024, p.A2T, 64, 0, 0, j * 64);
    } else if (it < c8) {
      int j = it - c7;
      bfu* dst = p.WT_3 + (size_t)(j == 0 ? 4160 : 4288) * 1024;
      for (int e = threadIdx.x; e < 64 * 1024 / 8; e += 256) *(uint4*)(dst + e * 8) = uint4{0, 0, 0, 0};
    } else {
      int row = (it - c8) * 4 + (threadIdx.x >> 6);
      rms_row_bf16(p.x + (size_t)row * 1024, p.ln_even, p.H + (size_t)row * 1024, threadIdx.x & 63);
    }
  }
}

struct Epi1 {
  const Params* p;
  int nt;
  DEVI void operator()(int row, int col, f32x4 v) const {
    if (nt < 4) {
#pragma unroll
      for (int i = 0; i < 4; ++i) p->U[(size_t)(row + i) * 512 + col] = (bfu)f2bf(gelu_(v[i]));
    } else if (nt < 8) {
      const int g = nt - 4, chunk = row >> 7, s = row & 127, c = col & 127;
      uint2 o;
      o.x = pkbf(gelu_(v[0]), gelu_(v[1]));
      o.y = pkbf(gelu_(v[2]), gelu_(v[3]));
      *(uint2*)(p->GVT + ((size_t)((chunk * 4 + g) * 128 + c)) * 128 + s) = o;
    } else if (nt < 12) {
#pragma unroll
      for (int i = 0; i < 4; ++i) p->Q[(size_t)(row + i) * 512 + col - 1024] = (bfu)f2bf(v[i]);
    } else if (nt < 16) {
#pragma unroll
      for (int i = 0; i < 4; ++i) p->K[(size_t)(row + i) * 512 + col - 1536] = (bfu)f2bf(v[i]);
    } else if (nt < 20) {
      const int cc = col - 2048, hh = cc >> 6, dim = cc & 63;
      const int b = row >> 14, s = row & (SEQ - 1);
      bfu* base = p->VT + ((size_t)((b * 8 + hh) * 64 + dim)) * SEQ;
      uint2 o;
      o.x = pkbf(v[0], v[1]);
      o.y = pkbf(v[2], v[3]);
      *(uint2*)(base + s) = o;
      bfu* b1 = base + (size_t)16 * 64 * SEQ;
#pragma unroll
      for (int i = 0; i < 4; ++i) b1[i * (SEQ / 4) + (s >> 2)] = (bfu)f2bf(v[i]);
      bfu* b2 = base + (size_t)2 * 16 * 64 * SEQ;
#pragma unroll
      for (int i = 0; i < 4; ++i) b2[((s + i) & 15) * (SEQ / 16) + (s >> 4)] = (bfu)f2bf(v[i]);
    } else {
#pragma unroll
      for (int i = 0; i < 4; ++i) p->SZ[(size_t)(row + i) * 1024 + col - 2560] = (bfu)f2bf(silu_(v[i]));
    }
  }
};

DEVI void phase1(const Params& p, char* smem, int bid, int nb) {
  constexpr int NT = 28, MT = T_TOK / 128;
  ALoadPlain al{p.H, 1024};
  TileSched ts(bid, nb, MT, NT, 16, 4);
  int mt, nt, st;
  while ((st = ts.next(mt, nt)) != 0) {
    if (st != 1) continue;
    Epi1 epi{&p, nt};
    gemm_tile(smem, al, p.WT_in, 1024, 1024, mt * 128, nt * 128, epi);
  }
}

struct ALoadWs {
  struct Raw { float4 a, b; };
  static constexpr bool kFat = true;
  const float* ws;
  const float* rinv;
  DEVI Raw load(int t, int s0) const {
    Raw r;
    r.a = *(const float4*)(ws + t * 128 + s0);
    r.b = *(const float4*)(ws + t * 128 + s0 + 4);
    return r;
  }
  DEVI uint4 finish(const Raw& r, int t, int s0) const {
    float f[8] = {r.a.x, r.a.y, r.a.z, r.a.w, r.b.x, r.b.y, r.b.z, r.b.w};
#pragma unroll
    for (int j = 0; j < 8; ++j) f[j] = (s0 + j <= t) ? f[j] * rinv[s0 + j] : 0.f;
    return pack8(f);
  }
};
struct EpiGm {
  const Params* p;
  int chunk, g;
  DEVI void operator()(int t, int c, f32x4 v) const {
    const float gn = p->gm_norm[g * 128 + c];
#pragma unroll
    for (int i = 0; i < 4; ++i) {
      const float val = v[i] * gn + p->gm_b[g * 128 + t + i];
      const size_t tok = (size_t)chunk * 128 + t + i;
      const float u = bf2f(p->U[tok * 512 + g * 128 + c]);
      const float sz = bf2f(p->SZ[tok * 1024 + g * 128 + c]);
      p->Y[tok * 1024 + g * 128 + c] = (bfu)f2bf(u * val * sz);
    }
  }
};

DEVI void gmlp_item(const Params& p, char* smem, int item) {
  const int chunk = item >> 2, g = item & 3;
  const bfu* gv = p.GVT + (size_t)item * 128 * 128;
  float* rinv = (float*)(smem + 2 * GSTAGE_BYTES);
  const int tid = threadIdx.x;
  if (tid < 128) {
    float ss = 0.f;
    for (int c = 0; c < 128; ++c) {
      float v = bf2f(gv[c * 128 + tid]);
      ss += v * v;
    }
    rinv[tid] = rsqrtf(ss * (1.f / 128.f) + 1e-6f);
  }
  __syncthreads();
  ALoadWs al{p.gm_ws + (size_t)g * 128 * 128, rinv};
  EpiGm epi{&p, chunk, g};
  gemm_tile(smem, al, gv, 128, 128, 0, 0, epi);
}

DEVI void attn_item(const Params& p, char* smem, int item) {
  const int qb = item & 63, bh = item >> 6, b = bh >> 3, h = bh & 7;
  const int q0 = qb * 256;
  bfu* Ob = (bfu*)smem;
  float* Mb = (float*)(smem + 32768);
  float* Lb = Mb + 256;
  const int tid = threadIdx.x, lane = tid & 63, wid = tid >> 6;
  const int qi = lane & 15, g = lane >> 4;
  const float slope = exp2f(-(float)(h + 1));
  const size_t tokb = (size_t)b * SEQ;
#pragma unroll 1
  for (int pi = 0; pi < 3; ++pi) {
    const int dshift = 2 * pi, d = 1 << dshift;
    const bfu* VT = p.VT + (size_t)pi * ((size_t)16 * 64 * SEQ) + (size_t)bh * 64 * SEQ;
#pragma unroll 1
    for (int u = wid; u < 16; u += 4) {
      const int r = u & (d - 1), tile = u >> dshift;
      const int sq0 = (q0 >> dshift) + tile * 16;
      const int sk0 = sq0 - 144;
      const int posq = ((sq0 + qi) << dshift) + r;
      const bfu* qp = p.Q + (tokb + posq) * 512 + h * 64 + g * 8;
      const bf16x8 qf0 = *(const bf16x8*)qp, qf1 = *(const bf16x8*)(qp + 32);
      const bfu* kbase = p.K + (tokb + r) * 512 + h * 64 + g * 8;
      const bfu* vbase = VT + (size_t)qi * SEQ + r * (SEQ >> dshift);
      bf16x8 kf[2][2];
      uint2 vf[4][2];
      auto loadkv = [&](int it) {
#pragma unroll
        for (int tt = 0; tt < 2; ++tt) {
          int sk = sk0 + (2 * it + tt) * 16 + qi;
          sk = sk < 0 ? 0 : sk;
          const bfu* kp = kbase + ((size_t)sk << dshift) * 512;
          kf[tt][0] = *(const bf16x8*)kp;
          kf[tt][1] = *(const bf16x8*)(kp + 32);
        }
        int kidx0 = sk0 + 32 * it + 4 * g, kidx1 = kidx0 + 16;
        kidx0 = kidx0 < 0 ? 0 : kidx0;
        kidx1 = kidx1 < 0 ? 0 : kidx1;
#pragma unroll
        for (int m = 0; m < 4; ++m) {
          vf[m][0] = *(const uint2*)(vbase + (size_t)(16 * m) * SEQ + kidx0);
          vf[m][1] = *(const uint2*)(vbase + (size_t)(16 * m) * SEQ + kidx1);
        }
      };
      loadkv(0);
      float mrun = -1e30f, l = 0.f;
      f32x4 O[4];
#pragma unroll
      for (int m = 0; m < 4; ++m) O[m] = f32x4{0.f, 0.f, 0.f, 0.f};
#pragma unroll 1
      for (int it = 0; it < 5; ++it) {
        bf16x8 ck[2][2];
        uint2 cv[4][2];
#pragma unroll
        for (int a = 0; a < 2; ++a)
#pragma unroll
          for (int c = 0; c < 2; ++c) ck[a][c] = kf[a][c];
#pragma unroll
        for (int m = 0; m < 4; ++m) {
          cv[m][0] = vf[m][0];
          cv[m][1] = vf[m][1];
        }
        if (it < 4) loadkv(it + 1);
        f32x4 S[2];
#pragma unroll
        for (int tt = 0; tt < 2; ++tt) {
          f32x4 z = {0.f, 0.f, 0.f, 0.f};
          z = __builtin_amdgcn_mfma_f32_16x16x32_bf16(ck[tt][0], qf0, z, 0, 0, 0);
          z = __builtin_amdgcn_mfma_f32_16x16x32_bf16(ck[tt][1], qf1, z, 0, 0, 0);
          S[tt] = z;
        }
        float mx = -INFINITY;
#pragma unroll
        for (int tt = 0; tt < 2; ++tt)
#pragma unroll
          for (int e = 0; e < 4; ++e) {
            const int kk = (2 * it + tt) * 16 + 4 * g + e;
            const int j = 144 + qi - kk;
            const bool valid = (j >= 0) && (j <= 128) && (sk0 + kk >= 0);
            const float sv = valid ? S[tt][e] * 0.125f - slope * (float)(j << dshift) : -INFINITY;
            S[tt][e] = sv;
            mx = fmaxf(mx, sv);
          }
        mx = fmaxf(mx, __shfl_xor(mx, 16));
        mx = fmaxf(mx, __shfl_xor(mx, 32));
        const float mnew = fmaxf(mrun, mx);
        const float alpha = __expf(mrun - mnew);
        mrun = mnew;
        float ls = 0.f;
#pragma unroll
        for (int tt = 0; tt < 2; ++tt)
#pragma unroll
          for (int e = 0; e < 4; ++e) {
            const float pe = __expf(S[tt][e] - mnew);
            S[tt][e] = pe;
            ls += pe;
          }
        l = l * alpha + ls;
        uint4 pk;
        pk.x = pkbf(S[0][0], S[0][1]);
        pk.y = pkbf(S[0][2], S[0][3]);
        pk.z = pkbf(S[1][0], S[1][1]);
        pk.w = pkbf(S[1][2], S[1][3]);
        const bf16x8 pf = __builtin_bit_cast(bf16x8, pk);
#pragma unroll
        for (int m = 0; m < 4; ++m) {
          O[m] *= alpha;
          const uint4 vv = {cv[m][0].x, cv[m][0].y, cv[m][1].x, cv[m][1].y};
          O[m] = __builtin_amdgcn_mfma_f32_16x16x32_bf16(__builtin_bit_cast(bf16x8, vv), pf, O[m], 0, 0, 0);
        }
      }
      l += __shfl_xor(l, 16);
      l += __shfl_xor(l, 32);
      const float mx = mrun;
      const float il = 1.f / l;
      const int ql = ((tile * 16 + qi) << dshift) + r;
      float wo = 0.f, wn = 1.f;
      float mnew = mx, lnew = l;
      if (pi > 0) {
        const float mo = Mb[ql], lo = Lb[ql];
        mnew = fmaxf(mo, mx);
        wo = lo * __expf(mo - mnew);
        wn = l * __expf(mx - mnew);
        lnew = wo + wn;
        const float inv = 1.f / lnew;
        wo *= inv;
        wn *= inv;
      }
      wn *= il;
#pragma unroll
      for (int m = 0; m < 4; ++m) {
        bfu* op = Ob + ql * 64 + 16 * m + 4 * g;
        float o[4];
        if (pi > 0) {
          const uint2 ov = *(const uint2*)op;
          o[0] = wo * bf2f(ov.x & 0xffffu) + wn * O[m][0];
          o[1] = wo * bf2f(ov.x >> 16) + wn * O[m][1];
          o[2] = wo * bf2f(ov.y & 0xffffu) + wn * O[m][2];
          o[3] = wo * bf2f(ov.y >> 16) + wn * O[m][3];
        } else {
#pragma unroll
          for (int e = 0; e < 4; ++e) o[e] = wn * O[m][e];
        }
        if (pi < 2) {
          uint2 w;
          w.x = pkbf(o[0], o[1]);
          w.y = pkbf(o[2], o[3]);
          *(uint2*)op = w;
        } else {
          const size_t oi = (tokb + q0 + ql) * 1024 + 512 + h * 64 + 16 * m + 4 * g;
          const uint2 sz = *(const uint2*)(p.SZ + oi);
          uint2 w;
          w.x = pkbf(o[0] * bf2f(sz.x & 0xffffu), o[1] * bf2f(sz.x >> 16));
          w.y = pkbf(o[2] * bf2f(sz.y & 0xffffu), o[3] * bf2f(sz.y >> 16));
          *(uint2*)(p.Y + oi) = w;
        }
      }
      if (pi < 2 && g == 0) {
        Mb[ql] = mnew;
        Lb[ql] = lnew;
      }
    }
    __syncthreads();
  }
}

DEVI void phase2(const Params& p, char* smem, int bid, int nb) {
  constexpr int NG = (T_TOK / 128) * 4;
  constexpr int NA = 16 * 64;
  for (int it = bid; it < NG + NA; it += nb) {
    if (it < NA) {
      attn_item(p, smem, it);
    } else {
      gmlp_item(p, smem, it - NA);
    }
  }
}

struct Epi3 {
  const Params* p;
  DEVI void operator()(int row, int col, f32x4 v) const {
#pragma unroll
    for (int i = 0; i < 4; ++i) {
      const size_t idx = (size_t)(row + i) * 1024 + col;
      p->out[idx] = p->x[idx] + v[i];
    }
  }
};
DEVI void phase3(const Params& p, char* smem, int bid, int nb) {
  ALoadPlain al{p.Y, 1024};
  Epi3 epi{&p};
  TileSched ts(bid, nb, T_TOK / 128, 8, 8, 8);
  int mt, nt, st;
  while ((st = ts.next(mt, nt)) != 0) {
    if (st != 1) continue;
    gemm_tile(smem, al, p.WT_out, 1024, 1024, mt * 128, nt * 128, epi);
  }
}
DEVI void phase3b(const Params& p, int bid, int nb) {
  for (int it = bid; it < T_TOK / 4; it += nb) {
    const int row = it * 4 + (threadIdx.x >> 6);
    rms_row_bf16(p.out + (size_t)row * 1024, p.ln_odd, p.H + (size_t)row * 1024, threadIdx.x & 63);
  }
}

struct ALoadMix {
  struct Raw { uint4 c, p; };
  static constexpr bool kFat = true;
  const bfu* H;
  const float* mu;
  DEVI Raw load(int row, int k) const {
    Raw r;
    r.c = *(const uint4*)(H + (size_t)row * 1024 + k);
    const int prow = ((row & (SEQ - 1)) != 0) ? row - 1 : row;
    r.p = *(const uint4*)(H + (size_t)prow * 1024 + k);
    return r;
  }
  DEVI uint4 finish(const Raw& r, int row, int k) const {
    float c[8], pv[8];
    unpack8(r.c, c);
    unpack8(r.p, pv);
    const float first = ((row & (SEQ - 1)) != 0) ? 1.f : 0.f;
    const float4 m0 = *(const float4*)(mu + k), m1 = *(const float4*)(mu + k + 4);
    const float mm[8] = {m0.x, m0.y, m0.z, m0.w, m1.x, m1.y, m1.z, m1.w};
#pragma unroll
    for (int j = 0; j < 8; ++j) c[j] = c[j] + (pv[j] * first - c[j]) * mm[j];
    return pack8(c);
  }
};
struct Epi4 {
  const Params* p;
  int nt;
  DEVI void operator()(int row, int col, f32x4 v) const {
    if (nt < 8) {
#pragma unroll
      for (int i = 0; i < 4; ++i) p->R[(size_t)(row + i) * 1024 + col] = (bfu)f2bf(v[i]);
    } else if (nt < 16) {
#pragma unroll
      for (int i = 0; i < 4; ++i) p->K1[(size_t)(row + i) * 1024 + col - 1024] = (bfu)f2bf(v[i]);
    } else if (nt < 24) {
#pragma unroll
      for (int i = 0; i < 4; ++i) p->V1[(size_t)(row + i) * 1024 + col - 2048] = (bfu)f2bf(v[i]);
    } else if (nt < 32) {
#pragma unroll
      for (int i = 0; i < 4; ++i) p->SG[(size_t)(row + i) * 1024 + col - 3072] = (bfu)f2bf(silu_(v[i]));
    } else if (nt == 32) {
      const int c = col - 4096;
      if (c < 64) {
#pragma unroll
        for (int i = 0; i < 4; ++i) p->TW[(size_t)(row + i) * 64 + c] = (bfu)f2bf(tanh_(v[i]));
      }
    } else {
      const int c = col - 4224;
      if (c < 64) {
#pragma unroll
        for (int i = 0; i < 4; ++i) p->TA[(size_t)(row + i) * 64 + c] = (bfu)f2bf(v[i]);
      }
    }
  }
};
DEVI void phase4_tile(const Params& p, char* smem, int mt, int nt) {
  float* smu = (float*)(smem + 2 * GSTAGE_BYTES);
  const int mi = (nt < 8) ? 0 : (nt < 16) ? 2 : (nt < 24) ? 3 : (nt < 32) ? 5 : (nt == 32) ? 1 : 4;
  *(float4*)(smu + threadIdx.x * 4) = *(const float4*)(p.mu + mi * 1024 + threadIdx.x * 4);
  __syncthreads();
  ALoadMix al{p.H, smu};
  Epi4 epi{&p, nt};
  gemm_tile<1>(smem, al, p.WT_3, 1024, 1024, mt * 128, nt * 128, epi);
}
DEVI void phase4(const Params& p, char* smem, int bid, int nb) {
  {
    TileSched ts(bid, nb, T_TOK / 128, 32, 8, 8);
    int mt, nt, st;
    while ((st = ts.next(mt, nt)) != 0) {
      if (st != 1) continue;
      phase4_tile(p, smem, mt, nt);
    }
  }
  for (int it = bid; it < (T_TOK / 128) * 2; it += nb) phase4_tile(p, smem, it >> 1, 32 + (it & 1));
}

struct Epi5w {
  const Params* p;
  DEVI void operator()(int row, int col, f32x4 v) const {
    const float w0 = p->w0[col];
#pragma unroll
    for (int i = 0; i < 4; ++i) p->EW[(size_t)(row + i) * 1024 + col] = (bfu)f2bf(0.6065306597126334f * sigmoid_(w0 + v[i]));
  }
};
struct Epi5a {
  const Params* p;
  DEVI void operator()(int row, int col, f32x4 v) const {
    const float a0 = p->a0[col];
#pragma unroll
    for (int i = 0; i < 4; ++i) p->AA[(size_t)(row + i) * 1024 + col] = (bfu)f2bf(sigmoid_(a0 + v[i]));
  }
};
DEVI void phase5(const Params& p, char* smem, int bid, int nb) {
  constexpr int N1 = (T_TOK / 128) * 8;
  for (int it = bid; it < 2 * N1; it += nb) {
    if (it < N1) {
      ALoadPlain al{p.TW, 64};
      Epi5w epi{&p};
      gemm_tile(smem, al, p.W2T, 64, 64, (it >> 3) * 128, (it & 7) * 128, epi);
    } else {
      const int j = it - N1;
      ALoadPlain al{p.TA, 64};
      Epi5a epi{&p};
      gemm_tile(smem, al, p.A2T, 64, 64, (j >> 3) * 128, (j & 7) * 128, epi);
    }
  }
}

DEVI void unpack4(uint2 v, float* f) {
  f[0] = __uint_as_float(v.x << 16); f[1] = __uint_as_float(v.x & 0xffff0000u);
  f[2] = __uint_as_float(v.y << 16); f[3] = __uint_as_float(v.y & 0xffff0000u);
}
DEVI uint2 pack4(const float* f) {
  uint2 r;
  r.x = pkbf(f[0], f[1]);
  r.y = pkbf(f[2], f[3]);
  return r;
}

DEVI void scanx_item(const Params& p, char* smem, int item) {
  const int bh = item & 31, c = item >> 5;
  const int b = bh >> 4, h = bh & 15;
  const size_t rowbase = ((size_t)b * SEQ + (size_t)c * 16) * 1024 + h * 64;
  float* sA = (float*)smem;
  float* sR = sA + 16 * 68;
  float* sBt = sR + 16 * 68;
  float* sKt = sBt + 16 * 68;
  float* sE = sKt + 16 * 68;
  float* sMab = sE + 16 * 64;
  float* sMak = sMab + 256;
  const int tid = threadIdx.x;
  const int tau = tid >> 4, c4 = (tid & 15) * 4;
  const size_t o = rowbase + (size_t)tau * 1024 + c4;
  float r[4], k[4], ew[4], a[4], vv[4];
  unpack4(*(const uint2*)(p.R + o), r);
  unpack4(*(const uint2*)(p.K1 + o), k);
  unpack4(*(const uint2*)(p.EW + o), ew);
  unpack4(*(const uint2*)(p.AA + o), a);
  unpack4(*(const uint2*)(p.V1 + o), vv);
  float kk[4], kp[4], bb[4];
  float ss = 0.f, cf = 0.f;
#pragma unroll
  for (int j = 0; j < 4; ++j) {
    const int ch = h * 64 + c4 + j;
    kk[j] = k[j] * p.k_k[ch];
    ss += kk[j] * kk[j];
    kp[j] = k[j] * (1.f + (a[j] - 1.f) * p.k_a[ch]);
    cf += r[j] * kp[j] * p.r_k[ch];
  }
  ss = reduce16(ss);
  cf = reduce16(cf);
  const float rn = rsqrtf(fmaxf(ss, 1e-24f));
#pragma unroll
  for (int j = 0; j < 4; ++j) {
    kk[j] *= rn;
    bb[j] = kk[j] * a[j];
    sE[tau * 64 + c4 + j] = ew[j];
  }
  if ((tid & 15) == 0) p.COEF[((size_t)b * SEQ + (size_t)c * 16 + tau) * 16 + h] = cf;
  __syncthreads();
  float Li[4] = {0.f, 0.f, 0.f, 0.f}, L15[4] = {0.f, 0.f, 0.f, 0.f};
#pragma unroll
  for (int i = 0; i < 16; ++i) {
    const float4 e = *(const float4*)(sE + i * 64 + c4);
    const float m = (i <= tau) ? 1.f : 0.f;
    Li[0] += m * e.x; Li[1] += m * e.y; Li[2] += m * e.z; Li[3] += m * e.w;
    L15[0] += e.x; L15[1] += e.y; L15[2] += e.z; L15[3] += e.w;
  }
  float rt[4], bhat[4], khat[4];
#pragma unroll
  for (int j = 0; j < 4; ++j) {
    const float ep = __expf(Li[j]), em = __expf(-Li[j]), eh = __expf(-(L15[j] - Li[j]));
    const float at = -kk[j] * __expf(-(Li[j] - ew[j]));
    rt[j] = r[j] * em;
    sA[tau * 68 + c4 + j] = at;
    sR[tau * 68 + c4 + j] = rt[j];
    sBt[tau * 68 + c4 + j] = bb[j] * ep;
    sKt[tau * 68 + c4 + j] = kp[j] * ep;
    bhat[j] = bb[j] * eh;
    khat[j] = kp[j] * eh;
  }
  *(uint2*)(p.R + o) = pack4(rt);
#pragma unroll
  for (int j = 0; j < 4; ++j) {
    const int lin = (c4 + j) * 16 + tau;
    const size_t off = rowbase + (size_t)(lin >> 6) * 1024 + (lin & 63);
    p.EW[off] = (bfu)f2bf(bhat[j]);
    p.K1[off] = (bfu)f2bf(khat[j]);
    p.V1[off] = (bfu)f2bf(vv[j]);
  }
  if (tau == 0) {
    float4 gq = {__expf(-L15[0]), __expf(-L15[1]), __expf(-L15[2]), __expf(-L15[3])};
    *(float4*)(p.G15 + (size_t)item * 64 + c4) = gq;
  }
  __syncthreads();
  {
    const int i = tid >> 4, tq = tid & 15;
    float mab = 0.f, mak = 0.f, mrb = 0.f, mrk = 0.f;
#pragma unroll
    for (int kq = 0; kq < 64; kq += 4) {
      const float4 bi = *(const float4*)(sBt + i * 68 + kq);
      const float4 ki = *(const float4*)(sKt + i * 68 + kq);
      const float4 aq = *(const float4*)(sA + tq * 68 + kq);
      const float4 rq = *(const float4*)(sR + tq * 68 + kq);
      mab += bi.x * aq.x + bi.y * aq.y + bi.z * aq.z + bi.w * aq.w;
      mak += ki.x * aq.x + ki.y * aq.y + ki.z * aq.z + ki.w * aq.w;
      mrb += bi.x * rq.x + bi.y * rq.y + bi.z * rq.z + bi.w * rq.w;
      mrk += ki.x * rq.x + ki.y * rq.y + ki.z * rq.z + ki.w * rq.w;
    }
    if (!(i < tq)) { mab = 0.f; mak = 0.f; }
    if (!(i <= tq)) { mrb = 0.f; mrk = 0.f; }
    sMab[i * 16 + tq] = mab;
    sMak[i * 16 + tq] = mak;
    bfu* mr = p.MRT + (size_t)item * 512 + tq * 32 + (i >> 2) * 8 + (i & 3);
    mr[0] = (bfu)f2bf(mrb);
    mr[4] = (bfu)f2bf(mrk);
  }
  __syncthreads();
  if (tid < 80) {
    float x[16];
#pragma unroll
    for (int t = 0; t < 16; ++t) {
      float accv = (tid < 64) ? sA[t * 68 + tid] : sMak[(tid - 64) * 16 + t];
#pragma unroll
      for (int i = 0; i < t; ++i) accv += x[i] * sMab[i * 16 + t];
      x[t] = accv;
    }
    if (tid < 64) {
#pragma unroll
      for (int t = 0; t < 16; ++t) p.AA[rowbase + (size_t)t * 1024 + tid] = (bfu)f2bf(x[t]);
    } else {
#pragma unroll
      for (int t = 0; t < 16; ++t) p.GT[(size_t)item * 256 + t * 16 + (tid - 64)] = (bfu)f2bf(x[t]);
    }
  }
  __syncthreads();
}
DEVI void phase6x(const Params& p, char* smem, int bid, int nb) {
  for (int it = bid; it < (SEQ / 16) * 32; it += nb) scanx_item(p, smem, it);
}

DEVI bf16x8 mk8(uint2 a, uint2 b) {
  const uint4 v = {a.x, a.y, b.x, b.y};
  return __builtin_bit_cast(bf16x8, v);
}
DEVI uint2 packacc(f32x4 a) {
  uint2 r;
  r.x = pkbf(a[0], a[1]);
  r.y = pkbf(a[2], a[3]);
  return r;
}
constexpr int SCH = 4;
constexpr int SROW = 136;
constexpr int SARR = 16 * SROW;
constexpr int SOFF_GT = 5 * SARR;
constexpr int SOFF_MR = SOFF_GT + 512;
constexpr int SOFF_G15 = SOFF_MR + 1024;
constexpr int SIMG = SOFF_G15 + 256;
#define SCANS_ISSUE(P, SC)                                                                           \
  {                                                                                                  \
    const size_t tokbase_ = ((size_t)b * SEQ + (size_t)(SC) * SCH * 16) * 1024 + h * 64;            \
    const size_t o0_ = tokbase_ + (size_t)(cl0 * 16 + row0) * 1024 + c80 * 8;                        \
    const size_t o1_ = tokbase_ + (size_t)((cl0 + 2) * 16 + row0) * 1024 + c80 * 8;                  \
    P##a0 = *(const uint4*)(p.AA + o0_);                                                             \
    P##r0 = *(const uint4*)(p.R + o0_);                                                              \
    P##e0 = *(const uint4*)(p.EW + o0_);                                                             \
    P##k0 = *(const uint4*)(p.K1 + o0_);                                                             \
    P##v0 = *(const uint4*)(p.V1 + o0_);                                                             \
    P##a1 = *(const uint4*)(p.AA + o1_);                                                             \
    P##r1 = *(const uint4*)(p.R + o1_);                                                              \
    P##e1 = *(const uint4*)(p.EW + o1_);                                                             \
    P##k1 = *(const uint4*)(p.K1 + o1_);                                                             \
    P##v1 = *(const uint4*)(p.V1 + o1_);                                                             \
    const size_t it0_ = (size_t)((SC) * SCH) * 32 + b * 16 + h;                                      \
    const char* ga_ = (const char*)(p.GT + (it0_ + (size_t)(tid >> 5) * 32) * 256 + (tid & 31) * 8); \
    const char* gb_ = (const char*)(p.G15 + (it0_ + (size_t)(t2 >> 4) * 32) * 64 + (t2 & 15) * 4);   \
    P##gm = *(const uint4*)(tid < 128 ? ga_ : gb_);                                                  \
    P##mr = *(const uint4*)(p.MRT + (it0_ + (size_t)(tid >> 6) * 32) * 512 + (tid & 63) * 8);        \
  }
#define SCANS_COMMIT(P)                                                                              \
  {                                                                                                  \
    char* b0_ = smem + cl0 * SIMG + row0 * SROW + c80 * 16;                                          \
    char* b1_ = b0_ + 2 * SIMG;                                                                      \
    *(uint2*)(b0_) = uint2{P##a0.x, P##a0.y};  *(uint2*)(b0_ + 8) = uint2{P##a0.z, P##a0.w};          \
    *(uint2*)(b0_ + SARR) = uint2{P##r0.x, P##r0.y};  *(uint2*)(b0_ + SARR + 8) = uint2{P##r0.z, P##r0.w};          \
    *(uint2*)(b0_ + 2 * SARR) = uint2{P##e0.x, P##e0.y};  *(uint2*)(b0_ + 2 * SARR + 8) = uint2{P##e0.z, P##e0.w};  \
    *(uint2*)(b0_ + 3 * SARR) = uint2{P##k0.x, P##k0.y};  *(uint2*)(b0_ + 3 * SARR + 8) = uint2{P##k0.z, P##k0.w};  \
    *(uint2*)(b0_ + 4 * SARR) = uint2{P##v0.x, P##v0.y};  *(uint2*)(b0_ + 4 * SARR + 8) = uint2{P##v0.z, P##v0.w};  \
    *(uint2*)(b1_) = uint2{P##a1.x, P##a1.y};  *(uint2*)(b1_ + 8) = uint2{P##a1.z, P##a1.w};          \
    *(uint2*)(b1_ + SARR) = uint2{P##r1.x, P##r1.y};  *(uint2*)(b1_ + SARR + 8) = uint2{P##r1.z, P##r1.w};          \
    *(uint2*)(b1_ + 2 * SARR) = uint2{P##e1.x, P##e1.y};  *(uint2*)(b1_ + 2 * SARR + 8) = uint2{P##e1.z, P##e1.w};  \
    *(uint2*)(b1_ + 3 * SARR) = uint2{P##k1.x, P##k1.y};  *(uint2*)(b1_ + 3 * SARR + 8) = uint2{P##k1.z, P##k1.w};  \
    *(uint2*)(b1_ + 4 * SARR) = uint2{P##v1.x, P##v1.y};  *(uint2*)(b1_ + 4 * SARR + 8) = uint2{P##v1.z, P##v1.w};  \
    if (tid < 128) {                                                                                 \
      *(uint4*)(smem + (tid >> 5) * SIMG + SOFF_GT + (tid & 31) * 16) = P##gm;                       \
    } else if (tid < 192) {                                                                          \
      *(uint4*)(smem + (t2 >> 4) * SIMG + SOFF_G15 + (t2 & 15) * 16) = P##gm;                        \
    }                                                                                                \
    *(uint4*)(smem + (tid >> 6) * SIMG + SOFF_MR + (tid & 63) * 16) = P##mr;                         \
  }
#define SCANS_COMPUTE(SCI)                                                                           \
  _Pragma("unroll 1") for (int cl = 0; cl < SCH; ++cl) {                                             \
    const char* img = smem + cl * SIMG;                                                              \
    const bf16x8 sB0 = mk8(packacc(acc[0]), packacc(acc[1]));                                        \
    const bf16x8 sB1 = mk8(packacc(acc[2]), packacc(acc[3]));                                        \
    const uint2 vb = *(const uint2*)(img + 4 * SARR + vrow * SROW + vcol * 2);                       \
    const uint2 gt = *(const uint2*)(img + SOFF_GT + (q * 16 + 4 * g) * 2);                          \
    f32x4 Z = {0.f, 0.f, 0.f, 0.f};                                                                  \
    Z = __builtin_amdgcn_mfma_f32_16x16x32_bf16(mk8(gt, zero2), mk8(vb, zero2), Z, 0, 0, 0);         \
    f32x4 Y = {0.f, 0.f, 0.f, 0.f};                                                                  \
    {                                                                                                \
      const char* wp = img + q * SROW + (4 * g) * 2;                                                 \
      const bf16x8 wf0 = mk8(*(const uint2*)(wp), *(const uint2*)(wp + 32));                         \
      const bf16x8 rf0 = mk8(*(const uint2*)(wp + SARR), *(const uint2*)(wp + SARR + 32));           \
      const bf16x8 wf1 = mk8(*(const uint2*)(wp + 64), *(const uint2*)(wp + 96));                    \
      const bf16x8 rf1 = mk8(*(const uint2*)(wp + SARR + 64), *(const uint2*)(wp + SARR + 96));      \
      Z = __builtin_amdgcn_mfma_f32_16x16x32_bf16(wf0, sB0, Z, 0, 0, 0);                             \
      Y = __builtin_amdgcn_mfma_f32_16x16x32_bf16(rf0, sB0, Y, 0, 0, 0);                             \
      Z = __builtin_amdgcn_mfma_f32_16x16x32_bf16(wf1, sB1, Z, 0, 0, 0);                             \
      Y = __builtin_amdgcn_mfma_f32_16x16x32_bf16(rf1, sB1, Y, 0, 0, 0);                             \
    }                                                                                                \
    const bf16x8 zvB = mk8(packacc(Z), vb);                                                          \
    const uint4 mr = *(const uint4*)(img + SOFF_MR + (q * 32 + g * 8) * 2);                          \
    Y = __builtin_amdgcn_mfma_f32_16x16x32_bf16(__builtin_bit_cast(bf16x8, mr), zvB, Y, 0, 0, 0);    \
    _Pragma("unroll") for (int n = 0; n < 4; ++n) {                                                  \
      const int ch = 16 * n + q;                                                                     \
      const char* bp = img + 2 * SARR + (ch >> 2) * SROW + ((ch & 3) * 16 + 4 * g) * 2;              \
      const bf16x8 bkf = mk8(*(const uint2*)(bp), *(const uint2*)(bp + SARR));                       \
      const float4 g15 = *(const float4*)(img + SOFF_G15 + (16 * n + 4 * g) * 4);                    \
      f32x4 scv = acc[n];                                                                            \
      scv[0] *= g15.x; scv[1] *= g15.y; scv[2] *= g15.z; scv[3] *= g15.w;                            \
      acc[n] = __builtin_amdgcn_mfma_f32_16x16x32_bf16(bkf, zvB, scv, 0, 0, 0);                      \
    }                                                                                                \
    const int c = (SCI) * SCH + cl;                                                                  \
    _Pragma("unroll") for (int e = 0; e < 4; ++e)                                                    \
        yout[(size_t)(c * 16 + 4 * g + e) * 1024] = (bfu)f2bf(Y[e]);                                 \
  }
DEVI void scans_block(const Params& p, char* smem, int bh) {
  const int b = bh >> 4, h = bh & 15;
  const int lane = threadIdx.x & 63, vs = threadIdx.x >> 6, q = lane & 15, g = lane >> 4;
  f32x4 acc[4];
#pragma unroll
  for (int n = 0; n < 4; ++n) acc[n] = f32x4{0.f, 0.f, 0.f, 0.f};
  const uint2 zero2 = {0u, 0u};
  bfu* yout = p.YS + ((size_t)b * SEQ) * 1024 + h * 64 + vs * 16 + q;
  const int tid = threadIdx.x;
  const int t2 = (tid - 128) & 63;
  const int cl0 = tid >> 7, row0 = (tid >> 3) & 15, c80 = tid & 7;
  uint4 Aa0, Aa1, Ar0, Ar1, Ae0, Ae1, Ak0, Ak1, Av0, Av1, Agm, Amr;
  constexpr int NSC = SEQ / 16 / SCH;
  const int vrow = vs * 4 + (q >> 2), vcol = (q & 3) * 16 + 4 * g;
  SCANS_ISSUE(A, 0);
  SCANS_COMMIT(A);
  __syncthreads();
#pragma unroll 1
  for (int sc = 0; sc < NSC; ++sc) {
    SCANS_ISSUE(A, (sc + 1 < NSC ? sc + 1 : NSC - 1));
    SCANS_COMPUTE(sc);
    __syncthreads();
    SCANS_COMMIT(A);
    __syncthreads();
  }
}
DEVI void phase6(const Params& p, char* smem, int bid, int nb) {
  for (int it = bid; it < 32; it += nb) scans_block(p, smem, it);
}

DEVI void phase6b(const Params& p, int bid, int nb) {
  for (int it = bid; it < T_TOK * 16 / 4; it += nb) {
    const int task = it * 4 + (threadIdx.x >> 6);
    const int lane = threadIdx.x & 63;
    const int t = task >> 4, h = task & 15;
    const size_t idx = (size_t)t * 1024 + h * 64 + lane;
    const int c = h * 64 + lane;
    const float ys = bf2f(p.YS[idx]);
    const float mean = wave_sum(ys) * (1.f / 64.f);
    const float dv = ys - mean;
    const float var = wave_sum(dv * dv) * (1.f / 64.f);
    float y = dv * rsqrtf(var + 64e-5f) * p.lnw[c] + p.lnb[c];
    const int tb = t & ~15, tau = t & 15;
    const float v = bf2f(p.V1[(size_t)(tb + (lane >> 2)) * 1024 + h * 64 + (lane & 3) * 16 + tau]);
    const float bon = p.COEF[(size_t)t * 16 + h];
    y = (y + bon * v) * bf2f(p.SG[idx]);
    p.YS[idx] = (bfu)f2bf(y);
  }
}

struct Epi7 {
  const Params* p;
  DEVI void operator()(int row, int col, f32x4 v) const {
#pragma unroll
    for (int i = 0; i < 4; ++i) {
      const size_t idx = (size_t)(row + i) * 1024 + col;
      p->out[idx] = p->out[idx] + v[i];
    }
  }
};
DEVI void phase7(const Params& p, char* smem, int bid, int nb) {
  ALoadPlain al{p.YS, 1024};
  Epi7 epi{&p};
  TileSched ts(bid, nb, T_TOK / 128, 8, 8, 8);
  int mt, nt, st;
  while ((st = ts.next(mt, nt)) != 0) {
    if (st != 1) continue;
    gemm_tile(smem, al, p.WT_o, 1024, 1024, mt * 128, nt * 128, epi);
  }
}
DEVI void phase8(const Params& p, int bid, int nb) {
  for (int it = bid; it < T_TOK / 4; it += nb) {
    const int row = it * 4 + (threadIdx.x >> 6);
    const int lane = threadIdx.x & 63;
    float* src = p.out + (size_t)row * 1024;
    float4 v[4];
    float ss = 0.f;
#pragma unroll
    for (int i = 0; i < 4; ++i) {
      v[i] = *(const float4*)(src + lane * 4 + 256 * i);
      ss += v[i].x * v[i].x + v[i].y * v[i].y + v[i].z * v[i].z + v[i].w * v[i].w;
    }
    ss = wave_sum(ss);
    const float rinv = rsqrtf(ss * (1.f / 1024.f) + 1e-6f);
#pragma unroll
    for (int i = 0; i < 4; ++i) {
      float4 g = *(const float4*)(p.fnorm + lane * 4 + 256 * i);
      float4 o = {v[i].x * rinv * g.x, v[i].y * rinv * g.y, v[i].z * rinv * g.z, v[i].w * rinv * g.w};
      *(float4*)(src + lane * 4 + 256 * i) = o;
    }
  }
}

template <int PH>
DEVI void run_phase(const Params& p, char* smem, int bid, int nb) {
  if (PH == 0) phase0(p, smem, bid, nb);
  if (PH == 1) phase1(p, smem, bid, nb);
  if (PH == 2) phase2(p, smem, bid, nb);
  if (PH == 3) phase3(p, smem, bid, nb);
  if (PH == 4) phase3b(p, bid, nb);
  if (PH == 5) phase4(p, smem, bid, nb);
  if (PH == 6) phase5(p, smem, bid, nb);
  if (PH == 7) phase6x(p, smem, bid, nb);
  if (PH == 8) phase6(p, smem, bid, nb);
  if (PH == 9) phase6b(p, bid, nb);
  if (PH == 10) phase7(p, smem, bid, nb);
  if (PH == 11) phase8(p, bid, nb);
}

template <int PH>
__global__ void __launch_bounds__(256, 2) phase_kernel(Params p) {
  extern __shared__ __attribute__((aligned(16))) char smem[];
  run_phase<PH>(p, smem, blockIdx.x, gridDim.x);
}

#ifndef REP_MASK
#define REP_MASK 0
#endif
template <int PH>
DEVI void mega_phase(const Params& p, char* smem, cg::grid_group& grid, int bid, int nb) {
  run_phase<PH>(p, smem, bid, nb);
  if ((REP_MASK >> PH) & 1) {
    grid.sync();
    run_phase<PH>(p, smem, bid, nb);
  }
}
__global__ void __launch_bounds__(256, 2) mega_kernel(Params p) {
  extern __shared__ __attribute__((aligned(16))) char smem[];
  cg::grid_group grid = cg::this_grid();
  const int bid = blockIdx.x, nb = gridDim.x;
  mega_phase<0>(p, smem, grid, bid, nb); grid.sync();
  mega_phase<1>(p, smem, grid, bid, nb); grid.sync();
  mega_phase<2>(p, smem, grid, bid, nb); grid.sync();
  mega_phase<3>(p, smem, grid, bid, nb); grid.sync();
  mega_phase<4>(p, smem, grid, bid, nb); grid.sync();
  mega_phase<5>(p, smem, grid, bid, nb); grid.sync();
  mega_phase<6>(p, smem, grid, bid, nb); grid.sync();
  mega_phase<7>(p, smem, grid, bid, nb); grid.sync();
  mega_phase<8>(p, smem, grid, bid, nb); grid.sync();
  mega_phase<9>(p, smem, grid, bid, nb); grid.sync();
  mega_phase<10>(p, smem, grid, bid, nb); grid.sync();
  mega_phase<11>(p, smem, grid, bid, nb);
}

extern "C" void kernel_launch(void* const* d_in, const int* in_sizes, int n_in, void* d_out, int out_size, void* d_ws,
                              size_t ws_size, hipStream_t stream) {
  Params p{};
  const float** fp = (const float**)&p;
  for (int i = 0; i < 26; ++i) fp[i] = (const float*)d_in[i];
  p.out = (float*)d_out;
  char* w = (char*)d_ws;
  size_t off = 0;
  auto take = [&](size_t bytes) {
    char* r = w + off;
    off += (bytes + 255) & ~(size_t)255;
    return (bfu*)r;
  };
  p.WT_in = take((size_t)3584 * 1024 * 2);
  p.WT_out = take((size_t)1024 * 1024 * 2);
  p.WT_3 = take((size_t)4352 * 1024 * 2);
  p.WT_o = take((size_t)1024 * 1024 * 2);
  p.W2T = take((size_t)1024 * 64 * 2);
  p.A2T = take((size_t)1024 * 64 * 2);
  p.TW = take((size_t)T_TOK * 64 * 2);
  p.TA = take((size_t)T_TOK * 64 * 2);
  const size_t SLOT = (size_t)T_TOK * 1024 * 2;
  bfu* slot0 = take(SLOT);
  bfu* slots = take(6 * SLOT);
  p.H = slot0;
  p.AA = slot0;
  p.U = slots;
  p.GVT = slots + SLOT / 4;
  p.Q = slots + 2 * (SLOT / 4);
  p.K = slots + 3 * (SLOT / 4);
  p.VT = slots + 4 * (SLOT / 4);
  p.SZ = slots + 7 * (SLOT / 4);
  p.Y = slots + 9 * (SLOT / 4);
  p.R = slots;
  p.K1 = slots + 1 * (SLOT / 2);
  p.V1 = slots + 2 * (SLOT / 2);
  p.SG = slots + 3 * (SLOT / 2);
  p.EW = slots + 4 * (SLOT / 2);
  p.YS = slots + 5 * (SLOT / 2);
  p.G15 = (float*)p.TW;
  p.GT = p.WT_in;
  p.MRT = take((size_t)(SEQ / 16) * 32 * 512 * 2);
  p.COEF = (float*)take((size_t)T_TOK * 16 * 4);
  if (off > ws_size) {
    fprintf(stderr, "workspace too small: need %zu have %zu\n", off, ws_size);
    return;
  }
#if MEGA
  static int grid_blocks = 0;
  if (!grid_blocks) {
    int dev = 0, cus = 0, per_cu = 0;
    (void)hipGetDevice(&dev);
    (void)hipDeviceGetAttribute(&cus, hipDeviceAttributeMultiprocessorCount, dev);
    (void)hipFuncSetAttribute((const void*)mega_kernel, hipFuncAttributeMaxDynamicSharedMemorySize, SMEM_BYTES);
    (void)hipOccupancyMaxActiveBlocksPerMultiprocessor(&per_cu, mega_kernel, 256, SMEM_BYTES);
    grid_blocks = cus * per_cu;
  }
  void* args[] = {&p};
  hipError_t e = hipLaunchCooperativeKernel((void*)mega_kernel, dim3(grid_blocks), dim3(256), args, SMEM_BYTES, stream);
  if (e != hipSuccess) fprintf(stderr, "cooperative launch failed: %s (grid %d)\n", hipGetErrorString(e), grid_blocks);
#else
  const int G = 2048;
  phase_kernel<0><<<G, 256, SMEM_BYTES, stream>>>(p);
  phase_kernel<1><<<G, 256, SMEM_BYTES, stream>>>(p);
  phase_kernel<2><<<G, 256, SMEM_BYTES, stream>>>(p);
  phase_kernel<3><<<G, 256, SMEM_BYTES, stream>>>(p);
  phase_kernel<4><<<G, 256, SMEM_BYTES, stream>>>(p);
  phase_kernel<5><<<G, 256, SMEM_BYTES, stream>>>(p);
  phase_kernel<6><<<G, 256, SMEM_BYTES, stream>>>(p);
  phase_kernel<7><<<G, 256, SMEM_BYTES, stream>>>(p);
  phase_kernel<8><<<32, 256, SMEM_BYTES, stream>>>(p);
  phase_kernel<9><<<G, 256, SMEM_BYTES, stream>>>(p);
  phase_kernel<10><<<G, 256, SMEM_BYTES, stream>>>(p);
  phase_kernel<11><<<G, 256, SMEM_BYTES, stream>>>(p);
#endif
}
```

```cpp
#include <hip/hip_runtime.h>
#include <hip/hip_cooperative_groups.h>
#include <stdint.h>
#include <cstdio>
namespace cg = cooperative_groups;

#ifndef MEGA
#define MEGA 1
#endif

typedef unsigned short bfu;
using bf16x8 = __attribute__((ext_vector_type(8))) short;
using f32x4 = __attribute__((ext_vector_type(4))) float;
#define DEVI __device__ __forceinline__

constexpr int GSTAGE_BYTES = 2 * 128 * 72 * 2;
constexpr int T_TOK = 32768;
constexpr int SEQ = 16384;
constexpr int SMEM_BYTES = 2 * GSTAGE_BYTES + 4096 + 512;

struct Params {
  const float *x, *ln_even, *w_in, *gm_norm, *gm_ws, *gm_b, *w_out, *ln_odd, *mu, *wr, *wk, *wv, *wg, *w0, *w1, *w2,
      *a0, *a1, *a2, *k_k, *k_a, *r_k, *lnw, *lnb, *wo, *fnorm;
  float* out;
  bfu *WT_in, *WT_out, *WT_3, *WT_o, *W2T, *A2T;
  bfu *H, *U, *GVT, *Q, *K, *VT, *SZ, *Y, *R, *K1, *V1, *SG, *EW, *AA, *YS, *TW, *TA, *GT, *MRT;
  float *G15, *COEF;
};

DEVI float bf2f(unsigned b) { return __uint_as_float(b << 16); }
DEVI unsigned f2bf(float x) {
  const __bf16 h = (__bf16)x;
  return (unsigned)__builtin_bit_cast(unsigned short, h);
}
typedef __bf16 bf16x2_t __attribute__((ext_vector_type(2)));
typedef float float2_t __attribute__((ext_vector_type(2)));
DEVI unsigned pkbf(float a, float b) {
  const float2_t f = {a, b};
  const bf16x2_t h = __builtin_convertvector(f, bf16x2_t);
  return __builtin_bit_cast(unsigned, h);
}
DEVI void unpack8(uint4 v, float* f) {
  f[0] = __uint_as_float(v.x << 16); f[1] = __uint_as_float(v.x & 0xffff0000u);
  f[2] = __uint_as_float(v.y << 16); f[3] = __uint_as_float(v.y & 0xffff0000u);
  f[4] = __uint_as_float(v.z << 16); f[5] = __uint_as_float(v.z & 0xffff0000u);
  f[6] = __uint_as_float(v.w << 16); f[7] = __uint_as_float(v.w & 0xffff0000u);
}
DEVI uint4 pack8(const float* f) {
  uint4 r;
  r.x = pkbf(f[0], f[1]);
  r.y = pkbf(f[2], f[3]);
  r.z = pkbf(f[4], f[5]);
  r.w = pkbf(f[6], f[7]);
  return r;
}
DEVI void unpack4(uint2 v, float* f) {
  f[0] = __uint_as_float(v.x << 16); f[1] = __uint_as_float(v.x & 0xffff0000u);
  f[2] = __uint_as_float(v.y << 16); f[3] = __uint_as_float(v.y & 0xffff0000u);
}
DEVI uint2 pack4(const float* f) {
  uint2 r;
  r.x = pkbf(f[0], f[1]);
  r.y = pkbf(f[2], f[3]);
  return r;
}

DEVI float sigmoid_(float x) { return 1.f / (1.f + __expf(-x)); }
DEVI float silu_(float x) { return x * sigmoid_(x); }
DEVI float tanh_(float y) { float t = __expf(2.f * y); return 1.f - 2.f / (1.f + t); }
DEVI float gelu_(float x) {
  float y = 0.7978845608028654f * (x + 0.044715f * x * x * x);
  return 0.5f * x * (1.f + tanh_(y));
}
DEVI float wave_sum(float v) {
#pragma unroll
  for (int o = 32; o > 0; o >>= 1) v += __shfl_xor(v, o);
  return v;
}
DEVI float wave_max(float v) {
#pragma unroll
  for (int o = 32; o > 0; o >>= 1) v = fmaxf(v, __shfl_xor(v, o));
  return v;
}
template <int CTRL>
DEVI float dppf(float x) {
  return __int_as_float(__builtin_amdgcn_update_dpp(0, __float_as_int(x), CTRL, 0xF, 0xF, true));
}
DEVI float reduce16(float x) {
  x += dppf<0xB1>(x);
  x += dppf<0x4E>(x);
  x += dppf<0x141>(x);
  x += dppf<0x140>(x);
  return x;
}

constexpr int LROW = 72;
constexpr int GSTAGE = 2 * 128 * LROW;

template <int DIST = 2, bool SW = true, class ALoad, class Epi>
DEVI void gemm_tile(char* smem, const ALoad& aload, const bfu* __restrict__ Bt, int ldb, int K, int m0, int n0,
                    const Epi& epi) {
  bfu* sbase = (bfu*)smem;
  const int tid = threadIdx.x, lane = tid & 63, wid = tid >> 6, wr = wid >> 1, wc = wid & 1;
  const int fr = lane & 15, fq = lane >> 4;
  f32x4 acc[4][4];
#pragma unroll
  for (int i = 0; i < 4; ++i)
#pragma unroll
    for (int j = 0; j < 4; ++j) acc[i][j] = f32x4{0.f, 0.f, 0.f, 0.f};
  const int r0 = tid >> 3, kc = (tid & 7) * 8;
  const int nk = K >> 6;
  struct GRegs { typename ALoad::Raw a0, a1, a2, a3; uint4 ap, b0, b1, b2, b3; };
  GRegs g0, g1;
  const bfu* Bp = Bt + (size_t)(n0 + r0) * ldb + kc;
  const size_t ldb32 = (size_t)ldb * 32;
  constexpr int ARS = ALoad::kConsec ? 1 : 32;
  const int ar0 = ALoad::kConsec ? 4 * r0 : r0;
#define GEMM_ISSUE(R, KT)                                   \
  {                                                         \
    const int k0_ = ((KT) << 6);                            \
    R.ap = aload.loadprev(m0 + ar0, k0_ + kc);              \
    R.a0 = aload.load(m0 + ar0, k0_ + kc);                  \
    R.a1 = aload.load(m0 + ar0 + ARS, k0_ + kc);            \
    R.a2 = aload.load(m0 + ar0 + 2 * ARS, k0_ + kc);        \
    R.a3 = aload.load(m0 + ar0 + 3 * ARS, k0_ + kc);        \
    R.b0 = *(const uint4*)(Bp + k0_);                       \
    R.b1 = *(const uint4*)(Bp + ldb32 + k0_);               \
    R.b2 = *(const uint4*)(Bp + 2 * ldb32 + k0_);           \
    R.b3 = *(const uint4*)(Bp + 3 * ldb32 + k0_);           \
  }
#define GEMM_COMMIT(R, S, KT)                               \
  {                                                         \
    const int k1_ = ((KT) << 6) + kc;                       \
    bfu* A_ = sbase + (S) * GSTAGE + ar0 * LROW + kc;       \
    bfu* B_ = sbase + (S) * GSTAGE + 128 * LROW + r0 * LROW + kc;   \
    *(uint4*)(A_) = aload.finish(R.a0, R.ap, m0 + ar0, k1_);                                 \
    *(uint4*)(A_ + ARS * LROW) = aload.finish(R.a1, aload.asprev(R.a0), m0 + ar0 + ARS, k1_);          \
    *(uint4*)(A_ + 2 * ARS * LROW) = aload.finish(R.a2, aload.asprev(R.a1), m0 + ar0 + 2 * ARS, k1_);  \
    *(uint4*)(A_ + 3 * ARS * LROW) = aload.finish(R.a3, aload.asprev(R.a2), m0 + ar0 + 3 * ARS, k1_);  \
    *(uint4*)(B_) = R.b0;                                   \
    *(uint4*)(B_ + 32 * LROW) = R.b1;                       \
    *(uint4*)(B_ + 64 * LROW) = R.b2;                       \
    *(uint4*)(B_ + 96 * LROW) = R.b3;                       \
  }
#define GEMM_COMPUTE(S)                                                                          \
  {                                                                                              \
    const bfu* cA = sbase + (S) * GSTAGE;                                                        \
    const bfu* cB = cA + 128 * LROW;                                                             \
    _Pragma("unroll") for (int ks = 0; ks < 2; ++ks) {                                           \
      bf16x8 af[4], bfv[4];                                                                      \
      _Pragma("unroll") for (int i = 0; i < 4; ++i) {                                            \
        af[i] = *(const bf16x8*)(cA + (wr * 64 + i * 16 + fr) * LROW + ks * 32 + fq * 8);        \
        bfv[i] = *(const bf16x8*)(cB + (wc * 64 + i * 16 + fr) * LROW + ks * 32 + fq * 8);       \
      }                                                                                          \
      _Pragma("unroll") for (int i = 0; i < 4; ++i) _Pragma("unroll") for (int j = 0; j < 4; ++j) \
          acc[i][j] = SW ? __builtin_amdgcn_mfma_f32_16x16x32_bf16(bfv[j], af[i], acc[i][j], 0, 0, 0)     \
                         : __builtin_amdgcn_mfma_f32_16x16x32_bf16(af[i], bfv[j], acc[i][j], 0, 0, 0);    \
    }                                                                                            \
  }
  const int nkm1 = nk - 1;
  if (DIST == 2) {
    GEMM_ISSUE(g0, 0);
    GEMM_ISSUE(g1, (1 < nkm1 ? 1 : nkm1));
    GEMM_COMMIT(g0, 0, 0);
    GEMM_ISSUE(g0, (2 < nkm1 ? 2 : nkm1));
    __syncthreads();
    if (nk == 1) {
      GEMM_COMPUTE(0);
      __syncthreads();
    } else {
      for (int kt = 0; kt < nk; kt += 2) {
        GEMM_COMMIT(g1, 1, (kt + 1 < nkm1 ? kt + 1 : nkm1));
        GEMM_ISSUE(g1, (kt + 3 < nkm1 ? kt + 3 : nkm1));
        GEMM_COMPUTE(0);
        __syncthreads();
        GEMM_COMMIT(g0, 0, (kt + 2 < nkm1 ? kt + 2 : nkm1));
        GEMM_ISSUE(g0, (kt + 4 < nkm1 ? kt + 4 : nkm1));
        GEMM_COMPUTE(1);
        __syncthreads();
      }
    }
  } else {
    GEMM_ISSUE(g0, 0);
    GEMM_COMMIT(g0, 0, 0);
    GEMM_ISSUE(g0, (1 < nkm1 ? 1 : nkm1));
    __syncthreads();
    for (int kt = 0; kt < nk; kt += 2) {
      GEMM_COMMIT(g0, 1, (kt + 1 < nkm1 ? kt + 1 : nkm1));
      GEMM_ISSUE(g0, (kt + 2 < nkm1 ? kt + 2 : nkm1));
      GEMM_COMPUTE(0);
      __syncthreads();
      GEMM_COMMIT(g0, 0, (kt + 2 < nkm1 ? kt + 2 : nkm1));
      GEMM_ISSUE(g0, (kt + 3 < nkm1 ? kt + 3 : nkm1));
      GEMM_COMPUTE(1);
      __syncthreads();
    }
  }
#pragma unroll
  for (int i = 0; i < 4; ++i)
#pragma unroll
    for (int j = 0; j < 4; ++j) {
      if (SW) epi(m0 + wr * 64 + i * 16 + fr, n0 + wc * 64 + j * 16 + fq * 4, acc[i][j]);
      else epi(m0 + wr * 64 + i * 16 + fq * 4, n0 + wc * 64 + j * 16 + fr, acc[i][j]);
    }
}

struct TileSched {
  int bid, nb, MT, NT, SM, SN, j, snc;
  bool swz;
  DEVI TileSched(int bid_, int nb_, int MT_, int NT_, int SM_, int SN_)
      : bid(bid_), nb(nb_), MT(MT_), NT(NT_), SM(SM_), SN(SN_), j(0) {
    swz = (nb == 8 * SM * SN);
    snc = (NT + SN - 1) / SN;
  }
  DEVI int next(int& mt, int& nt) {
    if (swz) {
      const int xcd = bid & 7, local = bid >> 3;
      const int s = j * 8 + xcd;
      ++j;
      const int sm = s / snc, sn = s - sm * snc;
      if (sm * SM >= MT) return 0;
      mt = sm * SM + local / SN;
      nt = sn * SN + local % SN;
      return (mt < MT && nt < NT) ? 1 : 2;
    } else {
      const int it = bid + j * nb;
      ++j;
      if (it >= MT * NT) return 0;
      mt = it / NT;
      nt = it - mt * NT;
      return 1;
    }
  }
};

struct ALoadPlain {
  typedef uint4 Raw;
  static constexpr bool kFat = false;
  static constexpr bool kConsec = false;
  const bfu* A;
  int lda;
  DEVI Raw load(int row, int k) const { return *(const uint4*)(A + (size_t)row * lda + k); }
  DEVI uint4 loadprev(int, int) const { return uint4{0u, 0u, 0u, 0u}; }
  DEVI uint4 asprev(const Raw&) const { return uint4{0u, 0u, 0u, 0u}; }
  DEVI uint4 finish(const Raw& r, const uint4&, int, int) const { return r; }
};

DEVI void transpose_tile(char* smem, const float* __restrict__ src, int Ns, bfu* __restrict__ dst, int ldd, int noff,
                         int k0, int n0) {
  float(*tile)[65] = (float(*)[65])smem;
  const int tid = threadIdx.x;
  const int kr = tid >> 4, nc = (tid & 15) * 4;
#pragma unroll
  for (int p = 0; p < 4; ++p) {
    float4 v = *(const float4*)(src + (size_t)(k0 + kr + 16 * p) * Ns + n0 + nc);
    tile[kr + 16 * p][nc] = v.x;
    tile[kr + 16 * p][nc + 1] = v.y;
    tile[kr + 16 * p][nc + 2] = v.z;
    tile[kr + 16 * p][nc + 3] = v.w;
  }
  __syncthreads();
  const int nr = tid >> 3, kc = (tid & 7) * 8;
#pragma unroll
  for (int p = 0; p < 2; ++p) {
    const int n = nr + 32 * p;
    float f[8];
#pragma unroll
    for (int j = 0; j < 8; ++j) f[j] = tile[kc + j][n];
    *(uint4*)(dst + (size_t)(noff + n0 + n) * ldd + k0 + kc) = pack8(f);
  }
  __syncthreads();
}

DEVI void rms_row_bf16(const float* __restrict__ src, const float* __restrict__ g, bfu* __restrict__ dst, int lane) {
  float4 v[4];
  float ss = 0.f;
#pragma unroll
  for (int i = 0; i < 4; ++i) {
    v[i] = *(const float4*)(src + lane * 4 + 256 * i);
    ss += v[i].x * v[i].x + v[i].y * v[i].y + v[i].z * v[i].z + v[i].w * v[i].w;
  }
  ss = wave_sum(ss);
  const float rinv = rsqrtf(ss * (1.f / 1024.f) + 1e-6f);
#pragma unroll
  for (int i = 0; i < 4; ++i) {
    float4 gg = *(const float4*)(g + lane * 4 + 256 * i);
    uint2 o;
    o.x = pkbf(v[i].x * rinv * gg.x, v[i].y * rinv * gg.y);
    o.y = pkbf(v[i].z * rinv * gg.z, v[i].w * rinv * gg.w);
    *(uint2*)(dst + lane * 4 + 256 * i) = o;
  }
}

DEVI void phase0(const Params& p, char* smem, int bid, int nb) {
  constexpr int NT_IN = 16 * 56, NT_SQ = 256, NT_SM = 16;
  constexpr int c0 = NT_IN, c1 = c0 + NT_SQ, c2 = c1 + 4 * NT_SQ, c3 = c2 + NT_SM, c4 = c3 + NT_SM, c5 = c4 + NT_SQ,
                c6 = c5 + NT_SM, c7 = c6 + NT_SM, c8 = c7 + 2, c9 = c8 + T_TOK / 4;
  for (int it = bid; it < c9; it += nb) {
    if (it < c0) {
      transpose_tile(smem, p.w_in, 3584, p.WT_in, 1024, 0, (it / 56) * 64, (it % 56) * 64);
    } else if (it < c1) {
      int j = it - c0;
      transpose_tile(smem, p.w_out, 1024, p.WT_out, 1024, 0, (j >> 4) * 64, (j & 15) * 64);
    } else if (it < c2) {
      int j = it - c1;
      int w = j >> 8;
      j &= 255;
      const float* src = (w == 0) ? p.wr : (w == 1) ? p.wk : (w == 2) ? p.wv : p.wg;
      transpose_tile(smem, src, 1024, p.WT_3, 1024, w * 1024, (j >> 4) * 64, (j & 15) * 64);
    } else if (it < c3) {
      int j = it - c2;
      transpose_tile(smem, p.w1, 64, p.WT_3, 1024, 4096, j * 64, 0);
    } else if (it < c4) {
      int j = it - c3;
      transpose_tile(smem, p.a1, 64, p.WT_3, 1024, 4224, j * 64, 0);
    } else if (it < c5) {
      int j = it - c4;
      transpose_tile(smem, p.wo, 1024, p.WT_o, 1024, 0, (j >> 4) * 64, (j & 15) * 64);
    } else if (it < c6) {
      int j = it - c5;
      transpose_tile(smem, p.w2, 1024, p.W2T, 64, 0, 0, j * 64);
    } else if (it < c7) {
      int j = it - c6;
      transpose_tile(smem, p.a2, 1024, p.A2T, 64, 0, 0, j * 64);
    } else if (it < c8) {
      int j = it - c7;
      bfu* dst = p.WT_3 + (size_t)(j == 0 ? 4160 : 4288) * 1024;
      for (int e = threadIdx.x; e < 64 * 1024 / 8; e += 256) *(uint4*)(dst + e * 8) = uint4{0, 0, 0, 0};
    } else {
      int row = (it - c8) * 4 + (threadIdx.x >> 6);
      rms_row_bf16(p.x + (size_t)row * 1024, p.ln_even, p.H + (size_t)row * 1024, threadIdx.x & 63);
    }
  }
}

struct Epi1T {
  const Params* p;
  int nt;
  DEVI void operator()(int row, int col, f32x4 v) const {
    if (nt < 8) {
      const int g = nt - 4, chunk = row >> 7, s = row & 127, c = col & 127;
      uint2 o;
      o.x = pkbf(gelu_(v[0]), gelu_(v[1]));
      o.y = pkbf(gelu_(v[2]), gelu_(v[3]));
      *(uint2*)(p->GVT + ((size_t)((chunk * 4 + g) * 128 + c)) * 128 + s) = o;
    } else {
      const int cc = col - 2048, hh = cc >> 6, dim = cc & 63;
      const int b = row >> 14, s = row & (SEQ - 1);
      bfu* base = p->VT + ((size_t)((b * 8 + hh) * 64 + dim)) * SEQ;
      uint2 o;
      o.x = pkbf(v[0], v[1]);
      o.y = pkbf(v[2], v[3]);
      *(uint2*)(base + s) = o;
      bfu* b1 = base + (size_t)16 * 64 * SEQ;
#pragma unroll
      for (int i = 0; i < 4; ++i) b1[i * (SEQ / 4) + (s >> 2)] = (bfu)f2bf(v[i]);
      bfu* b2 = base + (size_t)2 * 16 * 64 * SEQ;
#pragma unroll
      for (int i = 0; i < 4; ++i) b2[((s + i) & 15) * (SEQ / 16) + (s >> 4)] = (bfu)f2bf(v[i]);
    }
  }
};
struct Epi1C {
  const Params* p;
  int nt;
  DEVI void operator()(int row, int col, f32x4 v) const {
    uint2 o;
    if (nt < 4) {
      o.x = pkbf(gelu_(v[0]), gelu_(v[1]));
      o.y = pkbf(gelu_(v[2]), gelu_(v[3]));
      *(uint2*)(p->U + (size_t)row * 512 + col) = o;
    } else if (nt < 16) {
      o.x = pkbf(v[0], v[1]);
      o.y = pkbf(v[2], v[3]);
      bfu* dst = (nt < 12) ? p->Q + (size_t)row * 512 + col - 1024 : p->K + (size_t)row * 512 + col - 1536;
      *(uint2*)dst = o;
    } else {
      o.x = pkbf(silu_(v[0]), silu_(v[1]));
      o.y = pkbf(silu_(v[2]), silu_(v[3]));
      *(uint2*)(p->SZ + (size_t)row * 1024 + col - 2560) = o;
    }
  }
};

DEVI void phase1(const Params& p, char* smem, int bid, int nb) {
  constexpr int NT = 28, MT = T_TOK / 128;
  ALoadPlain al{p.H, 1024};
  TileSched ts(bid, nb, MT, NT, 16, 4);
  int mt, nt, st;
  while ((st = ts.next(mt, nt)) != 0) {
    if (st != 1) continue;
    if ((nt >= 4 && nt < 8) || (nt >= 16 && nt < 20)) {
      Epi1T epi{&p, nt};
      gemm_tile<2, false>(smem, al, p.WT_in, 1024, 1024, mt * 128, nt * 128, epi);
    } else {
      Epi1C epi{&p, nt};
      gemm_tile<2, true>(smem, al, p.WT_in, 1024, 1024, mt * 128, nt * 128, epi);
    }
  }
}

struct ALoadWs {
  struct Raw { float4 a, b; };
  static constexpr bool kFat = true;
  static constexpr bool kConsec = false;
  const float* ws;
  const float* rinv;
  DEVI Raw load(int t, int s0) const {
    Raw r;
    r.a = *(const float4*)(ws + t * 128 + s0);
    r.b = *(const float4*)(ws + t * 128 + s0 + 4);
    return r;
  }
  DEVI uint4 loadprev(int, int) const { return uint4{0u, 0u, 0u, 0u}; }
  DEVI uint4 asprev(const Raw&) const { return uint4{0u, 0u, 0u, 0u}; }
  DEVI uint4 finish(const Raw& r, const uint4&, int t, int s0) const {
    float f[8] = {r.a.x, r.a.y, r.a.z, r.a.w, r.b.x, r.b.y, r.b.z, r.b.w};
#pragma unroll
    for (int j = 0; j < 8; ++j) f[j] = (s0 + j <= t) ? f[j] * rinv[s0 + j] : 0.f;
    return pack8(f);
  }
};
struct EpiGm {
  const Params* p;
  int chunk, g;
  DEVI void operator()(int t, int c, f32x4 v) const {
    const float4 gn = *(const float4*)(p->gm_norm + g * 128 + c);
    const float bias = p->gm_b[g * 128 + t];
    const size_t tok = (size_t)chunk * 128 + t;
    float u[4], sz[4];
    unpack4(*(const uint2*)(p->U + tok * 512 + g * 128 + c), u);
    unpack4(*(const uint2*)(p->SZ + tok * 1024 + g * 128 + c), sz);
    uint2 o;
    o.x = pkbf(u[0] * (v[0] * gn.x + bias) * sz[0], u[1] * (v[1] * gn.y + bias) * sz[1]);
    o.y = pkbf(u[2] * (v[2] * gn.z + bias) * sz[2], u[3] * (v[3] * gn.w + bias) * sz[3]);
    *(uint2*)(p->Y + tok * 1024 + g * 128 + c) = o;
  }
};

DEVI void gmlp_item(const Params& p, char* smem, int item) {
  const int chunk = item >> 2, g = item & 3;
  const bfu* gv = p.GVT + (size_t)item * 128 * 128;
  float* rinv = (float*)(smem + 2 * GSTAGE_BYTES);
  const int tid = threadIdx.x;
  {
    float* sred = rinv + 128;
    const int s4 = (tid & 31) * 4, cg = tid >> 5;
    uint2 raw[16];
#pragma unroll
    for (int i = 0; i < 16; ++i) raw[i] = *(const uint2*)(gv + (cg * 16 + i) * 128 + s4);
    float ss[4] = {0.f, 0.f, 0.f, 0.f};
#pragma unroll
    for (int i = 0; i < 16; ++i) {
      float f[4];
      unpack4(raw[i], f);
#pragma unroll
      for (int j = 0; j < 4; ++j) ss[j] += f[j] * f[j];
    }
    *(float4*)(sred + cg * 128 + s4) = float4{ss[0], ss[1], ss[2], ss[3]};
    __syncthreads();
    if (tid < 128) {
      float t = 0.f;
#pragma unroll
      for (int i = 0; i < 8; ++i) t += sred[i * 128 + tid];
      rinv[tid] = rsqrtf(t * (1.f / 128.f) + 1e-6f);
    }
  }
  __syncthreads();
  ALoadWs al{p.gm_ws + (size_t)g * 128 * 128, rinv};
  EpiGm epi{&p, chunk, g};
  gemm_tile(smem, al, gv, 128, 128, 0, 0, epi);
}

DEVI void attn_item(const Params& p, char* smem, int item) {
  const int qb = item & 63, bh = item >> 6, b = bh >> 3, h = bh & 7;
  const int q0 = qb * 256;
  bfu* Ob = (bfu*)smem;
  float* Mb = (float*)(smem + 32768);
  float* Lb = Mb + 256;
  const int tid = threadIdx.x, lane = tid & 63, wid = tid >> 6;
  const int qi = lane & 15, g = lane >> 4;
  const float slope = exp2f(-(float)(h + 1));
  const size_t tokb = (size_t)b * SEQ;
#pragma unroll 1
  for (int pi = 0; pi < 3; ++pi) {
    const int dshift = 2 * pi, d = 1 << dshift;
    const bfu* VT = p.VT + (size_t)pi * ((size_t)16 * 64 * SEQ) + (size_t)bh * 64 * SEQ;
#pragma unroll 1
    for (int u = wid; u < 16; u += 4) {
      const int r = u & (d - 1), tile = u >> dshift;
      const int sq0 = (q0 >> dshift) + tile * 16;
      const int sk0 = sq0 - 144;
      const int posq = ((sq0 + qi) << dshift) + r;
      const bfu* qp = p.Q + (tokb + posq) * 512 + h * 64 + g * 8;
      const bf16x8 qf0 = *(const bf16x8*)qp, qf1 = *(const bf16x8*)(qp + 32);
      const bfu* kbase = p.K + (tokb + r) * 512 + h * 64 + g * 8;
      const bfu* vbase = VT + (size_t)qi * SEQ + r * (SEQ >> dshift);
      bf16x8 kf[2][2];
      uint2 vf[4][2];
      auto loadkv = [&](int it) {
#pragma unroll
        for (int tt = 0; tt < 2; ++tt) {
          int sk = sk0 + (2 * it + tt) * 16 + qi;
          sk = sk < 0 ? 0 : sk;
          const bfu* kp = kbase + ((size_t)sk << dshift) * 512;
          kf[tt][0] = *(const bf16x8*)kp;
          kf[tt][1] = *(const bf16x8*)(kp + 32);
        }
        int kidx0 = sk0 + 32 * it + 4 * g, kidx1 = kidx0 + 16;
        kidx0 = kidx0 < 0 ? 0 : kidx0;
        kidx1 = kidx1 < 0 ? 0 : kidx1;
#pragma unroll
        for (int m = 0; m < 4; ++m) {
          vf[m][0] = *(const uint2*)(vbase + (size_t)(16 * m) * SEQ + kidx0);
          vf[m][1] = *(const uint2*)(vbase + (size_t)(16 * m) * SEQ + kidx1);
        }
      };
      loadkv(0);
      float mrun = -1e30f, l = 0.f;
      f32x4 O[4];
#pragma unroll
      for (int m = 0; m < 4; ++m) O[m] = f32x4{0.f, 0.f, 0.f, 0.f};
#pragma unroll 1
      for (int it = 0; it < 5; ++it) {
        bf16x8 ck[2][2];
        uint2 cv[4][2];
#pragma unroll
        for (int a = 0; a < 2; ++a)
#pragma unroll
          for (int c = 0; c < 2; ++c) ck[a][c] = kf[a][c];
#pragma unroll
        for (int m = 0; m < 4; ++m) {
          cv[m][0] = vf[m][0];
          cv[m][1] = vf[m][1];
        }
        if (it < 4) loadkv(it + 1);
        f32x4 S[2];
#pragma unroll
        for (int tt = 0; tt < 2; ++tt) {
          f32x4 z = {0.f, 0.f, 0.f, 0.f};
          z = __builtin_amdgcn_mfma_f32_16x16x32_bf16(ck[tt][0], qf0, z, 0, 0, 0);
          z = __builtin_amdgcn_mfma_f32_16x16x32_bf16(ck[tt][1], qf1, z, 0, 0, 0);
          S[tt] = z;
        }
        float mx = -INFINITY;
#pragma unroll
        for (int tt = 0; tt < 2; ++tt)
#pragma unroll
          for (int e = 0; e < 4; ++e) {
            const int kk = (2 * it + tt) * 16 + 4 * g + e;
            const int j = 144 + qi - kk;
            const bool valid = (j >= 0) && (j <= 128) && (sk0 + kk >= 0);
            const float sv = valid ? S[tt][e] * 0.125f - slope * (float)(j << dshift) : -INFINITY;
            S[tt][e] = sv;
            mx = fmaxf(mx, sv);
          }
        mx = fmaxf(mx, __shfl_xor(mx, 16));
        mx = fmaxf(mx, __shfl_xor(mx, 32));
        const float mnew = fmaxf(mrun, mx);
        const float alpha = __expf(mrun - mnew);
        mrun = mnew;
        float ls = 0.f;
#pragma unroll
        for (int tt = 0; tt < 2; ++tt)
#pragma unroll
          for (int e = 0; e < 4; ++e) {
            const float pe = __expf(S[tt][e] - mnew);
            S[tt][e] = pe;
            ls += pe;
          }
        l = l * alpha + ls;
        uint4 pk;
        pk.x = pkbf(S[0][0], S[0][1]);
        pk.y = pkbf(S[0][2], S[0][3]);
        pk.z = pkbf(S[1][0], S[1][1]);
        pk.w = pkbf(S[1][2], S[1][3]);
        const bf16x8 pf = __builtin_bit_cast(bf16x8, pk);
#pragma unroll
        for (int m = 0; m < 4; ++m) {
          O[m] *= alpha;
          const uint4 vv = {cv[m][0].x, cv[m][0].y, cv[m][1].x, cv[m][1].y};
          O[m] = __builtin_amdgcn_mfma_f32_16x16x32_bf16(__builtin_bit_cast(bf16x8, vv), pf, O[m], 0, 0, 0);
        }
      }
      l += __shfl_xor(l, 16);
      l += __shfl_xor(l, 32);
      const float mx = mrun;
      const float il = 1.f / l;
      const int ql = ((tile * 16 + qi) << dshift) + r;
      float wo = 0.f, wn = 1.f;
      float mnew = mx, lnew = l;
      if (pi > 0) {
        const float mo = Mb[ql], lo = Lb[ql];
        mnew = fmaxf(mo, mx);
        wo = lo * __expf(mo - mnew);
        wn = l * __expf(mx - mnew);
        lnew = wo + wn;
        const float inv = 1.f / lnew;
        wo *= inv;
        wn *= inv;
      }
      wn *= il;
#pragma unroll
      for (int m = 0; m < 4; ++m) {
        bfu* op = Ob + ql * 64 + 16 * m + 4 * g;
        float o[4];
        if (pi > 0) {
          const uint2 ov = *(const uint2*)op;
          o[0] = wo * bf2f(ov.x & 0xffffu) + wn * O[m][0];
          o[1] = wo * bf2f(ov.x >> 16) + wn * O[m][1];
          o[2] = wo * bf2f(ov.y & 0xffffu) + wn * O[m][2];
          o[3] = wo * bf2f(ov.y >> 16) + wn * O[m][3];
        } else {
#pragma unroll
          for (int e = 0; e < 4; ++e) o[e] = wn * O[m][e];
        }
        if (pi < 2) {
          uint2 w;
          w.x = pkbf(o[0], o[1]);
          w.y = pkbf(o[2], o[3]);
          *(uint2*)op = w;
        } else {
          const size_t oi = (tokb + q0 + ql) * 1024 + 512 + h * 64 + 16 * m + 4 * g;
          const uint2 sz = *(const uint2*)(p.SZ + oi);
          uint2 w;
          w.x = pkbf(o[0] * bf2f(sz.x & 0xffffu), o[1] * bf2f(sz.x >> 16));
          w.y = pkbf(o[2] * bf2f(sz.y & 0xffffu), o[3] * bf2f(sz.y >> 16));
          *(uint2*)(p.Y + oi) = w;
        }
      }
      if (pi < 2 && g == 0) {
        Mb[ql] = mnew;
        Lb[ql] = lnew;
      }
    }
    __syncthreads();
  }
}

DEVI void phase2(const Params& p, char* smem, int bid, int nb) {
  constexpr int NG = (T_TOK / 128) * 4;
  constexpr int NA = 16 * 64;
  for (int it = bid; it < NG + NA; it += nb) {
    if (it < NA) {
      attn_item(p, smem, it);
    } else {
      gmlp_item(p, smem, it - NA);
    }
  }
}

struct Epi3 {
  const Params* p;
  DEVI void operator()(int row, int col, f32x4 v) const {
    const size_t idx = (size_t)row * 1024 + col;
    const float4 x = *(const float4*)(p->x + idx);
    const float4 o = {x.x + v[0], x.y + v[1], x.z + v[2], x.w + v[3]};
    *(float4*)(p->out + idx) = o;
  }
};
DEVI void phase3(const Params& p, char* smem, int bid, int nb) {
  ALoadPlain al{p.Y, 1024};
  Epi3 epi{&p};
  TileSched ts(bid, nb, T_TOK / 128, 8, 8, 8);
  int mt, nt, st;
  while ((st = ts.next(mt, nt)) != 0) {
    if (st != 1) continue;
    gemm_tile(smem, al, p.WT_out, 1024, 1024, mt * 128, nt * 128, epi);
  }
}
DEVI void phase3b(const Params& p, int bid, int nb) {
  for (int it = bid; it < T_TOK / 4; it += nb) {
    const int row = it * 4 + (threadIdx.x >> 6);
    rms_row_bf16(p.out + (size_t)row * 1024, p.ln_odd, p.H + (size_t)row * 1024, threadIdx.x & 63);
  }
}

struct ALoadMix {
  typedef uint4 Raw;
  static constexpr bool kFat = true;
  static constexpr bool kConsec = true;
  const bfu* H;
  const float* mu;
  DEVI Raw load(int row, int k) const { return *(const uint4*)(H + (size_t)row * 1024 + k); }
  DEVI uint4 loadprev(int row, int k) const {
    const int prow = ((row & (SEQ - 1)) != 0) ? row - 1 : row;
    return *(const uint4*)(H + (size_t)prow * 1024 + k);
  }
  DEVI uint4 asprev(const Raw& r) const { return r; }
  DEVI uint4 finish(const Raw& r, const uint4& pr, int row, int k) const {
    float c[8], pv[8];
    unpack8(r, c);
    unpack8(pr, pv);
    const float first = ((row & (SEQ - 1)) != 0) ? 1.f : 0.f;
    const float4 m0 = *(const float4*)(mu + k), m1 = *(const float4*)(mu + k + 4);
    const float mm[8] = {m0.x, m0.y, m0.z, m0.w, m1.x, m1.y, m1.z, m1.w};
#pragma unroll
    for (int j = 0; j < 8; ++j) c[j] = c[j] + (pv[j] * first - c[j]) * mm[j];
    return pack8(c);
  }
};
struct Epi4 {
  const Params* p;
  int nt;
  DEVI void operator()(int row, int col, f32x4 v) const {
    uint2 o;
    if (nt < 24) {
      o.x = pkbf(v[0], v[1]);
      o.y = pkbf(v[2], v[3]);
      bfu* dst = (nt < 8) ? p->R + (size_t)row * 1024 + col
                          : (nt < 16) ? p->K1 + (size_t)row * 1024 + col - 1024 : p->V1 + (size_t)row * 1024 + col - 2048;
      *(uint2*)dst = o;
    } else if (nt < 32) {
      o.x = pkbf(silu_(v[0]), silu_(v[1]));
      o.y = pkbf(silu_(v[2]), silu_(v[3]));
      *(uint2*)(p->SG + (size_t)row * 1024 + col - 3072) = o;
    } else if (nt == 32) {
      const int c = col - 4096;
      if (c < 64) {
        o.x = pkbf(tanh_(v[0]), tanh_(v[1]));
        o.y = pkbf(tanh_(v[2]), tanh_(v[3]));
        *(uint2*)(p->TW + (size_t)row * 64 + c) = o;
      }
    } else {
      const int c = col - 4224;
      if (c < 64) {
        o.x = pkbf(v[0], v[1]);
        o.y = pkbf(v[2], v[3]);
        *(uint2*)(p->TA + (size_t)row * 64 + c) = o;
      }
    }
  }
};
DEVI void phase4_tile(const Params& p, char* smem, int mt, int nt) {
  float* smu = (float*)(smem + 2 * GSTAGE_BYTES);
  const int mi = (nt < 8) ? 0 : (nt < 16) ? 2 : (nt < 24) ? 3 : (nt < 32) ? 5 : (nt == 32) ? 1 : 4;
  *(float4*)(smu + threadIdx.x * 4) = *(const float4*)(p.mu + mi * 1024 + threadIdx.x * 4);
  __syncthreads();
  ALoadMix al{p.H, smu};
  Epi4 epi{&p, nt};
  gemm_tile<1>(smem, al, p.WT_3, 1024, 1024, mt * 128, nt * 128, epi);
}
DEVI void phase4(const Params& p, char* smem, int bid, int nb) {
  {
    TileSched ts(bid, nb, T_TOK / 128, 32, 8, 8);
    int mt, nt, st;
    while ((st = ts.next(mt, nt)) != 0) {
      if (st != 1) continue;
      phase4_tile(p, smem, mt, nt);
    }
  }
  for (int it = bid; it < (T_TOK / 128) * 2; it += nb) phase4_tile(p, smem, it >> 1, 32 + (it & 1));
}

struct Epi5w {
  const Params* p;
  DEVI void operator()(int row, int col, f32x4 v) const {
    const float4 w0 = *(const float4*)(p->w0 + col);
    const float k = 0.6065306597126334f;
    uint2 o;
    o.x = pkbf(k * sigmoid_(w0.x + v[0]), k * sigmoid_(w0.y + v[1]));
    o.y = pkbf(k * sigmoid_(w0.z + v[2]), k * sigmoid_(w0.w + v[3]));
    *(uint2*)(p->EW + (size_t)row * 1024 + col) = o;
  }
};
struct Epi5a {
  const Params* p;
  DEVI void operator()(int row, int col, f32x4 v) const {
    const float4 a0 = *(const float4*)(p->a0 + col);
    uint2 o;
    o.x = pkbf(sigmoid_(a0.x + v[0]), sigmoid_(a0.y + v[1]));
    o.y = pkbf(sigmoid_(a0.z + v[2]), sigmoid_(a0.w + v[3]));
    *(uint2*)(p->AA + (size_t)row * 1024 + col) = o;
  }
};
DEVI void phase5(const Params& p, char* smem, int bid, int nb) {
  constexpr int N1 = (T_TOK / 128) * 8;
  for (int it = bid; it < 2 * N1; it += nb) {
    if (it < N1) {
      ALoadPlain al{p.TW, 64};
      Epi5w epi{&p};
      gemm_tile(smem, al, p.W2T, 64, 64, (it >> 3) * 128, (it & 7) * 128, epi);
    } else {
      const int j = it - N1;
      ALoadPlain al{p.TA, 64};
      Epi5a epi{&p};
      gemm_tile(smem, al, p.A2T, 64, 64, (j >> 3) * 128, (j & 7) * 128, epi);
    }
  }
}

DEVI void scanx_item(const Params& p, char* smem, int item) {
  const int bh = item & 31, c = item >> 5;
  const int b = bh >> 4, h = bh & 15;
  const size_t rowbase = ((size_t)b * SEQ + (size_t)c * 16) * 1024 + h * 64;
  float* sA = (float*)smem;
  float* sR = sA + 16 * 68;
  float* sBt = sR + 16 * 68;
  float* sKt = sBt + 16 * 68;
  float* sE = sKt + 16 * 68;
  float* sMab = sE + 16 * 64;
  float* sMak = sMab + 256;
  const int tid = threadIdx.x;
  const int tau = tid >> 4, c4 = (tid & 15) * 4;
  const size_t o = rowbase + (size_t)tau * 1024 + c4;
  float r[4], k[4], ew[4], a[4], vv[4];
  unpack4(*(const uint2*)(p.R + o), r);
  unpack4(*(const uint2*)(p.K1 + o), k);
  unpack4(*(const uint2*)(p.EW + o), ew);
  unpack4(*(const uint2*)(p.AA + o), a);
  unpack4(*(const uint2*)(p.V1 + o), vv);
  float kk[4], kp[4], bb[4];
  float ss = 0.f, cf = 0.f;
#pragma unroll
  for (int j = 0; j < 4; ++j) {
    const int ch = h * 64 + c4 + j;
    kk[j] = k[j] * p.k_k[ch];
    ss += kk[j] * kk[j];
    kp[j] = k[j] * (1.f + (a[j] - 1.f) * p.k_a[ch]);
    cf += r[j] * kp[j] * p.r_k[ch];
  }
  ss = reduce16(ss);
  cf = reduce16(cf);
  const float rn = rsqrtf(fmaxf(ss, 1e-24f));
#pragma unroll
  for (int j = 0; j < 4; ++j) {
    kk[j] *= rn;
    bb[j] = kk[j] * a[j];
    sE[tau * 64 + c4 + j] = ew[j];
  }
  if ((tid & 15) == 0) p.COEF[((size_t)b * SEQ + (size_t)c * 16 + tau) * 16 + h] = cf;
  __syncthreads();
  float Li[4] = {0.f, 0.f, 0.f, 0.f}, L15[4] = {0.f, 0.f, 0.f, 0.f};
#pragma unroll
  for (int i = 0; i < 16; ++i) {
    const float4 e = *(const float4*)(sE + i * 64 + c4);
    const float m = (i <= tau) ? 1.f : 0.f;
    Li[0] += m * e.x; Li[1] += m * e.y; Li[2] += m * e.z; Li[3] += m * e.w;
    L15[0] += e.x; L15[1] += e.y; L15[2] += e.z; L15[3] += e.w;
  }
  float rt[4], bhat[4], khat[4];
#pragma unroll
  for (int j = 0; j < 4; ++j) {
    const float ep = __expf(Li[j]), em = __expf(-Li[j]), eh = __expf(-(L15[j] - Li[j]));
    const float at = -kk[j] * __expf(-(Li[j] - ew[j]));
    rt[j] = r[j] * em;
    sA[tau * 68 + c4 + j] = at;
    sR[tau * 68 + c4 + j] = rt[j];
    sBt[tau * 68 + c4 + j] = bb[j] * ep;
    sKt[tau * 68 + c4 + j] = kp[j] * ep;
    bhat[j] = bb[j] * eh;
    khat[j] = kp[j] * eh;
  }
  *(uint2*)(p.R + o) = pack4(rt);
#pragma unroll
  for (int j = 0; j < 4; ++j) {
    const int lin = (c4 + j) * 16 + tau;
    const size_t off = rowbase + (size_t)(lin >> 6) * 1024 + (lin & 63);
    p.EW[off] = (bfu)f2bf(bhat[j]);
    p.K1[off] = (bfu)f2bf(khat[j]);
    p.V1[off] = (bfu)f2bf(vv[j]);
  }
  if (tau == 0) {
    float4 gq = {__expf(-L15[0]), __expf(-L15[1]), __expf(-L15[2]), __expf(-L15[3])};
    *(float4*)(p.G15 + (size_t)item * 64 + c4) = gq;
  }
  __syncthreads();
  {
    const int i = tid >> 4, tq = tid & 15;
    float mab = 0.f, mak = 0.f, mrb = 0.f, mrk = 0.f;
#pragma unroll
    for (int kq = 0; kq < 64; kq += 4) {
      const float4 bi = *(const float4*)(sBt + i * 68 + kq);
      const float4 ki = *(const float4*)(sKt + i * 68 + kq);
      const float4 aq = *(const float4*)(sA + tq * 68 + kq);
      const float4 rq = *(const float4*)(sR + tq * 68 + kq);
      mab += bi.x * aq.x + bi.y * aq.y + bi.z * aq.z + bi.w * aq.w;
      mak += ki.x * aq.x + ki.y * aq.y + ki.z * aq.z + ki.w * aq.w;
      mrb += bi.x * rq.x + bi.y * rq.y + bi.z * rq.z + bi.w * rq.w;
      mrk += ki.x * rq.x + ki.y * rq.y + ki.z * rq.z + ki.w * rq.w;
    }
    if (!(i < tq)) { mab = 0.f; mak = 0.f; }
    if (!(i <= tq)) { mrb = 0.f; mrk = 0.f; }
    sMab[i * 16 + tq] = mab;
    sMak[i * 16 + tq] = mak;
    bfu* mr = p.MRT + (size_t)item * 512 + tq * 32 + (i >> 2) * 8 + (i & 3);
    mr[0] = (bfu)f2bf(mrb);
    mr[4] = (bfu)f2bf(mrk);
  }
  __syncthreads();
  if (tid < 80) {
    float x[16];
#pragma unroll
    for (int t = 0; t < 16; ++t) {
      float accv = (tid < 64) ? sA[t * 68 + tid] : sMak[(tid - 64) * 16 + t];
#pragma unroll
      for (int i = 0; i < t; ++i) accv += x[i] * sMab[i * 16 + t];
      x[t] = accv;
    }
    if (tid < 64) {
#pragma unroll
      for (int t = 0; t < 16; ++t) p.AA[rowbase + (size_t)t * 1024 + tid] = (bfu)f2bf(x[t]);
    } else {
#pragma unroll
      for (int t = 0; t < 16; ++t) p.GT[(size_t)item * 256 + t * 16 + (tid - 64)] = (bfu)f2bf(x[t]);
    }
  }
  __syncthreads();
}
DEVI void phase6x(const Params& p, char* smem, int bid, int nb) {
  for (int it = bid; it < (SEQ / 16) * 32; it += nb) scanx_item(p, smem, it);
}

DEVI bf16x8 mk8(uint2 a, uint2 b) {
  const uint4 v = {a.x, a.y, b.x, b.y};
  return __builtin_bit_cast(bf16x8, v);
}
DEVI uint2 packacc(f32x4 a) {
  uint2 r;
  r.x = pkbf(a[0], a[1]);
  r.y = pkbf(a[2], a[3]);
  return r;
}
constexpr int SCH = 6;
constexpr int SROW = 136;
constexpr int SARR = 16 * SROW;
constexpr int SOFF_GT = 5 * SARR;
constexpr int SOFF_MR = SOFF_GT + 512;
constexpr int SOFF_G15 = SOFF_MR + 1024;
constexpr int SIMG = SOFF_G15 + 256;
#define SCANS_LD5(P, I, O)                       \
    P##a##I = *(const uint4*)(p.AA + (O));       \
    P##r##I = *(const uint4*)(p.R + (O));        \
    P##e##I = *(const uint4*)(p.EW + (O));       \
    P##k##I = *(const uint4*)(p.K1 + (O));       \
    P##v##I = *(const uint4*)(p.V1 + (O));
#define SCANS_ISSUE(P, SC)                                                                           \
  {                                                                                                  \
    const size_t hb_ = ((size_t)b * SEQ) * 1024 + h * 64 + c80 * 8;                                  \
    const int tk0_ = (SC) * SCH * 16 + cl0 * 16 + row0;                                              \
    const int tk1_ = tk0_ + 32, tk2_ = tk0_ + 64;                                                    \
    SCANS_LD5(P, 0, hb_ + (size_t)(tk0_ < SEQ ? tk0_ : SEQ - 1) * 1024)                              \
    SCANS_LD5(P, 1, hb_ + (size_t)(tk1_ < SEQ ? tk1_ : SEQ - 1) * 1024)                              \
    SCANS_LD5(P, 2, hb_ + (size_t)(tk2_ < SEQ ? tk2_ : SEQ - 1) * 1024)                              \
    const int c0_ = (SC) * SCH;                                                                      \
    const size_t ib_ = (size_t)b * 16 + h;                                                           \
    const int tg_ = tid < 192 ? tid : 191;                                                           \
    const int cg_ = c0_ + (tg_ >> 5);                                                                \
    P##gm = *(const uint4*)(p.GT + ((size_t)(cg_ < SEQ / 16 ? cg_ : SEQ / 16 - 1) * 32 + ib_) * 256 + (tg_ & 31) * 8);  \
    const int t5_ = tid < 96 ? tid : 95;                                                             \
    const int c5_ = c0_ + (t5_ >> 4);                                                                \
    P##g5 = *(const uint4*)(p.G15 + ((size_t)(c5_ < SEQ / 16 ? c5_ : SEQ / 16 - 1) * 32 + ib_) * 64 + (t5_ & 15) * 4);  \
    const int cm_ = c0_ + (tid >> 6);                                                                \
    P##mr = *(const uint4*)(p.MRT + ((size_t)(cm_ < SEQ / 16 ? cm_ : SEQ / 16 - 1) * 32 + ib_) * 512 + (tid & 63) * 8); \
    const int tm_ = 256 + (tid & 127);                                                               \
    const int cs_ = c0_ + (tm_ >> 6);                                                                \
    P##ms = *(const uint4*)(p.MRT + ((size_t)(cs_ < SEQ / 16 ? cs_ : SEQ / 16 - 1) * 32 + ib_) * 512 + (tm_ & 63) * 8); \
  }
#define SCANS_ST5(P, I, B)                                                                           \
    *(uint2*)(B) = uint2{P##a##I.x, P##a##I.y};  *(uint2*)((B) + 8) = uint2{P##a##I.z, P##a##I.w};   \
    *(uint2*)((B) + SARR) = uint2{P##r##I.x, P##r##I.y};  *(uint2*)((B) + SARR + 8) = uint2{P##r##I.z, P##r##I.w};   \
    *(uint2*)((B) + 2 * SARR) = uint2{P##e##I.x, P##e##I.y};  *(uint2*)((B) + 2 * SARR + 8) = uint2{P##e##I.z, P##e##I.w};   \
    *(uint2*)((B) + 3 * SARR) = uint2{P##k##I.x, P##k##I.y};  *(uint2*)((B) + 3 * SARR + 8) = uint2{P##k##I.z, P##k##I.w};   \
    *(uint2*)((B) + 4 * SARR) = uint2{P##v##I.x, P##v##I.y};  *(uint2*)((B) + 4 * SARR + 8) = uint2{P##v##I.z, P##v##I.w};
#define SCANS_COMMIT(P)                                                                              \
  {                                                                                                  \
    char* b0_ = smem + cl0 * SIMG + row0 * SROW + c80 * 16;                                          \
    SCANS_ST5(P, 0, b0_)                                                                             \
    SCANS_ST5(P, 1, b0_ + 2 * SIMG)                                                                  \
    SCANS_ST5(P, 2, b0_ + 4 * SIMG)                                                                  \
    if (tid < 192) *(uint4*)(smem + (tid >> 5) * SIMG + SOFF_GT + (tid & 31) * 16) = P##gm;          \
    if (tid < 96) *(uint4*)(smem + (tid >> 4) * SIMG + SOFF_G15 + (tid & 15) * 16) = P##g5;          \
    *(uint4*)(smem + (tid >> 6) * SIMG + SOFF_MR + (tid & 63) * 16) = P##mr;                         \
    if (tid < 128) *(uint4*)(smem + ((256 + tid) >> 6) * SIMG + SOFF_MR + (tid & 63) * 16) = P##ms;  \
  }
#define SCANS_COMPUTE(SCI)                                                                           \
  _Pragma("unroll 1") for (int cl = 0; cl < SCH && (SCI) * SCH + cl < SEQ / 16; ++cl) {             \
    const char* img = smem + cl * SIMG;                                                              \
        \
    const uint2 vb = *(const uint2*)(img + 4 * SARR + vrow * SROW + vcol * 2);                       \
    const uint2 gt = *(const uint2*)(img + SOFF_GT + (q * 16 + 4 * g) * 2);                          \
    const char* wp = img + q * SROW + (4 * g) * 2;                                                   \
    const uint2 w00 = *(const uint2*)(wp), w01 = *(const uint2*)(wp + 32);                           \
    const uint2 w10 = *(const uint2*)(wp + 64), w11 = *(const uint2*)(wp + 96);                      \
    const uint2 r00 = *(const uint2*)(wp + SARR), r01 = *(const uint2*)(wp + SARR + 32);             \
    const uint2 r10 = *(const uint2*)(wp + SARR + 64), r11 = *(const uint2*)(wp + SARR + 96);        \
    const uint4 mr = *(const uint4*)(img + SOFF_MR + (q * 32 + g * 8) * 2);                          \
    uint2 bk0[4], bk1[4];                                                                            \
    float4 g15[4];                                                                                   \
    _Pragma("unroll") for (int n = 0; n < 4; ++n) {                                                  \
      const int ch = 16 * n + q;                                                                     \
      const char* bp = img + 2 * SARR + (ch >> 2) * SROW + ((ch & 3) * 16 + 4 * g) * 2;              \
      bk0[n] = *(const uint2*)(bp);                                                                  \
      bk1[n] = *(const uint2*)(bp + SARR);                                                           \
      g15[n] = *(const float4*)(img + SOFF_G15 + (16 * n + 4 * g) * 4);                              \
    }                                                                                                \
    __builtin_amdgcn_sched_barrier(0);                                                               \
    const bf16x8 sB0 = mk8(packacc(acc[0]), packacc(acc[1]));                                        \
    const bf16x8 sB1 = mk8(packacc(acc[2]), packacc(acc[3]));                                        \
    f32x4 Z = {0.f, 0.f, 0.f, 0.f};                                                                  \
    Z = __builtin_amdgcn_mfma_f32_16x16x32_bf16(mk8(gt, zero2), mk8(vb, zero2), Z, 0, 0, 0);         \
    f32x4 Y = {0.f, 0.f, 0.f, 0.f};                                                                  \
    Z = __builtin_amdgcn_mfma_f32_16x16x32_bf16(mk8(w00, w01), sB0, Z, 0, 0, 0);                     \
    Y = __builtin_amdgcn_mfma_f32_16x16x32_bf16(mk8(r00, r01), sB0, Y, 0, 0, 0);                     \
    Z = __builtin_amdgcn_mfma_f32_16x16x32_bf16(mk8(w10, w11), sB1, Z, 0, 0, 0);                     \
    Y = __builtin_amdgcn_mfma_f32_16x16x32_bf16(mk8(r10, r11), sB1, Y, 0, 0, 0);                     \
    const bf16x8 zvB = mk8(packacc(Z), vb);                                                          \
    Y = __builtin_amdgcn_mfma_f32_16x16x32_bf16(__builtin_bit_cast(bf16x8, mr), zvB, Y, 0, 0, 0);    \
    _Pragma("unroll") for (int n = 0; n < 4; ++n) {                                                  \
      f32x4 scv = acc[n];                                                                            \
      scv[0] *= g15[n].x; scv[1] *= g15[n].y; scv[2] *= g15[n].z; scv[3] *= g15[n].w;                \
      acc[n] = __builtin_amdgcn_mfma_f32_16x16x32_bf16(mk8(bk0[n], bk1[n]), zvB, scv, 0, 0, 0);      \
    }                                                                                                \
    const int c = (SCI) * SCH + cl;                                                                  \
    _Pragma("unroll") for (int e = 0; e < 4; ++e)                                                    \
        yout[(size_t)(c * 16 + 4 * g + e) * 1024] = (bfu)f2bf(Y[e]);                                 \
  }
DEVI void scans_block(const Params& p, char* smem, int bh) {
  const int b = bh >> 4, h = bh & 15;
  const int lane = threadIdx.x & 63, vs = threadIdx.x >> 6, q = lane & 15, g = lane >> 4;
  f32x4 acc[4];
#pragma unroll
  for (int n = 0; n < 4; ++n) acc[n] = f32x4{0.f, 0.f, 0.f, 0.f};
  const uint2 zero2 = {0u, 0u};
  bfu* yout = p.YS + ((size_t)b * SEQ) * 1024 + h * 64 + vs * 16 + q;
  const int tid = threadIdx.x;
  const int t2 = (tid - 128) & 63;
  const int cl0 = tid >> 7, row0 = (tid >> 3) & 15, c80 = tid & 7;
  uint4 Aa0, Aa1, Aa2, Ar0, Ar1, Ar2, Ae0, Ae1, Ae2, Ak0, Ak1, Ak2, Av0, Av1, Av2, Agm, Ag5, Amr, Ams;
  constexpr int NSC = (SEQ / 16 + SCH - 1) / SCH;
  const int vrow = vs * 4 + (q >> 2), vcol = (q & 3) * 16 + 4 * g;
  SCANS_ISSUE(A, 0);
  SCANS_COMMIT(A);
  __syncthreads();
#pragma unroll 1
  for (int sc = 0; sc < NSC; ++sc) {
    SCANS_ISSUE(A, (sc + 1 < NSC ? sc + 1 : NSC - 1));
    SCANS_COMPUTE(sc);
    __syncthreads();
    SCANS_COMMIT(A);
    __syncthreads();
  }
}
DEVI void phase6(const Params& p, char* smem, int bid, int nb) {
  for (int it = bid; it < 32; it += nb) scans_block(p, smem, it);
}

DEVI void phase6b(const Params& p, int bid, int nb) {
  for (int it = bid; it < T_TOK * 16 / 4; it += nb) {
    const int task = it * 4 + (threadIdx.x >> 6);
    const int lane = threadIdx.x & 63;
    const int t = task >> 4, h = task & 15;
    const size_t idx = (size_t)t * 1024 + h * 64 + lane;
    const int c = h * 64 + lane;
    const float ys = bf2f(p.YS[idx]);
    const float mean = wave_sum(ys) * (1.f / 64.f);
    const float dv = ys - mean;
    const float var = wave_sum(dv * dv) * (1.f / 64.f);
    float y = dv * rsqrtf(var + 64e-5f) * p.lnw[c] + p.lnb[c];
    const int tb = t & ~15, tau = t & 15;
    const float v = bf2f(p.V1[(size_t)(tb + (lane >> 2)) * 1024 + h * 64 + (lane & 3) * 16 + tau]);
    const float bon = p.COEF[(size_t)t * 16 + h];
    y = (y + bon * v) * bf2f(p.SG[idx]);
    p.YS[idx] = (bfu)f2bf(y);
  }
}

struct Epi7 {
  const Params* p;
  DEVI void operator()(int row, int col, f32x4 v) const {
    float4* dst = (float4*)(p->out + (size_t)row * 1024 + col);
    float4 o = *dst;
    o.x += v[0]; o.y += v[1]; o.z += v[2]; o.w += v[3];
    *dst = o;
  }
};
DEVI void phase7(const Params& p, char* smem, int bid, int nb) {
  ALoadPlain al{p.YS, 1024};
  Epi7 epi{&p};
  TileSched ts(bid, nb, T_TOK / 128, 8, 8, 8);
  int mt, nt, st;
  while ((st = ts.next(mt, nt)) != 0) {
    if (st != 1) continue;
    gemm_tile(smem, al, p.WT_o, 1024, 1024, mt * 128, nt * 128, epi);
  }
}
DEVI void phase8(const Params& p, int bid, int nb) {
  for (int it = bid; it < T_TOK / 4; it += nb) {
    const int row = it * 4 + (threadIdx.x >> 6);
    const int lane = threadIdx.x & 63;
    float* src = p.out + (size_t)row * 1024;
    float4 v[4];
    float ss = 0.f;
#pragma unroll
    for (int i = 0; i < 4; ++i) {
      v[i] = *(const float4*)(src + lane * 4 + 256 * i);
      ss += v[i].x * v[i].x + v[i].y * v[i].y + v[i].z * v[i].z + v[i].w * v[i].w;
    }
    ss = wave_sum(ss);
    const float rinv = rsqrtf(ss * (1.f / 1024.f) + 1e-6f);
#pragma unroll
    for (int i = 0; i < 4; ++i) {
      float4 g = *(const float4*)(p.fnorm + lane * 4 + 256 * i);
      float4 o = {v[i].x * rinv * g.x, v[i].y * rinv * g.y, v[i].z * rinv * g.z, v[i].w * rinv * g.w};
      *(float4*)(src + lane * 4 + 256 * i) = o;
    }
  }
}

template <int PH>
DEVI void run_phase(const Params& p, char* smem, int bid, int nb) {
  if (PH == 0) phase0(p, smem, bid, nb);
  if (PH == 1) phase1(p, smem, bid, nb);
  if (PH == 2) phase2(p, smem, bid, nb);
  if (PH == 3) phase3(p, smem, bid, nb);
  if (PH == 4) phase3b(p, bid, nb);
  if (PH == 5) phase4(p, smem, bid, nb);
  if (PH == 6) phase5(p, smem, bid, nb);
  if (PH == 7) phase6x(p, smem, bid, nb);
  if (PH == 8) phase6(p, smem, bid, nb);
  if (PH == 9) phase6b(p, bid, nb);
  if (PH == 10) phase7(p, smem, bid, nb);
  if (PH == 11) phase8(p, bid, nb);
}

template <int PH>
__global__ void __launch_bounds__(256, 2) phase_kernel(Params p) {
  extern __shared__ __attribute__((aligned(16))) char smem[];
  run_phase<PH>(p, smem, blockIdx.x, gridDim.x);
}

#ifndef REP_MASK
#define REP_MASK 0
#endif
template <int PH>
DEVI void mega_phase(const Params& p, char* smem, cg::grid_group& grid, int bid, int nb) {
  run_phase<PH>(p, smem, bid, nb);
  if ((REP_MASK >> PH) & 1) {
    grid.sync();
    run_phase<PH>(p, smem, bid, nb);
  }
}
__global__ void __launch_bounds__(256, 2) mega_kernel(Params p) {
  extern __shared__ __attribute__((aligned(16))) char smem[];
  cg::grid_group grid = cg::this_grid();
  const int bid = blockIdx.x, nb = gridDim.x;
  mega_phase<0>(p, smem, grid, bid, nb); grid.sync();
  mega_phase<1>(p, smem, grid, bid, nb); grid.sync();
  mega_phase<2>(p, smem, grid, bid, nb); grid.sync();
  mega_phase<3>(p, smem, grid, bid, nb); grid.sync();
  mega_phase<4>(p, smem, grid, bid, nb); grid.sync();
  mega_phase<5>(p, smem, grid, bid, nb); grid.sync();
  mega_phase<6>(p, smem, grid, bid, nb); grid.sync();
  mega_phase<7>(p, smem, grid, bid, nb); grid.sync();
  mega_phase<8>(p, smem, grid, bid, nb); grid.sync();
  mega_phase<9>(p, smem, grid, bid, nb); grid.sync();
  mega_phase<10>(p, smem, grid, bid, nb); grid.sync();
  mega_phase<11>(p, smem, grid, bid, nb);
}

extern "C" void kernel_launch(void* const* d_in, const int* in_sizes, int n_in, void* d_out, int out_size, void* d_ws,
                              size_t ws_size, hipStream_t stream) {
  Params p{};
  const float** fp = (const float**)&p;
  for (int i = 0; i < 26; ++i) fp[i] = (const float*)d_in[i];
  p.out = (float*)d_out;
  char* w = (char*)d_ws;
  size_t off = 0;
  auto take = [&](size_t bytes) {
    char* r = w + off;
    off += (bytes + 255) & ~(size_t)255;
    return (bfu*)r;
  };
  p.WT_in = take((size_t)3584 * 1024 * 2);
  p.WT_out = take((size_t)1024 * 1024 * 2);
  p.WT_3 = take((size_t)4352 * 1024 * 2);
  p.WT_o = take((size_t)1024 * 1024 * 2);
  p.W2T = take((size_t)1024 * 64 * 2);
  p.A2T = take((size_t)1024 * 64 * 2);
  p.TW = take((size_t)T_TOK * 64 * 2);
  p.TA = take((size_t)T_TOK * 64 * 2);
  const size_t SLOT = (size_t)T_TOK * 1024 * 2;
  bfu* slot0 = take(SLOT);
  bfu* slots = take(6 * SLOT);
  p.H = slot0;
  p.AA = slot0;
  p.U = slots;
  p.GVT = slots + SLOT / 4;
  p.Q = slots + 2 * (SLOT / 4);
  p.K = slots + 3 * (SLOT / 4);
  p.VT = slots + 4 * (SLOT / 4);
  p.SZ = slots + 7 * (SLOT / 4);
  p.Y = slots + 9 * (SLOT / 4);
  p.R = slots;
  p.K1 = slots + 1 * (SLOT / 2);
  p.V1 = slots + 2 * (SLOT / 2);
  p.SG = slots + 3 * (SLOT / 2);
  p.EW = slots + 4 * (SLOT / 2);
  p.YS = slots + 5 * (SLOT / 2);
  p.G15 = (float*)p.TW;
  p.GT = p.WT_in;
  p.MRT = take((size_t)(SEQ / 16) * 32 * 512 * 2);
  p.COEF = (float*)take((size_t)T_TOK * 16 * 4);
  if (off > ws_size) {
    fprintf(stderr, "workspace too small: need %zu have %zu\n", off, ws_size);
    return;
  }
#if MEGA
  static int grid_blocks = 0;
  if (!grid_blocks) {
    int dev = 0, cus = 0, per_cu = 0;
    (void)hipGetDevice(&dev);
    (void)hipDeviceGetAttribute(&cus, hipDeviceAttributeMultiprocessorCount, dev);
    (void)hipFuncSetAttribute((const void*)mega_kernel, hipFuncAttributeMaxDynamicSharedMemorySize, SMEM_BYTES);
    (void)hipOccupancyMaxActiveBlocksPerMultiprocessor(&per_cu, mega_kernel, 256, SMEM_BYTES);
    grid_blocks = cus * per_cu;
  }
  void* args[] = {&p};
  hipError_t e = hipLaunchCooperativeKernel((void*)mega_kernel, dim3(grid_blocks), dim3(256), args, SMEM_BYTES, stream);
  if (e != hipSuccess) fprintf(stderr, "cooperative launch failed: %s (grid %d)\n", hipGetErrorString(e), grid_blocks);
#else
  const int G = 2048;
  phase_kernel<0><<<G, 256, SMEM_BYTES, stream>>>(p);
  phase_kernel<1><<<G, 256, SMEM_BYTES, stream>>>(p);
  phase_kernel<2><<<G, 256, SMEM_BYTES, stream>>>(p);
  phase_kernel<3><<<G, 256, SMEM_BYTES, stream>>>(p);
  phase_kernel<4><<<G, 256, SMEM_BYTES, stream>>>(p);
  phase_kernel<5><<<G, 256, SMEM_BYTES, stream>>>(p);
  phase_kernel<6><<<G, 256, SMEM_BYTES, stream>>>(p);
  phase_kernel<7><<<G, 256, SMEM_BYTES, stream>>>(p);
  phase_kernel<8><<<32, 256, SMEM_BYTES, stream>>>(p);
  phase_kernel<9><<<G, 256, SMEM_BYTES, stream>>>(p);
  phase_kernel<10><<<G, 256, SMEM_BYTES, stream>>>(p);
  phase_kernel<11><<<G, 256, SMEM_BYTES, stream>>>(p);
#endif
}
```

```cpp
#include <hip/hip_runtime.h>
#include <hip/hip_cooperative_groups.h>
#include <stdint.h>
#include <cstdio>
namespace cg = cooperative_groups;

#ifndef MEGA
#define MEGA 1
#endif

typedef unsigned short bfu;
using bf16x8 = __attribute__((ext_vector_type(8))) short;
using f32x4 = __attribute__((ext_vector_type(4))) float;
#define DEVI __device__ __forceinline__

constexpr int GSTAGE_BYTES = 2 * 128 * 72 * 2;
constexpr int T_TOK = 32768;
constexpr int SEQ = 16384;
constexpr int SMEM_BYTES = 2 * GSTAGE_BYTES + 4096 + 512;

struct Params {
  const float *x, *ln_even, *w_in, *gm_norm, *gm_ws, *gm_b, *w_out, *ln_odd, *mu, *wr, *wk, *wv, *wg, *w0, *w1, *w2,
      *a0, *a1, *a2, *k_k, *k_a, *r_k, *lnw, *lnb, *wo, *fnorm;
  float* out;
  bfu *WT_in, *WT_out, *WT_3, *WT_o, *W2T, *A2T;
  bfu *H, *U, *GVT, *Q, *K, *VT, *SZ, *Y, *R, *K1, *V1, *SG, *EW, *AA, *YS, *TW, *TA, *GT, *MRT;
  float *G15, *COEF;
};

DEVI float bf2f(unsigned b) { return __uint_as_float(b << 16); }
DEVI unsigned f2bf(float x) {
  const __bf16 h = (__bf16)x;
  return (unsigned)__builtin_bit_cast(unsigned short, h);
}
typedef __bf16 bf16x2_t __attribute__((ext_vector_type(2)));
typedef float float2_t __attribute__((ext_vector_type(2)));
DEVI unsigned pkbf(float a, float b) {
  const float2_t f = {a, b};
  const bf16x2_t h = __builtin_convertvector(f, bf16x2_t);
  return __builtin_bit_cast(unsigned, h);
}
DEVI void unpack8(uint4 v, float* f) {
  f[0] = __uint_as_float(v.x << 16); f[1] = __uint_as_float(v.x & 0xffff0000u);
  f[2] = __uint_as_float(v.y << 16); f[3] = __uint_as_float(v.y & 0xffff0000u);
  f[4] = __uint_as_float(v.z << 16); f[5] = __uint_as_float(v.z & 0xffff0000u);
  f[6] = __uint_as_float(v.w << 16); f[7] = __uint_as_float(v.w & 0xffff0000u);
}
DEVI uint4 pack8(const float* f) {
  uint4 r;
  r.x = pkbf(f[0], f[1]);
  r.y = pkbf(f[2], f[3]);
  r.z = pkbf(f[4], f[5]);
  r.w = pkbf(f[6], f[7]);
  return r;
}
DEVI void unpack4(uint2 v, float* f) {
  f[0] = __uint_as_float(v.x << 16); f[1] = __uint_as_float(v.x & 0xffff0000u);
  f[2] = __uint_as_float(v.y << 16); f[3] = __uint_as_float(v.y & 0xffff0000u);
}
DEVI uint2 pack4(const float* f) {
  uint2 r;
  r.x = pkbf(f[0], f[1]);
  r.y = pkbf(f[2], f[3]);
  return r;
}

DEVI float sigmoid_(float x) { return 1.f / (1.f + __expf(-x)); }
DEVI float silu_(float x) { return x * sigmoid_(x); }
DEVI float tanh_(float y) { float t = __expf(2.f * y); return 1.f - 2.f / (1.f + t); }
DEVI float gelu_(float x) {
  float y = 0.7978845608028654f * (x + 0.044715f * x * x * x);
  return 0.5f * x * (1.f + tanh_(y));
}
DEVI float wave_sum(float v) {
#pragma unroll
  for (int o = 32; o > 0; o >>= 1) v += __shfl_xor(v, o);
  return v;
}
DEVI float wave_max(float v) {
#pragma unroll
  for (int o = 32; o > 0; o >>= 1) v = fmaxf(v, __shfl_xor(v, o));
  return v;
}
template <int CTRL>
DEVI float dppf(float x) {
  return __int_as_float(__builtin_amdgcn_update_dpp(0, __float_as_int(x), CTRL, 0xF, 0xF, true));
}
DEVI float reduce16(float x) {
  x += dppf<0xB1>(x);
  x += dppf<0x4E>(x);
  x += dppf<0x141>(x);
  x += dppf<0x140>(x);
  return x;
}

constexpr int LROW = 72;
constexpr int GSTAGE = 2 * 128 * LROW;

template <int DIST = 2, bool SW = true, class ALoad, class Epi>
DEVI void gemm_tile(char* smem, const ALoad& aload, const bfu* __restrict__ Bt, int ldb, int K, int m0, int n0,
                    const Epi& epi) {
  bfu* sbase = (bfu*)smem;
  const int tid = threadIdx.x, lane = tid & 63, wid = tid >> 6, wr = wid >> 1, wc = wid & 1;
  const int fr = lane & 15, fq = lane >> 4;
  f32x4 acc[4][4];
#pragma unroll
  for (int i = 0; i < 4; ++i)
#pragma unroll
    for (int j = 0; j < 4; ++j) acc[i][j] = f32x4{0.f, 0.f, 0.f, 0.f};
  const int r0 = tid >> 3, kc = (tid & 7) * 8;
  const int nk = K >> 6;
  struct GRegs { typename ALoad::Raw a0, a1, a2, a3; uint4 ap, b0, b1, b2, b3; };
  GRegs g0, g1;
  const bfu* Bp = Bt + (size_t)(n0 + r0) * ldb + kc;
  const size_t ldb32 = (size_t)ldb * 32;
  constexpr int ARS = ALoad::kConsec ? 1 : 32;
  const int ar0 = ALoad::kConsec ? 4 * r0 : r0;
#define GEMM_ISSUE(R, KT)                                   \
  {                                                         \
    const int k0_ = ((KT) << 6);                            \
    R.ap = aload.loadprev(m0 + ar0, k0_ + kc);              \
    R.a0 = aload.load(m0 + ar0, k0_ + kc);                  \
    R.a1 = aload.load(m0 + ar0 + ARS, k0_ + kc);            \
    R.a2 = aload.load(m0 + ar0 + 2 * ARS, k0_ + kc);        \
    R.a3 = aload.load(m0 + ar0 + 3 * ARS, k0_ + kc);        \
    R.b0 = *(const uint4*)(Bp + k0_);                       \
    R.b1 = *(const uint4*)(Bp + ldb32 + k0_);               \
    R.b2 = *(const uint4*)(Bp + 2 * ldb32 + k0_);           \
    R.b3 = *(const uint4*)(Bp + 3 * ldb32 + k0_);           \
  }
#define GEMM_COMMIT(R, S, KT)                               \
  {                                                         \
    const int k1_ = ((KT) << 6) + kc;                       \
    bfu* A_ = sbase + (S) * GSTAGE + ar0 * LROW + kc;       \
    bfu* B_ = sbase + (S) * GSTAGE + 128 * LROW + r0 * LROW + kc;   \
    *(uint4*)(A_) = aload.finish(R.a0, R.ap, m0 + ar0, k1_);                                 \
    *(uint4*)(A_ + ARS * LROW) = aload.finish(R.a1, aload.asprev(R.a0), m0 + ar0 + ARS, k1_);          \
    *(uint4*)(A_ + 2 * ARS * LROW) = aload.finish(R.a2, aload.asprev(R.a1), m0 + ar0 + 2 * ARS, k1_);  \
    *(uint4*)(A_ + 3 * ARS * LROW) = aload.finish(R.a3, aload.asprev(R.a2), m0 + ar0 + 3 * ARS, k1_);  \
    *(uint4*)(B_) = R.b0;                                   \
    *(uint4*)(B_ + 32 * LROW) = R.b1;                       \
    *(uint4*)(B_ + 64 * LROW) = R.b2;                       \
    *(uint4*)(B_ + 96 * LROW) = R.b3;                       \
  }
#define GEMM_COMPUTE(S)                                                                          \
  {                                                                                              \
    const bfu* cA = sbase + (S) * GSTAGE;                                                        \
    const bfu* cB = cA + 128 * LROW;                                                             \
    _Pragma("unroll") for (int ks = 0; ks < 2; ++ks) {                                           \
      bf16x8 af[4], bfv[4];                                                                      \
      _Pragma("unroll") for (int i = 0; i < 4; ++i) {                                            \
        af[i] = *(const bf16x8*)(cA + (wr * 64 + i * 16 + fr) * LROW + ks * 32 + fq * 8);        \
        bfv[i] = *(const bf16x8*)(cB + (wc * 64 + i * 16 + fr) * LROW + ks * 32 + fq * 8);       \
      }                                                                                          \
      _Pragma("unroll") for (int i = 0; i < 4; ++i) _Pragma("unroll") for (int j = 0; j < 4; ++j) \
          acc[i][j] = SW ? __builtin_amdgcn_mfma_f32_16x16x32_bf16(bfv[j], af[i], acc[i][j], 0, 0, 0)     \
                         : __builtin_amdgcn_mfma_f32_16x16x32_bf16(af[i], bfv[j], acc[i][j], 0, 0, 0);    \
    }                                                                                            \
  }
  const int nkm1 = nk - 1;
  if (DIST == 2) {
    GEMM_ISSUE(g0, 0);
    GEMM_ISSUE(g1, (1 < nkm1 ? 1 : nkm1));
    GEMM_COMMIT(g0, 0, 0);
    GEMM_ISSUE(g0, (2 < nkm1 ? 2 : nkm1));
    __syncthreads();
    if (nk == 1) {
      GEMM_COMPUTE(0);
      __syncthreads();
    } else {
      for (int kt = 0; kt < nk; kt += 2) {
        GEMM_COMMIT(g1, 1, (kt + 1 < nkm1 ? kt + 1 : nkm1));
        GEMM_ISSUE(g1, (kt + 3 < nkm1 ? kt + 3 : nkm1));
        GEMM_COMPUTE(0);
        __syncthreads();
        GEMM_COMMIT(g0, 0, (kt + 2 < nkm1 ? kt + 2 : nkm1));
        GEMM_ISSUE(g0, (kt + 4 < nkm1 ? kt + 4 : nkm1));
        GEMM_COMPUTE(1);
        __syncthreads();
      }
    }
  } else {
    GEMM_ISSUE(g0, 0);
    GEMM_COMMIT(g0, 0, 0);
    GEMM_ISSUE(g0, (1 < nkm1 ? 1 : nkm1));
    __syncthreads();
    for (int kt = 0; kt < nk; kt += 2) {
      GEMM_COMMIT(g0, 1, (kt + 1 < nkm1 ? kt + 1 : nkm1));
      GEMM_ISSUE(g0, (kt + 2 < nkm1 ? kt + 2 : nkm1));
      GEMM_COMPUTE(0);
      __syncthreads();
      GEMM_COMMIT(g0, 0, (kt + 2 < nkm1 ? kt + 2 : nkm1));
      GEMM_ISSUE(g0, (kt + 3 < nkm1 ? kt + 3 : nkm1));
      GEMM_COMPUTE(1);
      __syncthreads();
    }
  }
#pragma unroll
  for (int i = 0; i < 4; ++i)
#pragma unroll
    for (int j = 0; j < 4; ++j) {
      if (SW) epi(m0 + wr * 64 + i * 16 + fr, n0 + wc * 64 + j * 16 + fq * 4, acc[i][j]);
      else epi(m0 + wr * 64 + i * 16 + fq * 4, n0 + wc * 64 + j * 16 + fr, acc[i][j]);
    }
}

struct TileSched {
  int bid, nb, MT, NT, SM, SN, j, snc;
  bool swz;
  DEVI TileSched(int bid_, int nb_, int MT_, int NT_, int SM_, int SN_)
      : bid(bid_), nb(nb_), MT(MT_), NT(NT_), SM(SM_), SN(SN_), j(0) {
    swz = (nb == 8 * SM * SN);
    snc = (NT + SN - 1) / SN;
  }
  DEVI int next(int& mt, int& nt) {
    if (swz) {
      const int xcd = bid & 7, local = bid >> 3;
      const int s = j * 8 + xcd;
      ++j;
      const int sm = s / snc, sn = s - sm * snc;
      if (sm * SM >= MT) return 0;
      mt = sm * SM + local / SN;
      nt = sn * SN + local % SN;
      return (mt < MT && nt < NT) ? 1 : 2;
    } else {
      const int it = bid + j * nb;
      ++j;
      if (it >= MT * NT) return 0;
      mt = it / NT;
      nt = it - mt * NT;
      return 1;
    }
  }
};

struct ALoadPlain {
  typedef uint4 Raw;
  static constexpr bool kFat = false;
  static constexpr bool kConsec = false;
  const bfu* A;
  int lda;
  DEVI Raw load(int row, int k) const { return *(const uint4*)(A + (size_t)row * lda + k); }
  DEVI uint4 loadprev(int, int) const { return uint4{0u, 0u, 0u, 0u}; }
  DEVI uint4 asprev(const Raw&) const { return uint4{0u, 0u, 0u, 0u}; }
  DEVI uint4 finish(const Raw& r, const uint4&, int, int) const { return r; }
};

DEVI void transpose_tile(char* smem, const float* __restrict__ src, int Ns, bfu* __restrict__ dst, int ldd, int noff,
                         int k0, int n0) {
  float(*tile)[65] = (float(*)[65])smem;
  const int tid = threadIdx.x;
  const int kr = tid >> 4, nc = (tid & 15) * 4;
#pragma unroll
  for (int p = 0; p < 4; ++p) {
    float4 v = *(const float4*)(src + (size_t)(k0 + kr + 16 * p) * Ns + n0 + nc);
    tile[kr + 16 * p][nc] = v.x;
    tile[kr + 16 * p][nc + 1] = v.y;
    tile[kr + 16 * p][nc + 2] = v.z;
    tile[kr + 16 * p][nc + 3] = v.w;
  }
  __syncthreads();
  const int nr = tid >> 3, kc = (tid & 7) * 8;
#pragma unroll
  for (int p = 0; p < 2; ++p) {
    const int n = nr + 32 * p;
    float f[8];
#pragma unroll
    for (int j = 0; j < 8; ++j) f[j] = tile[kc + j][n];
    *(uint4*)(dst + (size_t)(noff + n0 + n) * ldd + k0 + kc) = pack8(f);
  }
  __syncthreads();
}

DEVI void rms_row2_bf16(const float* __restrict__ src, const float* __restrict__ g, bfu* __restrict__ dst, int lane) {
  float4 v[2][4];
  float ss[2] = {0.f, 0.f};
#pragma unroll
  for (int r = 0; r < 2; ++r)
#pragma unroll
    for (int i = 0; i < 4; ++i) v[r][i] = *(const float4*)(src + r * 1024 + lane * 4 + 256 * i);
#pragma unroll
  for (int r = 0; r < 2; ++r)
#pragma unroll
    for (int i = 0; i < 4; ++i)
      ss[r] += v[r][i].x * v[r][i].x + v[r][i].y * v[r][i].y + v[r][i].z * v[r][i].z + v[r][i].w * v[r][i].w;
#pragma unroll
  for (int r = 0; r < 2; ++r) {
    const float rinv = rsqrtf(wave_sum(ss[r]) * (1.f / 1024.f) + 1e-6f);
#pragma unroll
    for (int i = 0; i < 4; ++i) {
      const float4 gg = *(const float4*)(g + lane * 4 + 256 * i);
      uint2 o;
      o.x = pkbf(v[r][i].x * rinv * gg.x, v[r][i].y * rinv * gg.y);
      o.y = pkbf(v[r][i].z * rinv * gg.z, v[r][i].w * rinv * gg.w);
      *(uint2*)(dst + r * 1024 + lane * 4 + 256 * i) = o;
    }
  }
}

DEVI void phase0(const Params& p, char* smem, int bid, int nb) {
  constexpr int NT_IN = 16 * 56, NT_SQ = 256, NT_SM = 16;
  constexpr int c0 = NT_IN, c1 = c0 + NT_SQ, c2 = c1 + 4 * NT_SQ, c3 = c2 + NT_SM, c4 = c3 + NT_SM, c5 = c4 + NT_SQ,
                c6 = c5 + NT_SM, c7 = c6 + NT_SM, c8 = c7 + 2, c9 = c8 + T_TOK / 8;
  for (int it = bid; it < c9; it += nb) {
    if (it < c0) {
      transpose_tile(smem, p.w_in, 3584, p.WT_in, 1024, 0, (it / 56) * 64, (it % 56) * 64);
    } else if (it < c1) {
      int j = it - c0;
      transpose_tile(smem, p.w_out, 1024, p.WT_out, 1024, 0, (j >> 4) * 64, (j & 15) * 64);
    } else if (it < c2) {
      int j = it - c1;
      int w = j >> 8;
      j &= 255;
      const float* src = (w == 0) ? p.wr : (w == 1) ? p.wk : (w == 2) ? p.wv : p.wg;
      transpose_tile(smem, src, 1024, p.WT_3, 1024, w * 1024, (j >> 4) * 64, (j & 15) * 64);
    } else if (it < c3) {
      int j = it - c2;
      transpose_tile(smem, p.w1, 64, p.WT_3, 1024, 4096, j * 64, 0);
    } else if (it < c4) {
      int j = it - c3;
      transpose_tile(smem, p.a1, 64, p.WT_3, 1024, 4224, j * 64, 0);
    } else if (it < c5) {
      int j = it - c4;
      transpose_tile(smem, p.wo, 1024, p.WT_o, 1024, 0, (j >> 4) * 64, (j & 15) * 64);
    } else if (it < c6) {
      int j = it - c5;
      transpose_tile(smem, p.w2, 1024, p.W2T, 64, 0, 0, j * 64);
    } else if (it < c7) {
      int j = it - c6;
      transpose_tile(smem, p.a2, 1024, p.A2T, 64, 0, 0, j * 64);
    } else if (it < c8) {
      int j = it - c7;
      bfu* dst = p.WT_3 + (size_t)(j == 0 ? 4160 : 4288) * 1024;
      for (int e = threadIdx.x; e < 64 * 1024 / 8; e += 256) *(uint4*)(dst + e * 8) = uint4{0, 0, 0, 0};
    } else {
      int row = (it - c8) * 8 + (threadIdx.x >> 6) * 2;
      rms_row2_bf16(p.x + (size_t)row * 1024, p.ln_even, p.H + (size_t)row * 1024, threadIdx.x & 63);
    }
  }
}

struct Epi1T {
  const Params* p;
  int nt;
  DEVI void operator()(int row, int col, f32x4 v) const {
    if (nt < 8) {
      const int g = nt - 4, chunk = row >> 7, s = row & 127, c = col & 127;
      uint2 o;
      o.x = pkbf(gelu_(v[0]), gelu_(v[1]));
      o.y = pkbf(gelu_(v[2]), gelu_(v[3]));
      *(uint2*)(p->GVT + ((size_t)((chunk * 4 + g) * 128 + c)) * 128 + s) = o;
    } else {
      const int cc = col - 2048, hh = cc >> 6, dim = cc & 63;
      const int b = row >> 14, s = row & (SEQ - 1);
      bfu* base = p->VT + ((size_t)((b * 8 + hh) * 64 + dim)) * SEQ;
      uint2 o;
      o.x = pkbf(v[0], v[1]);
      o.y = pkbf(v[2], v[3]);
      *(uint2*)(base + s) = o;
      bfu* b1 = base + (size_t)16 * 64 * SEQ;
#pragma unroll
      for (int i = 0; i < 4; ++i) b1[i * (SEQ / 4) + (s >> 2)] = (bfu)f2bf(v[i]);
      bfu* b2 = base + (size_t)2 * 16 * 64 * SEQ;
#pragma unroll
      for (int i = 0; i < 4; ++i) b2[((s + i) & 15) * (SEQ / 16) + (s >> 4)] = (bfu)f2bf(v[i]);
    }
  }
};
struct Epi1C {
  const Params* p;
  int nt;
  DEVI void operator()(int row, int col, f32x4 v) const {
    uint2 o;
    if (nt < 4) {
      o.x = pkbf(gelu_(v[0]), gelu_(v[1]));
      o.y = pkbf(gelu_(v[2]), gelu_(v[3]));
      *(uint2*)(p->U + (size_t)row * 512 + col) = o;
    } else if (nt < 16) {
      o.x = pkbf(v[0], v[1]);
      o.y = pkbf(v[2], v[3]);
      bfu* dst = (nt < 12) ? p->Q + (size_t)row * 512 + col - 1024 : p->K + (size_t)row * 512 + col - 1536;
      *(uint2*)dst = o;
    } else {
      o.x = pkbf(silu_(v[0]), silu_(v[1]));
      o.y = pkbf(silu_(v[2]), silu_(v[3]));
      *(uint2*)(p->SZ + (size_t)row * 1024 + col - 2560) = o;
    }
  }
};

DEVI void phase1(const Params& p, char* smem, int bid, int nb) {
  constexpr int NT = 28, MT = T_TOK / 128;
  ALoadPlain al{p.H, 1024};
  TileSched ts(bid, nb, MT, NT, 16, 4);
  int mt, nt, st;
  while ((st = ts.next(mt, nt)) != 0) {
    if (st != 1) continue;
    if ((nt >= 4 && nt < 8) || (nt >= 16 && nt < 20)) {
      Epi1T epi{&p, nt};
      gemm_tile<2, false>(smem, al, p.WT_in, 1024, 1024, mt * 128, nt * 128, epi);
    } else {
      Epi1C epi{&p, nt};
      gemm_tile<2, true>(smem, al, p.WT_in, 1024, 1024, mt * 128, nt * 128, epi);
    }
  }
}

struct ALoadWs {
  struct Raw { float4 a, b; };
  static constexpr bool kFat = true;
  static constexpr bool kConsec = false;
  const float* ws;
  const float* rinv;
  DEVI Raw load(int t, int s0) const {
    Raw r;
    r.a = *(const float4*)(ws + t * 128 + s0);
    r.b = *(const float4*)(ws + t * 128 + s0 + 4);
    return r;
  }
  DEVI uint4 loadprev(int, int) const { return uint4{0u, 0u, 0u, 0u}; }
  DEVI uint4 asprev(const Raw&) const { return uint4{0u, 0u, 0u, 0u}; }
  DEVI uint4 finish(const Raw& r, const uint4&, int t, int s0) const {
    float f[8] = {r.a.x, r.a.y, r.a.z, r.a.w, r.b.x, r.b.y, r.b.z, r.b.w};
#pragma unroll
    for (int j = 0; j < 8; ++j) f[j] = (s0 + j <= t) ? f[j] * rinv[s0 + j] : 0.f;
    return pack8(f);
  }
};
struct EpiGm {
  const Params* p;
  int chunk, g;
  DEVI void operator()(int t, int c, f32x4 v) const {
    const float4 gn = *(const float4*)(p->gm_norm + g * 128 + c);
    const float bias = p->gm_b[g * 128 + t];
    const size_t tok = (size_t)chunk * 128 + t;
    float u[4], sz[4];
    unpack4(*(const uint2*)(p->U + tok * 512 + g * 128 + c), u);
    unpack4(*(const uint2*)(p->SZ + tok * 1024 + g * 128 + c), sz);
    uint2 o;
    o.x = pkbf(u[0] * (v[0] * gn.x + bias) * sz[0], u[1] * (v[1] * gn.y + bias) * sz[1]);
    o.y = pkbf(u[2] * (v[2] * gn.z + bias) * sz[2], u[3] * (v[3] * gn.w + bias) * sz[3]);
    *(uint2*)(p->Y + tok * 1024 + g * 128 + c) = o;
  }
};

DEVI void gmlp_item(const Params& p, char* smem, int item) {
  const int chunk = item >> 2, g = item & 3;
  const bfu* gv = p.GVT + (size_t)item * 128 * 128;
  float* rinv = (float*)(smem + 2 * GSTAGE_BYTES);
  const int tid = threadIdx.x;
  {
    float* sred = rinv + 128;
    const int s4 = (tid & 31) * 4, cg = tid >> 5;
    uint2 raw[16];
#pragma unroll
    for (int i = 0; i < 16; ++i) raw[i] = *(const uint2*)(gv + (cg * 16 + i) * 128 + s4);
    float ss[4] = {0.f, 0.f, 0.f, 0.f};
#pragma unroll
    for (int i = 0; i < 16; ++i) {
      float f[4];
      unpack4(raw[i], f);
#pragma unroll
      for (int j = 0; j < 4; ++j) ss[j] += f[j] * f[j];
    }
    *(float4*)(sred + cg * 128 + s4) = float4{ss[0], ss[1], ss[2], ss[3]};
    __syncthreads();
    if (tid < 128) {
      float t = 0.f;
#pragma unroll
      for (int i = 0; i < 8; ++i) t += sred[i * 128 + tid];
      rinv[tid] = rsqrtf(t * (1.f / 128.f) + 1e-6f);
    }
  }
  __syncthreads();
  ALoadWs al{p.gm_ws + (size_t)g * 128 * 128, rinv};
  EpiGm epi{&p, chunk, g};
  gemm_tile(smem, al, gv, 128, 128, 0, 0, epi);
}

DEVI void attn_item(const Params& p, char* smem, int item) {
  const int qb = item & 63, bh = item >> 6, b = bh >> 3, h = bh & 7;
  const int q0 = qb * 256;
  bfu* Ob = (bfu*)smem;
  float* Mb = (float*)(smem + 32768);
  float* Lb = Mb + 256;
  const int tid = threadIdx.x, lane = tid & 63, wid = tid >> 6;
  const int qi = lane & 15, g = lane >> 4;
  const float slope = exp2f(-(float)(h + 1));
  const size_t tokb = (size_t)b * SEQ;
#pragma unroll 1
  for (int pi = 0; pi < 3; ++pi) {
    const int dshift = 2 * pi, d = 1 << dshift;
    const bfu* VT = p.VT + (size_t)pi * ((size_t)16 * 64 * SEQ) + (size_t)bh * 64 * SEQ;
#pragma unroll 1
    for (int u = wid; u < 16; u += 4) {
      const int r = u & (d - 1), tile = u >> dshift;
      const int sq0 = (q0 >> dshift) + tile * 16;
      const int sk0 = sq0 - 144;
      const int posq = ((sq0 + qi) << dshift) + r;
      const bfu* qp = p.Q + (tokb + posq) * 512 + h * 64 + g * 8;
      const bf16x8 qf0 = *(const bf16x8*)qp, qf1 = *(const bf16x8*)(qp + 32);
      const bfu* kbase = p.K + (tokb + r) * 512 + h * 64 + g * 8;
      const bfu* vbase = VT + (size_t)qi * SEQ + r * (SEQ >> dshift);
      bf16x8 kf[2][2];
      uint2 vf[4][2];
      auto loadkv = [&](int it) {
#pragma unroll
        for (int tt = 0; tt < 2; ++tt) {
          int sk = sk0 + (2 * it + tt) * 16 + qi;
          sk = sk < 0 ? 0 : sk;
          const bfu* kp = kbase + ((size_t)sk << dshift) * 512;
          kf[tt][0] = *(const bf16x8*)kp;
          kf[tt][1] = *(const bf16x8*)(kp + 32);
        }
        int kidx0 = sk0 + 32 * it + 4 * g, kidx1 = kidx0 + 16;
        kidx0 = kidx0 < 0 ? 0 : kidx0;
        kidx1 = kidx1 < 0 ? 0 : kidx1;
#pragma unroll
        for (int m = 0; m < 4; ++m) {
          vf[m][0] = *(const uint2*)(vbase + (size_t)(16 * m) * SEQ + kidx0);
          vf[m][1] = *(const uint2*)(vbase + (size_t)(16 * m) * SEQ + kidx1);
        }
      };
      loadkv(0);
      float mrun = -1e30f, l = 0.f;
      f32x4 O[4];
#pragma unroll
      for (int m = 0; m < 4; ++m) O[m] = f32x4{0.f, 0.f, 0.f, 0.f};
#pragma unroll 1
      for (int it = 0; it < 5; ++it) {
        bf16x8 ck[2][2];
        uint2 cv[4][2];
#pragma unroll
        for (int a = 0; a < 2; ++a)
#pragma unroll
          for (int c = 0; c < 2; ++c) ck[a][c] = kf[a][c];
#pragma unroll
        for (int m = 0; m < 4; ++m) {
          cv[m][0] = vf[m][0];
          cv[m][1] = vf[m][1];
        }
        if (it < 4) loadkv(it + 1);
        f32x4 S[2];
#pragma unroll
        for (int tt = 0; tt < 2; ++tt) {
          f32x4 z = {0.f, 0.f, 0.f, 0.f};
          z = __builtin_amdgcn_mfma_f32_16x16x32_bf16(ck[tt][0], qf0, z, 0, 0, 0);
          z = __builtin_amdgcn_mfma_f32_16x16x32_bf16(ck[tt][1], qf1, z, 0, 0, 0);
          S[tt] = z;
        }
        float mx = -INFINITY;
#pragma unroll
        for (int tt = 0; tt < 2; ++tt)
#pragma unroll
          for (int e = 0; e < 4; ++e) {
            const int kk = (2 * it + tt) * 16 + 4 * g + e;
            const int j = 144 + qi - kk;
            const bool valid = (j >= 0) && (j <= 128) && (sk0 + kk >= 0);
            const float sv = valid ? S[tt][e] * 0.125f - slope * (float)(j << dshift) : -INFINITY;
            S[tt][e] = sv;
            mx = fmaxf(mx, sv);
          }
        mx = fmaxf(mx, __shfl_xor(mx, 16));
        mx = fmaxf(mx, __shfl_xor(mx, 32));
        const float mnew = fmaxf(mrun, mx);
        const float alpha = __expf(mrun - mnew);
        mrun = mnew;
        float ls = 0.f;
#pragma unroll
        for (int tt = 0; tt < 2; ++tt)
#pragma unroll
          for (int e = 0; e < 4; ++e) {
            const float pe = __expf(S[tt][e] - mnew);
            S[tt][e] = pe;
            ls += pe;
          }
        l = l * alpha + ls;
        uint4 pk;
        pk.x = pkbf(S[0][0], S[0][1]);
        pk.y = pkbf(S[0][2], S[0][3]);
        pk.z = pkbf(S[1][0], S[1][1]);
        pk.w = pkbf(S[1][2], S[1][3]);
        const bf16x8 pf = __builtin_bit_cast(bf16x8, pk);
#pragma unroll
        for (int m = 0; m < 4; ++m) {
          O[m] *= alpha;
          const uint4 vv = {cv[m][0].x, cv[m][0].y, cv[m][1].x, cv[m][1].y};
          O[m] = __builtin_amdgcn_mfma_f32_16x16x32_bf16(__builtin_bit_cast(bf16x8, vv), pf, O[m], 0, 0, 0);
        }
      }
      l += __shfl_xor(l, 16);
      l += __shfl_xor(l, 32);
      const float mx = mrun;
      const float il = 1.f / l;
      const int ql = ((tile * 16 + qi) << dshift) + r;
      float wo = 0.f, wn = 1.f;
      float mnew = mx, lnew = l;
      if (pi > 0) {
        const float mo = Mb[ql], lo = Lb[ql];
        mnew = fmaxf(mo, mx);
        wo = lo * __expf(mo - mnew);
        wn = l * __expf(mx - mnew);
        lnew = wo + wn;
        const float inv = 1.f / lnew;
        wo *= inv;
        wn *= inv;
      }
      wn *= il;
#pragma unroll
      for (int m = 0; m < 4; ++m) {
        bfu* op = Ob + ql * 64 + 16 * m + 4 * g;
        float o[4];
        if (pi > 0) {
          const uint2 ov = *(const uint2*)op;
          o[0] = wo * bf2f(ov.x & 0xffffu) + wn * O[m][0];
          o[1] = wo * bf2f(ov.x >> 16) + wn * O[m][1];
          o[2] = wo * bf2f(ov.y & 0xffffu) + wn * O[m][2];
          o[3] = wo * bf2f(ov.y >> 16) + wn * O[m][3];
        } else {
#pragma unroll
          for (int e = 0; e < 4; ++e) o[e] = wn * O[m][e];
        }
        if (pi < 2) {
          uint2 w;
          w.x = pkbf(o[0], o[1]);
          w.y = pkbf(o[2], o[3]);
          *(uint2*)op = w;
        } else {
          const size_t oi = (tokb + q0 + ql) * 1024 + 512 + h * 64 + 16 * m + 4 * g;
          const uint2 sz = *(const uint2*)(p.SZ + oi);
          uint2 w;
          w.x = pkbf(o[0] * bf2f(sz.x & 0xffffu), o[1] * bf2f(sz.x >> 16));
          w.y = pkbf(o[2] * bf2f(sz.y & 0xffffu), o[3] * bf2f(sz.y >> 16));
          *(uint2*)(p.Y + oi) = w;
        }
      }
      if (pi < 2 && g == 0) {
        Mb[ql] = mnew;
        Lb[ql] = lnew;
      }
    }
    __syncthreads();
  }
}

DEVI void phase2(const Params& p, char* smem, int bid, int nb) {
  constexpr int NG = (T_TOK / 128) * 4;
  constexpr int NA = 16 * 64;
  for (int it = bid; it < NG + NA; it += nb) {
    if (it < NA) {
      attn_item(p, smem, it);
    } else {
      gmlp_item(p, smem, it - NA);
    }
  }
}

struct Epi3 {
  const Params* p;
  DEVI void operator()(int row, int col, f32x4 v) const {
    const size_t idx = (size_t)row * 1024 + col;
    const float4 x = *(const float4*)(p->x + idx);
    const float4 o = {x.x + v[0], x.y + v[1], x.z + v[2], x.w + v[3]};
    *(float4*)(p->out + idx) = o;
  }
};
DEVI void phase3(const Params& p, char* smem, int bid, int nb) {
  ALoadPlain al{p.Y, 1024};
  Epi3 epi{&p};
  TileSched ts(bid, nb, T_TOK / 128, 8, 8, 8);
  int mt, nt, st;
  while ((st = ts.next(mt, nt)) != 0) {
    if (st != 1) continue;
    gemm_tile(smem, al, p.WT_out, 1024, 1024, mt * 128, nt * 128, epi);
  }
}
DEVI void phase3b(const Params& p, int bid, int nb) {
  for (int it = bid; it < T_TOK / 8; it += nb) {
    const int row = it * 8 + (threadIdx.x >> 6) * 2;
    rms_row2_bf16(p.out + (size_t)row * 1024, p.ln_odd, p.H + (size_t)row * 1024, threadIdx.x & 63);
  }
}

struct ALoadMix {
  typedef uint4 Raw;
  static constexpr bool kFat = true;
  static constexpr bool kConsec = true;
  const bfu* H;
  const float* mu;
  DEVI Raw load(int row, int k) const { return *(const uint4*)(H + (size_t)row * 1024 + k); }
  DEVI uint4 loadprev(int row, int k) const {
    const int prow = ((row & (SEQ - 1)) != 0) ? row - 1 : row;
    return *(const uint4*)(H + (size_t)prow * 1024 + k);
  }
  DEVI uint4 asprev(const Raw& r) const { return r; }
  DEVI uint4 finish(const Raw& r, const uint4& pr, int row, int k) const {
    float c[8], pv[8];
    unpack8(r, c);
    unpack8(pr, pv);
    const float first = ((row & (SEQ - 1)) != 0) ? 1.f : 0.f;
    const float4 m0 = *(const float4*)(mu + k), m1 = *(const float4*)(mu + k + 4);
    const float mm[8] = {m0.x, m0.y, m0.z, m0.w, m1.x, m1.y, m1.z, m1.w};
#pragma unroll
    for (int j = 0; j < 8; ++j) c[j] = c[j] + (pv[j] * first - c[j]) * mm[j];
    return pack8(c);
  }
};
struct Epi4 {
  const Params* p;
  int nt;
  DEVI void operator()(int row, int col, f32x4 v) const {
    uint2 o;
    if (nt < 24) {
      o.x = pkbf(v[0], v[1]);
      o.y = pkbf(v[2], v[3]);
      bfu* dst = (nt < 8) ? p->R + (size_t)row * 1024 + col
                          : (nt < 16) ? p->K1 + (size_t)row * 1024 + col - 1024 : p->V1 + (size_t)row * 1024 + col - 2048;
      *(uint2*)dst = o;
    } else if (nt < 32) {
      o.x = pkbf(silu_(v[0]), silu_(v[1]));
      o.y = pkbf(silu_(v[2]), silu_(v[3]));
      *(uint2*)(p->SG + (size_t)row * 1024 + col - 3072) = o;
    } else if (nt == 32) {
      const int c = col - 4096;
      if (c < 64) {
        o.x = pkbf(tanh_(v[0]), tanh_(v[1]));
        o.y = pkbf(tanh_(v[2]), tanh_(v[3]));
        *(uint2*)(p->TW + (size_t)row * 64 + c) = o;
      }
    } else {
      const int c = col - 4224;
      if (c < 64) {
        o.x = pkbf(v[0], v[1]);
        o.y = pkbf(v[2], v[3]);
        *(uint2*)(p->TA + (size_t)row * 64 + c) = o;
      }
    }
  }
};
DEVI void phase4_tile(const Params& p, char* smem, int mt, int nt) {
  float* smu = (float*)(smem + 2 * GSTAGE_BYTES);
  const int mi = (nt < 8) ? 0 : (nt < 16) ? 2 : (nt < 24) ? 3 : (nt < 32) ? 5 : (nt == 32) ? 1 : 4;
  *(float4*)(smu + threadIdx.x * 4) = *(const float4*)(p.mu + mi * 1024 + threadIdx.x * 4);
  __syncthreads();
  ALoadMix al{p.H, smu};
  Epi4 epi{&p, nt};
  gemm_tile<1>(smem, al, p.WT_3, 1024, 1024, mt * 128, nt * 128, epi);
}
DEVI void phase4(const Params& p, char* smem, int bid, int nb) {
  {
    TileSched ts(bid, nb, T_TOK / 128, 32, 8, 8);
    int mt, nt, st;
    while ((st = ts.next(mt, nt)) != 0) {
      if (st != 1) continue;
      phase4_tile(p, smem, mt, nt);
    }
  }
  for (int it = bid; it < (T_TOK / 128) * 2; it += nb) phase4_tile(p, smem, it >> 1, 32 + (it & 1));
}

struct Epi5w {
  const Params* p;
  DEVI void operator()(int row, int col, f32x4 v) const {
    const float4 w0 = *(const float4*)(p->w0 + col);
    const float k = 0.6065306597126334f;
    uint2 o;
    o.x = pkbf(k * sigmoid_(w0.x + v[0]), k * sigmoid_(w0.y + v[1]));
    o.y = pkbf(k * sigmoid_(w0.z + v[2]), k * sigmoid_(w0.w + v[3]));
    *(uint2*)(p->EW + (size_t)row * 1024 + col) = o;
  }
};
struct Epi5a {
  const Params* p;
  DEVI void operator()(int row, int col, f32x4 v) const {
    const float4 a0 = *(const float4*)(p->a0 + col);
    uint2 o;
    o.x = pkbf(sigmoid_(a0.x + v[0]), sigmoid_(a0.y + v[1]));
    o.y = pkbf(sigmoid_(a0.z + v[2]), sigmoid_(a0.w + v[3]));
    *(uint2*)(p->AA + (size_t)row * 1024 + col) = o;
  }
};
DEVI void phase5(const Params& p, char* smem, int bid, int nb) {
  constexpr int N1 = (T_TOK / 128) * 8;
  for (int it = bid; it < 2 * N1; it += nb) {
    if (it < N1) {
      ALoadPlain al{p.TW, 64};
      Epi5w epi{&p};
      gemm_tile(smem, al, p.W2T, 64, 64, (it >> 3) * 128, (it & 7) * 128, epi);
    } else {
      const int j = it - N1;
      ALoadPlain al{p.TA, 64};
      Epi5a epi{&p};
      gemm_tile(smem, al, p.A2T, 64, 64, (j >> 3) * 128, (j & 7) * 128, epi);
    }
  }
}

DEVI void scanx_item(const Params& p, char* smem, int item) {
  const int bh = item & 31, c = item >> 5;
  const int b = bh >> 4, h = bh & 15;
  const size_t rowbase = ((size_t)b * SEQ + (size_t)c * 16) * 1024 + h * 64;
  float* sA = (float*)smem;
  float* sR = sA + 16 * 68;
  float* sBt = sR + 16 * 68;
  float* sKt = sBt + 16 * 68;
  float* sE = sKt + 16 * 68;
  float* sMab = sE + 16 * 64;
  float* sMak = sMab + 256;
  const int tid = threadIdx.x;
  const int tau = tid >> 4, c4 = (tid & 15) * 4;
  const size_t o = rowbase + (size_t)tau * 1024 + c4;
  float r[4], k[4], ew[4], a[4], vv[4];
  unpack4(*(const uint2*)(p.R + o), r);
  unpack4(*(const uint2*)(p.K1 + o), k);
  unpack4(*(const uint2*)(p.EW + o), ew);
  unpack4(*(const uint2*)(p.AA + o), a);
  unpack4(*(const uint2*)(p.V1 + o), vv);
  float kk[4], kp[4], bb[4];
  float ss = 0.f, cf = 0.f;
#pragma unroll
  for (int j = 0; j < 4; ++j) {
    const int ch = h * 64 + c4 + j;
    kk[j] = k[j] * p.k_k[ch];
    ss += kk[j] * kk[j];
    kp[j] = k[j] * (1.f + (a[j] - 1.f) * p.k_a[ch]);
    cf += r[j] * kp[j] * p.r_k[ch];
  }
  ss = reduce16(ss);
  cf = reduce16(cf);
  const float rn = rsqrtf(fmaxf(ss, 1e-24f));
#pragma unroll
  for (int j = 0; j < 4; ++j) {
    kk[j] *= rn;
    bb[j] = kk[j] * a[j];
    sE[tau * 64 + c4 + j] = ew[j];
  }
  if ((tid & 15) == 0) p.COEF[((size_t)b * SEQ + (size_t)c * 16 + tau) * 16 + h] = cf;
  __syncthreads();
  float Li[4] = {0.f, 0.f, 0.f, 0.f}, L15[4] = {0.f, 0.f, 0.f, 0.f};
#pragma unroll
  for (int i = 0; i < 16; ++i) {
    const float4 e = *(const float4*)(sE + i * 64 + c4);
    const float m = (i <= tau) ? 1.f : 0.f;
    Li[0] += m * e.x; Li[1] += m * e.y; Li[2] += m * e.z; Li[3] += m * e.w;
    L15[0] += e.x; L15[1] += e.y; L15[2] += e.z; L15[3] += e.w;
  }
  float rt[4], bhat[4], khat[4];
#pragma unroll
  for (int j = 0; j < 4; ++j) {
    const float ep = __expf(Li[j]), em = __expf(-Li[j]), eh = __expf(-(L15[j] - Li[j]));
    const float at = -kk[j] * __expf(-(Li[j] - ew[j]));
    rt[j] = r[j] * em;
    sA[tau * 68 + c4 + j] = at;
    sR[tau * 68 + c4 + j] = rt[j];
    sBt[tau * 68 + c4 + j] = bb[j] * ep;
    sKt[tau * 68 + c4 + j] = kp[j] * ep;
    bhat[j] = bb[j] * eh;
    khat[j] = kp[j] * eh;
  }
  *(uint2*)(p.R + o) = pack4(rt);
#pragma unroll
  for (int j = 0; j < 4; ++j) {
    const int lin = (c4 + j) * 16 + tau;
    const size_t off = rowbase + (size_t)(lin >> 6) * 1024 + (lin & 63);
    p.EW[off] = (bfu)f2bf(bhat[j]);
    p.K1[off] = (bfu)f2bf(khat[j]);
    p.V1[off] = (bfu)f2bf(vv[j]);
  }
  if (tau == 0) {
    float4 gq = {__expf(-L15[0]), __expf(-L15[1]), __expf(-L15[2]), __expf(-L15[3])};
    *(float4*)(p.G15 + (size_t)item * 64 + c4) = gq;
  }
  __syncthreads();
  {
    const int i = tid >> 4, tq = tid & 15;
    float mab = 0.f, mak = 0.f, mrb = 0.f, mrk = 0.f;
#pragma unroll
    for (int kq = 0; kq < 64; kq += 4) {
      const float4 bi = *(const float4*)(sBt + i * 68 + kq);
      const float4 ki = *(const float4*)(sKt + i * 68 + kq);
      const float4 aq = *(const float4*)(sA + tq * 68 + kq);
      const float4 rq = *(const float4*)(sR + tq * 68 + kq);
      mab += bi.x * aq.x + bi.y * aq.y + bi.z * aq.z + bi.w * aq.w;
      mak += ki.x * aq.x + ki.y * aq.y + ki.z * aq.z + ki.w * aq.w;
      mrb += bi.x * rq.x + bi.y * rq.y + bi.z * rq.z + bi.w * rq.w;
      mrk += ki.x * rq.x + ki.y * rq.y + ki.z * rq.z + ki.w * rq.w;
    }
    if (!(i < tq)) { mab = 0.f; mak = 0.f; }
    if (!(i <= tq)) { mrb = 0.f; mrk = 0.f; }
    sMab[i * 16 + tq] = mab;
    sMak[i * 16 + tq] = mak;
    bfu* mr = p.MRT + (size_t)item * 512 + tq * 32 + (i >> 2) * 8 + (i & 3);
    mr[0] = (bfu)f2bf(mrb);
    mr[4] = (bfu)f2bf(mrk);
  }
  __syncthreads();
  if (tid < 80) {
    float x[16];
#pragma unroll
    for (int t = 0; t < 16; ++t) {
      float accv = (tid < 64) ? sA[t * 68 + tid] : sMak[(tid - 64) * 16 + t];
#pragma unroll
      for (int i = 0; i < t; ++i) accv += x[i] * sMab[i * 16 + t];
      x[t] = accv;
    }
    if (tid < 64) {
#pragma unroll
      for (int t = 0; t < 16; ++t) p.AA[rowbase + (size_t)t * 1024 + tid] = (bfu)f2bf(x[t]);
    } else {
#pragma unroll
      for (int t = 0; t < 16; ++t) p.GT[(size_t)item * 256 + t * 16 + (tid - 64)] = (bfu)f2bf(x[t]);
    }
  }
  __syncthreads();
}
DEVI void phase6x(const Params& p, char* smem, int bid, int nb) {
  for (int it = bid; it < (SEQ / 16) * 32; it += nb) scanx_item(p, smem, it);
}

DEVI bf16x8 mk8(uint2 a, uint2 b) {
  const uint4 v = {a.x, a.y, b.x, b.y};
  return __builtin_bit_cast(bf16x8, v);
}
DEVI uint2 packacc(f32x4 a) {
  uint2 r;
  r.x = pkbf(a[0], a[1]);
  r.y = pkbf(a[2], a[3]);
  return r;
}
constexpr int SCH = 6;
constexpr int SROW = 136;
constexpr int SARR = 16 * SROW;
constexpr int SOFF_GT = 5 * SARR;
constexpr int SOFF_MR = SOFF_GT + 512;
constexpr int SOFF_G15 = SOFF_MR + 1024;
constexpr int SIMG = SOFF_G15 + 256;
#define SCANS_LD5(P, I, O)                       \
    P##a##I = *(const uint4*)(p.AA + (O));       \
    P##r##I = *(const uint4*)(p.R + (O));        \
    P##e##I = *(const uint4*)(p.EW + (O));       \
    P##k##I = *(const uint4*)(p.K1 + (O));       \
    P##v##I = *(const uint4*)(p.V1 + (O));
#define SCANS_ISSUE(P, SC)                                                                           \
  {                                                                                                  \
    const size_t hb_ = ((size_t)b * SEQ) * 1024 + h * 64 + c80 * 8;                                  \
    const int tk0_ = (SC) * SCH * 16 + cl0 * 16 + row0;                                              \
    const int tk1_ = tk0_ + 32, tk2_ = tk0_ + 64;                                                    \
    SCANS_LD5(P, 0, hb_ + (size_t)(tk0_ < SEQ ? tk0_ : SEQ - 1) * 1024)                              \
    SCANS_LD5(P, 1, hb_ + (size_t)(tk1_ < SEQ ? tk1_ : SEQ - 1) * 1024)                              \
    SCANS_LD5(P, 2, hb_ + (size_t)(tk2_ < SEQ ? tk2_ : SEQ - 1) * 1024)                              \
    const int c0_ = (SC) * SCH;                                                                      \
    const size_t ib_ = (size_t)b * 16 + h;                                                           \
    const int tg_ = tid < 192 ? tid : 191;                                                           \
    const int cg_ = c0_ + (tg_ >> 5);                                                                \
    P##gm = *(const uint4*)(p.GT + ((size_t)(cg_ < SEQ / 16 ? cg_ : SEQ / 16 - 1) * 32 + ib_) * 256 + (tg_ & 31) * 8);  \
    const int t5_ = tid < 96 ? tid : 95;                                                             \
    const int c5_ = c0_ + (t5_ >> 4);                                                                \
    P##g5 = *(const uint4*)(p.G15 + ((size_t)(c5_ < SEQ / 16 ? c5_ : SEQ / 16 - 1) * 32 + ib_) * 64 + (t5_ & 15) * 4);  \
    const int cm_ = c0_ + (tid >> 6);                                                                \
    P##mr = *(const uint4*)(p.MRT + ((size_t)(cm_ < SEQ / 16 ? cm_ : SEQ / 16 - 1) * 32 + ib_) * 512 + (tid & 63) * 8); \
    const int tm_ = 256 + (tid & 127);                                                               \
    const int cs_ = c0_ + (tm_ >> 6);                                                                \
    P##ms = *(const uint4*)(p.MRT + ((size_t)(cs_ < SEQ / 16 ? cs_ : SEQ / 16 - 1) * 32 + ib_) * 512 + (tm_ & 63) * 8); \
  }
#define SCANS_ST5(P, I, B)                                                                           \
    *(uint2*)(B) = uint2{P##a##I.x, P##a##I.y};  *(uint2*)((B) + 8) = uint2{P##a##I.z, P##a##I.w};   \
    *(uint2*)((B) + SARR) = uint2{P##r##I.x, P##r##I.y};  *(uint2*)((B) + SARR + 8) = uint2{P##r##I.z, P##r##I.w};   \
    *(uint2*)((B) + 2 * SARR) = uint2{P##e##I.x, P##e##I.y};  *(uint2*)((B) + 2 * SARR + 8) = uint2{P##e##I.z, P##e##I.w};   \
    *(uint2*)((B) + 3 * SARR) = uint2{P##k##I.x, P##k##I.y};  *(uint2*)((B) + 3 * SARR + 8) = uint2{P##k##I.z, P##k##I.w};   \
    *(uint2*)((B) + 4 * SARR) = uint2{P##v##I.x, P##v##I.y};  *(uint2*)((B) + 4 * SARR + 8) = uint2{P##v##I.z, P##v##I.w};
#define SCANS_COMMIT(P)                                                                              \
  {                                                                                                  \
    char* b0_ = smem + cl0 * SIMG + row0 * SROW + c80 * 16;                                          \
    SCANS_ST5(P, 0, b0_)                                                                             \
    SCANS_ST5(P, 1, b0_ + 2 * SIMG)                                                                  \
    SCANS_ST5(P, 2, b0_ + 4 * SIMG)                                                                  \
    if (tid < 192) *(uint4*)(smem + (tid >> 5) * SIMG + SOFF_GT + (tid & 31) * 16) = P##gm;          \
    if (tid < 96) *(uint4*)(smem + (tid >> 4) * SIMG + SOFF_G15 + (tid & 15) * 16) = P##g5;          \
    *(uint4*)(smem + (tid >> 6) * SIMG + SOFF_MR + (tid & 63) * 16) = P##mr;                         \
    if (tid < 128) *(uint4*)(smem + ((256 + tid) >> 6) * SIMG + SOFF_MR + (tid & 63) * 16) = P##ms;  \
  }
#define SCANS_COMPUTE(SCI)                                                                           \
  _Pragma("unroll 1") for (int cl = 0; cl < SCH && (SCI) * SCH + cl < SEQ / 16; ++cl) {             \
    const char* img = smem + cl * SIMG;                                                              \
        \
    const uint2 vb = *(const uint2*)(img + 4 * SARR + vrow * SROW + vcol * 2);                       \
    const uint2 gt = *(const uint2*)(img + SOFF_GT + (q * 16 + 4 * g) * 2);                          \
    const char* wp = img + q * SROW + (4 * g) * 2;                                                   \
    const uint2 w00 = *(const uint2*)(wp), w01 = *(const uint2*)(wp + 32);                           \
    const uint2 w10 = *(const uint2*)(wp + 64), w11 = *(const uint2*)(wp + 96);                      \
    const uint2 r00 = *(const uint2*)(wp + SARR), r01 = *(const uint2*)(wp + SARR + 32);             \
    const uint2 r10 = *(const uint2*)(wp + SARR + 64), r11 = *(const uint2*)(wp + SARR + 96);        \
    const uint4 mr = *(const uint4*)(img + SOFF_MR + (q * 32 + g * 8) * 2);                          \
    uint2 bk0[4], bk1[4];                                                                            \
    float4 g15[4];                                                                                   \
    _Pragma("unroll") for (int n = 0; n < 4; ++n) {                                                  \
      const int ch = 16 * n + q;                                                                     \
      const char* bp = img + 2 * SARR + (ch >> 2) * SROW + ((ch & 3) * 16 + 4 * g) * 2;              \
      bk0[n] = *(const uint2*)(bp);                                                                  \
      bk1[n] = *(const uint2*)(bp + SARR);                                                           \
      g15[n] = *(const float4*)(img + SOFF_G15 + (16 * n + 4 * g) * 4);                              \
    }                                                                                                \
    __builtin_amdgcn_sched_barrier(0);                                                               \
    const bf16x8 sB0 = mk8(packacc(acc[0]), packacc(acc[1]));                                        \
    const bf16x8 sB1 = mk8(packacc(acc[2]), packacc(acc[3]));                                        \
    f32x4 Z = {0.f, 0.f, 0.f, 0.f};                                                                  \
    Z = __builtin_amdgcn_mfma_f32_16x16x32_bf16(mk8(gt, zero2), mk8(vb, zero2), Z, 0, 0, 0);         \
    f32x4 Y = {0.f, 0.f, 0.f, 0.f};                                                                  \
    Z = __builtin_amdgcn_mfma_f32_16x16x32_bf16(mk8(w00, w01), sB0, Z, 0, 0, 0);                     \
    Y = __builtin_amdgcn_mfma_f32_16x16x32_bf16(mk8(r00, r01), sB0, Y, 0, 0, 0);                     \
    Z = __builtin_amdgcn_mfma_f32_16x16x32_bf16(mk8(w10, w11), sB1, Z, 0, 0, 0);                     \
    Y = __builtin_amdgcn_mfma_f32_16x16x32_bf16(mk8(r10, r11), sB1, Y, 0, 0, 0);                     \
    const bf16x8 zvB = mk8(packacc(Z), vb);                                                          \
    Y = __builtin_amdgcn_mfma_f32_16x16x32_bf16(__builtin_bit_cast(bf16x8, mr), zvB, Y, 0, 0, 0);    \
    _Pragma("unroll") for (int n = 0; n < 4; ++n) {                                                  \
      f32x4 scv = acc[n];                                                                            \
      scv[0] *= g15[n].x; scv[1] *= g15[n].y; scv[2] *= g15[n].z; scv[3] *= g15[n].w;                \
      acc[n] = __builtin_amdgcn_mfma_f32_16x16x32_bf16(mk8(bk0[n], bk1[n]), zvB, scv, 0, 0, 0);      \
    }                                                                                                \
    const int c = (SCI) * SCH + cl;                                                                  \
    _Pragma("unroll") for (int e = 0; e < 4; ++e)                                                    \
        yout[(size_t)(c * 16 + 4 * g + e) * 1024] = (bfu)f2bf(Y[e]);                                 \
  }
DEVI void scans_block(const Params& p, char* smem, int bh) {
  const int b = bh >> 4, h = bh & 15;
  const int lane = threadIdx.x & 63, vs = threadIdx.x >> 6, q = lane & 15, g = lane >> 4;
  f32x4 acc[4];
#pragma unroll
  for (int n = 0; n < 4; ++n) acc[n] = f32x4{0.f, 0.f, 0.f, 0.f};
  const uint2 zero2 = {0u, 0u};
  bfu* yout = p.YS + ((size_t)b * SEQ) * 1024 + h * 64 + vs * 16 + q;
  const int tid = threadIdx.x;
  const int t2 = (tid - 128) & 63;
  const int cl0 = tid >> 7, row0 = (tid >> 3) & 15, c80 = tid & 7;
  uint4 Aa0, Aa1, Aa2, Ar0, Ar1, Ar2, Ae0, Ae1, Ae2, Ak0, Ak1, Ak2, Av0, Av1, Av2, Agm, Ag5, Amr, Ams;
  constexpr int NSC = (SEQ / 16 + SCH - 1) / SCH;
  const int vrow = vs * 4 + (q >> 2), vcol = (q & 3) * 16 + 4 * g;
  SCANS_ISSUE(A, 0);
  SCANS_COMMIT(A);
  __syncthreads();
#pragma unroll 1
  for (int sc = 0; sc < NSC; ++sc) {
    SCANS_ISSUE(A, (sc + 1 < NSC ? sc + 1 : NSC - 1));
    SCANS_COMPUTE(sc);
    __syncthreads();
    SCANS_COMMIT(A);
    __syncthreads();
  }
}
DEVI void phase6(const Params& p, char* smem, int bid, int nb) {
  for (int it = bid; it < 32; it += nb) scans_block(p, smem, it);
}

DEVI void phase6b(const Params& p, int bid, int nb) {
  const int lane = threadIdx.x & 63, wv = threadIdx.x >> 6;
  for (int it = bid; it < T_TOK; it += nb) {
    const int t = it;
    const int tb = t & ~15, tau = t & 15;
    float ys[4], vv[4], sg[4], bon[4];
#pragma unroll
    for (int j = 0; j < 4; ++j) {
      const int h = wv * 4 + j;
      const size_t idx = (size_t)t * 1024 + h * 64 + lane;
      ys[j] = bf2f(p.YS[idx]);
      sg[j] = bf2f(p.SG[idx]);
      vv[j] = bf2f(p.V1[(size_t)(tb + (lane >> 2)) * 1024 + h * 64 + (lane & 3) * 16 + tau]);
      bon[j] = p.COEF[(size_t)t * 16 + h];
    }
#pragma unroll
    for (int j = 0; j < 4; ++j) {
      const int h = wv * 4 + j;
      const int c = h * 64 + lane;
      const float mean = wave_sum(ys[j]) * (1.f / 64.f);
      const float dv = ys[j] - mean;
      const float var = wave_sum(dv * dv) * (1.f / 64.f);
      float y = dv * rsqrtf(var + 64e-5f) * p.lnw[c] + p.lnb[c];
      y = (y + bon[j] * vv[j]) * sg[j];
      p.YS[(size_t)t * 1024 + c] = (bfu)f2bf(y);
    }
  }
}

struct Epi7 {
  const Params* p;
  DEVI void operator()(int row, int col, f32x4 v) const {
    float4* dst = (float4*)(p->out + (size_t)row * 1024 + col);
    float4 o = *dst;
    o.x += v[0]; o.y += v[1]; o.z += v[2]; o.w += v[3];
    *dst = o;
  }
};
DEVI void phase7(const Params& p, char* smem, int bid, int nb) {
  ALoadPlain al{p.YS, 1024};
  Epi7 epi{&p};
  TileSched ts(bid, nb, T_TOK / 128, 8, 8, 8);
  int mt, nt, st;
  while ((st = ts.next(mt, nt)) != 0) {
    if (st != 1) continue;
    gemm_tile(smem, al, p.WT_o, 1024, 1024, mt * 128, nt * 128, epi);
  }
}
DEVI void phase8(const Params& p, int bid, int nb) {
  for (int it = bid; it < T_TOK / 8; it += nb) {
    const int row = it * 8 + (threadIdx.x >> 6) * 2;
    const int lane = threadIdx.x & 63;
    float* src = p.out + (size_t)row * 1024;
    float4 v[2][4];
    float ss[2] = {0.f, 0.f};
#pragma unroll
    for (int r = 0; r < 2; ++r)
#pragma unroll
      for (int i = 0; i < 4; ++i) v[r][i] = *(const float4*)(src + r * 1024 + lane * 4 + 256 * i);
#pragma unroll
    for (int r = 0; r < 2; ++r)
#pragma unroll
      for (int i = 0; i < 4; ++i)
        ss[r] += v[r][i].x * v[r][i].x + v[r][i].y * v[r][i].y + v[r][i].z * v[r][i].z + v[r][i].w * v[r][i].w;
#pragma unroll
    for (int r = 0; r < 2; ++r) {
      const float rinv = rsqrtf(wave_sum(ss[r]) * (1.f / 1024.f) + 1e-6f);
#pragma unroll
      for (int i = 0; i < 4; ++i) {
        const float4 g = *(const float4*)(p.fnorm + lane * 4 + 256 * i);
        const float4 o = {v[r][i].x * rinv * g.x, v[r][i].y * rinv * g.y, v[r][i].z * rinv * g.z, v[r][i].w * rinv * g.w};
        *(float4*)(src + r * 1024 + lane * 4 + 256 * i) = o;
      }
    }
  }
}

template <int PH>
DEVI void run_phase(const Params& p, char* smem, int bid, int nb) {
  if (PH == 0) phase0(p, smem, bid, nb);
  if (PH == 1) phase1(p, smem, bid, nb);
  if (PH == 2) phase2(p, smem, bid, nb);
  if (PH == 3) phase3(p, smem, bid, nb);
  if (PH == 4) phase3b(p, bid, nb);
  if (PH == 5) phase4(p, smem, bid, nb);
  if (PH == 6) phase5(p, smem, bid, nb);
  if (PH == 7) phase6x(p, smem, bid, nb);
  if (PH == 8) phase6(p, smem, bid, nb);
  if (PH == 9) phase6b(p, bid, nb);
  if (PH == 10) phase7(p, smem, bid, nb);
  if (PH == 11) phase8(p, bid, nb);
}

template <int PH>
__global__ void __launch_bounds__(256, 2) phase_kernel(Params p) {
  extern __shared__ __attribute__((aligned(16))) char smem[];
  run_phase<PH>(p, smem, blockIdx.x, gridDim.x);
}

#ifndef REP_MASK
#define REP_MASK 0
#endif
template <int PH>
DEVI void mega_phase(const Params& p, char* smem, cg::grid_group& grid, int bid, int nb) {
  run_phase<PH>(p, smem, bid, nb);
  if ((REP_MASK >> PH) & 1) {
    grid.sync();
    run_phase<PH>(p, smem, bid, nb);
  }
}
__global__ void __launch_bounds__(256, 2) mega_kernel(Params p) {
  extern __shared__ __attribute__((aligned(16))) char smem[];
  cg::grid_group grid = cg::this_grid();
  const int bid = blockIdx.x, nb = gridDim.x;
  mega_phase<0>(p, smem, grid, bid, nb); grid.sync();
  mega_phase<1>(p, smem, grid, bid, nb); grid.sync();
  mega_phase<2>(p, smem, grid, bid, nb); grid.sync();
  mega_phase<3>(p, smem, grid, bid, nb); grid.sync();
  mega_phase<4>(p, smem, grid, bid, nb); grid.sync();
  mega_phase<5>(p, smem, grid, bid, nb); grid.sync();
  mega_phase<6>(p, smem, grid, bid, nb); grid.sync();
  mega_phase<7>(p, smem, grid, bid, nb); grid.sync();
  mega_phase<8>(p, smem, grid, bid, nb); grid.sync();
  mega_phase<9>(p, smem, grid, bid, nb); grid.sync();
  mega_phase<10>(p, smem, grid, bid, nb); grid.sync();
  mega_phase<11>(p, smem, grid, bid, nb);
}

extern "C" void kernel_launch(void* const* d_in, const int* in_sizes, int n_in, void* d_out, int out_size, void* d_ws,
                              size_t ws_size, hipStream_t stream) {
  Params p{};
  const float** fp = (const float**)&p;
  for (int i = 0; i < 26; ++i) fp[i] = (const float*)d_in[i];
  p.out = (float*)d_out;
  char* w = (char*)d_ws;
  size_t off = 0;
  auto take = [&](size_t bytes) {
    char* r = w + off;
    off += (bytes + 255) & ~(size_t)255;
    return (bfu*)r;
  };
  p.WT_in = take((size_t)3584 * 1024 * 2);
  p.WT_out = take((size_t)1024 * 1024 * 2);
  p.WT_3 = take((size_t)4352 * 1024 * 2);
  p.WT_o = take((size_t)1024 * 1024 * 2);
  p.W2T = take((size_t)1024 * 64 * 2);
  p.A2T = take((size_t)1024 * 64 * 2);
  p.TW = take((size_t)T_TOK * 64 * 2);
  p.TA = take((size_t)T_TOK * 64 * 2);
  const size_t SLOT = (size_t)T_TOK * 1024 * 2;
  bfu* slot0 = take(SLOT);
  bfu* slots = take(6 * SLOT);
  p.H = slot0;
  p.AA = slot0;
  p.U = slots;
  p.GVT = slots + SLOT / 4;
  p.Q = slots + 2 * (SLOT / 4);
  p.K = slots + 3 * (SLOT / 4);
  p.VT = slots + 4 * (SLOT / 4);
  p.SZ = slots + 7 * (SLOT / 4);
  p.Y = slots + 9 * (SLOT / 4);
  p.R = slots;
  p.K1 = slots + 1 * (SLOT / 2);
  p.V1 = slots + 2 * (SLOT / 2);
  p.SG = slots + 3 * (SLOT / 2);
  p.EW = slots + 4 * (SLOT / 2);
  p.YS = slots + 5 * (SLOT / 2);
  p.G15 = (float*)p.TW;
  p.GT = p.WT_in;
  p.MRT = take((size_t)(SEQ / 16) * 32 * 512 * 2);
  p.COEF = (float*)take((size_t)T_TOK * 16 * 4);
  if (off > ws_size) {
    fprintf(stderr, "workspace too small: need %zu have %zu\n", off, ws_size);
    return;
  }
#if MEGA
  static int grid_blocks = 0;
  if (!grid_blocks) {
    int dev = 0, cus = 0, per_cu = 0;
    (void)hipGetDevice(&dev);
    (void)hipDeviceGetAttribute(&cus, hipDeviceAttributeMultiprocessorCount, dev);
    (void)hipFuncSetAttribute((const void*)mega_kernel, hipFuncAttributeMaxDynamicSharedMemorySize, SMEM_BYTES);
    (void)hipOccupancyMaxActiveBlocksPerMultiprocessor(&per_cu, mega_kernel, 256, SMEM_BYTES);
    grid_blocks = cus * per_cu;
  }
  void* args[] = {&p};
  hipError_t e = hipLaunchCooperativeKernel((void*)mega_kernel, dim3(grid_blocks), dim3(256), args, SMEM_BYTES, stream);
  if (e != hipSuccess) fprintf(stderr, "cooperative launch failed: %s (grid %d)\n", hipGetErrorString(e), grid_blocks);
#else
  const int G = 2048;
  phase_kernel<0><<<G, 256, SMEM_BYTES, stream>>>(p);
  phase_kernel<1><<<G, 256, SMEM_BYTES, stream>>>(p);
  phase_kernel<2><<<G, 256, SMEM_BYTES, stream>>>(p);
  phase_kernel<3><<<G, 256, SMEM_BYTES, stream>>>(p);
  phase_kernel<4><<<G, 256, SMEM_BYTES, stream>>>(p);
  phase_kernel<5><<<G, 256, SMEM_BYTES, stream>>>(p);
  phase_kernel<6><<<G, 256, SMEM_BYTES, stream>>>(p);
  phase_kernel<7><<<G, 256, SMEM_BYTES, stream>>>(p);
  phase_kernel<8><<<32, 256, SMEM_BYTES, stream>>>(p);
  phase_kernel<9><<<G, 256, SMEM_BYTES, stream>>>(p);
  phase_kernel<10><<<G, 256, SMEM_BYTES, stream>>>(p);
  phase_kernel<11><<<G, 256, SMEM_BYTES, stream>>>(p);
#endif
}
```

```cpp
#include <hip/hip_runtime.h>
#include <hip/hip_cooperative_groups.h>
#include <stdint.h>
#include <cstdio>
namespace cg = cooperative_groups;

#ifndef MEGA
#define MEGA 1
#endif

typedef unsigned short bfu;
using bf16x8 = __attribute__((ext_vector_type(8))) short;
using f32x4 = __attribute__((ext_vector_type(4))) float;
#define DEVI __device__ __forceinline__
#define TIDX ((int)(threadIdx.x & 255))
#define HF ((int)(threadIdx.x >> 8))

constexpr int GSTAGE_BYTES = 2 * 128 * 72 * 2;
constexpr int T_TOK = 32768;
constexpr int SEQ = 16384;
constexpr int HALF_SMEM = 2 * GSTAGE_BYTES + 4096 + 512;
constexpr int SMEM_BYTES = 2 * HALF_SMEM;
constexpr int SMEM_UNUSED_ = 0;

struct Params {
  const float *x, *ln_even, *w_in, *gm_norm, *gm_ws, *gm_b, *w_out, *ln_odd, *mu, *wr, *wk, *wv, *wg, *w0, *w1, *w2,
      *a0, *a1, *a2, *k_k, *k_a, *r_k, *lnw, *lnb, *wo, *fnorm;
  float* out;
  bfu *WT_in, *WT_out, *WT_3, *WT_o, *W2T, *A2T;
  bfu *H, *U, *GVT, *Q, *K, *VT, *SZ, *Y, *R, *K1, *V1, *SG, *EW, *AA, *YS, *TW, *TA, *GT, *MRT;
  float *G15, *COEF;
};

DEVI float bf2f(unsigned b) { return __uint_as_float(b << 16); }
DEVI unsigned f2bf(float x) {
  const __bf16 h = (__bf16)x;
  return (unsigned)__builtin_bit_cast(unsigned short, h);
}
typedef __bf16 bf16x2_t __attribute__((ext_vector_type(2)));
typedef float float2_t __attribute__((ext_vector_type(2)));
DEVI unsigned pkbf(float a, float b) {
  const float2_t f = {a, b};
  const bf16x2_t h = __builtin_convertvector(f, bf16x2_t);
  return __builtin_bit_cast(unsigned, h);
}
DEVI void unpack8(uint4 v, float* f) {
  f[0] = __uint_as_float(v.x << 16); f[1] = __uint_as_float(v.x & 0xffff0000u);
  f[2] = __uint_as_float(v.y << 16); f[3] = __uint_as_float(v.y & 0xffff0000u);
  f[4] = __uint_as_float(v.z << 16); f[5] = __uint_as_float(v.z & 0xffff0000u);
  f[6] = __uint_as_float(v.w << 16); f[7] = __uint_as_float(v.w & 0xffff0000u);
}
DEVI uint4 pack8(const float* f) {
  uint4 r;
  r.x = pkbf(f[0], f[1]);
  r.y = pkbf(f[2], f[3]);
  r.z = pkbf(f[4], f[5]);
  r.w = pkbf(f[6], f[7]);
  return r;
}
DEVI void unpack4(uint2 v, float* f) {
  f[0] = __uint_as_float(v.x << 16); f[1] = __uint_as_float(v.x & 0xffff0000u);
  f[2] = __uint_as_float(v.y << 16); f[3] = __uint_as_float(v.y & 0xffff0000u);
}
DEVI uint2 pack4(const float* f) {
  uint2 r;
  r.x = pkbf(f[0], f[1]);
  r.y = pkbf(f[2], f[3]);
  return r;
}

DEVI float sigmoid_(float x) { return 1.f / (1.f + __expf(-x)); }
DEVI float silu_(float x) { return x * sigmoid_(x); }
DEVI float tanh_(float y) { float t = __expf(2.f * y); return 1.f - 2.f / (1.f + t); }
DEVI float gelu_(float x) {
  float y = 0.7978845608028654f * (x + 0.044715f * x * x * x);
  return 0.5f * x * (1.f + tanh_(y));
}
DEVI float wave_sum(float v) {
#pragma unroll
  for (int o = 32; o > 0; o >>= 1) v += __shfl_xor(v, o);
  return v;
}
DEVI float wave_max(float v) {
#pragma unroll
  for (int o = 32; o > 0; o >>= 1) v = fmaxf(v, __shfl_xor(v, o));
  return v;
}
template <int CTRL>
DEVI float dppf(float x) {
  return __int_as_float(__builtin_amdgcn_update_dpp(0, __float_as_int(x), CTRL, 0xF, 0xF, true));
}
DEVI float reduce16(float x) {
  x += dppf<0xB1>(x);
  x += dppf<0x4E>(x);
  x += dppf<0x141>(x);
  x += dppf<0x140>(x);
  return x;
}

constexpr int LROW = 72;
constexpr int GSTAGE = 2 * 128 * LROW;

template <int DIST = 2, bool SW = true, class ALoad, class Epi>
DEVI void gemm_tile(char* smem, const ALoad& aload, const bfu* __restrict__ Bt, int ldb, int K, int m0, int n0,
                    const Epi& epi) {
  bfu* sbase = (bfu*)smem;
  const int tid = TIDX, lane = tid & 63, wid = tid >> 6, wr = wid >> 1, wc = wid & 1;
  const int fr = lane & 15, fq = lane >> 4;
  f32x4 acc[4][4];
#pragma unroll
  for (int i = 0; i < 4; ++i)
#pragma unroll
    for (int j = 0; j < 4; ++j) acc[i][j] = f32x4{0.f, 0.f, 0.f, 0.f};
  const int r0 = tid >> 3, kc = (tid & 7) * 8;
  const int nk = K >> 6;
  struct GRegs { typename ALoad::Raw a0, a1, a2, a3; uint4 ap, b0, b1, b2, b3; };
  GRegs g0, g1;
  const bfu* Bp = Bt + (size_t)(n0 + r0) * ldb + kc;
  const size_t ldb32 = (size_t)ldb * 32;
  constexpr int ARS = ALoad::kConsec ? 1 : 32;
  const int ar0 = ALoad::kConsec ? 4 * r0 : r0;
#define GEMM_ISSUE(R, KT)                                   \
  {                                                         \
    const int k0_ = ((KT) << 6);                            \
    R.ap = aload.loadprev(m0 + ar0, k0_ + kc);              \
    R.a0 = aload.load(m0 + ar0, k0_ + kc);                  \
    R.a1 = aload.load(m0 + ar0 + ARS, k0_ + kc);            \
    R.a2 = aload.load(m0 + ar0 + 2 * ARS, k0_ + kc);        \
    R.a3 = aload.load(m0 + ar0 + 3 * ARS, k0_ + kc);        \
    R.b0 = *(const uint4*)(Bp + k0_);                       \
    R.b1 = *(const uint4*)(Bp + ldb32 + k0_);               \
    R.b2 = *(const uint4*)(Bp + 2 * ldb32 + k0_);           \
    R.b3 = *(const uint4*)(Bp + 3 * ldb32 + k0_);           \
  }
#define GEMM_COMMIT(R, S, KT)                               \
  {                                                         \
    const int k1_ = ((KT) << 6) + kc;                       \
    bfu* A_ = sbase + (S) * GSTAGE + ar0 * LROW + kc;       \
    bfu* B_ = sbase + (S) * GSTAGE + 128 * LROW + r0 * LROW + kc;   \
    *(uint4*)(A_) = aload.finish(R.a0, R.ap, m0 + ar0, k1_);                                 \
    *(uint4*)(A_ + ARS * LROW) = aload.finish(R.a1, aload.asprev(R.a0), m0 + ar0 + ARS, k1_);          \
    *(uint4*)(A_ + 2 * ARS * LROW) = aload.finish(R.a2, aload.asprev(R.a1), m0 + ar0 + 2 * ARS, k1_);  \
    *(uint4*)(A_ + 3 * ARS * LROW) = aload.finish(R.a3, aload.asprev(R.a2), m0 + ar0 + 3 * ARS, k1_);  \
    *(uint4*)(B_) = R.b0;                                   \
    *(uint4*)(B_ + 32 * LROW) = R.b1;                       \
    *(uint4*)(B_ + 64 * LROW) = R.b2;                       \
    *(uint4*)(B_ + 96 * LROW) = R.b3;                       \
  }
#define GEMM_COMPUTE(S)                                                                          \
  {                                                                                              \
    const bfu* cA = sbase + (S) * GSTAGE;                                                        \
    const bfu* cB = cA + 128 * LROW;                                                             \
    _Pragma("unroll") for (int ks = 0; ks < 2; ++ks) {                                           \
      bf16x8 af[4], bfv[4];                                                                      \
      _Pragma("unroll") for (int i = 0; i < 4; ++i) {                                            \
        af[i] = *(const bf16x8*)(cA + (wr * 64 + i * 16 + fr) * LROW + ks * 32 + fq * 8);        \
        bfv[i] = *(const bf16x8*)(cB + (wc * 64 + i * 16 + fr) * LROW + ks * 32 + fq * 8);       \
      }                                                                                          \
      _Pragma("unroll") for (int i = 0; i < 4; ++i) _Pragma("unroll") for (int j = 0; j < 4; ++j) \
          acc[i][j] = SW ? __builtin_amdgcn_mfma_f32_16x16x32_bf16(bfv[j], af[i], acc[i][j], 0, 0, 0)     \
                         : __builtin_amdgcn_mfma_f32_16x16x32_bf16(af[i], bfv[j], acc[i][j], 0, 0, 0);    \
    }                                                                                            \
  }
  const int nkm1 = nk - 1;
  if (DIST == 2) {
    GEMM_ISSUE(g0, 0);
    GEMM_ISSUE(g1, (1 < nkm1 ? 1 : nkm1));
    GEMM_COMMIT(g0, 0, 0);
    GEMM_ISSUE(g0, (2 < nkm1 ? 2 : nkm1));
    __syncthreads();
    if (nk == 1) {
      GEMM_COMPUTE(0);
      __syncthreads();
    } else {
      for (int kt = 0; kt < nk; kt += 2) {
        GEMM_COMMIT(g1, 1, (kt + 1 < nkm1 ? kt + 1 : nkm1));
        GEMM_ISSUE(g1, (kt + 3 < nkm1 ? kt + 3 : nkm1));
        GEMM_COMPUTE(0);
        __syncthreads();
        GEMM_COMMIT(g0, 0, (kt + 2 < nkm1 ? kt + 2 : nkm1));
        GEMM_ISSUE(g0, (kt + 4 < nkm1 ? kt + 4 : nkm1));
        GEMM_COMPUTE(1);
        __syncthreads();
      }
    }
  } else {
    GEMM_ISSUE(g0, 0);
    GEMM_COMMIT(g0, 0, 0);
    GEMM_ISSUE(g0, (1 < nkm1 ? 1 : nkm1));
    __syncthreads();
    for (int kt = 0; kt < nk; kt += 2) {
      GEMM_COMMIT(g0, 1, (kt + 1 < nkm1 ? kt + 1 : nkm1));
      GEMM_ISSUE(g0, (kt + 2 < nkm1 ? kt + 2 : nkm1));
      GEMM_COMPUTE(0);
      __syncthreads();
      GEMM_COMMIT(g0, 0, (kt + 2 < nkm1 ? kt + 2 : nkm1));
      GEMM_ISSUE(g0, (kt + 3 < nkm1 ? kt + 3 : nkm1));
      GEMM_COMPUTE(1);
      __syncthreads();
    }
  }
#pragma unroll
  for (int i = 0; i < 4; ++i)
#pragma unroll
    for (int j = 0; j < 4; ++j) {
      if (SW) epi(m0 + wr * 64 + i * 16 + fr, n0 + wc * 64 + j * 16 + fq * 4, acc[i][j]);
      else epi(m0 + wr * 64 + i * 16 + fq * 4, n0 + wc * 64 + j * 16 + fr, acc[i][j]);
    }
}

namespace pg8 {
#define PG8_LAS __attribute__((address_space(3)))
typedef unsigned short bf16_t;
typedef short bf16x8 __attribute__((ext_vector_type(8)));
typedef float f32x4 __attribute__((ext_vector_type(4)));
typedef unsigned u32x4 __attribute__((ext_vector_type(4)));
constexpr int BM = 256, BK = 64, HALF = 128, HTB = HALF * BK * 2  , STAGE_BYTES = 8 * HTB, NXCD = 8, WGM = 8;

__host__ __device__ __forceinline__ int lds_byte(int r, int c) { const int st = (r >> 4) * 2 + (c >> 5), rr = r & 15, cc = c & 31, ob = rr * 64 + cc * 2; return st * 1024 + (ob ^ (((ob >> 9) & 1) << 5)); }
__host__ __device__ __forceinline__ void stage_rc(int b, int& R, int& C) { const int st = b / 1024, sb = b % 1024, swz = sb ^ (((sb >> 9) & 1) << 5); R = (st >> 1) * 16 + swz / 64; C = (st & 1) * 32 + (swz % 64) / 2; }
__host__ __device__ __forceinline__ int perm32(int rho) { const int n = rho >> 4, i = rho & 15; return 8 * (i >> 2) + 4 * n + (i & 3); }

struct Unit { int pm, pn; };
struct Gemm { const bf16_t* A; const bf16_t* Bt; int M, N, K; };

struct StaticOrder {
    int nM, nN, nwg, G, c;
    __host__ __device__ void init(int M, int N, int G_, int c_) { nM = M / BM; nN = N / BM; nwg = nM * nN; G = G_; c = c_; }
    __host__ __device__ bool next(int i, Unit& u) const {
        const long L = (long)i * G + c; if (L >= nwg) return false;
        int wgid = (int)L; { const int q = nwg / NXCD, r = nwg % NXCD, xcd = wgid % NXCD, off = wgid / NXCD; wgid = (xcd < r ? xcd * (q + 1) : r * (q + 1) + (xcd - r) * q) + off; }
        const int nig = WGM * nN, gid = wgid / nig, fm = gid * WGM, gsz = (nM - fm) < WGM ? (nM - fm) : WGM;
        u.pm = fm + ((wgid % nig) % gsz); u.pn = (wgid % nig) / gsz; return true;
    }
    __device__ __forceinline__ void a_ready(const Unit&) const {}
    __device__ __forceinline__ void done(const Unit&) const {}
};
struct CountedOrder : StaticOrder {
    const unsigned* ready; unsigned need; unsigned* tmo;
    __device__ __forceinline__ void a_ready(const Unit& u) const {
        if (threadIdx.x < 64) {
            const unsigned long long t0 = __builtin_amdgcn_s_memrealtime(); unsigned polls = 0;
            while ((unsigned)__builtin_amdgcn_readfirstlane(__hip_atomic_load(ready + 64 * u.pm, __ATOMIC_RELAXED, __HIP_MEMORY_SCOPE_AGENT)) < need) {
                if ((++polls & 255u) == 0u && __builtin_amdgcn_readfirstlane(__hip_atomic_load(tmo, __ATOMIC_RELAXED, __HIP_MEMORY_SCOPE_AGENT)) != 0u) break;
                if (__builtin_amdgcn_s_memrealtime() - t0 > 2000000ull) {
                    if (threadIdx.x == 0) { unsigned expect = 0u; __hip_atomic_compare_exchange_strong(tmo + 1, &expect, 0x600u | (unsigned)(u.pm & 0xff), __ATOMIC_RELAXED, __ATOMIC_RELAXED, __HIP_MEMORY_SCOPE_AGENT); __hip_atomic_store(tmo, 1u, __ATOMIC_RELAXED, __HIP_MEMORY_SCOPE_AGENT); }
                    break; }
                __builtin_amdgcn_s_sleep(2); }
            __builtin_amdgcn_fence(__ATOMIC_ACQUIRE, "agent");
            asm volatile("s_waitcnt vmcnt(0)" ::: "memory");
        }
#if !defined(BROKEN_HOOK_NO_BARRIER)
        asm volatile("" ::: "memory"); __builtin_amdgcn_s_barrier(); asm volatile("" ::: "memory");
#endif
    }
};

__device__ __forceinline__ unsigned cvt_pk_bf16(float lo, float hi) { unsigned r; asm volatile("v_cvt_pk_bf16_f32 %0, %1, %2" : "=v"(r) : "v"(lo), "v"(hi)); return r; }
typedef float f32x2 __attribute__((ext_vector_type(2)));
__device__ __forceinline__ f32x2 gelu_pk(f32x2 v) {
    const f32x2 av = __builtin_elementwise_abs(v), d = av * 0.2316418882f + 1.0f;
    f32x2 t; t.x = __builtin_amdgcn_rcpf(d.x); t.y = __builtin_amdgcn_rcpf(d.y);
    f32x2 q = t * 0.5307027145f + (-0.7265760135f); q = q * t + 0.7107068705f; q = q * t + (-0.142248368f); q = q * t + 0.127414796f; q = q * t;
    const f32x2 s = (v * v) * (-0.72134752044f);
    f32x2 e; e.x = __builtin_amdgcn_exp2f(s.x); e.y = __builtin_amdgcn_exp2f(s.y);
    const f32x2 m = v * (q * e), r = v - m;
    f32x2 o; o.x = v.x < 0.f ? m.x : r.x; o.y = v.y < 0.f ? m.y : r.y; return o;
}

struct EpiF32 {
    static constexpr bool PERM = false, AFTER_DRAIN = false;
    float* C; int ldc; const float* bias;
    __device__ __forceinline__ void operator()(const f32x4 (&acc)[2][2][4][2], const Unit& u, int wr, int wc, int fr, int fq) const {
        const int row0 = u.pm * BM + wr * 64 + fr, col0 = u.pn * BM + wc * 32 + 4 * fq;
        f32x4 bv[2][2];
#pragma unroll
        for (int bj = 0; bj < 2; ++bj)
#pragma unroll
            for (int n = 0; n < 2; ++n) bv[bj][n] = bias ? *(const f32x4*)(bias + col0 + bj * HALF + n * 16) : (f32x4){0.f, 0.f, 0.f, 0.f};
#pragma unroll
        for (int ai = 0; ai < 2; ++ai)
#pragma unroll
            for (int m = 0; m < 4; ++m) { float* rowp = C + (size_t)(row0 + ai * HALF + m * 16) * ldc + col0;
#pragma unroll
                for (int bj = 0; bj < 2; ++bj)
#pragma unroll
                    for (int n = 0; n < 2; ++n) *(f32x4*)(rowp + bj * HALF + n * 16) = acc[ai][bj][m][n] + bv[bj][n]; }
    }
};
template <int ACT  > struct EpiBf16 {
    static constexpr bool PERM = true, AFTER_DRAIN = false;
    bf16_t* O; int ldc; const float* bias; int split_cols; size_t split_stride;
    __device__ __forceinline__ void operator()(const f32x4 (&acc)[2][2][4][2], const Unit& u, int wr, int wc, int fr, int fq) const {
        const int row0 = u.pm * BM + wr * 64 + fr; int colt = u.pn * BM; bf16_t* base = O;
        if (split_cols) { const int t = colt / split_cols; base += (size_t)t * split_stride; colt -= t * split_cols; }
        const int col0 = colt + wc * 32 + 8 * fq, bcol0 = u.pn * BM + wc * 32 + 8 * fq;
        f32x4 bv[2][2];
#pragma unroll
        for (int bj = 0; bj < 2; ++bj)
#pragma unroll
            for (int n = 0; n < 2; ++n) bv[bj][n] = bias ? *(const f32x4*)(bias + bcol0 + bj * HALF + 4 * n) : (f32x4){0.f, 0.f, 0.f, 0.f};
#pragma unroll
        for (int ai = 0; ai < 2; ++ai)
#pragma unroll
            for (int m = 0; m < 4; ++m) { bf16_t* rowp = base + (size_t)(row0 + ai * HALF + m * 16) * ldc + col0;
#pragma unroll
                for (int bj = 0; bj < 2; ++bj) { f32x4 v0 = acc[ai][bj][m][0] + bv[bj][0], v1 = acc[ai][bj][m][1] + bv[bj][1];
                    if (ACT == 1) { f32x2 a = gelu_pk((f32x2){v0[0], v0[1]}), b = gelu_pk((f32x2){v0[2], v0[3]}), c = gelu_pk((f32x2){v1[0], v1[1]}), d = gelu_pk((f32x2){v1[2], v1[3]});
                        v0 = (f32x4){a.x, a.y, b.x, b.y}; v1 = (f32x4){c.x, c.y, d.x, d.y}; }
                    if (ACT == 2) {
#pragma unroll
                        for (int j = 0; j < 4; ++j) { v0[j] = 0.5f * v0[j] * (1.0f + erff(v0[j] * 0.70710678f)); v1[j] = 0.5f * v1[j] * (1.0f + erff(v1[j] * 0.70710678f)); } }
                    u32x4 w; w.x = cvt_pk_bf16(v0[0], v0[1]); w.y = cvt_pk_bf16(v0[2], v0[3]); w.z = cvt_pk_bf16(v1[0], v1[1]); w.w = cvt_pk_bf16(v1[2], v1[3]);
                    *(u32x4*)(rowp + bj * HALF) = w; } }
    }
};


template <class Epi, class Sched, bool STAMP = false>
__device__ __forceinline__ void gemm_phase(PG8_LAS unsigned char* lds, const Gemm g, const Sched& S, const Epi& E, unsigned long long* stamps) {
    const int tid = threadIdx.x, wid = __builtin_amdgcn_readfirstlane(tid >> 6), lane = tid & 63, wr = wid >> 2, wc = wid & 3, fr = lane & 15, fq = lane >> 4;
    const int K = g.K, nt = K / BK;
    int ts_lo = 0, ts_hi = 0, nts = 0; const unsigned long long rt_entry = STAMP ? (unsigned long long)wall_clock64() : 0ull;
#define PG8_STAMP() do { if (STAMP && wid == 0 && nts < 64) { const unsigned long long _c = (unsigned long long)clock64(); \
        ts_lo = (lane == nts) ? (int)(unsigned)_c : ts_lo; ts_hi = (lane == nts) ? (int)(unsigned)(_c >> 32) : ts_hi; ++nts; } } while (0)
    PG8_STAMP();
    unsigned voffA[2], voffB[2];
#pragma unroll
    for (int i = 0; i < 2; ++i) { int R, C; stage_rc(tid * 16 + i * 8192, R, C); const int Rb = Epi::PERM ? ((R & ~31) + perm32(R & 31)) : R;
        voffA[i] = (unsigned)(R * K + C) * 2u; voffB[i] = (unsigned)(Rb * K + C) * 2u; }
    const size_t kstep = (size_t)(BK * 2);
    const size_t hstep = (size_t)HALF * K * 2;
    const size_t tstep = 2 * hstep;
    const unsigned ldsw = (unsigned)wid * 1024u;
    const int aoff = lds_byte(wr * 64 + fr, fq * 8), boff = lds_byte(wc * 32 + fr, fq * 8);
#define PG8_SA(b, h) (((b) * 2 + (h)) * HTB)
#define PG8_SB(b, h) ((4 + (b) * 2 + (h)) * HTB)
#define PG8_STAGE(bufoff, gbase, voff) do { _Pragma("unroll") for (int _i = 0; _i < 2; ++_i) \
        __builtin_amdgcn_global_load_lds((const unsigned*)((const char*)(gbase) + (voff)[_i]), (PG8_LAS unsigned*)(lds + (bufoff) + ldsw + _i * 8192), 16, 0, 0); } while (0)
#define PG8_LDA(dst, b, h) do { _Pragma("unroll") for (int m = 0; m < 4; ++m) _Pragma("unroll") for (int k = 0; k < 2; ++k) dst[m][k] = *(const PG8_LAS bf16x8*)(lds + PG8_SA(b, h) + aoff + m * 2048 + k * 1024); } while (0)
#define PG8_LDB(dst, b, h) do { _Pragma("unroll") for (int n = 0; n < 2; ++n) _Pragma("unroll") for (int k = 0; k < 2; ++k) dst[n][k] = *(const PG8_LAS bf16x8*)(lds + PG8_SB(b, h) + boff + n * 2048 + k * 1024); } while (0)
#define PG8_MMA(ai, bj, At, Bt) do { __builtin_amdgcn_s_setprio(1); _Pragma("unroll") for (int m = 0; m < 4; ++m) _Pragma("unroll") for (int n = 0; n < 2; ++n) _Pragma("unroll") for (int k = 0; k < 2; ++k) \
        acc[ai][bj][m][n] = __builtin_amdgcn_mfma_f32_16x16x32_bf16(Bt[n][k], At[m][k], acc[ai][bj][m][n], 0, 0, 0); __builtin_amdgcn_s_setprio(0); } while (0)
#define PG8_WAIT_V(n) asm volatile("s_waitcnt vmcnt(" #n ")" ::: "memory")
#define PG8_WAIT_L(n) asm volatile("s_waitcnt lgkmcnt(" #n ")" ::: "memory")
#define PG8_BAR __builtin_amdgcn_s_barrier()
#define PG8_SCHED __builtin_amdgcn_sched_barrier(0)
    Unit cur, nxt; int ui = 0;
    if (!S.next(0, cur)) return;
    f32x4 acc[2][2][4][2];
#pragma unroll
    for (int a = 0; a < 2; ++a)
#pragma unroll
        for (int b = 0; b < 2; ++b)
#pragma unroll
            for (int m = 0; m < 4; ++m)
#pragma unroll
                for (int n = 0; n < 2; ++n) acc[a][b][m][n] = (f32x4){0.f, 0.f, 0.f, 0.f};
    bf16x8 At[4][2], B0[2][2], B1[2][2];
    const char* cA = (const char*)g.A + (size_t)cur.pm * tstep; const char* cB = (const char*)g.Bt + (size_t)cur.pn * tstep;
    S.a_ready(cur);
    PG8_STAGE(PG8_SB(0, 0), cB, voffB); PG8_STAGE(PG8_SA(0, 0), cA, voffA); PG8_STAGE(PG8_SB(0, 1), cB + hstep, voffB); PG8_STAGE(PG8_SA(0, 1), cA + hstep, voffA);
    if (wr == 1) PG8_BAR;
    PG8_WAIT_V(4); PG8_BAR;
    PG8_STAGE(PG8_SB(1, 0), cB + kstep, voffB); PG8_STAGE(PG8_SA(1, 0), cA + kstep, voffA); PG8_STAGE(PG8_SB(1, 1), cB + hstep + kstep, voffB);
    PG8_WAIT_V(6); PG8_BAR;
    PG8_STAMP();
    for (;;) {
        const bool has_next = S.next(ui + 1, nxt);
        const char* nA = has_next ? (const char*)g.A + (size_t)nxt.pm * tstep : cA; const char* nB = has_next ? (const char*)g.Bt + (size_t)nxt.pn * tstep : cB;
        for (int t = 0; t < nt; t += 2) {
            const bool last = (t == nt - 2);
            const char* a1 = cA + (size_t)(t + 1) * kstep;
            const char* a2 = last ? nA : cA + (size_t)(t + 2) * kstep; const char* b2 = last ? nB : cB + (size_t)(t + 2) * kstep;
            const char* a3 = a2 + kstep; const char* b3 = b2 + kstep;
            if (last && has_next) S.a_ready(nxt);
            PG8_LDB(B0, 0, 0); PG8_SCHED; PG8_LDA(At, 0, 0); PG8_STAGE(PG8_SA(1, 1), a1 + hstep, voffA);
            PG8_WAIT_L(8); PG8_BAR; PG8_WAIT_L(0); PG8_MMA(0, 0, At, B0); PG8_BAR; PG8_SCHED;
            PG8_LDB(B1, 0, 1); PG8_STAGE(PG8_SB(0, 0), b2, voffB);
            PG8_BAR; PG8_WAIT_L(0); PG8_MMA(0, 1, At, B1); PG8_BAR;
            PG8_LDA(At, 0, 1); PG8_STAGE(PG8_SA(0, 0), a2, voffA);
            PG8_BAR; PG8_WAIT_L(0); PG8_MMA(1, 0, At, B0); PG8_BAR; PG8_SCHED;
            PG8_STAGE(PG8_SB(0, 1), b2 + hstep, voffB);
            PG8_WAIT_V(6); PG8_BAR; PG8_MMA(1, 1, At, B1); PG8_BAR;
            PG8_LDB(B0, 1, 0); PG8_SCHED; PG8_LDA(At, 1, 0); PG8_STAGE(PG8_SA(0, 1), a2 + hstep, voffA);
            PG8_WAIT_L(8); PG8_BAR; PG8_WAIT_L(0); PG8_MMA(0, 0, At, B0); PG8_BAR; PG8_SCHED;
            PG8_LDB(B1, 1, 1); PG8_STAGE(PG8_SB(1, 0), b3, voffB);
            PG8_BAR; PG8_WAIT_L(0); PG8_MMA(0, 1, At, B1); PG8_BAR;
            PG8_LDA(At, 1, 1); PG8_STAGE(PG8_SA(1, 0), a3, voffA);
            PG8_BAR; PG8_WAIT_L(0); PG8_MMA(1, 0, At, B0); PG8_BAR; PG8_SCHED;
            PG8_STAGE(PG8_SB(1, 1), b3 + hstep, voffB);
            PG8_WAIT_V(6); PG8_BAR; PG8_MMA(1, 1, At, B1); PG8_BAR;
        }
        PG8_STAMP();
        if constexpr (!Epi::AFTER_DRAIN) { E(acc, cur, wr, wc, fr, fq); S.done(cur); }
        PG8_STAMP();
        if (!has_next) break;
#pragma unroll
        for (int a = 0; a < 2; ++a)
#pragma unroll
            for (int b = 0; b < 2; ++b)
#pragma unroll
                for (int m = 0; m < 4; ++m)
#pragma unroll
                    for (int n = 0; n < 2; ++n) acc[a][b][m][n] = (f32x4){0.f, 0.f, 0.f, 0.f};
        cur = nxt; cA = nA; cB = nB; ++ui;
    }
    PG8_WAIT_V(0);
    if (wr == 0) PG8_BAR;
    PG8_BAR;
    if constexpr (Epi::AFTER_DRAIN) { E.fused(acc, cur, wr, wc, fr, fq, lds, wid, lane); S.done(cur); }
    PG8_STAMP();
    if (STAMP && wid == 0) { stamps[lane] = lane < nts ? (((unsigned long long)(unsigned)ts_hi << 32) | (unsigned)ts_lo) : 0ull;
        if (lane == 62) stamps[62] = rt_entry; if (lane == 63) stamps[63] = (unsigned long long)wall_clock64(); }
#undef PG8_STAMP
#undef PG8_SA
#undef PG8_SB
#undef PG8_STAGE
#undef PG8_LDA
#undef PG8_LDB
#undef PG8_MMA
#undef PG8_WAIT_V
#undef PG8_WAIT_L
#undef PG8_BAR
#undef PG8_SCHED
}
}

struct TileSched {
  int xcd, local, vbid, vnb, MT, NT, SM, SN, j, snc;
  bool swz;
  DEVI TileSched(int bid, int nb, int half, int MT_, int NT_, int SM_, int SN_) : MT(MT_), NT(NT_), SM(SM_), SN(SN_), j(0) {
    xcd = bid & 7;
    local = (bid >> 3) * 2 + half;
    vbid = bid * 2 + half;
    vnb = nb * 2;
    swz = (vnb == 8 * SM * SN) && ((nb & 7) == 0);
    snc = (NT + SN - 1) / SN;
  }
  DEVI int next(int& mt, int& nt) {
    if (swz) {
      const int s = j * 8 + xcd;
      ++j;
      const int sm = s / snc, sn = s - sm * snc;
      if (sm * SM >= MT) return 0;
      mt = sm * SM + local / SN;
      nt = sn * SN + local % SN;
      return (mt < MT && nt < NT) ? 1 : 2;
    } else {
      const int it = vbid + j * vnb;
      ++j;
      if (it >= MT * NT) return 0;
      mt = it / NT;
      nt = it - mt * NT;
      return 1;
    }
  }
};

struct ALoadPlain {
  typedef uint4 Raw;
  static constexpr bool kFat = false;
  static constexpr bool kConsec = false;
  const bfu* A;
  int lda;
  DEVI Raw load(int row, int k) const { return *(const uint4*)(A + (size_t)row * lda + k); }
  DEVI uint4 loadprev(int, int) const { return uint4{0u, 0u, 0u, 0u}; }
  DEVI uint4 asprev(const Raw&) const { return uint4{0u, 0u, 0u, 0u}; }
  DEVI uint4 finish(const Raw& r, const uint4&, int, int) const { return r; }
};

DEVI void transpose_tile(char* smem, const float* __restrict__ src, int Ns, bfu* __restrict__ dst, int ldd, int noff,
                         int k0, int n0) {
  float(*tile)[65] = (float(*)[65])smem;
  const int tid = TIDX;
  const int kr = tid >> 4, nc = (tid & 15) * 4;
#pragma unroll
  for (int p = 0; p < 4; ++p) {
    float4 v = *(const float4*)(src + (size_t)(k0 + kr + 16 * p) * Ns + n0 + nc);
    tile[kr + 16 * p][nc] = v.x;
    tile[kr + 16 * p][nc + 1] = v.y;
    tile[kr + 16 * p][nc + 2] = v.z;
    tile[kr + 16 * p][nc + 3] = v.w;
  }
  __syncthreads();
  const int nr = tid >> 3, kc = (tid & 7) * 8;
#pragma unroll
  for (int p = 0; p < 2; ++p) {
    const int n = nr + 32 * p;
    float f[8];
#pragma unroll
    for (int j = 0; j < 8; ++j) f[j] = tile[kc + j][n];
    *(uint4*)(dst + (size_t)(noff + n0 + n) * ldd + k0 + kc) = pack8(f);
  }
  __syncthreads();
}

DEVI void rms_row2_bf16(const float* __restrict__ src, const float* __restrict__ g, bfu* __restrict__ dst, int lane) {
  float4 v[2][4];
  float ss[2] = {0.f, 0.f};
#pragma unroll
  for (int r = 0; r < 2; ++r)
#pragma unroll
    for (int i = 0; i < 4; ++i) v[r][i] = *(const float4*)(src + r * 1024 + lane * 4 + 256 * i);
#pragma unroll
  for (int r = 0; r < 2; ++r)
#pragma unroll
    for (int i = 0; i < 4; ++i)
      ss[r] += v[r][i].x * v[r][i].x + v[r][i].y * v[r][i].y + v[r][i].z * v[r][i].z + v[r][i].w * v[r][i].w;
#pragma unroll
  for (int r = 0; r < 2; ++r) {
    const float rinv = rsqrtf(wave_sum(ss[r]) * (1.f / 1024.f) + 1e-6f);
#pragma unroll
    for (int i = 0; i < 4; ++i) {
      const float4 gg = *(const float4*)(g + lane * 4 + 256 * i);
      uint2 o;
      o.x = pkbf(v[r][i].x * rinv * gg.x, v[r][i].y * rinv * gg.y);
      o.y = pkbf(v[r][i].z * rinv * gg.z, v[r][i].w * rinv * gg.w);
      *(uint2*)(dst + r * 1024 + lane * 4 + 256 * i) = o;
    }
  }
}

DEVI void phase0(const Params& p, char* smem, int bid, int nb) {
  constexpr int NT_IN = 16 * 56, NT_SQ = 256, NT_SM = 16;
  constexpr int c0 = NT_IN, c1 = c0 + NT_SQ, c2 = c1 + 4 * NT_SQ, c3 = c2 + NT_SM, c4 = c3 + NT_SM, c5 = c4 + NT_SQ,
                c6 = c5 + NT_SM, c7 = c6 + NT_SM, c8 = c7 + 2, c9 = c8 + T_TOK / 8;
  smem += HF * HALF_SMEM;
  for (int it = bid * 2 + HF; it < c9; it += nb * 2) {
    if (it < c0) {
      transpose_tile(smem, p.w_in, 3584, p.WT_in, 1024, 0, (it / 56) * 64, (it % 56) * 64);
    } else if (it < c1) {
      int j = it - c0;
      transpose_tile(smem, p.w_out, 1024, p.WT_out, 1024, 0, (j >> 4) * 64, (j & 15) * 64);
    } else if (it < c2) {
      int j = it - c1;
      int w = j >> 8;
      j &= 255;
      const float* src = (w == 0) ? p.wr : (w == 1) ? p.wk : (w == 2) ? p.wv : p.wg;
      transpose_tile(smem, src, 1024, p.WT_3, 1024, w * 1024, (j >> 4) * 64, (j & 15) * 64);
    } else if (it < c3) {
      int j = it - c2;
      transpose_tile(smem, p.w1, 64, p.WT_3, 1024, 4096, j * 64, 0);
    } else if (it < c4) {
      int j = it - c3;
      transpose_tile(smem, p.a1, 64, p.WT_3, 1024, 4224, j * 64, 0);
    } else if (it < c5) {
      int j = it - c4;
      transpose_tile(smem, p.wo, 1024, p.WT_o, 1024, 0, (j >> 4) * 64, (j & 15) * 64);
    } else if (it < c6) {
      int j = it - c5;
      transpose_tile(smem, p.w2, 1024, p.W2T, 64, 0, 0, j * 64);
    } else if (it < c7) {
      int j = it - c6;
      transpose_tile(smem, p.a2, 1024, p.A2T, 64, 0, 0, j * 64);
    } else if (it < c8) {
      int j = it - c7;
      bfu* dst = p.WT_3 + (size_t)(j == 0 ? 4160 : 4288) * 1024;
      for (int e = TIDX; e < 64 * 1024 / 8; e += 256) *(uint4*)(dst + e * 8) = uint4{0, 0, 0, 0};
    } else {
      int row = (it - c8) * 8 + (TIDX >> 6) * 2;
      rms_row2_bf16(p.x + (size_t)row * 1024, p.ln_even, p.H + (size_t)row * 1024, TIDX & 63);
    }
  }
}

struct PgEpi1 {
  static constexpr bool PERM = true, AFTER_DRAIN = false;
  const Params* p;
  DEVI void operator()(const pg8::f32x4 (&acc)[2][2][4][2], const pg8::Unit& u, int wr, int wc, int fr, int fq) const {
    const int row0 = u.pm * 256 + wr * 64 + fr;
    const int seg = u.pn;
#pragma unroll
    for (int ai = 0; ai < 2; ++ai)
#pragma unroll
      for (int m = 0; m < 4; ++m) {
        const int row = row0 + ai * 128 + m * 16;
#pragma unroll
        for (int bj = 0; bj < 2; ++bj) {
          const int col = u.pn * 256 + bj * 128 + wc * 32 + 8 * fq;
          const f32x4 v0 = acc[ai][bj][m][0], v1 = acc[ai][bj][m][1];
          if (seg < 2) {
            uint4 w;
            w.x = pkbf(gelu_(v0[0]), gelu_(v0[1])); w.y = pkbf(gelu_(v0[2]), gelu_(v0[3]));
            w.z = pkbf(gelu_(v1[0]), gelu_(v1[1])); w.w = pkbf(gelu_(v1[2]), gelu_(v1[3]));
            *(uint4*)(p->U + (size_t)row * 512 + col) = w;
          } else if (seg < 4) {
            const int g = (col - 512) >> 7, c0 = col & 127, chunk = row >> 7, s = row & 127;
            bfu* base = p->GVT + ((size_t)((chunk * 4 + g) * 128 + c0)) * 128 + s;
#pragma unroll
            for (int e = 0; e < 4; ++e) {
              base[(size_t)e * 128] = (bfu)f2bf(gelu_(v0[e]));
              base[(size_t)(e + 4) * 128] = (bfu)f2bf(gelu_(v1[e]));
            }
          } else if (seg < 8) {
            uint4 w;
            w.x = pkbf(v0[0], v0[1]); w.y = pkbf(v0[2], v0[3]); w.z = pkbf(v1[0], v1[1]); w.w = pkbf(v1[2], v1[3]);
            bfu* dst = (seg < 6) ? p->Q + (size_t)row * 512 + (col - 1024) : p->K + (size_t)row * 512 + (col - 1536);
            *(uint4*)dst = w;
          } else if (seg < 10) {
            const int cc = col - 2048, hh = cc >> 6, dim0 = cc & 63;
            const int b = row >> 14, s = row & (SEQ - 1);
            bfu* base = p->VT + ((size_t)((b * 8 + hh) * 64 + dim0)) * SEQ;
            const size_t PST = (size_t)16 * 64 * SEQ;
            const int o1 = (s & 3) * (SEQ / 4) + (s >> 2), o2 = (s & 15) * (SEQ / 16) + (s >> 4);
#pragma unroll
            for (int e = 0; e < 8; ++e) {
              const bfu val = (bfu)f2bf(e < 4 ? v0[e & 3] : v1[e & 3]);
              bfu* bd = base + (size_t)e * SEQ;
              bd[s] = val;
              bd[PST + o1] = val;
              bd[2 * PST + o2] = val;
            }
          } else {
            uint4 w;
            w.x = pkbf(silu_(v0[0]), silu_(v0[1])); w.y = pkbf(silu_(v0[2]), silu_(v0[3]));
            w.z = pkbf(silu_(v1[0]), silu_(v1[1])); w.w = pkbf(silu_(v1[2]), silu_(v1[3]));
            *(uint4*)(p->SZ + (size_t)row * 1024 + (col - 2560)) = w;
          }
        }
      }
  }
};
struct PgEpiRes {
  static constexpr bool PERM = false, AFTER_DRAIN = false;
  const float* base;
  float* out;
  DEVI void operator()(const pg8::f32x4 (&acc)[2][2][4][2], const pg8::Unit& u, int wr, int wc, int fr, int fq) const {
    const int row0 = u.pm * 256 + wr * 64 + fr, col0 = u.pn * 256 + wc * 32 + 4 * fq;
#pragma unroll
    for (int ai = 0; ai < 2; ++ai)
#pragma unroll
      for (int m = 0; m < 4; ++m) {
        const size_t rb = (size_t)(row0 + ai * 128 + m * 16) * 1024 + col0;
#pragma unroll
        for (int bj = 0; bj < 2; ++bj)
#pragma unroll
          for (int n = 0; n < 2; ++n) {
            const size_t idx = rb + bj * 128 + n * 16;
            const f32x4 b = *(const f32x4*)(base + idx);
            *(f32x4*)(out + idx) = acc[ai][bj][m][n] + b;
          }
      }
  }
};
template <class Epi>
DEVI void pg_gemm(char* smem, const bfu* A, const bfu* Bt, int M, int N, int K, const Epi& E, int bid, int nb) {
  pg8::Gemm g{A, Bt, M, N, K};
  pg8::StaticOrder S;
  S.init(M, N, nb, bid);
  pg8::gemm_phase<Epi, pg8::StaticOrder, false>((PG8_LAS unsigned char*)smem, g, S, E, nullptr);
}

DEVI void phase1(const Params& p, char* smem, int bid, int nb) {
  PgEpi1 E{&p};
  pg_gemm(smem, p.H, p.WT_in, T_TOK, 3584, 1024, E, bid, nb);
}

struct ALoadWs {
  struct Raw { float4 a, b; };
  static constexpr bool kFat = true;
  static constexpr bool kConsec = false;
  const float* ws;
  const float* rinv;
  DEVI Raw load(int t, int s0) const {
    Raw r;
    r.a = *(const float4*)(ws + t * 128 + s0);
    r.b = *(const float4*)(ws + t * 128 + s0 + 4);
    return r;
  }
  DEVI uint4 loadprev(int, int) const { return uint4{0u, 0u, 0u, 0u}; }
  DEVI uint4 asprev(const Raw&) const { return uint4{0u, 0u, 0u, 0u}; }
  DEVI uint4 finish(const Raw& r, const uint4&, int t, int s0) const {
    float f[8] = {r.a.x, r.a.y, r.a.z, r.a.w, r.b.x, r.b.y, r.b.z, r.b.w};
#pragma unroll
    for (int j = 0; j < 8; ++j) f[j] = (s0 + j <= t) ? f[j] * rinv[s0 + j] : 0.f;
    return pack8(f);
  }
};
struct EpiGm {
  const Params* p;
  int chunk, g;
  DEVI void operator()(int t, int c, f32x4 v) const {
    const float4 gn = *(const float4*)(p->gm_norm + g * 128 + c);
    const float bias = p->gm_b[g * 128 + t];
    const size_t tok = (size_t)chunk * 128 + t;
    float u[4], sz[4];
    unpack4(*(const uint2*)(p->U + tok * 512 + g * 128 + c), u);
    unpack4(*(const uint2*)(p->SZ + tok * 1024 + g * 128 + c), sz);
    uint2 o;
    o.x = pkbf(u[0] * (v[0] * gn.x + bias) * sz[0], u[1] * (v[1] * gn.y + bias) * sz[1]);
    o.y = pkbf(u[2] * (v[2] * gn.z + bias) * sz[2], u[3] * (v[3] * gn.w + bias) * sz[3]);
    *(uint2*)(p->Y + tok * 1024 + g * 128 + c) = o;
  }
};

DEVI void gmlp_item(const Params& p, char* smem, int item) {
  const int chunk = item >> 2, g = item & 3;
  const bfu* gv = p.GVT + (size_t)item * 128 * 128;
  float* rinv = (float*)(smem + 2 * GSTAGE_BYTES);
  const int tid = TIDX;
  {
    float* sred = rinv + 128;
    const int s4 = (tid & 31) * 4, cg = tid >> 5;
    uint2 raw[16];
#pragma unroll
    for (int i = 0; i < 16; ++i) raw[i] = *(const uint2*)(gv + (cg * 16 + i) * 128 + s4);
    float ss[4] = {0.f, 0.f, 0.f, 0.f};
#pragma unroll
    for (int i = 0; i < 16; ++i) {
      float f[4];
      unpack4(raw[i], f);
#pragma unroll
      for (int j = 0; j < 4; ++j) ss[j] += f[j] * f[j];
    }
    *(float4*)(sred + cg * 128 + s4) = float4{ss[0], ss[1], ss[2], ss[3]};
    __syncthreads();
    if (tid < 128) {
      float t = 0.f;
#pragma unroll
      for (int i = 0; i < 8; ++i) t += sred[i * 128 + tid];
      rinv[tid] = rsqrtf(t * (1.f / 128.f) + 1e-6f);
    }
  }
  __syncthreads();
  ALoadWs al{p.gm_ws + (size_t)g * 128 * 128, rinv};
  EpiGm epi{&p, chunk, g};
  gemm_tile(smem, al, gv, 128, 128, 0, 0, epi);
}

DEVI void attn_item(const Params& p, char* smem, int item) {
  const int qb = item & 63, bh = item >> 6, b = bh >> 3, h = bh & 7;
  const int q0 = qb * 256;
  bfu* Ob = (bfu*)smem;
  float* Mb = (float*)(smem + 32768);
  float* Lb = Mb + 256;
  const int tid = threadIdx.x, lane = tid & 63, wid = tid >> 6;
  const int qi = lane & 15, g = lane >> 4;
  const float slope = exp2f(-(float)(h + 1));
  const size_t tokb = (size_t)b * SEQ;
#pragma unroll 1
  for (int pi = 0; pi < 3; ++pi) {
    const int dshift = 2 * pi, d = 1 << dshift;
    const bfu* VT = p.VT + (size_t)pi * ((size_t)16 * 64 * SEQ) + (size_t)bh * 64 * SEQ;
#pragma unroll 1
    for (int u = wid; u < 16; u += 8) {
      const int r = u & (d - 1), tile = u >> dshift;
      const int sq0 = (q0 >> dshift) + tile * 16;
      const int sk0 = sq0 - 144;
      const int posq = ((sq0 + qi) << dshift) + r;
      const bfu* qp = p.Q + (tokb + posq) * 512 + h * 64 + g * 8;
      const bf16x8 qf0 = *(const bf16x8*)qp, qf1 = *(const bf16x8*)(qp + 32);
      const bfu* kbase = p.K + (tokb + r) * 512 + h * 64 + g * 8;
      const bfu* vbase = VT + (size_t)qi * SEQ + r * (SEQ >> dshift);
      bf16x8 kf[2][2];
      uint2 vf[4][2];
      auto loadkv = [&](int it) {
#pragma unroll
        for (int tt = 0; tt < 2; ++tt) {
          int sk = sk0 + (2 * it + tt) * 16 + qi;
          sk = sk < 0 ? 0 : sk;
          const bfu* kp = kbase + ((size_t)sk << dshift) * 512;
          kf[tt][0] = *(const bf16x8*)kp;
          kf[tt][1] = *(const bf16x8*)(kp + 32);
        }
        int kidx0 = sk0 + 32 * it + 4 * g, kidx1 = kidx0 + 16;
        kidx0 = kidx0 < 0 ? 0 : kidx0;
        kidx1 = kidx1 < 0 ? 0 : kidx1;
#pragma unroll
        for (int m = 0; m < 4; ++m) {
          vf[m][0] = *(const uint2*)(vbase + (size_t)(16 * m) * SEQ + kidx0);
          vf[m][1] = *(const uint2*)(vbase + (size_t)(16 * m) * SEQ + kidx1);
        }
      };
      loadkv(0);
      float mrun = -1e30f, l = 0.f;
      f32x4 O[4];
#pragma unroll
      for (int m = 0; m < 4; ++m) O[m] = f32x4{0.f, 0.f, 0.f, 0.f};
#pragma unroll 1
      for (int it = 0; it < 5; ++it) {
        bf16x8 ck[2][2];
        uint2 cv[4][2];
#pragma unroll
        for (int a = 0; a < 2; ++a)
#pragma unroll
          for (int c = 0; c < 2; ++c) ck[a][c] = kf[a][c];
#pragma unroll
        for (int m = 0; m < 4; ++m) {
          cv[m][0] = vf[m][0];
          cv[m][1] = vf[m][1];
        }
        if (it < 4) loadkv(it + 1);
        f32x4 S[2];
#pragma unroll
        for (int tt = 0; tt < 2; ++tt) {
          f32x4 z = {0.f, 0.f, 0.f, 0.f};
          z = __builtin_amdgcn_mfma_f32_16x16x32_bf16(ck[tt][0], qf0, z, 0, 0, 0);
          z = __builtin_amdgcn_mfma_f32_16x16x32_bf16(ck[tt][1], qf1, z, 0, 0, 0);
          S[tt] = z;
        }
        float mx = -INFINITY;
#pragma unroll
        for (int tt = 0; tt < 2; ++tt)
#pragma unroll
          for (int e = 0; e < 4; ++e) {
            const int kk = (2 * it + tt) * 16 + 4 * g + e;
            const int j = 144 + qi - kk;
            const bool valid = (j >= 0) && (j <= 128) && (sk0 + kk >= 0);
            const float sv = valid ? S[tt][e] * 0.125f - slope * (float)(j << dshift) : -INFINITY;
            S[tt][e] = sv;
            mx = fmaxf(mx, sv);
          }
        mx = fmaxf(mx, __shfl_xor(mx, 16));
        mx = fmaxf(mx, __shfl_xor(mx, 32));
        const float mnew = fmaxf(mrun, mx);
        const float alpha = __expf(mrun - mnew);
        mrun = mnew;
        float ls = 0.f;
#pragma unroll
        for (int tt = 0; tt < 2; ++tt)
#pragma unroll
          for (int e = 0; e < 4; ++e) {
            const float pe = __expf(S[tt][e] - mnew);
            S[tt][e] = pe;
            ls += pe;
          }
        l = l * alpha + ls;
        uint4 pk;
        pk.x = pkbf(S[0][0], S[0][1]);
        pk.y = pkbf(S[0][2], S[0][3]);
        pk.z = pkbf(S[1][0], S[1][1]);
        pk.w = pkbf(S[1][2], S[1][3]);
        const bf16x8 pf = __builtin_bit_cast(bf16x8, pk);
#pragma unroll
        for (int m = 0; m < 4; ++m) {
          O[m] *= alpha;
          const uint4 vv = {cv[m][0].x, cv[m][0].y, cv[m][1].x, cv[m][1].y};
          O[m] = __builtin_amdgcn_mfma_f32_16x16x32_bf16(__builtin_bit_cast(bf16x8, vv), pf, O[m], 0, 0, 0);
        }
      }
      l += __shfl_xor(l, 16);
      l += __shfl_xor(l, 32);
      const float mx = mrun;
      const float il = 1.f / l;
      const int ql = ((tile * 16 + qi) << dshift) + r;
      float wo = 0.f, wn = 1.f;
      float mnew = mx, lnew = l;
      if (pi > 0) {
        const float mo = Mb[ql], lo = Lb[ql];
        mnew = fmaxf(mo, mx);
        wo = lo * __expf(mo - mnew);
        wn = l * __expf(mx - mnew);
        lnew = wo + wn;
        const float inv = 1.f / lnew;
        wo *= inv;
        wn *= inv;
      }
      wn *= il;
#pragma unroll
      for (int m = 0; m < 4; ++m) {
        bfu* op = Ob + ql * 64 + 16 * m + 4 * g;
        float o[4];
        if (pi > 0) {
          const uint2 ov = *(const uint2*)op;
          o[0] = wo * bf2f(ov.x & 0xffffu) + wn * O[m][0];
          o[1] = wo * bf2f(ov.x >> 16) + wn * O[m][1];
          o[2] = wo * bf2f(ov.y & 0xffffu) + wn * O[m][2];
          o[3] = wo * bf2f(ov.y >> 16) + wn * O[m][3];
        } else {
#pragma unroll
          for (int e = 0; e < 4; ++e) o[e] = wn * O[m][e];
        }
        if (pi < 2) {
          uint2 w;
          w.x = pkbf(o[0], o[1]);
          w.y = pkbf(o[2], o[3]);
          *(uint2*)op = w;
        } else {
          const size_t oi = (tokb + q0 + ql) * 1024 + 512 + h * 64 + 16 * m + 4 * g;
          const uint2 sz = *(const uint2*)(p.SZ + oi);
          uint2 w;
          w.x = pkbf(o[0] * bf2f(sz.x & 0xffffu), o[1] * bf2f(sz.x >> 16));
          w.y = pkbf(o[2] * bf2f(sz.y & 0xffffu), o[3] * bf2f(sz.y >> 16));
          *(uint2*)(p.Y + oi) = w;
        }
      }
      if (pi < 2 && g == 0) {
        Mb[ql] = mnew;
        Lb[ql] = lnew;
      }
    }
    __syncthreads();
  }
}

DEVI void phase2(const Params& p, char* smem, int bid, int nb) {
  for (int it = bid; it < 16 * 64; it += nb) attn_item(p, smem, it);
  char* hs = smem + HF * HALF_SMEM;
  for (int it = bid * 2 + HF; it < (T_TOK / 128) * 4; it += nb * 2) gmlp_item(p, hs, it);
}

DEVI void phase3(const Params& p, char* smem, int bid, int nb) {
  PgEpiRes E{p.x, p.out};
  pg_gemm(smem, p.Y, p.WT_out, T_TOK, 1024, 1024, E, bid, nb);
}
DEVI void phase3b(const Params& p, int bid, int nb) {
  for (int it = bid; it < T_TOK / 16; it += nb) {
    const int row = it * 16 + (threadIdx.x >> 6) * 2;
    rms_row2_bf16(p.out + (size_t)row * 1024, p.ln_odd, p.H + (size_t)row * 1024, threadIdx.x & 63);
  }
}

struct ALoadMix {
  typedef uint4 Raw;
  static constexpr bool kFat = true;
  static constexpr bool kConsec = true;
  const bfu* H;
  const float* mu;
  DEVI Raw load(int row, int k) const { return *(const uint4*)(H + (size_t)row * 1024 + k); }
  DEVI uint4 loadprev(int row, int k) const {
    const int prow = ((row & (SEQ - 1)) != 0) ? row - 1 : row;
    return *(const uint4*)(H + (size_t)prow * 1024 + k);
  }
  DEVI uint4 asprev(const Raw& r) const { return r; }
  DEVI uint4 finish(const Raw& r, const uint4& pr, int row, int k) const {
    float c[8], pv[8];
    unpack8(r, c);
    unpack8(pr, pv);
    const float first = ((row & (SEQ - 1)) != 0) ? 1.f : 0.f;
    const float4 m0 = *(const float4*)(mu + k), m1 = *(const float4*)(mu + k + 4);
    const float mm[8] = {m0.x, m0.y, m0.z, m0.w, m1.x, m1.y, m1.z, m1.w};
#pragma unroll
    for (int j = 0; j < 8; ++j) c[j] = c[j] + (pv[j] * first - c[j]) * mm[j];
    return pack8(c);
  }
};
struct Epi4 {
  const Params* p;
  int nt;
  DEVI void operator()(int row, int col, f32x4 v) const {
    uint2 o;
    if (nt < 24) {
      o.x = pkbf(v[0], v[1]);
      o.y = pkbf(v[2], v[3]);
      bfu* dst = (nt < 8) ? p->R + (size_t)row * 1024 + col
                          : (nt < 16) ? p->K1 + (size_t)row * 1024 + col - 1024 : p->V1 + (size_t)row * 1024 + col - 2048;
      *(uint2*)dst = o;
    } else if (nt < 32) {
      o.x = pkbf(silu_(v[0]), silu_(v[1]));
      o.y = pkbf(silu_(v[2]), silu_(v[3]));
      *(uint2*)(p->SG + (size_t)row * 1024 + col - 3072) = o;
    } else if (nt == 32) {
      const int c = col - 4096;
      if (c < 64) {
        o.x = pkbf(tanh_(v[0]), tanh_(v[1]));
        o.y = pkbf(tanh_(v[2]), tanh_(v[3]));
        *(uint2*)(p->TW + (size_t)row * 64 + c) = o;
      }
    } else {
      const int c = col - 4224;
      if (c < 64) {
        o.x = pkbf(v[0], v[1]);
        o.y = pkbf(v[2], v[3]);
        *(uint2*)(p->TA + (size_t)row * 64 + c) = o;
      }
    }
  }
};
DEVI void phase4_tile(const Params& p, char* smem, int mt, int nt) {
  float* smu = (float*)(smem + 2 * GSTAGE_BYTES);
  const int mi = (nt < 8) ? 0 : (nt < 16) ? 2 : (nt < 24) ? 3 : (nt < 32) ? 5 : (nt == 32) ? 1 : 4;
  *(float4*)(smu + TIDX * 4) = *(const float4*)(p.mu + mi * 1024 + TIDX * 4);
  __syncthreads();
  ALoadMix al{p.H, smu};
  Epi4 epi{&p, nt};
  gemm_tile<1>(smem, al, p.WT_3, 1024, 1024, mt * 128, nt * 128, epi);
}
DEVI void phase4(const Params& p, char* smem, int bid, int nb) {
  char* hs = smem + HF * HALF_SMEM;
  {
    TileSched ts(bid, nb, HF, T_TOK / 128, 32, 8, 8);
    int mt, nt, st;
    while ((st = ts.next(mt, nt)) != 0) {
      if (st != 1) continue;
      phase4_tile(p, hs, mt, nt);
    }
  }
  for (int it = bid * 2 + HF; it < (T_TOK / 128) * 2; it += nb * 2) phase4_tile(p, hs, it >> 1, 32 + (it & 1));
}

struct Epi5w {
  const Params* p;
  DEVI void operator()(int row, int col, f32x4 v) const {
    const float4 w0 = *(const float4*)(p->w0 + col);
    const float k = 0.6065306597126334f;
    uint2 o;
    o.x = pkbf(k * sigmoid_(w0.x + v[0]), k * sigmoid_(w0.y + v[1]));
    o.y = pkbf(k * sigmoid_(w0.z + v[2]), k * sigmoid_(w0.w + v[3]));
    *(uint2*)(p->EW + (size_t)row * 1024 + col) = o;
  }
};
struct Epi5a {
  const Params* p;
  DEVI void operator()(int row, int col, f32x4 v) const {
    const float4 a0 = *(const float4*)(p->a0 + col);
    uint2 o;
    o.x = pkbf(sigmoid_(a0.x + v[0]), sigmoid_(a0.y + v[1]));
    o.y = pkbf(sigmoid_(a0.z + v[2]), sigmoid_(a0.w + v[3]));
    *(uint2*)(p->AA + (size_t)row * 1024 + col) = o;
  }
};
DEVI void phase5(const Params& p, char* smem, int bid, int nb) {
  constexpr int N1 = (T_TOK / 128) * 8;
  char* hs = smem + HF * HALF_SMEM;
  for (int it = bid * 2 + HF; it < 2 * N1; it += nb * 2) {
    if (it < N1) {
      ALoadPlain al{p.TW, 64};
      Epi5w epi{&p};
      gemm_tile(hs, al, p.W2T, 64, 64, (it >> 3) * 128, (it & 7) * 128, epi);
    } else {
      const int j = it - N1;
      ALoadPlain al{p.TA, 64};
      Epi5a epi{&p};
      gemm_tile(hs, al, p.A2T, 64, 64, (j >> 3) * 128, (j & 7) * 128, epi);
    }
  }
}

DEVI void scanx_item(const Params& p, char* smem, int item) {
  const int bh = item & 31, c = item >> 5;
  const int b = bh >> 4, h = bh & 15;
  const size_t rowbase = ((size_t)b * SEQ + (size_t)c * 16) * 1024 + h * 64;
  float* sA = (float*)smem;
  float* sR = sA + 16 * 68;
  float* sBt = sR + 16 * 68;
  float* sKt = sBt + 16 * 68;
  float* sE = sKt + 16 * 68;
  float* sMab = sE + 16 * 64;
  float* sMak = sMab + 256;
  const int tid = TIDX;
  const int tau = tid >> 4, c4 = (tid & 15) * 4;
  const size_t o = rowbase + (size_t)tau * 1024 + c4;
  float r[4], k[4], ew[4], a[4], vv[4];
  unpack4(*(const uint2*)(p.R + o), r);
  unpack4(*(const uint2*)(p.K1 + o), k);
  unpack4(*(const uint2*)(p.EW + o), ew);
  unpack4(*(const uint2*)(p.AA + o), a);
  unpack4(*(const uint2*)(p.V1 + o), vv);
  float kk[4], kp[4], bb[4];
  float ss = 0.f, cf = 0.f;
#pragma unroll
  for (int j = 0; j < 4; ++j) {
    const int ch = h * 64 + c4 + j;
    kk[j] = k[j] * p.k_k[ch];
    ss += kk[j] * kk[j];
    kp[j] = k[j] * (1.f + (a[j] - 1.f) * p.k_a[ch]);
    cf += r[j] * kp[j] * p.r_k[ch];
  }
  ss = reduce16(ss);
  cf = reduce16(cf);
  const float rn = rsqrtf(fmaxf(ss, 1e-24f));
#pragma unroll
  for (int j = 0; j < 4; ++j) {
    kk[j] *= rn;
    bb[j] = kk[j] * a[j];
    sE[tau * 64 + c4 + j] = ew[j];
  }
  if ((tid & 15) == 0) p.COEF[((size_t)b * SEQ + (size_t)c * 16 + tau) * 16 + h] = cf;
  __syncthreads();
  float Li[4] = {0.f, 0.f, 0.f, 0.f}, L15[4] = {0.f, 0.f, 0.f, 0.f};
#pragma unroll
  for (int i = 0; i < 16; ++i) {
    const float4 e = *(const float4*)(sE + i * 64 + c4);
    const float m = (i <= tau) ? 1.f : 0.f;
    Li[0] += m * e.x; Li[1] += m * e.y; Li[2] += m * e.z; Li[3] += m * e.w;
    L15[0] += e.x; L15[1] += e.y; L15[2] += e.z; L15[3] += e.w;
  }
  float rt[4], bhat[4], khat[4];
#pragma unroll
  for (int j = 0; j < 4; ++j) {
    const float ep = __expf(Li[j]), em = __expf(-Li[j]), eh = __expf(-(L15[j] - Li[j]));
    const float at = -kk[j] * __expf(-(Li[j] - ew[j]));
    rt[j] = r[j] * em;
    sA[tau * 68 + c4 + j] = at;
    sR[tau * 68 + c4 + j] = rt[j];
    sBt[tau * 68 + c4 + j] = bb[j] * ep;
    sKt[tau * 68 + c4 + j] = kp[j] * ep;
    bhat[j] = bb[j] * eh;
    khat[j] = kp[j] * eh;
  }
  *(uint2*)(p.R + o) = pack4(rt);
#pragma unroll
  for (int j = 0; j < 4; ++j) {
    const int lin = (c4 + j) * 16 + tau;
    const size_t off = rowbase + (size_t)(lin >> 6) * 1024 + (lin & 63);
    p.EW[off] = (bfu)f2bf(bhat[j]);
    p.K1[off] = (bfu)f2bf(khat[j]);
    p.V1[off] = (bfu)f2bf(vv[j]);
  }
  if (tau == 0) {
    float4 gq = {__expf(-L15[0]), __expf(-L15[1]), __expf(-L15[2]), __expf(-L15[3])};
    *(float4*)(p.G15 + (size_t)item * 64 + c4) = gq;
  }
  __syncthreads();
  {
    const int i = tid >> 4, tq = tid & 15;
    float mab = 0.f, mak = 0.f, mrb = 0.f, mrk = 0.f;
#pragma unroll
    for (int kq = 0; kq < 64; kq += 4) {
      const float4 bi = *(const float4*)(sBt + i * 68 + kq);
      const float4 ki = *(const float4*)(sKt + i * 68 + kq);
      const float4 aq = *(const float4*)(sA + tq * 68 + kq);
      const float4 rq = *(const float4*)(sR + tq * 68 + kq);
      mab += bi.x * aq.x + bi.y * aq.y + bi.z * aq.z + bi.w * aq.w;
      mak += ki.x * aq.x + ki.y * aq.y + ki.z * aq.z + ki.w * aq.w;
      mrb += bi.x * rq.x + bi.y * rq.y + bi.z * rq.z + bi.w * rq.w;
      mrk += ki.x * rq.x + ki.y * rq.y + ki.z * rq.z + ki.w * rq.w;
    }
    if (!(i < tq)) { mab = 0.f; mak = 0.f; }
    if (!(i <= tq)) { mrb = 0.f; mrk = 0.f; }
    sMab[i * 16 + tq] = mab;
    sMak[i * 16 + tq] = mak;
    bfu* mr = p.MRT + (size_t)item * 512 + tq * 32 + (i >> 2) * 8 + (i & 3);
    mr[0] = (bfu)f2bf(mrb);
    mr[4] = (bfu)f2bf(mrk);
  }
  __syncthreads();
  if (tid < 80) {
    float x[16];
#pragma unroll
    for (int t = 0; t < 16; ++t) {
      float accv = (tid < 64) ? sA[t * 68 + tid] : sMak[(tid - 64) * 16 + t];
#pragma unroll
      for (int i = 0; i < t; ++i) accv += x[i] * sMab[i * 16 + t];
      x[t] = accv;
    }
    if (tid < 64) {
#pragma unroll
      for (int t = 0; t < 16; ++t) p.AA[rowbase + (size_t)t * 1024 + tid] = (bfu)f2bf(x[t]);
    } else {
#pragma unroll
      for (int t = 0; t < 16; ++t) p.GT[(size_t)item * 256 + t * 16 + (tid - 64)] = (bfu)f2bf(x[t]);
    }
  }
  __syncthreads();
}
DEVI void phase6x(const Params& p, char* smem, int bid, int nb) {
  char* hs = smem + HF * HALF_SMEM;
  for (int it = bid * 2 + HF; it < (SEQ / 16) * 32; it += nb * 2) scanx_item(p, hs, it);
}

DEVI bf16x8 mk8(uint2 a, uint2 b) {
  const uint4 v = {a.x, a.y, b.x, b.y};
  return __builtin_bit_cast(bf16x8, v);
}
DEVI uint2 packacc(f32x4 a) {
  uint2 r;
  r.x = pkbf(a[0], a[1]);
  r.y = pkbf(a[2], a[3]);
  return r;
}
constexpr int SCH = 6;
constexpr int SROW = 136;
constexpr int SARR = 16 * SROW;
constexpr int SOFF_GT = 5 * SARR;
constexpr int SOFF_MR = SOFF_GT + 512;
constexpr int SOFF_G15 = SOFF_MR + 1024;
constexpr int SIMG = SOFF_G15 + 256;
#define SCANS_LD5(P, I, O)                       \
    P##a##I = *(const uint4*)(p.AA + (O));       \
    P##r##I = *(const uint4*)(p.R + (O));        \
    P##e##I = *(const uint4*)(p.EW + (O));       \
    P##k##I = *(const uint4*)(p.K1 + (O));       \
    P##v##I = *(const uint4*)(p.V1 + (O));
#define SCANS_ISSUE(P, SC)                                                                           \
  {                                                                                                  \
    const size_t hb_ = ((size_t)b * SEQ) * 1024 + h * 64 + c80 * 8;                                  \
    const int tk0_ = (SC) * SCH * 16 + cl0 * 16 + row0;                                              \
    const int tk1_ = tk0_ + 32, tk2_ = tk0_ + 64;                                                    \
    SCANS_LD5(P, 0, hb_ + (size_t)(tk0_ < SEQ ? tk0_ : SEQ - 1) * 1024)                              \
    SCANS_LD5(P, 1, hb_ + (size_t)(tk1_ < SEQ ? tk1_ : SEQ - 1) * 1024)                              \
    SCANS_LD5(P, 2, hb_ + (size_t)(tk2_ < SEQ ? tk2_ : SEQ - 1) * 1024)                              \
    const int c0_ = (SC) * SCH;                                                                      \
    const size_t ib_ = (size_t)b * 16 + h;                                                           \
    const int tg_ = tid < 192 ? tid : 191;                                                           \
    const int cg_ = c0_ + (tg_ >> 5);                                                                \
    P##gm = *(const uint4*)(p.GT + ((size_t)(cg_ < SEQ / 16 ? cg_ : SEQ / 16 - 1) * 32 + ib_) * 256 + (tg_ & 31) * 8);  \
    const int t5_ = tid < 96 ? tid : 95;                                                             \
    const int c5_ = c0_ + (t5_ >> 4);                                                                \
    P##g5 = *(const uint4*)(p.G15 + ((size_t)(c5_ < SEQ / 16 ? c5_ : SEQ / 16 - 1) * 32 + ib_) * 64 + (t5_ & 15) * 4);  \
    const int cm_ = c0_ + (tid >> 6);                                                                \
    P##mr = *(const uint4*)(p.MRT + ((size_t)(cm_ < SEQ / 16 ? cm_ : SEQ / 16 - 1) * 32 + ib_) * 512 + (tid & 63) * 8); \
    const int tm_ = 256 + (tid & 127);                                                               \
    const int cs_ = c0_ + (tm_ >> 6);                                                                \
    P##ms = *(const uint4*)(p.MRT + ((size_t)(cs_ < SEQ / 16 ? cs_ : SEQ / 16 - 1) * 32 + ib_) * 512 + (tm_ & 63) * 8); \
  }
#define SCANS_ST5(P, I, B)                                                                           \
    *(uint2*)(B) = uint2{P##a##I.x, P##a##I.y};  *(uint2*)((B) + 8) = uint2{P##a##I.z, P##a##I.w};   \
    *(uint2*)((B) + SARR) = uint2{P##r##I.x, P##r##I.y};  *(uint2*)((B) + SARR + 8) = uint2{P##r##I.z, P##r##I.w};   \
    *(uint2*)((B) + 2 * SARR) = uint2{P##e##I.x, P##e##I.y};  *(uint2*)((B) + 2 * SARR + 8) = uint2{P##e##I.z, P##e##I.w};   \
    *(uint2*)((B) + 3 * SARR) = uint2{P##k##I.x, P##k##I.y};  *(uint2*)((B) + 3 * SARR + 8) = uint2{P##k##I.z, P##k##I.w};   \
    *(uint2*)((B) + 4 * SARR) = uint2{P##v##I.x, P##v##I.y};  *(uint2*)((B) + 4 * SARR + 8) = uint2{P##v##I.z, P##v##I.w};
#define SCANS_COMMIT(P)                                                                              \
  {                                                                                                  \
    char* b0_ = smem + cl0 * SIMG + row0 * SROW + c80 * 16;                                          \
    SCANS_ST5(P, 0, b0_)                                                                             \
    SCANS_ST5(P, 1, b0_ + 2 * SIMG)                                                                  \
    SCANS_ST5(P, 2, b0_ + 4 * SIMG)                                                                  \
    if (tid < 192) *(uint4*)(smem + (tid >> 5) * SIMG + SOFF_GT + (tid & 31) * 16) = P##gm;          \
    if (tid < 96) *(uint4*)(smem + (tid >> 4) * SIMG + SOFF_G15 + (tid & 15) * 16) = P##g5;          \
    *(uint4*)(smem + (tid >> 6) * SIMG + SOFF_MR + (tid & 63) * 16) = P##mr;                         \
    if (tid < 128) *(uint4*)(smem + ((256 + tid) >> 6) * SIMG + SOFF_MR + (tid & 63) * 16) = P##ms;  \
  }
#define SCANS_COMPUTE(SCI)                                                                           \
  _Pragma("unroll 1") for (int cl = 0; cl < SCH && (SCI) * SCH + cl < SEQ / 16; ++cl) {             \
    const char* img = smem + cl * SIMG;                                                              \
        \
    const uint2 vb = *(const uint2*)(img + 4 * SARR + vrow * SROW + vcol * 2);                       \
    const uint2 gt = *(const uint2*)(img + SOFF_GT + (q * 16 + 4 * g) * 2);                          \
    const char* wp = img + q * SROW + (4 * g) * 2;                                                   \
    const uint2 w00 = *(const uint2*)(wp), w01 = *(const uint2*)(wp + 32);                           \
    const uint2 w10 = *(const uint2*)(wp + 64), w11 = *(const uint2*)(wp + 96);                      \
    const uint2 r00 = *(const uint2*)(wp + SARR), r01 = *(const uint2*)(wp + SARR + 32);             \
    const uint2 r10 = *(const uint2*)(wp + SARR + 64), r11 = *(const uint2*)(wp + SARR + 96);        \
    const uint4 mr = *(const uint4*)(img + SOFF_MR + (q * 32 + g * 8) * 2);                          \
    uint2 bk0[4], bk1[4];                                                                            \
    float4 g15[4];                                                                                   \
    _Pragma("unroll") for (int n = 0; n < 4; ++n) {                                                  \
      const int ch = 16 * n + q;                                                                     \
      const char* bp = img + 2 * SARR + (ch >> 2) * SROW + ((ch & 3) * 16 + 4 * g) * 2;              \
      bk0[n] = *(const uint2*)(bp);                                                                  \
      bk1[n] = *(const uint2*)(bp + SARR);                                                           \
      g15[n] = *(const float4*)(img + SOFF_G15 + (16 * n + 4 * g) * 4);                              \
    }                                                                                                \
    __builtin_amdgcn_sched_barrier(0);                                                               \
    const bf16x8 sB0 = mk8(packacc(acc[0]), packacc(acc[1]));                                        \
    const bf16x8 sB1 = mk8(packacc(acc[2]), packacc(acc[3]));                                        \
    f32x4 Z = {0.f, 0.f, 0.f, 0.f};                                                                  \
    Z = __builtin_amdgcn_mfma_f32_16x16x32_bf16(mk8(gt, zero2), mk8(vb, zero2), Z, 0, 0, 0);         \
    f32x4 Y = {0.f, 0.f, 0.f, 0.f};                                                                  \
    Z = __builtin_amdgcn_mfma_f32_16x16x32_bf16(mk8(w00, w01), sB0, Z, 0, 0, 0);                     \
    Y = __builtin_amdgcn_mfma_f32_16x16x32_bf16(mk8(r00, r01), sB0, Y, 0, 0, 0);                     \
    Z = __builtin_amdgcn_mfma_f32_16x16x32_bf16(mk8(w10, w11), sB1, Z, 0, 0, 0);                     \
    Y = __builtin_amdgcn_mfma_f32_16x16x32_bf16(mk8(r10, r11), sB1, Y, 0, 0, 0);                     \
    const bf16x8 zvB = mk8(packacc(Z), vb);                                                          \
    Y = __builtin_amdgcn_mfma_f32_16x16x32_bf16(__builtin_bit_cast(bf16x8, mr), zvB, Y, 0, 0, 0);    \
    _Pragma("unroll") for (int n = 0; n < 4; ++n) {                                                  \
      f32x4 scv = acc[n];                                                                            \
      scv[0] *= g15[n].x; scv[1] *= g15[n].y; scv[2] *= g15[n].z; scv[3] *= g15[n].w;                \
      acc[n] = __builtin_amdgcn_mfma_f32_16x16x32_bf16(mk8(bk0[n], bk1[n]), zvB, scv, 0, 0, 0);      \
    }                                                                                                \
    const int c = (SCI) * SCH + cl;                                                                  \
    _Pragma("unroll") for (int e = 0; e < 4; ++e)                                                    \
        yout[(size_t)(c * 16 + 4 * g + e) * 1024] = (bfu)f2bf(Y[e]);                                 \
  }
DEVI void scans_block(const Params& p, char* smem, int bh) {
  const int b = bh >> 4, h = bh & 15;
  const int lane = threadIdx.x & 63, vs = threadIdx.x >> 6, q = lane & 15, g = lane >> 4;
  f32x4 acc[4];
#pragma unroll
  for (int n = 0; n < 4; ++n) acc[n] = f32x4{0.f, 0.f, 0.f, 0.f};
  const uint2 zero2 = {0u, 0u};
  bfu* yout = p.YS + ((size_t)b * SEQ) * 1024 + h * 64 + vs * 16 + q;
  const int tid = threadIdx.x;
  const int t2 = (tid - 128) & 63;
  const int cl0 = tid >> 7, row0 = (tid >> 3) & 15, c80 = tid & 7;
  uint4 Aa0, Aa1, Aa2, Ar0, Ar1, Ar2, Ae0, Ae1, Ae2, Ak0, Ak1, Ak2, Av0, Av1, Av2, Agm, Ag5, Amr, Ams;
  constexpr int NSC = (SEQ / 16 + SCH - 1) / SCH;
  const int vrow = vs * 4 + (q >> 2), vcol = (q & 3) * 16 + 4 * g;
  SCANS_ISSUE(A, 0);
  SCANS_COMMIT(A);
  __syncthreads();
#pragma unroll 1
  for (int sc = 0; sc < NSC; ++sc) {
    SCANS_ISSUE(A, (sc + 1 < NSC ? sc + 1 : NSC - 1));
    SCANS_COMPUTE(sc);
    __syncthreads();
    SCANS_COMMIT(A);
    __syncthreads();
  }
}
DEVI void phase6(const Params& p, char* smem, int bid, int nb) {
  for (int it = bid; it < 32; it += nb) {
    if (threadIdx.x < 256) {
      scans_block(p, smem, it);
    } else {
      constexpr int NSC = (SEQ / 16 + SCH - 1) / SCH;
      __syncthreads();
#pragma unroll 1
      for (int sc = 0; sc < NSC; ++sc) {
        __syncthreads();
        __syncthreads();
      }
    }
  }
}

DEVI void phase6b(const Params& p, int bid, int nb) {
  const int lane = threadIdx.x & 63, wv = (threadIdx.x >> 6) & 3;
  for (int it = bid; it < T_TOK / 2; it += nb) {
    const int t = it * 2 + (threadIdx.x >> 8);
    const int tb = t & ~15, tau = t & 15;
    float ys[4], vv[4], sg[4], bon[4];
#pragma unroll
    for (int j = 0; j < 4; ++j) {
      const int h = wv * 4 + j;
      const size_t idx = (size_t)t * 1024 + h * 64 + lane;
      ys[j] = bf2f(p.YS[idx]);
      sg[j] = bf2f(p.SG[idx]);
      vv[j] = bf2f(p.V1[(size_t)(tb + (lane >> 2)) * 1024 + h * 64 + (lane & 3) * 16 + tau]);
      bon[j] = p.COEF[(size_t)t * 16 + h];
    }
#pragma unroll
    for (int j = 0; j < 4; ++j) {
      const int h = wv * 4 + j;
      const int c = h * 64 + lane;
      const float mean = wave_sum(ys[j]) * (1.f / 64.f);
      const float dv = ys[j] - mean;
      const float var = wave_sum(dv * dv) * (1.f / 64.f);
      float y = dv * rsqrtf(var + 64e-5f) * p.lnw[c] + p.lnb[c];
      y = (y + bon[j] * vv[j]) * sg[j];
      p.YS[(size_t)t * 1024 + c] = (bfu)f2bf(y);
    }
  }
}

DEVI void phase7(const Params& p, char* smem, int bid, int nb) {
  PgEpiRes E{p.out, p.out};
  pg_gemm(smem, p.YS, p.WT_o, T_TOK, 1024, 1024, E, bid, nb);
}
DEVI void phase8(const Params& p, int bid, int nb) {
  for (int it = bid; it < T_TOK / 16; it += nb) {
    const int row = it * 16 + (threadIdx.x >> 6) * 2;
    const int lane = threadIdx.x & 63;
    float* src = p.out + (size_t)row * 1024;
    float4 v[2][4];
    float ss[2] = {0.f, 0.f};
#pragma unroll
    for (int r = 0; r < 2; ++r)
#pragma unroll
      for (int i = 0; i < 4; ++i) v[r][i] = *(const float4*)(src + r * 1024 + lane * 4 + 256 * i);
#pragma unroll
    for (int r = 0; r < 2; ++r)
#pragma unroll
      for (int i = 0; i < 4; ++i)
        ss[r] += v[r][i].x * v[r][i].x + v[r][i].y * v[r][i].y + v[r][i].z * v[r][i].z + v[r][i].w * v[r][i].w;
#pragma unroll
    for (int r = 0; r < 2; ++r) {
      const float rinv = rsqrtf(wave_sum(ss[r]) * (1.f / 1024.f) + 1e-6f);
#pragma unroll
      for (int i = 0; i < 4; ++i) {
        const float4 g = *(const float4*)(p.fnorm + lane * 4 + 256 * i);
        const float4 o = {v[r][i].x * rinv * g.x, v[r][i].y * rinv * g.y, v[r][i].z * rinv * g.z, v[r][i].w * rinv * g.w};
        *(float4*)(src + r * 1024 + lane * 4 + 256 * i) = o;
      }
    }
  }
}

template <int PH>
DEVI void run_phase(const Params& p, char* smem, int bid, int nb) {
  if (PH == 0) phase0(p, smem, bid, nb);
  if (PH == 1) phase1(p, smem, bid, nb);
  if (PH == 2) phase2(p, smem, bid, nb);
  if (PH == 3) phase3(p, smem, bid, nb);
  if (PH == 4) phase3b(p, bid, nb);
  if (PH == 5) phase4(p, smem, bid, nb);
  if (PH == 6) phase5(p, smem, bid, nb);
  if (PH == 7) phase6x(p, smem, bid, nb);
  if (PH == 8) phase6(p, smem, bid, nb);
  if (PH == 9) phase6b(p, bid, nb);
  if (PH == 10) phase7(p, smem, bid, nb);
  if (PH == 11) phase8(p, bid, nb);
}

#ifndef REP_MASK
#define REP_MASK 0
#endif
template <int PH>
DEVI void mega_phase(const Params& p, char* smem, cg::grid_group& grid, int bid, int nb) {
  run_phase<PH>(p, smem, bid, nb);
  if ((REP_MASK >> PH) & 1) {
    grid.sync();
    run_phase<PH>(p, smem, bid, nb);
  }
}
__global__ void __launch_bounds__(512, 2) mega_kernel(Params p) {
  extern __shared__ __attribute__((aligned(16))) char smem[];
  cg::grid_group grid = cg::this_grid();
  const int bid = blockIdx.x, nb = gridDim.x;
  mega_phase<0>(p, smem, grid, bid, nb); grid.sync();
  mega_phase<1>(p, smem, grid, bid, nb); grid.sync();
  mega_phase<2>(p, smem, grid, bid, nb); grid.sync();
  mega_phase<3>(p, smem, grid, bid, nb); grid.sync();
  mega_phase<4>(p, smem, grid, bid, nb); grid.sync();
  mega_phase<5>(p, smem, grid, bid, nb); grid.sync();
  mega_phase<6>(p, smem, grid, bid, nb); grid.sync();
  mega_phase<7>(p, smem, grid, bid, nb); grid.sync();
  mega_phase<8>(p, smem, grid, bid, nb); grid.sync();
  mega_phase<9>(p, smem, grid, bid, nb); grid.sync();
  mega_phase<10>(p, smem, grid, bid, nb); grid.sync();
  mega_phase<11>(p, smem, grid, bid, nb);
}

extern "C" void kernel_launch(void* const* d_in, const int* in_sizes, int n_in, void* d_out, int out_size, void* d_ws,
                              size_t ws_size, hipStream_t stream) {
  Params p{};
  const float** fp = (const float**)&p;
  for (int i = 0; i < 26; ++i) fp[i] = (const float*)d_in[i];
  p.out = (float*)d_out;
  char* w = (char*)d_ws;
  size_t off = 0;
  auto take = [&](size_t bytes) {
    char* r = w + off;
    off += (bytes + 255) & ~(size_t)255;
    return (bfu*)r;
  };
  p.WT_in = take((size_t)3584 * 1024 * 2);
  p.WT_out = take((size_t)1024 * 1024 * 2);
  p.WT_3 = take((size_t)4352 * 1024 * 2);
  p.WT_o = take((size_t)1024 * 1024 * 2);
  p.W2T = take((size_t)1024 * 64 * 2);
  p.A2T = take((size_t)1024 * 64 * 2);
  p.TW = take((size_t)T_TOK * 64 * 2);
  p.TA = take((size_t)T_TOK * 64 * 2);
  const size_t SLOT = (size_t)T_TOK * 1024 * 2;
  bfu* slot0 = take(SLOT);
  bfu* slots = take(6 * SLOT);
  p.H = slot0;
  p.AA = slot0;
  p.U = slots;
  p.GVT = slots + SLOT / 4;
  p.Q = slots + 2 * (SLOT / 4);
  p.K = slots + 3 * (SLOT / 4);
  p.VT = slots + 4 * (SLOT / 4);
  p.SZ = slots + 7 * (SLOT / 4);
  p.Y = slots + 9 * (SLOT / 4);
  p.R = slots;
  p.K1 = slots + 1 * (SLOT / 2);
  p.V1 = slots + 2 * (SLOT / 2);
  p.SG = slots + 3 * (SLOT / 2);
  p.EW = slots + 4 * (SLOT / 2);
  p.YS = slots + 5 * (SLOT / 2);
  p.G15 = (float*)p.TW;
  p.GT = p.WT_in;
  p.MRT = take((size_t)(SEQ / 16) * 32 * 512 * 2);
  p.COEF = (float*)take((size_t)T_TOK * 16 * 4);
  if (off > ws_size) {
    fprintf(stderr, "workspace too small: need %zu have %zu\n", off, ws_size);
    return;
  }
  static int grid_blocks = 0;
  if (!grid_blocks) {
    int dev = 0, cus = 0, per_cu = 0;
    (void)hipGetDevice(&dev);
    (void)hipDeviceGetAttribute(&cus, hipDeviceAttributeMultiprocessorCount, dev);
    (void)hipFuncSetAttribute((const void*)mega_kernel, hipFuncAttributeMaxDynamicSharedMemorySize, SMEM_BYTES);
    (void)hipOccupancyMaxActiveBlocksPerMultiprocessor(&per_cu, mega_kernel, 512, SMEM_BYTES);
    grid_blocks = cus * per_cu;
  }
  void* args[] = {&p};
  hipError_t e = hipLaunchCooperativeKernel((void*)mega_kernel, dim3(grid_blocks), dim3(512), args, SMEM_BYTES, stream);
  if (e != hipSuccess) fprintf(stderr, "cooperative launch failed: %s (grid %d)\n", hipGetErrorString(e), grid_blocks);
}
```

```cpp
#include <hip/hip_runtime.h>
#include <hip/hip_cooperative_groups.h>
#include <stdint.h>
#include <cstdio>
namespace cg = cooperative_groups;

#ifndef MEGA
#define MEGA 1
#endif

typedef unsigned short bfu;
using bf16x8 = __attribute__((ext_vector_type(8))) short;
using f32x4 = __attribute__((ext_vector_type(4))) float;
#define DEVI __device__ __forceinline__
#define TIDX ((int)(threadIdx.x & 255))
#define HF ((int)(threadIdx.x >> 8))

constexpr int GSTAGE_BYTES = 2 * 128 * 72 * 2;
constexpr int T_TOK = 32768;
constexpr int SEQ = 16384;
constexpr int HALF_SMEM = 2 * GSTAGE_BYTES + 4096 + 512;
constexpr int SMEM_BYTES = 2 * HALF_SMEM;
constexpr int SMEM_UNUSED_ = 0;

struct Params {
  const float *x, *ln_even, *w_in, *gm_norm, *gm_ws, *gm_b, *w_out, *ln_odd, *mu, *wr, *wk, *wv, *wg, *w0, *w1, *w2,
      *a0, *a1, *a2, *k_k, *k_a, *r_k, *lnw, *lnb, *wo, *fnorm;
  float* out;
  bfu *WT_in, *WT_out, *WT_3, *WT_o, *W2T, *A2T;
  bfu *H, *U, *GVT, *Q, *K, *VT, *SZ, *Y, *R, *K1, *V1, *SG, *EW, *AA, *YS, *TW, *TA, *GT, *MRT, *XR, *XK, *XV, *XG;
  float *G15, *COEF;
};

DEVI float bf2f(unsigned b) { return __uint_as_float(b << 16); }
DEVI unsigned f2bf(float x) {
  const __bf16 h = (__bf16)x;
  return (unsigned)__builtin_bit_cast(unsigned short, h);
}
typedef __bf16 bf16x2_t __attribute__((ext_vector_type(2)));
typedef float float2_t __attribute__((ext_vector_type(2)));
DEVI unsigned pkbf(float a, float b) {
  const float2_t f = {a, b};
  const bf16x2_t h = __builtin_convertvector(f, bf16x2_t);
  return __builtin_bit_cast(unsigned, h);
}
DEVI void unpack8(uint4 v, float* f) {
  f[0] = __uint_as_float(v.x << 16); f[1] = __uint_as_float(v.x & 0xffff0000u);
  f[2] = __uint_as_float(v.y << 16); f[3] = __uint_as_float(v.y & 0xffff0000u);
  f[4] = __uint_as_float(v.z << 16); f[5] = __uint_as_float(v.z & 0xffff0000u);
  f[6] = __uint_as_float(v.w << 16); f[7] = __uint_as_float(v.w & 0xffff0000u);
}
DEVI uint4 pack8(const float* f) {
  uint4 r;
  r.x = pkbf(f[0], f[1]);
  r.y = pkbf(f[2], f[3]);
  r.z = pkbf(f[4], f[5]);
  r.w = pkbf(f[6], f[7]);
  return r;
}
DEVI void unpack4(uint2 v, float* f) {
  f[0] = __uint_as_float(v.x << 16); f[1] = __uint_as_float(v.x & 0xffff0000u);
  f[2] = __uint_as_float(v.y << 16); f[3] = __uint_as_float(v.y & 0xffff0000u);
}
DEVI uint2 pack4(const float* f) {
  uint2 r;
  r.x = pkbf(f[0], f[1]);
  r.y = pkbf(f[2], f[3]);
  return r;
}

DEVI float sigmoid_(float x) { return 1.f / (1.f + __expf(-x)); }
DEVI float silu_(float x) { return x * sigmoid_(x); }
DEVI float tanh_(float y) { float t = __expf(2.f * y); return 1.f - 2.f / (1.f + t); }
DEVI float gelu_(float x) {
  float y = 0.7978845608028654f * (x + 0.044715f * x * x * x);
  return 0.5f * x * (1.f + tanh_(y));
}
DEVI float wave_sum(float v) {
#pragma unroll
  for (int o = 32; o > 0; o >>= 1) v += __shfl_xor(v, o);
  return v;
}
DEVI float wave_max(float v) {
#pragma unroll
  for (int o = 32; o > 0; o >>= 1) v = fmaxf(v, __shfl_xor(v, o));
  return v;
}
template <int CTRL>
DEVI float dppf(float x) {
  return __int_as_float(__builtin_amdgcn_update_dpp(0, __float_as_int(x), CTRL, 0xF, 0xF, true));
}
DEVI float reduce16(float x) {
  x += dppf<0xB1>(x);
  x += dppf<0x4E>(x);
  x += dppf<0x141>(x);
  x += dppf<0x140>(x);
  return x;
}

constexpr int LROW = 72;
constexpr int GSTAGE = 2 * 128 * LROW;

template <int DIST = 2, bool SW = true, class ALoad, class Epi>
DEVI void gemm_tile(char* smem, const ALoad& aload, const bfu* __restrict__ Bt, int ldb, int K, int m0, int n0,
                    const Epi& epi) {
  bfu* sbase = (bfu*)smem;
  const int tid = TIDX, lane = tid & 63, wid = tid >> 6, wr = wid >> 1, wc = wid & 1;
  const int fr = lane & 15, fq = lane >> 4;
  f32x4 acc[4][4];
#pragma unroll
  for (int i = 0; i < 4; ++i)
#pragma unroll
    for (int j = 0; j < 4; ++j) acc[i][j] = f32x4{0.f, 0.f, 0.f, 0.f};
  const int r0 = tid >> 3, kc = (tid & 7) * 8;
  const int nk = K >> 6;
  struct GRegs { typename ALoad::Raw a0, a1, a2, a3; uint4 ap, b0, b1, b2, b3; };
  GRegs g0, g1;
  const bfu* Bp = Bt + (size_t)(n0 + r0) * ldb + kc;
  const size_t ldb32 = (size_t)ldb * 32;
  constexpr int ARS = ALoad::kConsec ? 1 : 32;
  const int ar0 = ALoad::kConsec ? 4 * r0 : r0;
#define GEMM_ISSUE(R, KT)                                   \
  {                                                         \
    const int k0_ = ((KT) << 6);                            \
    R.ap = aload.loadprev(m0 + ar0, k0_ + kc);              \
    R.a0 = aload.load(m0 + ar0, k0_ + kc);                  \
    R.a1 = aload.load(m0 + ar0 + ARS, k0_ + kc);            \
    R.a2 = aload.load(m0 + ar0 + 2 * ARS, k0_ + kc);        \
    R.a3 = aload.load(m0 + ar0 + 3 * ARS, k0_ + kc);        \
    R.b0 = *(const uint4*)(Bp + k0_);                       \
    R.b1 = *(const uint4*)(Bp + ldb32 + k0_);               \
    R.b2 = *(const uint4*)(Bp + 2 * ldb32 + k0_);           \
    R.b3 = *(const uint4*)(Bp + 3 * ldb32 + k0_);           \
  }
#define GEMM_COMMIT(R, S, KT)                               \
  {                                                         \
    const int k1_ = ((KT) << 6) + kc;                       \
    bfu* A_ = sbase + (S) * GSTAGE + ar0 * LROW + kc;       \
    bfu* B_ = sbase + (S) * GSTAGE + 128 * LROW + r0 * LROW + kc;   \
    *(uint4*)(A_) = aload.finish(R.a0, R.ap, m0 + ar0, k1_);                                 \
    *(uint4*)(A_ + ARS * LROW) = aload.finish(R.a1, aload.asprev(R.a0), m0 + ar0 + ARS, k1_);          \
    *(uint4*)(A_ + 2 * ARS * LROW) = aload.finish(R.a2, aload.asprev(R.a1), m0 + ar0 + 2 * ARS, k1_);  \
    *(uint4*)(A_ + 3 * ARS * LROW) = aload.finish(R.a3, aload.asprev(R.a2), m0 + ar0 + 3 * ARS, k1_);  \
    *(uint4*)(B_) = R.b0;                                   \
    *(uint4*)(B_ + 32 * LROW) = R.b1;                       \
    *(uint4*)(B_ + 64 * LROW) = R.b2;                       \
    *(uint4*)(B_ + 96 * LROW) = R.b3;                       \
  }
#define GEMM_COMPUTE(S)                                                                          \
  {                                                                                              \
    const bfu* cA = sbase + (S) * GSTAGE;                                                        \
    const bfu* cB = cA + 128 * LROW;                                                             \
    _Pragma("unroll") for (int ks = 0; ks < 2; ++ks) {                                           \
      bf16x8 af[4], bfv[4];                                                                      \
      _Pragma("unroll") for (int i = 0; i < 4; ++i) {                                            \
        af[i] = *(const bf16x8*)(cA + (wr * 64 + i * 16 + fr) * LROW + ks * 32 + fq * 8);        \
        bfv[i] = *(const bf16x8*)(cB + (wc * 64 + i * 16 + fr) * LROW + ks * 32 + fq * 8);       \
      }                                                                                          \
      _Pragma("unroll") for (int i = 0; i < 4; ++i) _Pragma("unroll") for (int j = 0; j < 4; ++j) \
          acc[i][j] = SW ? __builtin_amdgcn_mfma_f32_16x16x32_bf16(bfv[j], af[i], acc[i][j], 0, 0, 0)     \
                         : __builtin_amdgcn_mfma_f32_16x16x32_bf16(af[i], bfv[j], acc[i][j], 0, 0, 0);    \
    }                                                                                            \
  }
  const int nkm1 = nk - 1;
  if (DIST == 2) {
    GEMM_ISSUE(g0, 0);
    GEMM_ISSUE(g1, (1 < nkm1 ? 1 : nkm1));
    GEMM_COMMIT(g0, 0, 0);
    GEMM_ISSUE(g0, (2 < nkm1 ? 2 : nkm1));
    __syncthreads();
    if (nk == 1) {
      GEMM_COMPUTE(0);
      __syncthreads();
    } else {
      for (int kt = 0; kt < nk; kt += 2) {
        GEMM_COMMIT(g1, 1, (kt + 1 < nkm1 ? kt + 1 : nkm1));
        GEMM_ISSUE(g1, (kt + 3 < nkm1 ? kt + 3 : nkm1));
        GEMM_COMPUTE(0);
        __syncthreads();
        GEMM_COMMIT(g0, 0, (kt + 2 < nkm1 ? kt + 2 : nkm1));
        GEMM_ISSUE(g0, (kt + 4 < nkm1 ? kt + 4 : nkm1));
        GEMM_COMPUTE(1);
        __syncthreads();
      }
    }
  } else {
    GEMM_ISSUE(g0, 0);
    GEMM_COMMIT(g0, 0, 0);
    GEMM_ISSUE(g0, (1 < nkm1 ? 1 : nkm1));
    __syncthreads();
    for (int kt = 0; kt < nk; kt += 2) {
      GEMM_COMMIT(g0, 1, (kt + 1 < nkm1 ? kt + 1 : nkm1));
      GEMM_ISSUE(g0, (kt + 2 < nkm1 ? kt + 2 : nkm1));
      GEMM_COMPUTE(0);
      __syncthreads();
      GEMM_COMMIT(g0, 0, (kt + 2 < nkm1 ? kt + 2 : nkm1));
      GEMM_ISSUE(g0, (kt + 3 < nkm1 ? kt + 3 : nkm1));
      GEMM_COMPUTE(1);
      __syncthreads();
    }
  }
#pragma unroll
  for (int i = 0; i < 4; ++i)
#pragma unroll
    for (int j = 0; j < 4; ++j) {
      if (SW) epi(m0 + wr * 64 + i * 16 + fr, n0 + wc * 64 + j * 16 + fq * 4, acc[i][j]);
      else epi(m0 + wr * 64 + i * 16 + fq * 4, n0 + wc * 64 + j * 16 + fr, acc[i][j]);
    }
}

namespace pg8 {
#define PG8_LAS __attribute__((address_space(3)))
typedef unsigned short bf16_t;
typedef short bf16x8 __attribute__((ext_vector_type(8)));
typedef float f32x4 __attribute__((ext_vector_type(4)));
typedef unsigned u32x4 __attribute__((ext_vector_type(4)));
constexpr int BM = 256, BK = 64, HALF = 128, HTB = HALF * BK * 2  , STAGE_BYTES = 8 * HTB, NXCD = 8, WGM = 8;

__host__ __device__ __forceinline__ int lds_byte(int r, int c) { const int st = (r >> 4) * 2 + (c >> 5), rr = r & 15, cc = c & 31, ob = rr * 64 + cc * 2; return st * 1024 + (ob ^ (((ob >> 9) & 1) << 5)); }
__host__ __device__ __forceinline__ void stage_rc(int b, int& R, int& C) { const int st = b / 1024, sb = b % 1024, swz = sb ^ (((sb >> 9) & 1) << 5); R = (st >> 1) * 16 + swz / 64; C = (st & 1) * 32 + (swz % 64) / 2; }
__host__ __device__ __forceinline__ int perm32(int rho) { const int n = rho >> 4, i = rho & 15; return 8 * (i >> 2) + 4 * n + (i & 3); }

struct Unit { int pm, pn; };
struct Gemm { const bf16_t* A; const bf16_t* Bt; int M, N, K; const bf16_t* A2; int pn_split; };

struct StaticOrder {
    int nM, nN, nwg, G, c;
    __host__ __device__ void init(int M, int N, int G_, int c_) { nM = M / BM; nN = N / BM; nwg = nM * nN; G = G_; c = c_; }
    __host__ __device__ bool next(int i, Unit& u) const {
        const long L = (long)i * G + c; if (L >= nwg) return false;
        int wgid = (int)L; { const int q = nwg / NXCD, r = nwg % NXCD, xcd = wgid % NXCD, off = wgid / NXCD; wgid = (xcd < r ? xcd * (q + 1) : r * (q + 1) + (xcd - r) * q) + off; }
        const int nig = WGM * nN, gid = wgid / nig, fm = gid * WGM, gsz = (nM - fm) < WGM ? (nM - fm) : WGM;
        u.pm = fm + ((wgid % nig) % gsz); u.pn = (wgid % nig) / gsz; return true;
    }
    __device__ __forceinline__ void a_ready(const Unit&) const {}
    __device__ __forceinline__ void done(const Unit&) const {}
};
struct CountedOrder : StaticOrder {
    const unsigned* ready; unsigned need; unsigned* tmo;
    __device__ __forceinline__ void a_ready(const Unit& u) const {
        if (threadIdx.x < 64) {
            const unsigned long long t0 = __builtin_amdgcn_s_memrealtime(); unsigned polls = 0;
            while ((unsigned)__builtin_amdgcn_readfirstlane(__hip_atomic_load(ready + 64 * u.pm, __ATOMIC_RELAXED, __HIP_MEMORY_SCOPE_AGENT)) < need) {
                if ((++polls & 255u) == 0u && __builtin_amdgcn_readfirstlane(__hip_atomic_load(tmo, __ATOMIC_RELAXED, __HIP_MEMORY_SCOPE_AGENT)) != 0u) break;
                if (__builtin_amdgcn_s_memrealtime() - t0 > 2000000ull) {
                    if (threadIdx.x == 0) { unsigned expect = 0u; __hip_atomic_compare_exchange_strong(tmo + 1, &expect, 0x600u | (unsigned)(u.pm & 0xff), __ATOMIC_RELAXED, __ATOMIC_RELAXED, __HIP_MEMORY_SCOPE_AGENT); __hip_atomic_store(tmo, 1u, __ATOMIC_RELAXED, __HIP_MEMORY_SCOPE_AGENT); }
                    break; }
                __builtin_amdgcn_s_sleep(2); }
            __builtin_amdgcn_fence(__ATOMIC_ACQUIRE, "agent");
            asm volatile("s_waitcnt vmcnt(0)" ::: "memory");
        }
#if !defined(BROKEN_HOOK_NO_BARRIER)
        asm volatile("" ::: "memory"); __builtin_amdgcn_s_barrier(); asm volatile("" ::: "memory");
#endif
    }
};

__device__ __forceinline__ unsigned cvt_pk_bf16(float lo, float hi) { unsigned r; asm volatile("v_cvt_pk_bf16_f32 %0, %1, %2" : "=v"(r) : "v"(lo), "v"(hi)); return r; }
typedef float f32x2 __attribute__((ext_vector_type(2)));
__device__ __forceinline__ f32x2 gelu_pk(f32x2 v) {
    const f32x2 av = __builtin_elementwise_abs(v), d = av * 0.2316418882f + 1.0f;
    f32x2 t; t.x = __builtin_amdgcn_rcpf(d.x); t.y = __builtin_amdgcn_rcpf(d.y);
    f32x2 q = t * 0.5307027145f + (-0.7265760135f); q = q * t + 0.7107068705f; q = q * t + (-0.142248368f); q = q * t + 0.127414796f; q = q * t;
    const f32x2 s = (v * v) * (-0.72134752044f);
    f32x2 e; e.x = __builtin_amdgcn_exp2f(s.x); e.y = __builtin_amdgcn_exp2f(s.y);
    const f32x2 m = v * (q * e), r = v - m;
    f32x2 o; o.x = v.x < 0.f ? m.x : r.x; o.y = v.y < 0.f ? m.y : r.y; return o;
}

struct EpiF32 {
    static constexpr bool PERM = false, AFTER_DRAIN = false;
    float* C; int ldc; const float* bias;
    __device__ __forceinline__ void operator()(const f32x4 (&acc)[2][2][4][2], const Unit& u, int wr, int wc, int fr, int fq) const {
        const int row0 = u.pm * BM + wr * 64 + fr, col0 = u.pn * BM + wc * 32 + 4 * fq;
        f32x4 bv[2][2];
#pragma unroll
        for (int bj = 0; bj < 2; ++bj)
#pragma unroll
            for (int n = 0; n < 2; ++n) bv[bj][n] = bias ? *(const f32x4*)(bias + col0 + bj * HALF + n * 16) : (f32x4){0.f, 0.f, 0.f, 0.f};
#pragma unroll
        for (int ai = 0; ai < 2; ++ai)
#pragma unroll
            for (int m = 0; m < 4; ++m) { float* rowp = C + (size_t)(row0 + ai * HALF + m * 16) * ldc + col0;
#pragma unroll
                for (int bj = 0; bj < 2; ++bj)
#pragma unroll
                    for (int n = 0; n < 2; ++n) *(f32x4*)(rowp + bj * HALF + n * 16) = acc[ai][bj][m][n] + bv[bj][n]; }
    }
};
template <int ACT  > struct EpiBf16 {
    static constexpr bool PERM = true, AFTER_DRAIN = false;
    bf16_t* O; int ldc; const float* bias; int split_cols; size_t split_stride;
    __device__ __forceinline__ void operator()(const f32x4 (&acc)[2][2][4][2], const Unit& u, int wr, int wc, int fr, int fq) const {
        const int row0 = u.pm * BM + wr * 64 + fr; int colt = u.pn * BM; bf16_t* base = O;
        if (split_cols) { const int t = colt / split_cols; base += (size_t)t * split_stride; colt -= t * split_cols; }
        const int col0 = colt + wc * 32 + 8 * fq, bcol0 = u.pn * BM + wc * 32 + 8 * fq;
        f32x4 bv[2][2];
#pragma unroll
        for (int bj = 0; bj < 2; ++bj)
#pragma unroll
            for (int n = 0; n < 2; ++n) bv[bj][n] = bias ? *(const f32x4*)(bias + bcol0 + bj * HALF + 4 * n) : (f32x4){0.f, 0.f, 0.f, 0.f};
#pragma unroll
        for (int ai = 0; ai < 2; ++ai)
#pragma unroll
            for (int m = 0; m < 4; ++m) { bf16_t* rowp = base + (size_t)(row0 + ai * HALF + m * 16) * ldc + col0;
#pragma unroll
                for (int bj = 0; bj < 2; ++bj) { f32x4 v0 = acc[ai][bj][m][0] + bv[bj][0], v1 = acc[ai][bj][m][1] + bv[bj][1];
                    if (ACT == 1) { f32x2 a = gelu_pk((f32x2){v0[0], v0[1]}), b = gelu_pk((f32x2){v0[2], v0[3]}), c = gelu_pk((f32x2){v1[0], v1[1]}), d = gelu_pk((f32x2){v1[2], v1[3]});
                        v0 = (f32x4){a.x, a.y, b.x, b.y}; v1 = (f32x4){c.x, c.y, d.x, d.y}; }
                    if (ACT == 2) {
#pragma unroll
                        for (int j = 0; j < 4; ++j) { v0[j] = 0.5f * v0[j] * (1.0f + erff(v0[j] * 0.70710678f)); v1[j] = 0.5f * v1[j] * (1.0f + erff(v1[j] * 0.70710678f)); } }
                    u32x4 w; w.x = cvt_pk_bf16(v0[0], v0[1]); w.y = cvt_pk_bf16(v0[2], v0[3]); w.z = cvt_pk_bf16(v1[0], v1[1]); w.w = cvt_pk_bf16(v1[2], v1[3]);
                    *(u32x4*)(rowp + bj * HALF) = w; } }
    }
};


template <class Epi, class Sched, bool STAMP = false>
__device__ __forceinline__ void gemm_phase(PG8_LAS unsigned char* lds, const Gemm g, const Sched& S, const Epi& E, unsigned long long* stamps) {
    const int tid = threadIdx.x, wid = __builtin_amdgcn_readfirstlane(tid >> 6), lane = tid & 63, wr = wid >> 2, wc = wid & 3, fr = lane & 15, fq = lane >> 4;
    const int K = g.K, nt = K / BK;
    int ts_lo = 0, ts_hi = 0, nts = 0; const unsigned long long rt_entry = STAMP ? (unsigned long long)wall_clock64() : 0ull;
#define PG8_STAMP() do { if (STAMP && wid == 0 && nts < 64) { const unsigned long long _c = (unsigned long long)clock64(); \
        ts_lo = (lane == nts) ? (int)(unsigned)_c : ts_lo; ts_hi = (lane == nts) ? (int)(unsigned)(_c >> 32) : ts_hi; ++nts; } } while (0)
    PG8_STAMP();
    unsigned voffA[2], voffB[2];
#pragma unroll
    for (int i = 0; i < 2; ++i) { int R, C; stage_rc(tid * 16 + i * 8192, R, C); const int Rb = Epi::PERM ? ((R & ~31) + perm32(R & 31)) : R;
        voffA[i] = (unsigned)(R * K + C) * 2u; voffB[i] = (unsigned)(Rb * K + C) * 2u; }
    const size_t kstep = (size_t)(BK * 2);
    const size_t hstep = (size_t)HALF * K * 2;
    const size_t tstep = 2 * hstep;
    const unsigned ldsw = (unsigned)wid * 1024u;
    const int aoff = lds_byte(wr * 64 + fr, fq * 8), boff = lds_byte(wc * 32 + fr, fq * 8);
#define PG8_SA(b, h) (((b) * 2 + (h)) * HTB)
#define PG8_SB(b, h) ((4 + (b) * 2 + (h)) * HTB)
#define PG8_STAGE(bufoff, gbase, voff) do { _Pragma("unroll") for (int _i = 0; _i < 2; ++_i) \
        __builtin_amdgcn_global_load_lds((const unsigned*)((const char*)(gbase) + (voff)[_i]), (PG8_LAS unsigned*)(lds + (bufoff) + ldsw + _i * 8192), 16, 0, 0); } while (0)
#define PG8_LDA(dst, b, h) do { _Pragma("unroll") for (int m = 0; m < 4; ++m) _Pragma("unroll") for (int k = 0; k < 2; ++k) dst[m][k] = *(const PG8_LAS bf16x8*)(lds + PG8_SA(b, h) + aoff + m * 2048 + k * 1024); } while (0)
#define PG8_LDB(dst, b, h) do { _Pragma("unroll") for (int n = 0; n < 2; ++n) _Pragma("unroll") for (int k = 0; k < 2; ++k) dst[n][k] = *(const PG8_LAS bf16x8*)(lds + PG8_SB(b, h) + boff + n * 2048 + k * 1024); } while (0)
#define PG8_MMA(ai, bj, At, Bt) do { __builtin_amdgcn_s_setprio(1); _Pragma("unroll") for (int m = 0; m < 4; ++m) _Pragma("unroll") for (int n = 0; n < 2; ++n) _Pragma("unroll") for (int k = 0; k < 2; ++k) \
        acc[ai][bj][m][n] = __builtin_amdgcn_mfma_f32_16x16x32_bf16(Bt[n][k], At[m][k], acc[ai][bj][m][n], 0, 0, 0); __builtin_amdgcn_s_setprio(0); } while (0)
#define PG8_WAIT_V(n) asm volatile("s_waitcnt vmcnt(" #n ")" ::: "memory")
#define PG8_WAIT_L(n) asm volatile("s_waitcnt lgkmcnt(" #n ")" ::: "memory")
#define PG8_BAR __builtin_amdgcn_s_barrier()
#define PG8_SCHED __builtin_amdgcn_sched_barrier(0)
    Unit cur, nxt; int ui = 0;
    if (!S.next(0, cur)) return;
    f32x4 acc[2][2][4][2];
#pragma unroll
    for (int a = 0; a < 2; ++a)
#pragma unroll
        for (int b = 0; b < 2; ++b)
#pragma unroll
            for (int m = 0; m < 4; ++m)
#pragma unroll
                for (int n = 0; n < 2; ++n) acc[a][b][m][n] = (f32x4){0.f, 0.f, 0.f, 0.f};
    bf16x8 At[4][2], B0[2][2], B1[2][2];
    const char* cA = (const char*)(cur.pn >= g.pn_split ? g.A2 : g.A) + (size_t)cur.pm * tstep; const char* cB = (const char*)g.Bt + (size_t)cur.pn * tstep;
    S.a_ready(cur);
    PG8_STAGE(PG8_SB(0, 0), cB, voffB); PG8_STAGE(PG8_SA(0, 0), cA, voffA); PG8_STAGE(PG8_SB(0, 1), cB + hstep, voffB); PG8_STAGE(PG8_SA(0, 1), cA + hstep, voffA);
    if (wr == 1) PG8_BAR;
    PG8_WAIT_V(4); PG8_BAR;
    PG8_STAGE(PG8_SB(1, 0), cB + kstep, voffB); PG8_STAGE(PG8_SA(1, 0), cA + kstep, voffA); PG8_STAGE(PG8_SB(1, 1), cB + hstep + kstep, voffB);
    PG8_WAIT_V(6); PG8_BAR;
    PG8_STAMP();
    for (;;) {
        const bool has_next = S.next(ui + 1, nxt);
        const char* nA = has_next ? (const char*)(nxt.pn >= g.pn_split ? g.A2 : g.A) + (size_t)nxt.pm * tstep : cA; const char* nB = has_next ? (const char*)g.Bt + (size_t)nxt.pn * tstep : cB;
        for (int t = 0; t < nt; t += 2) {
            const bool last = (t == nt - 2);
            const char* a1 = cA + (size_t)(t + 1) * kstep;
            const char* a2 = last ? nA : cA + (size_t)(t + 2) * kstep; const char* b2 = last ? nB : cB + (size_t)(t + 2) * kstep;
            const char* a3 = a2 + kstep; const char* b3 = b2 + kstep;
            if (last && has_next) S.a_ready(nxt);
            PG8_LDB(B0, 0, 0); PG8_SCHED; PG8_LDA(At, 0, 0); PG8_STAGE(PG8_SA(1, 1), a1 + hstep, voffA);
            PG8_WAIT_L(8); PG8_BAR; PG8_WAIT_L(0); PG8_MMA(0, 0, At, B0); PG8_BAR; PG8_SCHED;
            PG8_LDB(B1, 0, 1); PG8_STAGE(PG8_SB(0, 0), b2, voffB);
            PG8_BAR; PG8_WAIT_L(0); PG8_MMA(0, 1, At, B1); PG8_BAR;
            PG8_LDA(At, 0, 1); PG8_STAGE(PG8_SA(0, 0), a2, voffA);
            PG8_BAR; PG8_WAIT_L(0); PG8_MMA(1, 0, At, B0); PG8_BAR; PG8_SCHED;
            PG8_STAGE(PG8_SB(0, 1), b2 + hstep, voffB);
            PG8_WAIT_V(6); PG8_BAR; PG8_MMA(1, 1, At, B1); PG8_BAR;
            PG8_LDB(B0, 1, 0); PG8_SCHED; PG8_LDA(At, 1, 0); PG8_STAGE(PG8_SA(0, 1), a2 + hstep, voffA);
            PG8_WAIT_L(8); PG8_BAR; PG8_WAIT_L(0); PG8_MMA(0, 0, At, B0); PG8_BAR; PG8_SCHED;
            PG8_LDB(B1, 1, 1); PG8_STAGE(PG8_SB(1, 0), b3, voffB);
            PG8_BAR; PG8_WAIT_L(0); PG8_MMA(0, 1, At, B1); PG8_BAR;
            PG8_LDA(At, 1, 1); PG8_STAGE(PG8_SA(1, 0), a3, voffA);
            PG8_BAR; PG8_WAIT_L(0); PG8_MMA(1, 0, At, B0); PG8_BAR; PG8_SCHED;
            PG8_STAGE(PG8_SB(1, 1), b3 + hstep, voffB);
            PG8_WAIT_V(6); PG8_BAR; PG8_MMA(1, 1, At, B1); PG8_BAR;
        }
        PG8_STAMP();
        if constexpr (!Epi::AFTER_DRAIN) { E(acc, cur, wr, wc, fr, fq); S.done(cur); }
        PG8_STAMP();
        if (!has_next) break;
#pragma unroll
        for (int a = 0; a < 2; ++a)
#pragma unroll
            for (int b = 0; b < 2; ++b)
#pragma unroll
                for (int m = 0; m < 4; ++m)
#pragma unroll
                    for (int n = 0; n < 2; ++n) acc[a][b][m][n] = (f32x4){0.f, 0.f, 0.f, 0.f};
        cur = nxt; cA = nA; cB = nB; ++ui;
    }
    PG8_WAIT_V(0);
    if (wr == 0) PG8_BAR;
    PG8_BAR;
    if constexpr (Epi::AFTER_DRAIN) { E.fused(acc, cur, wr, wc, fr, fq, lds, wid, lane); S.done(cur); }
    PG8_STAMP();
    if (STAMP && wid == 0) { stamps[lane] = lane < nts ? (((unsigned long long)(unsigned)ts_hi << 32) | (unsigned)ts_lo) : 0ull;
        if (lane == 62) stamps[62] = rt_entry; if (lane == 63) stamps[63] = (unsigned long long)wall_clock64(); }
#undef PG8_STAMP
#undef PG8_SA
#undef PG8_SB
#undef PG8_STAGE
#undef PG8_LDA
#undef PG8_LDB
#undef PG8_MMA
#undef PG8_WAIT_V
#undef PG8_WAIT_L
#undef PG8_BAR
#undef PG8_SCHED
}
}

struct TileSched {
  int xcd, local, vbid, vnb, MT, NT, SM, SN, j, snc;
  bool swz;
  DEVI TileSched(int bid, int nb, int half, int MT_, int NT_, int SM_, int SN_) : MT(MT_), NT(NT_), SM(SM_), SN(SN_), j(0) {
    xcd = bid & 7;
    local = (bid >> 3) * 2 + half;
    vbid = bid * 2 + half;
    vnb = nb * 2;
    swz = (vnb == 8 * SM * SN) && ((nb & 7) == 0);
    snc = (NT + SN - 1) / SN;
  }
  DEVI int next(int& mt, int& nt) {
    if (swz) {
      const int s = j * 8 + xcd;
      ++j;
      const int sm = s / snc, sn = s - sm * snc;
      if (sm * SM >= MT) return 0;
      mt = sm * SM + local / SN;
      nt = sn * SN + local % SN;
      return (mt < MT && nt < NT) ? 1 : 2;
    } else {
      const int it = vbid + j * vnb;
      ++j;
      if (it >= MT * NT) return 0;
      mt = it / NT;
      nt = it - mt * NT;
      return 1;
    }
  }
};

struct ALoadPlain {
  typedef uint4 Raw;
  static constexpr bool kFat = false;
  static constexpr bool kConsec = false;
  const bfu* A;
  int lda;
  DEVI Raw load(int row, int k) const { return *(const uint4*)(A + (size_t)row * lda + k); }
  DEVI uint4 loadprev(int, int) const { return uint4{0u, 0u, 0u, 0u}; }
  DEVI uint4 asprev(const Raw&) const { return uint4{0u, 0u, 0u, 0u}; }
  DEVI uint4 finish(const Raw& r, const uint4&, int, int) const { return r; }
};

DEVI void transpose_tile(char* smem, const float* __restrict__ src, int Ns, bfu* __restrict__ dst, int ldd, int noff,
                         int k0, int n0) {
  float(*tile)[65] = (float(*)[65])smem;
  const int tid = TIDX;
  const int kr = tid >> 4, nc = (tid & 15) * 4;
#pragma unroll
  for (int p = 0; p < 4; ++p) {
    float4 v = *(const float4*)(src + (size_t)(k0 + kr + 16 * p) * Ns + n0 + nc);
    tile[kr + 16 * p][nc] = v.x;
    tile[kr + 16 * p][nc + 1] = v.y;
    tile[kr + 16 * p][nc + 2] = v.z;
    tile[kr + 16 * p][nc + 3] = v.w;
  }
  __syncthreads();
  const int nr = tid >> 3, kc = (tid & 7) * 8;
#pragma unroll
  for (int p = 0; p < 2; ++p) {
    const int n = nr + 32 * p;
    float f[8];
#pragma unroll
    for (int j = 0; j < 8; ++j) f[j] = tile[kc + j][n];
    *(uint4*)(dst + (size_t)(noff + n0 + n) * ldd + k0 + kc) = pack8(f);
  }
  __syncthreads();
}

DEVI void rms_row2_bf16(const float* __restrict__ src, const float* __restrict__ g, bfu* __restrict__ dst, int lane) {
  float4 v[2][4];
  float ss[2] = {0.f, 0.f};
#pragma unroll
  for (int r = 0; r < 2; ++r)
#pragma unroll
    for (int i = 0; i < 4; ++i) v[r][i] = *(const float4*)(src + r * 1024 + lane * 4 + 256 * i);
#pragma unroll
  for (int r = 0; r < 2; ++r)
#pragma unroll
    for (int i = 0; i < 4; ++i)
      ss[r] += v[r][i].x * v[r][i].x + v[r][i].y * v[r][i].y + v[r][i].z * v[r][i].z + v[r][i].w * v[r][i].w;
#pragma unroll
  for (int r = 0; r < 2; ++r) {
    const float rinv = rsqrtf(wave_sum(ss[r]) * (1.f / 1024.f) + 1e-6f);
#pragma unroll
    for (int i = 0; i < 4; ++i) {
      const float4 gg = *(const float4*)(g + lane * 4 + 256 * i);
      uint2 o;
      o.x = pkbf(v[r][i].x * rinv * gg.x, v[r][i].y * rinv * gg.y);
      o.y = pkbf(v[r][i].z * rinv * gg.z, v[r][i].w * rinv * gg.w);
      *(uint2*)(dst + r * 1024 + lane * 4 + 256 * i) = o;
    }
  }
}

DEVI void phase0(const Params& p, char* smem, int bid, int nb) {
  constexpr int NT_IN = 16 * 56, NT_SQ = 256, NT_SM = 16;
  constexpr int c0 = NT_IN, c1 = c0 + NT_SQ, c2 = c1 + 4 * NT_SQ, c3 = c2 + NT_SM, c4 = c3 + NT_SM, c5 = c4 + NT_SQ,
                c6 = c5 + NT_SM, c7 = c6 + NT_SM, c8 = c7 + 2, c9 = c8 + T_TOK / 8;
  smem += HF * HALF_SMEM;
  for (int it = bid * 2 + HF; it < c9; it += nb * 2) {
    if (it < c0) {
      transpose_tile(smem, p.w_in, 3584, p.WT_in, 1024, 0, (it / 56) * 64, (it % 56) * 64);
    } else if (it < c1) {
      int j = it - c0;
      transpose_tile(smem, p.w_out, 1024, p.WT_out, 1024, 0, (j >> 4) * 64, (j & 15) * 64);
    } else if (it < c2) {
      int j = it - c1;
      int w = j >> 8;
      j &= 255;
      const float* src = (w == 0) ? p.wr : (w == 1) ? p.wk : (w == 2) ? p.wv : p.wg;
      transpose_tile(smem, src, 1024, p.WT_3, 1024, w * 1024, (j >> 4) * 64, (j & 15) * 64);
    } else if (it < c3) {
      int j = it - c2;
      transpose_tile(smem, p.w1, 64, p.WT_3, 1024, 4096, j * 64, 0);
    } else if (it < c4) {
      int j = it - c3;
      transpose_tile(smem, p.a1, 64, p.WT_3, 1024, 4224, j * 64, 0);
    } else if (it < c5) {
      int j = it - c4;
      transpose_tile(smem, p.wo, 1024, p.WT_o, 1024, 0, (j >> 4) * 64, (j & 15) * 64);
    } else if (it < c6) {
      int j = it - c5;
      transpose_tile(smem, p.w2, 1024, p.W2T, 64, 0, 0, j * 64);
    } else if (it < c7) {
      int j = it - c6;
      transpose_tile(smem, p.a2, 1024, p.A2T, 64, 0, 0, j * 64);
    } else if (it < c8) {
      int j = it - c7;
      bfu* dst = p.WT_3 + (size_t)(j == 0 ? 4160 : 4288) * 1024;
      for (int e = TIDX; e < 64 * 1024 / 8; e += 256) *(uint4*)(dst + e * 8) = uint4{0, 0, 0, 0};
    } else {
      int row = (it - c8) * 8 + (TIDX >> 6) * 2;
      rms_row2_bf16(p.x + (size_t)row * 1024, p.ln_even, p.H + (size_t)row * 1024, TIDX & 63);
    }
  }
}

struct PgEpi1 {
  static constexpr bool PERM = true, AFTER_DRAIN = false;
  const Params* p;
  DEVI void operator()(const pg8::f32x4 (&acc)[2][2][4][2], const pg8::Unit& u, int wr, int wc, int fr, int fq) const {
    const int row0 = u.pm * 256 + wr * 64 + fr;
    const int seg = u.pn;
#pragma unroll
    for (int ai = 0; ai < 2; ++ai)
#pragma unroll
      for (int m = 0; m < 4; ++m) {
        const int row = row0 + ai * 128 + m * 16;
#pragma unroll
        for (int bj = 0; bj < 2; ++bj) {
          const int col = u.pn * 256 + bj * 128 + wc * 32 + 8 * fq;
          const f32x4 v0 = acc[ai][bj][m][0], v1 = acc[ai][bj][m][1];
          if (seg < 2) {
            uint4 w;
            w.x = pkbf(gelu_(v0[0]), gelu_(v0[1])); w.y = pkbf(gelu_(v0[2]), gelu_(v0[3]));
            w.z = pkbf(gelu_(v1[0]), gelu_(v1[1])); w.w = pkbf(gelu_(v1[2]), gelu_(v1[3]));
            *(uint4*)(p->U + (size_t)row * 512 + col) = w;
          } else if (seg < 4) {
            const int g = (col - 512) >> 7, c0 = col & 127, chunk = row >> 7, s = row & 127;
            bfu* base = p->GVT + ((size_t)((chunk * 4 + g) * 128 + c0)) * 128 + s;
#pragma unroll
            for (int e = 0; e < 4; ++e) {
              base[(size_t)e * 128] = (bfu)f2bf(gelu_(v0[e]));
              base[(size_t)(e + 4) * 128] = (bfu)f2bf(gelu_(v1[e]));
            }
          } else if (seg < 8) {
            uint4 w;
            w.x = pkbf(v0[0], v0[1]); w.y = pkbf(v0[2], v0[3]); w.z = pkbf(v1[0], v1[1]); w.w = pkbf(v1[2], v1[3]);
            bfu* dst = (seg < 6) ? p->Q + (size_t)row * 512 + (col - 1024) : p->K + (size_t)row * 512 + (col - 1536);
            *(uint4*)dst = w;
          } else if (seg < 10) {
            const int cc = col - 2048, hh = cc >> 6, dim0 = cc & 63;
            const int b = row >> 14, s = row & (SEQ - 1);
            bfu* base = p->VT + ((size_t)((b * 8 + hh) * 64 + dim0)) * SEQ;
            const size_t PST = (size_t)16 * 64 * SEQ;
            const int o1 = (s & 3) * (SEQ / 4) + (s >> 2), o2 = (s & 15) * (SEQ / 16) + (s >> 4);
#pragma unroll
            for (int e = 0; e < 8; ++e) {
              const bfu val = (bfu)f2bf(e < 4 ? v0[e & 3] : v1[e & 3]);
              bfu* bd = base + (size_t)e * SEQ;
              bd[s] = val;
              bd[PST + o1] = val;
              bd[2 * PST + o2] = val;
            }
          } else {
            uint4 w;
            w.x = pkbf(silu_(v0[0]), silu_(v0[1])); w.y = pkbf(silu_(v0[2]), silu_(v0[3]));
            w.z = pkbf(silu_(v1[0]), silu_(v1[1])); w.w = pkbf(silu_(v1[2]), silu_(v1[3]));
            *(uint4*)(p->SZ + (size_t)row * 1024 + (col - 2560)) = w;
          }
        }
      }
  }
};
struct PgEpiRes {
  static constexpr bool PERM = false, AFTER_DRAIN = false;
  const float* base;
  float* out;
  DEVI void operator()(const pg8::f32x4 (&acc)[2][2][4][2], const pg8::Unit& u, int wr, int wc, int fr, int fq) const {
    const int row0 = u.pm * 256 + wr * 64 + fr, col0 = u.pn * 256 + wc * 32 + 4 * fq;
#pragma unroll
    for (int ai = 0; ai < 2; ++ai)
#pragma unroll
      for (int m = 0; m < 4; ++m) {
        const size_t rb = (size_t)(row0 + ai * 128 + m * 16) * 1024 + col0;
#pragma unroll
        for (int bj = 0; bj < 2; ++bj)
#pragma unroll
          for (int n = 0; n < 2; ++n) {
            const size_t idx = rb + bj * 128 + n * 16;
            const f32x4 b = *(const f32x4*)(base + idx);
            *(f32x4*)(out + idx) = acc[ai][bj][m][n] + b;
          }
      }
  }
};
template <class Epi>
DEVI void pg_gemm(char* smem, const bfu* A, const bfu* Bt, int M, int N, int K, const Epi& E, int bid, int nb) {
  pg8::Gemm g{A, Bt, M, N, K, A, 1 << 30};
  pg8::StaticOrder S;
  S.init(M, N, nb, bid);
  pg8::gemm_phase<Epi, pg8::StaticOrder, false>((PG8_LAS unsigned char*)smem, g, S, E, nullptr);
}
template <class Epi>
DEVI void pg_gemm2(char* smem, const bfu* A, const bfu* A2, int pn_split, const bfu* Bt, int M, int N, int K, const Epi& E,
                   int bid, int nb) {
  pg8::Gemm g{A, Bt, M, N, K, A2, pn_split};
  pg8::StaticOrder S;
  S.init(M, N, nb, bid);
  pg8::gemm_phase<Epi, pg8::StaticOrder, false>((PG8_LAS unsigned char*)smem, g, S, E, nullptr);
}
struct PgEpi3 {
  static constexpr bool PERM = true, AFTER_DRAIN = false;
  bfu* O0;
  bfu* O1;
  int silu1;
  DEVI void operator()(const pg8::f32x4 (&acc)[2][2][4][2], const pg8::Unit& u, int wr, int wc, int fr, int fq) const {
    const int row0 = u.pm * 256 + wr * 64 + fr;
    const int grp = u.pn >> 2;
    bfu* O = grp ? O1 : O0;
    const bool act = grp && silu1;
    const int colb = (u.pn & 3) * 256 + wc * 32 + 8 * fq;
#pragma unroll
    for (int ai = 0; ai < 2; ++ai)
#pragma unroll
      for (int m = 0; m < 4; ++m) {
        bfu* rowp = O + (size_t)(row0 + ai * 128 + m * 16) * 1024 + colb;
#pragma unroll
        for (int bj = 0; bj < 2; ++bj) {
          f32x4 v0 = acc[ai][bj][m][0], v1 = acc[ai][bj][m][1];
          if (act) {
#pragma unroll
            for (int e = 0; e < 4; ++e) {
              v0[e] = silu_(v0[e]);
              v1[e] = silu_(v1[e]);
            }
          }
          uint4 w;
          w.x = pkbf(v0[0], v0[1]); w.y = pkbf(v0[2], v0[3]); w.z = pkbf(v1[0], v1[1]); w.w = pkbf(v1[2], v1[3]);
          *(uint4*)(rowp + bj * 128) = w;
        }
      }
  }
};

DEVI void phase1(const Params& p, char* smem, int bid, int nb) {
  PgEpi1 E{&p};
  pg_gemm(smem, p.H, p.WT_in, T_TOK, 3584, 1024, E, bid, nb);
}

struct ALoadWs {
  struct Raw { float4 a, b; };
  static constexpr bool kFat = true;
  static constexpr bool kConsec = false;
  const float* ws;
  const float* rinv;
  DEVI Raw load(int t, int s0) const {
    Raw r;
    r.a = *(const float4*)(ws + t * 128 + s0);
    r.b = *(const float4*)(ws + t * 128 + s0 + 4);
    return r;
  }
  DEVI uint4 loadprev(int, int) const { return uint4{0u, 0u, 0u, 0u}; }
  DEVI uint4 asprev(const Raw&) const { return uint4{0u, 0u, 0u, 0u}; }
  DEVI uint4 finish(const Raw& r, const uint4&, int t, int s0) const {
    float f[8] = {r.a.x, r.a.y, r.a.z, r.a.w, r.b.x, r.b.y, r.b.z, r.b.w};
#pragma unroll
    for (int j = 0; j < 8; ++j) f[j] = (s0 + j <= t) ? f[j] * rinv[s0 + j] : 0.f;
    return pack8(f);
  }
};
struct EpiGm {
  const Params* p;
  int chunk, g;
  DEVI void operator()(int t, int c, f32x4 v) const {
    const float4 gn = *(const float4*)(p->gm_norm + g * 128 + c);
    const float bias = p->gm_b[g * 128 + t];
    const size_t tok = (size_t)chunk * 128 + t;
    float u[4], sz[4];
    unpack4(*(const uint2*)(p->U + tok * 512 + g * 128 + c), u);
    unpack4(*(const uint2*)(p->SZ + tok * 1024 + g * 128 + c), sz);
    uint2 o;
    o.x = pkbf(u[0] * (v[0] * gn.x + bias) * sz[0], u[1] * (v[1] * gn.y + bias) * sz[1]);
    o.y = pkbf(u[2] * (v[2] * gn.z + bias) * sz[2], u[3] * (v[3] * gn.w + bias) * sz[3]);
    *(uint2*)(p->Y + tok * 1024 + g * 128 + c) = o;
  }
};

DEVI void gmlp_item(const Params& p, char* smem, int item) {
  const int chunk = item >> 2, g = item & 3;
  const bfu* gv = p.GVT + (size_t)item * 128 * 128;
  float* rinv = (float*)(smem + 2 * GSTAGE_BYTES);
  const int tid = TIDX;
  {
    float* sred = rinv + 128;
    const int s4 = (tid & 31) * 4, cg = tid >> 5;
    uint2 raw[16];
#pragma unroll
    for (int i = 0; i < 16; ++i) raw[i] = *(const uint2*)(gv + (cg * 16 + i) * 128 + s4);
    float ss[4] = {0.f, 0.f, 0.f, 0.f};
#pragma unroll
    for (int i = 0; i < 16; ++i) {
      float f[4];
      unpack4(raw[i], f);
#pragma unroll
      for (int j = 0; j < 4; ++j) ss[j] += f[j] * f[j];
    }
    *(float4*)(sred + cg * 128 + s4) = float4{ss[0], ss[1], ss[2], ss[3]};
    __syncthreads();
    if (tid < 128) {
      float t = 0.f;
#pragma unroll
      for (int i = 0; i < 8; ++i) t += sred[i * 128 + tid];
      rinv[tid] = rsqrtf(t * (1.f / 128.f) + 1e-6f);
    }
  }
  __syncthreads();
  ALoadWs al{p.gm_ws + (size_t)g * 128 * 128, rinv};
  EpiGm epi{&p, chunk, g};
  gemm_tile(smem, al, gv, 128, 128, 0, 0, epi);
}

DEVI void attn_item(const Params& p, char* smem, int item) {
  const int qb = item & 63, bh = item >> 6, b = bh >> 3, h = bh & 7;
  const int q0 = qb * 256;
  bfu* Ob = (bfu*)smem;
  float* Mb = (float*)(smem + 32768);
  float* Lb = Mb + 256;
  const int tid = threadIdx.x, lane = tid & 63, wid = tid >> 6;
  const int qi = lane & 15, g = lane >> 4;
  const float slope = exp2f(-(float)(h + 1));
  const size_t tokb = (size_t)b * SEQ;
#pragma unroll 1
  for (int pi = 0; pi < 3; ++pi) {
    const int dshift = 2 * pi, d = 1 << dshift;
    const bfu* VT = p.VT + (size_t)pi * ((size_t)16 * 64 * SEQ) + (size_t)bh * 64 * SEQ;
#pragma unroll 1
    for (int u = wid; u < 16; u += 8) {
      const int r = u & (d - 1), tile = u >> dshift;
      const int sq0 = (q0 >> dshift) + tile * 16;
      const int sk0 = sq0 - 144;
      const int posq = ((sq0 + qi) << dshift) + r;
      const bfu* qp = p.Q + (tokb + posq) * 512 + h * 64 + g * 8;
      const bf16x8 qf0 = *(const bf16x8*)qp, qf1 = *(const bf16x8*)(qp + 32);
      const bfu* kbase = p.K + (tokb + r) * 512 + h * 64 + g * 8;
      const bfu* vbase = VT + (size_t)qi * SEQ + r * (SEQ >> dshift);
      bf16x8 kf[2][2];
      uint2 vf[4][2];
      auto loadkv = [&](int it) {
#pragma unroll
        for (int tt = 0; tt < 2; ++tt) {
          int sk = sk0 + (2 * it + tt) * 16 + qi;
          sk = sk < 0 ? 0 : sk;
          const bfu* kp = kbase + ((size_t)sk << dshift) * 512;
          kf[tt][0] = *(const bf16x8*)kp;
          kf[tt][1] = *(const bf16x8*)(kp + 32);
        }
        int kidx0 = sk0 + 32 * it + 4 * g, kidx1 = kidx0 + 16;
        kidx0 = kidx0 < 0 ? 0 : kidx0;
        kidx1 = kidx1 < 0 ? 0 : kidx1;
#pragma unroll
        for (int m = 0; m < 4; ++m) {
          vf[m][0] = *(const uint2*)(vbase + (size_t)(16 * m) * SEQ + kidx0);
          vf[m][1] = *(const uint2*)(vbase + (size_t)(16 * m) * SEQ + kidx1);
        }
      };
      loadkv(0);
      float mrun = -1e30f, l = 0.f;
      f32x4 O[4];
#pragma unroll
      for (int m = 0; m < 4; ++m) O[m] = f32x4{0.f, 0.f, 0.f, 0.f};
#pragma unroll 1
      for (int it = 0; it < 5; ++it) {
        bf16x8 ck[2][2];
        uint2 cv[4][2];
#pragma unroll
        for (int a = 0; a < 2; ++a)
#pragma unroll
          for (int c = 0; c < 2; ++c) ck[a][c] = kf[a][c];
#pragma unroll
        for (int m = 0; m < 4; ++m) {
          cv[m][0] = vf[m][0];
          cv[m][1] = vf[m][1];
        }
        if (it < 4) loadkv(it + 1);
        f32x4 S[2];
#pragma unroll
        for (int tt = 0; tt < 2; ++tt) {
          f32x4 z = {0.f, 0.f, 0.f, 0.f};
          z = __builtin_amdgcn_mfma_f32_16x16x32_bf16(ck[tt][0], qf0, z, 0, 0, 0);
          z = __builtin_amdgcn_mfma_f32_16x16x32_bf16(ck[tt][1], qf1, z, 0, 0, 0);
          S[tt] = z;
        }
        float mx = -INFINITY;
#pragma unroll
        for (int tt = 0; tt < 2; ++tt)
#pragma unroll
          for (int e = 0; e < 4; ++e) {
            const int kk = (2 * it + tt) * 16 + 4 * g + e;
            const int j = 144 + qi - kk;
            const bool valid = (j >= 0) && (j <= 128) && (sk0 + kk >= 0);
            const float sv = valid ? S[tt][e] * 0.125f - slope * (float)(j << dshift) : -INFINITY;
            S[tt][e] = sv;
            mx = fmaxf(mx, sv);
          }
        mx = fmaxf(mx, __shfl_xor(mx, 16));
        mx = fmaxf(mx, __shfl_xor(mx, 32));
        const float mnew = fmaxf(mrun, mx);
        const float alpha = __expf(mrun - mnew);
        mrun = mnew;
        float ls = 0.f;
#pragma unroll
        for (int tt = 0; tt < 2; ++tt)
#pragma unroll
          for (int e = 0; e < 4; ++e) {
            const float pe = __expf(S[tt][e] - mnew);
            S[tt][e] = pe;
            ls += pe;
          }
        l = l * alpha + ls;
        uint4 pk;
        pk.x = pkbf(S[0][0], S[0][1]);
        pk.y = pkbf(S[0][2], S[0][3]);
        pk.z = pkbf(S[1][0], S[1][1]);
        pk.w = pkbf(S[1][2], S[1][3]);
        const bf16x8 pf = __builtin_bit_cast(bf16x8, pk);
#pragma unroll
        for (int m = 0; m < 4; ++m) {
          O[m] *= alpha;
          const uint4 vv = {cv[m][0].x, cv[m][0].y, cv[m][1].x, cv[m][1].y};
          O[m] = __builtin_amdgcn_mfma_f32_16x16x32_bf16(__builtin_bit_cast(bf16x8, vv), pf, O[m], 0, 0, 0);
        }
      }
      l += __shfl_xor(l, 16);
      l += __shfl_xor(l, 32);
      const float mx = mrun;
      const float il = 1.f / l;
      const int ql = ((tile * 16 + qi) << dshift) + r;
      float wo = 0.f, wn = 1.f;
      float mnew = mx, lnew = l;
      if (pi > 0) {
        const float mo = Mb[ql], lo = Lb[ql];
        mnew = fmaxf(mo, mx);
        wo = lo * __expf(mo - mnew);
        wn = l * __expf(mx - mnew);
        lnew = wo + wn;
        const float inv = 1.f / lnew;
        wo *= inv;
        wn *= inv;
      }
      wn *= il;
#pragma unroll
      for (int m = 0; m < 4; ++m) {
        bfu* op = Ob + ql * 64 + 16 * m + 4 * g;
        float o[4];
        if (pi > 0) {
          const uint2 ov = *(const uint2*)op;
          o[0] = wo * bf2f(ov.x & 0xffffu) + wn * O[m][0];
          o[1] = wo * bf2f(ov.x >> 16) + wn * O[m][1];
          o[2] = wo * bf2f(ov.y & 0xffffu) + wn * O[m][2];
          o[3] = wo * bf2f(ov.y >> 16) + wn * O[m][3];
        } else {
#pragma unroll
          for (int e = 0; e < 4; ++e) o[e] = wn * O[m][e];
        }
        if (pi < 2) {
          uint2 w;
          w.x = pkbf(o[0], o[1]);
          w.y = pkbf(o[2], o[3]);
          *(uint2*)op = w;
        } else {
          const size_t oi = (tokb + q0 + ql) * 1024 + 512 + h * 64 + 16 * m + 4 * g;
          const uint2 sz = *(const uint2*)(p.SZ + oi);
          uint2 w;
          w.x = pkbf(o[0] * bf2f(sz.x & 0xffffu), o[1] * bf2f(sz.x >> 16));
          w.y = pkbf(o[2] * bf2f(sz.y & 0xffffu), o[3] * bf2f(sz.y >> 16));
          *(uint2*)(p.Y + oi) = w;
        }
      }
      if (pi < 2 && g == 0) {
        Mb[ql] = mnew;
        Lb[ql] = lnew;
      }
    }
    __syncthreads();
  }
}

DEVI void phase2(const Params& p, char* smem, int bid, int nb) {
  for (int it = bid; it < 16 * 64; it += nb) attn_item(p, smem, it);
  char* hs = smem + HF * HALF_SMEM;
  for (int it = bid * 2 + HF; it < (T_TOK / 128) * 4; it += nb * 2) gmlp_item(p, hs, it);
}

DEVI void phase3(const Params& p, char* smem, int bid, int nb) {
  PgEpiRes E{p.x, p.out};
  pg_gemm(smem, p.Y, p.WT_out, T_TOK, 1024, 1024, E, bid, nb);
}
DEVI void phase3b(const Params& p, int bid, int nb) {
  for (int it = bid; it < T_TOK / 16; it += nb) {
    const int row = it * 16 + (threadIdx.x >> 6) * 2;
    rms_row2_bf16(p.out + (size_t)row * 1024, p.ln_odd, p.H + (size_t)row * 1024, threadIdx.x & 63);
  }
}

struct ALoadMix {
  typedef uint4 Raw;
  static constexpr bool kFat = true;
  static constexpr bool kConsec = true;
  const bfu* H;
  const float* mu;
  DEVI Raw load(int row, int k) const { return *(const uint4*)(H + (size_t)row * 1024 + k); }
  DEVI uint4 loadprev(int row, int k) const {
    const int prow = ((row & (SEQ - 1)) != 0) ? row - 1 : row;
    return *(const uint4*)(H + (size_t)prow * 1024 + k);
  }
  DEVI uint4 asprev(const Raw& r) const { return r; }
  DEVI uint4 finish(const Raw& r, const uint4& pr, int row, int k) const {
    float c[8], pv[8];
    unpack8(r, c);
    unpack8(pr, pv);
    const float first = ((row & (SEQ - 1)) != 0) ? 1.f : 0.f;
    const float4 m0 = *(const float4*)(mu + k), m1 = *(const float4*)(mu + k + 4);
    const float mm[8] = {m0.x, m0.y, m0.z, m0.w, m1.x, m1.y, m1.z, m1.w};
#pragma unroll
    for (int j = 0; j < 8; ++j) c[j] = c[j] + (pv[j] * first - c[j]) * mm[j];
    return pack8(c);
  }
};
struct Epi4 {
  const Params* p;
  int nt;
  DEVI void operator()(int row, int col, f32x4 v) const {
    uint2 o;
    if (nt < 24) {
      o.x = pkbf(v[0], v[1]);
      o.y = pkbf(v[2], v[3]);
      bfu* dst = (nt < 8) ? p->R + (size_t)row * 1024 + col
                          : (nt < 16) ? p->K1 + (size_t)row * 1024 + col - 1024 : p->V1 + (size_t)row * 1024 + col - 2048;
      *(uint2*)dst = o;
    } else if (nt < 32) {
      o.x = pkbf(silu_(v[0]), silu_(v[1]));
      o.y = pkbf(silu_(v[2]), silu_(v[3]));
      *(uint2*)(p->SG + (size_t)row * 1024 + col - 3072) = o;
    } else if (nt == 32) {
      const int c = col - 4096;
      if (c < 64) {
        o.x = pkbf(tanh_(v[0]), tanh_(v[1]));
        o.y = pkbf(tanh_(v[2]), tanh_(v[3]));
        *(uint2*)(p->TW + (size_t)row * 64 + c) = o;
      }
    } else {
      const int c = col - 4224;
      if (c < 64) {
        o.x = pkbf(v[0], v[1]);
        o.y = pkbf(v[2], v[3]);
        *(uint2*)(p->TA + (size_t)row * 64 + c) = o;
      }
    }
  }
};
DEVI void phase4_tile(const Params& p, char* smem, int mt, int nt) {
  float* smu = (float*)(smem + 2 * GSTAGE_BYTES);
  const int mi = (nt < 8) ? 0 : (nt < 16) ? 2 : (nt < 24) ? 3 : (nt < 32) ? 5 : (nt == 32) ? 1 : 4;
  *(float4*)(smu + TIDX * 4) = *(const float4*)(p.mu + mi * 1024 + TIDX * 4);
  __syncthreads();
  ALoadMix al{p.H, smu};
  Epi4 epi{&p, nt};
  gemm_tile<1>(smem, al, p.WT_3, 1024, 1024, mt * 128, nt * 128, epi);
}
DEVI void phaseM(const Params& p, char* smem, int bid, int nb) {
  char* hs = smem + HF * HALF_SMEM;
  for (int it = bid * 2 + HF; it < (T_TOK / 128) * 2; it += nb * 2) phase4_tile(p, hs, it >> 1, 32 + (it & 1));
  const int tid = threadIdx.x;
  const int cc = (tid & 127) * 8, rsub = tid >> 7;
  float mr[8], mk[8], mv[8], mg[8];
  {
    const float4 a0 = *(const float4*)(p.mu + 0 * 1024 + cc), a1 = *(const float4*)(p.mu + 0 * 1024 + cc + 4);
    const float4 b0 = *(const float4*)(p.mu + 2 * 1024 + cc), b1 = *(const float4*)(p.mu + 2 * 1024 + cc + 4);
    const float4 c0 = *(const float4*)(p.mu + 3 * 1024 + cc), c1 = *(const float4*)(p.mu + 3 * 1024 + cc + 4);
    const float4 d0 = *(const float4*)(p.mu + 5 * 1024 + cc), d1 = *(const float4*)(p.mu + 5 * 1024 + cc + 4);
    mr[0] = a0.x; mr[1] = a0.y; mr[2] = a0.z; mr[3] = a0.w; mr[4] = a1.x; mr[5] = a1.y; mr[6] = a1.z; mr[7] = a1.w;
    mk[0] = b0.x; mk[1] = b0.y; mk[2] = b0.z; mk[3] = b0.w; mk[4] = b1.x; mk[5] = b1.y; mk[6] = b1.z; mk[7] = b1.w;
    mv[0] = c0.x; mv[1] = c0.y; mv[2] = c0.z; mv[3] = c0.w; mv[4] = c1.x; mv[5] = c1.y; mv[6] = c1.z; mv[7] = c1.w;
    mg[0] = d0.x; mg[1] = d0.y; mg[2] = d0.z; mg[3] = d0.w; mg[4] = d1.x; mg[5] = d1.y; mg[6] = d1.z; mg[7] = d1.w;
  }
#pragma unroll 1
  for (int it = bid; it < T_TOK / 8; it += nb) {
    const int ra = it * 8 + rsub, rb = ra + 4;
    const size_t oa = (size_t)ra * 1024 + cc, ob = (size_t)rb * 1024 + cc;
    const uint4 ca = *(const uint4*)(p.H + oa), cb = *(const uint4*)(p.H + ob);
    const uint4 pa = *(const uint4*)(p.H + (((ra & (SEQ - 1)) != 0) ? oa - 1024 : oa));
    const uint4 pb = *(const uint4*)(p.H + ob - 1024);
    const float fa = ((ra & (SEQ - 1)) != 0) ? 1.f : 0.f;
#pragma unroll
    for (int half = 0; half < 2; ++half) {
      float c[8], d[8], o[8];
      unpack8(half ? cb : ca, c);
      unpack8(half ? pb : pa, d);
      const float f = half ? 1.f : fa;
      const size_t oo = half ? ob : oa;
#pragma unroll
      for (int j = 0; j < 8; ++j) d[j] = d[j] * f - c[j];
#pragma unroll
      for (int j = 0; j < 8; ++j) o[j] = c[j] + d[j] * mr[j];
      *(uint4*)(p.XR + oo) = pack8(o);
#pragma unroll
      for (int j = 0; j < 8; ++j) o[j] = c[j] + d[j] * mk[j];
      *(uint4*)(p.XK + oo) = pack8(o);
#pragma unroll
      for (int j = 0; j < 8; ++j) o[j] = c[j] + d[j] * mv[j];
      *(uint4*)(p.XV + oo) = pack8(o);
#pragma unroll
      for (int j = 0; j < 8; ++j) o[j] = c[j] + d[j] * mg[j];
      *(uint4*)(p.XG + oo) = pack8(o);
    }
  }
}
DEVI void phase3a(const Params& p, char* smem, int bid, int nb) {
  PgEpi3 E{p.R, p.K1, 0};
  pg_gemm2(smem, p.XR, p.XK, 4, p.WT_3, T_TOK, 2048, 1024, E, bid, nb);
}
DEVI void phase3c(const Params& p, char* smem, int bid, int nb) {
  PgEpi3 E{p.V1, p.SG, 1};
  pg_gemm2(smem, p.XV, p.XG, 4, p.WT_3 + (size_t)2048 * 1024, T_TOK, 2048, 1024, E, bid, nb);
}

struct Epi5w {
  const Params* p;
  DEVI void operator()(int row, int col, f32x4 v) const {
    const float4 w0 = *(const float4*)(p->w0 + col);
    const float k = 0.6065306597126334f;
    uint2 o;
    o.x = pkbf(k * sigmoid_(w0.x + v[0]), k * sigmoid_(w0.y + v[1]));
    o.y = pkbf(k * sigmoid_(w0.z + v[2]), k * sigmoid_(w0.w + v[3]));
    *(uint2*)(p->EW + (size_t)row * 1024 + col) = o;
  }
};
struct Epi5a {
  const Params* p;
  DEVI void operator()(int row, int col, f32x4 v) const {
    const float4 a0 = *(const float4*)(p->a0 + col);
    uint2 o;
    o.x = pkbf(sigmoid_(a0.x + v[0]), sigmoid_(a0.y + v[1]));
    o.y = pkbf(sigmoid_(a0.z + v[2]), sigmoid_(a0.w + v[3]));
    *(uint2*)(p->AA + (size_t)row * 1024 + col) = o;
  }
};
DEVI void phase5(const Params& p, char* smem, int bid, int nb) {
  constexpr int N1 = (T_TOK / 128) * 8;
  char* hs = smem + HF * HALF_SMEM;
  for (int it = bid * 2 + HF; it < 2 * N1; it += nb * 2) {
    if (it < N1) {
      ALoadPlain al{p.TW, 64};
      Epi5w epi{&p};
      gemm_tile(hs, al, p.W2T, 64, 64, (it >> 3) * 128, (it & 7) * 128, epi);
    } else {
      const int j = it - N1;
      ALoadPlain al{p.TA, 64};
      Epi5a epi{&p};
      gemm_tile(hs, al, p.A2T, 64, 64, (j >> 3) * 128, (j & 7) * 128, epi);
    }
  }
}

DEVI void scanx_item(const Params& p, char* smem, int item) {
  const int bh = item & 31, c = item >> 5;
  const int b = bh >> 4, h = bh & 15;
  const size_t rowbase = ((size_t)b * SEQ + (size_t)c * 16) * 1024 + h * 64;
  float* sA = (float*)smem;
  float* sR = sA + 16 * 68;
  float* sBt = sR + 16 * 68;
  float* sKt = sBt + 16 * 68;
  float* sE = sKt + 16 * 68;
  float* sMab = sE + 16 * 64;
  float* sMak = sMab + 256;
  const int tid = TIDX;
  const int tau = tid >> 4, c4 = (tid & 15) * 4;
  const size_t o = rowbase + (size_t)tau * 1024 + c4;
  float r[4], k[4], ew[4], a[4], vv[4];
  unpack4(*(const uint2*)(p.R + o), r);
  unpack4(*(const uint2*)(p.K1 + o), k);
  unpack4(*(const uint2*)(p.EW + o), ew);
  unpack4(*(const uint2*)(p.AA + o), a);
  unpack4(*(const uint2*)(p.V1 + o), vv);
  float kk[4], kp[4], bb[4];
  float ss = 0.f, cf = 0.f;
#pragma unroll
  for (int j = 0; j < 4; ++j) {
    const int ch = h * 64 + c4 + j;
    kk[j] = k[j] * p.k_k[ch];
    ss += kk[j] * kk[j];
    kp[j] = k[j] * (1.f + (a[j] - 1.f) * p.k_a[ch]);
    cf += r[j] * kp[j] * p.r_k[ch];
  }
  ss = reduce16(ss);
  cf = reduce16(cf);
  const float rn = rsqrtf(fmaxf(ss, 1e-24f));
#pragma unroll
  for (int j = 0; j < 4; ++j) {
    kk[j] *= rn;
    bb[j] = kk[j] * a[j];
    sE[tau * 64 + c4 + j] = ew[j];
  }
  if ((tid & 15) == 0) p.COEF[((size_t)b * SEQ + (size_t)c * 16 + tau) * 16 + h] = cf;
  __syncthreads();
  float Li[4] = {0.f, 0.f, 0.f, 0.f}, L15[4] = {0.f, 0.f, 0.f, 0.f};
#pragma unroll
  for (int i = 0; i < 16; ++i) {
    const float4 e = *(const float4*)(sE + i * 64 + c4);
    const float m = (i <= tau) ? 1.f : 0.f;
    Li[0] += m * e.x; Li[1] += m * e.y; Li[2] += m * e.z; Li[3] += m * e.w;
    L15[0] += e.x; L15[1] += e.y; L15[2] += e.z; L15[3] += e.w;
  }
  float rt[4], bhat[4], khat[4];
#pragma unroll
  for (int j = 0; j < 4; ++j) {
    const float ep = __expf(Li[j]), em = __expf(-Li[j]), eh = __expf(-(L15[j] - Li[j]));
    const float at = -kk[j] * __expf(-(Li[j] - ew[j]));
    rt[j] = r[j] * em;
    sA[tau * 68 + c4 + j] = at;
    sR[tau * 68 + c4 + j] = rt[j];
    sBt[tau * 68 + c4 + j] = bb[j] * ep;
    sKt[tau * 68 + c4 + j] = kp[j] * ep;
    bhat[j] = bb[j] * eh;
    khat[j] = kp[j] * eh;
  }
  *(uint2*)(p.R + o) = pack4(rt);
#pragma unroll
  for (int j = 0; j < 4; ++j) {
    const int lin = (c4 + j) * 16 + tau;
    const size_t off = rowbase + (size_t)(lin >> 6) * 1024 + (lin & 63);
    p.EW[off] = (bfu)f2bf(bhat[j]);
    p.K1[off] = (bfu)f2bf(khat[j]);
    p.V1[off] = (bfu)f2bf(vv[j]);
  }
  if (tau == 0) {
    float4 gq = {__expf(-L15[0]), __expf(-L15[1]), __expf(-L15[2]), __expf(-L15[3])};
    *(float4*)(p.G15 + (size_t)item * 64 + c4) = gq;
  }
  __syncthreads();
  {
    const int i = tid >> 4, tq = tid & 15;
    float mab = 0.f, mak = 0.f, mrb = 0.f, mrk = 0.f;
#pragma unroll
    for (int kq = 0; kq < 64; kq += 4) {
      const float4 bi = *(const float4*)(sBt + i * 68 + kq);
      const float4 ki = *(const float4*)(sKt + i * 68 + kq);
      const float4 aq = *(const float4*)(sA + tq * 68 + kq);
      const float4 rq = *(const float4*)(sR + tq * 68 + kq);
      mab += bi.x * aq.x + bi.y * aq.y + bi.z * aq.z + bi.w * aq.w;
      mak += ki.x * aq.x + ki.y * aq.y + ki.z * aq.z + ki.w * aq.w;
      mrb += bi.x * rq.x + bi.y * rq.y + bi.z * rq.z + bi.w * rq.w;
      mrk += ki.x * rq.x + ki.y * rq.y + ki.z * rq.z + ki.w * rq.w;
    }
    if (!(i < tq)) { mab = 0.f; mak = 0.f; }
    if (!(i <= tq)) { mrb = 0.f; mrk = 0.f; }
    sMab[i * 16 + tq] = mab;
    sMak[i * 16 + tq] = mak;
    bfu* mr = p.MRT + (size_t)item * 512 + tq * 32 + (i >> 2) * 8 + (i & 3);
    mr[0] = (bfu)f2bf(mrb);
    mr[4] = (bfu)f2bf(mrk);
  }
  __syncthreads();
  if (tid < 80) {
    float x[16];
#pragma unroll
    for (int t = 0; t < 16; ++t) {
      float accv = (tid < 64) ? sA[t * 68 + tid] : sMak[(tid - 64) * 16 + t];
#pragma unroll
      for (int i = 0; i < t; ++i) accv += x[i] * sMab[i * 16 + t];
      x[t] = accv;
    }
    if (tid < 64) {
#pragma unroll
      for (int t = 0; t < 16; ++t) p.AA[rowbase + (size_t)t * 1024 + tid] = (bfu)f2bf(x[t]);
    } else {
#pragma unroll
      for (int t = 0; t < 16; ++t) p.GT[(size_t)item * 256 + t * 16 + (tid - 64)] = (bfu)f2bf(x[t]);
    }
  }
  __syncthreads();
}
DEVI void phase6x(const Params& p, char* smem, int bid, int nb) {
  char* hs = smem + HF * HALF_SMEM;
  for (int it = bid * 2 + HF; it < (SEQ / 16) * 32; it += nb * 2) scanx_item(p, hs, it);
}

DEVI bf16x8 mk8(uint2 a, uint2 b) {
  const uint4 v = {a.x, a.y, b.x, b.y};
  return __builtin_bit_cast(bf16x8, v);
}
DEVI uint2 packacc(f32x4 a) {
  uint2 r;
  r.x = pkbf(a[0], a[1]);
  r.y = pkbf(a[2], a[3]);
  return r;
}
constexpr int SCH = 6;
constexpr int SROW = 136;
constexpr int SARR = 16 * SROW;
constexpr int SOFF_GT = 5 * SARR;
constexpr int SOFF_MR = SOFF_GT + 512;
constexpr int SOFF_G15 = SOFF_MR + 1024;
constexpr int SIMG = SOFF_G15 + 256;
#define SCANS_LD5(P, I, O)                       \
    P##a##I = *(const uint4*)(p.AA + (O));       \
    P##r##I = *(const uint4*)(p.R + (O));        \
    P##e##I = *(const uint4*)(p.EW + (O));       \
    P##k##I = *(const uint4*)(p.K1 + (O));       \
    P##v##I = *(const uint4*)(p.V1 + (O));
#define SCANS_ISSUE(P, SC)                                                                           \
  {                                                                                                  \
    const size_t hb_ = ((size_t)b * SEQ) * 1024 + h * 64 + c80 * 8;                                  \
    const int tk0_ = (SC) * SCH * 16 + cl0 * 16 + row0;                                              \
    const int tk1_ = tk0_ + 32, tk2_ = tk0_ + 64;                                                    \
    SCANS_LD5(P, 0, hb_ + (size_t)(tk0_ < SEQ ? tk0_ : SEQ - 1) * 1024)                              \
    SCANS_LD5(P, 1, hb_ + (size_t)(tk1_ < SEQ ? tk1_ : SEQ - 1) * 1024)                              \
    SCANS_LD5(P, 2, hb_ + (size_t)(tk2_ < SEQ ? tk2_ : SEQ - 1) * 1024)                              \
    const int c0_ = (SC) * SCH;                                                                      \
    const size_t ib_ = (size_t)b * 16 + h;                                                           \
    const int tg_ = tid < 192 ? tid : 191;                                                           \
    const int cg_ = c0_ + (tg_ >> 5);                                                                \
    P##gm = *(const uint4*)(p.GT + ((size_t)(cg_ < SEQ / 16 ? cg_ : SEQ / 16 - 1) * 32 + ib_) * 256 + (tg_ & 31) * 8);  \
    const int t5_ = tid < 96 ? tid : 95;                                                             \
    const int c5_ = c0_ + (t5_ >> 4);                                                                \
    P##g5 = *(const uint4*)(p.G15 + ((size_t)(c5_ < SEQ / 16 ? c5_ : SEQ / 16 - 1) * 32 + ib_) * 64 + (t5_ & 15) * 4);  \
    const int cm_ = c0_ + (tid >> 6);                                                                \
    P##mr = *(const uint4*)(p.MRT + ((size_t)(cm_ < SEQ / 16 ? cm_ : SEQ / 16 - 1) * 32 + ib_) * 512 + (tid & 63) * 8); \
    const int tm_ = 256 + (tid & 127);                                                               \
    const int cs_ = c0_ + (tm_ >> 6);                                                                \
    P##ms = *(const uint4*)(p.MRT + ((size_t)(cs_ < SEQ / 16 ? cs_ : SEQ / 16 - 1) * 32 + ib_) * 512 + (tm_ & 63) * 8); \
  }
#define SCANS_ST5(P, I, B)                                                                           \
    *(uint2*)(B) = uint2{P##a##I.x, P##a##I.y};  *(uint2*)((B) + 8) = uint2{P##a##I.z, P##a##I.w};   \
    *(uint2*)((B) + SARR) = uint2{P##r##I.x, P##r##I.y};  *(uint2*)((B) + SARR + 8) = uint2{P##r##I.z, P##r##I.w};   \
    *(uint2*)((B) + 2 * SARR) = uint2{P##e##I.x, P##e##I.y};  *(uint2*)((B) + 2 * SARR + 8) = uint2{P##e##I.z, P##e##I.w};   \
    *(uint2*)((B) + 3 * SARR) = uint2{P##k##I.x, P##k##I.y};  *(uint2*)((B) + 3 * SARR + 8) = uint2{P##k##I.z, P##k##I.w};   \
    *(uint2*)((B) + 4 * SARR) = uint2{P##v##I.x, P##v##I.y};  *(uint2*)((B) + 4 * SARR + 8) = uint2{P##v##I.z, P##v##I.w};
#define SCANS_COMMIT(P)                                                                              \
  {                                                                                                  \
    char* b0_ = smem + cl0 * SIMG + row0 * SROW + c80 * 16;                                          \
    SCANS_ST5(P, 0, b0_)                                                                             \
    SCANS_ST5(P, 1, b0_ + 2 * SIMG)                                                                  \
    SCANS_ST5(P, 2, b0_ + 4 * SIMG)                                                                  \
    if (tid < 192) *(uint4*)(smem + (tid >> 5) * SIMG + SOFF_GT + (tid & 31) * 16) = P##gm;          \
    if (tid < 96) *(uint4*)(smem + (tid >> 4) * SIMG + SOFF_G15 + (tid & 15) * 16) = P##g5;          \
    *(uint4*)(smem + (tid >> 6) * SIMG + SOFF_MR + (tid & 63) * 16) = P##mr;                         \
    if (tid < 128) *(uint4*)(smem + ((256 + tid) >> 6) * SIMG + SOFF_MR + (tid & 63) * 16) = P##ms;  \
  }
#define SCANS_COMPUTE(SCI)                                                                           \
  _Pragma("unroll 1") for (int cl = 0; cl < SCH && (SCI) * SCH + cl < SEQ / 16; ++cl) {             \
    const char* img = smem + cl * SIMG;                                                              \
        \
    const uint2 vb = *(const uint2*)(img + 4 * SARR + vrow * SROW + vcol * 2);                       \
    const uint2 gt = *(const uint2*)(img + SOFF_GT + (q * 16 + 4 * g) * 2);                          \
    const char* wp = img + q * SROW + (4 * g) * 2;                                                   \
    const uint2 w00 = *(const uint2*)(wp), w01 = *(const uint2*)(wp + 32);                           \
    const uint2 w10 = *(const uint2*)(wp + 64), w11 = *(const uint2*)(wp + 96);                      \
    const uint2 r00 = *(const uint2*)(wp + SARR), r01 = *(const uint2*)(wp + SARR + 32);             \
    const uint2 r10 = *(const uint2*)(wp + SARR + 64), r11 = *(const uint2*)(wp + SARR + 96);        \
    const uint4 mr = *(const uint4*)(img + SOFF_MR + (q * 32 + g * 8) * 2);                          \
    uint2 bk0[4], bk1[4];                                                                            \
    float4 g15[4];                                                                                   \
    _Pragma("unroll") for (int n = 0; n < 4; ++n) {                                                  \
      const int ch = 16 * n + q;                                                                     \
      const char* bp = img + 2 * SARR + (ch >> 2) * SROW + ((ch & 3) * 16 + 4 * g) * 2;              \
      bk0[n] = *(const uint2*)(bp);                                                                  \
      bk1[n] = *(const uint2*)(bp + SARR);                                                           \
      g15[n] = *(const float4*)(img + SOFF_G15 + (16 * n + 4 * g) * 4);                              \
    }                                                                                                \
    __builtin_amdgcn_sched_barrier(0);                                                               \
    const bf16x8 sB0 = mk8(packacc(acc[0]), packacc(acc[1]));                                        \
    const bf16x8 sB1 = mk8(packacc(acc[2]), packacc(acc[3]));                                        \
    f32x4 Z = {0.f, 0.f, 0.f, 0.f};                                                                  \
    Z = __builtin_amdgcn_mfma_f32_16x16x32_bf16(mk8(gt, zero2), mk8(vb, zero2), Z, 0, 0, 0);         \
    f32x4 Y = {0.f, 0.f, 0.f, 0.f};                                                                  \
    Z = __builtin_amdgcn_mfma_f32_16x16x32_bf16(mk8(w00, w01), sB0, Z, 0, 0, 0);                     \
    Y = __builtin_amdgcn_mfma_f32_16x16x32_bf16(mk8(r00, r01), sB0, Y, 0, 0, 0);                     \
    Z = __builtin_amdgcn_mfma_f32_16x16x32_bf16(mk8(w10, w11), sB1, Z, 0, 0, 0);                     \
    Y = __builtin_amdgcn_mfma_f32_16x16x32_bf16(mk8(r10, r11), sB1, Y, 0, 0, 0);                     \
    const bf16x8 zvB = mk8(packacc(Z), vb);                                                          \
    Y = __builtin_amdgcn_mfma_f32_16x16x32_bf16(__builtin_bit_cast(bf16x8, mr), zvB, Y, 0, 0, 0);    \
    _Pragma("unroll") for (int n = 0; n < 4; ++n) {                                                  \
      f32x4 scv = acc[n];                                                                            \
      scv[0] *= g15[n].x; scv[1] *= g15[n].y; scv[2] *= g15[n].z; scv[3] *= g15[n].w;                \
      acc[n] = __builtin_amdgcn_mfma_f32_16x16x32_bf16(mk8(bk0[n], bk1[n]), zvB, scv, 0, 0, 0);      \
    }                                                                                                \
    const int c = (SCI) * SCH + cl;                                                                  \
    _Pragma("unroll") for (int e = 0; e < 4; ++e)                                                    \
        yout[(size_t)(c * 16 + 4 * g + e) * 1024] = (bfu)f2bf(Y[e]);                                 \
  }
DEVI void scans_block(const Params& p, char* smem, int bh) {
  const int b = bh >> 4, h = bh & 15;
  const int lane = threadIdx.x & 63, vs = threadIdx.x >> 6, q = lane & 15, g = lane >> 4;
  f32x4 acc[4];
#pragma unroll
  for (int n = 0; n < 4; ++n) acc[n] = f32x4{0.f, 0.f, 0.f, 0.f};
  const uint2 zero2 = {0u, 0u};
  bfu* yout = p.YS + ((size_t)b * SEQ) * 1024 + h * 64 + vs * 16 + q;
  const int tid = threadIdx.x;
  const int t2 = (tid - 128) & 63;
  const int cl0 = tid >> 7, row0 = (tid >> 3) & 15, c80 = tid & 7;
  uint4 Aa0, Aa1, Aa2, Ar0, Ar1, Ar2, Ae0, Ae1, Ae2, Ak0, Ak1, Ak2, Av0, Av1, Av2, Agm, Ag5, Amr, Ams;
  constexpr int NSC = (SEQ / 16 + SCH - 1) / SCH;
  const int vrow = vs * 4 + (q >> 2), vcol = (q & 3) * 16 + 4 * g;
  SCANS_ISSUE(A, 0);
  SCANS_COMMIT(A);
  __syncthreads();
#pragma unroll 1
  for (int sc = 0; sc < NSC; ++sc) {
    SCANS_ISSUE(A, (sc + 1 < NSC ? sc + 1 : NSC - 1));
    SCANS_COMPUTE(sc);
    __syncthreads();
    SCANS_COMMIT(A);
    __syncthreads();
  }
}
DEVI void phase6(const Params& p, char* smem, int bid, int nb) {
  for (int it = bid; it < 32; it += nb) {
    if (threadIdx.x < 256) {
      scans_block(p, smem, it);
    } else {
      constexpr int NSC = (SEQ / 16 + SCH - 1) / SCH;
      __syncthreads();
#pragma unroll 1
      for (int sc = 0; sc < NSC; ++sc) {
        __syncthreads();
        __syncthreads();
      }
    }
  }
}

DEVI void phase6b(const Params& p, int bid, int nb) {
  const int lane = threadIdx.x & 63, wv = (threadIdx.x >> 6) & 3;
  for (int it = bid; it < T_TOK / 2; it += nb) {
    const int t = it * 2 + (threadIdx.x >> 8);
    const int tb = t & ~15, tau = t & 15;
    float ys[4], vv[4], sg[4], bon[4];
#pragma unroll
    for (int j = 0; j < 4; ++j) {
      const int h = wv * 4 + j;
      const size_t idx = (size_t)t * 1024 + h * 64 + lane;
      ys[j] = bf2f(p.YS[idx]);
      sg[j] = bf2f(p.SG[idx]);
      vv[j] = bf2f(p.V1[(size_t)(tb + (lane >> 2)) * 1024 + h * 64 + (lane & 3) * 16 + tau]);
      bon[j] = p.COEF[(size_t)t * 16 + h];
    }
#pragma unroll
    for (int j = 0; j < 4; ++j) {
      const int h = wv * 4 + j;
      const int c = h * 64 + lane;
      const float mean = wave_sum(ys[j]) * (1.f / 64.f);
      const float dv = ys[j] - mean;
      const float var = wave_sum(dv * dv) * (1.f / 64.f);
      float y = dv * rsqrtf(var + 64e-5f) * p.lnw[c] + p.lnb[c];
      y = (y + bon[j] * vv[j]) * sg[j];
      p.YS[(size_t)t * 1024 + c] = (bfu)f2bf(y);
    }
  }
}

DEVI void phase7(const Params& p, char* smem, int bid, int nb) {
  PgEpiRes E{p.out, p.out};
  pg_gemm(smem, p.YS, p.WT_o, T_TOK, 1024, 1024, E, bid, nb);
}
DEVI void phase8(const Params& p, int bid, int nb) {
  for (int it = bid; it < T_TOK / 16; it += nb) {
    const int row = it * 16 + (threadIdx.x >> 6) * 2;
    const int lane = threadIdx.x & 63;
    float* src = p.out + (size_t)row * 1024;
    float4 v[2][4];
    float ss[2] = {0.f, 0.f};
#pragma unroll
    for (int r = 0; r < 2; ++r)
#pragma unroll
      for (int i = 0; i < 4; ++i) v[r][i] = *(const float4*)(src + r * 1024 + lane * 4 + 256 * i);
#pragma unroll
    for (int r = 0; r < 2; ++r)
#pragma unroll
      for (int i = 0; i < 4; ++i)
        ss[r] += v[r][i].x * v[r][i].x + v[r][i].y * v[r][i].y + v[r][i].z * v[r][i].z + v[r][i].w * v[r][i].w;
#pragma unroll
    for (int r = 0; r < 2; ++r) {
      const float rinv = rsqrtf(wave_sum(ss[r]) * (1.f / 1024.f) + 1e-6f);
#pragma unroll
      for (int i = 0; i < 4; ++i) {
        const float4 g = *(const float4*)(p.fnorm + lane * 4 + 256 * i);
        const float4 o = {v[r][i].x * rinv * g.x, v[r][i].y * rinv * g.y, v[r][i].z * rinv * g.z, v[r][i].w * rinv * g.w};
        *(float4*)(src + r * 1024 + lane * 4 + 256 * i) = o;
      }
    }
  }
}

template <int PH>
DEVI void run_phase(const Params& p, char* smem, int bid, int nb) {
  if (PH == 0) phase0(p, smem, bid, nb);
  if (PH == 1) phase1(p, smem, bid, nb);
  if (PH == 2) phase2(p, smem, bid, nb);
  if (PH == 3) phase3(p, smem, bid, nb);
  if (PH == 4) phase3b(p, bid, nb);
  if (PH == 5) phaseM(p, smem, bid, nb);
  if (PH == 6) phase3a(p, smem, bid, nb);
  if (PH == 7) phase3c(p, smem, bid, nb);
  if (PH == 8) phase5(p, smem, bid, nb);
  if (PH == 9) phase6x(p, smem, bid, nb);
  if (PH == 10) phase6(p, smem, bid, nb);
  if (PH == 11) phase6b(p, bid, nb);
  if (PH == 12) phase7(p, smem, bid, nb);
  if (PH == 13) phase8(p, bid, nb);
}

#ifndef REP_MASK
#define REP_MASK 0
#endif
template <int PH>
DEVI void mega_phase(const Params& p, char* smem, cg::grid_group& grid, int bid, int nb) {
  run_phase<PH>(p, smem, bid, nb);
  if ((REP_MASK >> PH) & 1) {
    grid.sync();
    run_phase<PH>(p, smem, bid, nb);
  }
}
__global__ void __launch_bounds__(512, 2) mega_kernel(Params p) {
  extern __shared__ __attribute__((aligned(16))) char smem[];
  cg::grid_group grid = cg::this_grid();
  const int bid = blockIdx.x, nb = gridDim.x;
  mega_phase<0>(p, smem, grid, bid, nb); grid.sync();
  mega_phase<1>(p, smem, grid, bid, nb); grid.sync();
  mega_phase<2>(p, smem, grid, bid, nb); grid.sync();
  mega_phase<3>(p, smem, grid, bid, nb); grid.sync();
  mega_phase<4>(p, smem, grid, bid, nb); grid.sync();
  mega_phase<5>(p, smem, grid, bid, nb); grid.sync();
  mega_phase<6>(p, smem, grid, bid, nb); grid.sync();
  mega_phase<7>(p, smem, grid, bid, nb); grid.sync();
  mega_phase<8>(p, smem, grid, bid, nb); grid.sync();
  mega_phase<9>(p, smem, grid, bid, nb); grid.sync();
  mega_phase<10>(p, smem, grid, bid, nb); grid.sync();
  mega_phase<11>(p, smem, grid, bid, nb); grid.sync();
  mega_phase<12>(p, smem, grid, bid, nb); grid.sync();
  mega_phase<13>(p, smem, grid, bid, nb);
}

extern "C" void kernel_launch(void* const* d_in, const int* in_sizes, int n_in, void* d_out, int out_size, void* d_ws,
                              size_t ws_size, hipStream_t stream) {
  Params p{};
  const float** fp = (const float**)&p;
  for (int i = 0; i < 26; ++i) fp[i] = (const float*)d_in[i];
  p.out = (float*)d_out;
  char* w = (char*)d_ws;
  size_t off = 0;
  auto take = [&](size_t bytes) {
    char* r = w + off;
    off += (bytes + 255) & ~(size_t)255;
    return (bfu*)r;
  };
  p.WT_in = take((size_t)3584 * 1024 * 2);
  p.WT_out = take((size_t)1024 * 1024 * 2);
  p.WT_3 = take((size_t)4352 * 1024 * 2);
  p.WT_o = take((size_t)1024 * 1024 * 2);
  p.W2T = take((size_t)1024 * 64 * 2);
  p.A2T = take((size_t)1024 * 64 * 2);
  p.TW = take((size_t)T_TOK * 64 * 2);
  p.TA = take((size_t)T_TOK * 64 * 2);
  const size_t SLOT = (size_t)T_TOK * 1024 * 2;
  bfu* slot0 = take(SLOT);
  bfu* slots = take(6 * SLOT);
  p.H = slot0;
  p.AA = slot0;
  p.U = slots;
  p.GVT = slots + SLOT / 4;
  p.Q = slots + 2 * (SLOT / 4);
  p.K = slots + 3 * (SLOT / 4);
  p.VT = slots + 4 * (SLOT / 4);
  p.SZ = slots + 7 * (SLOT / 4);
  p.Y = slots + 9 * (SLOT / 4);
  p.R = slots;
  p.K1 = slots + 1 * (SLOT / 2);
  p.XV = slots + 2 * (SLOT / 2);
  p.XG = slots + 3 * (SLOT / 2);
  p.XR = slots + 4 * (SLOT / 2);
  p.XK = slots + 5 * (SLOT / 2);
  p.V1 = slots + 4 * (SLOT / 2);
  p.SG = slots + 5 * (SLOT / 2);
  p.EW = slots + 2 * (SLOT / 2);
  p.YS = slots + 3 * (SLOT / 2);
  p.G15 = (float*)p.TW;
  p.GT = p.WT_in;
  p.MRT = take((size_t)(SEQ / 16) * 32 * 512 * 2);
  p.COEF = (float*)take((size_t)T_TOK * 16 * 4);
  if (off > ws_size) {
    fprintf(stderr, "workspace too small: need %zu have %zu\n", off, ws_size);
    return;
  }
  static int grid_blocks = 0;
  if (!grid_blocks) {
    int dev = 0, cus = 0, per_cu = 0;
    (void)hipGetDevice(&dev);
    (void)hipDeviceGetAttribute(&cus, hipDeviceAttributeMultiprocessorCount, dev);
    (void)hipFuncSetAttribute((const void*)mega_kernel, hipFuncAttributeMaxDynamicSharedMemorySize, SMEM_BYTES);
    (void)hipOccupancyMaxActiveBlocksPerMultiprocessor(&per_cu, mega_kernel, 512, SMEM_BYTES);
    grid_blocks = cus * per_cu;
  }
  void* args[] = {&p};
  hipError_t e = hipLaunchCooperativeKernel((void*)mega_kernel, dim3(grid_blocks), dim3(512), args, SMEM_BYTES, stream);
  if (e != hipSuccess) fprintf(stderr, "cooperative launch failed: %s (grid %d)\n", hipGetErrorString(e), grid_blocks);
}
```

```cpp
#include <hip/hip_runtime.h>
#include <hip/hip_cooperative_groups.h>
#include <stdint.h>
#include <cstdio>
namespace cg = cooperative_groups;

#ifndef MEGA
#define MEGA 1
#endif

typedef unsigned short bfu;
using bf16x8 = __attribute__((ext_vector_type(8))) short;
using f32x4 = __attribute__((ext_vector_type(4))) float;
#define DEVI __device__ __forceinline__
#define TIDX ((int)(threadIdx.x & 255))
#define HF ((int)(threadIdx.x >> 8))

constexpr int GSTAGE_BYTES = 2 * 128 * 72 * 2;
constexpr int T_TOK = 32768;
constexpr int SEQ = 16384;
constexpr int HALF_SMEM = 2 * GSTAGE_BYTES + 4096 + 512;
constexpr int SMEM_BYTES = 2 * HALF_SMEM;
constexpr int SMEM_UNUSED_ = 0;

struct Params {
  const float *x, *ln_even, *w_in, *gm_norm, *gm_ws, *gm_b, *w_out, *ln_odd, *mu, *wr, *wk, *wv, *wg, *w0, *w1, *w2,
      *a0, *a1, *a2, *k_k, *k_a, *r_k, *lnw, *lnb, *wo, *fnorm;
  float* out;
  bfu *WT_in, *WT_out, *WT_3, *WT_o, *W2T, *A2T;
  bfu *H, *U, *GVT, *Q, *K, *VT, *SZ, *Y, *R, *K1, *V1, *SG, *EW, *AA, *YS, *TW, *TA, *GT, *MRT, *XR, *XK, *XV, *XG;
  float *G15, *COEF;
  unsigned* BAR;
};

DEVI float bf2f(unsigned b) { return __uint_as_float(b << 16); }
DEVI unsigned f2bf(float x) {
  const __bf16 h = (__bf16)x;
  return (unsigned)__builtin_bit_cast(unsigned short, h);
}
typedef __bf16 bf16x2_t __attribute__((ext_vector_type(2)));
typedef float float2_t __attribute__((ext_vector_type(2)));
DEVI unsigned pkbf(float a, float b) {
  const float2_t f = {a, b};
  const bf16x2_t h = __builtin_convertvector(f, bf16x2_t);
  return __builtin_bit_cast(unsigned, h);
}
DEVI void unpack8(uint4 v, float* f) {
  f[0] = __uint_as_float(v.x << 16); f[1] = __uint_as_float(v.x & 0xffff0000u);
  f[2] = __uint_as_float(v.y << 16); f[3] = __uint_as_float(v.y & 0xffff0000u);
  f[4] = __uint_as_float(v.z << 16); f[5] = __uint_as_float(v.z & 0xffff0000u);
  f[6] = __uint_as_float(v.w << 16); f[7] = __uint_as_float(v.w & 0xffff0000u);
}
DEVI uint4 pack8(const float* f) {
  uint4 r;
  r.x = pkbf(f[0], f[1]);
  r.y = pkbf(f[2], f[3]);
  r.z = pkbf(f[4], f[5]);
  r.w = pkbf(f[6], f[7]);
  return r;
}
DEVI void unpack4(uint2 v, float* f) {
  f[0] = __uint_as_float(v.x << 16); f[1] = __uint_as_float(v.x & 0xffff0000u);
  f[2] = __uint_as_float(v.y << 16); f[3] = __uint_as_float(v.y & 0xffff0000u);
}
DEVI uint2 pack4(const float* f) {
  uint2 r;
  r.x = pkbf(f[0], f[1]);
  r.y = pkbf(f[2], f[3]);
  return r;
}

DEVI float sigmoid_(float x) { return 1.f / (1.f + __expf(-x)); }
DEVI float silu_(float x) { return x * sigmoid_(x); }
DEVI float tanh_(float y) { float t = __expf(2.f * y); return 1.f - 2.f / (1.f + t); }
DEVI float gelu_(float x) {
  float y = 0.7978845608028654f * (x + 0.044715f * x * x * x);
  return 0.5f * x * (1.f + tanh_(y));
}
DEVI float wave_sum(float v) {
#pragma unroll
  for (int o = 32; o > 0; o >>= 1) v += __shfl_xor(v, o);
  return v;
}
DEVI float wave_max(float v) {
#pragma unroll
  for (int o = 32; o > 0; o >>= 1) v = fmaxf(v, __shfl_xor(v, o));
  return v;
}
template <int CTRL>
DEVI float dppf(float x) {
  return __int_as_float(__builtin_amdgcn_update_dpp(0, __float_as_int(x), CTRL, 0xF, 0xF, true));
}
DEVI float reduce16(float x) {
  x += dppf<0xB1>(x);
  x += dppf<0x4E>(x);
  x += dppf<0x141>(x);
  x += dppf<0x140>(x);
  return x;
}

constexpr int LROW = 72;
constexpr int GSTAGE = 2 * 128 * LROW;

template <int DIST = 2, bool SW = true, class ALoad, class Epi>
DEVI void gemm_tile(char* smem, const ALoad& aload, const bfu* __restrict__ Bt, int ldb, int K, int m0, int n0,
                    const Epi& epi) {
  bfu* sbase = (bfu*)smem;
  const int tid = TIDX, lane = tid & 63, wid = tid >> 6, wr = wid >> 1, wc = wid & 1;
  const int fr = lane & 15, fq = lane >> 4;
  f32x4 acc[4][4];
#pragma unroll
  for (int i = 0; i < 4; ++i)
#pragma unroll
    for (int j = 0; j < 4; ++j) acc[i][j] = f32x4{0.f, 0.f, 0.f, 0.f};
  const int r0 = tid >> 3, kc = (tid & 7) * 8;
  const int nk = K >> 6;
  struct GRegs { typename ALoad::Raw a0, a1, a2, a3; uint4 ap, b0, b1, b2, b3; };
  GRegs g0, g1;
  const bfu* Bp = Bt + (size_t)(n0 + r0) * ldb + kc;
  const size_t ldb32 = (size_t)ldb * 32;
  constexpr int ARS = ALoad::kConsec ? 1 : 32;
  const int ar0 = ALoad::kConsec ? 4 * r0 : r0;
#define GEMM_ISSUE(R, KT)                                   \
  {                                                         \
    const int k0_ = ((KT) << 6);                            \
    R.ap = aload.loadprev(m0 + ar0, k0_ + kc);              \
    R.a0 = aload.load(m0 + ar0, k0_ + kc);                  \
    R.a1 = aload.load(m0 + ar0 + ARS, k0_ + kc);            \
    R.a2 = aload.load(m0 + ar0 + 2 * ARS, k0_ + kc);        \
    R.a3 = aload.load(m0 + ar0 + 3 * ARS, k0_ + kc);        \
    R.b0 = *(const uint4*)(Bp + k0_);                       \
    R.b1 = *(const uint4*)(Bp + ldb32 + k0_);               \
    R.b2 = *(const uint4*)(Bp + 2 * ldb32 + k0_);           \
    R.b3 = *(const uint4*)(Bp + 3 * ldb32 + k0_);           \
  }
#define GEMM_COMMIT(R, S, KT)                               \
  {                                                         \
    const int k1_ = ((KT) << 6) + kc;                       \
    bfu* A_ = sbase + (S) * GSTAGE + ar0 * LROW + kc;       \
    bfu* B_ = sbase + (S) * GSTAGE + 128 * LROW + r0 * LROW + kc;   \
    *(uint4*)(A_) = aload.finish(R.a0, R.ap, m0 + ar0, k1_);                                 \
    *(uint4*)(A_ + ARS * LROW) = aload.finish(R.a1, aload.asprev(R.a0), m0 + ar0 + ARS, k1_);          \
    *(uint4*)(A_ + 2 * ARS * LROW) = aload.finish(R.a2, aload.asprev(R.a1), m0 + ar0 + 2 * ARS, k1_);  \
    *(uint4*)(A_ + 3 * ARS * LROW) = aload.finish(R.a3, aload.asprev(R.a2), m0 + ar0 + 3 * ARS, k1_);  \
    *(uint4*)(B_) = R.b0;                                   \
    *(uint4*)(B_ + 32 * LROW) = R.b1;                       \
    *(uint4*)(B_ + 64 * LROW) = R.b2;                       \
    *(uint4*)(B_ + 96 * LROW) = R.b3;                       \
  }
#define GEMM_COMPUTE(S)                                                                          \
  {                                                                                              \
    const bfu* cA = sbase + (S) * GSTAGE;                                                        \
    const bfu* cB = cA + 128 * LROW;                                                             \
    _Pragma("unroll") for (int ks = 0; ks < 2; ++ks) {                                           \
      bf16x8 af[4], bfv[4];                                                                      \
      _Pragma("unroll") for (int i = 0; i < 4; ++i) {                                            \
        af[i] = *(const bf16x8*)(cA + (wr * 64 + i * 16 + fr) * LROW + ks * 32 + fq * 8);        \
        bfv[i] = *(const bf16x8*)(cB + (wc * 64 + i * 16 + fr) * LROW + ks * 32 + fq * 8);       \
      }                                                                                          \
      _Pragma("unroll") for (int i = 0; i < 4; ++i) _Pragma("unroll") for (int j = 0; j < 4; ++j) \
          acc[i][j] = SW ? __builtin_amdgcn_mfma_f32_16x16x32_bf16(bfv[j], af[i], acc[i][j], 0, 0, 0)     \
                         : __builtin_amdgcn_mfma_f32_16x16x32_bf16(af[i], bfv[j], acc[i][j], 0, 0, 0);    \
    }                                                                                            \
  }
  const int nkm1 = nk - 1;
  if (DIST == 2) {
    GEMM_ISSUE(g0, 0);
    GEMM_ISSUE(g1, (1 < nkm1 ? 1 : nkm1));
    GEMM_COMMIT(g0, 0, 0);
    GEMM_ISSUE(g0, (2 < nkm1 ? 2 : nkm1));
    __syncthreads();
    if (nk == 1) {
      GEMM_COMPUTE(0);
      __syncthreads();
    } else {
      for (int kt = 0; kt < nk; kt += 2) {
        GEMM_COMMIT(g1, 1, (kt + 1 < nkm1 ? kt + 1 : nkm1));
        GEMM_ISSUE(g1, (kt + 3 < nkm1 ? kt + 3 : nkm1));
        GEMM_COMPUTE(0);
        __syncthreads();
        GEMM_COMMIT(g0, 0, (kt + 2 < nkm1 ? kt + 2 : nkm1));
        GEMM_ISSUE(g0, (kt + 4 < nkm1 ? kt + 4 : nkm1));
        GEMM_COMPUTE(1);
        __syncthreads();
      }
    }
  } else {
    GEMM_ISSUE(g0, 0);
    GEMM_COMMIT(g0, 0, 0);
    GEMM_ISSUE(g0, (1 < nkm1 ? 1 : nkm1));
    __syncthreads();
    for (int kt = 0; kt < nk; kt += 2) {
      GEMM_COMMIT(g0, 1, (kt + 1 < nkm1 ? kt + 1 : nkm1));
      GEMM_ISSUE(g0, (kt + 2 < nkm1 ? kt + 2 : nkm1));
      GEMM_COMPUTE(0);
      __syncthreads();
      GEMM_COMMIT(g0, 0, (kt + 2 < nkm1 ? kt + 2 : nkm1));
      GEMM_ISSUE(g0, (kt + 3 < nkm1 ? kt + 3 : nkm1));
      GEMM_COMPUTE(1);
      __syncthreads();
    }
  }
#pragma unroll
  for (int i = 0; i < 4; ++i)
#pragma unroll
    for (int j = 0; j < 4; ++j) {
      if (SW) epi(m0 + wr * 64 + i * 16 + fr, n0 + wc * 64 + j * 16 + fq * 4, acc[i][j]);
      else epi(m0 + wr * 64 + i * 16 + fq * 4, n0 + wc * 64 + j * 16 + fr, acc[i][j]);
    }
}

namespace pg8 {
#define PG8_LAS __attribute__((address_space(3)))
typedef unsigned short bf16_t;
typedef short bf16x8 __attribute__((ext_vector_type(8)));
typedef float f32x4 __attribute__((ext_vector_type(4)));
typedef unsigned u32x4 __attribute__((ext_vector_type(4)));
constexpr int BM = 256, BK = 64, HALF = 128, HTB = HALF * BK * 2  , STAGE_BYTES = 8 * HTB, NXCD = 8, WGM = 8;

__host__ __device__ __forceinline__ int lds_byte(int r, int c) { const int st = (r >> 4) * 2 + (c >> 5), rr = r & 15, cc = c & 31, ob = rr * 64 + cc * 2; return st * 1024 + (ob ^ (((ob >> 9) & 1) << 5)); }
__host__ __device__ __forceinline__ void stage_rc(int b, int& R, int& C) { const int st = b / 1024, sb = b % 1024, swz = sb ^ (((sb >> 9) & 1) << 5); R = (st >> 1) * 16 + swz / 64; C = (st & 1) * 32 + (swz % 64) / 2; }
__host__ __device__ __forceinline__ int perm32(int rho) { const int n = rho >> 4, i = rho & 15; return 8 * (i >> 2) + 4 * n + (i & 3); }

struct Unit { int pm, pn; };
struct Gemm { const bf16_t* A; const bf16_t* Bt; int M, N, K; const bf16_t* A2; int pn_split; };

struct StaticOrder {
    int nM, nN, nwg, G, c;
    __host__ __device__ void init(int M, int N, int G_, int c_) { nM = M / BM; nN = N / BM; nwg = nM * nN; G = G_; c = c_; }
    __host__ __device__ bool next(int i, Unit& u) const {
        const long L = (long)i * G + c; if (L >= nwg) return false;
        int wgid = (int)L; { const int q = nwg / NXCD, r = nwg % NXCD, xcd = wgid % NXCD, off = wgid / NXCD; wgid = (xcd < r ? xcd * (q + 1) : r * (q + 1) + (xcd - r) * q) + off; }
        const int nig = WGM * nN, gid = wgid / nig, fm = gid * WGM, gsz = (nM - fm) < WGM ? (nM - fm) : WGM;
        u.pm = fm + ((wgid % nig) % gsz); u.pn = (wgid % nig) / gsz; return true;
    }
    __device__ __forceinline__ void a_ready(const Unit&) const {}
    __device__ __forceinline__ void done(const Unit&) const {}
};
struct CountedOrder : StaticOrder {
    const unsigned* ready; unsigned need; unsigned* tmo;
    __device__ __forceinline__ void a_ready(const Unit& u) const {
        if (threadIdx.x < 64) {
            const unsigned long long t0 = __builtin_amdgcn_s_memrealtime(); unsigned polls = 0;
            while ((unsigned)__builtin_amdgcn_readfirstlane(__hip_atomic_load(ready + 64 * u.pm, __ATOMIC_RELAXED, __HIP_MEMORY_SCOPE_AGENT)) < need) {
                if ((++polls & 255u) == 0u && __builtin_amdgcn_readfirstlane(__hip_atomic_load(tmo, __ATOMIC_RELAXED, __HIP_MEMORY_SCOPE_AGENT)) != 0u) break;
                if (__builtin_amdgcn_s_memrealtime() - t0 > 2000000ull) {
                    if (threadIdx.x == 0) { unsigned expect = 0u; __hip_atomic_compare_exchange_strong(tmo + 1, &expect, 0x600u | (unsigned)(u.pm & 0xff), __ATOMIC_RELAXED, __ATOMIC_RELAXED, __HIP_MEMORY_SCOPE_AGENT); __hip_atomic_store(tmo, 1u, __ATOMIC_RELAXED, __HIP_MEMORY_SCOPE_AGENT); }
                    break; }
                __builtin_amdgcn_s_sleep(2); }
            __builtin_amdgcn_fence(__ATOMIC_ACQUIRE, "agent");
            asm volatile("s_waitcnt vmcnt(0)" ::: "memory");
        }
#if !defined(BROKEN_HOOK_NO_BARRIER)
        asm volatile("" ::: "memory"); __builtin_amdgcn_s_barrier(); asm volatile("" ::: "memory");
#endif
    }
};

__device__ __forceinline__ unsigned cvt_pk_bf16(float lo, float hi) { unsigned r; asm volatile("v_cvt_pk_bf16_f32 %0, %1, %2" : "=v"(r) : "v"(lo), "v"(hi)); return r; }
typedef float f32x2 __attribute__((ext_vector_type(2)));
__device__ __forceinline__ f32x2 gelu_pk(f32x2 v) {
    const f32x2 av = __builtin_elementwise_abs(v), d = av * 0.2316418882f + 1.0f;
    f32x2 t; t.x = __builtin_amdgcn_rcpf(d.x); t.y = __builtin_amdgcn_rcpf(d.y);
    f32x2 q = t * 0.5307027145f + (-0.7265760135f); q = q * t + 0.7107068705f; q = q * t + (-0.142248368f); q = q * t + 0.127414796f; q = q * t;
    const f32x2 s = (v * v) * (-0.72134752044f);
    f32x2 e; e.x = __builtin_amdgcn_exp2f(s.x); e.y = __builtin_amdgcn_exp2f(s.y);
    const f32x2 m = v * (q * e), r = v - m;
    f32x2 o; o.x = v.x < 0.f ? m.x : r.x; o.y = v.y < 0.f ? m.y : r.y; return o;
}

struct EpiF32 {
    static constexpr bool PERM = false, AFTER_DRAIN = false;
    float* C; int ldc; const float* bias;
    __device__ __forceinline__ void operator()(const f32x4 (&acc)[2][2][4][2], const Unit& u, int wr, int wc, int fr, int fq) const {
        const int row0 = u.pm * BM + wr * 64 + fr, col0 = u.pn * BM + wc * 32 + 4 * fq;
        f32x4 bv[2][2];
#pragma unroll
        for (int bj = 0; bj < 2; ++bj)
#pragma unroll
            for (int n = 0; n < 2; ++n) bv[bj][n] = bias ? *(const f32x4*)(bias + col0 + bj * HALF + n * 16) : (f32x4){0.f, 0.f, 0.f, 0.f};
#pragma unroll
        for (int ai = 0; ai < 2; ++ai)
#pragma unroll
            for (int m = 0; m < 4; ++m) { float* rowp = C + (size_t)(row0 + ai * HALF + m * 16) * ldc + col0;
#pragma unroll
                for (int bj = 0; bj < 2; ++bj)
#pragma unroll
                    for (int n = 0; n < 2; ++n) *(f32x4*)(rowp + bj * HALF + n * 16) = acc[ai][bj][m][n] + bv[bj][n]; }
    }
};
template <int ACT  > struct EpiBf16 {
    static constexpr bool PERM = true, AFTER_DRAIN = false;
    bf16_t* O; int ldc; const float* bias; int split_cols; size_t split_stride;
    __device__ __forceinline__ void operator()(const f32x4 (&acc)[2][2][4][2], const Unit& u, int wr, int wc, int fr, int fq) const {
        const int row0 = u.pm * BM + wr * 64 + fr; int colt = u.pn * BM; bf16_t* base = O;
        if (split_cols) { const int t = colt / split_cols; base += (size_t)t * split_stride; colt -= t * split_cols; }
        const int col0 = colt + wc * 32 + 8 * fq, bcol0 = u.pn * BM + wc * 32 + 8 * fq;
        f32x4 bv[2][2];
#pragma unroll
        for (int bj = 0; bj < 2; ++bj)
#pragma unroll
            for (int n = 0; n < 2; ++n) bv[bj][n] = bias ? *(const f32x4*)(bias + bcol0 + bj * HALF + 4 * n) : (f32x4){0.f, 0.f, 0.f, 0.f};
#pragma unroll
        for (int ai = 0; ai < 2; ++ai)
#pragma unroll
            for (int m = 0; m < 4; ++m) { bf16_t* rowp = base + (size_t)(row0 + ai * HALF + m * 16) * ldc + col0;
#pragma unroll
                for (int bj = 0; bj < 2; ++bj) { f32x4 v0 = acc[ai][bj][m][0] + bv[bj][0], v1 = acc[ai][bj][m][1] + bv[bj][1];
                    if (ACT == 1) { f32x2 a = gelu_pk((f32x2){v0[0], v0[1]}), b = gelu_pk((f32x2){v0[2], v0[3]}), c = gelu_pk((f32x2){v1[0], v1[1]}), d = gelu_pk((f32x2){v1[2], v1[3]});
                        v0 = (f32x4){a.x, a.y, b.x, b.y}; v1 = (f32x4){c.x, c.y, d.x, d.y}; }
                    if (ACT == 2) {
#pragma unroll
                        for (int j = 0; j < 4; ++j) { v0[j] = 0.5f * v0[j] * (1.0f + erff(v0[j] * 0.70710678f)); v1[j] = 0.5f * v1[j] * (1.0f + erff(v1[j] * 0.70710678f)); } }
                    u32x4 w; w.x = cvt_pk_bf16(v0[0], v0[1]); w.y = cvt_pk_bf16(v0[2], v0[3]); w.z = cvt_pk_bf16(v1[0], v1[1]); w.w = cvt_pk_bf16(v1[2], v1[3]);
                    *(u32x4*)(rowp + bj * HALF) = w; } }
    }
};


template <class Epi, class Sched, bool STAMP = false>
__device__ __forceinline__ void gemm_phase(PG8_LAS unsigned char* lds, const Gemm g, const Sched& S, const Epi& E, unsigned long long* stamps) {
    const int tid = threadIdx.x, wid = __builtin_amdgcn_readfirstlane(tid >> 6), lane = tid & 63, wr = wid >> 2, wc = wid & 3, fr = lane & 15, fq = lane >> 4;
    const int K = g.K, nt = K / BK;
    int ts_lo = 0, ts_hi = 0, nts = 0; const unsigned long long rt_entry = STAMP ? (unsigned long long)wall_clock64() : 0ull;
#define PG8_STAMP() do { if (STAMP && wid == 0 && nts < 64) { const unsigned long long _c = (unsigned long long)clock64(); \
        ts_lo = (lane == nts) ? (int)(unsigned)_c : ts_lo; ts_hi = (lane == nts) ? (int)(unsigned)(_c >> 32) : ts_hi; ++nts; } } while (0)
    PG8_STAMP();
    unsigned voffA[2], voffB[2];
#pragma unroll
    for (int i = 0; i < 2; ++i) { int R, C; stage_rc(tid * 16 + i * 8192, R, C); const int Rb = Epi::PERM ? ((R & ~31) + perm32(R & 31)) : R;
        voffA[i] = (unsigned)(R * K + C) * 2u; voffB[i] = (unsigned)(Rb * K + C) * 2u; }
    const size_t kstep = (size_t)(BK * 2);
    const size_t hstep = (size_t)HALF * K * 2;
    const size_t tstep = 2 * hstep;
    const unsigned ldsw = (unsigned)wid * 1024u;
    const int aoff = lds_byte(wr * 64 + fr, fq * 8), boff = lds_byte(wc * 32 + fr, fq * 8);
#define PG8_SA(b, h) (((b) * 2 + (h)) * HTB)
#define PG8_SB(b, h) ((4 + (b) * 2 + (h)) * HTB)
#define PG8_STAGE(bufoff, gbase, voff) do { _Pragma("unroll") for (int _i = 0; _i < 2; ++_i) \
        __builtin_amdgcn_global_load_lds((const unsigned*)((const char*)(gbase) + (voff)[_i]), (PG8_LAS unsigned*)(lds + (bufoff) + ldsw + _i * 8192), 16, 0, 0); } while (0)
#define PG8_LDA(dst, b, h) do { _Pragma("unroll") for (int m = 0; m < 4; ++m) _Pragma("unroll") for (int k = 0; k < 2; ++k) dst[m][k] = *(const PG8_LAS bf16x8*)(lds + PG8_SA(b, h) + aoff + m * 2048 + k * 1024); } while (0)
#define PG8_LDB(dst, b, h) do { _Pragma("unroll") for (int n = 0; n < 2; ++n) _Pragma("unroll") for (int k = 0; k < 2; ++k) dst[n][k] = *(const PG8_LAS bf16x8*)(lds + PG8_SB(b, h) + boff + n * 2048 + k * 1024); } while (0)
#define PG8_MMA(ai, bj, At, Bt) do { __builtin_amdgcn_s_setprio(1); _Pragma("unroll") for (int m = 0; m < 4; ++m) _Pragma("unroll") for (int n = 0; n < 2; ++n) _Pragma("unroll") for (int k = 0; k < 2; ++k) \
        acc[ai][bj][m][n] = __builtin_amdgcn_mfma_f32_16x16x32_bf16(Bt[n][k], At[m][k], acc[ai][bj][m][n], 0, 0, 0); __builtin_amdgcn_s_setprio(0); } while (0)
#define PG8_WAIT_V(n) asm volatile("s_waitcnt vmcnt(" #n ")" ::: "memory")
#define PG8_WAIT_L(n) asm volatile("s_waitcnt lgkmcnt(" #n ")" ::: "memory")
#define PG8_BAR __builtin_amdgcn_s_barrier()
#define PG8_SCHED __builtin_amdgcn_sched_barrier(0)
    Unit cur, nxt; int ui = 0;
    if (!S.next(0, cur)) return;
    f32x4 acc[2][2][4][2];
#pragma unroll
    for (int a = 0; a < 2; ++a)
#pragma unroll
        for (int b = 0; b < 2; ++b)
#pragma unroll
            for (int m = 0; m < 4; ++m)
#pragma unroll
                for (int n = 0; n < 2; ++n) acc[a][b][m][n] = (f32x4){0.f, 0.f, 0.f, 0.f};
    bf16x8 At[4][2], B0[2][2], B1[2][2];
    const char* cA = (const char*)(cur.pn >= g.pn_split ? g.A2 : g.A) + (size_t)cur.pm * tstep; const char* cB = (const char*)g.Bt + (size_t)cur.pn * tstep;
    S.a_ready(cur);
    PG8_STAGE(PG8_SB(0, 0), cB, voffB); PG8_STAGE(PG8_SA(0, 0), cA, voffA); PG8_STAGE(PG8_SB(0, 1), cB + hstep, voffB); PG8_STAGE(PG8_SA(0, 1), cA + hstep, voffA);
    if (wr == 1) PG8_BAR;
    PG8_WAIT_V(4); PG8_BAR;
    PG8_STAGE(PG8_SB(1, 0), cB + kstep, voffB); PG8_STAGE(PG8_SA(1, 0), cA + kstep, voffA); PG8_STAGE(PG8_SB(1, 1), cB + hstep + kstep, voffB);
    PG8_WAIT_V(6); PG8_BAR;
    PG8_STAMP();
    for (;;) {
        const bool has_next = S.next(ui + 1, nxt);
        const char* nA = has_next ? (const char*)(nxt.pn >= g.pn_split ? g.A2 : g.A) + (size_t)nxt.pm * tstep : cA; const char* nB = has_next ? (const char*)g.Bt + (size_t)nxt.pn * tstep : cB;
        for (int t = 0; t < nt; t += 2) {
            const bool last = (t == nt - 2);
            const char* a1 = cA + (size_t)(t + 1) * kstep;
            const char* a2 = last ? nA : cA + (size_t)(t + 2) * kstep; const char* b2 = last ? nB : cB + (size_t)(t + 2) * kstep;
            const char* a3 = a2 + kstep; const char* b3 = b2 + kstep;
            if (last && has_next) S.a_ready(nxt);
            PG8_LDB(B0, 0, 0); PG8_SCHED; PG8_LDA(At, 0, 0); PG8_STAGE(PG8_SA(1, 1), a1 + hstep, voffA);
            PG8_WAIT_L(8); PG8_BAR; PG8_WAIT_L(0); PG8_MMA(0, 0, At, B0); PG8_BAR; PG8_SCHED;
            PG8_LDB(B1, 0, 1); PG8_STAGE(PG8_SB(0, 0), b2, voffB);
            PG8_BAR; PG8_WAIT_L(0); PG8_MMA(0, 1, At, B1); PG8_BAR;
            PG8_LDA(At, 0, 1); PG8_STAGE(PG8_SA(0, 0), a2, voffA);
            PG8_BAR; PG8_WAIT_L(0); PG8_MMA(1, 0, At, B0); PG8_BAR; PG8_SCHED;
            PG8_STAGE(PG8_SB(0, 1), b2 + hstep, voffB);
            PG8_WAIT_V(6); PG8_BAR; PG8_MMA(1, 1, At, B1); PG8_BAR;
            PG8_LDB(B0, 1, 0); PG8_SCHED; PG8_LDA(At, 1, 0); PG8_STAGE(PG8_SA(0, 1), a2 + hstep, voffA);
            PG8_WAIT_L(8); PG8_BAR; PG8_WAIT_L(0); PG8_MMA(0, 0, At, B0); PG8_BAR; PG8_SCHED;
            PG8_LDB(B1, 1, 1); PG8_STAGE(PG8_SB(1, 0), b3, voffB);
            PG8_BAR; PG8_WAIT_L(0); PG8_MMA(0, 1, At, B1); PG8_BAR;
            PG8_LDA(At, 1, 1); PG8_STAGE(PG8_SA(1, 0), a3, voffA);
            PG8_BAR; PG8_WAIT_L(0); PG8_MMA(1, 0, At, B0); PG8_BAR; PG8_SCHED;
            PG8_STAGE(PG8_SB(1, 1), b3 + hstep, voffB);
            PG8_WAIT_V(6); PG8_BAR; PG8_MMA(1, 1, At, B1); PG8_BAR;
        }
        PG8_STAMP();
        if constexpr (!Epi::AFTER_DRAIN) { E(acc, cur, wr, wc, fr, fq); S.done(cur); }
        PG8_STAMP();
        if (!has_next) break;
#pragma unroll
        for (int a = 0; a < 2; ++a)
#pragma unroll
            for (int b = 0; b < 2; ++b)
#pragma unroll
                for (int m = 0; m < 4; ++m)
#pragma unroll
                    for (int n = 0; n < 2; ++n) acc[a][b][m][n] = (f32x4){0.f, 0.f, 0.f, 0.f};
        cur = nxt; cA = nA; cB = nB; ++ui;
    }
    PG8_WAIT_V(0);
    if (wr == 0) PG8_BAR;
    PG8_BAR;
    if constexpr (Epi::AFTER_DRAIN) { E.fused(acc, cur, wr, wc, fr, fq, lds, wid, lane); S.done(cur); }
    PG8_STAMP();
    if (STAMP && wid == 0) { stamps[lane] = lane < nts ? (((unsigned long long)(unsigned)ts_hi << 32) | (unsigned)ts_lo) : 0ull;
        if (lane == 62) stamps[62] = rt_entry; if (lane == 63) stamps[63] = (unsigned long long)wall_clock64(); }
#undef PG8_STAMP
#undef PG8_SA
#undef PG8_SB
#undef PG8_STAGE
#undef PG8_LDA
#undef PG8_LDB
#undef PG8_MMA
#undef PG8_WAIT_V
#undef PG8_WAIT_L
#undef PG8_BAR
#undef PG8_SCHED
}
}

struct TileSched {
  int xcd, local, vbid, vnb, MT, NT, SM, SN, j, snc;
  bool swz;
  DEVI TileSched(int bid, int nb, int half, int MT_, int NT_, int SM_, int SN_) : MT(MT_), NT(NT_), SM(SM_), SN(SN_), j(0) {
    xcd = bid & 7;
    local = (bid >> 3) * 2 + half;
    vbid = bid * 2 + half;
    vnb = nb * 2;
    swz = (vnb == 8 * SM * SN) && ((nb & 7) == 0);
    snc = (NT + SN - 1) / SN;
  }
  DEVI int next(int& mt, int& nt) {
    if (swz) {
      const int s = j * 8 + xcd;
      ++j;
      const int sm = s / snc, sn = s - sm * snc;
      if (sm * SM >= MT) return 0;
      mt = sm * SM + local / SN;
      nt = sn * SN + local % SN;
      return (mt < MT && nt < NT) ? 1 : 2;
    } else {
      const int it = vbid + j * vnb;
      ++j;
      if (it >= MT * NT) return 0;
      mt = it / NT;
      nt = it - mt * NT;
      return 1;
    }
  }
};

struct ALoadPlain {
  typedef uint4 Raw;
  static constexpr bool kFat = false;
  static constexpr bool kConsec = false;
  const bfu* A;
  int lda;
  DEVI Raw load(int row, int k) const { return *(const uint4*)(A + (size_t)row * lda + k); }
  DEVI uint4 loadprev(int, int) const { return uint4{0u, 0u, 0u, 0u}; }
  DEVI uint4 asprev(const Raw&) const { return uint4{0u, 0u, 0u, 0u}; }
  DEVI uint4 finish(const Raw& r, const uint4&, int, int) const { return r; }
};

DEVI void transpose_tile(char* smem, const float* __restrict__ src, int Ns, bfu* __restrict__ dst, int ldd, int noff,
                         int k0, int n0) {
  float(*tile)[65] = (float(*)[65])smem;
  const int tid = TIDX;
  const int kr = tid >> 4, nc = (tid & 15) * 4;
#pragma unroll
  for (int p = 0; p < 4; ++p) {
    float4 v = *(const float4*)(src + (size_t)(k0 + kr + 16 * p) * Ns + n0 + nc);
    tile[kr + 16 * p][nc] = v.x;
    tile[kr + 16 * p][nc + 1] = v.y;
    tile[kr + 16 * p][nc + 2] = v.z;
    tile[kr + 16 * p][nc + 3] = v.w;
  }
  __syncthreads();
  const int nr = tid >> 3, kc = (tid & 7) * 8;
#pragma unroll
  for (int p = 0; p < 2; ++p) {
    const int n = nr + 32 * p;
    float f[8];
#pragma unroll
    for (int j = 0; j < 8; ++j) f[j] = tile[kc + j][n];
    *(uint4*)(dst + (size_t)(noff + n0 + n) * ldd + k0 + kc) = pack8(f);
  }
  __syncthreads();
}

DEVI void rms_row2_bf16(const float* __restrict__ src, const float* __restrict__ g, bfu* __restrict__ dst, int lane) {
  float4 v[2][4];
  float ss[2] = {0.f, 0.f};
#pragma unroll
  for (int r = 0; r < 2; ++r)
#pragma unroll
    for (int i = 0; i < 4; ++i) v[r][i] = *(const float4*)(src + r * 1024 + lane * 4 + 256 * i);
#pragma unroll
  for (int r = 0; r < 2; ++r)
#pragma unroll
    for (int i = 0; i < 4; ++i)
      ss[r] += v[r][i].x * v[r][i].x + v[r][i].y * v[r][i].y + v[r][i].z * v[r][i].z + v[r][i].w * v[r][i].w;
#pragma unroll
  for (int r = 0; r < 2; ++r) {
    const float rinv = rsqrtf(wave_sum(ss[r]) * (1.f / 1024.f) + 1e-6f);
#pragma unroll
    for (int i = 0; i < 4; ++i) {
      const float4 gg = *(const float4*)(g + lane * 4 + 256 * i);
      uint2 o;
      o.x = pkbf(v[r][i].x * rinv * gg.x, v[r][i].y * rinv * gg.y);
      o.y = pkbf(v[r][i].z * rinv * gg.z, v[r][i].w * rinv * gg.w);
      *(uint2*)(dst + r * 1024 + lane * 4 + 256 * i) = o;
    }
  }
}

DEVI void phase0(const Params& p, char* smem, int bid, int nb) {
  constexpr int NT_IN = 16 * 56, NT_SQ = 256, NT_SM = 16;
  constexpr int c0 = NT_IN, c1 = c0 + NT_SQ, c2 = c1 + 4 * NT_SQ, c3 = c2 + NT_SM, c4 = c3 + NT_SM, c5 = c4 + NT_SQ,
                c6 = c5 + NT_SM, c7 = c6 + NT_SM, c8 = c7 + 2, c9 = c8 + T_TOK / 8;
  smem += HF * HALF_SMEM;
  for (int it = bid * 2 + HF; it < c9; it += nb * 2) {
    if (it < c0) {
      transpose_tile(smem, p.w_in, 3584, p.WT_in, 1024, 0, (it / 56) * 64, (it % 56) * 64);
    } else if (it < c1) {
      int j = it - c0;
      transpose_tile(smem, p.w_out, 1024, p.WT_out, 1024, 0, (j >> 4) * 64, (j & 15) * 64);
    } else if (it < c2) {
      int j = it - c1;
      int w = j >> 8;
      j &= 255;
      const float* src = (w == 0) ? p.wr : (w == 1) ? p.wk : (w == 2) ? p.wv : p.wg;
      transpose_tile(smem, src, 1024, p.WT_3, 1024, w * 1024, (j >> 4) * 64, (j & 15) * 64);
    } else if (it < c3) {
      int j = it - c2;
      transpose_tile(smem, p.w1, 64, p.WT_3, 1024, 4096, j * 64, 0);
    } else if (it < c4) {
      int j = it - c3;
      transpose_tile(smem, p.a1, 64, p.WT_3, 1024, 4224, j * 64, 0);
    } else if (it < c5) {
      int j = it - c4;
      transpose_tile(smem, p.wo, 1024, p.WT_o, 1024, 0, (j >> 4) * 64, (j & 15) * 64);
    } else if (it < c6) {
      int j = it - c5;
      transpose_tile(smem, p.w2, 1024, p.W2T, 64, 0, 0, j * 64);
    } else if (it < c7) {
      int j = it - c6;
      transpose_tile(smem, p.a2, 1024, p.A2T, 64, 0, 0, j * 64);
    } else if (it < c8) {
      int j = it - c7;
      bfu* dst = p.WT_3 + (size_t)(j == 0 ? 4160 : 4288) * 1024;
      for (int e = TIDX; e < 64 * 1024 / 8; e += 256) *(uint4*)(dst + e * 8) = uint4{0, 0, 0, 0};
    } else {
      int row = (it - c8) * 8 + (TIDX >> 6) * 2;
      rms_row2_bf16(p.x + (size_t)row * 1024, p.ln_even, p.H + (size_t)row * 1024, TIDX & 63);
    }
  }
}

struct PgEpi1 {
  static constexpr bool PERM = true, AFTER_DRAIN = false;
  const Params* p;
  DEVI void operator()(const pg8::f32x4 (&acc)[2][2][4][2], const pg8::Unit& u, int wr, int wc, int fr, int fq) const {
    const int row0 = u.pm * 256 + wr * 64 + fr;
    const int seg = u.pn;
#pragma unroll
    for (int ai = 0; ai < 2; ++ai)
#pragma unroll
      for (int m = 0; m < 4; ++m) {
        const int row = row0 + ai * 128 + m * 16;
#pragma unroll
        for (int bj = 0; bj < 2; ++bj) {
          const int col = u.pn * 256 + bj * 128 + wc * 32 + 8 * fq;
          const f32x4 v0 = acc[ai][bj][m][0], v1 = acc[ai][bj][m][1];
          if (seg < 2) {
            uint4 w;
            w.x = pkbf(gelu_(v0[0]), gelu_(v0[1])); w.y = pkbf(gelu_(v0[2]), gelu_(v0[3]));
            w.z = pkbf(gelu_(v1[0]), gelu_(v1[1])); w.w = pkbf(gelu_(v1[2]), gelu_(v1[3]));
            *(uint4*)(p->U + (size_t)row * 512 + col) = w;
          } else if (seg < 4) {
            const int g = (col - 512) >> 7, c0 = col & 127, chunk = row >> 7, s = row & 127;
            bfu* base = p->GVT + ((size_t)((chunk * 4 + g) * 128 + c0)) * 128 + s;
#pragma unroll
            for (int e = 0; e < 4; ++e) {
              base[(size_t)e * 128] = (bfu)f2bf(gelu_(v0[e]));
              base[(size_t)(e + 4) * 128] = (bfu)f2bf(gelu_(v1[e]));
            }
          } else if (seg < 8) {
            uint4 w;
            w.x = pkbf(v0[0], v0[1]); w.y = pkbf(v0[2], v0[3]); w.z = pkbf(v1[0], v1[1]); w.w = pkbf(v1[2], v1[3]);
            bfu* dst = (seg < 6) ? p->Q + (size_t)row * 512 + (col - 1024) : p->K + (size_t)row * 512 + (col - 1536);
            *(uint4*)dst = w;
          } else if (seg < 10) {
            const int cc = col - 2048, hh = cc >> 6, dim0 = cc & 63;
            const int b = row >> 14, s = row & (SEQ - 1);
            bfu* base = p->VT + ((size_t)((b * 8 + hh) * 64 + dim0)) * SEQ;
            const size_t PST = (size_t)16 * 64 * SEQ;
            const int o1 = (s & 3) * (SEQ / 4) + (s >> 2), o2 = (s & 15) * (SEQ / 16) + (s >> 4);
#pragma unroll
            for (int e = 0; e < 8; ++e) {
              const bfu val = (bfu)f2bf(e < 4 ? v0[e & 3] : v1[e & 3]);
              bfu* bd = base + (size_t)e * SEQ;
              bd[s] = val;
              bd[PST + o1] = val;
              bd[2 * PST + o2] = val;
            }
          } else {
            uint4 w;
            w.x = pkbf(silu_(v0[0]), silu_(v0[1])); w.y = pkbf(silu_(v0[2]), silu_(v0[3]));
            w.z = pkbf(silu_(v1[0]), silu_(v1[1])); w.w = pkbf(silu_(v1[2]), silu_(v1[3]));
            *(uint4*)(p->SZ + (size_t)row * 1024 + (col - 2560)) = w;
          }
        }
      }
  }
};
struct PgEpiRes {
  static constexpr bool PERM = false, AFTER_DRAIN = false;
  const float* base;
  float* out;
  DEVI void operator()(const pg8::f32x4 (&acc)[2][2][4][2], const pg8::Unit& u, int wr, int wc, int fr, int fq) const {
    const int row0 = u.pm * 256 + wr * 64 + fr, col0 = u.pn * 256 + wc * 32 + 4 * fq;
#pragma unroll
    for (int ai = 0; ai < 2; ++ai)
#pragma unroll
      for (int m = 0; m < 4; ++m) {
        const size_t rb = (size_t)(row0 + ai * 128 + m * 16) * 1024 + col0;
#pragma unroll
        for (int bj = 0; bj < 2; ++bj)
#pragma unroll
          for (int n = 0; n < 2; ++n) {
            const size_t idx = rb + bj * 128 + n * 16;
            const f32x4 b = *(const f32x4*)(base + idx);
            *(f32x4*)(out + idx) = acc[ai][bj][m][n] + b;
          }
      }
  }
};
template <class Epi>
DEVI void pg_gemm(char* smem, const bfu* A, const bfu* Bt, int M, int N, int K, const Epi& E, int bid, int nb) {
  pg8::Gemm g{A, Bt, M, N, K, A, 1 << 30};
  pg8::StaticOrder S;
  S.init(M, N, nb, bid);
  pg8::gemm_phase<Epi, pg8::StaticOrder, false>((PG8_LAS unsigned char*)smem, g, S, E, nullptr);
}
template <class Epi>
DEVI void pg_gemm2(char* smem, const bfu* A, const bfu* A2, int pn_split, const bfu* Bt, int M, int N, int K, const Epi& E,
                   int bid, int nb) {
  pg8::Gemm g{A, Bt, M, N, K, A2, pn_split};
  pg8::StaticOrder S;
  S.init(M, N, nb, bid);
  pg8::gemm_phase<Epi, pg8::StaticOrder, false>((PG8_LAS unsigned char*)smem, g, S, E, nullptr);
}
struct PgEpi3 {
  static constexpr bool PERM = true, AFTER_DRAIN = false;
  bfu* O0;
  bfu* O1;
  int silu1;
  DEVI void operator()(const pg8::f32x4 (&acc)[2][2][4][2], const pg8::Unit& u, int wr, int wc, int fr, int fq) const {
    const int row0 = u.pm * 256 + wr * 64 + fr;
    const int grp = u.pn >> 2;
    bfu* O = grp ? O1 : O0;
    const bool act = grp && silu1;
    const int colb = (u.pn & 3) * 256 + wc * 32 + 8 * fq;
#pragma unroll
    for (int ai = 0; ai < 2; ++ai)
#pragma unroll
      for (int m = 0; m < 4; ++m) {
        bfu* rowp = O + (size_t)(row0 + ai * 128 + m * 16) * 1024 + colb;
#pragma unroll
        for (int bj = 0; bj < 2; ++bj) {
          f32x4 v0 = acc[ai][bj][m][0], v1 = acc[ai][bj][m][1];
          if (act) {
#pragma unroll
            for (int e = 0; e < 4; ++e) {
              v0[e] = silu_(v0[e]);
              v1[e] = silu_(v1[e]);
            }
          }
          uint4 w;
          w.x = pkbf(v0[0], v0[1]); w.y = pkbf(v0[2], v0[3]); w.z = pkbf(v1[0], v1[1]); w.w = pkbf(v1[2], v1[3]);
          *(uint4*)(rowp + bj * 128) = w;
        }
      }
  }
};

DEVI void phase1(const Params& p, char* smem, int bid, int nb) {
  PgEpi1 E{&p};
  pg_gemm(smem, p.H, p.WT_in, T_TOK, 3584, 1024, E, bid, nb);
}

struct ALoadWs {
  struct Raw { float4 a, b; };
  static constexpr bool kFat = true;
  static constexpr bool kConsec = false;
  const float* ws;
  const float* rinv;
  DEVI Raw load(int t, int s0) const {
    Raw r;
    r.a = *(const float4*)(ws + t * 128 + s0);
    r.b = *(const float4*)(ws + t * 128 + s0 + 4);
    return r;
  }
  DEVI uint4 loadprev(int, int) const { return uint4{0u, 0u, 0u, 0u}; }
  DEVI uint4 asprev(const Raw&) const { return uint4{0u, 0u, 0u, 0u}; }
  DEVI uint4 finish(const Raw& r, const uint4&, int t, int s0) const {
    float f[8] = {r.a.x, r.a.y, r.a.z, r.a.w, r.b.x, r.b.y, r.b.z, r.b.w};
#pragma unroll
    for (int j = 0; j < 8; ++j) f[j] = (s0 + j <= t) ? f[j] * rinv[s0 + j] : 0.f;
    return pack8(f);
  }
};
struct EpiGm {
  const Params* p;
  int chunk, g;
  DEVI void operator()(int t, int c, f32x4 v) const {
    const float4 gn = *(const float4*)(p->gm_norm + g * 128 + c);
    const float bias = p->gm_b[g * 128 + t];
    const size_t tok = (size_t)chunk * 128 + t;
    float u[4], sz[4];
    unpack4(*(const uint2*)(p->U + tok * 512 + g * 128 + c), u);
    unpack4(*(const uint2*)(p->SZ + tok * 1024 + g * 128 + c), sz);
    uint2 o;
    o.x = pkbf(u[0] * (v[0] * gn.x + bias) * sz[0], u[1] * (v[1] * gn.y + bias) * sz[1]);
    o.y = pkbf(u[2] * (v[2] * gn.z + bias) * sz[2], u[3] * (v[3] * gn.w + bias) * sz[3]);
    *(uint2*)(p->Y + tok * 1024 + g * 128 + c) = o;
  }
};

DEVI void gmlp_item(const Params& p, char* smem, int item) {
  const int chunk = item >> 2, g = item & 3;
  const bfu* gv = p.GVT + (size_t)item * 128 * 128;
  float* rinv = (float*)(smem + 2 * GSTAGE_BYTES);
  const int tid = TIDX;
  {
    float* sred = rinv + 128;
    const int s4 = (tid & 31) * 4, cg = tid >> 5;
    uint2 raw[16];
#pragma unroll
    for (int i = 0; i < 16; ++i) raw[i] = *(const uint2*)(gv + (cg * 16 + i) * 128 + s4);
    float ss[4] = {0.f, 0.f, 0.f, 0.f};
#pragma unroll
    for (int i = 0; i < 16; ++i) {
      float f[4];
      unpack4(raw[i], f);
#pragma unroll
      for (int j = 0; j < 4; ++j) ss[j] += f[j] * f[j];
    }
    *(float4*)(sred + cg * 128 + s4) = float4{ss[0], ss[1], ss[2], ss[3]};
    __syncthreads();
    if (tid < 128) {
      float t = 0.f;
#pragma unroll
      for (int i = 0; i < 8; ++i) t += sred[i * 128 + tid];
      rinv[tid] = rsqrtf(t * (1.f / 128.f) + 1e-6f);
    }
  }
  __syncthreads();
  ALoadWs al{p.gm_ws + (size_t)g * 128 * 128, rinv};
  EpiGm epi{&p, chunk, g};
  gemm_tile(smem, al, gv, 128, 128, 0, 0, epi);
}

DEVI void attn_item(const Params& p, char* smem, int item) {
  const int qb = item & 63, bh = item >> 6, b = bh >> 3, h = bh & 7;
  const int q0 = qb * 256;
  bfu* Ob = (bfu*)smem;
  float* Mb = (float*)(smem + 32768);
  float* Lb = Mb + 256;
  const int tid = threadIdx.x, lane = tid & 63, wid = tid >> 6;
  const int qi = lane & 15, g = lane >> 4;
  const float slope = exp2f(-(float)(h + 1));
  const size_t tokb = (size_t)b * SEQ;
#pragma unroll 1
  for (int pi = 0; pi < 3; ++pi) {
    const int dshift = 2 * pi, d = 1 << dshift;
    const bfu* VT = p.VT + (size_t)pi * ((size_t)16 * 64 * SEQ) + (size_t)bh * 64 * SEQ;
#pragma unroll 1
    for (int u = wid; u < 16; u += 8) {
      const int r = u & (d - 1), tile = u >> dshift;
      const int sq0 = (q0 >> dshift) + tile * 16;
      const int sk0 = sq0 - 144;
      const int posq = ((sq0 + qi) << dshift) + r;
      const bfu* qp = p.Q + (tokb + posq) * 512 + h * 64 + g * 8;
      const bf16x8 qf0 = *(const bf16x8*)qp, qf1 = *(const bf16x8*)(qp + 32);
      const bfu* kbase = p.K + (tokb + r) * 512 + h * 64 + g * 8;
      const bfu* vbase = VT + (size_t)qi * SEQ + r * (SEQ >> dshift);
      bf16x8 kf[2][2];
      uint2 vf[4][2];
      auto loadkv = [&](int it) {
#pragma unroll
        for (int tt = 0; tt < 2; ++tt) {
          int sk = sk0 + (2 * it + tt) * 16 + qi;
          sk = sk < 0 ? 0 : sk;
          const bfu* kp = kbase + ((size_t)sk << dshift) * 512;
          kf[tt][0] = *(const bf16x8*)kp;
          kf[tt][1] = *(const bf16x8*)(kp + 32);
        }
        int kidx0 = sk0 + 32 * it + 4 * g, kidx1 = kidx0 + 16;
        kidx0 = kidx0 < 0 ? 0 : kidx0;
        kidx1 = kidx1 < 0 ? 0 : kidx1;
#pragma unroll
        for (int m = 0; m < 4; ++m) {
          vf[m][0] = *(const uint2*)(vbase + (size_t)(16 * m) * SEQ + kidx0);
          vf[m][1] = *(const uint2*)(vbase + (size_t)(16 * m) * SEQ + kidx1);
        }
      };
      loadkv(0);
      float mrun = -1e30f, l = 0.f;
      f32x4 O[4];
#pragma unroll
      for (int m = 0; m < 4; ++m) O[m] = f32x4{0.f, 0.f, 0.f, 0.f};
#pragma unroll 1
      for (int it = 0; it < 5; ++it) {
        bf16x8 ck[2][2];
        uint2 cv[4][2];
#pragma unroll
        for (int a = 0; a < 2; ++a)
#pragma unroll
          for (int c = 0; c < 2; ++c) ck[a][c] = kf[a][c];
#pragma unroll
        for (int m = 0; m < 4; ++m) {
          cv[m][0] = vf[m][0];
          cv[m][1] = vf[m][1];
        }
        if (it < 4) loadkv(it + 1);
        f32x4 S[2];
#pragma unroll
        for (int tt = 0; tt < 2; ++tt) {
          f32x4 z = {0.f, 0.f, 0.f, 0.f};
          z = __builtin_amdgcn_mfma_f32_16x16x32_bf16(ck[tt][0], qf0, z, 0, 0, 0);
          z = __builtin_amdgcn_mfma_f32_16x16x32_bf16(ck[tt][1], qf1, z, 0, 0, 0);
          S[tt] = z;
        }
        float mx = -INFINITY;
#pragma unroll
        for (int tt = 0; tt < 2; ++tt)
#pragma unroll
          for (int e = 0; e < 4; ++e) {
            const int kk = (2 * it + tt) * 16 + 4 * g + e;
            const int j = 144 + qi - kk;
            const bool valid = (j >= 0) && (j <= 128) && (sk0 + kk >= 0);
            const float sv = valid ? S[tt][e] * 0.125f - slope * (float)(j << dshift) : -INFINITY;
            S[tt][e] = sv;
            mx = fmaxf(mx, sv);
          }
        mx = fmaxf(mx, __shfl_xor(mx, 16));
        mx = fmaxf(mx, __shfl_xor(mx, 32));
        const float mnew = fmaxf(mrun, mx);
        const float alpha = __expf(mrun - mnew);
        mrun = mnew;
        float ls = 0.f;
#pragma unroll
        for (int tt = 0; tt < 2; ++tt)
#pragma unroll
          for (int e = 0; e < 4; ++e) {
            const float pe = __expf(S[tt][e] - mnew);
            S[tt][e] = pe;
            ls += pe;
          }
        l = l * alpha + ls;
        uint4 pk;
        pk.x = pkbf(S[0][0], S[0][1]);
        pk.y = pkbf(S[0][2], S[0][3]);
        pk.z = pkbf(S[1][0], S[1][1]);
        pk.w = pkbf(S[1][2], S[1][3]);
        const bf16x8 pf = __builtin_bit_cast(bf16x8, pk);
#pragma unroll
        for (int m = 0; m < 4; ++m) {
          O[m] *= alpha;
          const uint4 vv = {cv[m][0].x, cv[m][0].y, cv[m][1].x, cv[m][1].y};
          O[m] = __builtin_amdgcn_mfma_f32_16x16x32_bf16(__builtin_bit_cast(bf16x8, vv), pf, O[m], 0, 0, 0);
        }
      }
      l += __shfl_xor(l, 16);
      l += __shfl_xor(l, 32);
      const float mx = mrun;
      const float il = 1.f / l;
      const int ql = ((tile * 16 + qi) << dshift) + r;
      float wo = 0.f, wn = 1.f;
      float mnew = mx, lnew = l;
      if (pi > 0) {
        const float mo = Mb[ql], lo = Lb[ql];
        mnew = fmaxf(mo, mx);
        wo = lo * __expf(mo - mnew);
        wn = l * __expf(mx - mnew);
        lnew = wo + wn;
        const float inv = 1.f / lnew;
        wo *= inv;
        wn *= inv;
      }
      wn *= il;
#pragma unroll
      for (int m = 0; m < 4; ++m) {
        bfu* op = Ob + ql * 64 + 16 * m + 4 * g;
        float o[4];
        if (pi > 0) {
          const uint2 ov = *(const uint2*)op;
          o[0] = wo * bf2f(ov.x & 0xffffu) + wn * O[m][0];
          o[1] = wo * bf2f(ov.x >> 16) + wn * O[m][1];
          o[2] = wo * bf2f(ov.y & 0xffffu) + wn * O[m][2];
          o[3] = wo * bf2f(ov.y >> 16) + wn * O[m][3];
        } else {
#pragma unroll
          for (int e = 0; e < 4; ++e) o[e] = wn * O[m][e];
        }
        if (pi < 2) {
          uint2 w;
          w.x = pkbf(o[0], o[1]);
          w.y = pkbf(o[2], o[3]);
          *(uint2*)op = w;
        } else {
          const size_t oi = (tokb + q0 + ql) * 1024 + 512 + h * 64 + 16 * m + 4 * g;
          const uint2 sz = *(const uint2*)(p.SZ + oi);
          uint2 w;
          w.x = pkbf(o[0] * bf2f(sz.x & 0xffffu), o[1] * bf2f(sz.x >> 16));
          w.y = pkbf(o[2] * bf2f(sz.y & 0xffffu), o[3] * bf2f(sz.y >> 16));
          *(uint2*)(p.Y + oi) = w;
        }
      }
      if (pi < 2 && g == 0) {
        Mb[ql] = mnew;
        Lb[ql] = lnew;
      }
    }
    __syncthreads();
  }
}

DEVI void phase2(const Params& p, char* smem, int bid, int nb) {
  for (int it = bid; it < 16 * 64; it += nb) attn_item(p, smem, it);
  char* hs = smem + HF * HALF_SMEM;
  for (int it = bid * 2 + HF; it < (T_TOK / 128) * 4; it += nb * 2) gmlp_item(p, hs, it);
}

DEVI void phase3(const Params& p, char* smem, int bid, int nb) {
  PgEpiRes E{p.x, p.out};
  pg_gemm(smem, p.Y, p.WT_out, T_TOK, 1024, 1024, E, bid, nb);
}
DEVI void phase3b(const Params& p, int bid, int nb) {
  for (int it = bid; it < T_TOK / 16; it += nb) {
    const int row = it * 16 + (threadIdx.x >> 6) * 2;
    rms_row2_bf16(p.out + (size_t)row * 1024, p.ln_odd, p.H + (size_t)row * 1024, threadIdx.x & 63);
  }
}

struct ALoadMix {
  typedef uint4 Raw;
  static constexpr bool kFat = true;
  static constexpr bool kConsec = true;
  const bfu* H;
  const float* mu;
  DEVI Raw load(int row, int k) const { return *(const uint4*)(H + (size_t)row * 1024 + k); }
  DEVI uint4 loadprev(int row, int k) const {
    const int prow = ((row & (SEQ - 1)) != 0) ? row - 1 : row;
    return *(const uint4*)(H + (size_t)prow * 1024 + k);
  }
  DEVI uint4 asprev(const Raw& r) const { return r; }
  DEVI uint4 finish(const Raw& r, const uint4& pr, int row, int k) const {
    float c[8], pv[8];
    unpack8(r, c);
    unpack8(pr, pv);
    const float first = ((row & (SEQ - 1)) != 0) ? 1.f : 0.f;
    const float4 m0 = *(const float4*)(mu + k), m1 = *(const float4*)(mu + k + 4);
    const float mm[8] = {m0.x, m0.y, m0.z, m0.w, m1.x, m1.y, m1.z, m1.w};
#pragma unroll
    for (int j = 0; j < 8; ++j) c[j] = c[j] + (pv[j] * first - c[j]) * mm[j];
    return pack8(c);
  }
};
struct Epi4 {
  const Params* p;
  int nt;
  DEVI void operator()(int row, int col, f32x4 v) const {
    uint2 o;
    if (nt < 24) {
      o.x = pkbf(v[0], v[1]);
      o.y = pkbf(v[2], v[3]);
      bfu* dst = (nt < 8) ? p->R + (size_t)row * 1024 + col
                          : (nt < 16) ? p->K1 + (size_t)row * 1024 + col - 1024 : p->V1 + (size_t)row * 1024 + col - 2048;
      *(uint2*)dst = o;
    } else if (nt < 32) {
      o.x = pkbf(silu_(v[0]), silu_(v[1]));
      o.y = pkbf(silu_(v[2]), silu_(v[3]));
      *(uint2*)(p->SG + (size_t)row * 1024 + col - 3072) = o;
    } else if (nt == 32) {
      const int c = col - 4096;
      if (c < 64) {
        o.x = pkbf(tanh_(v[0]), tanh_(v[1]));
        o.y = pkbf(tanh_(v[2]), tanh_(v[3]));
        *(uint2*)(p->TW + (size_t)row * 64 + c) = o;
      }
    } else {
      const int c = col - 4224;
      if (c < 64) {
        o.x = pkbf(v[0], v[1]);
        o.y = pkbf(v[2], v[3]);
        *(uint2*)(p->TA + (size_t)row * 64 + c) = o;
      }
    }
  }
};
DEVI void phase4_tile(const Params& p, char* smem, int mt, int nt) {
  float* smu = (float*)(smem + 2 * GSTAGE_BYTES);
  const int mi = (nt < 8) ? 0 : (nt < 16) ? 2 : (nt < 24) ? 3 : (nt < 32) ? 5 : (nt == 32) ? 1 : 4;
  *(float4*)(smu + TIDX * 4) = *(const float4*)(p.mu + mi * 1024 + TIDX * 4);
  __syncthreads();
  ALoadMix al{p.H, smu};
  Epi4 epi{&p, nt};
  gemm_tile<1>(smem, al, p.WT_3, 1024, 1024, mt * 128, nt * 128, epi);
}
DEVI void phaseM(const Params& p, char* smem, int bid, int nb) {
  char* hs = smem + HF * HALF_SMEM;
  for (int it = bid * 2 + HF; it < (T_TOK / 128) * 2; it += nb * 2) phase4_tile(p, hs, it >> 1, 32 + (it & 1));
  const int tid = threadIdx.x;
  const int cc = (tid & 127) * 8, rsub = tid >> 7;
  float mr[8], mk[8], mv[8], mg[8];
  {
    const float4 a0 = *(const float4*)(p.mu + 0 * 1024 + cc), a1 = *(const float4*)(p.mu + 0 * 1024 + cc + 4);
    const float4 b0 = *(const float4*)(p.mu + 2 * 1024 + cc), b1 = *(const float4*)(p.mu + 2 * 1024 + cc + 4);
    const float4 c0 = *(const float4*)(p.mu + 3 * 1024 + cc), c1 = *(const float4*)(p.mu + 3 * 1024 + cc + 4);
    const float4 d0 = *(const float4*)(p.mu + 5 * 1024 + cc), d1 = *(const float4*)(p.mu + 5 * 1024 + cc + 4);
    mr[0] = a0.x; mr[1] = a0.y; mr[2] = a0.z; mr[3] = a0.w; mr[4] = a1.x; mr[5] = a1.y; mr[6] = a1.z; mr[7] = a1.w;
    mk[0] = b0.x; mk[1] = b0.y; mk[2] = b0.z; mk[3] = b0.w; mk[4] = b1.x; mk[5] = b1.y; mk[6] = b1.z; mk[7] = b1.w;
    mv[0] = c0.x; mv[1] = c0.y; mv[2] = c0.z; mv[3] = c0.w; mv[4] = c1.x; mv[5] = c1.y; mv[6] = c1.z; mv[7] = c1.w;
    mg[0] = d0.x; mg[1] = d0.y; mg[2] = d0.z; mg[3] = d0.w; mg[4] = d1.x; mg[5] = d1.y; mg[6] = d1.z; mg[7] = d1.w;
  }
#pragma unroll 1
  for (int it = bid; it < T_TOK / 8; it += nb) {
    const int ra = it * 8 + rsub, rb = ra + 4;
    const size_t oa = (size_t)ra * 1024 + cc, ob = (size_t)rb * 1024 + cc;
    const uint4 ca = *(const uint4*)(p.H + oa), cb = *(const uint4*)(p.H + ob);
    const uint4 pa = *(const uint4*)(p.H + (((ra & (SEQ - 1)) != 0) ? oa - 1024 : oa));
    const uint4 pb = *(const uint4*)(p.H + ob - 1024);
    const float fa = ((ra & (SEQ - 1)) != 0) ? 1.f : 0.f;
#pragma unroll
    for (int half = 0; half < 2; ++half) {
      float c[8], d[8], o[8];
      unpack8(half ? cb : ca, c);
      unpack8(half ? pb : pa, d);
      const float f = half ? 1.f : fa;
      const size_t oo = half ? ob : oa;
#pragma unroll
      for (int j = 0; j < 8; ++j) d[j] = d[j] * f - c[j];
#pragma unroll
      for (int j = 0; j < 8; ++j) o[j] = c[j] + d[j] * mr[j];
      *(uint4*)(p.XR + oo) = pack8(o);
#pragma unroll
      for (int j = 0; j < 8; ++j) o[j] = c[j] + d[j] * mk[j];
      *(uint4*)(p.XK + oo) = pack8(o);
#pragma unroll
      for (int j = 0; j < 8; ++j) o[j] = c[j] + d[j] * mv[j];
      *(uint4*)(p.XV + oo) = pack8(o);
#pragma unroll
      for (int j = 0; j < 8; ++j) o[j] = c[j] + d[j] * mg[j];
      *(uint4*)(p.XG + oo) = pack8(o);
    }
  }
}
DEVI void phase3a(const Params& p, char* smem, int bid, int nb) {
  PgEpi3 E{p.R, p.K1, 0};
  pg_gemm2(smem, p.XR, p.XK, 4, p.WT_3, T_TOK, 2048, 1024, E, bid, nb);
}
DEVI void phase3c(const Params& p, char* smem, int bid, int nb) {
  PgEpi3 E{p.V1, p.SG, 1};
  pg_gemm2(smem, p.XV, p.XG, 4, p.WT_3 + (size_t)2048 * 1024, T_TOK, 2048, 1024, E, bid, nb);
}

struct Epi5w {
  const Params* p;
  DEVI void operator()(int row, int col, f32x4 v) const {
    const float4 w0 = *(const float4*)(p->w0 + col);
    const float k = 0.6065306597126334f;
    uint2 o;
    o.x = pkbf(k * sigmoid_(w0.x + v[0]), k * sigmoid_(w0.y + v[1]));
    o.y = pkbf(k * sigmoid_(w0.z + v[2]), k * sigmoid_(w0.w + v[3]));
    *(uint2*)(p->EW + (size_t)row * 1024 + col) = o;
  }
};
struct Epi5a {
  const Params* p;
  DEVI void operator()(int row, int col, f32x4 v) const {
    const float4 a0 = *(const float4*)(p->a0 + col);
    uint2 o;
    o.x = pkbf(sigmoid_(a0.x + v[0]), sigmoid_(a0.y + v[1]));
    o.y = pkbf(sigmoid_(a0.z + v[2]), sigmoid_(a0.w + v[3]));
    *(uint2*)(p->AA + (size_t)row * 1024 + col) = o;
  }
};
DEVI void phase5(const Params& p, char* smem, int bid, int nb) {
  constexpr int N1 = (T_TOK / 128) * 8;
  char* hs = smem + HF * HALF_SMEM;
  for (int it = bid * 2 + HF; it < 2 * N1; it += nb * 2) {
    if (it < N1) {
      ALoadPlain al{p.TW, 64};
      Epi5w epi{&p};
      gemm_tile(hs, al, p.W2T, 64, 64, (it >> 3) * 128, (it & 7) * 128, epi);
    } else {
      const int j = it - N1;
      ALoadPlain al{p.TA, 64};
      Epi5a epi{&p};
      gemm_tile(hs, al, p.A2T, 64, 64, (j >> 3) * 128, (j & 7) * 128, epi);
    }
  }
}

DEVI void scanx_item(const Params& p, char* smem, int item, int next_item, uint2& ur, uint2& uk, uint2& ue, uint2& ua, uint2& uv) {
  const int bh = item & 31, c = item >> 5;
  const int b = bh >> 4, h = bh & 15;
  const size_t rowbase = ((size_t)b * SEQ + (size_t)c * 16) * 1024 + h * 64;
  float* sA = (float*)smem;
  float* sR = sA + 16 * 68;
  float* sBt = sR + 16 * 68;
  float* sKt = sBt + 16 * 68;
  float* sE = sKt + 16 * 68;
  float* sMab = sE + 16 * 64;
  float* sMak = sMab + 256;
  float* sM2 = sMak + 256;
  float* sM4 = sM2 + 256;
  float* sT = sM4 + 256;
  float* sT2 = sT + 256;
  const int tid = TIDX;
  const int tau = tid >> 4, c4 = (tid & 15) * 4;
  const size_t o = rowbase + (size_t)tau * 1024 + c4;
  float r[4], k[4], ew[4], a[4], vv[4];
  unpack4(ur, r);
  unpack4(uk, k);
  unpack4(ue, ew);
  unpack4(ua, a);
  unpack4(uv, vv);
  {
    const int nbh = next_item & 31, nc = next_item >> 5;
    const size_t no = ((size_t)(nbh >> 4) * SEQ + (size_t)nc * 16 + tau) * 1024 + (nbh & 15) * 64 + c4;
    ur = *(const uint2*)(p.R + no);
    uk = *(const uint2*)(p.K1 + no);
    ue = *(const uint2*)(p.EW + no);
    ua = *(const uint2*)(p.AA + no);
    uv = *(const uint2*)(p.V1 + no);
  }
  float kk[4], kp[4], bb[4];
  float ss = 0.f, cf = 0.f;
#pragma unroll
  for (int j = 0; j < 4; ++j) {
    const int ch = h * 64 + c4 + j;
    kk[j] = k[j] * p.k_k[ch];
    ss += kk[j] * kk[j];
    kp[j] = k[j] * (1.f + (a[j] - 1.f) * p.k_a[ch]);
    cf += r[j] * kp[j] * p.r_k[ch];
  }
  ss = reduce16(ss);
  cf = reduce16(cf);
  const float rn = rsqrtf(fmaxf(ss, 1e-24f));
#pragma unroll
  for (int j = 0; j < 4; ++j) {
    kk[j] *= rn;
    bb[j] = kk[j] * a[j];
    sE[tau * 64 + c4 + j] = ew[j];
  }
  if ((tid & 15) == 0) p.COEF[((size_t)b * SEQ + (size_t)c * 16 + tau) * 16 + h] = cf;
  __syncthreads();
  float Li[4] = {0.f, 0.f, 0.f, 0.f}, L15[4] = {0.f, 0.f, 0.f, 0.f};
#pragma unroll
  for (int i = 0; i < 16; ++i) {
    const float4 e = *(const float4*)(sE + i * 64 + c4);
    const float m = (i <= tau) ? 1.f : 0.f;
    Li[0] += m * e.x; Li[1] += m * e.y; Li[2] += m * e.z; Li[3] += m * e.w;
    L15[0] += e.x; L15[1] += e.y; L15[2] += e.z; L15[3] += e.w;
  }
  float rt[4], bhat[4], khat[4];
#pragma unroll
  for (int j = 0; j < 4; ++j) {
    const float ep = __expf(Li[j]), em = __expf(-Li[j]), eh = __expf(-(L15[j] - Li[j]));
    const float at = -kk[j] * __expf(-(Li[j] - ew[j]));
    rt[j] = r[j] * em;
    sA[tau * 68 + c4 + j] = at;
    sR[tau * 68 + c4 + j] = rt[j];
    sBt[tau * 68 + c4 + j] = bb[j] * ep;
    sKt[tau * 68 + c4 + j] = kp[j] * ep;
    bhat[j] = bb[j] * eh;
    khat[j] = kp[j] * eh;
  }
  *(uint2*)(p.R + o) = pack4(rt);
#pragma unroll
  for (int j = 0; j < 4; ++j) {
    const int lin = (c4 + j) * 16 + tau;
    const size_t off = rowbase + (size_t)(lin >> 6) * 1024 + (lin & 63);
    p.EW[off] = (bfu)f2bf(bhat[j]);
    p.K1[off] = (bfu)f2bf(khat[j]);
    p.V1[off] = (bfu)f2bf(vv[j]);
  }
  if (tau == 0) {
    float4 gq = {__expf(-L15[0]), __expf(-L15[1]), __expf(-L15[2]), __expf(-L15[3])};
    *(float4*)(p.G15 + (size_t)item * 64 + c4) = gq;
  }
  __syncthreads();
  {
    const int i = tid >> 4, tq = tid & 15;
    float mab = 0.f, mak = 0.f, mrb = 0.f, mrk = 0.f;
#pragma unroll
    for (int kq = 0; kq < 64; kq += 4) {
      const float4 bi = *(const float4*)(sBt + i * 68 + kq);
      const float4 ki = *(const float4*)(sKt + i * 68 + kq);
      const float4 aq = *(const float4*)(sA + tq * 68 + kq);
      const float4 rq = *(const float4*)(sR + tq * 68 + kq);
      mab += bi.x * aq.x + bi.y * aq.y + bi.z * aq.z + bi.w * aq.w;
      mak += ki.x * aq.x + ki.y * aq.y + ki.z * aq.z + ki.w * aq.w;
      mrb += bi.x * rq.x + bi.y * rq.y + bi.z * rq.z + bi.w * rq.w;
      mrk += ki.x * rq.x + ki.y * rq.y + ki.z * rq.z + ki.w * rq.w;
    }
    if (!(i < tq)) { mab = 0.f; mak = 0.f; }
    if (!(i <= tq)) { mrb = 0.f; mrk = 0.f; }
    sMab[i * 16 + tq] = mab;
    sMak[i * 16 + tq] = mak;
    bfu* mr = p.MRT + (size_t)item * 512 + tq * 32 + (i >> 2) * 8 + (i & 3);
    mr[0] = (bfu)f2bf(mrb);
    mr[4] = (bfu)f2bf(mrk);
  }
  __syncthreads();
  {
    const int i = tid >> 4, j = tid & 15;
    float m2 = 0.f;
#pragma unroll
    for (int kq = 0; kq < 16; ++kq) m2 += sMab[i * 16 + kq] * sMab[kq * 16 + j];
    sM2[i * 16 + j] = m2;
    __syncthreads();
    float t1 = ((i == j) ? 1.f : 0.f) + sMab[i * 16 + j] + m2, m4 = 0.f;
#pragma unroll
    for (int kq = 0; kq < 16; ++kq) {
      t1 += sMab[i * 16 + kq] * sM2[kq * 16 + j];
      m4 += sM2[i * 16 + kq] * sM2[kq * 16 + j];
    }
    sT[i * 16 + j] = t1;
    sM4[i * 16 + j] = m4;
    __syncthreads();
    float t2 = t1, m8 = 0.f;
#pragma unroll
    for (int kq = 0; kq < 16; ++kq) {
      t2 += sT[i * 16 + kq] * sM4[kq * 16 + j];
      m8 += sM4[i * 16 + kq] * sM4[kq * 16 + j];
    }
    sT2[i * 16 + j] = t2;
    __syncthreads();
    sM2[i * 16 + j] = m8;
    __syncthreads();
    float t3 = t2;
#pragma unroll
    for (int kq = 0; kq < 16; ++kq) t3 += sT2[i * 16 + kq] * sM2[kq * 16 + j];
    sT[i * 16 + j] = t3;
    __syncthreads();
  }
  {
    const int tq = tid >> 4, k4 = (tid & 15) * 4, ii = tid & 15;
    float w0 = 0.f, w1 = 0.f, w2 = 0.f, w3 = 0.f, gt = 0.f;
#pragma unroll
    for (int jj = 0; jj < 16; ++jj) {
      const float tm = sT[jj * 16 + tq];
      const float4 av = *(const float4*)(sA + jj * 68 + k4);
      w0 += av.x * tm; w1 += av.y * tm; w2 += av.z * tm; w3 += av.w * tm;
      gt += sMak[ii * 16 + jj] * tm;
    }
    uint2 wv;
    wv.x = pkbf(w0, w1);
    wv.y = pkbf(w2, w3);
    *(uint2*)(p.AA + rowbase + (size_t)tq * 1024 + k4) = wv;
    p.GT[(size_t)item * 256 + tq * 16 + ii] = (bfu)f2bf(gt);
  }
  __syncthreads();
}
DEVI void phase6x(const Params& p, char* smem, int bid, int nb) {
  char* hs = smem + HF * HALF_SMEM;
  constexpr int NI = (SEQ / 16) * 32;
  const int vnb = nb * 2;
  int it = bid * 2 + HF;
  if (it >= NI) return;
  uint2 ur, uk, ue, ua, uv;
  {
    const int tau = TIDX >> 4, c4 = (TIDX & 15) * 4;
    const int bh = it & 31, c = it >> 5;
    const size_t o = ((size_t)(bh >> 4) * SEQ + (size_t)c * 16 + tau) * 1024 + (bh & 15) * 64 + c4;
    ur = *(const uint2*)(p.R + o);
    uk = *(const uint2*)(p.K1 + o);
    ue = *(const uint2*)(p.EW + o);
    ua = *(const uint2*)(p.AA + o);
    uv = *(const uint2*)(p.V1 + o);
  }
#pragma unroll 1
  for (; it < NI; it += vnb) scanx_item(p, hs, it, (it + vnb < NI) ? it + vnb : it, ur, uk, ue, ua, uv);
}

DEVI bf16x8 mk8(uint2 a, uint2 b) {
  const uint4 v = {a.x, a.y, b.x, b.y};
  return __builtin_bit_cast(bf16x8, v);
}
DEVI uint2 packacc(f32x4 a) {
  uint2 r;
  r.x = pkbf(a[0], a[1]);
  r.y = pkbf(a[2], a[3]);
  return r;
}
constexpr int SCH = 4;
constexpr int SROW = 136;
constexpr int SARR = 16 * SROW;
constexpr int SOFF_GT = 5 * SARR;
constexpr int SOFF_MR = SOFF_GT + 512;
constexpr int SOFF_G15 = SOFF_MR + 1024;
constexpr int SIMG = SOFF_G15 + 256;
#define SCANS_LD5(P, I, O)                       \
    P##a##I = *(const uint4*)(p.AA + (O));       \
    P##r##I = *(const uint4*)(p.R + (O));        \
    P##e##I = *(const uint4*)(p.EW + (O));       \
    P##k##I = *(const uint4*)(p.K1 + (O));       \
    P##v##I = *(const uint4*)(p.V1 + (O));
#define SCANS_ISSUE(P, SC)                                                                           \
  {                                                                                                  \
    const size_t hb_ = ((size_t)b * SEQ) * 1024 + h * 64 + c80 * 8;                                  \
    const int tk0_ = (SC) * SCH * 16 + cl0 * 16 + row0;                                              \
    const int tk1_ = tk0_ + 32;                                                                      \
    SCANS_LD5(P, 0, hb_ + (size_t)(tk0_ < SEQ ? tk0_ : SEQ - 1) * 1024)                              \
    SCANS_LD5(P, 1, hb_ + (size_t)(tk1_ < SEQ ? tk1_ : SEQ - 1) * 1024)                              \
    const int c0_ = (SC) * SCH;                                                                      \
    const size_t ib_ = (size_t)b * 16 + h;                                                           \
    const int tg_ = tid < 128 ? tid : 127;                                                           \
    const int cg_ = c0_ + (tg_ >> 5);                                                                \
    P##gm = *(const uint4*)(p.GT + ((size_t)(cg_ < SEQ / 16 ? cg_ : SEQ / 16 - 1) * 32 + ib_) * 256 + (tg_ & 31) * 8);  \
    const int t5_ = tid < 64 ? tid : 63;                                                             \
    const int c5_ = c0_ + (t5_ >> 4);                                                                \
    P##g5 = *(const uint4*)(p.G15 + ((size_t)(c5_ < SEQ / 16 ? c5_ : SEQ / 16 - 1) * 32 + ib_) * 64 + (t5_ & 15) * 4);  \
    const int cm_ = c0_ + (tid >> 6);                                                                \
    P##mr = *(const uint4*)(p.MRT + ((size_t)(cm_ < SEQ / 16 ? cm_ : SEQ / 16 - 1) * 32 + ib_) * 512 + (tid & 63) * 8); \
  }
#define SCANS_ST5(P, I, B)                                                                           \
    *(uint2*)(B) = uint2{P##a##I.x, P##a##I.y};  *(uint2*)((B) + 8) = uint2{P##a##I.z, P##a##I.w};   \
    *(uint2*)((B) + SARR) = uint2{P##r##I.x, P##r##I.y};  *(uint2*)((B) + SARR + 8) = uint2{P##r##I.z, P##r##I.w};   \
    *(uint2*)((B) + 2 * SARR) = uint2{P##e##I.x, P##e##I.y};  *(uint2*)((B) + 2 * SARR + 8) = uint2{P##e##I.z, P##e##I.w};   \
    *(uint2*)((B) + 3 * SARR) = uint2{P##k##I.x, P##k##I.y};  *(uint2*)((B) + 3 * SARR + 8) = uint2{P##k##I.z, P##k##I.w};   \
    *(uint2*)((B) + 4 * SARR) = uint2{P##v##I.x, P##v##I.y};  *(uint2*)((B) + 4 * SARR + 8) = uint2{P##v##I.z, P##v##I.w};
#define SCANS_COMMIT(P)                                                                              \
  {                                                                                                  \
    char* b0_ = smem + cl0 * SIMG + row0 * SROW + c80 * 16;                                          \
    SCANS_ST5(P, 0, b0_)                                                                             \
    SCANS_ST5(P, 1, b0_ + 2 * SIMG)                                                                  \
    if (tid < 128) *(uint4*)(smem + (tid >> 5) * SIMG + SOFF_GT + (tid & 31) * 16) = P##gm;          \
    if (tid < 64) *(uint4*)(smem + (tid >> 4) * SIMG + SOFF_G15 + (tid & 15) * 16) = P##g5;          \
    *(uint4*)(smem + (tid >> 6) * SIMG + SOFF_MR + (tid & 63) * 16) = P##mr;                         \
  }
#define SCANS_COMPUTE(SCI)                                                                           \
  _Pragma("unroll 1") for (int cl = 0; cl < SCH && (SCI) * SCH + cl < SEQ / 16; ++cl) {             \
    const char* img = smem + cl * SIMG;                                                              \
        \
    const uint2 vb = *(const uint2*)(img + 4 * SARR + vrow * SROW + vcol * 2);                       \
    const uint2 gt = *(const uint2*)(img + SOFF_GT + (q * 16 + 4 * g) * 2);                          \
    const char* wp = img + q * SROW + (4 * g) * 2;                                                   \
    const uint2 w00 = *(const uint2*)(wp), w01 = *(const uint2*)(wp + 32);                           \
    const uint2 w10 = *(const uint2*)(wp + 64), w11 = *(const uint2*)(wp + 96);                      \
    const uint2 r00 = *(const uint2*)(wp + SARR), r01 = *(const uint2*)(wp + SARR + 32);             \
    const uint2 r10 = *(const uint2*)(wp + SARR + 64), r11 = *(const uint2*)(wp + SARR + 96);        \
    const uint4 mr = *(const uint4*)(img + SOFF_MR + (q * 32 + g * 8) * 2);                          \
    uint2 bk0[4], bk1[4];                                                                            \
    float4 g15[4];                                                                                   \
    _Pragma("unroll") for (int n = 0; n < 4; ++n) {                                                  \
      const int ch = 16 * n + q;                                                                     \
      const char* bp = img + 2 * SARR + (ch >> 2) * SROW + ((ch & 3) * 16 + 4 * g) * 2;              \
      bk0[n] = *(const uint2*)(bp);                                                                  \
      bk1[n] = *(const uint2*)(bp + SARR);                                                           \
      g15[n] = *(const float4*)(img + SOFF_G15 + (16 * n + 4 * g) * 4);                              \
    }                                                                                                \
    __builtin_amdgcn_sched_barrier(0);                                                               \
    const bf16x8 sB0 = mk8(packacc(acc[0]), packacc(acc[1]));                                        \
    const bf16x8 sB1 = mk8(packacc(acc[2]), packacc(acc[3]));                                        \
    f32x4 Z = {0.f, 0.f, 0.f, 0.f};                                                                  \
    Z = __builtin_amdgcn_mfma_f32_16x16x32_bf16(mk8(gt, zero2), mk8(vb, zero2), Z, 0, 0, 0);         \
    f32x4 Y = {0.f, 0.f, 0.f, 0.f};                                                                  \
    Z = __builtin_amdgcn_mfma_f32_16x16x32_bf16(mk8(w00, w01), sB0, Z, 0, 0, 0);                     \
    Y = __builtin_amdgcn_mfma_f32_16x16x32_bf16(mk8(r00, r01), sB0, Y, 0, 0, 0);                     \
    Z = __builtin_amdgcn_mfma_f32_16x16x32_bf16(mk8(w10, w11), sB1, Z, 0, 0, 0);                     \
    Y = __builtin_amdgcn_mfma_f32_16x16x32_bf16(mk8(r10, r11), sB1, Y, 0, 0, 0);                     \
    const bf16x8 zvB = mk8(packacc(Z), vb);                                                          \
    Y = __builtin_amdgcn_mfma_f32_16x16x32_bf16(__builtin_bit_cast(bf16x8, mr), zvB, Y, 0, 0, 0);    \
    _Pragma("unroll") for (int n = 0; n < 4; ++n) {                                                  \
      f32x4 scv = acc[n];                                                                            \
      scv[0] *= g15[n].x; scv[1] *= g15[n].y; scv[2] *= g15[n].z; scv[3] *= g15[n].w;                \
      acc[n] = __builtin_amdgcn_mfma_f32_16x16x32_bf16(mk8(bk0[n], bk1[n]), zvB, scv, 0, 0, 0);      \
    }                                                                                                \
    const int c = (SCI) * SCH + cl;                                                                  \
    _Pragma("unroll") for (int e = 0; e < 4; ++e)                                                    \
        yout[(size_t)(c * 16 + 4 * g + e) * 1024] = (bfu)f2bf(Y[e]);                                 \
  }
DEVI void scans_block(const Params& p, char* smem, int bh) {
  const int b = bh >> 4, h = bh & 15;
  const int lane = threadIdx.x & 63, vs = threadIdx.x >> 6, q = lane & 15, g = lane >> 4;
  f32x4 acc[4];
#pragma unroll
  for (int n = 0; n < 4; ++n) acc[n] = f32x4{0.f, 0.f, 0.f, 0.f};
  const uint2 zero2 = {0u, 0u};
  bfu* yout = p.YS + ((size_t)b * SEQ) * 1024 + h * 64 + vs * 16 + q;
  const int tid = threadIdx.x;
  const int t2 = (tid - 128) & 63;
  const int cl0 = tid >> 7, row0 = (tid >> 3) & 15, c80 = tid & 7;
  uint4 Aa0, Aa1, Ar0, Ar1, Ae0, Ae1, Ak0, Ak1, Av0, Av1, Agm, Ag5, Amr;
  constexpr int NSC = (SEQ / 16 + SCH - 1) / SCH;
  const int vrow = vs * 4 + (q >> 2), vcol = (q & 3) * 16 + 4 * g;
  SCANS_ISSUE(A, 0);
  SCANS_COMMIT(A);
  __syncthreads();
#pragma unroll 1
  for (int sc = 0; sc < NSC; ++sc) {
    SCANS_ISSUE(A, (sc + 1 < NSC ? sc + 1 : NSC - 1));
    SCANS_COMPUTE(sc);
    __syncthreads();
    SCANS_COMMIT(A);
    __syncthreads();
  }
}
DEVI void phase6(const Params& p, char* smem, int bid, int nb) {
  for (int it = bid; it < 32; it += nb) {
    if (threadIdx.x < 256) {
      scans_block(p, smem, it);
    } else {
      constexpr int NSC = (SEQ / 16 + SCH - 1) / SCH;
      __syncthreads();
#pragma unroll 1
      for (int sc = 0; sc < NSC; ++sc) {
        __syncthreads();
        __syncthreads();
      }
    }
  }
}

DEVI void phase6b(const Params& p, int bid, int nb) {
  const int lane = threadIdx.x & 63, wv = (threadIdx.x >> 6) & 3;
  for (int it = bid; it < T_TOK / 2; it += nb) {
    const int t = it * 2 + (threadIdx.x >> 8);
    const int tb = t & ~15, tau = t & 15;
    float ys[4], vv[4], sg[4], bon[4];
#pragma unroll
    for (int j = 0; j < 4; ++j) {
      const int h = wv * 4 + j;
      const size_t idx = (size_t)t * 1024 + h * 64 + lane;
      ys[j] = bf2f(p.YS[idx]);
      sg[j] = bf2f(p.SG[idx]);
      vv[j] = bf2f(p.V1[(size_t)(tb + (lane >> 2)) * 1024 + h * 64 + (lane & 3) * 16 + tau]);
      bon[j] = p.COEF[(size_t)t * 16 + h];
    }
#pragma unroll
    for (int j = 0; j < 4; ++j) {
      const int h = wv * 4 + j;
      const int c = h * 64 + lane;
      const float mean = wave_sum(ys[j]) * (1.f / 64.f);
      const float dv = ys[j] - mean;
      const float var = wave_sum(dv * dv) * (1.f / 64.f);
      float y = dv * rsqrtf(var + 64e-5f) * p.lnw[c] + p.lnb[c];
      y = (y + bon[j] * vv[j]) * sg[j];
      p.YS[(size_t)t * 1024 + c] = (bfu)f2bf(y);
    }
  }
}

DEVI void phase7(const Params& p, char* smem, int bid, int nb) {
  PgEpiRes E{p.out, p.out};
  pg_gemm(smem, p.YS, p.WT_o, T_TOK, 1024, 1024, E, bid, nb);
}
DEVI void phase8(const Params& p, int bid, int nb) {
  for (int it = bid; it < T_TOK / 16; it += nb) {
    const int row = it * 16 + (threadIdx.x >> 6) * 2;
    const int lane = threadIdx.x & 63;
    float* src = p.out + (size_t)row * 1024;
    float4 v[2][4];
    float ss[2] = {0.f, 0.f};
#pragma unroll
    for (int r = 0; r < 2; ++r)
#pragma unroll
      for (int i = 0; i < 4; ++i) v[r][i] = *(const float4*)(src + r * 1024 + lane * 4 + 256 * i);
#pragma unroll
    for (int r = 0; r < 2; ++r)
#pragma unroll
      for (int i = 0; i < 4; ++i)
        ss[r] += v[r][i].x * v[r][i].x + v[r][i].y * v[r][i].y + v[r][i].z * v[r][i].z + v[r][i].w * v[r][i].w;
#pragma unroll
    for (int r = 0; r < 2; ++r) {
      const float rinv = rsqrtf(wave_sum(ss[r]) * (1.f / 1024.f) + 1e-6f);
#pragma unroll
      for (int i = 0; i < 4; ++i) {
        const float4 g = *(const float4*)(p.fnorm + lane * 4 + 256 * i);
        const float4 o = {v[r][i].x * rinv * g.x, v[r][i].y * rinv * g.y, v[r][i].z * rinv * g.z, v[r][i].w * rinv * g.w};
        *(float4*)(src + r * 1024 + lane * 4 + 256 * i) = o;
      }
    }
  }
}

#define XB_TMO      128
#define XB_XCNT(j)  (256  + 64 * (j))
#define XB_XSUB(j)  (1280 + 64 * (j))
#define XB_XGEN(j)  (2304 + 64 * (j))
#define XB_TOP      3328
#define XB_TOPGEN   3392
#define XCD_BAR_WORDS 3456
#define XB_SPIN_CAP (1u << 18)
#define LAS __attribute__((address_space(3)))

__device__ __forceinline__ unsigned xb_ld(unsigned* p)              { return __hip_atomic_load(p, __ATOMIC_RELAXED, __HIP_MEMORY_SCOPE_AGENT); }
__device__ __forceinline__ unsigned xb_add(unsigned* p, unsigned v) { return __hip_atomic_fetch_add(p, v, __ATOMIC_RELAXED, __HIP_MEMORY_SCOPE_AGENT); }
__device__ __forceinline__ unsigned xb_xcc_id() { return (unsigned)__builtin_amdgcn_s_getreg((3 << 11) | 20) & 0xFu; }
#define XB_SPIN(cond, bar) do { unsigned _sp = 0; while (cond) { __builtin_amdgcn_s_sleep(1); \
    if ((++_sp & 255u) == 0u) { if (xb_ld(&(bar)[XB_TMO])) break; if (_sp > XB_SPIN_CAP) { atomicAdd(&(bar)[XB_TMO], 1u); break; } } } } while (0)

struct XcdBarrier {
    unsigned* bar; unsigned x;
    volatile LAS unsigned* st;
};

__device__ __forceinline__ XcdBarrier xcd_barrier_post(unsigned* bar, volatile LAS unsigned* st) {
    XcdBarrier b; b.bar = bar; b.x = xb_xcc_id(); b.st = st;
    if (threadIdx.x == 0) (void)xb_add(&bar[XB_XCNT(b.x)], 1u);
    return b;
}
__device__ __forceinline__ void xcd_barrier_complete(unsigned* bar, unsigned x, unsigned& nloc, unsigned& nx) {
    const unsigned G = gridDim.x * gridDim.y * gridDim.z;
    unsigned sum, cnt, mine, sp = 0u;
    for (;;) {
        sum = 0u; cnt = 0u; mine = 0u;
#pragma unroll
        for (unsigned j = 0; j < 16; ++j) { const unsigned c = xb_ld(&bar[XB_XCNT(j)]); sum += c; cnt += (c > 0u) ? 1u : 0u; mine = (j == x) ? c : mine; }
        if (sum == G) break;
        __builtin_amdgcn_s_sleep(1);
        if ((++sp & 255u) == 0u) { if (xb_ld(&bar[XB_TMO])) break; if (sp > XB_SPIN_CAP) { atomicAdd(&bar[XB_TMO], 1u); break; } }
    }
    nloc = mine > 0u ? mine : 1u; nx = cnt > 0u ? cnt : 1u;
}

__device__ __forceinline__ void xcd_barrier(const XcdBarrier& b) {
    asm volatile("s_waitcnt vmcnt(0)" ::: "memory");
    __syncthreads();
    if (threadIdx.x == 0) {
        unsigned* bar = b.bar;
        __builtin_amdgcn_s_waitcnt(0);
        unsigned nloc = b.st[0], nx = b.st[1];
        if (nloc == 0u) { xcd_barrier_complete(bar, b.x, nloc, nx); b.st[0] = nloc; b.st[1] = nx; }
        const unsigned old = xb_add(&bar[XB_XSUB(b.x)], 1u);
        const unsigned gen = old / nloc;
        if (old + 1u == (gen + 1u) * nloc) {
            __builtin_amdgcn_fence(__ATOMIC_RELEASE, "agent");
            asm volatile("s_waitcnt vmcnt(0)" ::: "memory");
            const unsigned og = xb_add(&bar[XB_TOP], 1u);
            const unsigned tg = og / nx;
            if (og + 1u == (tg + 1u) * nx) xb_add(&bar[XB_TOPGEN], 1u);
            else XB_SPIN(xb_ld(&bar[XB_TOPGEN]) == tg, bar);
            __builtin_amdgcn_fence(__ATOMIC_ACQUIRE, "agent");
            xb_add(&bar[XB_XGEN(b.x)], 1u);
            asm volatile("s_waitcnt vmcnt(0)" ::: "memory");
        } else {
            XB_SPIN(xb_ld(&bar[XB_XGEN(b.x)]) == gen, bar);
            __builtin_amdgcn_fence(__ATOMIC_ACQUIRE, "agent");
            asm volatile("s_waitcnt vmcnt(0)" ::: "memory");
        }
    }
    __syncthreads();
}


template <int PH>
DEVI void run_phase(const Params& p, char* smem, int bid, int nb) {
  if (PH == 0) phase0(p, smem, bid, nb);
  if (PH == 1) phase1(p, smem, bid, nb);
  if (PH == 2) phase2(p, smem, bid, nb);
  if (PH == 3) phase3(p, smem, bid, nb);
  if (PH == 4) phase3b(p, bid, nb);
  if (PH == 5) phaseM(p, smem, bid, nb);
  if (PH == 6) phase3a(p, smem, bid, nb);
  if (PH == 7) phase3c(p, smem, bid, nb);
  if (PH == 8) phase5(p, smem, bid, nb);
  if (PH == 9) phase6x(p, smem, bid, nb);
  if (PH == 10) phase6(p, smem, bid, nb);
  if (PH == 11) phase6b(p, bid, nb);
  if (PH == 12) phase7(p, smem, bid, nb);
  if (PH == 13) phase8(p, bid, nb);
}

#ifndef REP_MASK
#define REP_MASK 0
#endif
template <int PH>
DEVI void mega_phase(const Params& p, char* smem, cg::grid_group& grid, int bid, int nb) {
  run_phase<PH>(p, smem, bid, nb);
  if ((REP_MASK >> PH) & 1) {
    grid.sync();
    run_phase<PH>(p, smem, bid, nb);
  }
}
__global__ void __launch_bounds__(512, 2) mega_kernel(Params pk) {
  const Params& p = *(const Params*)__builtin_amdgcn_kernarg_segment_ptr();
  extern __shared__ __attribute__((aligned(16))) char smem[];
  cg::grid_group grid = cg::this_grid();
  const int bid = blockIdx.x, nb = gridDim.x;
  volatile LAS unsigned* st = (volatile LAS unsigned*)(smem + SMEM_BYTES);
  if (threadIdx.x == 0) {
    st[0] = 0u;
    st[1] = 0u;
  }
  __syncthreads();
  (void)xcd_barrier_post(p.BAR, st);
#define XBAR() do { XcdBarrier xb_; xb_.bar = p.BAR; xb_.x = xb_xcc_id(); xb_.st = (volatile LAS unsigned*)(smem + SMEM_BYTES); xcd_barrier(xb_); } while (0)
  mega_phase<0>(p, smem, grid, bid, nb); grid.sync();
  mega_phase<1>(p, smem, grid, bid, nb); XBAR();
  mega_phase<2>(p, smem, grid, bid, nb); XBAR();
  mega_phase<3>(p, smem, grid, bid, nb); XBAR();
  mega_phase<4>(p, smem, grid, bid, nb); XBAR();
  mega_phase<5>(p, smem, grid, bid, nb); XBAR();
  mega_phase<6>(p, smem, grid, bid, nb); XBAR();
  mega_phase<7>(p, smem, grid, bid, nb); XBAR();
  mega_phase<8>(p, smem, grid, bid, nb); XBAR();
  mega_phase<9>(p, smem, grid, bid, nb); XBAR();
  mega_phase<10>(p, smem, grid, bid, nb); XBAR();
  mega_phase<11>(p, smem, grid, bid, nb); XBAR();
  mega_phase<12>(p, smem, grid, bid, nb); grid.sync();
  mega_phase<13>(p, smem, grid, bid, nb);
}

extern "C" void kernel_launch(void* const* d_in, const int* in_sizes, int n_in, void* d_out, int out_size, void* d_ws,
                              size_t ws_size, hipStream_t stream) {
  Params p{};
  const float** fp = (const float**)&p;
  for (int i = 0; i < 26; ++i) fp[i] = (const float*)d_in[i];
  p.out = (float*)d_out;
  char* w = (char*)d_ws;
  size_t off = 0;
  auto take = [&](size_t bytes) {
    char* r = w + off;
    off += (bytes + 255) & ~(size_t)255;
    return (bfu*)r;
  };
  p.WT_in = take((size_t)3584 * 1024 * 2);
  p.WT_out = take((size_t)1024 * 1024 * 2);
  p.WT_3 = take((size_t)4352 * 1024 * 2);
  p.WT_o = take((size_t)1024 * 1024 * 2);
  p.W2T = take((size_t)1024 * 64 * 2);
  p.A2T = take((size_t)1024 * 64 * 2);
  p.TW = take((size_t)T_TOK * 64 * 2);
  p.TA = take((size_t)T_TOK * 64 * 2);
  const size_t SLOT = (size_t)T_TOK * 1024 * 2;
  bfu* slot0 = take(SLOT);
  bfu* slots = take(6 * SLOT);
  p.H = slot0;
  p.AA = slot0;
  p.U = slots;
  p.GVT = slots + SLOT / 4;
  p.Q = slots + 2 * (SLOT / 4);
  p.K = slots + 3 * (SLOT / 4);
  p.VT = slots + 4 * (SLOT / 4);
  p.SZ = slots + 7 * (SLOT / 4);
  p.Y = slots + 9 * (SLOT / 4);
  p.R = slots;
  p.K1 = slots + 1 * (SLOT / 2);
  p.XV = slots + 2 * (SLOT / 2);
  p.XG = slots + 3 * (SLOT / 2);
  p.XR = slots + 4 * (SLOT / 2);
  p.XK = slots + 5 * (SLOT / 2);
  p.V1 = slots + 4 * (SLOT / 2);
  p.SG = slots + 5 * (SLOT / 2);
  p.EW = slots + 2 * (SLOT / 2);
  p.YS = slots + 3 * (SLOT / 2);
  p.G15 = (float*)p.TW;
  p.GT = p.WT_in;
  p.MRT = take((size_t)(SEQ / 16) * 32 * 512 * 2);
  p.COEF = (float*)take((size_t)T_TOK * 16 * 4);
  p.BAR = (unsigned*)take((size_t)XCD_BAR_WORDS * 4);
  if (off > ws_size) {
    fprintf(stderr, "workspace too small: need %zu have %zu\n", off, ws_size);
    return;
  }
  static int grid_blocks = 0;
  if (!grid_blocks) {
    int dev = 0, cus = 0, per_cu = 0;
    (void)hipGetDevice(&dev);
    (void)hipDeviceGetAttribute(&cus, hipDeviceAttributeMultiprocessorCount, dev);
    (void)hipFuncSetAttribute((const void*)mega_kernel, hipFuncAttributeMaxDynamicSharedMemorySize, SMEM_BYTES + 16);
    (void)hipOccupancyMaxActiveBlocksPerMultiprocessor(&per_cu, mega_kernel, 512, SMEM_BYTES + 16);
    grid_blocks = cus * per_cu;
  }
  (void)hipMemsetAsync(p.BAR, 0, (size_t)XCD_BAR_WORDS * 4, stream);
  void* args[] = {&p};
  hipError_t e = hipLaunchCooperativeKernel((void*)mega_kernel, dim3(grid_blocks), dim3(512), args, SMEM_BYTES + 16, stream);
  if (e != hipSuccess) fprintf(stderr, "cooperative launch failed: %s (grid %d)\n", hipGetErrorString(e), grid_blocks);
}
```

```cpp
#include <hip/hip_runtime.h>
#include <hip/hip_cooperative_groups.h>
#include <stdint.h>
#include <cstdio>
namespace cg = cooperative_groups;

#ifndef MEGA
#define MEGA 1
#endif

typedef unsigned short bfu;
using bf16x8 = __attribute__((ext_vector_type(8))) short;
using f32x4 = __attribute__((ext_vector_type(4))) float;
#define DEVI __device__ __forceinline__
#define TIDX ((int)(threadIdx.x & 255))
#define HF ((int)(threadIdx.x >> 8))

constexpr int GSTAGE_BYTES = 2 * 128 * 72 * 2;
constexpr int T_TOK = 32768;
constexpr int SEQ = 16384;
constexpr int HALF_SMEM = 2 * GSTAGE_BYTES + 4096 + 512;
constexpr int SMEM_BYTES = 2 * HALF_SMEM;
constexpr int SMEM_UNUSED_ = 0;

struct Params {
  const float *x, *ln_even, *w_in, *gm_norm, *gm_ws, *gm_b, *w_out, *ln_odd, *mu, *wr, *wk, *wv, *wg, *w0, *w1, *w2,
      *a0, *a1, *a2, *k_k, *k_a, *r_k, *lnw, *lnb, *wo, *fnorm;
  float* out;
  bfu *WT_in, *WT_out, *WT_3, *WT_o, *W2T, *A2T;
  bfu *H, *U, *GVT, *Q, *K, *VT, *SZ, *Y, *R, *K1, *V1, *SG, *EW, *AA, *YS, *TW, *TA, *GT, *MRT, *XR, *XK, *XV, *XG;
  float *G15, *COEF;
  unsigned* BAR;
};

DEVI float bf2f(unsigned b) { return __uint_as_float(b << 16); }
DEVI unsigned f2bf(float x) {
  const __bf16 h = (__bf16)x;
  return (unsigned)__builtin_bit_cast(unsigned short, h);
}
typedef __bf16 bf16x2_t __attribute__((ext_vector_type(2)));
typedef float float2_t __attribute__((ext_vector_type(2)));
DEVI unsigned pkbf(float a, float b) {
  const float2_t f = {a, b};
  const bf16x2_t h = __builtin_convertvector(f, bf16x2_t);
  return __builtin_bit_cast(unsigned, h);
}
DEVI void unpack8(uint4 v, float* f) {
  f[0] = __uint_as_float(v.x << 16); f[1] = __uint_as_float(v.x & 0xffff0000u);
  f[2] = __uint_as_float(v.y << 16); f[3] = __uint_as_float(v.y & 0xffff0000u);
  f[4] = __uint_as_float(v.z << 16); f[5] = __uint_as_float(v.z & 0xffff0000u);
  f[6] = __uint_as_float(v.w << 16); f[7] = __uint_as_float(v.w & 0xffff0000u);
}
DEVI uint4 pack8(const float* f) {
  uint4 r;
  r.x = pkbf(f[0], f[1]);
  r.y = pkbf(f[2], f[3]);
  r.z = pkbf(f[4], f[5]);
  r.w = pkbf(f[6], f[7]);
  return r;
}
DEVI void unpack4(uint2 v, float* f) {
  f[0] = __uint_as_float(v.x << 16); f[1] = __uint_as_float(v.x & 0xffff0000u);
  f[2] = __uint_as_float(v.y << 16); f[3] = __uint_as_float(v.y & 0xffff0000u);
}
DEVI uint2 pack4(const float* f) {
  uint2 r;
  r.x = pkbf(f[0], f[1]);
  r.y = pkbf(f[2], f[3]);
  return r;
}

DEVI float sigmoid_(float x) { return 1.f / (1.f + __expf(-x)); }
DEVI float silu_(float x) { return x * sigmoid_(x); }
DEVI float tanh_(float y) { float t = __expf(2.f * y); return 1.f - 2.f / (1.f + t); }
DEVI float gelu_(float x) {
  float y = 0.7978845608028654f * (x + 0.044715f * x * x * x);
  return 0.5f * x * (1.f + tanh_(y));
}
DEVI float wave_sum(float v) {
#pragma unroll
  for (int o = 32; o > 0; o >>= 1) v += __shfl_xor(v, o);
  return v;
}
DEVI float wave_max(float v) {
#pragma unroll
  for (int o = 32; o > 0; o >>= 1) v = fmaxf(v, __shfl_xor(v, o));
  return v;
}
template <int CTRL>
DEVI float dppf(float x) {
  return __int_as_float(__builtin_amdgcn_update_dpp(0, __float_as_int(x), CTRL, 0xF, 0xF, true));
}
DEVI float reduce16(float x) {
  x += dppf<0xB1>(x);
  x += dppf<0x4E>(x);
  x += dppf<0x141>(x);
  x += dppf<0x140>(x);
  return x;
}

constexpr int LROW = 72;
constexpr int GSTAGE = 2 * 128 * LROW;

template <int DIST = 2, bool SW = true, class ALoad, class Epi>
DEVI void gemm_tile(char* smem, const ALoad& aload, const bfu* __restrict__ Bt, int ldb, int K, int m0, int n0,
                    const Epi& epi) {
  bfu* sbase = (bfu*)smem;
  const int tid = TIDX, lane = tid & 63, wid = tid >> 6, wr = wid >> 1, wc = wid & 1;
  const int fr = lane & 15, fq = lane >> 4;
  f32x4 acc[4][4];
#pragma unroll
  for (int i = 0; i < 4; ++i)
#pragma unroll
    for (int j = 0; j < 4; ++j) acc[i][j] = f32x4{0.f, 0.f, 0.f, 0.f};
  const int r0 = tid >> 3, kc = (tid & 7) * 8;
  const int nk = K >> 6;
  struct GRegs { typename ALoad::Raw a0, a1, a2, a3; uint4 ap, b0, b1, b2, b3; };
  GRegs g0, g1;
  const bfu* Bp = Bt + (size_t)(n0 + r0) * ldb + kc;
  const size_t ldb32 = (size_t)ldb * 32;
  constexpr int ARS = ALoad::kConsec ? 1 : 32;
  const int ar0 = ALoad::kConsec ? 4 * r0 : r0;
#define GEMM_ISSUE(R, KT)                                   \
  {                                                         \
    const int k0_ = ((KT) << 6);                            \
    R.ap = aload.loadprev(m0 + ar0, k0_ + kc);              \
    R.a0 = aload.load(m0 + ar0, k0_ + kc);                  \
    R.a1 = aload.load(m0 + ar0 + ARS, k0_ + kc);            \
    R.a2 = aload.load(m0 + ar0 + 2 * ARS, k0_ + kc);        \
    R.a3 = aload.load(m0 + ar0 + 3 * ARS, k0_ + kc);        \
    R.b0 = *(const uint4*)(Bp + k0_);                       \
    R.b1 = *(const uint4*)(Bp + ldb32 + k0_);               \
    R.b2 = *(const uint4*)(Bp + 2 * ldb32 + k0_);           \
    R.b3 = *(const uint4*)(Bp + 3 * ldb32 + k0_);           \
  }
#define GEMM_COMMIT(R, S, KT)                               \
  {                                                         \
    const int k1_ = ((KT) << 6) + kc;                       \
    bfu* A_ = sbase + (S) * GSTAGE + ar0 * LROW + kc;       \
    bfu* B_ = sbase + (S) * GSTAGE + 128 * LROW + r0 * LROW + kc;   \
    *(uint4*)(A_) = aload.finish(R.a0, R.ap, m0 + ar0, k1_);                                 \
    *(uint4*)(A_ + ARS * LROW) = aload.finish(R.a1, aload.asprev(R.a0), m0 + ar0 + ARS, k1_);          \
    *(uint4*)(A_ + 2 * ARS * LROW) = aload.finish(R.a2, aload.asprev(R.a1), m0 + ar0 + 2 * ARS, k1_);  \
    *(uint4*)(A_ + 3 * ARS * LROW) = aload.finish(R.a3, aload.asprev(R.a2), m0 + ar0 + 3 * ARS, k1_);  \
    *(uint4*)(B_) = R.b0;                                   \
    *(uint4*)(B_ + 32 * LROW) = R.b1;                       \
    *(uint4*)(B_ + 64 * LROW) = R.b2;                       \
    *(uint4*)(B_ + 96 * LROW) = R.b3;                       \
  }
#define GEMM_COMPUTE(S)                                                                          \
  {                                                                                              \
    const bfu* cA = sbase + (S) * GSTAGE;                                                        \
    const bfu* cB = cA + 128 * LROW;                                                             \
    _Pragma("unroll") for (int ks = 0; ks < 2; ++ks) {                                           \
      bf16x8 af[4], bfv[4];                                                                      \
      _Pragma("unroll") for (int i = 0; i < 4; ++i) {                                            \
        af[i] = *(const bf16x8*)(cA + (wr * 64 + i * 16 + fr) * LROW + ks * 32 + fq * 8);        \
        bfv[i] = *(const bf16x8*)(cB + (wc * 64 + i * 16 + fr) * LROW + ks * 32 + fq * 8);       \
      }                                                                                          \
      _Pragma("unroll") for (int i = 0; i < 4; ++i) _Pragma("unroll") for (int j = 0; j < 4; ++j) \
          acc[i][j] = SW ? __builtin_amdgcn_mfma_f32_16x16x32_bf16(bfv[j], af[i], acc[i][j], 0, 0, 0)     \
                         : __builtin_amdgcn_mfma_f32_16x16x32_bf16(af[i], bfv[j], acc[i][j], 0, 0, 0);    \
    }                                                                                            \
  }
  const int nkm1 = nk - 1;
  if (DIST == 2) {
    GEMM_ISSUE(g0, 0);
    GEMM_ISSUE(g1, (1 < nkm1 ? 1 : nkm1));
    GEMM_COMMIT(g0, 0, 0);
    GEMM_ISSUE(g0, (2 < nkm1 ? 2 : nkm1));
    __syncthreads();
    if (nk == 1) {
      GEMM_COMPUTE(0);
      __syncthreads();
    } else {
      for (int kt = 0; kt < nk; kt += 2) {
        GEMM_COMMIT(g1, 1, (kt + 1 < nkm1 ? kt + 1 : nkm1));
        GEMM_ISSUE(g1, (kt + 3 < nkm1 ? kt + 3 : nkm1));
        GEMM_COMPUTE(0);
        __syncthreads();
        GEMM_COMMIT(g0, 0, (kt + 2 < nkm1 ? kt + 2 : nkm1));
        GEMM_ISSUE(g0, (kt + 4 < nkm1 ? kt + 4 : nkm1));
        GEMM_COMPUTE(1);
        __syncthreads();
      }
    }
  } else {
    GEMM_ISSUE(g0, 0);
    GEMM_COMMIT(g0, 0, 0);
    GEMM_ISSUE(g0, (1 < nkm1 ? 1 : nkm1));
    __syncthreads();
    for (int kt = 0; kt < nk; kt += 2) {
      GEMM_COMMIT(g0, 1, (kt + 1 < nkm1 ? kt + 1 : nkm1));
      GEMM_ISSUE(g0, (kt + 2 < nkm1 ? kt + 2 : nkm1));
      GEMM_COMPUTE(0);
      __syncthreads();
      GEMM_COMMIT(g0, 0, (kt + 2 < nkm1 ? kt + 2 : nkm1));
      GEMM_ISSUE(g0, (kt + 3 < nkm1 ? kt + 3 : nkm1));
      GEMM_COMPUTE(1);
      __syncthreads();
    }
  }
#pragma unroll
  for (int i = 0; i < 4; ++i)
#pragma unroll
    for (int j = 0; j < 4; ++j) {
      if (SW) epi(m0 + wr * 64 + i * 16 + fr, n0 + wc * 64 + j * 16 + fq * 4, acc[i][j]);
      else epi(m0 + wr * 64 + i * 16 + fq * 4, n0 + wc * 64 + j * 16 + fr, acc[i][j]);
    }
}

namespace pg8 {
#define PG8_LAS __attribute__((address_space(3)))
typedef unsigned short bf16_t;
typedef short bf16x8 __attribute__((ext_vector_type(8)));
typedef float f32x4 __attribute__((ext_vector_type(4)));
typedef unsigned u32x4 __attribute__((ext_vector_type(4)));
constexpr int BM = 256, BK = 64, HALF = 128, HTB = HALF * BK * 2  , STAGE_BYTES = 8 * HTB, NXCD = 8, WGM = 8;

__host__ __device__ __forceinline__ int lds_byte(int r, int c) { const int st = (r >> 4) * 2 + (c >> 5), rr = r & 15, cc = c & 31, ob = rr * 64 + cc * 2; return st * 1024 + (ob ^ (((ob >> 9) & 1) << 5)); }
__host__ __device__ __forceinline__ void stage_rc(int b, int& R, int& C) { const int st = b / 1024, sb = b % 1024, swz = sb ^ (((sb >> 9) & 1) << 5); R = (st >> 1) * 16 + swz / 64; C = (st & 1) * 32 + (swz % 64) / 2; }
__host__ __device__ __forceinline__ int perm32(int rho) { const int n = rho >> 4, i = rho & 15; return 8 * (i >> 2) + 4 * n + (i & 3); }

struct Unit { int pm, pn; };
struct Gemm { const bf16_t* A; const bf16_t* Bt; int M, N, K; const bf16_t* A2; int pn_split; };

struct StaticOrder {
    int nM, nN, nwg, G, c;
    __host__ __device__ void init(int M, int N, int G_, int c_) { nM = M / BM; nN = N / BM; nwg = nM * nN; G = G_; c = c_; }
    __host__ __device__ bool next(int i, Unit& u) const {
        const long L = (long)i * G + c; if (L >= nwg) return false;
        int wgid = (int)L; { const int q = nwg / NXCD, r = nwg % NXCD, xcd = wgid % NXCD, off = wgid / NXCD; wgid = (xcd < r ? xcd * (q + 1) : r * (q + 1) + (xcd - r) * q) + off; }
        const int nig = WGM * nN, gid = wgid / nig, fm = gid * WGM, gsz = (nM - fm) < WGM ? (nM - fm) : WGM;
        u.pm = fm + ((wgid % nig) % gsz); u.pn = (wgid % nig) / gsz; return true;
    }
    __device__ __forceinline__ void a_ready(const Unit&) const {}
    __device__ __forceinline__ void done(const Unit&) const {}
};
struct CountedOrder : StaticOrder {
    const unsigned* ready; unsigned need; unsigned* tmo;
    __device__ __forceinline__ void a_ready(const Unit& u) const {
        if (threadIdx.x < 64) {
            const unsigned long long t0 = __builtin_amdgcn_s_memrealtime(); unsigned polls = 0;
            while ((unsigned)__builtin_amdgcn_readfirstlane(__hip_atomic_load(ready + 64 * u.pm, __ATOMIC_RELAXED, __HIP_MEMORY_SCOPE_AGENT)) < need) {
                if ((++polls & 255u) == 0u && __builtin_amdgcn_readfirstlane(__hip_atomic_load(tmo, __ATOMIC_RELAXED, __HIP_MEMORY_SCOPE_AGENT)) != 0u) break;
                if (__builtin_amdgcn_s_memrealtime() - t0 > 2000000ull) {
                    if (threadIdx.x == 0) { unsigned expect = 0u; __hip_atomic_compare_exchange_strong(tmo + 1, &expect, 0x600u | (unsigned)(u.pm & 0xff), __ATOMIC_RELAXED, __ATOMIC_RELAXED, __HIP_MEMORY_SCOPE_AGENT); __hip_atomic_store(tmo, 1u, __ATOMIC_RELAXED, __HIP_MEMORY_SCOPE_AGENT); }
                    break; }
                __builtin_amdgcn_s_sleep(2); }
            __builtin_amdgcn_fence(__ATOMIC_ACQUIRE, "agent");
            asm volatile("s_waitcnt vmcnt(0)" ::: "memory");
        }
#if !defined(BROKEN_HOOK_NO_BARRIER)
        asm volatile("" ::: "memory"); __builtin_amdgcn_s_barrier(); asm volatile("" ::: "memory");
#endif
    }
};

__device__ __forceinline__ unsigned cvt_pk_bf16(float lo, float hi) { unsigned r; asm volatile("v_cvt_pk_bf16_f32 %0, %1, %2" : "=v"(r) : "v"(lo), "v"(hi)); return r; }
typedef float f32x2 __attribute__((ext_vector_type(2)));
__device__ __forceinline__ f32x2 gelu_pk(f32x2 v) {
    const f32x2 av = __builtin_elementwise_abs(v), d = av * 0.2316418882f + 1.0f;
    f32x2 t; t.x = __builtin_amdgcn_rcpf(d.x); t.y = __builtin_amdgcn_rcpf(d.y);
    f32x2 q = t * 0.5307027145f + (-0.7265760135f); q = q * t + 0.7107068705f; q = q * t + (-0.142248368f); q = q * t + 0.127414796f; q = q * t;
    const f32x2 s = (v * v) * (-0.72134752044f);
    f32x2 e; e.x = __builtin_amdgcn_exp2f(s.x); e.y = __builtin_amdgcn_exp2f(s.y);
    const f32x2 m = v * (q * e), r = v - m;
    f32x2 o; o.x = v.x < 0.f ? m.x : r.x; o.y = v.y < 0.f ? m.y : r.y; return o;
}

struct EpiF32 {
    static constexpr bool PERM = false, AFTER_DRAIN = false;
    float* C; int ldc; const float* bias;
    __device__ __forceinline__ void operator()(const f32x4 (&acc)[2][2][4][2], const Unit& u, int wr, int wc, int fr, int fq) const {
        const int row0 = u.pm * BM + wr * 64 + fr, col0 = u.pn * BM + wc * 32 + 4 * fq;
        f32x4 bv[2][2];
#pragma unroll
        for (int bj = 0; bj < 2; ++bj)
#pragma unroll
            for (int n = 0; n < 2; ++n) bv[bj][n] = bias ? *(const f32x4*)(bias + col0 + bj * HALF + n * 16) : (f32x4){0.f, 0.f, 0.f, 0.f};
#pragma unroll
        for (int ai = 0; ai < 2; ++ai)
#pragma unroll
            for (int m = 0; m < 4; ++m) { float* rowp = C + (size_t)(row0 + ai * HALF + m * 16) * ldc + col0;
#pragma unroll
                for (int bj = 0; bj < 2; ++bj)
#pragma unroll
                    for (int n = 0; n < 2; ++n) *(f32x4*)(rowp + bj * HALF + n * 16) = acc[ai][bj][m][n] + bv[bj][n]; }
    }
};
template <int ACT  > struct EpiBf16 {
    static constexpr bool PERM = true, AFTER_DRAIN = false;
    bf16_t* O; int ldc; const float* bias; int split_cols; size_t split_stride;
    __device__ __forceinline__ void operator()(const f32x4 (&acc)[2][2][4][2], const Unit& u, int wr, int wc, int fr, int fq) const {
        const int row0 = u.pm * BM + wr * 64 + fr; int colt = u.pn * BM; bf16_t* base = O;
        if (split_cols) { const int t = colt / split_cols; base += (size_t)t * split_stride; colt -= t * split_cols; }
        const int col0 = colt + wc * 32 + 8 * fq, bcol0 = u.pn * BM + wc * 32 + 8 * fq;
        f32x4 bv[2][2];
#pragma unroll
        for (int bj = 0; bj < 2; ++bj)
#pragma unroll
            for (int n = 0; n < 2; ++n) bv[bj][n] = bias ? *(const f32x4*)(bias + bcol0 + bj * HALF + 4 * n) : (f32x4){0.f, 0.f, 0.f, 0.f};
#pragma unroll
        for (int ai = 0; ai < 2; ++ai)
#pragma unroll
            for (int m = 0; m < 4; ++m) { bf16_t* rowp = base + (size_t)(row0 + ai * HALF + m * 16) * ldc + col0;
#pragma unroll
                for (int bj = 0; bj < 2; ++bj) { f32x4 v0 = acc[ai][bj][m][0] + bv[bj][0], v1 = acc[ai][bj][m][1] + bv[bj][1];
                    if (ACT == 1) { f32x2 a = gelu_pk((f32x2){v0[0], v0[1]}), b = gelu_pk((f32x2){v0[2], v0[3]}), c = gelu_pk((f32x2){v1[0], v1[1]}), d = gelu_pk((f32x2){v1[2], v1[3]});
                        v0 = (f32x4){a.x, a.y, b.x, b.y}; v1 = (f32x4){c.x, c.y, d.x, d.y}; }
                    if (ACT == 2) {
#pragma unroll
                        for (int j = 0; j < 4; ++j) { v0[j] = 0.5f * v0[j] * (1.0f + erff(v0[j] * 0.70710678f)); v1[j] = 0.5f * v1[j] * (1.0f + erff(v1[j] * 0.70710678f)); } }
                    u32x4 w; w.x = cvt_pk_bf16(v0[0], v0[1]); w.y = cvt_pk_bf16(v0[2], v0[3]); w.z = cvt_pk_bf16(v1[0], v1[1]); w.w = cvt_pk_bf16(v1[2], v1[3]);
                    *(u32x4*)(rowp + bj * HALF) = w; } }
    }
};


template <class Epi, class Sched, bool STAMP = false>
__device__ __forceinline__ void gemm_phase(PG8_LAS unsigned char* lds, const Gemm g, const Sched& S, const Epi& E, unsigned long long* stamps) {
    const int tid = threadIdx.x, wid = __builtin_amdgcn_readfirstlane(tid >> 6), lane = tid & 63, wr = wid >> 2, wc = wid & 3, fr = lane & 15, fq = lane >> 4;
    const int K = g.K, nt = K / BK;
    int ts_lo = 0, ts_hi = 0, nts = 0; const unsigned long long rt_entry = STAMP ? (unsigned long long)wall_clock64() : 0ull;
#define PG8_STAMP() do { if (STAMP && wid == 0 && nts < 64) { const unsigned long long _c = (unsigned long long)clock64(); \
        ts_lo = (lane == nts) ? (int)(unsigned)_c : ts_lo; ts_hi = (lane == nts) ? (int)(unsigned)(_c >> 32) : ts_hi; ++nts; } } while (0)
    PG8_STAMP();
    unsigned voffA[2], voffB[2];
#pragma unroll
    for (int i = 0; i < 2; ++i) { int R, C; stage_rc(tid * 16 + i * 8192, R, C); const int Rb = Epi::PERM ? ((R & ~31) + perm32(R & 31)) : R;
        voffA[i] = (unsigned)(R * K + C) * 2u; voffB[i] = (unsigned)(Rb * K + C) * 2u; }
    const size_t kstep = (size_t)(BK * 2);
    const size_t hstep = (size_t)HALF * K * 2;
    const size_t tstep = 2 * hstep;
    const unsigned ldsw = (unsigned)wid * 1024u;
    const int aoff = lds_byte(wr * 64 + fr, fq * 8), boff = lds_byte(wc * 32 + fr, fq * 8);
#define PG8_SA(b, h) (((b) * 2 + (h)) * HTB)
#define PG8_SB(b, h) ((4 + (b) * 2 + (h)) * HTB)
#define PG8_STAGE(bufoff, gbase, voff) do { _Pragma("unroll") for (int _i = 0; _i < 2; ++_i) \
        __builtin_amdgcn_global_load_lds((const unsigned*)((const char*)(gbase) + (voff)[_i]), (PG8_LAS unsigned*)(lds + (bufoff) + ldsw + _i * 8192), 16, 0, 0); } while (0)
#define PG8_LDA(dst, b, h) do { _Pragma("unroll") for (int m = 0; m < 4; ++m) _Pragma("unroll") for (int k = 0; k < 2; ++k) dst[m][k] = *(const PG8_LAS bf16x8*)(lds + PG8_SA(b, h) + aoff + m * 2048 + k * 1024); } while (0)
#define PG8_LDB(dst, b, h) do { _Pragma("unroll") for (int n = 0; n < 2; ++n) _Pragma("unroll") for (int k = 0; k < 2; ++k) dst[n][k] = *(const PG8_LAS bf16x8*)(lds + PG8_SB(b, h) + boff + n * 2048 + k * 1024); } while (0)
#define PG8_MMA(ai, bj, At, Bt) do { __builtin_amdgcn_s_setprio(1); _Pragma("unroll") for (int m = 0; m < 4; ++m) _Pragma("unroll") for (int n = 0; n < 2; ++n) _Pragma("unroll") for (int k = 0; k < 2; ++k) \
        acc[ai][bj][m][n] = __builtin_amdgcn_mfma_f32_16x16x32_bf16(Bt[n][k], At[m][k], acc[ai][bj][m][n], 0, 0, 0); __builtin_amdgcn_s_setprio(0); } while (0)
#define PG8_WAIT_V(n) asm volatile("s_waitcnt vmcnt(" #n ")" ::: "memory")
#define PG8_WAIT_L(n) asm volatile("s_waitcnt lgkmcnt(" #n ")" ::: "memory")
#define PG8_BAR __builtin_amdgcn_s_barrier()
#define PG8_SCHED __builtin_amdgcn_sched_barrier(0)
    Unit cur, nxt; int ui = 0;
    if (!S.next(0, cur)) return;
    f32x4 acc[2][2][4][2];
#pragma unroll
    for (int a = 0; a < 2; ++a)
#pragma unroll
        for (int b = 0; b < 2; ++b)
#pragma unroll
            for (int m = 0; m < 4; ++m)
#pragma unroll
                for (int n = 0; n < 2; ++n) acc[a][b][m][n] = (f32x4){0.f, 0.f, 0.f, 0.f};
    bf16x8 At[4][2], B0[2][2], B1[2][2];
    const char* cA = (const char*)(cur.pn >= g.pn_split ? g.A2 : g.A) + (size_t)cur.pm * tstep; const char* cB = (const char*)g.Bt + (size_t)cur.pn * tstep;
    S.a_ready(cur);
    PG8_STAGE(PG8_SB(0, 0), cB, voffB); PG8_STAGE(PG8_SA(0, 0), cA, voffA); PG8_STAGE(PG8_SB(0, 1), cB + hstep, voffB); PG8_STAGE(PG8_SA(0, 1), cA + hstep, voffA);
    if (wr == 1) PG8_BAR;
    PG8_WAIT_V(4); PG8_BAR;
    PG8_STAGE(PG8_SB(1, 0), cB + kstep, voffB); PG8_STAGE(PG8_SA(1, 0), cA + kstep, voffA); PG8_STAGE(PG8_SB(1, 1), cB + hstep + kstep, voffB);
    PG8_WAIT_V(6); PG8_BAR;
    PG8_STAMP();
    for (;;) {
        const bool has_next = S.next(ui + 1, nxt);
        const char* nA = has_next ? (const char*)(nxt.pn >= g.pn_split ? g.A2 : g.A) + (size_t)nxt.pm * tstep : cA; const char* nB = has_next ? (const char*)g.Bt + (size_t)nxt.pn * tstep : cB;
        for (int t = 0; t < nt; t += 2) {
            const bool last = (t == nt - 2);
            const char* a1 = cA + (size_t)(t + 1) * kstep;
            const char* a2 = last ? nA : cA + (size_t)(t + 2) * kstep; const char* b2 = last ? nB : cB + (size_t)(t + 2) * kstep;
            const char* a3 = a2 + kstep; const char* b3 = b2 + kstep;
            if (last && has_next) S.a_ready(nxt);
            PG8_LDB(B0, 0, 0); PG8_SCHED; PG8_LDA(At, 0, 0); PG8_STAGE(PG8_SA(1, 1), a1 + hstep, voffA);
            PG8_WAIT_L(8); PG8_BAR; PG8_WAIT_L(0); PG8_MMA(0, 0, At, B0); PG8_BAR; PG8_SCHED;
            PG8_LDB(B1, 0, 1); PG8_STAGE(PG8_SB(0, 0), b2, voffB);
            PG8_BAR; PG8_WAIT_L(0); PG8_MMA(0, 1, At, B1); PG8_BAR;
            PG8_LDA(At, 0, 1); PG8_STAGE(PG8_SA(0, 0), a2, voffA);
            PG8_BAR; PG8_WAIT_L(0); PG8_MMA(1, 0, At, B0); PG8_BAR; PG8_SCHED;
            PG8_STAGE(PG8_SB(0, 1), b2 + hstep, voffB);
            PG8_WAIT_V(6); PG8_BAR; PG8_MMA(1, 1, At, B1); PG8_BAR;
            PG8_LDB(B0, 1, 0); PG8_SCHED; PG8_LDA(At, 1, 0); PG8_STAGE(PG8_SA(0, 1), a2 + hstep, voffA);
            PG8_WAIT_L(8); PG8_BAR; PG8_WAIT_L(0); PG8_MMA(0, 0, At, B0); PG8_BAR; PG8_SCHED;
            PG8_LDB(B1, 1, 1); PG8_STAGE(PG8_SB(1, 0), b3, voffB);
            PG8_BAR; PG8_WAIT_L(0); PG8_MMA(0, 1, At, B1); PG8_BAR;
            PG8_LDA(At, 1, 1); PG8_STAGE(PG8_SA(1, 0), a3, voffA);
            PG8_BAR; PG8_WAIT_L(0); PG8_MMA(1, 0, At, B0); PG8_BAR; PG8_SCHED;
            PG8_STAGE(PG8_SB(1, 1), b3 + hstep, voffB);
            PG8_WAIT_V(6); PG8_BAR; PG8_MMA(1, 1, At, B1); PG8_BAR;
        }
        PG8_STAMP();
        if constexpr (!Epi::AFTER_DRAIN) { E(acc, cur, wr, wc, fr, fq); S.done(cur); }
        PG8_STAMP();
        if (!has_next) break;
#pragma unroll
        for (int a = 0; a < 2; ++a)
#pragma unroll
            for (int b = 0; b < 2; ++b)
#pragma unroll
                for (int m = 0; m < 4; ++m)
#pragma unroll
                    for (int n = 0; n < 2; ++n) acc[a][b][m][n] = (f32x4){0.f, 0.f, 0.f, 0.f};
        cur = nxt; cA = nA; cB = nB; ++ui;
    }
    PG8_WAIT_V(0);
    if (wr == 0) PG8_BAR;
    PG8_BAR;
    if constexpr (Epi::AFTER_DRAIN) { E.fused(acc, cur, wr, wc, fr, fq, lds, wid, lane); S.done(cur); }
    PG8_STAMP();
    if (STAMP && wid == 0) { stamps[lane] = lane < nts ? (((unsigned long long)(unsigned)ts_hi << 32) | (unsigned)ts_lo) : 0ull;
        if (lane == 62) stamps[62] = rt_entry; if (lane == 63) stamps[63] = (unsigned long long)wall_clock64(); }
#undef PG8_STAMP
#undef PG8_SA
#undef PG8_SB
#undef PG8_STAGE
#undef PG8_LDA
#undef PG8_LDB
#undef PG8_MMA
#undef PG8_WAIT_V
#undef PG8_WAIT_L
#undef PG8_BAR
#undef PG8_SCHED
}
}

struct TileSched {
  int xcd, local, vbid, vnb, MT, NT, SM, SN, j, snc;
  bool swz;
  DEVI TileSched(int bid, int nb, int half, int MT_, int NT_, int SM_, int SN_) : MT(MT_), NT(NT_), SM(SM_), SN(SN_), j(0) {
    xcd = bid & 7;
    local = (bid >> 3) * 2 + half;
    vbid = bid * 2 + half;
    vnb = nb * 2;
    swz = (vnb == 8 * SM * SN) && ((nb & 7) == 0);
    snc = (NT + SN - 1) / SN;
  }
  DEVI int next(int& mt, int& nt) {
    if (swz) {
      const int s = j * 8 + xcd;
      ++j;
      const int sm = s / snc, sn = s - sm * snc;
      if (sm * SM >= MT) return 0;
      mt = sm * SM + local / SN;
      nt = sn * SN + local % SN;
      return (mt < MT && nt < NT) ? 1 : 2;
    } else {
      const int it = vbid + j * vnb;
      ++j;
      if (it >= MT * NT) return 0;
      mt = it / NT;
      nt = it - mt * NT;
      return 1;
    }
  }
};

struct ALoadPlain {
  typedef uint4 Raw;
  static constexpr bool kFat = false;
  static constexpr bool kConsec = false;
  const bfu* A;
  int lda;
  DEVI Raw load(int row, int k) const { return *(const uint4*)(A + (size_t)row * lda + k); }
  DEVI uint4 loadprev(int, int) const { return uint4{0u, 0u, 0u, 0u}; }
  DEVI uint4 asprev(const Raw&) const { return uint4{0u, 0u, 0u, 0u}; }
  DEVI uint4 finish(const Raw& r, const uint4&, int, int) const { return r; }
};

DEVI void transpose_tile(char* smem, const float* __restrict__ src, int Ns, bfu* __restrict__ dst, int ldd, int noff,
                         int k0, int n0) {
  float(*tile)[65] = (float(*)[65])smem;
  const int tid = TIDX;
  const int kr = tid >> 4, nc = (tid & 15) * 4;
#pragma unroll
  for (int p = 0; p < 4; ++p) {
    float4 v = *(const float4*)(src + (size_t)(k0 + kr + 16 * p) * Ns + n0 + nc);
    tile[kr + 16 * p][nc] = v.x;
    tile[kr + 16 * p][nc + 1] = v.y;
    tile[kr + 16 * p][nc + 2] = v.z;
    tile[kr + 16 * p][nc + 3] = v.w;
  }
  __syncthreads();
  const int nr = tid >> 3, kc = (tid & 7) * 8;
#pragma unroll
  for (int p = 0; p < 2; ++p) {
    const int n = nr + 32 * p;
    float f[8];
#pragma unroll
    for (int j = 0; j < 8; ++j) f[j] = tile[kc + j][n];
    *(uint4*)(dst + (size_t)(noff + n0 + n) * ldd + k0 + kc) = pack8(f);
  }
  __syncthreads();
}

DEVI void rms_row2_bf16(const float* __restrict__ src, const float* __restrict__ g, bfu* __restrict__ dst, int lane) {
  float4 v[2][4];
  float ss[2] = {0.f, 0.f};
#pragma unroll
  for (int r = 0; r < 2; ++r)
#pragma unroll
    for (int i = 0; i < 4; ++i) v[r][i] = *(const float4*)(src + r * 1024 + lane * 4 + 256 * i);
#pragma unroll
  for (int r = 0; r < 2; ++r)
#pragma unroll
    for (int i = 0; i < 4; ++i)
      ss[r] += v[r][i].x * v[r][i].x + v[r][i].y * v[r][i].y + v[r][i].z * v[r][i].z + v[r][i].w * v[r][i].w;
#pragma unroll
  for (int r = 0; r < 2; ++r) {
    const float rinv = rsqrtf(wave_sum(ss[r]) * (1.f / 1024.f) + 1e-6f);
#pragma unroll
    for (int i = 0; i < 4; ++i) {
      const float4 gg = *(const float4*)(g + lane * 4 + 256 * i);
      uint2 o;
      o.x = pkbf(v[r][i].x * rinv * gg.x, v[r][i].y * rinv * gg.y);
      o.y = pkbf(v[r][i].z * rinv * gg.z, v[r][i].w * rinv * gg.w);
      *(uint2*)(dst + r * 1024 + lane * 4 + 256 * i) = o;
    }
  }
}

DEVI void phase0(const Params& p, char* smem, int bid, int nb) {
  constexpr int NT_IN = 16 * 56, NT_SQ = 256, NT_SM = 16;
  constexpr int c0 = NT_IN, c1 = c0 + NT_SQ, c2 = c1 + 4 * NT_SQ, c3 = c2 + NT_SM, c4 = c3 + NT_SM, c5 = c4 + NT_SQ,
                c6 = c5 + NT_SM, c7 = c6 + NT_SM, c8 = c7 + 2, c9 = c8 + T_TOK / 8;
  smem += HF * HALF_SMEM;
  for (int it = bid * 2 + HF; it < c9; it += nb * 2) {
    if (it < c0) {
      transpose_tile(smem, p.w_in, 3584, p.WT_in, 1024, 0, (it / 56) * 64, (it % 56) * 64);
    } else if (it < c1) {
      int j = it - c0;
      transpose_tile(smem, p.w_out, 1024, p.WT_out, 1024, 0, (j >> 4) * 64, (j & 15) * 64);
    } else if (it < c2) {
      int j = it - c1;
      int w = j >> 8;
      j &= 255;
      const float* src = (w == 0) ? p.wr : (w == 1) ? p.wk : (w == 2) ? p.wv : p.wg;
      transpose_tile(smem, src, 1024, p.WT_3, 1024, w * 1024, (j >> 4) * 64, (j & 15) * 64);
    } else if (it < c3) {
      int j = it - c2;
      transpose_tile(smem, p.w1, 64, p.WT_3, 1024, 4096, j * 64, 0);
    } else if (it < c4) {
      int j = it - c3;
      transpose_tile(smem, p.a1, 64, p.WT_3, 1024, 4224, j * 64, 0);
    } else if (it < c5) {
      int j = it - c4;
      transpose_tile(smem, p.wo, 1024, p.WT_o, 1024, 0, (j >> 4) * 64, (j & 15) * 64);
    } else if (it < c6) {
      int j = it - c5;
      transpose_tile(smem, p.w2, 1024, p.W2T, 64, 0, 0, j * 64);
    } else if (it < c7) {
      int j = it - c6;
      transpose_tile(smem, p.a2, 1024, p.A2T, 64, 0, 0, j * 64);
    } else if (it < c8) {
      int j = it - c7;
      bfu* dst = p.WT_3 + (size_t)(j == 0 ? 4160 : 4288) * 1024;
      for (int e = TIDX; e < 64 * 1024 / 8; e += 256) *(uint4*)(dst + e * 8) = uint4{0, 0, 0, 0};
    } else {
      int row = (it - c8) * 8 + (TIDX >> 6) * 2;
      rms_row2_bf16(p.x + (size_t)row * 1024, p.ln_even, p.H + (size_t)row * 1024, TIDX & 63);
    }
  }
}

struct PgEpi1 {
  static constexpr bool PERM = true, AFTER_DRAIN = false;
  const Params* p;
  DEVI void operator()(const pg8::f32x4 (&acc)[2][2][4][2], const pg8::Unit& u, int wr, int wc, int fr, int fq) const {
    const int row0 = u.pm * 256 + wr * 64 + fr;
    const int seg = u.pn;
#pragma unroll
    for (int ai = 0; ai < 2; ++ai)
#pragma unroll
      for (int m = 0; m < 4; ++m) {
        const int row = row0 + ai * 128 + m * 16;
#pragma unroll
        for (int bj = 0; bj < 2; ++bj) {
          const int col = u.pn * 256 + bj * 128 + wc * 32 + 8 * fq;
          const f32x4 v0 = acc[ai][bj][m][0], v1 = acc[ai][bj][m][1];
          if (seg < 2) {
            uint4 w;
            w.x = pkbf(gelu_(v0[0]), gelu_(v0[1])); w.y = pkbf(gelu_(v0[2]), gelu_(v0[3]));
            w.z = pkbf(gelu_(v1[0]), gelu_(v1[1])); w.w = pkbf(gelu_(v1[2]), gelu_(v1[3]));
            *(uint4*)(p->U + (size_t)row * 512 + col) = w;
          } else if (seg < 4) {
            const int g = (col - 512) >> 7, c0 = col & 127, chunk = row >> 7, s = row & 127;
            bfu* base = p->GVT + ((size_t)((chunk * 4 + g) * 128 + c0)) * 128 + s;
#pragma unroll
            for (int e = 0; e < 4; ++e) {
              base[(size_t)e * 128] = (bfu)f2bf(gelu_(v0[e]));
              base[(size_t)(e + 4) * 128] = (bfu)f2bf(gelu_(v1[e]));
            }
          } else if (seg < 8) {
            uint4 w;
            w.x = pkbf(v0[0], v0[1]); w.y = pkbf(v0[2], v0[3]); w.z = pkbf(v1[0], v1[1]); w.w = pkbf(v1[2], v1[3]);
            bfu* dst = (seg < 6) ? p->Q + (size_t)row * 512 + (col - 1024) : p->K + (size_t)row * 512 + (col - 1536);
            *(uint4*)dst = w;
          } else if (seg < 10) {
            const int cc = col - 2048, hh = cc >> 6, dim0 = cc & 63;
            const int b = row >> 14, s = row & (SEQ - 1);
            bfu* base = p->VT + ((size_t)((b * 8 + hh) * 64 + dim0)) * SEQ;
            const size_t PST = (size_t)16 * 64 * SEQ;
            const int o1 = (s & 3) * (SEQ / 4) + (s >> 2), o2 = (s & 15) * (SEQ / 16) + (s >> 4);
#pragma unroll
            for (int e = 0; e < 8; ++e) {
              const bfu val = (bfu)f2bf(e < 4 ? v0[e & 3] : v1[e & 3]);
              bfu* bd = base + (size_t)e * SEQ;
              bd[s] = val;
              bd[PST + o1] = val;
              bd[2 * PST + o2] = val;
            }
          } else {
            uint4 w;
            w.x = pkbf(silu_(v0[0]), silu_(v0[1])); w.y = pkbf(silu_(v0[2]), silu_(v0[3]));
            w.z = pkbf(silu_(v1[0]), silu_(v1[1])); w.w = pkbf(silu_(v1[2]), silu_(v1[3]));
            *(uint4*)(p->SZ + (size_t)row * 1024 + (col - 2560)) = w;
          }
        }
      }
  }
};
struct PgEpiRes {
  static constexpr bool PERM = false, AFTER_DRAIN = false;
  const float* base;
  float* out;
  DEVI void operator()(const pg8::f32x4 (&acc)[2][2][4][2], const pg8::Unit& u, int wr, int wc, int fr, int fq) const {
    const int row0 = u.pm * 256 + wr * 64 + fr, col0 = u.pn * 256 + wc * 32 + 4 * fq;
#pragma unroll
    for (int ai = 0; ai < 2; ++ai)
#pragma unroll
      for (int m = 0; m < 4; ++m) {
        const size_t rb = (size_t)(row0 + ai * 128 + m * 16) * 1024 + col0;
#pragma unroll
        for (int bj = 0; bj < 2; ++bj)
#pragma unroll
          for (int n = 0; n < 2; ++n) {
            const size_t idx = rb + bj * 128 + n * 16;
            const f32x4 b = *(const f32x4*)(base + idx);
            *(f32x4*)(out + idx) = acc[ai][bj][m][n] + b;
          }
      }
  }
};
template <class Epi>
DEVI void pg_gemm(char* smem, const bfu* A, const bfu* Bt, int M, int N, int K, const Epi& E, int bid, int nb) {
  pg8::Gemm g{A, Bt, M, N, K, A, 1 << 30};
  pg8::StaticOrder S;
  S.init(M, N, nb, bid);
  pg8::gemm_phase<Epi, pg8::StaticOrder, false>((PG8_LAS unsigned char*)smem, g, S, E, nullptr);
}
template <class Epi>
DEVI void pg_gemm2(char* smem, const bfu* A, const bfu* A2, int pn_split, const bfu* Bt, int M, int N, int K, const Epi& E,
                   int bid, int nb) {
  pg8::Gemm g{A, Bt, M, N, K, A2, pn_split};
  pg8::StaticOrder S;
  S.init(M, N, nb, bid);
  pg8::gemm_phase<Epi, pg8::StaticOrder, false>((PG8_LAS unsigned char*)smem, g, S, E, nullptr);
}
struct PgEpi3 {
  static constexpr bool PERM = true, AFTER_DRAIN = false;
  bfu* O0;
  bfu* O1;
  int silu1;
  DEVI void operator()(const pg8::f32x4 (&acc)[2][2][4][2], const pg8::Unit& u, int wr, int wc, int fr, int fq) const {
    const int row0 = u.pm * 256 + wr * 64 + fr;
    const int grp = u.pn >> 2;
    bfu* O = grp ? O1 : O0;
    const bool act = grp && silu1;
    const int colb = (u.pn & 3) * 256 + wc * 32 + 8 * fq;
#pragma unroll
    for (int ai = 0; ai < 2; ++ai)
#pragma unroll
      for (int m = 0; m < 4; ++m) {
        bfu* rowp = O + (size_t)(row0 + ai * 128 + m * 16) * 1024 + colb;
#pragma unroll
        for (int bj = 0; bj < 2; ++bj) {
          f32x4 v0 = acc[ai][bj][m][0], v1 = acc[ai][bj][m][1];
          if (act) {
#pragma unroll
            for (int e = 0; e < 4; ++e) {
              v0[e] = silu_(v0[e]);
              v1[e] = silu_(v1[e]);
            }
          }
          uint4 w;
          w.x = pkbf(v0[0], v0[1]); w.y = pkbf(v0[2], v0[3]); w.z = pkbf(v1[0], v1[1]); w.w = pkbf(v1[2], v1[3]);
          *(uint4*)(rowp + bj * 128) = w;
        }
      }
  }
};

DEVI void phase1(const Params& p, char* smem, int bid, int nb) {
  PgEpi1 E{&p};
  pg_gemm(smem, p.H, p.WT_in, T_TOK, 3584, 1024, E, bid, nb);
}

struct ALoadWs {
  struct Raw { float4 a, b; };
  static constexpr bool kFat = true;
  static constexpr bool kConsec = false;
  const float* ws;
  const float* rinv;
  DEVI Raw load(int t, int s0) const {
    Raw r;
    r.a = *(const float4*)(ws + t * 128 + s0);
    r.b = *(const float4*)(ws + t * 128 + s0 + 4);
    return r;
  }
  DEVI uint4 loadprev(int, int) const { return uint4{0u, 0u, 0u, 0u}; }
  DEVI uint4 asprev(const Raw&) const { return uint4{0u, 0u, 0u, 0u}; }
  DEVI uint4 finish(const Raw& r, const uint4&, int t, int s0) const {
    float f[8] = {r.a.x, r.a.y, r.a.z, r.a.w, r.b.x, r.b.y, r.b.z, r.b.w};
#pragma unroll
    for (int j = 0; j < 8; ++j) f[j] = (s0 + j <= t) ? f[j] * rinv[s0 + j] : 0.f;
    return pack8(f);
  }
};
struct EpiGm {
  const Params* p;
  int chunk, g;
  DEVI void operator()(int t, int c, f32x4 v) const {
    const float4 gn = *(const float4*)(p->gm_norm + g * 128 + c);
    const float bias = p->gm_b[g * 128 + t];
    const size_t tok = (size_t)chunk * 128 + t;
    float u[4], sz[4];
    unpack4(*(const uint2*)(p->U + tok * 512 + g * 128 + c), u);
    unpack4(*(const uint2*)(p->SZ + tok * 1024 + g * 128 + c), sz);
    uint2 o;
    o.x = pkbf(u[0] * (v[0] * gn.x + bias) * sz[0], u[1] * (v[1] * gn.y + bias) * sz[1]);
    o.y = pkbf(u[2] * (v[2] * gn.z + bias) * sz[2], u[3] * (v[3] * gn.w + bias) * sz[3]);
    *(uint2*)(p->Y + tok * 1024 + g * 128 + c) = o;
  }
};

DEVI void gmlp_item(const Params& p, char* smem, int item) {
  const int chunk = item >> 2, g = item & 3;
  const bfu* gv = p.GVT + (size_t)item * 128 * 128;
  float* rinv = (float*)(smem + 2 * GSTAGE_BYTES);
  const int tid = TIDX;
  {
    float* sred = rinv + 128;
    const int s4 = (tid & 31) * 4, cg = tid >> 5;
    uint2 raw[16];
#pragma unroll
    for (int i = 0; i < 16; ++i) raw[i] = *(const uint2*)(gv + (cg * 16 + i) * 128 + s4);
    float ss[4] = {0.f, 0.f, 0.f, 0.f};
#pragma unroll
    for (int i = 0; i < 16; ++i) {
      float f[4];
      unpack4(raw[i], f);
#pragma unroll
      for (int j = 0; j < 4; ++j) ss[j] += f[j] * f[j];
    }
    *(float4*)(sred + cg * 128 + s4) = float4{ss[0], ss[1], ss[2], ss[3]};
    __syncthreads();
    if (tid < 128) {
      float t = 0.f;
#pragma unroll
      for (int i = 0; i < 8; ++i) t += sred[i * 128 + tid];
      rinv[tid] = rsqrtf(t * (1.f / 128.f) + 1e-6f);
    }
  }
  __syncthreads();
  ALoadWs al{p.gm_ws + (size_t)g * 128 * 128, rinv};
  EpiGm epi{&p, chunk, g};
  gemm_tile(smem, al, gv, 128, 128, 0, 0, epi);
}

DEVI void attn_item(const Params& p, char* smem, int item) {
  const int qb = item & 63, bh = item >> 6, b = bh >> 3, h = bh & 7;
  const int q0 = qb * 256;
  bfu* Ob = (bfu*)smem;
  float* Mb = (float*)(smem + 32768);
  float* Lb = Mb + 256;
  const int tid = threadIdx.x, lane = tid & 63, wid = tid >> 6;
  const int qi = lane & 15, g = lane >> 4;
  const float slope = exp2f(-(float)(h + 1));
  const size_t tokb = (size_t)b * SEQ;
#pragma unroll 1
  for (int pi = 0; pi < 3; ++pi) {
    const int dshift = 2 * pi, d = 1 << dshift;
    const bfu* VT = p.VT + (size_t)pi * ((size_t)16 * 64 * SEQ) + (size_t)bh * 64 * SEQ;
#pragma unroll 1
    for (int u = wid; u < 16; u += 8) {
      const int r = u & (d - 1), tile = u >> dshift;
      const int sq0 = (q0 >> dshift) + tile * 16;
      const int sk0 = sq0 - 144;
      const int posq = ((sq0 + qi) << dshift) + r;
      const bfu* qp = p.Q + (tokb + posq) * 512 + h * 64 + g * 8;
      const bf16x8 qf0 = *(const bf16x8*)qp, qf1 = *(const bf16x8*)(qp + 32);
      const bfu* kbase = p.K + (tokb + r) * 512 + h * 64 + g * 8;
      const bfu* vbase = VT + (size_t)qi * SEQ + r * (SEQ >> dshift);
      bf16x8 kf[2][2];
      uint2 vf[4][2];
      auto loadkv = [&](int it) {
#pragma unroll
        for (int tt = 0; tt < 2; ++tt) {
          int sk = sk0 + (2 * it + tt) * 16 + qi;
          sk = sk < 0 ? 0 : sk;
          const bfu* kp = kbase + ((size_t)sk << dshift) * 512;
          kf[tt][0] = *(const bf16x8*)kp;
          kf[tt][1] = *(const bf16x8*)(kp + 32);
        }
        int kidx0 = sk0 + 32 * it + 4 * g, kidx1 = kidx0 + 16;
        kidx0 = kidx0 < 0 ? 0 : kidx0;
        kidx1 = kidx1 < 0 ? 0 : kidx1;
#pragma unroll
        for (int m = 0; m < 4; ++m) {
          vf[m][0] = *(const uint2*)(vbase + (size_t)(16 * m) * SEQ + kidx0);
          vf[m][1] = *(const uint2*)(vbase + (size_t)(16 * m) * SEQ + kidx1);
        }
      };
      loadkv(0);
      const int hi = 144 + qi, lo = (16 + qi > -sk0) ? 16 + qi : -sk0;
      const float sd = slope * (float)d;
      float mrun = -1e30f, l = 0.f;
      f32x4 O[4];
#pragma unroll
      for (int m = 0; m < 4; ++m) O[m] = f32x4{0.f, 0.f, 0.f, 0.f};
#pragma unroll 1
      for (int it = 0; it < 5; ++it) {
        bf16x8 ck[2][2];
        uint2 cv[4][2];
#pragma unroll
        for (int a = 0; a < 2; ++a)
#pragma unroll
          for (int c = 0; c < 2; ++c) ck[a][c] = kf[a][c];
#pragma unroll
        for (int m = 0; m < 4; ++m) {
          cv[m][0] = vf[m][0];
          cv[m][1] = vf[m][1];
        }
        if (it < 4) loadkv(it + 1);
        f32x4 S[2];
#pragma unroll
        for (int tt = 0; tt < 2; ++tt) {
          f32x4 z = {0.f, 0.f, 0.f, 0.f};
          z = __builtin_amdgcn_mfma_f32_16x16x32_bf16(ck[tt][0], qf0, z, 0, 0, 0);
          z = __builtin_amdgcn_mfma_f32_16x16x32_bf16(ck[tt][1], qf1, z, 0, 0, 0);
          S[tt] = z;
        }
        float mx = -INFINITY;
#pragma unroll
        for (int tt = 0; tt < 2; ++tt)
#pragma unroll
          for (int e = 0; e < 4; ++e) {
            const int kb = (2 * it + tt) * 16 + 4 * g;
            const bool valid = (kb >= lo - e) && (kb <= hi - e);
            const float sv = valid ? fmaf(S[tt][e], 0.125f, sd * (float)e - sd * (float)(hi - kb)) : -INFINITY;
            S[tt][e] = sv;
            mx = fmaxf(mx, sv);
          }
        mx = fmaxf(mx, __shfl_xor(mx, 16));
        mx = fmaxf(mx, __shfl_xor(mx, 32));
        const float mnew = fmaxf(mrun, mx);
        const float alpha = __expf(mrun - mnew);
        mrun = mnew;
        float ls = 0.f;
#pragma unroll
        for (int tt = 0; tt < 2; ++tt)
#pragma unroll
          for (int e = 0; e < 4; ++e) {
            const float pe = __expf(S[tt][e] - mnew);
            S[tt][e] = pe;
            ls += pe;
          }
        l = l * alpha + ls;
        uint4 pk;
        pk.x = pkbf(S[0][0], S[0][1]);
        pk.y = pkbf(S[0][2], S[0][3]);
        pk.z = pkbf(S[1][0], S[1][1]);
        pk.w = pkbf(S[1][2], S[1][3]);
        const bf16x8 pf = __builtin_bit_cast(bf16x8, pk);
#pragma unroll
        for (int m = 0; m < 4; ++m) {
          O[m] *= alpha;
          const uint4 vv = {cv[m][0].x, cv[m][0].y, cv[m][1].x, cv[m][1].y};
          O[m] = __builtin_amdgcn_mfma_f32_16x16x32_bf16(__builtin_bit_cast(bf16x8, vv), pf, O[m], 0, 0, 0);
        }
      }
      l += __shfl_xor(l, 16);
      l += __shfl_xor(l, 32);
      const float mx = mrun;
      const float il = 1.f / l;
      const int ql = ((tile * 16 + qi) << dshift) + r;
      float wo = 0.f, wn = 1.f;
      float mnew = mx, lnew = l;
      if (pi > 0) {
        const float mo = Mb[ql], lo = Lb[ql];
        mnew = fmaxf(mo, mx);
        wo = lo * __expf(mo - mnew);
        wn = l * __expf(mx - mnew);
        lnew = wo + wn;
        const float inv = 1.f / lnew;
        wo *= inv;
        wn *= inv;
      }
      wn *= il;
#pragma unroll
      for (int m = 0; m < 4; ++m) {
        bfu* op = Ob + ql * 64 + 16 * m + 4 * g;
        float o[4];
        if (pi > 0) {
          const uint2 ov = *(const uint2*)op;
          o[0] = wo * bf2f(ov.x & 0xffffu) + wn * O[m][0];
          o[1] = wo * bf2f(ov.x >> 16) + wn * O[m][1];
          o[2] = wo * bf2f(ov.y & 0xffffu) + wn * O[m][2];
          o[3] = wo * bf2f(ov.y >> 16) + wn * O[m][3];
        } else {
#pragma unroll
          for (int e = 0; e < 4; ++e) o[e] = wn * O[m][e];
        }
        if (pi < 2) {
          uint2 w;
          w.x = pkbf(o[0], o[1]);
          w.y = pkbf(o[2], o[3]);
          *(uint2*)op = w;
        } else {
          const size_t oi = (tokb + q0 + ql) * 1024 + 512 + h * 64 + 16 * m + 4 * g;
          const uint2 sz = *(const uint2*)(p.SZ + oi);
          uint2 w;
          w.x = pkbf(o[0] * bf2f(sz.x & 0xffffu), o[1] * bf2f(sz.x >> 16));
          w.y = pkbf(o[2] * bf2f(sz.y & 0xffffu), o[3] * bf2f(sz.y >> 16));
          *(uint2*)(p.Y + oi) = w;
        }
      }
      if (pi < 2 && g == 0) {
        Mb[ql] = mnew;
        Lb[ql] = lnew;
      }
    }
    __syncthreads();
  }
}

DEVI void phase2(const Params& p, char* smem, int bid, int nb) {
  for (int it = bid; it < 16 * 64; it += nb) attn_item(p, smem, it);
  char* hs = smem + HF * HALF_SMEM;
  for (int it = bid * 2 + HF; it < (T_TOK / 128) * 4; it += nb * 2) gmlp_item(p, hs, it);
}

DEVI void phase3(const Params& p, char* smem, int bid, int nb) {
  PgEpiRes E{p.x, p.out};
  pg_gemm(smem, p.Y, p.WT_out, T_TOK, 1024, 1024, E, bid, nb);
}
DEVI void phase3b(const Params& p, int bid, int nb) {
  for (int it = bid; it < T_TOK / 16; it += nb) {
    const int row = it * 16 + (threadIdx.x >> 6) * 2;
    rms_row2_bf16(p.out + (size_t)row * 1024, p.ln_odd, p.H + (size_t)row * 1024, threadIdx.x & 63);
  }
}

struct ALoadMix {
  typedef uint4 Raw;
  static constexpr bool kFat = true;
  static constexpr bool kConsec = true;
  const bfu* H;
  const float* mu;
  DEVI Raw load(int row, int k) const { return *(const uint4*)(H + (size_t)row * 1024 + k); }
  DEVI uint4 loadprev(int row, int k) const {
    const int prow = ((row & (SEQ - 1)) != 0) ? row - 1 : row;
    return *(const uint4*)(H + (size_t)prow * 1024 + k);
  }
  DEVI uint4 asprev(const Raw& r) const { return r; }
  DEVI uint4 finish(const Raw& r, const uint4& pr, int row, int k) const {
    float c[8], pv[8];
    unpack8(r, c);
    unpack8(pr, pv);
    const float first = ((row & (SEQ - 1)) != 0) ? 1.f : 0.f;
    const float4 m0 = *(const float4*)(mu + k), m1 = *(const float4*)(mu + k + 4);
    const float mm[8] = {m0.x, m0.y, m0.z, m0.w, m1.x, m1.y, m1.z, m1.w};
#pragma unroll
    for (int j = 0; j < 8; ++j) c[j] = c[j] + (pv[j] * first - c[j]) * mm[j];
    return pack8(c);
  }
};
struct Epi4 {
  const Params* p;
  int nt;
  DEVI void operator()(int row, int col, f32x4 v) const {
    uint2 o;
    if (nt < 24) {
      o.x = pkbf(v[0], v[1]);
      o.y = pkbf(v[2], v[3]);
      bfu* dst = (nt < 8) ? p->R + (size_t)row * 1024 + col
                          : (nt < 16) ? p->K1 + (size_t)row * 1024 + col - 1024 : p->V1 + (size_t)row * 1024 + col - 2048;
      *(uint2*)dst = o;
    } else if (nt < 32) {
      o.x = pkbf(silu_(v[0]), silu_(v[1]));
      o.y = pkbf(silu_(v[2]), silu_(v[3]));
      *(uint2*)(p->SG + (size_t)row * 1024 + col - 3072) = o;
    } else if (nt == 32) {
      const int c = col - 4096;
      if (c < 64) {
        o.x = pkbf(tanh_(v[0]), tanh_(v[1]));
        o.y = pkbf(tanh_(v[2]), tanh_(v[3]));
        *(uint2*)(p->TW + (size_t)row * 64 + c) = o;
      }
    } else {
      const int c = col - 4224;
      if (c < 64) {
        o.x = pkbf(v[0], v[1]);
        o.y = pkbf(v[2], v[3]);
        *(uint2*)(p->TA + (size_t)row * 64 + c) = o;
      }
    }
  }
};
DEVI void phase4_tile(const Params& p, char* smem, int mt, int nt) {
  float* smu = (float*)(smem + 2 * GSTAGE_BYTES);
  const int mi = (nt < 8) ? 0 : (nt < 16) ? 2 : (nt < 24) ? 3 : (nt < 32) ? 5 : (nt == 32) ? 1 : 4;
  *(float4*)(smu + TIDX * 4) = *(const float4*)(p.mu + mi * 1024 + TIDX * 4);
  __syncthreads();
  ALoadMix al{p.H, smu};
  Epi4 epi{&p, nt};
  gemm_tile<1>(smem, al, p.WT_3, 1024, 1024, mt * 128, nt * 128, epi);
}
DEVI void phaseM(const Params& p, char* smem, int bid, int nb) {
  char* hs = smem + HF * HALF_SMEM;
  for (int it = bid * 2 + HF; it < (T_TOK / 128) * 2; it += nb * 2) phase4_tile(p, hs, it >> 1, 32 + (it & 1));
  const int tid = threadIdx.x;
  const int cc = (tid & 127) * 8, rsub = tid >> 7;
  float mr[8], mk[8], mv[8], mg[8];
  {
    const float4 a0 = *(const float4*)(p.mu + 0 * 1024 + cc), a1 = *(const float4*)(p.mu + 0 * 1024 + cc + 4);
    const float4 b0 = *(const float4*)(p.mu + 2 * 1024 + cc), b1 = *(const float4*)(p.mu + 2 * 1024 + cc + 4);
    const float4 c0 = *(const float4*)(p.mu + 3 * 1024 + cc), c1 = *(const float4*)(p.mu + 3 * 1024 + cc + 4);
    const float4 d0 = *(const float4*)(p.mu + 5 * 1024 + cc), d1 = *(const float4*)(p.mu + 5 * 1024 + cc + 4);
    mr[0] = a0.x; mr[1] = a0.y; mr[2] = a0.z; mr[3] = a0.w; mr[4] = a1.x; mr[5] = a1.y; mr[6] = a1.z; mr[7] = a1.w;
    mk[0] = b0.x; mk[1] = b0.y; mk[2] = b0.z; mk[3] = b0.w; mk[4] = b1.x; mk[5] = b1.y; mk[6] = b1.z; mk[7] = b1.w;
    mv[0] = c0.x; mv[1] = c0.y; mv[2] = c0.z; mv[3] = c0.w; mv[4] = c1.x; mv[5] = c1.y; mv[6] = c1.z; mv[7] = c1.w;
    mg[0] = d0.x; mg[1] = d0.y; mg[2] = d0.z; mg[3] = d0.w; mg[4] = d1.x; mg[5] = d1.y; mg[6] = d1.z; mg[7] = d1.w;
  }
#pragma unroll 1
  for (int it = bid; it < T_TOK / 8; it += nb) {
    const int ra = it * 8 + rsub, rb = ra + 4;
    const size_t oa = (size_t)ra * 1024 + cc, ob = (size_t)rb * 1024 + cc;
    const uint4 ca = *(const uint4*)(p.H + oa), cb = *(const uint4*)(p.H + ob);
    const uint4 pa = *(const uint4*)(p.H + (((ra & (SEQ - 1)) != 0) ? oa - 1024 : oa));
    const uint4 pb = *(const uint4*)(p.H + ob - 1024);
    const float fa = ((ra & (SEQ - 1)) != 0) ? 1.f : 0.f;
#pragma unroll
    for (int half = 0; half < 2; ++half) {
      float c[8], d[8], o[8];
      unpack8(half ? cb : ca, c);
      unpack8(half ? pb : pa, d);
      const float f = half ? 1.f : fa;
      const size_t oo = half ? ob : oa;
#pragma unroll
      for (int j = 0; j < 8; ++j) d[j] = d[j] * f - c[j];
#pragma unroll
      for (int j = 0; j < 8; ++j) o[j] = c[j] + d[j] * mr[j];
      *(uint4*)(p.XR + oo) = pack8(o);
#pragma unroll
      for (int j = 0; j < 8; ++j) o[j] = c[j] + d[j] * mk[j];
      *(uint4*)(p.XK + oo) = pack8(o);
#pragma unroll
      for (int j = 0; j < 8; ++j) o[j] = c[j] + d[j] * mv[j];
      *(uint4*)(p.XV + oo) = pack8(o);
#pragma unroll
      for (int j = 0; j < 8; ++j) o[j] = c[j] + d[j] * mg[j];
      *(uint4*)(p.XG + oo) = pack8(o);
    }
  }
}
DEVI void phase3a(const Params& p, char* smem, int bid, int nb) {
  PgEpi3 E{p.R, p.K1, 0};
  pg_gemm2(smem, p.XR, p.XK, 4, p.WT_3, T_TOK, 2048, 1024, E, bid, nb);
}
DEVI void phase3c(const Params& p, char* smem, int bid, int nb) {
  PgEpi3 E{p.V1, p.SG, 1};
  pg_gemm2(smem, p.XV, p.XG, 4, p.WT_3 + (size_t)2048 * 1024, T_TOK, 2048, 1024, E, bid, nb);
}

struct Epi5w {
  const Params* p;
  DEVI void operator()(int row, int col, f32x4 v) const {
    const float4 w0 = *(const float4*)(p->w0 + col);
    const float k = 0.6065306597126334f;
    uint2 o;
    o.x = pkbf(k * sigmoid_(w0.x + v[0]), k * sigmoid_(w0.y + v[1]));
    o.y = pkbf(k * sigmoid_(w0.z + v[2]), k * sigmoid_(w0.w + v[3]));
    *(uint2*)(p->EW + (size_t)row * 1024 + col) = o;
  }
};
struct Epi5a {
  const Params* p;
  DEVI void operator()(int row, int col, f32x4 v) const {
    const float4 a0 = *(const float4*)(p->a0 + col);
    uint2 o;
    o.x = pkbf(sigmoid_(a0.x + v[0]), sigmoid_(a0.y + v[1]));
    o.y = pkbf(sigmoid_(a0.z + v[2]), sigmoid_(a0.w + v[3]));
    *(uint2*)(p->AA + (size_t)row * 1024 + col) = o;
  }
};
DEVI void phase5(const Params& p, char* smem, int bid, int nb) {
  constexpr int N1 = (T_TOK / 128) * 8;
  char* hs = smem + HF * HALF_SMEM;
  for (int it = bid * 2 + HF; it < 2 * N1; it += nb * 2) {
    if (it < N1) {
      ALoadPlain al{p.TW, 64};
      Epi5w epi{&p};
      gemm_tile(hs, al, p.W2T, 64, 64, (it >> 3) * 128, (it & 7) * 128, epi);
    } else {
      const int j = it - N1;
      ALoadPlain al{p.TA, 64};
      Epi5a epi{&p};
      gemm_tile(hs, al, p.A2T, 64, 64, (j >> 3) * 128, (j & 7) * 128, epi);
    }
  }
}

DEVI void scanx_item(const Params& p, char* smem, int item, int next_item, uint2& ur, uint2& uk, uint2& ue, uint2& ua, uint2& uv) {
  const int bh = item & 31, c = item >> 5;
  const int b = bh >> 4, h = bh & 15;
  const size_t rowbase = ((size_t)b * SEQ + (size_t)c * 16) * 1024 + h * 64;
  float* sA = (float*)smem;
  float* sR = sA + 16 * 68;
  float* sBt = sR + 16 * 68;
  float* sKt = sBt + 16 * 68;
  float* sE = sKt + 16 * 68;
  float* sMab = sE + 16 * 64;
  float* sMak = sMab + 256;
  float* sM2 = sMak + 256;
  float* sM4 = sM2 + 256;
  float* sT = sM4 + 256;
  float* sT2 = sT + 256;
  const int tid = TIDX;
  const int tau = tid >> 4, c4 = (tid & 15) * 4;
  const size_t o = rowbase + (size_t)tau * 1024 + c4;
  float r[4], k[4], ew[4], a[4], vv[4];
  unpack4(ur, r);
  unpack4(uk, k);
  unpack4(ue, ew);
  unpack4(ua, a);
  unpack4(uv, vv);
  {
    const int nbh = next_item & 31, nc = next_item >> 5;
    const size_t no = ((size_t)(nbh >> 4) * SEQ + (size_t)nc * 16 + tau) * 1024 + (nbh & 15) * 64 + c4;
    ur = *(const uint2*)(p.R + no);
    uk = *(const uint2*)(p.K1 + no);
    ue = *(const uint2*)(p.EW + no);
    ua = *(const uint2*)(p.AA + no);
    uv = *(const uint2*)(p.V1 + no);
  }
  float kk[4], kp[4], bb[4];
  float ss = 0.f, cf = 0.f;
#pragma unroll
  for (int j = 0; j < 4; ++j) {
    const int ch = h * 64 + c4 + j;
    kk[j] = k[j] * p.k_k[ch];
    ss += kk[j] * kk[j];
    kp[j] = k[j] * (1.f + (a[j] - 1.f) * p.k_a[ch]);
    cf += r[j] * kp[j] * p.r_k[ch];
  }
  ss = reduce16(ss);
  cf = reduce16(cf);
  const float rn = rsqrtf(fmaxf(ss, 1e-24f));
#pragma unroll
  for (int j = 0; j < 4; ++j) {
    kk[j] *= rn;
    bb[j] = kk[j] * a[j];
    sE[tau * 64 + c4 + j] = ew[j];
  }
  if ((tid & 15) == 0) p.COEF[((size_t)b * SEQ + (size_t)c * 16 + tau) * 16 + h] = cf;
  __syncthreads();
  float Li[4] = {0.f, 0.f, 0.f, 0.f}, L15[4] = {0.f, 0.f, 0.f, 0.f};
#pragma unroll
  for (int i = 0; i < 16; ++i) {
    const float4 e = *(const float4*)(sE + i * 64 + c4);
    const float m = (i <= tau) ? 1.f : 0.f;
    Li[0] += m * e.x; Li[1] += m * e.y; Li[2] += m * e.z; Li[3] += m * e.w;
    L15[0] += e.x; L15[1] += e.y; L15[2] += e.z; L15[3] += e.w;
  }
  float rt[4], bhat[4], khat[4];
#pragma unroll
  for (int j = 0; j < 4; ++j) {
    const float ep = __expf(Li[j]), em = __expf(-Li[j]), eh = __expf(-(L15[j] - Li[j]));
    const float at = -kk[j] * __expf(-(Li[j] - ew[j]));
    rt[j] = r[j] * em;
    sA[tau * 68 + c4 + j] = at;
    sR[tau * 68 + c4 + j] = rt[j];
    sBt[tau * 68 + c4 + j] = bb[j] * ep;
    sKt[tau * 68 + c4 + j] = kp[j] * ep;
    bhat[j] = bb[j] * eh;
    khat[j] = kp[j] * eh;
  }
  *(uint2*)(p.R + o) = pack4(rt);
#pragma unroll
  for (int j = 0; j < 4; ++j) {
    const int lin = (c4 + j) * 16 + tau;
    const size_t off = rowbase + (size_t)(lin >> 6) * 1024 + (lin & 63);
    p.EW[off] = (bfu)f2bf(bhat[j]);
    p.K1[off] = (bfu)f2bf(khat[j]);
    p.V1[off] = (bfu)f2bf(vv[j]);
  }
  if (tau == 0) {
    float4 gq = {__expf(-L15[0]), __expf(-L15[1]), __expf(-L15[2]), __expf(-L15[3])};
    *(float4*)(p.G15 + (size_t)item * 64 + c4) = gq;
  }
  __syncthreads();
  {
    const int i = tid >> 4, tq = tid & 15;
    float mab = 0.f, mak = 0.f, mrb = 0.f, mrk = 0.f;
#pragma unroll
    for (int kq = 0; kq < 64; kq += 4) {
      const float4 bi = *(const float4*)(sBt + i * 68 + kq);
      const float4 ki = *(const float4*)(sKt + i * 68 + kq);
      const float4 aq = *(const float4*)(sA + tq * 68 + kq);
      const float4 rq = *(const float4*)(sR + tq * 68 + kq);
      mab += bi.x * aq.x + bi.y * aq.y + bi.z * aq.z + bi.w * aq.w;
      mak += ki.x * aq.x + ki.y * aq.y + ki.z * aq.z + ki.w * aq.w;
      mrb += bi.x * rq.x + bi.y * rq.y + bi.z * rq.z + bi.w * rq.w;
      mrk += ki.x * rq.x + ki.y * rq.y + ki.z * rq.z + ki.w * rq.w;
    }
    if (!(i < tq)) { mab = 0.f; mak = 0.f; }
    if (!(i <= tq)) { mrb = 0.f; mrk = 0.f; }
    sMab[i * 16 + tq] = mab;
    sMak[i * 16 + tq] = mak;
    bfu* mr = p.MRT + (size_t)item * 512 + tq * 32 + (i >> 2) * 8 + (i & 3);
    mr[0] = (bfu)f2bf(mrb);
    mr[4] = (bfu)f2bf(mrk);
  }
  __syncthreads();
  {
    const int i = tid >> 4, j = tid & 15;
    float m2 = 0.f;
#pragma unroll
    for (int kq = 0; kq < 16; ++kq) m2 += sMab[i * 16 + kq] * sMab[kq * 16 + j];
    sM2[i * 16 + j] = m2;
    __syncthreads();
    float t1 = ((i == j) ? 1.f : 0.f) + sMab[i * 16 + j] + m2, m4 = 0.f;
#pragma unroll
    for (int kq = 0; kq < 16; ++kq) {
      t1 += sMab[i * 16 + kq] * sM2[kq * 16 + j];
      m4 += sM2[i * 16 + kq] * sM2[kq * 16 + j];
    }
    sT[i * 16 + j] = t1;
    sM4[i * 16 + j] = m4;
    __syncthreads();
    float t2 = t1, m8 = 0.f;
#pragma unroll
    for (int kq = 0; kq < 16; ++kq) {
      t2 += sT[i * 16 + kq] * sM4[kq * 16 + j];
      m8 += sM4[i * 16 + kq] * sM4[kq * 16 + j];
    }
    sT2[i * 16 + j] = t2;
    __syncthreads();
    sM2[i * 16 + j] = m8;
    __syncthreads();
    float t3 = t2;
#pragma unroll
    for (int kq = 0; kq < 16; ++kq) t3 += sT2[i * 16 + kq] * sM2[kq * 16 + j];
    sT[i * 16 + j] = t3;
    __syncthreads();
  }
  {
    const int tq = tid >> 4, k4 = (tid & 15) * 4, ii = tid & 15;
    float w0 = 0.f, w1 = 0.f, w2 = 0.f, w3 = 0.f, gt = 0.f;
#pragma unroll
    for (int jj = 0; jj < 16; ++jj) {
      const float tm = sT[jj * 16 + tq];
      const float4 av = *(const float4*)(sA + jj * 68 + k4);
      w0 += av.x * tm; w1 += av.y * tm; w2 += av.z * tm; w3 += av.w * tm;
      gt += sMak[ii * 16 + jj] * tm;
    }
    uint2 wv;
    wv.x = pkbf(w0, w1);
    wv.y = pkbf(w2, w3);
    *(uint2*)(p.AA + rowbase + (size_t)tq * 1024 + k4) = wv;
    p.GT[(size_t)item * 256 + tq * 16 + ii] = (bfu)f2bf(gt);
  }
  __syncthreads();
}
DEVI void phase6x(const Params& p, char* smem, int bid, int nb) {
  char* hs = smem + HF * HALF_SMEM;
  constexpr int NI = (SEQ / 16) * 32;
  const int vnb = nb * 2;
  int it = bid * 2 + HF;
  if (it >= NI) return;
  uint2 ur, uk, ue, ua, uv;
  {
    const int tau = TIDX >> 4, c4 = (TIDX & 15) * 4;
    const int bh = it & 31, c = it >> 5;
    const size_t o = ((size_t)(bh >> 4) * SEQ + (size_t)c * 16 + tau) * 1024 + (bh & 15) * 64 + c4;
    ur = *(const uint2*)(p.R + o);
    uk = *(const uint2*)(p.K1 + o);
    ue = *(const uint2*)(p.EW + o);
    ua = *(const uint2*)(p.AA + o);
    uv = *(const uint2*)(p.V1 + o);
  }
#pragma unroll 1
  for (; it < NI; it += vnb) scanx_item(p, hs, it, (it + vnb < NI) ? it + vnb : it, ur, uk, ue, ua, uv);
}

DEVI bf16x8 mk8(uint2 a, uint2 b) {
  const uint4 v = {a.x, a.y, b.x, b.y};
  return __builtin_bit_cast(bf16x8, v);
}
DEVI uint2 packacc(f32x4 a) {
  uint2 r;
  r.x = pkbf(a[0], a[1]);
  r.y = pkbf(a[2], a[3]);
  return r;
}
constexpr int SCH = 4;
constexpr int SROW = 136;
constexpr int SARR = 16 * SROW;
constexpr int SOFF_GT = 5 * SARR;
constexpr int SOFF_MR = SOFF_GT + 512;
constexpr int SOFF_G15 = SOFF_MR + 1024;
constexpr int SIMG = SOFF_G15 + 256;
#define SCANS_LD5(P, I, O)                       \
    P##a##I = *(const uint4*)(p.AA + (O));       \
    P##r##I = *(const uint4*)(p.R + (O));        \
    P##e##I = *(const uint4*)(p.EW + (O));       \
    P##k##I = *(const uint4*)(p.K1 + (O));       \
    P##v##I = *(const uint4*)(p.V1 + (O));
#define SCANS_ISSUE(P, SC)                                                                           \
  {                                                                                                  \
    const size_t hb_ = ((size_t)b * SEQ) * 1024 + h * 64 + c80 * 8;                                  \
    const int tk0_ = (SC) * SCH * 16 + cl0 * 16 + row0;                                              \
    const int tk1_ = tk0_ + 32;                                                                      \
    SCANS_LD5(P, 0, hb_ + (size_t)(tk0_ < SEQ ? tk0_ : SEQ - 1) * 1024)                              \
    SCANS_LD5(P, 1, hb_ + (size_t)(tk1_ < SEQ ? tk1_ : SEQ - 1) * 1024)                              \
    const int c0_ = (SC) * SCH;                                                                      \
    const size_t ib_ = (size_t)b * 16 + h;                                                           \
    const int tg_ = tid < 128 ? tid : 127;                                                           \
    const int cg_ = c0_ + (tg_ >> 5);                                                                \
    P##gm = *(const uint4*)(p.GT + ((size_t)(cg_ < SEQ / 16 ? cg_ : SEQ / 16 - 1) * 32 + ib_) * 256 + (tg_ & 31) * 8);  \
    const int t5_ = tid < 64 ? tid : 63;                                                             \
    const int c5_ = c0_ + (t5_ >> 4);                                                                \
    P##g5 = *(const uint4*)(p.G15 + ((size_t)(c5_ < SEQ / 16 ? c5_ : SEQ / 16 - 1) * 32 + ib_) * 64 + (t5_ & 15) * 4);  \
    const int cm_ = c0_ + (tid >> 6);                                                                \
    P##mr = *(const uint4*)(p.MRT + ((size_t)(cm_ < SEQ / 16 ? cm_ : SEQ / 16 - 1) * 32 + ib_) * 512 + (tid & 63) * 8); \
  }
#define SCANS_ST5(P, I, B)                                                                           \
    *(uint2*)(B) = uint2{P##a##I.x, P##a##I.y};  *(uint2*)((B) + 8) = uint2{P##a##I.z, P##a##I.w};   \
    *(uint2*)((B) + SARR) = uint2{P##r##I.x, P##r##I.y};  *(uint2*)((B) + SARR + 8) = uint2{P##r##I.z, P##r##I.w};   \
    *(uint2*)((B) + 2 * SARR) = uint2{P##e##I.x, P##e##I.y};  *(uint2*)((B) + 2 * SARR + 8) = uint2{P##e##I.z, P##e##I.w};   \
    *(uint2*)((B) + 3 * SARR) = uint2{P##k##I.x, P##k##I.y};  *(uint2*)((B) + 3 * SARR + 8) = uint2{P##k##I.z, P##k##I.w};   \
    *(uint2*)((B) + 4 * SARR) = uint2{P##v##I.x, P##v##I.y};  *(uint2*)((B) + 4 * SARR + 8) = uint2{P##v##I.z, P##v##I.w};
#define SCANS_COMMIT(P)                                                                              \
  {                                                                                                  \
    char* b0_ = smem + cl0 * SIMG + row0 * SROW + c80 * 16;                                          \
    SCANS_ST5(P, 0, b0_)                                                                             \
    SCANS_ST5(P, 1, b0_ + 2 * SIMG)                                                                  \
    if (tid < 128) *(uint4*)(smem + (tid >> 5) * SIMG + SOFF_GT + (tid & 31) * 16) = P##gm;          \
    if (tid < 64) *(uint4*)(smem + (tid >> 4) * SIMG + SOFF_G15 + (tid & 15) * 16) = P##g5;          \
    *(uint4*)(smem + (tid >> 6) * SIMG + SOFF_MR + (tid & 63) * 16) = P##mr;                         \
  }
#define SCANS_COMPUTE(SCI)                                                                           \
  _Pragma("unroll 1") for (int cl = 0; cl < SCH && (SCI) * SCH + cl < SEQ / 16; ++cl) {             \
    const char* img = smem + cl * SIMG;                                                              \
        \
    const uint2 vb = *(const uint2*)(img + 4 * SARR + vrow * SROW + vcol * 2);                       \
    const uint2 gt = *(const uint2*)(img + SOFF_GT + (q * 16 + 4 * g) * 2);                          \
    const char* wp = img + q * SROW + (4 * g) * 2;                                                   \
    const uint2 w00 = *(const uint2*)(wp), w01 = *(const uint2*)(wp + 32);                           \
    const uint2 w10 = *(const uint2*)(wp + 64), w11 = *(const uint2*)(wp + 96);                      \
    const uint2 r00 = *(const uint2*)(wp + SARR), r01 = *(const uint2*)(wp + SARR + 32);             \
    const uint2 r10 = *(const uint2*)(wp + SARR + 64), r11 = *(const uint2*)(wp + SARR + 96);        \
    const uint4 mr = *(const uint4*)(img + SOFF_MR + (q * 32 + g * 8) * 2);                          \
    uint2 bk0[4], bk1[4];                                                                            \
    float4 g15[4];                                                                                   \
    _Pragma("unroll") for (int n = 0; n < 4; ++n) {                                                  \
      const int ch = 16 * n + q;                                                                     \
      const char* bp = img + 2 * SARR + (ch >> 2) * SROW + ((ch & 3) * 16 + 4 * g) * 2;              \
      bk0[n] = *(const uint2*)(bp);                                                                  \
      bk1[n] = *(const uint2*)(bp + SARR);                                                           \
      g15[n] = *(const float4*)(img + SOFF_G15 + (16 * n + 4 * g) * 4);                              \
    }                                                                                                \
    __builtin_amdgcn_sched_barrier(0);                                                               \
    const bf16x8 sB0 = mk8(packacc(acc[0]), packacc(acc[1]));                                        \
    const bf16x8 sB1 = mk8(packacc(acc[2]), packacc(acc[3]));                                        \
    f32x4 Z = {0.f, 0.f, 0.f, 0.f};                                                                  \
    Z = __builtin_amdgcn_mfma_f32_16x16x32_bf16(mk8(gt, zero2), mk8(vb, zero2), Z, 0, 0, 0);         \
    f32x4 Y = {0.f, 0.f, 0.f, 0.f};                                                                  \
    Z = __builtin_amdgcn_mfma_f32_16x16x32_bf16(mk8(w00, w01), sB0, Z, 0, 0, 0);                     \
    Y = __builtin_amdgcn_mfma_f32_16x16x32_bf16(mk8(r00, r01), sB0, Y, 0, 0, 0);                     \
    Z = __builtin_amdgcn_mfma_f32_16x16x32_bf16(mk8(w10, w11), sB1, Z, 0, 0, 0);                     \
    Y = __builtin_amdgcn_mfma_f32_16x16x32_bf16(mk8(r10, r11), sB1, Y, 0, 0, 0);                     \
    const bf16x8 zvB = mk8(packacc(Z), vb);                                                          \
    Y = __builtin_amdgcn_mfma_f32_16x16x32_bf16(__builtin_bit_cast(bf16x8, mr), zvB, Y, 0, 0, 0);    \
    _Pragma("unroll") for (int n = 0; n < 4; ++n) {                                                  \
      f32x4 scv = acc[n];                                                                            \
      scv[0] *= g15[n].x; scv[1] *= g15[n].y; scv[2] *= g15[n].z; scv[3] *= g15[n].w;                \
      acc[n] = __builtin_amdgcn_mfma_f32_16x16x32_bf16(mk8(bk0[n], bk1[n]), zvB, scv, 0, 0, 0);      \
    }                                                                                                \
    _Pragma("unroll") for (int e = 0; e < 4; ++e)                                                    \
        ybuf[(cl * 16 + 4 * g + e) * 16 + q] = (bfu)f2bf(Y[e]);                                      \
  }
DEVI void scans_block(const Params& p, char* smem, int bh, int vs) {
  const int b = bh >> 4, h = bh & 15;
  const int lane = threadIdx.x & 63, wv = threadIdx.x >> 6, q = lane & 15, g = lane >> 4;
  f32x4 acc[4];
#pragma unroll
  for (int n = 0; n < 4; ++n) acc[n] = f32x4{0.f, 0.f, 0.f, 0.f};
  const uint2 zero2 = {0u, 0u};
  bfu* yout = p.YS + ((size_t)b * SEQ) * 1024 + h * 64 + vs * 16;
  bfu* ybuf = (bfu*)(smem + SCH * SIMG);
  const int tid = TIDX, grp = HF;
  const int cl0 = tid >> 7, row0 = (tid >> 3) & 15, c80 = tid & 7;
  uint4 Aa0, Aa1, Ar0, Ar1, Ae0, Ae1, Ak0, Ak1, Av0, Av1, Agm, Ag5, Amr;
  constexpr int NSC = (SEQ / 16 + SCH - 1) / SCH;
  const int vrow = vs * 4 + (q >> 2), vcol = (q & 3) * 16 + 4 * g;
  if (grp == 0) {
    SCANS_ISSUE(A, 0);
    SCANS_COMMIT(A);
    SCANS_ISSUE(A, 2);
  } else {
    SCANS_ISSUE(A, 1);
  }
  __syncthreads();
#pragma unroll 1
  for (int sc = 0; sc < NSC; ++sc) {
    if (wv == 0) {
      SCANS_COMPUTE(sc);
    }
    __syncthreads();
    if (threadIdx.x >= 64 && threadIdx.x < 64 + SCH * 32) {
      const int idx = threadIdx.x - 64, tok = sc * SCH * 16 + (idx >> 1);
      if (tok < SEQ) *(uint4*)(yout + (size_t)tok * 1024 + (idx & 1) * 8) = *(const uint4*)(ybuf + (idx >> 1) * 16 + (idx & 1) * 8);
    }
    if (((sc + 1) & 1) == grp) {
      SCANS_COMMIT(A);
      SCANS_ISSUE(A, (sc + 3 < NSC ? sc + 3 : NSC - 1));
    }
    __syncthreads();
  }
}
DEVI void phase6(const Params& p, char* smem, int bid, int nb) {
  for (int it = bid; it < 128; it += nb) scans_block(p, smem, it >> 2, it & 3);
}

DEVI void phase6b(const Params& p, int bid, int nb) {
  const int lane = threadIdx.x & 63, wv = (threadIdx.x >> 6) & 3;
  for (int it = bid; it < T_TOK / 2; it += nb) {
    const int t = it * 2 + (threadIdx.x >> 8);
    const int tb = t & ~15, tau = t & 15;
    float ys[4], vv[4], sg[4], bon[4];
#pragma unroll
    for (int j = 0; j < 4; ++j) {
      const int h = wv * 4 + j;
      const size_t idx = (size_t)t * 1024 + h * 64 + lane;
      ys[j] = bf2f(p.YS[idx]);
      sg[j] = bf2f(p.SG[idx]);
      vv[j] = bf2f(p.V1[(size_t)(tb + (lane >> 2)) * 1024 + h * 64 + (lane & 3) * 16 + tau]);
      bon[j] = p.COEF[(size_t)t * 16 + h];
    }
#pragma unroll
    for (int j = 0; j < 4; ++j) {
      const int h = wv * 4 + j;
      const int c = h * 64 + lane;
      const float mean = wave_sum(ys[j]) * (1.f / 64.f);
      const float dv = ys[j] - mean;
      const float var = wave_sum(dv * dv) * (1.f / 64.f);
      float y = dv * rsqrtf(var + 64e-5f) * p.lnw[c] + p.lnb[c];
      y = (y + bon[j] * vv[j]) * sg[j];
      p.YS[(size_t)t * 1024 + c] = (bfu)f2bf(y);
    }
  }
}

DEVI void phase7(const Params& p, char* smem, int bid, int nb) {
  PgEpiRes E{p.out, p.out};
  pg_gemm(smem, p.YS, p.WT_o, T_TOK, 1024, 1024, E, bid, nb);
}
DEVI void phase8(const Params& p, int bid, int nb) {
  for (int it = bid; it < T_TOK / 16; it += nb) {
    const int row = it * 16 + (threadIdx.x >> 6) * 2;
    const int lane = threadIdx.x & 63;
    float* src = p.out + (size_t)row * 1024;
    float4 v[2][4];
    float ss[2] = {0.f, 0.f};
#pragma unroll
    for (int r = 0; r < 2; ++r)
#pragma unroll
      for (int i = 0; i < 4; ++i) v[r][i] = *(const float4*)(src + r * 1024 + lane * 4 + 256 * i);
#pragma unroll
    for (int r = 0; r < 2; ++r)
#pragma unroll
      for (int i = 0; i < 4; ++i)
        ss[r] += v[r][i].x * v[r][i].x + v[r][i].y * v[r][i].y + v[r][i].z * v[r][i].z + v[r][i].w * v[r][i].w;
#pragma unroll
    for (int r = 0; r < 2; ++r) {
      const float rinv = rsqrtf(wave_sum(ss[r]) * (1.f / 1024.f) + 1e-6f);
#pragma unroll
      for (int i = 0; i < 4; ++i) {
        const float4 g = *(const float4*)(p.fnorm + lane * 4 + 256 * i);
        const float4 o = {v[r][i].x * rinv * g.x, v[r][i].y * rinv * g.y, v[r][i].z * rinv * g.z, v[r][i].w * rinv * g.w};
        *(float4*)(src + r * 1024 + lane * 4 + 256 * i) = o;
      }
    }
  }
}

#define XB_TMO      128
#define XB_XCNT(j)  (256  + 64 * (j))
#define XB_XSUB(j)  (1280 + 64 * (j))
#define XB_XGEN(j)  (2304 + 64 * (j))
#define XB_TOP      3328
#define XB_TOPGEN   3392
#define XCD_BAR_WORDS 3456
#define XB_SPIN_CAP (1u << 18)
#define LAS __attribute__((address_space(3)))

__device__ __forceinline__ unsigned xb_ld(unsigned* p)              { return __hip_atomic_load(p, __ATOMIC_RELAXED, __HIP_MEMORY_SCOPE_AGENT); }
__device__ __forceinline__ unsigned xb_add(unsigned* p, unsigned v) { return __hip_atomic_fetch_add(p, v, __ATOMIC_RELAXED, __HIP_MEMORY_SCOPE_AGENT); }
__device__ __forceinline__ unsigned xb_xcc_id() { return (unsigned)__builtin_amdgcn_s_getreg((3 << 11) | 20) & 0xFu; }
#define XB_SPIN(cond, bar) do { unsigned _sp = 0; while (cond) { __builtin_amdgcn_s_sleep(1); \
    if ((++_sp & 255u) == 0u) { if (xb_ld(&(bar)[XB_TMO])) break; if (_sp > XB_SPIN_CAP) { atomicAdd(&(bar)[XB_TMO], 1u); break; } } } } while (0)

struct XcdBarrier {
    unsigned* bar; unsigned x;
    volatile LAS unsigned* st;
};

__device__ __forceinline__ XcdBarrier xcd_barrier_post(unsigned* bar, volatile LAS unsigned* st) {
    XcdBarrier b; b.bar = bar; b.x = xb_xcc_id(); b.st = st;
    if (threadIdx.x == 0) (void)xb_add(&bar[XB_XCNT(b.x)], 1u);
    return b;
}
__device__ __forceinline__ void xcd_barrier_complete(unsigned* bar, unsigned x, unsigned& nloc, unsigned& nx) {
    const unsigned G = gridDim.x * gridDim.y * gridDim.z;
    unsigned sum, cnt, mine, sp = 0u;
    for (;;) {
        sum = 0u; cnt = 0u; mine = 0u;
#pragma unroll
        for (unsigned j = 0; j < 16; ++j) { const unsigned c = xb_ld(&bar[XB_XCNT(j)]); sum += c; cnt += (c > 0u) ? 1u : 0u; mine = (j == x) ? c : mine; }
        if (sum == G) break;
        __builtin_amdgcn_s_sleep(1);
        if ((++sp & 255u) == 0u) { if (xb_ld(&bar[XB_TMO])) break; if (sp > XB_SPIN_CAP) { atomicAdd(&bar[XB_TMO], 1u); break; } }
    }
    nloc = mine > 0u ? mine : 1u; nx = cnt > 0u ? cnt : 1u;
}

__device__ __forceinline__ void xcd_barrier(const XcdBarrier& b) {
    asm volatile("s_waitcnt vmcnt(0)" ::: "memory");
    __syncthreads();
    if (threadIdx.x == 0) {
        unsigned* bar = b.bar;
        __builtin_amdgcn_s_waitcnt(0);
        unsigned nloc = b.st[0], nx = b.st[1];
        if (nloc == 0u) { xcd_barrier_complete(bar, b.x, nloc, nx); b.st[0] = nloc; b.st[1] = nx; }
        const unsigned old = xb_add(&bar[XB_XSUB(b.x)], 1u);
        const unsigned gen = old / nloc;
        if (old + 1u == (gen + 1u) * nloc) {
            __builtin_amdgcn_fence(__ATOMIC_RELEASE, "agent");
            asm volatile("s_waitcnt vmcnt(0)" ::: "memory");
            const unsigned og = xb_add(&bar[XB_TOP], 1u);
            const unsigned tg = og / nx;
            if (og + 1u == (tg + 1u) * nx) xb_add(&bar[XB_TOPGEN], 1u);
            else XB_SPIN(xb_ld(&bar[XB_TOPGEN]) == tg, bar);
            __builtin_amdgcn_fence(__ATOMIC_ACQUIRE, "agent");
            xb_add(&bar[XB_XGEN(b.x)], 1u);
            asm volatile("s_waitcnt vmcnt(0)" ::: "memory");
        } else {
            XB_SPIN(xb_ld(&bar[XB_XGEN(b.x)]) == gen, bar);
            __builtin_amdgcn_fence(__ATOMIC_ACQUIRE, "agent");
            asm volatile("s_waitcnt vmcnt(0)" ::: "memory");
        }
    }
    __syncthreads();
}


template <int PH>
DEVI void run_phase(const Params& p, char* smem, int bid, int nb) {
  if (PH == 0) phase0(p, smem, bid, nb);
  if (PH == 1) phase1(p, smem, bid, nb);
  if (PH == 2) phase2(p, smem, bid, nb);
  if (PH == 3) phase3(p, smem, bid, nb);
  if (PH == 4) phase3b(p, bid, nb);
  if (PH == 5) phaseM(p, smem, bid, nb);
  if (PH == 6) phase3a(p, smem, bid, nb);
  if (PH == 7) phase3c(p, smem, bid, nb);
  if (PH == 8) phase5(p, smem, bid, nb);
  if (PH == 9) phase6x(p, smem, bid, nb);
  if (PH == 10) phase6(p, smem, bid, nb);
  if (PH == 11) phase6b(p, bid, nb);
  if (PH == 12) phase7(p, smem, bid, nb);
  if (PH == 13) phase8(p, bid, nb);
}

#ifndef REP_MASK
#define REP_MASK 0
#endif
template <int PH>
DEVI void mega_phase(const Params& p, char* smem, cg::grid_group& grid, int bid, int nb) {
  run_phase<PH>(p, smem, bid, nb);
  if ((REP_MASK >> PH) & 1) {
    grid.sync();
    run_phase<PH>(p, smem, bid, nb);
  }
}
__global__ void __launch_bounds__(512, 2) mega_kernel(Params pk) {
  const Params& p = *(const Params*)__builtin_amdgcn_kernarg_segment_ptr();
  extern __shared__ __attribute__((aligned(16))) char smem[];
  cg::grid_group grid = cg::this_grid();
  const int bid = blockIdx.x, nb = gridDim.x;
  volatile LAS unsigned* st = (volatile LAS unsigned*)(smem + SMEM_BYTES);
  if (threadIdx.x == 0) {
    st[0] = 0u;
    st[1] = 0u;
  }
  __syncthreads();
  (void)xcd_barrier_post(p.BAR, st);
#define XBAR() do { XcdBarrier xb_; xb_.bar = p.BAR; xb_.x = xb_xcc_id(); xb_.st = (volatile LAS unsigned*)(smem + SMEM_BYTES); xcd_barrier(xb_); } while (0)
  mega_phase<0>(p, smem, grid, bid, nb); grid.sync();
  mega_phase<1>(p, smem, grid, bid, nb); XBAR();
  mega_phase<2>(p, smem, grid, bid, nb); XBAR();
  mega_phase<3>(p, smem, grid, bid, nb); XBAR();
  mega_phase<4>(p, smem, grid, bid, nb); XBAR();
  mega_phase<5>(p, smem, grid, bid, nb); XBAR();
  mega_phase<6>(p, smem, grid, bid, nb); XBAR();
  mega_phase<7>(p, smem, grid, bid, nb); XBAR();
  mega_phase<8>(p, smem, grid, bid, nb); XBAR();
  mega_phase<9>(p, smem, grid, bid, nb); XBAR();
  mega_phase<10>(p, smem, grid, bid, nb); XBAR();
  mega_phase<11>(p, smem, grid, bid, nb); XBAR();
  mega_phase<12>(p, smem, grid, bid, nb); grid.sync();
  mega_phase<13>(p, smem, grid, bid, nb);
}

extern "C" void kernel_launch(void* const* d_in, const int* in_sizes, int n_in, void* d_out, int out_size, void* d_ws,
                              size_t ws_size, hipStream_t stream) {
  Params p{};
  const float** fp = (const float**)&p;
  for (int i = 0; i < 26; ++i) fp[i] = (const float*)d_in[i];
  p.out = (float*)d_out;
  char* w = (char*)d_ws;
  size_t off = 0;
  auto take = [&](size_t bytes) {
    char* r = w + off;
    off += (bytes + 255) & ~(size_t)255;
    return (bfu*)r;
  };
  p.WT_in = take((size_t)3584 * 1024 * 2);
  p.WT_out = take((size_t)1024 * 1024 * 2);
  p.WT_3 = take((size_t)4352 * 1024 * 2);
  p.WT_o = take((size_t)1024 * 1024 * 2);
  p.W2T = take((size_t)1024 * 64 * 2);
  p.A2T = take((size_t)1024 * 64 * 2);
  p.TW = take((size_t)T_TOK * 64 * 2);
  p.TA = take((size_t)T_TOK * 64 * 2);
  const size_t SLOT = (size_t)T_TOK * 1024 * 2;
  bfu* slot0 = take(SLOT);
  bfu* slots = take(6 * SLOT);
  p.H = slot0;
  p.AA = slot0;
  p.U = slots;
  p.GVT = slots + SLOT / 4;
  p.Q = slots + 2 * (SLOT / 4);
  p.K = slots + 3 * (SLOT / 4);
  p.VT = slots + 4 * (SLOT / 4);
  p.SZ = slots + 7 * (SLOT / 4);
  p.Y = slots + 9 * (SLOT / 4);
  p.R = slots;
  p.K1 = slots + 1 * (SLOT / 2);
  p.XV = slots + 2 * (SLOT / 2);
  p.XG = slots + 3 * (SLOT / 2);
  p.XR = slots + 4 * (SLOT / 2);
  p.XK = slots + 5 * (SLOT / 2);
  p.V1 = slots + 4 * (SLOT / 2);
  p.SG = slots + 5 * (SLOT / 2);
  p.EW = slots + 2 * (SLOT / 2);
  p.YS = slots + 3 * (SLOT / 2);
  p.G15 = (float*)p.TW;
  p.GT = p.WT_in;
  p.MRT = take((size_t)(SEQ / 16) * 32 * 512 * 2);
  p.COEF = (float*)take((size_t)T_TOK * 16 * 4);
  p.BAR = (unsigned*)take((size_t)XCD_BAR_WORDS * 4);
  if (off > ws_size) {
    fprintf(stderr, "workspace too small: need %zu have %zu\n", off, ws_size);
    return;
  }
  static int grid_blocks = 0;
  if (!grid_blocks) {
    int dev = 0, cus = 0, per_cu = 0;
    (void)hipGetDevice(&dev);
    (void)hipDeviceGetAttribute(&cus, hipDeviceAttributeMultiprocessorCount, dev);
    (void)hipFuncSetAttribute((const void*)mega_kernel, hipFuncAttributeMaxDynamicSharedMemorySize, SMEM_BYTES + 16);
    (void)hipOccupancyMaxActiveBlocksPerMultiprocessor(&per_cu, mega_kernel, 512, SMEM_BYTES + 16);
    grid_blocks = cus * per_cu;
  }
  (void)hipMemsetAsync(p.BAR, 0, (size_t)XCD_BAR_WORDS * 4, stream);
  void* args[] = {&p};
  hipError_t e = hipLaunchCooperativeKernel((void*)mega_kernel, dim3(grid_blocks), dim3(512), args, SMEM_BYTES + 16, stream);
  if (e != hipSuccess) fprintf(stderr, "cooperative launch failed: %s (grid %d)\n", hipGetErrorString(e), grid_blocks);
}
```

```cpp
#include <hip/hip_runtime.h>
#include <hip/hip_cooperative_groups.h>
#include <stdint.h>
#include <cstdio>
namespace cg = cooperative_groups;

#ifndef MEGA
#define MEGA 1
#endif

typedef unsigned short bfu;
using bf16x8 = __attribute__((ext_vector_type(8))) short;
using f32x4 = __attribute__((ext_vector_type(4))) float;
#define DEVI __device__ __forceinline__
#define TIDX ((int)(threadIdx.x & 255))
#define HF ((int)(threadIdx.x >> 8))

constexpr int GSTAGE_BYTES = 2 * 128 * 72 * 2;
constexpr int T_TOK = 32768;
constexpr int SEQ = 16384;
constexpr int HALF_SMEM = 2 * GSTAGE_BYTES + 4096 + 512;
constexpr int SMEM_BYTES = 2 * HALF_SMEM;
constexpr int SMEM_UNUSED_ = 0;

struct Params {
  const float *x, *ln_even, *w_in, *gm_norm, *gm_ws, *gm_b, *w_out, *ln_odd, *mu, *wr, *wk, *wv, *wg, *w0, *w1, *w2,
      *a0, *a1, *a2, *k_k, *k_a, *r_k, *lnw, *lnb, *wo, *fnorm;
  float* out;
  bfu *WT_in, *WT_out, *WT_3, *WT_o, *W2T, *A2T;
  bfu *H, *U, *GVT, *Q, *K, *VT, *SZ, *Y, *R, *K1, *V1, *SG, *EW, *AA, *YS, *TW, *TA, *GT, *MRT, *XR, *XK, *XV, *XG;
  float *G15, *COEF;
  unsigned* BAR;
};

DEVI float bf2f(unsigned b) { return __uint_as_float(b << 16); }
DEVI unsigned f2bf(float x) {
  const __bf16 h = (__bf16)x;
  return (unsigned)__builtin_bit_cast(unsigned short, h);
}
typedef __bf16 bf16x2_t __attribute__((ext_vector_type(2)));
typedef float float2_t __attribute__((ext_vector_type(2)));
DEVI unsigned pkbf(float a, float b) {
  const float2_t f = {a, b};
  const bf16x2_t h = __builtin_convertvector(f, bf16x2_t);
  return __builtin_bit_cast(unsigned, h);
}
DEVI void unpack8(uint4 v, float* f) {
  f[0] = __uint_as_float(v.x << 16); f[1] = __uint_as_float(v.x & 0xffff0000u);
  f[2] = __uint_as_float(v.y << 16); f[3] = __uint_as_float(v.y & 0xffff0000u);
  f[4] = __uint_as_float(v.z << 16); f[5] = __uint_as_float(v.z & 0xffff0000u);
  f[6] = __uint_as_float(v.w << 16); f[7] = __uint_as_float(v.w & 0xffff0000u);
}
DEVI uint4 pack8(const float* f) {
  uint4 r;
  r.x = pkbf(f[0], f[1]);
  r.y = pkbf(f[2], f[3]);
  r.z = pkbf(f[4], f[5]);
  r.w = pkbf(f[6], f[7]);
  return r;
}
DEVI void unpack4(uint2 v, float* f) {
  f[0] = __uint_as_float(v.x << 16); f[1] = __uint_as_float(v.x & 0xffff0000u);
  f[2] = __uint_as_float(v.y << 16); f[3] = __uint_as_float(v.y & 0xffff0000u);
}
DEVI uint2 pack4(const float* f) {
  uint2 r;
  r.x = pkbf(f[0], f[1]);
  r.y = pkbf(f[2], f[3]);
  return r;
}

DEVI float sigmoid_(float x) { return __builtin_amdgcn_rcpf(1.f + __expf(-x)); }
DEVI float silu_(float x) { return x * sigmoid_(x); }
DEVI float tanh_(float y) { return 1.f - 2.f * __builtin_amdgcn_rcpf(1.f + __expf(2.f * y)); }
DEVI float gelu_(float x) {
  const float y = 0.7978845608028654f * (x + 0.044715f * x * x * x);
  return x * __builtin_amdgcn_rcpf(1.f + __expf(-2.f * y));
}
DEVI float wave_sum(float v) {
#pragma unroll
  for (int o = 32; o > 0; o >>= 1) v += __shfl_xor(v, o);
  return v;
}
DEVI float wave_max(float v) {
#pragma unroll
  for (int o = 32; o > 0; o >>= 1) v = fmaxf(v, __shfl_xor(v, o));
  return v;
}
template <int CTRL>
DEVI float dppf(float x) {
  return __int_as_float(__builtin_amdgcn_update_dpp(0, __float_as_int(x), CTRL, 0xF, 0xF, true));
}
DEVI float reduce16(float x) {
  x += dppf<0xB1>(x);
  x += dppf<0x4E>(x);
  x += dppf<0x141>(x);
  x += dppf<0x140>(x);
  return x;
}

constexpr int LROW = 72;
constexpr int GSTAGE = 2 * 128 * LROW;

template <int DIST = 2, bool SW = true, class ALoad, class Epi>
DEVI void gemm_tile(char* smem, const ALoad& aload, const bfu* __restrict__ Bt, int ldb, int K, int m0, int n0,
                    const Epi& epi) {
  bfu* sbase = (bfu*)smem;
  const int tid = TIDX, lane = tid & 63, wid = tid >> 6, wr = wid >> 1, wc = wid & 1;
  const int fr = lane & 15, fq = lane >> 4;
  f32x4 acc[4][4];
#pragma unroll
  for (int i = 0; i < 4; ++i)
#pragma unroll
    for (int j = 0; j < 4; ++j) acc[i][j] = f32x4{0.f, 0.f, 0.f, 0.f};
  const int r0 = tid >> 3, kc = (tid & 7) * 8;
  const int nk = K >> 6;
  struct GRegs { typename ALoad::Raw a0, a1, a2, a3; uint4 ap, b0, b1, b2, b3; };
  GRegs g0, g1;
  const bfu* Bp = Bt + (size_t)(n0 + r0) * ldb + kc;
  const size_t ldb32 = (size_t)ldb * 32;
  constexpr int ARS = ALoad::kConsec ? 1 : 32;
  const int ar0 = ALoad::kConsec ? 4 * r0 : r0;
#define GEMM_ISSUE(R, KT)                                   \
  {                                                         \
    const int k0_ = ((KT) << 6);                            \
    R.ap = aload.loadprev(m0 + ar0, k0_ + kc);              \
    R.a0 = aload.load(m0 + ar0, k0_ + kc);                  \
    R.a1 = aload.load(m0 + ar0 + ARS, k0_ + kc);            \
    R.a2 = aload.load(m0 + ar0 + 2 * ARS, k0_ + kc);        \
    R.a3 = aload.load(m0 + ar0 + 3 * ARS, k0_ + kc);        \
    R.b0 = *(const uint4*)(Bp + k0_);                       \
    R.b1 = *(const uint4*)(Bp + ldb32 + k0_);               \
    R.b2 = *(const uint4*)(Bp + 2 * ldb32 + k0_);           \
    R.b3 = *(const uint4*)(Bp + 3 * ldb32 + k0_);           \
  }
#define GEMM_COMMIT(R, S, KT)                               \
  {                                                         \
    const int k1_ = ((KT) << 6) + kc;                       \
    bfu* A_ = sbase + (S) * GSTAGE + ar0 * LROW + kc;       \
    bfu* B_ = sbase + (S) * GSTAGE + 128 * LROW + r0 * LROW + kc;   \
    *(uint4*)(A_) = aload.finish(R.a0, R.ap, m0 + ar0, k1_);                                 \
    *(uint4*)(A_ + ARS * LROW) = aload.finish(R.a1, aload.asprev(R.a0), m0 + ar0 + ARS, k1_);          \
    *(uint4*)(A_ + 2 * ARS * LROW) = aload.finish(R.a2, aload.asprev(R.a1), m0 + ar0 + 2 * ARS, k1_);  \
    *(uint4*)(A_ + 3 * ARS * LROW) = aload.finish(R.a3, aload.asprev(R.a2), m0 + ar0 + 3 * ARS, k1_);  \
    *(uint4*)(B_) = R.b0;                                   \
    *(uint4*)(B_ + 32 * LROW) = R.b1;                       \
    *(uint4*)(B_ + 64 * LROW) = R.b2;                       \
    *(uint4*)(B_ + 96 * LROW) = R.b3;                       \
  }
#define GEMM_COMPUTE(S)                                                                          \
  {                                                                                              \
    const bfu* cA = sbase + (S) * GSTAGE;                                                        \
    const bfu* cB = cA + 128 * LROW;                                                             \
    _Pragma("unroll") for (int ks = 0; ks < 2; ++ks) {                                           \
      bf16x8 af[4], bfv[4];                                                                      \
      _Pragma("unroll") for (int i = 0; i < 4; ++i) {                                            \
        af[i] = *(const bf16x8*)(cA + (wr * 64 + i * 16 + fr) * LROW + ks * 32 + fq * 8);        \
        bfv[i] = *(const bf16x8*)(cB + (wc * 64 + i * 16 + fr) * LROW + ks * 32 + fq * 8);       \
      }                                                                                          \
      _Pragma("unroll") for (int i = 0; i < 4; ++i) _Pragma("unroll") for (int j = 0; j < 4; ++j) \
          acc[i][j] = SW ? __builtin_amdgcn_mfma_f32_16x16x32_bf16(bfv[j], af[i], acc[i][j], 0, 0, 0)     \
                         : __builtin_amdgcn_mfma_f32_16x16x32_bf16(af[i], bfv[j], acc[i][j], 0, 0, 0);    \
    }                                                                                            \
  }
  const int nkm1 = nk - 1;
  if (DIST == 2) {
    GEMM_ISSUE(g0, 0);
    GEMM_ISSUE(g1, (1 < nkm1 ? 1 : nkm1));
    GEMM_COMMIT(g0, 0, 0);
    GEMM_ISSUE(g0, (2 < nkm1 ? 2 : nkm1));
    __syncthreads();
    if (nk == 1) {
      GEMM_COMPUTE(0);
      __syncthreads();
    } else {
      for (int kt = 0; kt < nk; kt += 2) {
        GEMM_COMMIT(g1, 1, (kt + 1 < nkm1 ? kt + 1 : nkm1));
        GEMM_ISSUE(g1, (kt + 3 < nkm1 ? kt + 3 : nkm1));
        GEMM_COMPUTE(0);
        __syncthreads();
        GEMM_COMMIT(g0, 0, (kt + 2 < nkm1 ? kt + 2 : nkm1));
        GEMM_ISSUE(g0, (kt + 4 < nkm1 ? kt + 4 : nkm1));
        GEMM_COMPUTE(1);
        __syncthreads();
      }
    }
  } else {
    GEMM_ISSUE(g0, 0);
    GEMM_COMMIT(g0, 0, 0);
    GEMM_ISSUE(g0, (1 < nkm1 ? 1 : nkm1));
    __syncthreads();
    for (int kt = 0; kt < nk; kt += 2) {
      GEMM_COMMIT(g0, 1, (kt + 1 < nkm1 ? kt + 1 : nkm1));
      GEMM_ISSUE(g0, (kt + 2 < nkm1 ? kt + 2 : nkm1));
      GEMM_COMPUTE(0);
      __syncthreads();
      GEMM_COMMIT(g0, 0, (kt + 2 < nkm1 ? kt + 2 : nkm1));
      GEMM_ISSUE(g0, (kt + 3 < nkm1 ? kt + 3 : nkm1));
      GEMM_COMPUTE(1);
      __syncthreads();
    }
  }
#pragma unroll
  for (int i = 0; i < 4; ++i)
#pragma unroll
    for (int j = 0; j < 4; ++j) {
      if (SW) epi(m0 + wr * 64 + i * 16 + fr, n0 + wc * 64 + j * 16 + fq * 4, acc[i][j]);
      else epi(m0 + wr * 64 + i * 16 + fq * 4, n0 + wc * 64 + j * 16 + fr, acc[i][j]);
    }
}

namespace pg8 {
#define PG8_LAS __attribute__((address_space(3)))
typedef unsigned short bf16_t;
typedef short bf16x8 __attribute__((ext_vector_type(8)));
typedef float f32x4 __attribute__((ext_vector_type(4)));
typedef unsigned u32x4 __attribute__((ext_vector_type(4)));
constexpr int BM = 256, BK = 64, HALF = 128, HTB = HALF * BK * 2  , STAGE_BYTES = 8 * HTB, NXCD = 8, WGM = 8;

__host__ __device__ __forceinline__ int lds_byte(int r, int c) { const int st = (r >> 4) * 2 + (c >> 5), rr = r & 15, cc = c & 31, ob = rr * 64 + cc * 2; return st * 1024 + (ob ^ (((ob >> 9) & 1) << 5)); }
__host__ __device__ __forceinline__ void stage_rc(int b, int& R, int& C) { const int st = b / 1024, sb = b % 1024, swz = sb ^ (((sb >> 9) & 1) << 5); R = (st >> 1) * 16 + swz / 64; C = (st & 1) * 32 + (swz % 64) / 2; }
__host__ __device__ __forceinline__ int perm32(int rho) { const int n = rho >> 4, i = rho & 15; return 8 * (i >> 2) + 4 * n + (i & 3); }

struct Unit { int pm, pn; };
struct Gemm { const bf16_t* A; const bf16_t* Bt; int M, N, K; const bf16_t* A2; int pn_split; unsigned long long rmap, cmap;
  __device__ __forceinline__ size_t rt(int pm) const { return rmap ? (size_t)((rmap >> (4 * pm)) & 15ull) : (size_t)pm; }
  __device__ __forceinline__ size_t ct(int pn) const { return cmap ? (size_t)((cmap >> (4 * pn)) & 15ull) : (size_t)pn; } };

struct StaticOrder {
    int nM, nN, nwg, G, c;
    __host__ __device__ void init(int M, int N, int G_, int c_) { nM = M / BM; nN = N / BM; nwg = nM * nN; G = G_; c = c_; }
    __host__ __device__ bool next(int i, Unit& u) const {
        const long L = (long)i * G + c; if (L >= nwg) return false;
        int wgid = (int)L; { const int q = nwg / NXCD, r = nwg % NXCD, xcd = wgid % NXCD, off = wgid / NXCD; wgid = (xcd < r ? xcd * (q + 1) : r * (q + 1) + (xcd - r) * q) + off; }
        const int nig = WGM * nN, gid = wgid / nig, fm = gid * WGM, gsz = (nM - fm) < WGM ? (nM - fm) : WGM;
        u.pm = fm + ((wgid % nig) % gsz); u.pn = (wgid % nig) / gsz; return true;
    }
    __device__ __forceinline__ void a_ready(const Unit&) const {}
    __device__ __forceinline__ void done(const Unit&) const {}
};
struct CountedOrder : StaticOrder {
    const unsigned* ready; unsigned need; unsigned* tmo;
    __device__ __forceinline__ void a_ready(const Unit& u) const {
        if (threadIdx.x < 64) {
            const unsigned long long t0 = __builtin_amdgcn_s_memrealtime(); unsigned polls = 0;
            while ((unsigned)__builtin_amdgcn_readfirstlane(__hip_atomic_load(ready + 64 * u.pm, __ATOMIC_RELAXED, __HIP_MEMORY_SCOPE_AGENT)) < need) {
                if ((++polls & 255u) == 0u && __builtin_amdgcn_readfirstlane(__hip_atomic_load(tmo, __ATOMIC_RELAXED, __HIP_MEMORY_SCOPE_AGENT)) != 0u) break;
                if (__builtin_amdgcn_s_memrealtime() - t0 > 2000000ull) {
                    if (threadIdx.x == 0) { unsigned expect = 0u; __hip_atomic_compare_exchange_strong(tmo + 1, &expect, 0x600u | (unsigned)(u.pm & 0xff), __ATOMIC_RELAXED, __ATOMIC_RELAXED, __HIP_MEMORY_SCOPE_AGENT); __hip_atomic_store(tmo, 1u, __ATOMIC_RELAXED, __HIP_MEMORY_SCOPE_AGENT); }
                    break; }
                __builtin_amdgcn_s_sleep(2); }
            __builtin_amdgcn_fence(__ATOMIC_ACQUIRE, "agent");
            asm volatile("s_waitcnt vmcnt(0)" ::: "memory");
        }
#if !defined(BROKEN_HOOK_NO_BARRIER)
        asm volatile("" ::: "memory"); __builtin_amdgcn_s_barrier(); asm volatile("" ::: "memory");
#endif
    }
};

__device__ __forceinline__ unsigned cvt_pk_bf16(float lo, float hi) { unsigned r; asm volatile("v_cvt_pk_bf16_f32 %0, %1, %2" : "=v"(r) : "v"(lo), "v"(hi)); return r; }
typedef float f32x2 __attribute__((ext_vector_type(2)));
__device__ __forceinline__ f32x2 gelu_pk(f32x2 v) {
    const f32x2 av = __builtin_elementwise_abs(v), d = av * 0.2316418882f + 1.0f;
    f32x2 t; t.x = __builtin_amdgcn_rcpf(d.x); t.y = __builtin_amdgcn_rcpf(d.y);
    f32x2 q = t * 0.5307027145f + (-0.7265760135f); q = q * t + 0.7107068705f; q = q * t + (-0.142248368f); q = q * t + 0.127414796f; q = q * t;
    const f32x2 s = (v * v) * (-0.72134752044f);
    f32x2 e; e.x = __builtin_amdgcn_exp2f(s.x); e.y = __builtin_amdgcn_exp2f(s.y);
    const f32x2 m = v * (q * e), r = v - m;
    f32x2 o; o.x = v.x < 0.f ? m.x : r.x; o.y = v.y < 0.f ? m.y : r.y; return o;
}

struct EpiF32 {
    static constexpr bool PERM = false, AFTER_DRAIN = false;
    float* C; int ldc; const float* bias;
    __device__ __forceinline__ void operator()(const f32x4 (&acc)[2][2][4][2], const Unit& u, int wr, int wc, int fr, int fq) const {
        const int row0 = u.pm * BM + wr * 64 + fr, col0 = u.pn * BM + wc * 32 + 4 * fq;
        f32x4 bv[2][2];
#pragma unroll
        for (int bj = 0; bj < 2; ++bj)
#pragma unroll
            for (int n = 0; n < 2; ++n) bv[bj][n] = bias ? *(const f32x4*)(bias + col0 + bj * HALF + n * 16) : (f32x4){0.f, 0.f, 0.f, 0.f};
#pragma unroll
        for (int ai = 0; ai < 2; ++ai)
#pragma unroll
            for (int m = 0; m < 4; ++m) { float* rowp = C + (size_t)(row0 + ai * HALF + m * 16) * ldc + col0;
#pragma unroll
                for (int bj = 0; bj < 2; ++bj)
#pragma unroll
                    for (int n = 0; n < 2; ++n) *(f32x4*)(rowp + bj * HALF + n * 16) = acc[ai][bj][m][n] + bv[bj][n]; }
    }
};
template <int ACT  > struct EpiBf16 {
    static constexpr bool PERM = true, AFTER_DRAIN = false;
    bf16_t* O; int ldc; const float* bias; int split_cols; size_t split_stride;
    __device__ __forceinline__ void operator()(const f32x4 (&acc)[2][2][4][2], const Unit& u, int wr, int wc, int fr, int fq) const {
        const int row0 = u.pm * BM + wr * 64 + fr; int colt = u.pn * BM; bf16_t* base = O;
        if (split_cols) { const int t = colt / split_cols; base += (size_t)t * split_stride; colt -= t * split_cols; }
        const int col0 = colt + wc * 32 + 8 * fq, bcol0 = u.pn * BM + wc * 32 + 8 * fq;
        f32x4 bv[2][2];
#pragma unroll
        for (int bj = 0; bj < 2; ++bj)
#pragma unroll
            for (int n = 0; n < 2; ++n) bv[bj][n] = bias ? *(const f32x4*)(bias + bcol0 + bj * HALF + 4 * n) : (f32x4){0.f, 0.f, 0.f, 0.f};
#pragma unroll
        for (int ai = 0; ai < 2; ++ai)
#pragma unroll
            for (int m = 0; m < 4; ++m) { bf16_t* rowp = base + (size_t)(row0 + ai * HALF + m * 16) * ldc + col0;
#pragma unroll
                for (int bj = 0; bj < 2; ++bj) { f32x4 v0 = acc[ai][bj][m][0] + bv[bj][0], v1 = acc[ai][bj][m][1] + bv[bj][1];
                    if (ACT == 1) { f32x2 a = gelu_pk((f32x2){v0[0], v0[1]}), b = gelu_pk((f32x2){v0[2], v0[3]}), c = gelu_pk((f32x2){v1[0], v1[1]}), d = gelu_pk((f32x2){v1[2], v1[3]});
                        v0 = (f32x4){a.x, a.y, b.x, b.y}; v1 = (f32x4){c.x, c.y, d.x, d.y}; }
                    if (ACT == 2) {
#pragma unroll
                        for (int j = 0; j < 4; ++j) { v0[j] = 0.5f * v0[j] * (1.0f + erff(v0[j] * 0.70710678f)); v1[j] = 0.5f * v1[j] * (1.0f + erff(v1[j] * 0.70710678f)); } }
                    u32x4 w; w.x = cvt_pk_bf16(v0[0], v0[1]); w.y = cvt_pk_bf16(v0[2], v0[3]); w.z = cvt_pk_bf16(v1[0], v1[1]); w.w = cvt_pk_bf16(v1[2], v1[3]);
                    *(u32x4*)(rowp + bj * HALF) = w; } }
    }
};


template <class Epi, class Sched, bool STAMP = false>
__device__ __forceinline__ void gemm_phase(PG8_LAS unsigned char* lds, const Gemm g, const Sched& S, const Epi& E, unsigned long long* stamps) {
    const int tid = threadIdx.x, wid = __builtin_amdgcn_readfirstlane(tid >> 6), lane = tid & 63, wr = wid >> 2, wc = wid & 3, fr = lane & 15, fq = lane >> 4;
    const int K = g.K, nt = K / BK;
    int ts_lo = 0, ts_hi = 0, nts = 0; const unsigned long long rt_entry = STAMP ? (unsigned long long)wall_clock64() : 0ull;
#define PG8_STAMP() do { if (STAMP && wid == 0 && nts < 64) { const unsigned long long _c = (unsigned long long)clock64(); \
        ts_lo = (lane == nts) ? (int)(unsigned)_c : ts_lo; ts_hi = (lane == nts) ? (int)(unsigned)(_c >> 32) : ts_hi; ++nts; } } while (0)
    PG8_STAMP();
    unsigned voffA[2], voffB[2];
#pragma unroll
    for (int i = 0; i < 2; ++i) { int R, C; stage_rc(tid * 16 + i * 8192, R, C); const int Rb = Epi::PERM ? ((R & ~31) + perm32(R & 31)) : R;
        voffA[i] = (unsigned)(R * K + C) * 2u; voffB[i] = (unsigned)(Rb * K + C) * 2u; }
    const size_t kstep = (size_t)(BK * 2);
    const size_t hstep = (size_t)HALF * K * 2;
    const size_t tstep = 2 * hstep;
    const unsigned ldsw = (unsigned)wid * 1024u;
    const int aoff = lds_byte(wr * 64 + fr, fq * 8), boff = lds_byte(wc * 32 + fr, fq * 8);
#define PG8_SA(b, h) (((b) * 2 + (h)) * HTB)
#define PG8_SB(b, h) ((4 + (b) * 2 + (h)) * HTB)
#define PG8_STAGE(bufoff, gbase, voff) do { _Pragma("unroll") for (int _i = 0; _i < 2; ++_i) \
        __builtin_amdgcn_global_load_lds((const unsigned*)((const char*)(gbase) + (voff)[_i]), (PG8_LAS unsigned*)(lds + (bufoff) + ldsw + _i * 8192), 16, 0, 0); } while (0)
#define PG8_LDA(dst, b, h) do { _Pragma("unroll") for (int m = 0; m < 4; ++m) _Pragma("unroll") for (int k = 0; k < 2; ++k) dst[m][k] = *(const PG8_LAS bf16x8*)(lds + PG8_SA(b, h) + aoff + m * 2048 + k * 1024); } while (0)
#define PG8_LDB(dst, b, h) do { _Pragma("unroll") for (int n = 0; n < 2; ++n) _Pragma("unroll") for (int k = 0; k < 2; ++k) dst[n][k] = *(const PG8_LAS bf16x8*)(lds + PG8_SB(b, h) + boff + n * 2048 + k * 1024); } while (0)
#define PG8_MMA(ai, bj, At, Bt) do { __builtin_amdgcn_s_setprio(1); _Pragma("unroll") for (int m = 0; m < 4; ++m) _Pragma("unroll") for (int n = 0; n < 2; ++n) _Pragma("unroll") for (int k = 0; k < 2; ++k) \
        acc[ai][bj][m][n] = __builtin_amdgcn_mfma_f32_16x16x32_bf16(Bt[n][k], At[m][k], acc[ai][bj][m][n], 0, 0, 0); __builtin_amdgcn_s_setprio(0); } while (0)
#define PG8_WAIT_V(n) asm volatile("s_waitcnt vmcnt(" #n ")" ::: "memory")
#define PG8_WAIT_L(n) asm volatile("s_waitcnt lgkmcnt(" #n ")" ::: "memory")
#define PG8_BAR __builtin_amdgcn_s_barrier()
#define PG8_SCHED __builtin_amdgcn_sched_barrier(0)
    Unit cur, nxt; int ui = 0;
    if (!S.next(0, cur)) return;
    f32x4 acc[2][2][4][2];
#pragma unroll
    for (int a = 0; a < 2; ++a)
#pragma unroll
        for (int b = 0; b < 2; ++b)
#pragma unroll
            for (int m = 0; m < 4; ++m)
#pragma unroll
                for (int n = 0; n < 2; ++n) acc[a][b][m][n] = (f32x4){0.f, 0.f, 0.f, 0.f};
    bf16x8 At[4][2], B0[2][2], B1[2][2];
    const char* cA = (const char*)(cur.pn >= g.pn_split ? g.A2 : g.A) + g.rt(cur.pm) * tstep; const char* cB = (const char*)g.Bt + g.ct(cur.pn) * tstep;
    S.a_ready(cur);
    PG8_STAGE(PG8_SB(0, 0), cB, voffB); PG8_STAGE(PG8_SA(0, 0), cA, voffA); PG8_STAGE(PG8_SB(0, 1), cB + hstep, voffB); PG8_STAGE(PG8_SA(0, 1), cA + hstep, voffA);
    if (wr == 1) PG8_BAR;
    PG8_WAIT_V(4); PG8_BAR;
    PG8_STAGE(PG8_SB(1, 0), cB + kstep, voffB); PG8_STAGE(PG8_SA(1, 0), cA + kstep, voffA); PG8_STAGE(PG8_SB(1, 1), cB + hstep + kstep, voffB);
    PG8_WAIT_V(6); PG8_BAR;
    PG8_STAMP();
    for (;;) {
        const bool has_next = S.next(ui + 1, nxt);
        const char* nA = has_next ? (const char*)(nxt.pn >= g.pn_split ? g.A2 : g.A) + g.rt(nxt.pm) * tstep : cA; const char* nB = has_next ? (const char*)g.Bt + g.ct(nxt.pn) * tstep : cB;
        for (int t = 0; t < nt; t += 2) {
            const bool last = (t == nt - 2);
            const char* a1 = cA + (size_t)(t + 1) * kstep;
            const char* a2 = last ? nA : cA + (size_t)(t + 2) * kstep; const char* b2 = last ? nB : cB + (size_t)(t + 2) * kstep;
            const char* a3 = a2 + kstep; const char* b3 = b2 + kstep;
            if (last && has_next) S.a_ready(nxt);
            PG8_LDB(B0, 0, 0); PG8_SCHED; PG8_LDA(At, 0, 0); PG8_STAGE(PG8_SA(1, 1), a1 + hstep, voffA);
            PG8_WAIT_L(8); PG8_BAR; PG8_WAIT_L(0); PG8_MMA(0, 0, At, B0); PG8_BAR; PG8_SCHED;
            PG8_LDB(B1, 0, 1); PG8_STAGE(PG8_SB(0, 0), b2, voffB);
            PG8_BAR; PG8_WAIT_L(0); PG8_MMA(0, 1, At, B1); PG8_BAR;
            PG8_LDA(At, 0, 1); PG8_STAGE(PG8_SA(0, 0), a2, voffA);
            PG8_BAR; PG8_WAIT_L(0); PG8_MMA(1, 0, At, B0); PG8_BAR; PG8_SCHED;
            PG8_STAGE(PG8_SB(0, 1), b2 + hstep, voffB);
            PG8_WAIT_V(6); PG8_BAR; PG8_MMA(1, 1, At, B1); PG8_BAR;
            PG8_LDB(B0, 1, 0); PG8_SCHED; PG8_LDA(At, 1, 0); PG8_STAGE(PG8_SA(0, 1), a2 + hstep, voffA);
            PG8_WAIT_L(8); PG8_BAR; PG8_WAIT_L(0); PG8_MMA(0, 0, At, B0); PG8_BAR; PG8_SCHED;
            PG8_LDB(B1, 1, 1); PG8_STAGE(PG8_SB(1, 0), b3, voffB);
            PG8_BAR; PG8_WAIT_L(0); PG8_MMA(0, 1, At, B1); PG8_BAR;
            PG8_LDA(At, 1, 1); PG8_STAGE(PG8_SA(1, 0), a3, voffA);
            PG8_BAR; PG8_WAIT_L(0); PG8_MMA(1, 0, At, B0); PG8_BAR; PG8_SCHED;
            PG8_STAGE(PG8_SB(1, 1), b3 + hstep, voffB);
            PG8_WAIT_V(6); PG8_BAR; PG8_MMA(1, 1, At, B1); PG8_BAR;
        }
        PG8_STAMP();
        if constexpr (!Epi::AFTER_DRAIN) { E(acc, cur, wr, wc, fr, fq); S.done(cur); }
        PG8_STAMP();
        if (!has_next) break;
#pragma unroll
        for (int a = 0; a < 2; ++a)
#pragma unroll
            for (int b = 0; b < 2; ++b)
#pragma unroll
                for (int m = 0; m < 4; ++m)
#pragma unroll
                    for (int n = 0; n < 2; ++n) acc[a][b][m][n] = (f32x4){0.f, 0.f, 0.f, 0.f};
        cur = nxt; cA = nA; cB = nB; ++ui;
    }
    PG8_WAIT_V(0);
    if (wr == 0) PG8_BAR;
    PG8_BAR;
    if constexpr (Epi::AFTER_DRAIN) { E.fused(acc, cur, wr, wc, fr, fq, lds, wid, lane); S.done(cur); }
    PG8_STAMP();
    if (STAMP && wid == 0) { stamps[lane] = lane < nts ? (((unsigned long long)(unsigned)ts_hi << 32) | (unsigned)ts_lo) : 0ull;
        if (lane == 62) stamps[62] = rt_entry; if (lane == 63) stamps[63] = (unsigned long long)wall_clock64(); }
#undef PG8_STAMP
#undef PG8_SA
#undef PG8_SB
#undef PG8_STAGE
#undef PG8_LDA
#undef PG8_LDB
#undef PG8_MMA
#undef PG8_WAIT_V
#undef PG8_WAIT_L
#undef PG8_BAR
#undef PG8_SCHED
}
}

struct TileSched {
  int xcd, local, vbid, vnb, MT, NT, SM, SN, j, snc;
  bool swz;
  DEVI TileSched(int bid, int nb, int half, int MT_, int NT_, int SM_, int SN_) : MT(MT_), NT(NT_), SM(SM_), SN(SN_), j(0) {
    xcd = bid & 7;
    local = (bid >> 3) * 2 + half;
    vbid = bid * 2 + half;
    vnb = nb * 2;
    swz = (vnb == 8 * SM * SN) && ((nb & 7) == 0);
    snc = (NT + SN - 1) / SN;
  }
  DEVI int next(int& mt, int& nt) {
    if (swz) {
      const int s = j * 8 + xcd;
      ++j;
      const int sm = s / snc, sn = s - sm * snc;
      if (sm * SM >= MT) return 0;
      mt = sm * SM + local / SN;
      nt = sn * SN + local % SN;
      return (mt < MT && nt < NT) ? 1 : 2;
    } else {
      const int it = vbid + j * vnb;
      ++j;
      if (it >= MT * NT) return 0;
      mt = it / NT;
      nt = it - mt * NT;
      return 1;
    }
  }
};

struct ALoadPlain {
  typedef uint4 Raw;
  static constexpr bool kFat = false;
  static constexpr bool kConsec = false;
  const bfu* A;
  int lda;
  DEVI Raw load(int row, int k) const { return *(const uint4*)(A + (size_t)row * lda + k); }
  DEVI uint4 loadprev(int, int) const { return uint4{0u, 0u, 0u, 0u}; }
  DEVI uint4 asprev(const Raw&) const { return uint4{0u, 0u, 0u, 0u}; }
  DEVI uint4 finish(const Raw& r, const uint4&, int, int) const { return r; }
};

DEVI void transpose_tile(char* smem, const float* __restrict__ src, int Ns, bfu* __restrict__ dst, int ldd, int noff,
                         int k0, int n0) {
  float(*tile)[65] = (float(*)[65])smem;
  const int tid = TIDX;
  const int kr = tid >> 4, nc = (tid & 15) * 4;
#pragma unroll
  for (int p = 0; p < 4; ++p) {
    float4 v = *(const float4*)(src + (size_t)(k0 + kr + 16 * p) * Ns + n0 + nc);
    tile[kr + 16 * p][nc] = v.x;
    tile[kr + 16 * p][nc + 1] = v.y;
    tile[kr + 16 * p][nc + 2] = v.z;
    tile[kr + 16 * p][nc + 3] = v.w;
  }
  __syncthreads();
  const int nr = tid >> 3, kc = (tid & 7) * 8;
#pragma unroll
  for (int p = 0; p < 2; ++p) {
    const int n = nr + 32 * p;
    float f[8];
#pragma unroll
    for (int j = 0; j < 8; ++j) f[j] = tile[kc + j][n];
    *(uint4*)(dst + (size_t)(noff + n0 + n) * ldd + k0 + kc) = pack8(f);
  }
  __syncthreads();
}

DEVI void rms_row2_bf16(const float* __restrict__ src, const float* __restrict__ g, bfu* __restrict__ dst, int lane) {
  float4 v[2][4];
  float ss[2] = {0.f, 0.f};
#pragma unroll
  for (int r = 0; r < 2; ++r)
#pragma unroll
    for (int i = 0; i < 4; ++i) v[r][i] = *(const float4*)(src + r * 1024 + lane * 4 + 256 * i);
#pragma unroll
  for (int r = 0; r < 2; ++r)
#pragma unroll
    for (int i = 0; i < 4; ++i)
      ss[r] += v[r][i].x * v[r][i].x + v[r][i].y * v[r][i].y + v[r][i].z * v[r][i].z + v[r][i].w * v[r][i].w;
#pragma unroll
  for (int r = 0; r < 2; ++r) {
    const float rinv = rsqrtf(wave_sum(ss[r]) * (1.f / 1024.f) + 1e-6f);
#pragma unroll
    for (int i = 0; i < 4; ++i) {
      const float4 gg = *(const float4*)(g + lane * 4 + 256 * i);
      uint2 o;
      o.x = pkbf(v[r][i].x * rinv * gg.x, v[r][i].y * rinv * gg.y);
      o.y = pkbf(v[r][i].z * rinv * gg.z, v[r][i].w * rinv * gg.w);
      *(uint2*)(dst + r * 1024 + lane * 4 + 256 * i) = o;
    }
  }
}

DEVI void phase0(const Params& p, char* smem, int bid, int nb) {
  constexpr int NT_IN = 16 * 56, NT_SQ = 256, NT_SM = 16;
  constexpr int c0 = NT_IN, c1 = c0 + NT_SQ, c2 = c1 + 4 * NT_SQ, c3 = c2 + NT_SM, c4 = c3 + NT_SM, c5 = c4 + NT_SQ,
                c6 = c5 + NT_SM, c7 = c6 + NT_SM, c8 = c7 + 2, c9 = c8 + T_TOK / 8;
  smem += HF * HALF_SMEM;
  for (int it = bid * 2 + HF; it < c9; it += nb * 2) {
    if (it < c0) {
      transpose_tile(smem, p.w_in, 3584, p.WT_in, 1024, 0, (it / 56) * 64, (it % 56) * 64);
    } else if (it < c1) {
      int j = it - c0;
      transpose_tile(smem, p.w_out, 1024, p.WT_out, 1024, 0, (j >> 4) * 64, (j & 15) * 64);
    } else if (it < c2) {
      int j = it - c1;
      int w = j >> 8;
      j &= 255;
      const float* src = (w == 0) ? p.wr : (w == 1) ? p.wk : (w == 2) ? p.wv : p.wg;
      transpose_tile(smem, src, 1024, p.WT_3, 1024, w * 1024, (j >> 4) * 64, (j & 15) * 64);
    } else if (it < c3) {
      int j = it - c2;
      transpose_tile(smem, p.w1, 64, p.WT_3, 1024, 4096, j * 64, 0);
    } else if (it < c4) {
      int j = it - c3;
      transpose_tile(smem, p.a1, 64, p.WT_3, 1024, 4224, j * 64, 0);
    } else if (it < c5) {
      int j = it - c4;
      transpose_tile(smem, p.wo, 1024, p.WT_o, 1024, 0, (j >> 4) * 64, (j & 15) * 64);
    } else if (it < c6) {
      int j = it - c5;
      transpose_tile(smem, p.w2, 1024, p.W2T, 64, 0, 0, j * 64);
    } else if (it < c7) {
      int j = it - c6;
      transpose_tile(smem, p.a2, 1024, p.A2T, 64, 0, 0, j * 64);
    } else if (it < c8) {
      int j = it - c7;
      bfu* dst = p.WT_3 + (size_t)(j == 0 ? 4160 : 4288) * 1024;
      for (int e = TIDX; e < 64 * 1024 / 8; e += 256) *(uint4*)(dst + e * 8) = uint4{0, 0, 0, 0};
    } else {
      int row = (it - c8) * 8 + (TIDX >> 6) * 2;
      rms_row2_bf16(p.x + (size_t)row * 1024, p.ln_even, p.H + (size_t)row * 1024, TIDX & 63);
    }
  }
}

constexpr unsigned long long kCmap1 = 0xDCBA765410ull;
struct PgEpi1 {
  static constexpr bool PERM = true, AFTER_DRAIN = false;
  const Params* p;
  DEVI void operator()(const pg8::f32x4 (&acc)[2][2][4][2], const pg8::Unit& u, int wr, int wc, int fr, int fq) const {
    const int row0 = u.pm * 256 + wr * 64 + fr;
    const int seg = (int)((kCmap1 >> (4 * u.pn)) & 15ull);
#pragma unroll
    for (int ai = 0; ai < 2; ++ai)
#pragma unroll
      for (int m = 0; m < 4; ++m) {
        const int row = row0 + ai * 128 + m * 16;
#pragma unroll
        for (int bj = 0; bj < 2; ++bj) {
          const int col = seg * 256 + bj * 128 + wc * 32 + 8 * fq;
          const f32x4 v0 = acc[ai][bj][m][0], v1 = acc[ai][bj][m][1];
          uint4 w;
          if (seg < 2) {
            w.x = pkbf(gelu_(v0[0]), gelu_(v0[1])); w.y = pkbf(gelu_(v0[2]), gelu_(v0[3]));
            w.z = pkbf(gelu_(v1[0]), gelu_(v1[1])); w.w = pkbf(gelu_(v1[2]), gelu_(v1[3]));
            *(uint4*)(p->U + (size_t)row * 512 + col) = w;
          } else if (seg < 8) {
            w.x = pkbf(v0[0], v0[1]); w.y = pkbf(v0[2], v0[3]); w.z = pkbf(v1[0], v1[1]); w.w = pkbf(v1[2], v1[3]);
            bfu* dst = (seg < 6) ? p->Q + (size_t)row * 512 + (col - 1024) : p->K + (size_t)row * 512 + (col - 1536);
            *(uint4*)dst = w;
          } else {
            w.x = pkbf(silu_(v0[0]), silu_(v0[1])); w.y = pkbf(silu_(v0[2]), silu_(v0[3]));
            w.z = pkbf(silu_(v1[0]), silu_(v1[1])); w.w = pkbf(silu_(v1[2]), silu_(v1[3]));
            *(uint4*)(p->SZ + (size_t)row * 1024 + (col - 2560)) = w;
          }
        }
      }
  }
};
constexpr unsigned long long kRmap1 = 0x9832ull;
struct PgEpi1T {
  static constexpr bool PERM = true, AFTER_DRAIN = false;
  const Params* p;
  DEVI void operator()(const pg8::f32x4 (&acc)[2][2][4][2], const pg8::Unit& u, int wr, int wc, int fr, int fq) const {
    const int ch0 = (u.pm & 1) * 256 + wr * 64 + fr;
    const bool isv = u.pm >= 2;
#pragma unroll
    for (int ai = 0; ai < 2; ++ai)
#pragma unroll
      for (int m = 0; m < 4; ++m) {
        const int ch = ch0 + ai * 128 + m * 16;
#pragma unroll
        for (int bj = 0; bj < 2; ++bj) {
          const int t = u.pn * 256 + bj * 128 + wc * 32 + 8 * fq;
          const f32x4 v0 = acc[ai][bj][m][0], v1 = acc[ai][bj][m][1];
          if (!isv) {
            const int g = ch >> 7, c = ch & 127;
            uint4 w;
            w.x = pkbf(gelu_(v0[0]), gelu_(v0[1])); w.y = pkbf(gelu_(v0[2]), gelu_(v0[3]));
            w.z = pkbf(gelu_(v1[0]), gelu_(v1[1])); w.w = pkbf(gelu_(v1[2]), gelu_(v1[3]));
            *(uint4*)(p->GVT + ((size_t)(((t >> 7) * 4 + g) * 128 + c)) * 128 + (t & 127)) = w;
          } else {
            const int hh = ch >> 6, dim = ch & 63;
            const int b = t >> 14, s = t & (SEQ - 1);
            bfu* base = p->VT + ((size_t)((b * 8 + hh) * 64 + dim)) * SEQ;
            const size_t PST = (size_t)16 * 64 * SEQ;
            uint4 w;
            w.x = pkbf(v0[0], v0[1]); w.y = pkbf(v0[2], v0[3]); w.z = pkbf(v1[0], v1[1]); w.w = pkbf(v1[2], v1[3]);
            *(uint4*)(base + s) = w;
            bfu* b1 = base + PST + (s >> 2);
#pragma unroll
            for (int e = 0; e < 4; ++e) *(unsigned*)(b1 + (size_t)e * (SEQ / 4)) = pkbf(v0[e], v1[e]);
            bfu* b2 = base + 2 * PST + (size_t)(s & 15) * (SEQ / 16) + (s >> 4);
#pragma unroll
            for (int e = 0; e < 4; ++e) {
              b2[(size_t)e * (SEQ / 16)] = (bfu)f2bf(v0[e]);
              b2[(size_t)(e + 4) * (SEQ / 16)] = (bfu)f2bf(v1[e]);
            }
          }
        }
      }
  }
};
struct PgEpiRes {
  static constexpr bool PERM = false, AFTER_DRAIN = false;
  const float* base;
  float* out;
  DEVI void operator()(const pg8::f32x4 (&acc)[2][2][4][2], const pg8::Unit& u, int wr, int wc, int fr, int fq) const {
    const int row0 = u.pm * 256 + wr * 64 + fr, col0 = u.pn * 256 + wc * 32 + 4 * fq;
#pragma unroll
    for (int ai = 0; ai < 2; ++ai)
#pragma unroll
      for (int m = 0; m < 4; ++m) {
        const size_t rb = (size_t)(row0 + ai * 128 + m * 16) * 1024 + col0;
#pragma unroll
        for (int bj = 0; bj < 2; ++bj)
#pragma unroll
          for (int n = 0; n < 2; ++n) {
            const size_t idx = rb + bj * 128 + n * 16;
            const f32x4 b = *(const f32x4*)(base + idx);
            *(f32x4*)(out + idx) = acc[ai][bj][m][n] + b;
          }
      }
  }
};
template <class Epi>
DEVI void pg_gemm(char* smem, const bfu* A, const bfu* Bt, int M, int N, int K, const Epi& E, int bid, int nb) {
  pg8::Gemm g{A, Bt, M, N, K, A, 1 << 30, 0ull, 0ull};
  pg8::StaticOrder S;
  S.init(M, N, nb, bid);
  pg8::gemm_phase<Epi, pg8::StaticOrder, false>((PG8_LAS unsigned char*)smem, g, S, E, nullptr);
}
template <class Epi>
DEVI void pg_gemm2(char* smem, const bfu* A, const bfu* A2, int pn_split, const bfu* Bt, int M, int N, int K, const Epi& E,
                   int bid, int nb) {
  pg8::Gemm g{A, Bt, M, N, K, A2, pn_split, 0ull, 0ull};
  pg8::StaticOrder S;
  S.init(M, N, nb, bid);
  pg8::gemm_phase<Epi, pg8::StaticOrder, false>((PG8_LAS unsigned char*)smem, g, S, E, nullptr);
}
struct PgEpi3 {
  static constexpr bool PERM = true, AFTER_DRAIN = false;
  bfu* O0;
  bfu* O1;
  int silu1;
  DEVI void operator()(const pg8::f32x4 (&acc)[2][2][4][2], const pg8::Unit& u, int wr, int wc, int fr, int fq) const {
    const int row0 = u.pm * 256 + wr * 64 + fr;
    const int grp = u.pn >> 2;
    bfu* O = grp ? O1 : O0;
    const bool act = grp && silu1;
    const int colb = (u.pn & 3) * 256 + wc * 32 + 8 * fq;
#pragma unroll
    for (int ai = 0; ai < 2; ++ai)
#pragma unroll
      for (int m = 0; m < 4; ++m) {
        bfu* rowp = O + (size_t)(row0 + ai * 128 + m * 16) * 1024 + colb;
#pragma unroll
        for (int bj = 0; bj < 2; ++bj) {
          f32x4 v0 = acc[ai][bj][m][0], v1 = acc[ai][bj][m][1];
          if (act) {
#pragma unroll
            for (int e = 0; e < 4; ++e) {
              v0[e] = silu_(v0[e]);
              v1[e] = silu_(v1[e]);
            }
          }
          uint4 w;
          w.x = pkbf(v0[0], v0[1]); w.y = pkbf(v0[2], v0[3]); w.z = pkbf(v1[0], v1[1]); w.w = pkbf(v1[2], v1[3]);
          *(uint4*)(rowp + bj * 128) = w;
        }
      }
  }
};

DEVI void phase1(const Params& p, char* smem, int bid, int nb) {
  {
    PgEpi1 E{&p};
    pg8::Gemm g{p.H, p.WT_in, T_TOK, 2560, 1024, p.H, 1 << 30, 0ull, kCmap1};
    pg8::StaticOrder S;
    S.init(T_TOK, 2560, nb, bid);
    pg8::gemm_phase<PgEpi1, pg8::StaticOrder, false>((PG8_LAS unsigned char*)smem, g, S, E, nullptr);
  }
  {
    PgEpi1T E{&p};
    pg8::Gemm g{p.WT_in, p.H, 1024, T_TOK, 1024, p.WT_in, 1 << 30, kRmap1, 0ull};
    pg8::StaticOrder S;
    S.init(1024, T_TOK, nb, bid);
    pg8::gemm_phase<PgEpi1T, pg8::StaticOrder, false>((PG8_LAS unsigned char*)smem, g, S, E, nullptr);
  }
}

struct ALoadWs {
  struct Raw { float4 a, b; };
  static constexpr bool kFat = true;
  static constexpr bool kConsec = false;
  const float* ws;
  const float* rinv;
  DEVI Raw load(int t, int s0) const {
    Raw r;
    r.a = *(const float4*)(ws + t * 128 + s0);
    r.b = *(const float4*)(ws + t * 128 + s0 + 4);
    return r;
  }
  DEVI uint4 loadprev(int, int) const { return uint4{0u, 0u, 0u, 0u}; }
  DEVI uint4 asprev(const Raw&) const { return uint4{0u, 0u, 0u, 0u}; }
  DEVI uint4 finish(const Raw& r, const uint4&, int t, int s0) const {
    float f[8] = {r.a.x, r.a.y, r.a.z, r.a.w, r.b.x, r.b.y, r.b.z, r.b.w};
#pragma unroll
    for (int j = 0; j < 8; ++j) f[j] = (s0 + j <= t) ? f[j] * rinv[s0 + j] : 0.f;
    return pack8(f);
  }
};
struct EpiGm {
  const Params* p;
  int chunk, g;
  DEVI void operator()(int t, int c, f32x4 v) const {
    const float4 gn = *(const float4*)(p->gm_norm + g * 128 + c);
    const float bias = p->gm_b[g * 128 + t];
    const size_t tok = (size_t)chunk * 128 + t;
    float u[4], sz[4];
    unpack4(*(const uint2*)(p->U + tok * 512 + g * 128 + c), u);
    unpack4(*(const uint2*)(p->SZ + tok * 1024 + g * 128 + c), sz);
    uint2 o;
    o.x = pkbf(u[0] * (v[0] * gn.x + bias) * sz[0], u[1] * (v[1] * gn.y + bias) * sz[1]);
    o.y = pkbf(u[2] * (v[2] * gn.z + bias) * sz[2], u[3] * (v[3] * gn.w + bias) * sz[3]);
    *(uint2*)(p->Y + tok * 1024 + g * 128 + c) = o;
  }
};

DEVI void gmlp_item(const Params& p, char* smem, int item) {
  const int chunk = item >> 2, g = item & 3;
  const bfu* gv = p.GVT + (size_t)item * 128 * 128;
  float* rinv = (float*)(smem + 2 * GSTAGE_BYTES);
  const int tid = TIDX;
  {
    float* sred = rinv + 128;
    const int s4 = (tid & 31) * 4, cg = tid >> 5;
    uint2 raw[16];
#pragma unroll
    for (int i = 0; i < 16; ++i) raw[i] = *(const uint2*)(gv + (cg * 16 + i) * 128 + s4);
    float ss[4] = {0.f, 0.f, 0.f, 0.f};
#pragma unroll
    for (int i = 0; i < 16; ++i) {
      float f[4];
      unpack4(raw[i], f);
#pragma unroll
      for (int j = 0; j < 4; ++j) ss[j] += f[j] * f[j];
    }
    *(float4*)(sred + cg * 128 + s4) = float4{ss[0], ss[1], ss[2], ss[3]};
    __syncthreads();
    if (tid < 128) {
      float t = 0.f;
#pragma unroll
      for (int i = 0; i < 8; ++i) t += sred[i * 128 + tid];
      rinv[tid] = rsqrtf(t * (1.f / 128.f) + 1e-6f);
    }
  }
  __syncthreads();
  ALoadWs al{p.gm_ws + (size_t)g * 128 * 128, rinv};
  EpiGm epi{&p, chunk, g};
  gemm_tile(smem, al, gv, 128, 128, 0, 0, epi);
}

DEVI void attn_item(const Params& p, char* smem, int item) {
  const int qb = item & 63, bh = item >> 6, b = bh >> 3, h = bh & 7;
  const int q0 = qb * 256;
  bfu* Ob = (bfu*)smem;
  float* Mb = (float*)(smem + 32768);
  float* Lb = Mb + 256;
  const int tid = threadIdx.x, lane = tid & 63, wid = tid >> 6;
  const int qi = lane & 15, g = lane >> 4;
  const float slope = exp2f(-(float)(h + 1));
  const size_t tokb = (size_t)b * SEQ;
#pragma unroll 1
  for (int pi = 0; pi < 3; ++pi) {
    const int dshift = 2 * pi, d = 1 << dshift;
    const bfu* VT = p.VT + (size_t)pi * ((size_t)16 * 64 * SEQ) + (size_t)bh * 64 * SEQ;
#pragma unroll 1
    for (int u = wid; u < 16; u += 8) {
      const int r = u & (d - 1), tile = u >> dshift;
      const int sq0 = (q0 >> dshift) + tile * 16;
      const int sk0 = sq0 - 144;
      const int posq = ((sq0 + qi) << dshift) + r;
      const bfu* qp = p.Q + (tokb + posq) * 512 + h * 64 + g * 8;
      const bf16x8 qf0 = *(const bf16x8*)qp, qf1 = *(const bf16x8*)(qp + 32);
      const bfu* kbase = p.K + (tokb + r) * 512 + h * 64 + g * 8;
      const bfu* vbase = VT + (size_t)qi * SEQ + r * (SEQ >> dshift);
      bf16x8 kf[2][2];
      uint2 vf[4][2];
      auto loadkv = [&](int it) {
#pragma unroll
        for (int tt = 0; tt < 2; ++tt) {
          int sk = sk0 + (2 * it + tt) * 16 + qi;
          sk = sk < 0 ? 0 : sk;
          const bfu* kp = kbase + ((size_t)sk << dshift) * 512;
          kf[tt][0] = *(const bf16x8*)kp;
          kf[tt][1] = *(const bf16x8*)(kp + 32);
        }
        int kidx0 = sk0 + 32 * it + 4 * g, kidx1 = kidx0 + 16;
        kidx0 = kidx0 < 0 ? 0 : kidx0;
        kidx1 = kidx1 < 0 ? 0 : kidx1;
#pragma unroll
        for (int m = 0; m < 4; ++m) {
          vf[m][0] = *(const uint2*)(vbase + (size_t)(16 * m) * SEQ + kidx0);
          vf[m][1] = *(const uint2*)(vbase + (size_t)(16 * m) * SEQ + kidx1);
        }
      };
      loadkv(0);
      const int hi = 144 + qi, lo = (16 + qi > -sk0) ? 16 + qi : -sk0;
      const float sd = slope * (float)d;
      float mrun = -1e30f, l = 0.f;
      f32x4 O[4];
#pragma unroll
      for (int m = 0; m < 4; ++m) O[m] = f32x4{0.f, 0.f, 0.f, 0.f};
#pragma unroll 1
      for (int it = 0; it < 5; ++it) {
        bf16x8 ck[2][2];
        uint2 cv[4][2];
#pragma unroll
        for (int a = 0; a < 2; ++a)
#pragma unroll
          for (int c = 0; c < 2; ++c) ck[a][c] = kf[a][c];
#pragma unroll
        for (int m = 0; m < 4; ++m) {
          cv[m][0] = vf[m][0];
          cv[m][1] = vf[m][1];
        }
        if (it < 4) loadkv(it + 1);
        f32x4 S[2];
#pragma unroll
        for (int tt = 0; tt < 2; ++tt) {
          f32x4 z = {0.f, 0.f, 0.f, 0.f};
          z = __builtin_amdgcn_mfma_f32_16x16x32_bf16(ck[tt][0], qf0, z, 0, 0, 0);
          z = __builtin_amdgcn_mfma_f32_16x16x32_bf16(ck[tt][1], qf1, z, 0, 0, 0);
          S[tt] = z;
        }
        float mx = -INFINITY;
#pragma unroll
        for (int tt = 0; tt < 2; ++tt)
#pragma unroll
          for (int e = 0; e < 4; ++e) {
            const int kb = (2 * it + tt) * 16 + 4 * g;
            const bool valid = (kb >= lo - e) && (kb <= hi - e);
            const float sv = valid ? fmaf(S[tt][e], 0.125f, sd * (float)e - sd * (float)(hi - kb)) : -INFINITY;
            S[tt][e] = sv;
            mx = fmaxf(mx, sv);
          }
        mx = fmaxf(mx, __shfl_xor(mx, 16));
        mx = fmaxf(mx, __shfl_xor(mx, 32));
        const float mnew = fmaxf(mrun, mx);
        const float alpha = __expf(mrun - mnew);
        mrun = mnew;
        float ls = 0.f;
#pragma unroll
        for (int tt = 0; tt < 2; ++tt)
#pragma unroll
          for (int e = 0; e < 4; ++e) {
            const float pe = __expf(S[tt][e] - mnew);
            S[tt][e] = pe;
            ls += pe;
          }
        l = l * alpha + ls;
        uint4 pk;
        pk.x = pkbf(S[0][0], S[0][1]);
        pk.y = pkbf(S[0][2], S[0][3]);
        pk.z = pkbf(S[1][0], S[1][1]);
        pk.w = pkbf(S[1][2], S[1][3]);
        const bf16x8 pf = __builtin_bit_cast(bf16x8, pk);
#pragma unroll
        for (int m = 0; m < 4; ++m) {
          O[m] *= alpha;
          const uint4 vv = {cv[m][0].x, cv[m][0].y, cv[m][1].x, cv[m][1].y};
          O[m] = __builtin_amdgcn_mfma_f32_16x16x32_bf16(__builtin_bit_cast(bf16x8, vv), pf, O[m], 0, 0, 0);
        }
      }
      l += __shfl_xor(l, 16);
      l += __shfl_xor(l, 32);
      const float mx = mrun;
      const float il = 1.f / l;
      const int ql = ((tile * 16 + qi) << dshift) + r;
      float wo = 0.f, wn = 1.f;
      float mnew = mx, lnew = l;
      if (pi > 0) {
        const float mo = Mb[ql], lo = Lb[ql];
        mnew = fmaxf(mo, mx);
        wo = lo * __expf(mo - mnew);
        wn = l * __expf(mx - mnew);
        lnew = wo + wn;
        const float inv = 1.f / lnew;
        wo *= inv;
        wn *= inv;
      }
      wn *= il;
#pragma unroll
      for (int m = 0; m < 4; ++m) {
        bfu* op = Ob + ql * 64 + 16 * m + 4 * g;
        float o[4];
        if (pi > 0) {
          const uint2 ov = *(const uint2*)op;
          o[0] = wo * bf2f(ov.x & 0xffffu) + wn * O[m][0];
          o[1] = wo * bf2f(ov.x >> 16) + wn * O[m][1];
          o[2] = wo * bf2f(ov.y & 0xffffu) + wn * O[m][2];
          o[3] = wo * bf2f(ov.y >> 16) + wn * O[m][3];
        } else {
#pragma unroll
          for (int e = 0; e < 4; ++e) o[e] = wn * O[m][e];
        }
        if (pi < 2) {
          uint2 w;
          w.x = pkbf(o[0], o[1]);
          w.y = pkbf(o[2], o[3]);
          *(uint2*)op = w;
        } else {
          const size_t oi = (tokb + q0 + ql) * 1024 + 512 + h * 64 + 16 * m + 4 * g;
          const uint2 sz = *(const uint2*)(p.SZ + oi);
          uint2 w;
          w.x = pkbf(o[0] * bf2f(sz.x & 0xffffu), o[1] * bf2f(sz.x >> 16));
          w.y = pkbf(o[2] * bf2f(sz.y & 0xffffu), o[3] * bf2f(sz.y >> 16));
          *(uint2*)(p.Y + oi) = w;
        }
      }
      if (pi < 2 && g == 0) {
        Mb[ql] = mnew;
        Lb[ql] = lnew;
      }
    }
    __syncthreads();
  }
}

DEVI void phase2(const Params& p, char* smem, int bid, int nb) {
  for (int it = bid; it < 16 * 64; it += nb) attn_item(p, smem, it);
  char* hs = smem + HF * HALF_SMEM;
  for (int it = bid * 2 + HF; it < (T_TOK / 128) * 4; it += nb * 2) gmlp_item(p, hs, it);
}

DEVI void phase3(const Params& p, char* smem, int bid, int nb) {
  PgEpiRes E{p.x, p.out};
  pg_gemm(smem, p.Y, p.WT_out, T_TOK, 1024, 1024, E, bid, nb);
}
DEVI void phase3b(const Params& p, int bid, int nb) {
  for (int it = bid; it < T_TOK / 16; it += nb) {
    const int row = it * 16 + (threadIdx.x >> 6) * 2;
    rms_row2_bf16(p.out + (size_t)row * 1024, p.ln_odd, p.H + (size_t)row * 1024, threadIdx.x & 63);
  }
}

struct ALoadMix {
  typedef uint4 Raw;
  static constexpr bool kFat = true;
  static constexpr bool kConsec = true;
  const bfu* H;
  const float* mu;
  DEVI Raw load(int row, int k) const { return *(const uint4*)(H + (size_t)row * 1024 + k); }
  DEVI uint4 loadprev(int row, int k) const {
    const int prow = ((row & (SEQ - 1)) != 0) ? row - 1 : row;
    return *(const uint4*)(H + (size_t)prow * 1024 + k);
  }
  DEVI uint4 asprev(const Raw& r) const { return r; }
  DEVI uint4 finish(const Raw& r, const uint4& pr, int row, int k) const {
    float c[8], pv[8];
    unpack8(r, c);
    unpack8(pr, pv);
    const float first = ((row & (SEQ - 1)) != 0) ? 1.f : 0.f;
    const float4 m0 = *(const float4*)(mu + k), m1 = *(const float4*)(mu + k + 4);
    const float mm[8] = {m0.x, m0.y, m0.z, m0.w, m1.x, m1.y, m1.z, m1.w};
#pragma unroll
    for (int j = 0; j < 8; ++j) c[j] = c[j] + (pv[j] * first - c[j]) * mm[j];
    return pack8(c);
  }
};
struct Epi4 {
  const Params* p;
  int nt;
  DEVI void operator()(int row, int col, f32x4 v) const {
    uint2 o;
    if (nt < 24) {
      o.x = pkbf(v[0], v[1]);
      o.y = pkbf(v[2], v[3]);
      bfu* dst = (nt < 8) ? p->R + (size_t)row * 1024 + col
                          : (nt < 16) ? p->K1 + (size_t)row * 1024 + col - 1024 : p->V1 + (size_t)row * 1024 + col - 2048;
      *(uint2*)dst = o;
    } else if (nt < 32) {
      o.x = pkbf(silu_(v[0]), silu_(v[1]));
      o.y = pkbf(silu_(v[2]), silu_(v[3]));
      *(uint2*)(p->SG + (size_t)row * 1024 + col - 3072) = o;
    } else if (nt == 32) {
      const int c = col - 4096;
      if (c < 64) {
        o.x = pkbf(tanh_(v[0]), tanh_(v[1]));
        o.y = pkbf(tanh_(v[2]), tanh_(v[3]));
        *(uint2*)(p->TW + (size_t)row * 64 + c) = o;
      }
    } else {
      const int c = col - 4224;
      if (c < 64) {
        o.x = pkbf(v[0], v[1]);
        o.y = pkbf(v[2], v[3]);
        *(uint2*)(p->TA + (size_t)row * 64 + c) = o;
      }
    }
  }
};
DEVI void phase4_tile(const Params& p, char* smem, int mt, int nt) {
  float* smu = (float*)(smem + 2 * GSTAGE_BYTES);
  const int mi = (nt < 8) ? 0 : (nt < 16) ? 2 : (nt < 24) ? 3 : (nt < 32) ? 5 : (nt == 32) ? 1 : 4;
  *(float4*)(smu + TIDX * 4) = *(const float4*)(p.mu + mi * 1024 + TIDX * 4);
  __syncthreads();
  ALoadMix al{p.H, smu};
  Epi4 epi{&p, nt};
  gemm_tile<1>(smem, al, p.WT_3, 1024, 1024, mt * 128, nt * 128, epi);
}
DEVI void phaseM(const Params& p, char* smem, int bid, int nb) {
  char* hs = smem + HF * HALF_SMEM;
  for (int it = bid * 2 + HF; it < (T_TOK / 128) * 2; it += nb * 2) phase4_tile(p, hs, it >> 1, 32 + (it & 1));
  const int tid = threadIdx.x;
  const int cc = (tid & 127) * 8, rsub = tid >> 7;
  float mr[8], mk[8], mv[8], mg[8];
  {
    const float4 a0 = *(const float4*)(p.mu + 0 * 1024 + cc), a1 = *(const float4*)(p.mu + 0 * 1024 + cc + 4);
    const float4 b0 = *(const float4*)(p.mu + 2 * 1024 + cc), b1 = *(const float4*)(p.mu + 2 * 1024 + cc + 4);
    const float4 c0 = *(const float4*)(p.mu + 3 * 1024 + cc), c1 = *(const float4*)(p.mu + 3 * 1024 + cc + 4);
    const float4 d0 = *(const float4*)(p.mu + 5 * 1024 + cc), d1 = *(const float4*)(p.mu + 5 * 1024 + cc + 4);
    mr[0] = a0.x; mr[1] = a0.y; mr[2] = a0.z; mr[3] = a0.w; mr[4] = a1.x; mr[5] = a1.y; mr[6] = a1.z; mr[7] = a1.w;
    mk[0] = b0.x; mk[1] = b0.y; mk[2] = b0.z; mk[3] = b0.w; mk[4] = b1.x; mk[5] = b1.y; mk[6] = b1.z; mk[7] = b1.w;
    mv[0] = c0.x; mv[1] = c0.y; mv[2] = c0.z; mv[3] = c0.w; mv[4] = c1.x; mv[5] = c1.y; mv[6] = c1.z; mv[7] = c1.w;
    mg[0] = d0.x; mg[1] = d0.y; mg[2] = d0.z; mg[3] = d0.w; mg[4] = d1.x; mg[5] = d1.y; mg[6] = d1.z; mg[7] = d1.w;
  }
#pragma unroll 1
  for (int it = bid; it < T_TOK / 8; it += nb) {
    const int ra = it * 8 + rsub, rb = ra + 4;
    const size_t oa = (size_t)ra * 1024 + cc, ob = (size_t)rb * 1024 + cc;
    const uint4 ca = *(const uint4*)(p.H + oa), cb = *(const uint4*)(p.H + ob);
    const uint4 pa = *(const uint4*)(p.H + (((ra & (SEQ - 1)) != 0) ? oa - 1024 : oa));
    const uint4 pb = *(const uint4*)(p.H + ob - 1024);
    const float fa = ((ra & (SEQ - 1)) != 0) ? 1.f : 0.f;
#pragma unroll
    for (int half = 0; half < 2; ++half) {
      float c[8], d[8], o[8];
      unpack8(half ? cb : ca, c);
      unpack8(half ? pb : pa, d);
      const float f = half ? 1.f : fa;
      const size_t oo = half ? ob : oa;
#pragma unroll
      for (int j = 0; j < 8; ++j) d[j] = d[j] * f - c[j];
#pragma unroll
      for (int j = 0; j < 8; ++j) o[j] = c[j] + d[j] * mr[j];
      *(uint4*)(p.XR + oo) = pack8(o);
#pragma unroll
      for (int j = 0; j < 8; ++j) o[j] = c[j] + d[j] * mk[j];
      *(uint4*)(p.XK + oo) = pack8(o);
#pragma unroll
      for (int j = 0; j < 8; ++j) o[j] = c[j] + d[j] * mv[j];
      *(uint4*)(p.XV + oo) = pack8(o);
#pragma unroll
      for (int j = 0; j < 8; ++j) o[j] = c[j] + d[j] * mg[j];
      *(uint4*)(p.XG + oo) = pack8(o);
    }
  }
}
DEVI void phase3a(const Params& p, char* smem, int bid, int nb) {
  PgEpi3 E{p.R, p.K1, 0};
  pg_gemm2(smem, p.XR, p.XK, 4, p.WT_3, T_TOK, 2048, 1024, E, bid, nb);
}
DEVI void phase3c(const Params& p, char* smem, int bid, int nb) {
  PgEpi3 E{p.V1, p.SG, 1};
  pg_gemm2(smem, p.XV, p.XG, 4, p.WT_3 + (size_t)2048 * 1024, T_TOK, 2048, 1024, E, bid, nb);
}

struct Epi5w {
  const Params* p;
  DEVI void operator()(int row, int col, f32x4 v) const {
    const float4 w0 = *(const float4*)(p->w0 + col);
    const float k = 0.6065306597126334f;
    uint2 o;
    o.x = pkbf(k * sigmoid_(w0.x + v[0]), k * sigmoid_(w0.y + v[1]));
    o.y = pkbf(k * sigmoid_(w0.z + v[2]), k * sigmoid_(w0.w + v[3]));
    *(uint2*)(p->EW + (size_t)row * 1024 + col) = o;
  }
};
struct Epi5a {
  const Params* p;
  DEVI void operator()(int row, int col, f32x4 v) const {
    const float4 a0 = *(const float4*)(p->a0 + col);
    uint2 o;
    o.x = pkbf(sigmoid_(a0.x + v[0]), sigmoid_(a0.y + v[1]));
    o.y = pkbf(sigmoid_(a0.z + v[2]), sigmoid_(a0.w + v[3]));
    *(uint2*)(p->AA + (size_t)row * 1024 + col) = o;
  }
};
DEVI void phase5(const Params& p, char* smem, int bid, int nb) {
  constexpr int N1 = (T_TOK / 128) * 8;
  char* hs = smem + HF * HALF_SMEM;
  for (int it = bid * 2 + HF; it < 2 * N1; it += nb * 2) {
    if (it < N1) {
      ALoadPlain al{p.TW, 64};
      Epi5w epi{&p};
      gemm_tile(hs, al, p.W2T, 64, 64, (it >> 3) * 128, (it & 7) * 128, epi);
    } else {
      const int j = it - N1;
      ALoadPlain al{p.TA, 64};
      Epi5a epi{&p};
      gemm_tile(hs, al, p.A2T, 64, 64, (j >> 3) * 128, (j & 7) * 128, epi);
    }
  }
}

DEVI void scanx_item(const Params& p, char* smem, int item, int next_item, uint2& ur, uint2& uk, uint2& ue, uint2& ua, uint2& uv) {
  const int bh = item & 31, c = item >> 5;
  const int b = bh >> 4, h = bh & 15;
  const size_t rowbase = ((size_t)b * SEQ + (size_t)c * 16) * 1024 + h * 64;
  float* sA = (float*)smem;
  float* sR = sA + 16 * 68;
  float* sBt = sR + 16 * 68;
  float* sKt = sBt + 16 * 68;
  float* sE = sKt + 16 * 68;
  float* sMab = sE + 16 * 64;
  float* sMak = sMab + 256;
  float* sM2 = sMak + 256;
  float* sM4 = sM2 + 256;
  float* sT = sM4 + 256;
  float* sT2 = sT + 256;
  const int tid = TIDX;
  const int tau = tid >> 4, c4 = (tid & 15) * 4;
  const size_t o = rowbase + (size_t)tau * 1024 + c4;
  float r[4], k[4], ew[4], a[4], vv[4];
  unpack4(ur, r);
  unpack4(uk, k);
  unpack4(ue, ew);
  unpack4(ua, a);
  unpack4(uv, vv);
  {
    const int nbh = next_item & 31, nc = next_item >> 5;
    const size_t no = ((size_t)(nbh >> 4) * SEQ + (size_t)nc * 16 + tau) * 1024 + (nbh & 15) * 64 + c4;
    ur = *(const uint2*)(p.R + no);
    uk = *(const uint2*)(p.K1 + no);
    ue = *(const uint2*)(p.EW + no);
    ua = *(const uint2*)(p.AA + no);
    uv = *(const uint2*)(p.V1 + no);
  }
  float kk[4], kp[4], bb[4];
  float ss = 0.f, cf = 0.f;
#pragma unroll
  for (int j = 0; j < 4; ++j) {
    const int ch = h * 64 + c4 + j;
    kk[j] = k[j] * p.k_k[ch];
    ss += kk[j] * kk[j];
    kp[j] = k[j] * (1.f + (a[j] - 1.f) * p.k_a[ch]);
    cf += r[j] * kp[j] * p.r_k[ch];
  }
  ss = reduce16(ss);
  cf = reduce16(cf);
  const float rn = rsqrtf(fmaxf(ss, 1e-24f));
#pragma unroll
  for (int j = 0; j < 4; ++j) {
    kk[j] *= rn;
    bb[j] = kk[j] * a[j];
    sE[tau * 64 + c4 + j] = ew[j];
  }
  if ((tid & 15) == 0) p.COEF[((size_t)b * SEQ + (size_t)c * 16 + tau) * 16 + h] = cf;
  __syncthreads();
  float Li[4] = {0.f, 0.f, 0.f, 0.f}, L15[4] = {0.f, 0.f, 0.f, 0.f};
#pragma unroll
  for (int i = 0; i < 16; ++i) {
    const float4 e = *(const float4*)(sE + i * 64 + c4);
    const float m = (i <= tau) ? 1.f : 0.f;
    Li[0] += m * e.x; Li[1] += m * e.y; Li[2] += m * e.z; Li[3] += m * e.w;
    L15[0] += e.x; L15[1] += e.y; L15[2] += e.z; L15[3] += e.w;
  }
  float rt[4], bhat[4], khat[4];
#pragma unroll
  for (int j = 0; j < 4; ++j) {
    const float ep = __expf(Li[j]), em = __expf(-Li[j]), eh = __expf(-(L15[j] - Li[j]));
    const float at = -kk[j] * __expf(-(Li[j] - ew[j]));
    rt[j] = r[j] * em;
    sA[tau * 68 + c4 + j] = at;
    sR[tau * 68 + c4 + j] = rt[j];
    sBt[tau * 68 + c4 + j] = bb[j] * ep;
    sKt[tau * 68 + c4 + j] = kp[j] * ep;
    bhat[j] = bb[j] * eh;
    khat[j] = kp[j] * eh;
  }
  *(uint2*)(p.R + o) = pack4(rt);
#pragma unroll
  for (int j = 0; j < 4; ++j) {
    const int lin = (c4 + j) * 16 + tau;
    const size_t off = rowbase + (size_t)(lin >> 6) * 1024 + (lin & 63);
    p.EW[off] = (bfu)f2bf(bhat[j]);
    p.K1[off] = (bfu)f2bf(khat[j]);
    p.V1[off] = (bfu)f2bf(vv[j]);
  }
  if (tau == 0) {
    float4 gq = {__expf(-L15[0]), __expf(-L15[1]), __expf(-L15[2]), __expf(-L15[3])};
    *(float4*)(p.G15 + (size_t)item * 64 + c4) = gq;
  }
  __syncthreads();
  {
    const int i = tid >> 4, tq = tid & 15;
    float mab = 0.f, mak = 0.f, mrb = 0.f, mrk = 0.f;
#pragma unroll
    for (int kq = 0; kq < 64; kq += 4) {
      const float4 bi = *(const float4*)(sBt + i * 68 + kq);
      const float4 ki = *(const float4*)(sKt + i * 68 + kq);
      const float4 aq = *(const float4*)(sA + tq * 68 + kq);
      const float4 rq = *(const float4*)(sR + tq * 68 + kq);
      mab += bi.x * aq.x + bi.y * aq.y + bi.z * aq.z + bi.w * aq.w;
      mak += ki.x * aq.x + ki.y * aq.y + ki.z * aq.z + ki.w * aq.w;
      mrb += bi.x * rq.x + bi.y * rq.y + bi.z * rq.z + bi.w * rq.w;
      mrk += ki.x * rq.x + ki.y * rq.y + ki.z * rq.z + ki.w * rq.w;
    }
    if (!(i < tq)) { mab = 0.f; mak = 0.f; }
    if (!(i <= tq)) { mrb = 0.f; mrk = 0.f; }
    sMab[i * 16 + tq] = mab;
    sMak[i * 16 + tq] = mak;
    bfu* mr = p.MRT + (size_t)item * 512 + tq * 32 + (i >> 2) * 8 + (i & 3);
    mr[0] = (bfu)f2bf(mrb);
    mr[4] = (bfu)f2bf(mrk);
  }
  __syncthreads();
  {
    const int i = tid >> 4, j = tid & 15;
    float m2 = 0.f;
#pragma unroll
    for (int kq = 0; kq < 16; ++kq) m2 += sMab[i * 16 + kq] * sMab[kq * 16 + j];
    sM2[i * 16 + j] = m2;
    __syncthreads();
    float t1 = ((i == j) ? 1.f : 0.f) + sMab[i * 16 + j] + m2, m4 = 0.f;
#pragma unroll
    for (int kq = 0; kq < 16; ++kq) {
      t1 += sMab[i * 16 + kq] * sM2[kq * 16 + j];
      m4 += sM2[i * 16 + kq] * sM2[kq * 16 + j];
    }
    sT[i * 16 + j] = t1;
    sM4[i * 16 + j] = m4;
    __syncthreads();
    float t2 = t1, m8 = 0.f;
#pragma unroll
    for (int kq = 0; kq < 16; ++kq) {
      t2 += sT[i * 16 + kq] * sM4[kq * 16 + j];
      m8 += sM4[i * 16 + kq] * sM4[kq * 16 + j];
    }
    sT2[i * 16 + j] = t2;
    __syncthreads();
    sM2[i * 16 + j] = m8;
    __syncthreads();
    float t3 = t2;
#pragma unroll
    for (int kq = 0; kq < 16; ++kq) t3 += sT2[i * 16 + kq] * sM2[kq * 16 + j];
    sT[i * 16 + j] = t3;
    __syncthreads();
  }
  {
    const int tq = tid >> 4, k4 = (tid & 15) * 4, ii = tid & 15;
    float w0 = 0.f, w1 = 0.f, w2 = 0.f, w3 = 0.f, gt = 0.f;
#pragma unroll
    for (int jj = 0; jj < 16; ++jj) {
      const float tm = sT[jj * 16 + tq];
      const float4 av = *(const float4*)(sA + jj * 68 + k4);
      w0 += av.x * tm; w1 += av.y * tm; w2 += av.z * tm; w3 += av.w * tm;
      gt += sMak[ii * 16 + jj] * tm;
    }
    uint2 wv;
    wv.x = pkbf(w0, w1);
    wv.y = pkbf(w2, w3);
    *(uint2*)(p.AA + rowbase + (size_t)tq * 1024 + k4) = wv;
    p.GT[(size_t)item * 256 + tq * 16 + ii] = (bfu)f2bf(gt);
  }
  __syncthreads();
}
DEVI void phase6x(const Params& p, char* smem, int bid, int nb) {
  char* hs = smem + HF * HALF_SMEM;
  constexpr int NI = (SEQ / 16) * 32;
  const int vnb = nb * 2;
  int it = bid * 2 + HF;
  if (it >= NI) return;
  uint2 ur, uk, ue, ua, uv;
  {
    const int tau = TIDX >> 4, c4 = (TIDX & 15) * 4;
    const int bh = it & 31, c = it >> 5;
    const size_t o = ((size_t)(bh >> 4) * SEQ + (size_t)c * 16 + tau) * 1024 + (bh & 15) * 64 + c4;
    ur = *(const uint2*)(p.R + o);
    uk = *(const uint2*)(p.K1 + o);
    ue = *(const uint2*)(p.EW + o);
    ua = *(const uint2*)(p.AA + o);
    uv = *(const uint2*)(p.V1 + o);
  }
#pragma unroll 1
  for (; it < NI; it += vnb) scanx_item(p, hs, it, (it + vnb < NI) ? it + vnb : it, ur, uk, ue, ua, uv);
}

DEVI bf16x8 mk8(uint2 a, uint2 b) {
  const uint4 v = {a.x, a.y, b.x, b.y};
  return __builtin_bit_cast(bf16x8, v);
}
DEVI uint2 packacc(f32x4 a) {
  uint2 r;
  r.x = pkbf(a[0], a[1]);
  r.y = pkbf(a[2], a[3]);
  return r;
}
constexpr int SCH = 4;
constexpr int SROW = 136;
constexpr int SARR = 16 * SROW;
constexpr int SOFF_GT = 5 * SARR;
constexpr int SOFF_MR = SOFF_GT + 512;
constexpr int SOFF_G15 = SOFF_MR + 1024;
constexpr int SIMG = SOFF_G15 + 256;
#define SCANS_LD5(P, I, O)                       \
    P##a##I = *(const uint4*)(p.AA + (O));       \
    P##r##I = *(const uint4*)(p.R + (O));        \
    P##e##I = *(const uint4*)(p.EW + (O));       \
    P##k##I = *(const uint4*)(p.K1 + (O));       \
    P##v##I = *(const uint4*)(p.V1 + (O));
#define SCANS_ISSUE(P, SC)                                                                           \
  {                                                                                                  \
    const size_t hb_ = ((size_t)b * SEQ) * 1024 + h * 64 + c80 * 8;                                  \
    const int tk0_ = (SC) * SCH * 16 + cl0 * 16 + row0;                                              \
    const int tk1_ = tk0_ + 32;                                                                      \
    SCANS_LD5(P, 0, hb_ + (size_t)(tk0_ < SEQ ? tk0_ : SEQ - 1) * 1024)                              \
    SCANS_LD5(P, 1, hb_ + (size_t)(tk1_ < SEQ ? tk1_ : SEQ - 1) * 1024)                              \
    const int c0_ = (SC) * SCH;                                                                      \
    const size_t ib_ = (size_t)b * 16 + h;                                                           \
    const int tg_ = tid < 128 ? tid : 127;                                                           \
    const int cg_ = c0_ + (tg_ >> 5);                                                                \
    P##gm = *(const uint4*)(p.GT + ((size_t)(cg_ < SEQ / 16 ? cg_ : SEQ / 16 - 1) * 32 + ib_) * 256 + (tg_ & 31) * 8);  \
    const int t5_ = tid < 64 ? tid : 63;                                                             \
    const int c5_ = c0_ + (t5_ >> 4);                                                                \
    P##g5 = *(const uint4*)(p.G15 + ((size_t)(c5_ < SEQ / 16 ? c5_ : SEQ / 16 - 1) * 32 + ib_) * 64 + (t5_ & 15) * 4);  \
    const int cm_ = c0_ + (tid >> 6);                                                                \
    P##mr = *(const uint4*)(p.MRT + ((size_t)(cm_ < SEQ / 16 ? cm_ : SEQ / 16 - 1) * 32 + ib_) * 512 + (tid & 63) * 8); \
  }
#define SCANS_ST5(P, I, B)                                                                           \
    *(uint2*)(B) = uint2{P##a##I.x, P##a##I.y};  *(uint2*)((B) + 8) = uint2{P##a##I.z, P##a##I.w};   \
    *(uint2*)((B) + SARR) = uint2{P##r##I.x, P##r##I.y};  *(uint2*)((B) + SARR + 8) = uint2{P##r##I.z, P##r##I.w};   \
    *(uint2*)((B) + 2 * SARR) = uint2{P##e##I.x, P##e##I.y};  *(uint2*)((B) + 2 * SARR + 8) = uint2{P##e##I.z, P##e##I.w};   \
    *(uint2*)((B) + 3 * SARR) = uint2{P##k##I.x, P##k##I.y};  *(uint2*)((B) + 3 * SARR + 8) = uint2{P##k##I.z, P##k##I.w};   \
    *(uint2*)((B) + 4 * SARR) = uint2{P##v##I.x, P##v##I.y};  *(uint2*)((B) + 4 * SARR + 8) = uint2{P##v##I.z, P##v##I.w};
#define SCANS_COMMIT(P)                                                                              \
  {                                                                                                  \
    char* b0_ = smem + cl0 * SIMG + row0 * SROW + c80 * 16;                                          \
    SCANS_ST5(P, 0, b0_)                                                                             \
    SCANS_ST5(P, 1, b0_ + 2 * SIMG)                                                                  \
    if (tid < 128) *(uint4*)(smem + (tid >> 5) * SIMG + SOFF_GT + (tid & 31) * 16) = P##gm;          \
    if (tid < 64) *(uint4*)(smem + (tid >> 4) * SIMG + SOFF_G15 + (tid & 15) * 16) = P##g5;          \
    *(uint4*)(smem + (tid >> 6) * SIMG + SOFF_MR + (tid & 63) * 16) = P##mr;                         \
  }
#define SCANS_COMPUTE(SCI)                                                                           \
  _Pragma("unroll 1") for (int cl = 0; cl < SCH && (SCI) * SCH + cl < SEQ / 16; ++cl) {             \
    const char* img = smem + cl * SIMG;                                                              \
        \
    const uint2 vb = *(const uint2*)(img + 4 * SARR + vrow * SROW + vcol * 2);                       \
    const uint2 gt = *(const uint2*)(img + SOFF_GT + (q * 16 + 4 * g) * 2);                          \
    const char* wp = img + q * SROW + (4 * g) * 2;                                                   \
    const uint2 w00 = *(const uint2*)(wp), w01 = *(const uint2*)(wp + 32);                           \
    const uint2 w10 = *(const uint2*)(wp + 64), w11 = *(const uint2*)(wp + 96);                      \
    const uint2 r00 = *(const uint2*)(wp + SARR), r01 = *(const uint2*)(wp + SARR + 32);             \
    const uint2 r10 = *(const uint2*)(wp + SARR + 64), r11 = *(const uint2*)(wp + SARR + 96);        \
    const uint4 mr = *(const uint4*)(img + SOFF_MR + (q * 32 + g * 8) * 2);                          \
    uint2 bk0[4], bk1[4];                                                                            \
    float4 g15[4];                                                                                   \
    _Pragma("unroll") for (int n = 0; n < 4; ++n) {                                                  \
      const int ch = 16 * n + q;                                                                     \
      const char* bp = img + 2 * SARR + (ch >> 2) * SROW + ((ch & 3) * 16 + 4 * g) * 2;              \
      bk0[n] = *(const uint2*)(bp);                                                                  \
      bk1[n] = *(const uint2*)(bp + SARR);                                                           \
      g15[n] = *(const float4*)(img + SOFF_G15 + (16 * n + 4 * g) * 4);                              \
    }                                                                                                \
    __builtin_amdgcn_sched_barrier(0);                                                               \
    const bf16x8 sB0 = mk8(packacc(acc[0]), packacc(acc[1]));                                        \
    const bf16x8 sB1 = mk8(packacc(acc[2]), packacc(acc[3]));                                        \
    f32x4 Z = {0.f, 0.f, 0.f, 0.f};                                                                  \
    Z = __builtin_amdgcn_mfma_f32_16x16x32_bf16(mk8(gt, zero2), mk8(vb, zero2), Z, 0, 0, 0);         \
    f32x4 Y = {0.f, 0.f, 0.f, 0.f};                                                                  \
    Z = __builtin_amdgcn_mfma_f32_16x16x32_bf16(mk8(w00, w01), sB0, Z, 0, 0, 0);                     \
    Y = __builtin_amdgcn_mfma_f32_16x16x32_bf16(mk8(r00, r01), sB0, Y, 0, 0, 0);                     \
    Z = __builtin_amdgcn_mfma_f32_16x16x32_bf16(mk8(w10, w11), sB1, Z, 0, 0, 0);                     \
    Y = __builtin_amdgcn_mfma_f32_16x16x32_bf16(mk8(r10, r11), sB1, Y, 0, 0, 0);                     \
    const bf16x8 zvB = mk8(packacc(Z), vb);                                                          \
    Y = __builtin_amdgcn_mfma_f32_16x16x32_bf16(__builtin_bit_cast(bf16x8, mr), zvB, Y, 0, 0, 0);    \
    _Pragma("unroll") for (int n = 0; n < 4; ++n) {                                                  \
      f32x4 scv = acc[n];                                                                            \
      scv[0] *= g15[n].x; scv[1] *= g15[n].y; scv[2] *= g15[n].z; scv[3] *= g15[n].w;                \
      acc[n] = __builtin_amdgcn_mfma_f32_16x16x32_bf16(mk8(bk0[n], bk1[n]), zvB, scv, 0, 0, 0);      \
    }                                                                                                \
    _Pragma("unroll") for (int e = 0; e < 4; ++e)                                                    \
        ybuf[(cl * 16 + 4 * g + e) * 16 + q] = (bfu)f2bf(Y[e]);                                      \
  }
DEVI void scans_block(const Params& p, char* smem, int bh, int vs) {
  const int b = bh >> 4, h = bh & 15;
  const int lane = threadIdx.x & 63, wv = threadIdx.x >> 6, q = lane & 15, g = lane >> 4;
  f32x4 acc[4];
#pragma unroll
  for (int n = 0; n < 4; ++n) acc[n] = f32x4{0.f, 0.f, 0.f, 0.f};
  const uint2 zero2 = {0u, 0u};
  bfu* yout = p.YS + ((size_t)b * SEQ) * 1024 + h * 64 + vs * 16;
  bfu* ybuf = (bfu*)(smem + SCH * SIMG);
  const int tid = TIDX, grp = HF;
  const int cl0 = tid >> 7, row0 = (tid >> 3) & 15, c80 = tid & 7;
  uint4 Aa0, Aa1, Ar0, Ar1, Ae0, Ae1, Ak0, Ak1, Av0, Av1, Agm, Ag5, Amr;
  constexpr int NSC = (SEQ / 16 + SCH - 1) / SCH;
  const int vrow = vs * 4 + (q >> 2), vcol = (q & 3) * 16 + 4 * g;
  if (grp == 0) {
    SCANS_ISSUE(A, 0);
    SCANS_COMMIT(A);
    SCANS_ISSUE(A, 2);
  } else {
    SCANS_ISSUE(A, 1);
  }
  __syncthreads();
#pragma unroll 1
  for (int sc = 0; sc < NSC; ++sc) {
    if (wv == 0) {
      SCANS_COMPUTE(sc);
    }
    __syncthreads();
    if (threadIdx.x >= 64 && threadIdx.x < 64 + SCH * 32) {
      const int idx = threadIdx.x - 64, tok = sc * SCH * 16 + (idx >> 1);
      if (tok < SEQ) *(uint4*)(yout + (size_t)tok * 1024 + (idx & 1) * 8) = *(const uint4*)(ybuf + (idx >> 1) * 16 + (idx & 1) * 8);
    }
    if (((sc + 1) & 1) == grp) {
      SCANS_COMMIT(A);
      SCANS_ISSUE(A, (sc + 3 < NSC ? sc + 3 : NSC - 1));
    }
    __syncthreads();
  }
}
DEVI void phase6(const Params& p, char* smem, int bid, int nb) {
  for (int it = bid; it < 128; it += nb) scans_block(p, smem, it >> 2, it & 3);
}

DEVI void phase6b(const Params& p, int bid, int nb) {
  const int lane = threadIdx.x & 63, wv = (threadIdx.x >> 6) & 3;
  for (int it = bid; it < T_TOK / 2; it += nb) {
    const int t = it * 2 + (threadIdx.x >> 8);
    const int tb = t & ~15, tau = t & 15;
    float ys[4], vv[4], sg[4], bon[4];
#pragma unroll
    for (int j = 0; j < 4; ++j) {
      const int h = wv * 4 + j;
      const size_t idx = (size_t)t * 1024 + h * 64 + lane;
      ys[j] = bf2f(p.YS[idx]);
      sg[j] = bf2f(p.SG[idx]);
      vv[j] = bf2f(p.V1[(size_t)(tb + (lane >> 2)) * 1024 + h * 64 + (lane & 3) * 16 + tau]);
      bon[j] = p.COEF[(size_t)t * 16 + h];
    }
#pragma unroll
    for (int j = 0; j < 4; ++j) {
      const int h = wv * 4 + j;
      const int c = h * 64 + lane;
      const float mean = wave_sum(ys[j]) * (1.f / 64.f);
      const float dv = ys[j] - mean;
      const float var = wave_sum(dv * dv) * (1.f / 64.f);
      float y = dv * rsqrtf(var + 64e-5f) * p.lnw[c] + p.lnb[c];
      y = (y + bon[j] * vv[j]) * sg[j];
      p.YS[(size_t)t * 1024 + c] = (bfu)f2bf(y);
    }
  }
}

DEVI void phase7(const Params& p, char* smem, int bid, int nb) {
  PgEpiRes E{p.out, p.out};
  pg_gemm(smem, p.YS, p.WT_o, T_TOK, 1024, 1024, E, bid, nb);
}
DEVI void phase8(const Params& p, int bid, int nb) {
  for (int it = bid; it < T_TOK / 16; it += nb) {
    const int row = it * 16 + (threadIdx.x >> 6) * 2;
    const int lane = threadIdx.x & 63;
    float* src = p.out + (size_t)row * 1024;
    float4 v[2][4];
    float ss[2] = {0.f, 0.f};
#pragma unroll
    for (int r = 0; r < 2; ++r)
#pragma unroll
      for (int i = 0; i < 4; ++i) v[r][i] = *(const float4*)(src + r * 1024 + lane * 4 + 256 * i);
#pragma unroll
    for (int r = 0; r < 2; ++r)
#pragma unroll
      for (int i = 0; i < 4; ++i)
        ss[r] += v[r][i].x * v[r][i].x + v[r][i].y * v[r][i].y + v[r][i].z * v[r][i].z + v[r][i].w * v[r][i].w;
#pragma unroll
    for (int r = 0; r < 2; ++r) {
      const float rinv = rsqrtf(wave_sum(ss[r]) * (1.f / 1024.f) + 1e-6f);
#pragma unroll
      for (int i = 0; i < 4; ++i) {
        const float4 g = *(const float4*)(p.fnorm + lane * 4 + 256 * i);
        const float4 o = {v[r][i].x * rinv * g.x, v[r][i].y * rinv * g.y, v[r][i].z * rinv * g.z, v[r][i].w * rinv * g.w};
        *(float4*)(src + r * 1024 + lane * 4 + 256 * i) = o;
      }
    }
  }
}

#define XB_TMO      128
#define XB_XCNT(j)  (256  + 64 * (j))
#define XB_XSUB(j)  (1280 + 64 * (j))
#define XB_XGEN(j)  (2304 + 64 * (j))
#define XB_TOP      3328
#define XB_TOPGEN   3392
#define XCD_BAR_WORDS 3456
#define XB_SPIN_CAP (1u << 18)
#define LAS __attribute__((address_space(3)))

__device__ __forceinline__ unsigned xb_ld(unsigned* p)              { return __hip_atomic_load(p, __ATOMIC_RELAXED, __HIP_MEMORY_SCOPE_AGENT); }
__device__ __forceinline__ unsigned xb_add(unsigned* p, unsigned v) { return __hip_atomic_fetch_add(p, v, __ATOMIC_RELAXED, __HIP_MEMORY_SCOPE_AGENT); }
__device__ __forceinline__ unsigned xb_xcc_id() { return (unsigned)__builtin_amdgcn_s_getreg((3 << 11) | 20) & 0xFu; }
#define XB_SPIN(cond, bar) do { unsigned _sp = 0; while (cond) { __builtin_amdgcn_s_sleep(1); \
    if ((++_sp & 255u) == 0u) { if (xb_ld(&(bar)[XB_TMO])) break; if (_sp > XB_SPIN_CAP) { atomicAdd(&(bar)[XB_TMO], 1u); break; } } } } while (0)

struct XcdBarrier {
    unsigned* bar; unsigned x;
    volatile LAS unsigned* st;
};

__device__ __forceinline__ XcdBarrier xcd_barrier_post(unsigned* bar, volatile LAS unsigned* st) {
    XcdBarrier b; b.bar = bar; b.x = xb_xcc_id(); b.st = st;
    if (threadIdx.x == 0) (void)xb_add(&bar[XB_XCNT(b.x)], 1u);
    return b;
}
__device__ __forceinline__ void xcd_barrier_complete(unsigned* bar, unsigned x, unsigned& nloc, unsigned& nx) {
    const unsigned G = gridDim.x * gridDim.y * gridDim.z;
    unsigned sum, cnt, mine, sp = 0u;
    for (;;) {
        sum = 0u; cnt = 0u; mine = 0u;
#pragma unroll
        for (unsigned j = 0; j < 16; ++j) { const unsigned c = xb_ld(&bar[XB_XCNT(j)]); sum += c; cnt += (c > 0u) ? 1u : 0u; mine = (j == x) ? c : mine; }
        if (sum == G) break;
        __builtin_amdgcn_s_sleep(1);
        if ((++sp & 255u) == 0u) { if (xb_ld(&bar[XB_TMO])) break; if (sp > XB_SPIN_CAP) { atomicAdd(&bar[XB_TMO], 1u); break; } }
    }
    nloc = mine > 0u ? mine : 1u; nx = cnt > 0u ? cnt : 1u;
}

__device__ __forceinline__ void xcd_barrier(const XcdBarrier& b) {
    asm volatile("s_waitcnt vmcnt(0)" ::: "memory");
    __syncthreads();
    if (threadIdx.x == 0) {
        unsigned* bar = b.bar;
        __builtin_amdgcn_s_waitcnt(0);
        unsigned nloc = b.st[0], nx = b.st[1];
        if (nloc == 0u) { xcd_barrier_complete(bar, b.x, nloc, nx); b.st[0] = nloc; b.st[1] = nx; }
        const unsigned old = xb_add(&bar[XB_XSUB(b.x)], 1u);
        const unsigned gen = old / nloc;
        if (old + 1u == (gen + 1u) * nloc) {
            __builtin_amdgcn_fence(__ATOMIC_RELEASE, "agent");
            asm volatile("s_waitcnt vmcnt(0)" ::: "memory");
            const unsigned og = xb_add(&bar[XB_TOP], 1u);
            const unsigned tg = og / nx;
            if (og + 1u == (tg + 1u) * nx) xb_add(&bar[XB_TOPGEN], 1u);
            else XB_SPIN(xb_ld(&bar[XB_TOPGEN]) == tg, bar);
            __builtin_amdgcn_fence(__ATOMIC_ACQUIRE, "agent");
            xb_add(&bar[XB_XGEN(b.x)], 1u);
            asm volatile("s_waitcnt vmcnt(0)" ::: "memory");
        } else {
            XB_SPIN(xb_ld(&bar[XB_XGEN(b.x)]) == gen, bar);
            __builtin_amdgcn_fence(__ATOMIC_ACQUIRE, "agent");
            asm volatile("s_waitcnt vmcnt(0)" ::: "memory");
        }
    }
    __syncthreads();
}


template <int PH>
DEVI void run_phase(const Params& p, char* smem, int bid, int nb) {
  if (PH == 0) phase0(p, smem, bid, nb);
  if (PH == 1) phase1(p, smem, bid, nb);
  if (PH == 2) phase2(p, smem, bid, nb);
  if (PH == 3) phase3(p, smem, bid, nb);
  if (PH == 4) phase3b(p, bid, nb);
  if (PH == 5) phaseM(p, smem, bid, nb);
  if (PH == 6) phase3a(p, smem, bid, nb);
  if (PH == 7) phase3c(p, smem, bid, nb);
  if (PH == 8) phase5(p, smem, bid, nb);
  if (PH == 9) phase6x(p, smem, bid, nb);
  if (PH == 10) phase6(p, smem, bid, nb);
  if (PH == 11) phase6b(p, bid, nb);
  if (PH == 12) phase7(p, smem, bid, nb);
  if (PH == 13) phase8(p, bid, nb);
}

#ifndef REP_MASK
#define REP_MASK 0
#endif
template <int PH>
DEVI void mega_phase(const Params& p, char* smem, cg::grid_group& grid, int bid, int nb) {
  run_phase<PH>(p, smem, bid, nb);
  if ((REP_MASK >> PH) & 1) {
    grid.sync();
    run_phase<PH>(p, smem, bid, nb);
  }
}
__global__ void __launch_bounds__(512, 2) mega_kernel(Params pk) {
  const Params& p = *(const Params*)__builtin_amdgcn_kernarg_segment_ptr();
  extern __shared__ __attribute__((aligned(16))) char smem[];
  cg::grid_group grid = cg::this_grid();
  const int bid = blockIdx.x, nb = gridDim.x;
  volatile LAS unsigned* st = (volatile LAS unsigned*)(smem + SMEM_BYTES);
  if (threadIdx.x == 0) {
    st[0] = 0u;
    st[1] = 0u;
  }
  __syncthreads();
  (void)xcd_barrier_post(p.BAR, st);
#define XBAR() do { XcdBarrier xb_; xb_.bar = p.BAR; xb_.x = xb_xcc_id(); xb_.st = (volatile LAS unsigned*)(smem + SMEM_BYTES); xcd_barrier(xb_); } while (0)
  mega_phase<0>(p, smem, grid, bid, nb); grid.sync();
  mega_phase<1>(p, smem, grid, bid, nb); XBAR();
  mega_phase<2>(p, smem, grid, bid, nb); XBAR();
  mega_phase<3>(p, smem, grid, bid, nb); XBAR();
  mega_phase<4>(p, smem, grid, bid, nb); XBAR();
  mega_phase<5>(p, smem, grid, bid, nb); XBAR();
  mega_phase<6>(p, smem, grid, bid, nb); XBAR();
  mega_phase<7>(p, smem, grid, bid, nb); XBAR();
  mega_phase<8>(p, smem, grid, bid, nb); XBAR();
  mega_phase<9>(p, smem, grid, bid, nb); XBAR();
  mega_phase<10>(p, smem, grid, bid, nb); XBAR();
  mega_phase<11>(p, smem, grid, bid, nb); XBAR();
  mega_phase<12>(p, smem, grid, bid, nb); grid.sync();
  mega_phase<13>(p, smem, grid, bid, nb);
}

extern "C" void kernel_launch(void* const* d_in, const int* in_sizes, int n_in, void* d_out, int out_size, void* d_ws,
                              size_t ws_size, hipStream_t stream) {
  Params p{};
  const float** fp = (const float**)&p;
  for (int i = 0; i < 26; ++i) fp[i] = (const float*)d_in[i];
  p.out = (float*)d_out;
  char* w = (char*)d_ws;
  size_t off = 0;
  auto take = [&](size_t bytes) {
    char* r = w + off;
    off += (bytes + 255) & ~(size_t)255;
    return (bfu*)r;
  };
  p.WT_in = take((size_t)3584 * 1024 * 2);
  p.WT_out = take((size_t)1024 * 1024 * 2);
  p.WT_3 = take((size_t)4352 * 1024 * 2);
  p.WT_o = take((size_t)1024 * 1024 * 2);
  p.W2T = take((size_t)1024 * 64 * 2);
  p.A2T = take((size_t)1024 * 64 * 2);
  p.TW = take((size_t)T_TOK * 64 * 2);
  p.TA = take((size_t)T_TOK * 64 * 2);
  const size_t SLOT = (size_t)T_TOK * 1024 * 2;
  bfu* slot0 = take(SLOT);
  bfu* slots = take(6 * SLOT);
  p.H = slot0;
  p.AA = slot0;
  p.U = slots;
  p.GVT = slots + SLOT / 4;
  p.Q = slots + 2 * (SLOT / 4);
  p.K = slots + 3 * (SLOT / 4);
  p.VT = slots + 4 * (SLOT / 4);
  p.SZ = slots + 7 * (SLOT / 4);
  p.Y = slots + 9 * (SLOT / 4);
  p.R = slots;
  p.K1 = slots + 1 * (SLOT / 2);
  p.XV = slots + 2 * (SLOT / 2);
  p.XG = slots + 3 * (SLOT / 2);
  p.XR = slots + 4 * (SLOT / 2);
  p.XK = slots + 5 * (SLOT / 2);
  p.V1 = slots + 4 * (SLOT / 2);
  p.SG = slots + 5 * (SLOT / 2);
  p.EW = slots + 2 * (SLOT / 2);
  p.YS = slots + 3 * (SLOT / 2);
  p.G15 = (float*)p.TW;
  p.GT = p.WT_in;
  p.MRT = take((size_t)(SEQ / 16) * 32 * 512 * 2);
  p.COEF = (float*)take((size_t)T_TOK * 16 * 4);
  p.BAR = (unsigned*)take((size_t)XCD_BAR_WORDS * 4);
  if (off > ws_size) {
    fprintf(stderr, "workspace too small: need %zu have %zu\n", off, ws_size);
    return;
  }
  static int grid_blocks = 0;
  if (!grid_blocks) {
    int dev = 0, cus = 0, per_cu = 0;
    (void)hipGetDevice(&dev);
    (void)hipDeviceGetAttribute(&cus, hipDeviceAttributeMultiprocessorCount, dev);
    (void)hipFuncSetAttribute((const void*)mega_kernel, hipFuncAttributeMaxDynamicSharedMemorySize, SMEM_BYTES + 16);
    (void)hipOccupancyMaxActiveBlocksPerMultiprocessor(&per_cu, mega_kernel, 512, SMEM_BYTES + 16);
    grid_blocks = cus * per_cu;
  }
  (void)hipMemsetAsync(p.BAR, 0, (size_t)XCD_BAR_WORDS * 4, stream);
  void* args[] = {&p};
  hipError_t e = hipLaunchCooperativeKernel((void*)mega_kernel, dim3(grid_blocks), dim3(512), args, SMEM_BYTES + 16, stream);
  if (e != hipSuccess) fprintf(stderr, "cooperative launch failed: %s (grid %d)\n", hipGetErrorString(e), grid_blocks);
}
```

```cpp
#include <hip/hip_runtime.h>
#include <hip/hip_cooperative_groups.h>
#include <stdint.h>
#include <cstdio>
namespace cg = cooperative_groups;

#ifndef MEGA
#define MEGA 1
#endif

typedef unsigned short bfu;
using bf16x8 = __attribute__((ext_vector_type(8))) short;
using f32x4 = __attribute__((ext_vector_type(4))) float;
#define DEVI __device__ __forceinline__
#define TIDX ((int)(threadIdx.x & 255))
#define HF ((int)(threadIdx.x >> 8))

constexpr int GSTAGE_BYTES = 2 * 128 * 72 * 2;
constexpr int T_TOK = 32768;
constexpr int SEQ = 16384;
constexpr int HALF_SMEM = 2 * GSTAGE_BYTES + 4096 + 512;
constexpr int SMEM_BYTES = 2 * HALF_SMEM;
constexpr int SMEM_UNUSED_ = 0;

struct Params {
  const float *x, *ln_even, *w_in, *gm_norm, *gm_ws, *gm_b, *w_out, *ln_odd, *mu, *wr, *wk, *wv, *wg, *w0, *w1, *w2,
      *a0, *a1, *a2, *k_k, *k_a, *r_k, *lnw, *lnb, *wo, *fnorm;
  float* out;
  bfu *WT_in, *WT_out, *WT_3, *WT_o, *W2T, *A2T;
  bfu *H, *U, *GVT, *Q, *K, *VT, *SZ, *Y, *R, *K1, *V1, *SG, *EW, *AA, *YS, *TW, *TA, *GT, *MRT, *XR, *XK, *XV, *XG;
  float *G15, *COEF;
  unsigned* BAR;
};

DEVI float bf2f(unsigned b) { return __uint_as_float(b << 16); }
DEVI unsigned f2bf(float x) {
  const __bf16 h = (__bf16)x;
  return (unsigned)__builtin_bit_cast(unsigned short, h);
}
typedef __bf16 bf16x2_t __attribute__((ext_vector_type(2)));
typedef float float2_t __attribute__((ext_vector_type(2)));
DEVI unsigned pkbf(float a, float b) {
  const float2_t f = {a, b};
  const bf16x2_t h = __builtin_convertvector(f, bf16x2_t);
  return __builtin_bit_cast(unsigned, h);
}
DEVI void unpack8(uint4 v, float* f) {
  f[0] = __uint_as_float(v.x << 16); f[1] = __uint_as_float(v.x & 0xffff0000u);
  f[2] = __uint_as_float(v.y << 16); f[3] = __uint_as_float(v.y & 0xffff0000u);
  f[4] = __uint_as_float(v.z << 16); f[5] = __uint_as_float(v.z & 0xffff0000u);
  f[6] = __uint_as_float(v.w << 16); f[7] = __uint_as_float(v.w & 0xffff0000u);
}
DEVI uint4 pack8(const float* f) {
  uint4 r;
  r.x = pkbf(f[0], f[1]);
  r.y = pkbf(f[2], f[3]);
  r.z = pkbf(f[4], f[5]);
  r.w = pkbf(f[6], f[7]);
  return r;
}
DEVI void unpack4(uint2 v, float* f) {
  f[0] = __uint_as_float(v.x << 16); f[1] = __uint_as_float(v.x & 0xffff0000u);
  f[2] = __uint_as_float(v.y << 16); f[3] = __uint_as_float(v.y & 0xffff0000u);
}
DEVI uint2 pack4(const float* f) {
  uint2 r;
  r.x = pkbf(f[0], f[1]);
  r.y = pkbf(f[2], f[3]);
  return r;
}

DEVI float sigmoid_(float x) { return __builtin_amdgcn_rcpf(1.f + __expf(-x)); }
DEVI float silu_(float x) { return x * sigmoid_(x); }
DEVI float tanh_(float y) { return 1.f - 2.f * __builtin_amdgcn_rcpf(1.f + __expf(2.f * y)); }
DEVI float gelu_(float x) {
  const float y = 0.7978845608028654f * (x + 0.044715f * x * x * x);
  return x * __builtin_amdgcn_rcpf(1.f + __expf(-2.f * y));
}
DEVI float wave_sum(float v) {
#pragma unroll
  for (int o = 32; o > 0; o >>= 1) v += __shfl_xor(v, o);
  return v;
}
DEVI float wave_max(float v) {
#pragma unroll
  for (int o = 32; o > 0; o >>= 1) v = fmaxf(v, __shfl_xor(v, o));
  return v;
}
template <int CTRL>
DEVI float dppf(float x) {
  return __int_as_float(__builtin_amdgcn_update_dpp(0, __float_as_int(x), CTRL, 0xF, 0xF, true));
}
DEVI float reduce16(float x) {
  x += dppf<0xB1>(x);
  x += dppf<0x4E>(x);
  x += dppf<0x141>(x);
  x += dppf<0x140>(x);
  return x;
}

constexpr int LROW = 72;
constexpr int GSTAGE = 2 * 128 * LROW;

template <int DIST = 2, bool SW = true, class ALoad, class Epi>
DEVI void gemm_tile(char* smem, const ALoad& aload, const bfu* __restrict__ Bt, int ldb, int K, int m0, int n0,
                    const Epi& epi) {
  bfu* sbase = (bfu*)smem;
  const int tid = TIDX, lane = tid & 63, wid = tid >> 6, wr = wid >> 1, wc = wid & 1;
  const int fr = lane & 15, fq = lane >> 4;
  f32x4 acc[4][4];
#pragma unroll
  for (int i = 0; i < 4; ++i)
#pragma unroll
    for (int j = 0; j < 4; ++j) acc[i][j] = f32x4{0.f, 0.f, 0.f, 0.f};
  const int r0 = tid >> 3, kc = (tid & 7) * 8;
  const int nk = K >> 6;
  struct GRegs { typename ALoad::Raw a0, a1, a2, a3; uint4 ap, b0, b1, b2, b3; };
  GRegs g0, g1;
  const bfu* Bp = Bt + (size_t)(n0 + r0) * ldb + kc;
  const size_t ldb32 = (size_t)ldb * 32;
  constexpr int ARS = ALoad::kConsec ? 1 : 32;
  const int ar0 = ALoad::kConsec ? 4 * r0 : r0;
#define GEMM_ISSUE(R, KT)                                   \
  {                                                         \
    const int k0_ = ((KT) << 6);                            \
    R.ap = aload.loadprev(m0 + ar0, k0_ + kc);              \
    R.a0 = aload.load(m0 + ar0, k0_ + kc);                  \
    R.a1 = aload.load(m0 + ar0 + ARS, k0_ + kc);            \
    R.a2 = aload.load(m0 + ar0 + 2 * ARS, k0_ + kc);        \
    R.a3 = aload.load(m0 + ar0 + 3 * ARS, k0_ + kc);        \
    R.b0 = *(const uint4*)(Bp + k0_);                       \
    R.b1 = *(const uint4*)(Bp + ldb32 + k0_);               \
    R.b2 = *(const uint4*)(Bp + 2 * ldb32 + k0_);           \
    R.b3 = *(const uint4*)(Bp + 3 * ldb32 + k0_);           \
  }
#define GEMM_COMMIT(R, S, KT)                               \
  {                                                         \
    const int k1_ = ((KT) << 6) + kc;                       \
    bfu* A_ = sbase + (S) * GSTAGE + ar0 * LROW + kc;       \
    bfu* B_ = sbase + (S) * GSTAGE + 128 * LROW + r0 * LROW + kc;   \
    *(uint4*)(A_) = aload.finish(R.a0, R.ap, m0 + ar0, k1_);                                 \
    *(uint4*)(A_ + ARS * LROW) = aload.finish(R.a1, aload.asprev(R.a0), m0 + ar0 + ARS, k1_);          \
    *(uint4*)(A_ + 2 * ARS * LROW) = aload.finish(R.a2, aload.asprev(R.a1), m0 + ar0 + 2 * ARS, k1_);  \
    *(uint4*)(A_ + 3 * ARS * LROW) = aload.finish(R.a3, aload.asprev(R.a2), m0 + ar0 + 3 * ARS, k1_);  \
    *(uint4*)(B_) = R.b0;                                   \
    *(uint4*)(B_ + 32 * LROW) = R.b1;                       \
    *(uint4*)(B_ + 64 * LROW) = R.b2;                       \
    *(uint4*)(B_ + 96 * LROW) = R.b3;                       \
  }
#define GEMM_COMPUTE(S)                                                                          \
  {                                                                                              \
    const bfu* cA = sbase + (S) * GSTAGE;                                                        \
    const bfu* cB = cA + 128 * LROW;                                                             \
    _Pragma("unroll") for (int ks = 0; ks < 2; ++ks) {                                           \
      bf16x8 af[4], bfv[4];                                                                      \
      _Pragma("unroll") for (int i = 0; i < 4; ++i) {                                            \
        af[i] = *(const bf16x8*)(cA + (wr * 64 + i * 16 + fr) * LROW + ks * 32 + fq * 8);        \
        bfv[i] = *(const bf16x8*)(cB + (wc * 64 + i * 16 + fr) * LROW + ks * 32 + fq * 8);       \
      }                                                                                          \
      _Pragma("unroll") for (int i = 0; i < 4; ++i) _Pragma("unroll") for (int j = 0; j < 4; ++j) \
          acc[i][j] = SW ? __builtin_amdgcn_mfma_f32_16x16x32_bf16(bfv[j], af[i], acc[i][j], 0, 0, 0)     \
                         : __builtin_amdgcn_mfma_f32_16x16x32_bf16(af[i], bfv[j], acc[i][j], 0, 0, 0);    \
    }                                                                                            \
  }
  const int nkm1 = nk - 1;
  if (DIST == 2 && nk == 1) {
    GEMM_ISSUE(g0, 0);
    GEMM_COMMIT(g0, 0, 0);
    __syncthreads();
    GEMM_COMPUTE(0);
    __syncthreads();
  } else if (DIST == 2) {
    GEMM_ISSUE(g0, 0);
    GEMM_ISSUE(g1, (1 < nkm1 ? 1 : nkm1));
    GEMM_COMMIT(g0, 0, 0);
    GEMM_ISSUE(g0, (2 < nkm1 ? 2 : nkm1));
    __syncthreads();
    {
      for (int kt = 0; kt < nk; kt += 2) {
        GEMM_COMMIT(g1, 1, (kt + 1 < nkm1 ? kt + 1 : nkm1));
        GEMM_ISSUE(g1, (kt + 3 < nkm1 ? kt + 3 : nkm1));
        GEMM_COMPUTE(0);
        __syncthreads();
        GEMM_COMMIT(g0, 0, (kt + 2 < nkm1 ? kt + 2 : nkm1));
        GEMM_ISSUE(g0, (kt + 4 < nkm1 ? kt + 4 : nkm1));
        GEMM_COMPUTE(1);
        __syncthreads();
      }
    }
  } else {
    GEMM_ISSUE(g0, 0);
    GEMM_COMMIT(g0, 0, 0);
    GEMM_ISSUE(g0, (1 < nkm1 ? 1 : nkm1));
    __syncthreads();
    for (int kt = 0; kt < nk; kt += 2) {
      GEMM_COMMIT(g0, 1, (kt + 1 < nkm1 ? kt + 1 : nkm1));
      GEMM_ISSUE(g0, (kt + 2 < nkm1 ? kt + 2 : nkm1));
      GEMM_COMPUTE(0);
      __syncthreads();
      GEMM_COMMIT(g0, 0, (kt + 2 < nkm1 ? kt + 2 : nkm1));
      GEMM_ISSUE(g0, (kt + 3 < nkm1 ? kt + 3 : nkm1));
      GEMM_COMPUTE(1);
      __syncthreads();
    }
  }
#pragma unroll
  for (int i = 0; i < 4; ++i)
#pragma unroll
    for (int j = 0; j < 4; ++j) {
      if (SW) epi(m0 + wr * 64 + i * 16 + fr, n0 + wc * 64 + j * 16 + fq * 4, acc[i][j]);
      else epi(m0 + wr * 64 + i * 16 + fq * 4, n0 + wc * 64 + j * 16 + fr, acc[i][j]);
    }
}

namespace pg8 {
#define PG8_LAS __attribute__((address_space(3)))
typedef unsigned short bf16_t;
typedef short bf16x8 __attribute__((ext_vector_type(8)));
typedef float f32x4 __attribute__((ext_vector_type(4)));
typedef unsigned u32x4 __attribute__((ext_vector_type(4)));
constexpr int BM = 256, BK = 64, HALF = 128, HTB = HALF * BK * 2  , STAGE_BYTES = 8 * HTB, NXCD = 8, WGM = 8;

__host__ __device__ __forceinline__ int lds_byte(int r, int c) { const int st = (r >> 4) * 2 + (c >> 5), rr = r & 15, cc = c & 31, ob = rr * 64 + cc * 2; return st * 1024 + (ob ^ (((ob >> 9) & 1) << 5)); }
__host__ __device__ __forceinline__ void stage_rc(int b, int& R, int& C) { const int st = b / 1024, sb = b % 1024, swz = sb ^ (((sb >> 9) & 1) << 5); R = (st >> 1) * 16 + swz / 64; C = (st & 1) * 32 + (swz % 64) / 2; }
__host__ __device__ __forceinline__ int perm32(int rho) { const int n = rho >> 4, i = rho & 15; return 8 * (i >> 2) + 4 * n + (i & 3); }

struct Unit { int pm, pn; };
struct Gemm { const bf16_t* A; const bf16_t* Bt; int M, N, K; const bf16_t* A2; int pn_split; unsigned long long rmap, cmap;
  __device__ __forceinline__ size_t rt(int pm) const { return rmap ? (size_t)((rmap >> (4 * pm)) & 15ull) : (size_t)pm; }
  __device__ __forceinline__ size_t ct(int pn) const { return cmap ? (size_t)((cmap >> (4 * pn)) & 15ull) : (size_t)pn; } };

struct StaticOrder {
    int nM, nN, nwg, G, c;
    __host__ __device__ void init(int M, int N, int G_, int c_) { nM = M / BM; nN = N / BM; nwg = nM * nN; G = G_; c = c_; }
    __host__ __device__ bool next(int i, Unit& u) const {
        const long L = (long)i * G + c; if (L >= nwg) return false;
        int wgid = (int)L; { const int q = nwg / NXCD, r = nwg % NXCD, xcd = wgid % NXCD, off = wgid / NXCD; wgid = (xcd < r ? xcd * (q + 1) : r * (q + 1) + (xcd - r) * q) + off; }
        const int nig = WGM * nN, gid = wgid / nig, fm = gid * WGM, gsz = (nM - fm) < WGM ? (nM - fm) : WGM;
        u.pm = fm + ((wgid % nig) % gsz); u.pn = (wgid % nig) / gsz; return true;
    }
    __device__ __forceinline__ void a_ready(const Unit&) const {}
    __device__ __forceinline__ void done(const Unit&) const {}
};
struct CountedOrder : StaticOrder {
    const unsigned* ready; unsigned need; unsigned* tmo;
    __device__ __forceinline__ void a_ready(const Unit& u) const {
        if (threadIdx.x < 64) {
            const unsigned long long t0 = __builtin_amdgcn_s_memrealtime(); unsigned polls = 0;
            while ((unsigned)__builtin_amdgcn_readfirstlane(__hip_atomic_load(ready + 64 * u.pm, __ATOMIC_RELAXED, __HIP_MEMORY_SCOPE_AGENT)) < need) {
                if ((++polls & 255u) == 0u && __builtin_amdgcn_readfirstlane(__hip_atomic_load(tmo, __ATOMIC_RELAXED, __HIP_MEMORY_SCOPE_AGENT)) != 0u) break;
                if (__builtin_amdgcn_s_memrealtime() - t0 > 2000000ull) {
                    if (threadIdx.x == 0) { unsigned expect = 0u; __hip_atomic_compare_exchange_strong(tmo + 1, &expect, 0x600u | (unsigned)(u.pm & 0xff), __ATOMIC_RELAXED, __ATOMIC_RELAXED, __HIP_MEMORY_SCOPE_AGENT); __hip_atomic_store(tmo, 1u, __ATOMIC_RELAXED, __HIP_MEMORY_SCOPE_AGENT); }
                    break; }
                __builtin_amdgcn_s_sleep(2); }
            __builtin_amdgcn_fence(__ATOMIC_ACQUIRE, "agent");
            asm volatile("s_waitcnt vmcnt(0)" ::: "memory");
        }
#if !defined(BROKEN_HOOK_NO_BARRIER)
        asm volatile("" ::: "memory"); __builtin_amdgcn_s_barrier(); asm volatile("" ::: "memory");
#endif
    }
};

__device__ __forceinline__ unsigned cvt_pk_bf16(float lo, float hi) { unsigned r; asm volatile("v_cvt_pk_bf16_f32 %0, %1, %2" : "=v"(r) : "v"(lo), "v"(hi)); return r; }
typedef float f32x2 __attribute__((ext_vector_type(2)));
__device__ __forceinline__ f32x2 gelu_pk(f32x2 v) {
    const f32x2 av = __builtin_elementwise_abs(v), d = av * 0.2316418882f + 1.0f;
    f32x2 t; t.x = __builtin_amdgcn_rcpf(d.x); t.y = __builtin_amdgcn_rcpf(d.y);
    f32x2 q = t * 0.5307027145f + (-0.7265760135f); q = q * t + 0.7107068705f; q = q * t + (-0.142248368f); q = q * t + 0.127414796f; q = q * t;
    const f32x2 s = (v * v) * (-0.72134752044f);
    f32x2 e; e.x = __builtin_amdgcn_exp2f(s.x); e.y = __builtin_amdgcn_exp2f(s.y);
    const f32x2 m = v * (q * e), r = v - m;
    f32x2 o; o.x = v.x < 0.f ? m.x : r.x; o.y = v.y < 0.f ? m.y : r.y; return o;
}

struct EpiF32 {
    static constexpr bool PERM = false, AFTER_DRAIN = false;
    float* C; int ldc; const float* bias;
    __device__ __forceinline__ void operator()(const f32x4 (&acc)[2][2][4][2], const Unit& u, int wr, int wc, int fr, int fq) const {
        const int row0 = u.pm * BM + wr * 64 + fr, col0 = u.pn * BM + wc * 32 + 4 * fq;
        f32x4 bv[2][2];
#pragma unroll
        for (int bj = 0; bj < 2; ++bj)
#pragma unroll
            for (int n = 0; n < 2; ++n) bv[bj][n] = bias ? *(const f32x4*)(bias + col0 + bj * HALF + n * 16) : (f32x4){0.f, 0.f, 0.f, 0.f};
#pragma unroll
        for (int ai = 0; ai < 2; ++ai)
#pragma unroll
            for (int m = 0; m < 4; ++m) { float* rowp = C + (size_t)(row0 + ai * HALF + m * 16) * ldc + col0;
#pragma unroll
                for (int bj = 0; bj < 2; ++bj)
#pragma unroll
                    for (int n = 0; n < 2; ++n) *(f32x4*)(rowp + bj * HALF + n * 16) = acc[ai][bj][m][n] + bv[bj][n]; }
    }
};
template <int ACT  > struct EpiBf16 {
    static constexpr bool PERM = true, AFTER_DRAIN = false;
    bf16_t* O; int ldc; const float* bias; int split_cols; size_t split_stride;
    __device__ __forceinline__ void operator()(const f32x4 (&acc)[2][2][4][2], const Unit& u, int wr, int wc, int fr, int fq) const {
        const int row0 = u.pm * BM + wr * 64 + fr; int colt = u.pn * BM; bf16_t* base = O;
        if (split_cols) { const int t = colt / split_cols; base += (size_t)t * split_stride; colt -= t * split_cols; }
        const int col0 = colt + wc * 32 + 8 * fq, bcol0 = u.pn * BM + wc * 32 + 8 * fq;
        f32x4 bv[2][2];
#pragma unroll
        for (int bj = 0; bj < 2; ++bj)
#pragma unroll
            for (int n = 0; n < 2; ++n) bv[bj][n] = bias ? *(const f32x4*)(bias + bcol0 + bj * HALF + 4 * n) : (f32x4){0.f, 0.f, 0.f, 0.f};
#pragma unroll
        for (int ai = 0; ai < 2; ++ai)
#pragma unroll
            for (int m = 0; m < 4; ++m) { bf16_t* rowp = base + (size_t)(row0 + ai * HALF + m * 16) * ldc + col0;
#pragma unroll
                for (int bj = 0; bj < 2; ++bj) { f32x4 v0 = acc[ai][bj][m][0] + bv[bj][0], v1 = acc[ai][bj][m][1] + bv[bj][1];
                    if (ACT == 1) { f32x2 a = gelu_pk((f32x2){v0[0], v0[1]}), b = gelu_pk((f32x2){v0[2], v0[3]}), c = gelu_pk((f32x2){v1[0], v1[1]}), d = gelu_pk((f32x2){v1[2], v1[3]});
                        v0 = (f32x4){a.x, a.y, b.x, b.y}; v1 = (f32x4){c.x, c.y, d.x, d.y}; }
                    if (ACT == 2) {
#pragma unroll
                        for (int j = 0; j < 4; ++j) { v0[j] = 0.5f * v0[j] * (1.0f + erff(v0[j] * 0.70710678f)); v1[j] = 0.5f * v1[j] * (1.0f + erff(v1[j] * 0.70710678f)); } }
                    u32x4 w; w.x = cvt_pk_bf16(v0[0], v0[1]); w.y = cvt_pk_bf16(v0[2], v0[3]); w.z = cvt_pk_bf16(v1[0], v1[1]); w.w = cvt_pk_bf16(v1[2], v1[3]);
                    *(u32x4*)(rowp + bj * HALF) = w; } }
    }
};


template <class Epi, class Sched, bool STAMP = false>
__device__ __forceinline__ void gemm_phase(PG8_LAS unsigned char* lds, const Gemm g, const Sched& S, const Epi& E, unsigned long long* stamps) {
    const int tid = threadIdx.x, wid = __builtin_amdgcn_readfirstlane(tid >> 6), lane = tid & 63, wr = wid >> 2, wc = wid & 3, fr = lane & 15, fq = lane >> 4;
    const int K = g.K, nt = K / BK;
    int ts_lo = 0, ts_hi = 0, nts = 0; const unsigned long long rt_entry = STAMP ? (unsigned long long)wall_clock64() : 0ull;
#define PG8_STAMP() do { if (STAMP && wid == 0 && nts < 64) { const unsigned long long _c = (unsigned long long)clock64(); \
        ts_lo = (lane == nts) ? (int)(unsigned)_c : ts_lo; ts_hi = (lane == nts) ? (int)(unsigned)(_c >> 32) : ts_hi; ++nts; } } while (0)
    PG8_STAMP();
    unsigned voffA[2], voffB[2];
#pragma unroll
    for (int i = 0; i < 2; ++i) { int R, C; stage_rc(tid * 16 + i * 8192, R, C); const int Rb = Epi::PERM ? ((R & ~31) + perm32(R & 31)) : R;
        voffA[i] = (unsigned)(R * K + C) * 2u; voffB[i] = (unsigned)(Rb * K + C) * 2u; }
    const size_t kstep = (size_t)(BK * 2);
    const size_t hstep = (size_t)HALF * K * 2;
    const size_t tstep = 2 * hstep;
    const unsigned ldsw = (unsigned)wid * 1024u;
    const int aoff = lds_byte(wr * 64 + fr, fq * 8), boff = lds_byte(wc * 32 + fr, fq * 8);
#define PG8_SA(b, h) (((b) * 2 + (h)) * HTB)
#define PG8_SB(b, h) ((4 + (b) * 2 + (h)) * HTB)
#define PG8_STAGE(bufoff, gbase, voff) do { _Pragma("unroll") for (int _i = 0; _i < 2; ++_i) \
        __builtin_amdgcn_global_load_lds((const unsigned*)((const char*)(gbase) + (voff)[_i]), (PG8_LAS unsigned*)(lds + (bufoff) + ldsw + _i * 8192), 16, 0, 0); } while (0)
#define PG8_LDA(dst, b, h) do { _Pragma("unroll") for (int m = 0; m < 4; ++m) _Pragma("unroll") for (int k = 0; k < 2; ++k) dst[m][k] = *(const PG8_LAS bf16x8*)(lds + PG8_SA(b, h) + aoff + m * 2048 + k * 1024); } while (0)
#define PG8_LDB(dst, b, h) do { _Pragma("unroll") for (int n = 0; n < 2; ++n) _Pragma("unroll") for (int k = 0; k < 2; ++k) dst[n][k] = *(const PG8_LAS bf16x8*)(lds + PG8_SB(b, h) + boff + n * 2048 + k * 1024); } while (0)
#define PG8_MMA(ai, bj, At, Bt) do { __builtin_amdgcn_s_setprio(1); _Pragma("unroll") for (int m = 0; m < 4; ++m) _Pragma("unroll") for (int n = 0; n < 2; ++n) _Pragma("unroll") for (int k = 0; k < 2; ++k) \
        acc[ai][bj][m][n] = __builtin_amdgcn_mfma_f32_16x16x32_bf16(Bt[n][k], At[m][k], acc[ai][bj][m][n], 0, 0, 0); __builtin_amdgcn_s_setprio(0); } while (0)
#define PG8_WAIT_V(n) asm volatile("s_waitcnt vmcnt(" #n ")" ::: "memory")
#define PG8_WAIT_L(n) asm volatile("s_waitcnt lgkmcnt(" #n ")" ::: "memory")
#define PG8_BAR __builtin_amdgcn_s_barrier()
#define PG8_SCHED __builtin_amdgcn_sched_barrier(0)
    Unit cur, nxt; int ui = 0;
    if (!S.next(0, cur)) return;
    f32x4 acc[2][2][4][2];
#pragma unroll
    for (int a = 0; a < 2; ++a)
#pragma unroll
        for (int b = 0; b < 2; ++b)
#pragma unroll
            for (int m = 0; m < 4; ++m)
#pragma unroll
                for (int n = 0; n < 2; ++n) acc[a][b][m][n] = (f32x4){0.f, 0.f, 0.f, 0.f};
    bf16x8 At[4][2], B0[2][2], B1[2][2];
    const char* cA = (const char*)(cur.pn >= g.pn_split ? g.A2 : g.A) + g.rt(cur.pm) * tstep; const char* cB = (const char*)g.Bt + g.ct(cur.pn) * tstep;
    S.a_ready(cur);
    PG8_STAGE(PG8_SB(0, 0), cB, voffB); PG8_STAGE(PG8_SA(0, 0), cA, voffA); PG8_STAGE(PG8_SB(0, 1), cB + hstep, voffB); PG8_STAGE(PG8_SA(0, 1), cA + hstep, voffA);
    if (wr == 1) PG8_BAR;
    PG8_WAIT_V(4); PG8_BAR;
    PG8_STAGE(PG8_SB(1, 0), cB + kstep, voffB); PG8_STAGE(PG8_SA(1, 0), cA + kstep, voffA); PG8_STAGE(PG8_SB(1, 1), cB + hstep + kstep, voffB);
    PG8_WAIT_V(6); PG8_BAR;
    PG8_STAMP();
    for (;;) {
        const bool has_next = S.next(ui + 1, nxt);
        const char* nA = has_next ? (const char*)(nxt.pn >= g.pn_split ? g.A2 : g.A) + g.rt(nxt.pm) * tstep : cA; const char* nB = has_next ? (const char*)g.Bt + g.ct(nxt.pn) * tstep : cB;
        for (int t = 0; t < nt; t += 2) {
            const bool last = (t == nt - 2);
            const char* a1 = cA + (size_t)(t + 1) * kstep;
            const char* a2 = last ? nA : cA + (size_t)(t + 2) * kstep; const char* b2 = last ? nB : cB + (size_t)(t + 2) * kstep;
            const char* a3 = a2 + kstep; const char* b3 = b2 + kstep;
            if (last && has_next) S.a_ready(nxt);
            PG8_LDB(B0, 0, 0); PG8_SCHED; PG8_LDA(At, 0, 0); PG8_STAGE(PG8_SA(1, 1), a1 + hstep, voffA);
            PG8_WAIT_L(8); PG8_BAR; PG8_WAIT_L(0); PG8_MMA(0, 0, At, B0); PG8_BAR; PG8_SCHED;
            PG8_LDB(B1, 0, 1); PG8_STAGE(PG8_SB(0, 0), b2, voffB);
            PG8_BAR; PG8_WAIT_L(0); PG8_MMA(0, 1, At, B1); PG8_BAR;
            PG8_LDA(At, 0, 1); PG8_STAGE(PG8_SA(0, 0), a2, voffA);
            PG8_BAR; PG8_WAIT_L(0); PG8_MMA(1, 0, At, B0); PG8_BAR; PG8_SCHED;
            PG8_STAGE(PG8_SB(0, 1), b2 + hstep, voffB);
            PG8_WAIT_V(6); PG8_BAR; PG8_MMA(1, 1, At, B1); PG8_BAR;
            PG8_LDB(B0, 1, 0); PG8_SCHED; PG8_LDA(At, 1, 0); PG8_STAGE(PG8_SA(0, 1), a2 + hstep, voffA);
            PG8_WAIT_L(8); PG8_BAR; PG8_WAIT_L(0); PG8_MMA(0, 0, At, B0); PG8_BAR; PG8_SCHED;
            PG8_LDB(B1, 1, 1); PG8_STAGE(PG8_SB(1, 0), b3, voffB);
            PG8_BAR; PG8_WAIT_L(0); PG8_MMA(0, 1, At, B1); PG8_BAR;
            PG8_LDA(At, 1, 1); PG8_STAGE(PG8_SA(1, 0), a3, voffA);
            PG8_BAR; PG8_WAIT_L(0); PG8_MMA(1, 0, At, B0); PG8_BAR; PG8_SCHED;
            PG8_STAGE(PG8_SB(1, 1), b3 + hstep, voffB);
            PG8_WAIT_V(6); PG8_BAR; PG8_MMA(1, 1, At, B1); PG8_BAR;
        }
        PG8_STAMP();
        if constexpr (!Epi::AFTER_DRAIN) { E(acc, cur, wr, wc, fr, fq); S.done(cur); }
        PG8_STAMP();
        if (!has_next) break;
#pragma unroll
        for (int a = 0; a < 2; ++a)
#pragma unroll
            for (int b = 0; b < 2; ++b)
#pragma unroll
                for (int m = 0; m < 4; ++m)
#pragma unroll
                    for (int n = 0; n < 2; ++n) acc[a][b][m][n] = (f32x4){0.f, 0.f, 0.f, 0.f};
        cur = nxt; cA = nA; cB = nB; ++ui;
    }
    PG8_WAIT_V(0);
    if (wr == 0) PG8_BAR;
    PG8_BAR;
    if constexpr (Epi::AFTER_DRAIN) { E.fused(acc, cur, wr, wc, fr, fq, lds, wid, lane); S.done(cur); }
    PG8_STAMP();
    if (STAMP && wid == 0) { stamps[lane] = lane < nts ? (((unsigned long long)(unsigned)ts_hi << 32) | (unsigned)ts_lo) : 0ull;
        if (lane == 62) stamps[62] = rt_entry; if (lane == 63) stamps[63] = (unsigned long long)wall_clock64(); }
#undef PG8_STAMP
#undef PG8_SA
#undef PG8_SB
#undef PG8_STAGE
#undef PG8_LDA
#undef PG8_LDB
#undef PG8_MMA
#undef PG8_WAIT_V
#undef PG8_WAIT_L
#undef PG8_BAR
#undef PG8_SCHED
}
}

struct TileSched {
  int xcd, local, vbid, vnb, MT, NT, SM, SN, j, snc;
  bool swz;
  DEVI TileSched(int bid, int nb, int half, int MT_, int NT_, int SM_, int SN_) : MT(MT_), NT(NT_), SM(SM_), SN(SN_), j(0) {
    xcd = bid & 7;
    local = (bid >> 3) * 2 + half;
    vbid = bid * 2 + half;
    vnb = nb * 2;
    swz = (vnb == 8 * SM * SN) && ((nb & 7) == 0);
    snc = (NT + SN - 1) / SN;
  }
  DEVI int next(int& mt, int& nt) {
    if (swz) {
      const int s = j * 8 + xcd;
      ++j;
      const int sm = s / snc, sn = s - sm * snc;
      if (sm * SM >= MT) return 0;
      mt = sm * SM + local / SN;
      nt = sn * SN + local % SN;
      return (mt < MT && nt < NT) ? 1 : 2;
    } else {
      const int it = vbid + j * vnb;
      ++j;
      if (it >= MT * NT) return 0;
      mt = it / NT;
      nt = it - mt * NT;
      return 1;
    }
  }
};

struct ALoadPlain {
  typedef uint4 Raw;
  static constexpr bool kFat = false;
  static constexpr bool kConsec = false;
  const bfu* A;
  int lda;
  DEVI Raw load(int row, int k) const { return *(const uint4*)(A + (size_t)row * lda + k); }
  DEVI uint4 loadprev(int, int) const { return uint4{0u, 0u, 0u, 0u}; }
  DEVI uint4 asprev(const Raw&) const { return uint4{0u, 0u, 0u, 0u}; }
  DEVI uint4 finish(const Raw& r, const uint4&, int, int) const { return r; }
};

DEVI void transpose_tile(char* smem, const float* __restrict__ src, int Ns, bfu* __restrict__ dst, int ldd, int noff,
                         int k0, int n0) {
  float(*tile)[65] = (float(*)[65])smem;
  const int tid = TIDX;
  const int kr = tid >> 4, nc = (tid & 15) * 4;
#pragma unroll
  for (int p = 0; p < 4; ++p) {
    float4 v = *(const float4*)(src + (size_t)(k0 + kr + 16 * p) * Ns + n0 + nc);
    tile[kr + 16 * p][nc] = v.x;
    tile[kr + 16 * p][nc + 1] = v.y;
    tile[kr + 16 * p][nc + 2] = v.z;
    tile[kr + 16 * p][nc + 3] = v.w;
  }
  __syncthreads();
  const int nr = tid >> 3, kc = (tid & 7) * 8;
#pragma unroll
  for (int p = 0; p < 2; ++p) {
    const int n = nr + 32 * p;
    float f[8];
#pragma unroll
    for (int j = 0; j < 8; ++j) f[j] = tile[kc + j][n];
    *(uint4*)(dst + (size_t)(noff + n0 + n) * ldd + k0 + kc) = pack8(f);
  }
  __syncthreads();
}

DEVI void rms_row2_bf16(const float* __restrict__ src, const float* __restrict__ g, bfu* __restrict__ dst, int lane) {
  float4 v[2][4];
  float ss[2] = {0.f, 0.f};
#pragma unroll
  for (int r = 0; r < 2; ++r)
#pragma unroll
    for (int i = 0; i < 4; ++i) v[r][i] = *(const float4*)(src + r * 1024 + lane * 4 + 256 * i);
#pragma unroll
  for (int r = 0; r < 2; ++r)
#pragma unroll
    for (int i = 0; i < 4; ++i)
      ss[r] += v[r][i].x * v[r][i].x + v[r][i].y * v[r][i].y + v[r][i].z * v[r][i].z + v[r][i].w * v[r][i].w;
#pragma unroll
  for (int r = 0; r < 2; ++r) {
    const float rinv = rsqrtf(wave_sum(ss[r]) * (1.f / 1024.f) + 1e-6f);
#pragma unroll
    for (int i = 0; i < 4; ++i) {
      const float4 gg = *(const float4*)(g + lane * 4 + 256 * i);
      uint2 o;
      o.x = pkbf(v[r][i].x * rinv * gg.x, v[r][i].y * rinv * gg.y);
      o.y = pkbf(v[r][i].z * rinv * gg.z, v[r][i].w * rinv * gg.w);
      *(uint2*)(dst + r * 1024 + lane * 4 + 256 * i) = o;
    }
  }
}

DEVI void phase0(const Params& p, char* smem, int bid, int nb) {
  constexpr int NT_IN = 16 * 56, NT_SQ = 256, NT_SM = 16;
  constexpr int c0 = NT_IN, c1 = c0 + NT_SQ, c2 = c1 + 4 * NT_SQ, c3 = c2 + NT_SM, c4 = c3 + NT_SM, c5 = c4 + NT_SQ,
                c6 = c5 + NT_SM, c7 = c6 + NT_SM, c8 = c7 + 2, c9 = c8 + T_TOK / 8;
  smem += HF * HALF_SMEM;
  for (int it = bid * 2 + HF; it < c9; it += nb * 2) {
    if (it < c0) {
      transpose_tile(smem, p.w_in, 3584, p.WT_in, 1024, 0, (it / 56) * 64, (it % 56) * 64);
    } else if (it < c1) {
      int j = it - c0;
      transpose_tile(smem, p.w_out, 1024, p.WT_out, 1024, 0, (j >> 4) * 64, (j & 15) * 64);
    } else if (it < c2) {
      int j = it - c1;
      int w = j >> 8;
      j &= 255;
      const float* src = (w == 0) ? p.wr : (w == 1) ? p.wk : (w == 2) ? p.wv : p.wg;
      transpose_tile(smem, src, 1024, p.WT_3, 1024, w * 1024, (j >> 4) * 64, (j & 15) * 64);
    } else if (it < c3) {
      int j = it - c2;
      transpose_tile(smem, p.w1, 64, p.WT_3, 1024, 4096, j * 64, 0);
    } else if (it < c4) {
      int j = it - c3;
      transpose_tile(smem, p.a1, 64, p.WT_3, 1024, 4224, j * 64, 0);
    } else if (it < c5) {
      int j = it - c4;
      transpose_tile(smem, p.wo, 1024, p.WT_o, 1024, 0, (j >> 4) * 64, (j & 15) * 64);
    } else if (it < c6) {
      int j = it - c5;
      transpose_tile(smem, p.w2, 1024, p.W2T, 64, 0, 0, j * 64);
    } else if (it < c7) {
      int j = it - c6;
      transpose_tile(smem, p.a2, 1024, p.A2T, 64, 0, 0, j * 64);
    } else if (it < c8) {
      int j = it - c7;
      bfu* dst = p.WT_3 + (size_t)(j == 0 ? 4160 : 4288) * 1024;
      for (int e = TIDX; e < 64 * 1024 / 8; e += 256) *(uint4*)(dst + e * 8) = uint4{0, 0, 0, 0};
    } else {
      int row = (it - c8) * 8 + (TIDX >> 6) * 2;
      rms_row2_bf16(p.x + (size_t)row * 1024, p.ln_even, p.H + (size_t)row * 1024, TIDX & 63);
    }
  }
}

constexpr unsigned long long kCmap1 = 0xDCBA765410ull;
struct PgEpi1 {
  static constexpr bool PERM = true, AFTER_DRAIN = false;
  const Params* p;
  DEVI void operator()(const pg8::f32x4 (&acc)[2][2][4][2], const pg8::Unit& u, int wr, int wc, int fr, int fq) const {
    const int row0 = u.pm * 256 + wr * 64 + fr;
    const int seg = (int)((kCmap1 >> (4 * u.pn)) & 15ull);
#pragma unroll
    for (int ai = 0; ai < 2; ++ai)
#pragma unroll
      for (int m = 0; m < 4; ++m) {
        const int row = row0 + ai * 128 + m * 16;
#pragma unroll
        for (int bj = 0; bj < 2; ++bj) {
          const int col = seg * 256 + bj * 128 + wc * 32 + 8 * fq;
          const f32x4 v0 = acc[ai][bj][m][0], v1 = acc[ai][bj][m][1];
          uint4 w;
          if (seg < 2) {
            w.x = pkbf(gelu_(v0[0]), gelu_(v0[1])); w.y = pkbf(gelu_(v0[2]), gelu_(v0[3]));
            w.z = pkbf(gelu_(v1[0]), gelu_(v1[1])); w.w = pkbf(gelu_(v1[2]), gelu_(v1[3]));
            *(uint4*)(p->U + (size_t)row * 512 + col) = w;
          } else if (seg < 8) {
            w.x = pkbf(v0[0], v0[1]); w.y = pkbf(v0[2], v0[3]); w.z = pkbf(v1[0], v1[1]); w.w = pkbf(v1[2], v1[3]);
            bfu* dst = (seg < 6) ? p->Q + (size_t)row * 512 + (col - 1024) : p->K + (size_t)row * 512 + (col - 1536);
            *(uint4*)dst = w;
          } else {
            w.x = pkbf(silu_(v0[0]), silu_(v0[1])); w.y = pkbf(silu_(v0[2]), silu_(v0[3]));
            w.z = pkbf(silu_(v1[0]), silu_(v1[1])); w.w = pkbf(silu_(v1[2]), silu_(v1[3]));
            *(uint4*)(p->SZ + (size_t)row * 1024 + (col - 2560)) = w;
          }
        }
      }
  }
};
constexpr unsigned long long kRmap1 = 0x9832ull;
struct PgEpi1T {
  static constexpr bool PERM = true, AFTER_DRAIN = false;
  const Params* p;
  DEVI void operator()(const pg8::f32x4 (&acc)[2][2][4][2], const pg8::Unit& u, int wr, int wc, int fr, int fq) const {
    const int ch0 = (u.pm & 1) * 256 + wr * 64 + fr;
    const bool isv = u.pm >= 2;
#pragma unroll
    for (int ai = 0; ai < 2; ++ai)
#pragma unroll
      for (int m = 0; m < 4; ++m) {
        const int ch = ch0 + ai * 128 + m * 16;
#pragma unroll
        for (int bj = 0; bj < 2; ++bj) {
          const int t = u.pn * 256 + bj * 128 + wc * 32 + 8 * fq;
          const f32x4 v0 = acc[ai][bj][m][0], v1 = acc[ai][bj][m][1];
          if (!isv) {
            const int g = ch >> 7, c = ch & 127;
            uint4 w;
            w.x = pkbf(gelu_(v0[0]), gelu_(v0[1])); w.y = pkbf(gelu_(v0[2]), gelu_(v0[3]));
            w.z = pkbf(gelu_(v1[0]), gelu_(v1[1])); w.w = pkbf(gelu_(v1[2]), gelu_(v1[3]));
            *(uint4*)(p->GVT + ((size_t)(((t >> 7) * 4 + g) * 128 + c)) * 128 + (t & 127)) = w;
          } else {
            const int hh = ch >> 6, dim = ch & 63;
            const int b = t >> 14, s = t & (SEQ - 1);
            bfu* base = p->VT + ((size_t)((b * 8 + hh) * 64 + dim)) * SEQ;
            const size_t PST = (size_t)16 * 64 * SEQ;
            uint4 w;
            w.x = pkbf(v0[0], v0[1]); w.y = pkbf(v0[2], v0[3]); w.z = pkbf(v1[0], v1[1]); w.w = pkbf(v1[2], v1[3]);
            *(uint4*)(base + s) = w;
            bfu* b1 = base + PST + (s >> 2);
#pragma unroll
            for (int e = 0; e < 4; ++e) *(unsigned*)(b1 + (size_t)e * (SEQ / 4)) = pkbf(v0[e], v1[e]);
            bfu* b2 = base + 2 * PST + (size_t)(s & 15) * (SEQ / 16) + (s >> 4);
#pragma unroll
            for (int e = 0; e < 4; ++e) {
              b2[(size_t)e * (SEQ / 16)] = (bfu)f2bf(v0[e]);
              b2[(size_t)(e + 4) * (SEQ / 16)] = (bfu)f2bf(v1[e]);
            }
          }
        }
      }
  }
};
struct PgEpiRes {
  static constexpr bool PERM = false, AFTER_DRAIN = false;
  const float* base;
  float* out;
  DEVI void operator()(const pg8::f32x4 (&acc)[2][2][4][2], const pg8::Unit& u, int wr, int wc, int fr, int fq) const {
    const int row0 = u.pm * 256 + wr * 64 + fr, col0 = u.pn * 256 + wc * 32 + 4 * fq;
#pragma unroll
    for (int ai = 0; ai < 2; ++ai)
#pragma unroll
      for (int m = 0; m < 4; ++m) {
        const size_t rb = (size_t)(row0 + ai * 128 + m * 16) * 1024 + col0;
#pragma unroll
        for (int bj = 0; bj < 2; ++bj)
#pragma unroll
          for (int n = 0; n < 2; ++n) {
            const size_t idx = rb + bj * 128 + n * 16;
            const f32x4 b = *(const f32x4*)(base + idx);
            *(f32x4*)(out + idx) = acc[ai][bj][m][n] + b;
          }
      }
  }
};
template <class Epi>
DEVI void pg_gemm(char* smem, const bfu* A, const bfu* Bt, int M, int N, int K, const Epi& E, int bid, int nb) {
  pg8::Gemm g{A, Bt, M, N, K, A, 1 << 30, 0ull, 0ull};
  pg8::StaticOrder S;
  S.init(M, N, nb, bid);
  pg8::gemm_phase<Epi, pg8::StaticOrder, false>((PG8_LAS unsigned char*)smem, g, S, E, nullptr);
}
template <class Epi>
DEVI void pg_gemm2(char* smem, const bfu* A, const bfu* A2, int pn_split, const bfu* Bt, int M, int N, int K, const Epi& E,
                   int bid, int nb) {
  pg8::Gemm g{A, Bt, M, N, K, A2, pn_split, 0ull, 0ull};
  pg8::StaticOrder S;
  S.init(M, N, nb, bid);
  pg8::gemm_phase<Epi, pg8::StaticOrder, false>((PG8_LAS unsigned char*)smem, g, S, E, nullptr);
}
struct PgEpi3 {
  static constexpr bool PERM = true, AFTER_DRAIN = false;
  bfu* O0;
  bfu* O1;
  int silu1;
  DEVI void operator()(const pg8::f32x4 (&acc)[2][2][4][2], const pg8::Unit& u, int wr, int wc, int fr, int fq) const {
    const int row0 = u.pm * 256 + wr * 64 + fr;
    const int grp = u.pn >> 2;
    bfu* O = grp ? O1 : O0;
    const bool act = grp && silu1;
    const int colb = (u.pn & 3) * 256 + wc * 32 + 8 * fq;
#pragma unroll
    for (int ai = 0; ai < 2; ++ai)
#pragma unroll
      for (int m = 0; m < 4; ++m) {
        bfu* rowp = O + (size_t)(row0 + ai * 128 + m * 16) * 1024 + colb;
#pragma unroll
        for (int bj = 0; bj < 2; ++bj) {
          f32x4 v0 = acc[ai][bj][m][0], v1 = acc[ai][bj][m][1];
          if (act) {
#pragma unroll
            for (int e = 0; e < 4; ++e) {
              v0[e] = silu_(v0[e]);
              v1[e] = silu_(v1[e]);
            }
          }
          uint4 w;
          w.x = pkbf(v0[0], v0[1]); w.y = pkbf(v0[2], v0[3]); w.z = pkbf(v1[0], v1[1]); w.w = pkbf(v1[2], v1[3]);
          *(uint4*)(rowp + bj * 128) = w;
        }
      }
  }
};

DEVI void phase1(const Params& p, char* smem, int bid, int nb) {
  {
    PgEpi1 E{&p};
    pg8::Gemm g{p.H, p.WT_in, T_TOK, 2560, 1024, p.H, 1 << 30, 0ull, kCmap1};
    pg8::StaticOrder S;
    S.init(T_TOK, 2560, nb, bid);
    pg8::gemm_phase<PgEpi1, pg8::StaticOrder, false>((PG8_LAS unsigned char*)smem, g, S, E, nullptr);
  }
  {
    PgEpi1T E{&p};
    pg8::Gemm g{p.WT_in, p.H, 1024, T_TOK, 1024, p.WT_in, 1 << 30, kRmap1, 0ull};
    pg8::StaticOrder S;
    S.init(1024, T_TOK, nb, bid);
    pg8::gemm_phase<PgEpi1T, pg8::StaticOrder, false>((PG8_LAS unsigned char*)smem, g, S, E, nullptr);
  }
}

struct ALoadWs {
  struct Raw { float4 a, b; };
  static constexpr bool kFat = true;
  static constexpr bool kConsec = false;
  const float* ws;
  const float* rinv;
  DEVI Raw load(int t, int s0) const {
    Raw r;
    r.a = *(const float4*)(ws + t * 128 + s0);
    r.b = *(const float4*)(ws + t * 128 + s0 + 4);
    return r;
  }
  DEVI uint4 loadprev(int, int) const { return uint4{0u, 0u, 0u, 0u}; }
  DEVI uint4 asprev(const Raw&) const { return uint4{0u, 0u, 0u, 0u}; }
  DEVI uint4 finish(const Raw& r, const uint4&, int t, int s0) const {
    float f[8] = {r.a.x, r.a.y, r.a.z, r.a.w, r.b.x, r.b.y, r.b.z, r.b.w};
#pragma unroll
    for (int j = 0; j < 8; ++j) f[j] = (s0 + j <= t) ? f[j] * rinv[s0 + j] : 0.f;
    return pack8(f);
  }
};
struct EpiGm {
  const Params* p;
  int chunk, g;
  DEVI void operator()(int t, int c, f32x4 v) const {
    const float4 gn = *(const float4*)(p->gm_norm + g * 128 + c);
    const float bias = p->gm_b[g * 128 + t];
    const size_t tok = (size_t)chunk * 128 + t;
    float u[4], sz[4];
    unpack4(*(const uint2*)(p->U + tok * 512 + g * 128 + c), u);
    unpack4(*(const uint2*)(p->SZ + tok * 1024 + g * 128 + c), sz);
    uint2 o;
    o.x = pkbf(u[0] * (v[0] * gn.x + bias) * sz[0], u[1] * (v[1] * gn.y + bias) * sz[1]);
    o.y = pkbf(u[2] * (v[2] * gn.z + bias) * sz[2], u[3] * (v[3] * gn.w + bias) * sz[3]);
    *(uint2*)(p->Y + tok * 1024 + g * 128 + c) = o;
  }
};

DEVI void gmlp_item(const Params& p, char* smem, int item) {
  const int chunk = item >> 2, g = item & 3;
  const bfu* gv = p.GVT + (size_t)item * 128 * 128;
  float* rinv = (float*)(smem + 2 * GSTAGE_BYTES);
  const int tid = TIDX;
  {
    float* sred = rinv + 128;
    const int s4 = (tid & 31) * 4, cg = tid >> 5;
    uint2 raw[16];
#pragma unroll
    for (int i = 0; i < 16; ++i) raw[i] = *(const uint2*)(gv + (cg * 16 + i) * 128 + s4);
    float ss[4] = {0.f, 0.f, 0.f, 0.f};
#pragma unroll
    for (int i = 0; i < 16; ++i) {
      float f[4];
      unpack4(raw[i], f);
#pragma unroll
      for (int j = 0; j < 4; ++j) ss[j] += f[j] * f[j];
    }
    *(float4*)(sred + cg * 128 + s4) = float4{ss[0], ss[1], ss[2], ss[3]};
    __syncthreads();
    if (tid < 128) {
      float t = 0.f;
#pragma unroll
      for (int i = 0; i < 8; ++i) t += sred[i * 128 + tid];
      rinv[tid] = rsqrtf(t * (1.f / 128.f) + 1e-6f);
    }
  }
  __syncthreads();
  ALoadWs al{p.gm_ws + (size_t)g * 128 * 128, rinv};
  EpiGm epi{&p, chunk, g};
  gemm_tile(smem, al, gv, 128, 128, 0, 0, epi);
}

DEVI void attn_item(const Params& p, char* smem, int item) {
  const int qb = item & 63, bh = item >> 6, b = bh >> 3, h = bh & 7;
  const int q0 = qb * 256;
  bfu* Ob = (bfu*)smem;
  float* Mb = (float*)(smem + 32768);
  float* Lb = Mb + 256;
  const int tid = threadIdx.x, lane = tid & 63, wid = tid >> 6;
  const int qi = lane & 15, g = lane >> 4;
  const float slope = exp2f(-(float)(h + 1));
  const size_t tokb = (size_t)b * SEQ;
#pragma unroll 1
  for (int pi = 0; pi < 3; ++pi) {
    const int dshift = 2 * pi, d = 1 << dshift;
    const bfu* VT = p.VT + (size_t)pi * ((size_t)16 * 64 * SEQ) + (size_t)bh * 64 * SEQ;
#pragma unroll 1
    for (int u = wid; u < 16; u += 8) {
      const int r = u & (d - 1), tile = u >> dshift;
      const int sq0 = (q0 >> dshift) + tile * 16;
      const int sk0 = sq0 - 144;
      const int posq = ((sq0 + qi) << dshift) + r;
      const bfu* qp = p.Q + (tokb + posq) * 512 + h * 64 + g * 8;
      const bf16x8 qf0 = *(const bf16x8*)qp, qf1 = *(const bf16x8*)(qp + 32);
      const bfu* kbase = p.K + (tokb + r) * 512 + h * 64 + g * 8;
      const bfu* vbase = VT + (size_t)qi * SEQ + r * (SEQ >> dshift);
      bf16x8 kf[2][2];
      uint2 vf[4][2];
      auto loadkv = [&](int it) {
#pragma unroll
        for (int tt = 0; tt < 2; ++tt) {
          int sk = sk0 + (2 * it + tt) * 16 + qi;
          sk = sk < 0 ? 0 : sk;
          const bfu* kp = kbase + ((size_t)sk << dshift) * 512;
          kf[tt][0] = *(const bf16x8*)kp;
          kf[tt][1] = *(const bf16x8*)(kp + 32);
        }
        int kidx0 = sk0 + 32 * it + 4 * g, kidx1 = kidx0 + 16;
        kidx0 = kidx0 < 0 ? 0 : kidx0;
        kidx1 = kidx1 < 0 ? 0 : kidx1;
#pragma unroll
        for (int m = 0; m < 4; ++m) {
          vf[m][0] = *(const uint2*)(vbase + (size_t)(16 * m) * SEQ + kidx0);
          vf[m][1] = *(const uint2*)(vbase + (size_t)(16 * m) * SEQ + kidx1);
        }
      };
      loadkv(0);
      const int hi = 144 + qi, lo = (16 + qi > -sk0) ? 16 + qi : -sk0;
      const float sd = slope * (float)d;
      float mrun = -1e30f, l = 0.f;
      f32x4 O[4];
#pragma unroll
      for (int m = 0; m < 4; ++m) O[m] = f32x4{0.f, 0.f, 0.f, 0.f};
#pragma unroll 1
      for (int it = 0; it < 5; ++it) {
        bf16x8 ck[2][2];
        uint2 cv[4][2];
#pragma unroll
        for (int a = 0; a < 2; ++a)
#pragma unroll
          for (int c = 0; c < 2; ++c) ck[a][c] = kf[a][c];
#pragma unroll
        for (int m = 0; m < 4; ++m) {
          cv[m][0] = vf[m][0];
          cv[m][1] = vf[m][1];
        }
        if (it < 4) loadkv(it + 1);
        f32x4 S[2];
#pragma unroll
        for (int tt = 0; tt < 2; ++tt) {
          f32x4 z = {0.f, 0.f, 0.f, 0.f};
          z = __builtin_amdgcn_mfma_f32_16x16x32_bf16(ck[tt][0], qf0, z, 0, 0, 0);
          z = __builtin_amdgcn_mfma_f32_16x16x32_bf16(ck[tt][1], qf1, z, 0, 0, 0);
          S[tt] = z;
        }
        float mx = -INFINITY;
#pragma unroll
        for (int tt = 0; tt < 2; ++tt)
#pragma unroll
          for (int e = 0; e < 4; ++e) {
            const int kb = (2 * it + tt) * 16 + 4 * g;
            const bool valid = (kb >= lo - e) && (kb <= hi - e);
            const float sv = valid ? fmaf(S[tt][e], 0.125f, sd * (float)e - sd * (float)(hi - kb)) : -INFINITY;
            S[tt][e] = sv;
            mx = fmaxf(mx, sv);
          }
        mx = fmaxf(mx, __shfl_xor(mx, 16));
        mx = fmaxf(mx, __shfl_xor(mx, 32));
        const float mnew = fmaxf(mrun, mx);
        const float alpha = __expf(mrun - mnew);
        mrun = mnew;
        float ls = 0.f;
#pragma unroll
        for (int tt = 0; tt < 2; ++tt)
#pragma unroll
          for (int e = 0; e < 4; ++e) {
            const float pe = __expf(S[tt][e] - mnew);
            S[tt][e] = pe;
            ls += pe;
          }
        l = l * alpha + ls;
        uint4 pk;
        pk.x = pkbf(S[0][0], S[0][1]);
        pk.y = pkbf(S[0][2], S[0][3]);
        pk.z = pkbf(S[1][0], S[1][1]);
        pk.w = pkbf(S[1][2], S[1][3]);
        const bf16x8 pf = __builtin_bit_cast(bf16x8, pk);
#pragma unroll
        for (int m = 0; m < 4; ++m) {
          O[m] *= alpha;
          const uint4 vv = {cv[m][0].x, cv[m][0].y, cv[m][1].x, cv[m][1].y};
          O[m] = __builtin_amdgcn_mfma_f32_16x16x32_bf16(__builtin_bit_cast(bf16x8, vv), pf, O[m], 0, 0, 0);
        }
      }
      l += __shfl_xor(l, 16);
      l += __shfl_xor(l, 32);
      const float mx = mrun;
      const float il = 1.f / l;
      const int ql = ((tile * 16 + qi) << dshift) + r;
      float wo = 0.f, wn = 1.f;
      float mnew = mx, lnew = l;
      if (pi > 0) {
        const float mo = Mb[ql], lo = Lb[ql];
        mnew = fmaxf(mo, mx);
        wo = lo * __expf(mo - mnew);
        wn = l * __expf(mx - mnew);
        lnew = wo + wn;
        const float inv = 1.f / lnew;
        wo *= inv;
        wn *= inv;
      }
      wn *= il;
#pragma unroll
      for (int m = 0; m < 4; ++m) {
        bfu* op = Ob + ql * 64 + 16 * m + 4 * g;
        float o[4];
        if (pi > 0) {
          const uint2 ov = *(const uint2*)op;
          o[0] = wo * bf2f(ov.x & 0xffffu) + wn * O[m][0];
          o[1] = wo * bf2f(ov.x >> 16) + wn * O[m][1];
          o[2] = wo * bf2f(ov.y & 0xffffu) + wn * O[m][2];
          o[3] = wo * bf2f(ov.y >> 16) + wn * O[m][3];
        } else {
#pragma unroll
          for (int e = 0; e < 4; ++e) o[e] = wn * O[m][e];
        }
        if (pi < 2) {
          uint2 w;
          w.x = pkbf(o[0], o[1]);
          w.y = pkbf(o[2], o[3]);
          *(uint2*)op = w;
        } else {
          const size_t oi = (tokb + q0 + ql) * 1024 + 512 + h * 64 + 16 * m + 4 * g;
          const uint2 sz = *(const uint2*)(p.SZ + oi);
          uint2 w;
          w.x = pkbf(o[0] * bf2f(sz.x & 0xffffu), o[1] * bf2f(sz.x >> 16));
          w.y = pkbf(o[2] * bf2f(sz.y & 0xffffu), o[3] * bf2f(sz.y >> 16));
          *(uint2*)(p.Y + oi) = w;
        }
      }
      if (pi < 2 && g == 0) {
        Mb[ql] = mnew;
        Lb[ql] = lnew;
      }
    }
    __syncthreads();
  }
}

DEVI void phase2(const Params& p, char* smem, int bid, int nb) {
  for (int it = bid; it < 16 * 64; it += nb) attn_item(p, smem, it);
  char* hs = smem + HF * HALF_SMEM;
  for (int it = bid * 2 + HF; it < (T_TOK / 128) * 4; it += nb * 2) gmlp_item(p, hs, it);
}

DEVI void phase3(const Params& p, char* smem, int bid, int nb) {
  PgEpiRes E{p.x, p.out};
  pg_gemm(smem, p.Y, p.WT_out, T_TOK, 1024, 1024, E, bid, nb);
}
DEVI void phase3b(const Params& p, int bid, int nb) {
  for (int it = bid; it < T_TOK / 16; it += nb) {
    const int row = it * 16 + (threadIdx.x >> 6) * 2;
    rms_row2_bf16(p.out + (size_t)row * 1024, p.ln_odd, p.H + (size_t)row * 1024, threadIdx.x & 63);
  }
}

struct ALoadMix {
  typedef uint4 Raw;
  static constexpr bool kFat = true;
  static constexpr bool kConsec = true;
  const bfu* H;
  const float* mu;
  DEVI Raw load(int row, int k) const { return *(const uint4*)(H + (size_t)row * 1024 + k); }
  DEVI uint4 loadprev(int row, int k) const {
    const int prow = ((row & (SEQ - 1)) != 0) ? row - 1 : row;
    return *(const uint4*)(H + (size_t)prow * 1024 + k);
  }
  DEVI uint4 asprev(const Raw& r) const { return r; }
  DEVI uint4 finish(const Raw& r, const uint4& pr, int row, int k) const {
    float c[8], pv[8];
    unpack8(r, c);
    unpack8(pr, pv);
    const float first = ((row & (SEQ - 1)) != 0) ? 1.f : 0.f;
    const float4 m0 = *(const float4*)(mu + k), m1 = *(const float4*)(mu + k + 4);
    const float mm[8] = {m0.x, m0.y, m0.z, m0.w, m1.x, m1.y, m1.z, m1.w};
#pragma unroll
    for (int j = 0; j < 8; ++j) c[j] = c[j] + (pv[j] * first - c[j]) * mm[j];
    return pack8(c);
  }
};
struct Epi4 {
  const Params* p;
  int nt;
  DEVI void operator()(int row, int col, f32x4 v) const {
    uint2 o;
    if (nt < 24) {
      o.x = pkbf(v[0], v[1]);
      o.y = pkbf(v[2], v[3]);
      bfu* dst = (nt < 8) ? p->R + (size_t)row * 1024 + col
                          : (nt < 16) ? p->K1 + (size_t)row * 1024 + col - 1024 : p->V1 + (size_t)row * 1024 + col - 2048;
      *(uint2*)dst = o;
    } else if (nt < 32) {
      o.x = pkbf(silu_(v[0]), silu_(v[1]));
      o.y = pkbf(silu_(v[2]), silu_(v[3]));
      *(uint2*)(p->SG + (size_t)row * 1024 + col - 3072) = o;
    } else if (nt == 32) {
      const int c = col - 4096;
      if (c < 64) {
        o.x = pkbf(tanh_(v[0]), tanh_(v[1]));
        o.y = pkbf(tanh_(v[2]), tanh_(v[3]));
        *(uint2*)(p->TW + (size_t)row * 64 + c) = o;
      }
    } else {
      const int c = col - 4224;
      if (c < 64) {
        o.x = pkbf(v[0], v[1]);
        o.y = pkbf(v[2], v[3]);
        *(uint2*)(p->TA + (size_t)row * 64 + c) = o;
      }
    }
  }
};
DEVI void phase4_tile(const Params& p, char* smem, int mt, int nt) {
  float* smu = (float*)(smem + 2 * GSTAGE_BYTES);
  const int mi = (nt < 8) ? 0 : (nt < 16) ? 2 : (nt < 24) ? 3 : (nt < 32) ? 5 : (nt == 32) ? 1 : 4;
  *(float4*)(smu + TIDX * 4) = *(const float4*)(p.mu + mi * 1024 + TIDX * 4);
  __syncthreads();
  ALoadMix al{p.H, smu};
  Epi4 epi{&p, nt};
  gemm_tile<1>(smem, al, p.WT_3, 1024, 1024, mt * 128, nt * 128, epi);
}
DEVI void phaseM(const Params& p, char* smem, int bid, int nb) {
  char* hs = smem + HF * HALF_SMEM;
  for (int it = bid * 2 + HF; it < (T_TOK / 128) * 2; it += nb * 2) phase4_tile(p, hs, it >> 1, 32 + (it & 1));
  const int tid = threadIdx.x;
  const int cc = (tid & 127) * 8, rsub = tid >> 7;
  float mr[8], mk[8], mv[8], mg[8];
  {
    const float4 a0 = *(const float4*)(p.mu + 0 * 1024 + cc), a1 = *(const float4*)(p.mu + 0 * 1024 + cc + 4);
    const float4 b0 = *(const float4*)(p.mu + 2 * 1024 + cc), b1 = *(const float4*)(p.mu + 2 * 1024 + cc + 4);
    const float4 c0 = *(const float4*)(p.mu + 3 * 1024 + cc), c1 = *(const float4*)(p.mu + 3 * 1024 + cc + 4);
    const float4 d0 = *(const float4*)(p.mu + 5 * 1024 + cc), d1 = *(const float4*)(p.mu + 5 * 1024 + cc + 4);
    mr[0] = a0.x; mr[1] = a0.y; mr[2] = a0.z; mr[3] = a0.w; mr[4] = a1.x; mr[5] = a1.y; mr[6] = a1.z; mr[7] = a1.w;
    mk[0] = b0.x; mk[1] = b0.y; mk[2] = b0.z; mk[3] = b0.w; mk[4] = b1.x; mk[5] = b1.y; mk[6] = b1.z; mk[7] = b1.w;
    mv[0] = c0.x; mv[1] = c0.y; mv[2] = c0.z; mv[3] = c0.w; mv[4] = c1.x; mv[5] = c1.y; mv[6] = c1.z; mv[7] = c1.w;
    mg[0] = d0.x; mg[1] = d0.y; mg[2] = d0.z; mg[3] = d0.w; mg[4] = d1.x; mg[5] = d1.y; mg[6] = d1.z; mg[7] = d1.w;
  }
#pragma unroll 1
  for (int it = bid; it < T_TOK / 8; it += nb) {
    const int ra = it * 8 + rsub, rb = ra + 4;
    const size_t oa = (size_t)ra * 1024 + cc, ob = (size_t)rb * 1024 + cc;
    const uint4 ca = *(const uint4*)(p.H + oa), cb = *(const uint4*)(p.H + ob);
    const uint4 pa = *(const uint4*)(p.H + (((ra & (SEQ - 1)) != 0) ? oa - 1024 : oa));
    const uint4 pb = *(const uint4*)(p.H + ob - 1024);
    const float fa = ((ra & (SEQ - 1)) != 0) ? 1.f : 0.f;
#pragma unroll
    for (int half = 0; half < 2; ++half) {
      float c[8], d[8], o[8];
      unpack8(half ? cb : ca, c);
      unpack8(half ? pb : pa, d);
      const float f = half ? 1.f : fa;
      const size_t oo = half ? ob : oa;
#pragma unroll
      for (int j = 0; j < 8; ++j) d[j] = d[j] * f - c[j];
#pragma unroll
      for (int j = 0; j < 8; ++j) o[j] = c[j] + d[j] * mr[j];
      *(uint4*)(p.XR + oo) = pack8(o);
#pragma unroll
      for (int j = 0; j < 8; ++j) o[j] = c[j] + d[j] * mk[j];
      *(uint4*)(p.XK + oo) = pack8(o);
#pragma unroll
      for (int j = 0; j < 8; ++j) o[j] = c[j] + d[j] * mv[j];
      *(uint4*)(p.XV + oo) = pack8(o);
#pragma unroll
      for (int j = 0; j < 8; ++j) o[j] = c[j] + d[j] * mg[j];
      *(uint4*)(p.XG + oo) = pack8(o);
    }
  }
}
DEVI void phase3a(const Params& p, char* smem, int bid, int nb) {
  PgEpi3 E{p.R, p.K1, 0};
  pg_gemm2(smem, p.XR, p.XK, 4, p.WT_3, T_TOK, 2048, 1024, E, bid, nb);
}
DEVI void phase3c(const Params& p, char* smem, int bid, int nb) {
  PgEpi3 E{p.V1, p.SG, 1};
  pg_gemm2(smem, p.XV, p.XG, 4, p.WT_3 + (size_t)2048 * 1024, T_TOK, 2048, 1024, E, bid, nb);
}

struct Epi5w {
  const Params* p;
  DEVI void operator()(int row, int col, f32x4 v) const {
    const float4 w0 = *(const float4*)(p->w0 + col);
    const float k = 0.6065306597126334f;
    uint2 o;
    o.x = pkbf(k * sigmoid_(w0.x + v[0]), k * sigmoid_(w0.y + v[1]));
    o.y = pkbf(k * sigmoid_(w0.z + v[2]), k * sigmoid_(w0.w + v[3]));
    *(uint2*)(p->EW + (size_t)row * 1024 + col) = o;
  }
};
struct Epi5a {
  const Params* p;
  DEVI void operator()(int row, int col, f32x4 v) const {
    const float4 a0 = *(const float4*)(p->a0 + col);
    uint2 o;
    o.x = pkbf(sigmoid_(a0.x + v[0]), sigmoid_(a0.y + v[1]));
    o.y = pkbf(sigmoid_(a0.z + v[2]), sigmoid_(a0.w + v[3]));
    *(uint2*)(p->AA + (size_t)row * 1024 + col) = o;
  }
};
DEVI void phase5(const Params& p, char* smem, int bid, int nb) {
  constexpr int N1 = (T_TOK / 128) * 8;
  char* hs = smem + HF * HALF_SMEM;
  for (int it = bid * 2 + HF; it < 2 * N1; it += nb * 2) {
    if (it < N1) {
      ALoadPlain al{p.TW, 64};
      Epi5w epi{&p};
      gemm_tile(hs, al, p.W2T, 64, 64, (it >> 3) * 128, (it & 7) * 128, epi);
    } else {
      const int j = it - N1;
      ALoadPlain al{p.TA, 64};
      Epi5a epi{&p};
      gemm_tile(hs, al, p.A2T, 64, 64, (j >> 3) * 128, (j & 7) * 128, epi);
    }
  }
}

DEVI void scanx_item(const Params& p, char* smem, int item, int next_item, uint2& ur, uint2& uk, uint2& ue, uint2& ua, uint2& uv) {
  const int bh = item & 31, c = item >> 5;
  const int b = bh >> 4, h = bh & 15;
  const size_t rowbase = ((size_t)b * SEQ + (size_t)c * 16) * 1024 + h * 64;
  float* sA = (float*)smem;
  float* sR = sA + 16 * 68;
  float* sBt = sR + 16 * 68;
  float* sKt = sBt + 16 * 68;
  float* sE = sKt + 16 * 68;
  float* sMab = sE + 16 * 64;
  float* sMak = sMab + 256;
  float* sM2 = sMak + 256;
  float* sM4 = sM2 + 256;
  float* sT = sM4 + 256;
  float* sT2 = sT + 256;
  const int tid = TIDX;
  const int tau = tid >> 4, c4 = (tid & 15) * 4;
  const size_t o = rowbase + (size_t)tau * 1024 + c4;
  float r[4], k[4], ew[4], a[4], vv[4];
  unpack4(ur, r);
  unpack4(uk, k);
  unpack4(ue, ew);
  unpack4(ua, a);
  unpack4(uv, vv);
  {
    const int nbh = next_item & 31, nc = next_item >> 5;
    const size_t no = ((size_t)(nbh >> 4) * SEQ + (size_t)nc * 16 + tau) * 1024 + (nbh & 15) * 64 + c4;
    ur = *(const uint2*)(p.R + no);
    uk = *(const uint2*)(p.K1 + no);
    ue = *(const uint2*)(p.EW + no);
    ua = *(const uint2*)(p.AA + no);
    uv = *(const uint2*)(p.V1 + no);
  }
  float kk[4], kp[4], bb[4];
  float ss = 0.f, cf = 0.f;
#pragma unroll
  for (int j = 0; j < 4; ++j) {
    const int ch = h * 64 + c4 + j;
    kk[j] = k[j] * p.k_k[ch];
    ss += kk[j] * kk[j];
    kp[j] = k[j] * (1.f + (a[j] - 1.f) * p.k_a[ch]);
    cf += r[j] * kp[j] * p.r_k[ch];
  }
  ss = reduce16(ss);
  cf = reduce16(cf);
  const float rn = rsqrtf(fmaxf(ss, 1e-24f));
#pragma unroll
  for (int j = 0; j < 4; ++j) {
    kk[j] *= rn;
    bb[j] = kk[j] * a[j];
    sE[tau * 64 + c4 + j] = ew[j];
  }
  if ((tid & 15) == 0) p.COEF[((size_t)b * SEQ + (size_t)c * 16 + tau) * 16 + h] = cf;
  __syncthreads();
  float Li[4] = {0.f, 0.f, 0.f, 0.f}, L15[4] = {0.f, 0.f, 0.f, 0.f};
#pragma unroll
  for (int i = 0; i < 16; ++i) {
    const float4 e = *(const float4*)(sE + i * 64 + c4);
    const float m = (i <= tau) ? 1.f : 0.f;
    Li[0] += m * e.x; Li[1] += m * e.y; Li[2] += m * e.z; Li[3] += m * e.w;
    L15[0] += e.x; L15[1] += e.y; L15[2] += e.z; L15[3] += e.w;
  }
  float rt[4], bhat[4], khat[4];
#pragma unroll
  for (int j = 0; j < 4; ++j) {
    const float ep = __expf(Li[j]), em = __expf(-Li[j]), eh = __expf(-(L15[j] - Li[j]));
    const float at = -kk[j] * __expf(-(Li[j] - ew[j]));
    rt[j] = r[j] * em;
    sA[tau * 68 + c4 + j] = at;
    sR[tau * 68 + c4 + j] = rt[j];
    sBt[tau * 68 + c4 + j] = bb[j] * ep;
    sKt[tau * 68 + c4 + j] = kp[j] * ep;
    bhat[j] = bb[j] * eh;
    khat[j] = kp[j] * eh;
  }
  *(uint2*)(p.R + o) = pack4(rt);
#pragma unroll
  for (int j = 0; j < 4; ++j) {
    const int lin = (c4 + j) * 16 + tau;
    const size_t off = rowbase + (size_t)(lin >> 6) * 1024 + (lin & 63);
    p.EW[off] = (bfu)f2bf(bhat[j]);
    p.K1[off] = (bfu)f2bf(khat[j]);
    p.V1[off] = (bfu)f2bf(vv[j]);
  }
  if (tau == 0) {
    float4 gq = {__expf(-L15[0]), __expf(-L15[1]), __expf(-L15[2]), __expf(-L15[3])};
    *(float4*)(p.G15 + (size_t)item * 64 + c4) = gq;
  }
  __syncthreads();
  {
    const int i = tid >> 4, tq = tid & 15;
    float mab = 0.f, mak = 0.f, mrb = 0.f, mrk = 0.f;
#pragma unroll
    for (int kq = 0; kq < 64; kq += 4) {
      const float4 bi = *(const float4*)(sBt + i * 68 + kq);
      const float4 ki = *(const float4*)(sKt + i * 68 + kq);
      const float4 aq = *(const float4*)(sA + tq * 68 + kq);
      const float4 rq = *(const float4*)(sR + tq * 68 + kq);
      mab += bi.x * aq.x + bi.y * aq.y + bi.z * aq.z + bi.w * aq.w;
      mak += ki.x * aq.x + ki.y * aq.y + ki.z * aq.z + ki.w * aq.w;
      mrb += bi.x * rq.x + bi.y * rq.y + bi.z * rq.z + bi.w * rq.w;
      mrk += ki.x * rq.x + ki.y * rq.y + ki.z * rq.z + ki.w * rq.w;
    }
    if (!(i < tq)) { mab = 0.f; mak = 0.f; }
    if (!(i <= tq)) { mrb = 0.f; mrk = 0.f; }
    sMab[i * 16 + tq] = mab;
    sMak[i * 16 + tq] = mak;
    bfu* mr = p.MRT + (size_t)item * 512 + tq * 32 + (i >> 2) * 8 + (i & 3);
    mr[0] = (bfu)f2bf(mrb);
    mr[4] = (bfu)f2bf(mrk);
  }
  __syncthreads();
  {
    const int i = tid >> 4, j = tid & 15;
    float m2 = 0.f;
#pragma unroll
    for (int kq = 0; kq < 16; ++kq) m2 += sMab[i * 16 + kq] * sMab[kq * 16 + j];
    sM2[i * 16 + j] = m2;
    __syncthreads();
    float t1 = ((i == j) ? 1.f : 0.f) + sMab[i * 16 + j] + m2, m4 = 0.f;
#pragma unroll
    for (int kq = 0; kq < 16; ++kq) {
      t1 += sMab[i * 16 + kq] * sM2[kq * 16 + j];
      m4 += sM2[i * 16 + kq] * sM2[kq * 16 + j];
    }
    sT[i * 16 + j] = t1;
    sM4[i * 16 + j] = m4;
    __syncthreads();
    float t2 = t1, m8 = 0.f;
#pragma unroll
    for (int kq = 0; kq < 16; ++kq) {
      t2 += sT[i * 16 + kq] * sM4[kq * 16 + j];
      m8 += sM4[i * 16 + kq] * sM4[kq * 16 + j];
    }
    sT2[i * 16 + j] = t2;
    __syncthreads();
    sM2[i * 16 + j] = m8;
    __syncthreads();
    float t3 = t2;
#pragma unroll
    for (int kq = 0; kq < 16; ++kq) t3 += sT2[i * 16 + kq] * sM2[kq * 16 + j];
    sT[i * 16 + j] = t3;
    __syncthreads();
  }
  {
    const int tq = tid >> 4, k4 = (tid & 15) * 4, ii = tid & 15;
    float w0 = 0.f, w1 = 0.f, w2 = 0.f, w3 = 0.f, gt = 0.f;
#pragma unroll
    for (int jj = 0; jj < 16; ++jj) {
      const float tm = sT[jj * 16 + tq];
      const float4 av = *(const float4*)(sA + jj * 68 + k4);
      w0 += av.x * tm; w1 += av.y * tm; w2 += av.z * tm; w3 += av.w * tm;
      gt += sMak[ii * 16 + jj] * tm;
    }
    uint2 wv;
    wv.x = pkbf(w0, w1);
    wv.y = pkbf(w2, w3);
    *(uint2*)(p.AA + rowbase + (size_t)tq * 1024 + k4) = wv;
    p.GT[(size_t)item * 256 + tq * 16 + ii] = (bfu)f2bf(gt);
  }
  __syncthreads();
}
DEVI void phase6x(const Params& p, char* smem, int bid, int nb) {
  char* hs = smem + HF * HALF_SMEM;
  constexpr int NI = (SEQ / 16) * 32;
  const int vnb = nb * 2;
  int it = bid * 2 + HF;
  if (it >= NI) return;
  uint2 ur, uk, ue, ua, uv;
  {
    const int tau = TIDX >> 4, c4 = (TIDX & 15) * 4;
    const int bh = it & 31, c = it >> 5;
    const size_t o = ((size_t)(bh >> 4) * SEQ + (size_t)c * 16 + tau) * 1024 + (bh & 15) * 64 + c4;
    ur = *(const uint2*)(p.R + o);
    uk = *(const uint2*)(p.K1 + o);
    ue = *(const uint2*)(p.EW + o);
    ua = *(const uint2*)(p.AA + o);
    uv = *(const uint2*)(p.V1 + o);
  }
#pragma unroll 1
  for (; it < NI; it += vnb) scanx_item(p, hs, it, (it + vnb < NI) ? it + vnb : it, ur, uk, ue, ua, uv);
}

DEVI bf16x8 mk8(uint2 a, uint2 b) {
  const uint4 v = {a.x, a.y, b.x, b.y};
  return __builtin_bit_cast(bf16x8, v);
}
DEVI uint2 packacc(f32x4 a) {
  uint2 r;
  r.x = pkbf(a[0], a[1]);
  r.y = pkbf(a[2], a[3]);
  return r;
}
constexpr int SCH = 4;
constexpr int SROW = 136;
constexpr int SARR = 16 * SROW;
constexpr int SOFF_GT = 5 * SARR;
constexpr int SOFF_MR = SOFF_GT + 512;
constexpr int SOFF_G15 = SOFF_MR + 1024;
constexpr int SIMG = SOFF_G15 + 256;
#define SCANS_LD5(P, I, O)                       \
    P##a##I = *(const uint4*)(p.AA + (O));       \
    P##r##I = *(const uint4*)(p.R + (O));        \
    P##e##I = *(const uint4*)(p.EW + (O));       \
    P##k##I = *(const uint4*)(p.K1 + (O));       \
    P##v##I = *(const uint4*)(p.V1 + (O));
#define SCANS_ISSUE(P, SC)                                                                           \
  {                                                                                                  \
    const size_t hb_ = ((size_t)b * SEQ) * 1024 + h * 64 + c80 * 8;                                  \
    const int tk0_ = (SC) * SCH * 16 + cl0 * 16 + row0;                                              \
    const int tk1_ = tk0_ + 32;                                                                      \
    SCANS_LD5(P, 0, hb_ + (size_t)(tk0_ < SEQ ? tk0_ : SEQ - 1) * 1024)                              \
    SCANS_LD5(P, 1, hb_ + (size_t)(tk1_ < SEQ ? tk1_ : SEQ - 1) * 1024)                              \
    const int c0_ = (SC) * SCH;                                                                      \
    const size_t ib_ = (size_t)b * 16 + h;                                                           \
    const int tg_ = tid < 128 ? tid : 127;                                                           \
    const int cg_ = c0_ + (tg_ >> 5);                                                                \
    P##gm = *(const uint4*)(p.GT + ((size_t)(cg_ < SEQ / 16 ? cg_ : SEQ / 16 - 1) * 32 + ib_) * 256 + (tg_ & 31) * 8);  \
    const int t5_ = tid < 64 ? tid : 63;                                                             \
    const int c5_ = c0_ + (t5_ >> 4);                                                                \
    P##g5 = *(const uint4*)(p.G15 + ((size_t)(c5_ < SEQ / 16 ? c5_ : SEQ / 16 - 1) * 32 + ib_) * 64 + (t5_ & 15) * 4);  \
    const int cm_ = c0_ + (tid >> 6);                                                                \
    P##mr = *(const uint4*)(p.MRT + ((size_t)(cm_ < SEQ / 16 ? cm_ : SEQ / 16 - 1) * 32 + ib_) * 512 + (tid & 63) * 8); \
  }
#define SCANS_ST5(P, I, B)                                                                           \
    *(uint2*)(B) = uint2{P##a##I.x, P##a##I.y};  *(uint2*)((B) + 8) = uint2{P##a##I.z, P##a##I.w};   \
    *(uint2*)((B) + SARR) = uint2{P##r##I.x, P##r##I.y};  *(uint2*)((B) + SARR + 8) = uint2{P##r##I.z, P##r##I.w};   \
    *(uint2*)((B) + 2 * SARR) = uint2{P##e##I.x, P##e##I.y};  *(uint2*)((B) + 2 * SARR + 8) = uint2{P##e##I.z, P##e##I.w};   \
    *(uint2*)((B) + 3 * SARR) = uint2{P##k##I.x, P##k##I.y};  *(uint2*)((B) + 3 * SARR + 8) = uint2{P##k##I.z, P##k##I.w};   \
    *(uint2*)((B) + 4 * SARR) = uint2{P##v##I.x, P##v##I.y};  *(uint2*)((B) + 4 * SARR + 8) = uint2{P##v##I.z, P##v##I.w};
#define SCANS_COMMIT(P)                                                                              \
  {                                                                                                  \
    char* b0_ = smem + cl0 * SIMG + row0 * SROW + c80 * 16;                                          \
    SCANS_ST5(P, 0, b0_)                                                                             \
    SCANS_ST5(P, 1, b0_ + 2 * SIMG)                                                                  \
    if (tid < 128) *(uint4*)(smem + (tid >> 5) * SIMG + SOFF_GT + (tid & 31) * 16) = P##gm;          \
    if (tid < 64) *(uint4*)(smem + (tid >> 4) * SIMG + SOFF_G15 + (tid & 15) * 16) = P##g5;          \
    *(uint4*)(smem + (tid >> 6) * SIMG + SOFF_MR + (tid & 63) * 16) = P##mr;                         \
  }
#define SCANS_COMPUTE(SCI)                                                                           \
  _Pragma("unroll 1") for (int cl = 0; cl < SCH && (SCI) * SCH + cl < SEQ / 16; ++cl) {             \
    const char* img = smem + cl * SIMG;                                                              \
        \
    const uint2 vb = *(const uint2*)(img + 4 * SARR + vrow * SROW + vcol * 2);                       \
    const uint2 gt = *(const uint2*)(img + SOFF_GT + (q * 16 + 4 * g) * 2);                          \
    const char* wp = img + q * SROW + (4 * g) * 2;                                                   \
    const uint2 w00 = *(const uint2*)(wp), w01 = *(const uint2*)(wp + 32);                           \
    const uint2 w10 = *(const uint2*)(wp + 64), w11 = *(const uint2*)(wp + 96);                      \
    const uint2 r00 = *(const uint2*)(wp + SARR), r01 = *(const uint2*)(wp + SARR + 32);             \
    const uint2 r10 = *(const uint2*)(wp + SARR + 64), r11 = *(const uint2*)(wp + SARR + 96);        \
    const uint4 mr = *(const uint4*)(img + SOFF_MR + (q * 32 + g * 8) * 2);                          \
    uint2 bk0[4], bk1[4];                                                                            \
    float4 g15[4];                                                                                   \
    _Pragma("unroll") for (int n = 0; n < 4; ++n) {                                                  \
      const int ch = 16 * n + q;                                                                     \
      const char* bp = img + 2 * SARR + (ch >> 2) * SROW + ((ch & 3) * 16 + 4 * g) * 2;              \
      bk0[n] = *(const uint2*)(bp);                                                                  \
      bk1[n] = *(const uint2*)(bp + SARR);                                                           \
      g15[n] = *(const float4*)(img + SOFF_G15 + (16 * n + 4 * g) * 4);                              \
    }                                                                                                \
    __builtin_amdgcn_sched_barrier(0);                                                               \
    const bf16x8 sB0 = mk8(packacc(acc[0]), packacc(acc[1]));                                        \
    const bf16x8 sB1 = mk8(packacc(acc[2]), packacc(acc[3]));                                        \
    f32x4 Z = {0.f, 0.f, 0.f, 0.f};                                                                  \
    Z = __builtin_amdgcn_mfma_f32_16x16x32_bf16(mk8(gt, zero2), mk8(vb, zero2), Z, 0, 0, 0);         \
    f32x4 Y = {0.f, 0.f, 0.f, 0.f};                                                                  \
    Z = __builtin_amdgcn_mfma_f32_16x16x32_bf16(mk8(w00, w01), sB0, Z, 0, 0, 0);                     \
    Y = __builtin_amdgcn_mfma_f32_16x16x32_bf16(mk8(r00, r01), sB0, Y, 0, 0, 0);                     \
    Z = __builtin_amdgcn_mfma_f32_16x16x32_bf16(mk8(w10, w11), sB1, Z, 0, 0, 0);                     \
    Y = __builtin_amdgcn_mfma_f32_16x16x32_bf16(mk8(r10, r11), sB1, Y, 0, 0, 0);                     \
    const bf16x8 zvB = mk8(packacc(Z), vb);                                                          \
    Y = __builtin_amdgcn_mfma_f32_16x16x32_bf16(__builtin_bit_cast(bf16x8, mr), zvB, Y, 0, 0, 0);    \
    _Pragma("unroll") for (int n = 0; n < 4; ++n) {                                                  \
      f32x4 scv = acc[n];                                                                            \
      scv[0] *= g15[n].x; scv[1] *= g15[n].y; scv[2] *= g15[n].z; scv[3] *= g15[n].w;                \
      acc[n] = __builtin_amdgcn_mfma_f32_16x16x32_bf16(mk8(bk0[n], bk1[n]), zvB, scv, 0, 0, 0);      \
    }                                                                                                \
    _Pragma("unroll") for (int e = 0; e < 4; ++e)                                                    \
        ybuf[(cl * 16 + 4 * g + e) * 16 + q] = (bfu)f2bf(Y[e]);                                      \
  }
DEVI void scans_block(const Params& p, char* smem, int bh, int vs) {
  const int b = bh >> 4, h = bh & 15;
  const int lane = threadIdx.x & 63, wv = threadIdx.x >> 6, q = lane & 15, g = lane >> 4;
  f32x4 acc[4];
#pragma unroll
  for (int n = 0; n < 4; ++n) acc[n] = f32x4{0.f, 0.f, 0.f, 0.f};
  const uint2 zero2 = {0u, 0u};
  bfu* yout = p.YS + ((size_t)b * SEQ) * 1024 + h * 64 + vs * 16;
  bfu* ybuf = (bfu*)(smem + SCH * SIMG);
  const int tid = TIDX, grp = HF;
  const int cl0 = tid >> 7, row0 = (tid >> 3) & 15, c80 = tid & 7;
  uint4 Aa0, Aa1, Ar0, Ar1, Ae0, Ae1, Ak0, Ak1, Av0, Av1, Agm, Ag5, Amr;
  constexpr int NSC = (SEQ / 16 + SCH - 1) / SCH;
  const int vrow = vs * 4 + (q >> 2), vcol = (q & 3) * 16 + 4 * g;
  if (grp == 0) {
    SCANS_ISSUE(A, 0);
    SCANS_COMMIT(A);
    SCANS_ISSUE(A, 2);
  } else {
    SCANS_ISSUE(A, 1);
  }
  __syncthreads();
#pragma unroll 1
  for (int sc = 0; sc < NSC; ++sc) {
    if (wv == 0) {
      SCANS_COMPUTE(sc);
    }
    __syncthreads();
    if (threadIdx.x >= 64 && threadIdx.x < 64 + SCH * 32) {
      const int idx = threadIdx.x - 64, tok = sc * SCH * 16 + (idx >> 1);
      if (tok < SEQ) *(uint4*)(yout + (size_t)tok * 1024 + (idx & 1) * 8) = *(const uint4*)(ybuf + (idx >> 1) * 16 + (idx & 1) * 8);
    }
    if (((sc + 1) & 1) == grp) {
      SCANS_COMMIT(A);
      SCANS_ISSUE(A, (sc + 3 < NSC ? sc + 3 : NSC - 1));
    }
    __syncthreads();
  }
}
DEVI void phase6(const Params& p, char* smem, int bid, int nb) {
  for (int it = bid; it < 128; it += nb) scans_block(p, smem, it >> 2, it & 3);
}

DEVI void phase6b(const Params& p, int bid, int nb) {
  const int lane = threadIdx.x & 63, wv = (threadIdx.x >> 6) & 3;
  for (int it = bid; it < T_TOK / 4; it += nb) {
    const int t0 = it * 4 + (threadIdx.x >> 8) * 2;
    float ys[8], vv[8], sg[8], bon[8];
#pragma unroll
    for (int j = 0; j < 8; ++j) {
      const int t = t0 + (j >> 2), h = wv * 4 + (j & 3);
      const int tb = t & ~15, tau = t & 15;
      const size_t idx = (size_t)t * 1024 + h * 64 + lane;
      ys[j] = bf2f(p.YS[idx]);
      sg[j] = bf2f(p.SG[idx]);
      vv[j] = bf2f(p.V1[(size_t)(tb + (lane >> 2)) * 1024 + h * 64 + (lane & 3) * 16 + tau]);
      bon[j] = p.COEF[(size_t)t * 16 + h];
    }
#pragma unroll
    for (int j = 0; j < 8; ++j) {
      const int t = t0 + (j >> 2), h = wv * 4 + (j & 3);
      const int c = h * 64 + lane;
      const float mean = wave_sum(ys[j]) * (1.f / 64.f);
      const float dv = ys[j] - mean;
      const float var = wave_sum(dv * dv) * (1.f / 64.f);
      float y = dv * rsqrtf(var + 64e-5f) * p.lnw[c] + p.lnb[c];
      y = (y + bon[j] * vv[j]) * sg[j];
      p.YS[(size_t)t * 1024 + c] = (bfu)f2bf(y);
    }
  }
}

DEVI void phase7(const Params& p, char* smem, int bid, int nb) {
  PgEpiRes E{p.out, p.out};
  pg_gemm(smem, p.YS, p.WT_o, T_TOK, 1024, 1024, E, bid, nb);
}
DEVI void phase8(const Params& p, int bid, int nb) {
  for (int it = bid; it < T_TOK / 16; it += nb) {
    const int row = it * 16 + (threadIdx.x >> 6) * 2;
    const int lane = threadIdx.x & 63;
    float* src = p.out + (size_t)row * 1024;
    float4 v[2][4];
    float ss[2] = {0.f, 0.f};
#pragma unroll
    for (int r = 0; r < 2; ++r)
#pragma unroll
      for (int i = 0; i < 4; ++i) v[r][i] = *(const float4*)(src + r * 1024 + lane * 4 + 256 * i);
#pragma unroll
    for (int r = 0; r < 2; ++r)
#pragma unroll
      for (int i = 0; i < 4; ++i)
        ss[r] += v[r][i].x * v[r][i].x + v[r][i].y * v[r][i].y + v[r][i].z * v[r][i].z + v[r][i].w * v[r][i].w;
#pragma unroll
    for (int r = 0; r < 2; ++r) {
      const float rinv = rsqrtf(wave_sum(ss[r]) * (1.f / 1024.f) + 1e-6f);
#pragma unroll
      for (int i = 0; i < 4; ++i) {
        const float4 g = *(const float4*)(p.fnorm + lane * 4 + 256 * i);
        const float4 o = {v[r][i].x * rinv * g.x, v[r][i].y * rinv * g.y, v[r][i].z * rinv * g.z, v[r][i].w * rinv * g.w};
        *(float4*)(src + r * 1024 + lane * 4 + 256 * i) = o;
      }
    }
  }
}

#define XB_TMO      128
#define XB_XCNT(j)  (256  + 64 * (j))
#define XB_XSUB(j)  (1280 + 64 * (j))
#define XB_XGEN(j)  (2304 + 64 * (j))
#define XB_TOP      3328
#define XB_TOPGEN   3392
#define XCD_BAR_WORDS 3456
#define XB_SPIN_CAP (1u << 18)
#define LAS __attribute__((address_space(3)))

__device__ __forceinline__ unsigned xb_ld(unsigned* p)              { return __hip_atomic_load(p, __ATOMIC_RELAXED, __HIP_MEMORY_SCOPE_AGENT); }
__device__ __forceinline__ unsigned xb_add(unsigned* p, unsigned v) { return __hip_atomic_fetch_add(p, v, __ATOMIC_RELAXED, __HIP_MEMORY_SCOPE_AGENT); }
__device__ __forceinline__ unsigned xb_xcc_id() { return (unsigned)__builtin_amdgcn_s_getreg((3 << 11) | 20) & 0xFu; }
#define XB_SPIN(cond, bar) do { unsigned _sp = 0; while (cond) { __builtin_amdgcn_s_sleep(1); \
    if ((++_sp & 255u) == 0u) { if (xb_ld(&(bar)[XB_TMO])) break; if (_sp > XB_SPIN_CAP) { atomicAdd(&(bar)[XB_TMO], 1u); break; } } } } while (0)

struct XcdBarrier {
    unsigned* bar; unsigned x;
    volatile LAS unsigned* st;
};

__device__ __forceinline__ XcdBarrier xcd_barrier_post(unsigned* bar, volatile LAS unsigned* st) {
    XcdBarrier b; b.bar = bar; b.x = xb_xcc_id(); b.st = st;
    if (threadIdx.x == 0) (void)xb_add(&bar[XB_XCNT(b.x)], 1u);
    return b;
}
__device__ __forceinline__ void xcd_barrier_complete(unsigned* bar, unsigned x, unsigned& nloc, unsigned& nx) {
    const unsigned G = gridDim.x * gridDim.y * gridDim.z;
    unsigned sum, cnt, mine, sp = 0u;
    for (;;) {
        sum = 0u; cnt = 0u; mine = 0u;
#pragma unroll
        for (unsigned j = 0; j < 16; ++j) { const unsigned c = xb_ld(&bar[XB_XCNT(j)]); sum += c; cnt += (c > 0u) ? 1u : 0u; mine = (j == x) ? c : mine; }
        if (sum == G) break;
        __builtin_amdgcn_s_sleep(1);
        if ((++sp & 255u) == 0u) { if (xb_ld(&bar[XB_TMO])) break; if (sp > XB_SPIN_CAP) { atomicAdd(&bar[XB_TMO], 1u); break; } }
    }
    nloc = mine > 0u ? mine : 1u; nx = cnt > 0u ? cnt : 1u;
}

__device__ __forceinline__ void xcd_barrier(const XcdBarrier& b) {
    asm volatile("s_waitcnt vmcnt(0)" ::: "memory");
    __syncthreads();
    if (threadIdx.x == 0) {
        unsigned* bar = b.bar;
        __builtin_amdgcn_s_waitcnt(0);
        unsigned nloc = b.st[0], nx = b.st[1];
        if (nloc == 0u) { xcd_barrier_complete(bar, b.x, nloc, nx); b.st[0] = nloc; b.st[1] = nx; }
        const unsigned old = xb_add(&bar[XB_XSUB(b.x)], 1u);
        const unsigned gen = old / nloc;
        if (old + 1u == (gen + 1u) * nloc) {
            __builtin_amdgcn_fence(__ATOMIC_RELEASE, "agent");
            asm volatile("s_waitcnt vmcnt(0)" ::: "memory");
            const unsigned og = xb_add(&bar[XB_TOP], 1u);
            const unsigned tg = og / nx;
            if (og + 1u == (tg + 1u) * nx) xb_add(&bar[XB_TOPGEN], 1u);
            else XB_SPIN(xb_ld(&bar[XB_TOPGEN]) == tg, bar);
            __builtin_amdgcn_fence(__ATOMIC_ACQUIRE, "agent");
            xb_add(&bar[XB_XGEN(b.x)], 1u);
            asm volatile("s_waitcnt vmcnt(0)" ::: "memory");
        } else {
            XB_SPIN(xb_ld(&bar[XB_XGEN(b.x)]) == gen, bar);
            __builtin_amdgcn_fence(__ATOMIC_ACQUIRE, "agent");
            asm volatile("s_waitcnt vmcnt(0)" ::: "memory");
        }
    }
    __syncthreads();
}


template <int PH>
DEVI void run_phase(const Params& p, char* smem, int bid, int nb) {
  if (PH == 0) phase0(p, smem, bid, nb);
  if (PH == 1) phase1(p, smem, bid, nb);
  if (PH == 2) phase2(p, smem, bid, nb);
  if (PH == 3) phase3(p, smem, bid, nb);
  if (PH == 4) phase3b(p, bid, nb);
  if (PH == 5) phaseM(p, smem, bid, nb);
  if (PH == 6) phase3a(p, smem, bid, nb);
  if (PH == 7) phase3c(p, smem, bid, nb);
  if (PH == 8) phase5(p, smem, bid, nb);
  if (PH == 9) phase6x(p, smem, bid, nb);
  if (PH == 10) phase6(p, smem, bid, nb);
  if (PH == 11) phase6b(p, bid, nb);
  if (PH == 12) phase7(p, smem, bid, nb);
  if (PH == 13) phase8(p, bid, nb);
}

#ifndef REP_MASK
#define REP_MASK 0
#endif
template <int PH>
DEVI void mega_phase(const Params& p, char* smem, cg::grid_group& grid, int bid, int nb) {
  run_phase<PH>(p, smem, bid, nb);
  if ((REP_MASK >> PH) & 1) {
    grid.sync();
    run_phase<PH>(p, smem, bid, nb);
  }
}
__global__ void __launch_bounds__(512, 2) mega_kernel(Params pk) {
  const Params& p = *(const Params*)__builtin_amdgcn_kernarg_segment_ptr();
  extern __shared__ __attribute__((aligned(16))) char smem[];
  cg::grid_group grid = cg::this_grid();
  const int bid = blockIdx.x, nb = gridDim.x;
  volatile LAS unsigned* st = (volatile LAS unsigned*)(smem + SMEM_BYTES);
  if (threadIdx.x == 0) {
    st[0] = 0u;
    st[1] = 0u;
  }
  __syncthreads();
  (void)xcd_barrier_post(p.BAR, st);
#define XBAR() do { XcdBarrier xb_; xb_.bar = p.BAR; xb_.x = xb_xcc_id(); xb_.st = (volatile LAS unsigned*)(smem + SMEM_BYTES); xcd_barrier(xb_); } while (0)
  mega_phase<0>(p, smem, grid, bid, nb); grid.sync();
  mega_phase<1>(p, smem, grid, bid, nb); XBAR();
  mega_phase<2>(p, smem, grid, bid, nb); XBAR();
  mega_phase<3>(p, smem, grid, bid, nb); XBAR();
  mega_phase<4>(p, smem, grid, bid, nb); XBAR();
  mega_phase<5>(p, smem, grid, bid, nb); XBAR();
  mega_phase<6>(p, smem, grid, bid, nb); XBAR();
  mega_phase<7>(p, smem, grid, bid, nb); XBAR();
  mega_phase<8>(p, smem, grid, bid, nb); XBAR();
  mega_phase<9>(p, smem, grid, bid, nb); XBAR();
  mega_phase<10>(p, smem, grid, bid, nb); XBAR();
  mega_phase<11>(p, smem, grid, bid, nb); XBAR();
  mega_phase<12>(p, smem, grid, bid, nb); grid.sync();
  mega_phase<13>(p, smem, grid, bid, nb);
}

extern "C" void kernel_launch(void* const* d_in, const int* in_sizes, int n_in, void* d_out, int out_size, void* d_ws,
                              size_t ws_size, hipStream_t stream) {
  Params p{};
  const float** fp = (const float**)&p;
  for (int i = 0; i < 26; ++i) fp[i] = (const float*)d_in[i];
  p.out = (float*)d_out;
  char* w = (char*)d_ws;
  size_t off = 0;
  auto take = [&](size_t bytes) {
    char* r = w + off;
    off += (bytes + 255) & ~(size_t)255;
    return (bfu*)r;
  };
  p.WT_in = take((size_t)3584 * 1024 * 2);
  p.WT_out = take((size_t)1024 * 1024 * 2);
  p.WT_3 = take((size_t)4352 * 1024 * 2);
  p.WT_o = take((size_t)1024 * 1024 * 2);
  p.W2T = take((size_t)1024 * 64 * 2);
  p.A2T = take((size_t)1024 * 64 * 2);
  p.TW = take((size_t)T_TOK * 64 * 2);
  p.TA = take((size_t)T_TOK * 64 * 2);
  const size_t SLOT = (size_t)T_TOK * 1024 * 2;
  bfu* slot0 = take(SLOT);
  bfu* slots = take(6 * SLOT);
  p.H = slot0;
  p.AA = slot0;
  p.U = slots;
  p.GVT = slots + SLOT / 4;
  p.Q = slots + 2 * (SLOT / 4);
  p.K = slots + 3 * (SLOT / 4);
  p.VT = slots + 4 * (SLOT / 4);
  p.SZ = slots + 7 * (SLOT / 4);
  p.Y = slots + 9 * (SLOT / 4);
  p.R = slots;
  p.K1 = slots + 1 * (SLOT / 2);
  p.XV = slots + 2 * (SLOT / 2);
  p.XG = slots + 3 * (SLOT / 2);
  p.XR = slots + 4 * (SLOT / 2);
  p.XK = slots + 5 * (SLOT / 2);
  p.V1 = slots + 4 * (SLOT / 2);
  p.SG = slots + 5 * (SLOT / 2);
  p.EW = slots + 2 * (SLOT / 2);
  p.YS = slots + 3 * (SLOT / 2);
  p.G15 = (float*)p.TW;
  p.GT = p.WT_in;
  p.MRT = take((size_t)(SEQ / 16) * 32 * 512 * 2);
  p.COEF = (float*)take((size_t)T_TOK * 16 * 4);
  p.BAR = (unsigned*)take((size_t)XCD_BAR_WORDS * 4);
  if (off > ws_size) {
    fprintf(stderr, "workspace too small: need %zu have %zu\n", off, ws_size);
    return;
  }
  static int grid_blocks = 0;
  if (!grid_blocks) {
    int dev = 0, cus = 0, per_cu = 0;
    (void)hipGetDevice(&dev);
    (void)hipDeviceGetAttribute(&cus, hipDeviceAttributeMultiprocessorCount, dev);
    (void)hipFuncSetAttribute((const void*)mega_kernel, hipFuncAttributeMaxDynamicSharedMemorySize, SMEM_BYTES + 16);
    (void)hipOccupancyMaxActiveBlocksPerMultiprocessor(&per_cu, mega_kernel, 512, SMEM_BYTES + 16);
    grid_blocks = cus * per_cu;
  }
  (void)hipMemsetAsync(p.BAR, 0, (size_t)XCD_BAR_WORDS * 4, stream);
  void* args[] = {&p};
  hipError_t e = hipLaunchCooperativeKernel((void*)mega_kernel, dim3(grid_blocks), dim3(512), args, SMEM_BYTES + 16, stream);
  if (e != hipSuccess) fprintf(stderr, "cooperative launch failed: %s (grid %d)\n", hipGetErrorString(e), grid_blocks);
}
```

```cpp
#include <hip/hip_runtime.h>
#include <hip/hip_cooperative_groups.h>
#include <stdint.h>
#include <cstdio>
namespace cg = cooperative_groups;

#ifndef MEGA
#define MEGA 1
#endif

typedef unsigned short bfu;
using bf16x8 = __attribute__((ext_vector_type(8))) short;
using f32x4 = __attribute__((ext_vector_type(4))) float;
#define DEVI __device__ __forceinline__
#define TIDX ((int)(threadIdx.x & 255))
#define HF ((int)(threadIdx.x >> 8))

constexpr int GSTAGE_BYTES = 2 * 128 * 72 * 2;
constexpr int T_TOK = 32768;
constexpr int SEQ = 16384;
constexpr int HALF_SMEM = 2 * GSTAGE_BYTES + 4096 + 512;
constexpr int SMEM_BYTES = 2 * HALF_SMEM;
constexpr int SMEM_UNUSED_ = 0;

struct Params {
  const float *x, *ln_even, *w_in, *gm_norm, *gm_ws, *gm_b, *w_out, *ln_odd, *mu, *wr, *wk, *wv, *wg, *w0, *w1, *w2,
      *a0, *a1, *a2, *k_k, *k_a, *r_k, *lnw, *lnb, *wo, *fnorm;
  float* out;
  bfu *WT_in, *WT_out, *WT_3, *WT_o, *W2T, *A2T;
  bfu *H, *U, *GVT, *Q, *K, *VT, *SZ, *Y, *R, *K1, *V1, *SG, *EW, *AA, *YS, *TW, *TA, *GT, *MRT, *XR, *XK, *XV, *XG;
  float *G15, *COEF;
  unsigned* BAR;
};

DEVI float bf2f(unsigned b) { return __uint_as_float(b << 16); }
DEVI unsigned f2bf(float x) {
  const __bf16 h = (__bf16)x;
  return (unsigned)__builtin_bit_cast(unsigned short, h);
}
typedef __bf16 bf16x2_t __attribute__((ext_vector_type(2)));
typedef float float2_t __attribute__((ext_vector_type(2)));
DEVI unsigned pkbf(float a, float b) {
  const float2_t f = {a, b};
  const bf16x2_t h = __builtin_convertvector(f, bf16x2_t);
  return __builtin_bit_cast(unsigned, h);
}
DEVI void unpack8(uint4 v, float* f) {
  f[0] = __uint_as_float(v.x << 16); f[1] = __uint_as_float(v.x & 0xffff0000u);
  f[2] = __uint_as_float(v.y << 16); f[3] = __uint_as_float(v.y & 0xffff0000u);
  f[4] = __uint_as_float(v.z << 16); f[5] = __uint_as_float(v.z & 0xffff0000u);
  f[6] = __uint_as_float(v.w << 16); f[7] = __uint_as_float(v.w & 0xffff0000u);
}
DEVI uint4 pack8(const float* f) {
  uint4 r;
  r.x = pkbf(f[0], f[1]);
  r.y = pkbf(f[2], f[3]);
  r.z = pkbf(f[4], f[5]);
  r.w = pkbf(f[6], f[7]);
  return r;
}
DEVI void unpack4(uint2 v, float* f) {
  f[0] = __uint_as_float(v.x << 16); f[1] = __uint_as_float(v.x & 0xffff0000u);
  f[2] = __uint_as_float(v.y << 16); f[3] = __uint_as_float(v.y & 0xffff0000u);
}
DEVI uint2 pack4(const float* f) {
  uint2 r;
  r.x = pkbf(f[0], f[1]);
  r.y = pkbf(f[2], f[3]);
  return r;
}

DEVI float sigmoid_(float x) { return __builtin_amdgcn_rcpf(1.f + __expf(-x)); }
DEVI float silu_(float x) { return x * sigmoid_(x); }
DEVI float tanh_(float y) { return 1.f - 2.f * __builtin_amdgcn_rcpf(1.f + __expf(2.f * y)); }
DEVI float gelu_(float x) {
  const float y = 0.7978845608028654f * (x + 0.044715f * x * x * x);
  return x * __builtin_amdgcn_rcpf(1.f + __expf(-2.f * y));
}
DEVI float wave_sum(float v) {
#pragma unroll
  for (int o = 32; o > 0; o >>= 1) v += __shfl_xor(v, o);
  return v;
}
DEVI float wave_max(float v) {
#pragma unroll
  for (int o = 32; o > 0; o >>= 1) v = fmaxf(v, __shfl_xor(v, o));
  return v;
}
template <int CTRL>
DEVI float dppf(float x) {
  return __int_as_float(__builtin_amdgcn_update_dpp(0, __float_as_int(x), CTRL, 0xF, 0xF, true));
}
DEVI float reduce16(float x) {
  x += dppf<0xB1>(x);
  x += dppf<0x4E>(x);
  x += dppf<0x141>(x);
  x += dppf<0x140>(x);
  return x;
}

constexpr int LROW = 72;
constexpr int GSTAGE = 2 * 128 * LROW;

template <int DIST = 2, bool SW = true, class ALoad, class Epi>
DEVI void gemm_tile(char* smem, const ALoad& aload, const bfu* __restrict__ Bt, int ldb, int K, int m0, int n0,
                    const Epi& epi) {
  bfu* sbase = (bfu*)smem;
  const int tid = TIDX, lane = tid & 63, wid = tid >> 6, wr = wid >> 1, wc = wid & 1;
  const int fr = lane & 15, fq = lane >> 4;
  f32x4 acc[4][4];
#pragma unroll
  for (int i = 0; i < 4; ++i)
#pragma unroll
    for (int j = 0; j < 4; ++j) acc[i][j] = f32x4{0.f, 0.f, 0.f, 0.f};
  const int r0 = tid >> 3, kc = (tid & 7) * 8;
  const int nk = K >> 6;
  struct GRegs { typename ALoad::Raw a0, a1, a2, a3; uint4 ap, b0, b1, b2, b3; };
  GRegs g0, g1;
  const bfu* Bp = Bt + (size_t)(n0 + r0) * ldb + kc;
  const size_t ldb32 = (size_t)ldb * 32;
  constexpr int ARS = ALoad::kConsec ? 1 : 32;
  const int ar0 = ALoad::kConsec ? 4 * r0 : r0;
#define GEMM_ISSUE(R, KT)                                   \
  {                                                         \
    const int k0_ = ((KT) << 6);                            \
    R.ap = aload.loadprev(m0 + ar0, k0_ + kc);              \
    R.a0 = aload.load(m0 + ar0, k0_ + kc);                  \
    R.a1 = aload.load(m0 + ar0 + ARS, k0_ + kc);            \
    R.a2 = aload.load(m0 + ar0 + 2 * ARS, k0_ + kc);        \
    R.a3 = aload.load(m0 + ar0 + 3 * ARS, k0_ + kc);        \
    R.b0 = *(const uint4*)(Bp + k0_);                       \
    R.b1 = *(const uint4*)(Bp + ldb32 + k0_);               \
    R.b2 = *(const uint4*)(Bp + 2 * ldb32 + k0_);           \
    R.b3 = *(const uint4*)(Bp + 3 * ldb32 + k0_);           \
  }
#define GEMM_COMMIT(R, S, KT)                               \
  {                                                         \
    const int k1_ = ((KT) << 6) + kc;                       \
    bfu* A_ = sbase + (S) * GSTAGE + ar0 * LROW + kc;       \
    bfu* B_ = sbase + (S) * GSTAGE + 128 * LROW + r0 * LROW + kc;   \
    *(uint4*)(A_) = aload.finish(R.a0, R.ap, m0 + ar0, k1_);                                 \
    *(uint4*)(A_ + ARS * LROW) = aload.finish(R.a1, aload.asprev(R.a0), m0 + ar0 + ARS, k1_);          \
    *(uint4*)(A_ + 2 * ARS * LROW) = aload.finish(R.a2, aload.asprev(R.a1), m0 + ar0 + 2 * ARS, k1_);  \
    *(uint4*)(A_ + 3 * ARS * LROW) = aload.finish(R.a3, aload.asprev(R.a2), m0 + ar0 + 3 * ARS, k1_);  \
    *(uint4*)(B_) = R.b0;                                   \
    *(uint4*)(B_ + 32 * LROW) = R.b1;                       \
    *(uint4*)(B_ + 64 * LROW) = R.b2;                       \
    *(uint4*)(B_ + 96 * LROW) = R.b3;                       \
  }
#define GEMM_COMPUTE(S)                                                                          \
  {                                                                                              \
    const bfu* cA = sbase + (S) * GSTAGE;                                                        \
    const bfu* cB = cA + 128 * LROW;                                                             \
    _Pragma("unroll") for (int ks = 0; ks < 2; ++ks) {                                           \
      bf16x8 af[4], bfv[4];                                                                      \
      _Pragma("unroll") for (int i = 0; i < 4; ++i) {                                            \
        af[i] = *(const bf16x8*)(cA + (wr * 64 + i * 16 + fr) * LROW + ks * 32 + fq * 8);        \
        bfv[i] = *(const bf16x8*)(cB + (wc * 64 + i * 16 + fr) * LROW + ks * 32 + fq * 8);       \
      }                                                                                          \
      _Pragma("unroll") for (int i = 0; i < 4; ++i) _Pragma("unroll") for (int j = 0; j < 4; ++j) \
          acc[i][j] = SW ? __builtin_amdgcn_mfma_f32_16x16x32_bf16(bfv[j], af[i], acc[i][j], 0, 0, 0)     \
                         : __builtin_amdgcn_mfma_f32_16x16x32_bf16(af[i], bfv[j], acc[i][j], 0, 0, 0);    \
    }                                                                                            \
  }
  const int nkm1 = nk - 1;
  if (DIST == 2 && nk == 1) {
    GEMM_ISSUE(g0, 0);
    GEMM_COMMIT(g0, 0, 0);
    __syncthreads();
    GEMM_COMPUTE(0);
    __syncthreads();
  } else if (DIST == 2) {
    GEMM_ISSUE(g0, 0);
    GEMM_ISSUE(g1, (1 < nkm1 ? 1 : nkm1));
    GEMM_COMMIT(g0, 0, 0);
    GEMM_ISSUE(g0, (2 < nkm1 ? 2 : nkm1));
    __syncthreads();
    {
      for (int kt = 0; kt < nk; kt += 2) {
        GEMM_COMMIT(g1, 1, (kt + 1 < nkm1 ? kt + 1 : nkm1));
        GEMM_ISSUE(g1, (kt + 3 < nkm1 ? kt + 3 : nkm1));
        GEMM_COMPUTE(0);
        __syncthreads();
        GEMM_COMMIT(g0, 0, (kt + 2 < nkm1 ? kt + 2 : nkm1));
        GEMM_ISSUE(g0, (kt + 4 < nkm1 ? kt + 4 : nkm1));
        GEMM_COMPUTE(1);
        __syncthreads();
      }
    }
  } else {
    GEMM_ISSUE(g0, 0);
    GEMM_COMMIT(g0, 0, 0);
    GEMM_ISSUE(g0, (1 < nkm1 ? 1 : nkm1));
    __syncthreads();
    for (int kt = 0; kt < nk; kt += 2) {
      GEMM_COMMIT(g0, 1, (kt + 1 < nkm1 ? kt + 1 : nkm1));
      GEMM_ISSUE(g0, (kt + 2 < nkm1 ? kt + 2 : nkm1));
      GEMM_COMPUTE(0);
      __syncthreads();
      GEMM_COMMIT(g0, 0, (kt + 2 < nkm1 ? kt + 2 : nkm1));
      GEMM_ISSUE(g0, (kt + 3 < nkm1 ? kt + 3 : nkm1));
      GEMM_COMPUTE(1);
      __syncthreads();
    }
  }
#pragma unroll
  for (int i = 0; i < 4; ++i)
#pragma unroll
    for (int j = 0; j < 4; ++j) {
      if (SW) epi(m0 + wr * 64 + i * 16 + fr, n0 + wc * 64 + j * 16 + fq * 4, acc[i][j]);
      else epi(m0 + wr * 64 + i * 16 + fq * 4, n0 + wc * 64 + j * 16 + fr, acc[i][j]);
    }
}

namespace pg8 {
#define PG8_LAS __attribute__((address_space(3)))
typedef unsigned short bf16_t;
typedef short bf16x8 __attribute__((ext_vector_type(8)));
typedef float f32x4 __attribute__((ext_vector_type(4)));
typedef unsigned u32x4 __attribute__((ext_vector_type(4)));
constexpr int BM = 256, BK = 64, HALF = 128, HTB = HALF * BK * 2  , STAGE_BYTES = 8 * HTB, NXCD = 8, WGM = 8;

__host__ __device__ __forceinline__ int lds_byte(int r, int c) { const int st = (r >> 4) * 2 + (c >> 5), rr = r & 15, cc = c & 31, ob = rr * 64 + cc * 2; return st * 1024 + (ob ^ (((ob >> 9) & 1) << 5)); }
__host__ __device__ __forceinline__ void stage_rc(int b, int& R, int& C) { const int st = b / 1024, sb = b % 1024, swz = sb ^ (((sb >> 9) & 1) << 5); R = (st >> 1) * 16 + swz / 64; C = (st & 1) * 32 + (swz % 64) / 2; }
__host__ __device__ __forceinline__ int perm32(int rho) { const int n = rho >> 4, i = rho & 15; return 8 * (i >> 2) + 4 * n + (i & 3); }

struct Unit { int pm, pn; };
struct Gemm { const bf16_t* A; const bf16_t* Bt; int M, N, K; const bf16_t* A2; int pn_split; unsigned long long rmap, cmap;
  __device__ __forceinline__ size_t rt(int pm) const { return rmap ? (size_t)((rmap >> (4 * pm)) & 15ull) : (size_t)pm; }
  __device__ __forceinline__ size_t ct(int pn) const { return cmap ? (size_t)((cmap >> (4 * pn)) & 15ull) : (size_t)pn; } };

struct StaticOrder {
    int nM, nN, nwg, G, c;
    __host__ __device__ void init(int M, int N, int G_, int c_) { nM = M / BM; nN = N / BM; nwg = nM * nN; G = G_; c = c_; }
    __host__ __device__ bool next(int i, Unit& u) const {
        const long L = (long)i * G + c; if (L >= nwg) return false;
        int wgid = (int)L; { const int q = nwg / NXCD, r = nwg % NXCD, xcd = wgid % NXCD, off = wgid / NXCD; wgid = (xcd < r ? xcd * (q + 1) : r * (q + 1) + (xcd - r) * q) + off; }
        const int nig = WGM * nN, gid = wgid / nig, fm = gid * WGM, gsz = (nM - fm) < WGM ? (nM - fm) : WGM;
        u.pm = fm + ((wgid % nig) % gsz); u.pn = (wgid % nig) / gsz; return true;
    }
    __device__ __forceinline__ void a_ready(const Unit&) const {}
    __device__ __forceinline__ void done(const Unit&) const {}
};
struct CountedOrder : StaticOrder {
    const unsigned* ready; unsigned need; unsigned* tmo;
    __device__ __forceinline__ void a_ready(const Unit& u) const {
        if (threadIdx.x < 64) {
            const unsigned long long t0 = __builtin_amdgcn_s_memrealtime(); unsigned polls = 0;
            while ((unsigned)__builtin_amdgcn_readfirstlane(__hip_atomic_load(ready + 64 * u.pm, __ATOMIC_RELAXED, __HIP_MEMORY_SCOPE_AGENT)) < need) {
                if ((++polls & 255u) == 0u && __builtin_amdgcn_readfirstlane(__hip_atomic_load(tmo, __ATOMIC_RELAXED, __HIP_MEMORY_SCOPE_AGENT)) != 0u) break;
                if (__builtin_amdgcn_s_memrealtime() - t0 > 2000000ull) {
                    if (threadIdx.x == 0) { unsigned expect = 0u; __hip_atomic_compare_exchange_strong(tmo + 1, &expect, 0x600u | (unsigned)(u.pm & 0xff), __ATOMIC_RELAXED, __ATOMIC_RELAXED, __HIP_MEMORY_SCOPE_AGENT); __hip_atomic_store(tmo, 1u, __ATOMIC_RELAXED, __HIP_MEMORY_SCOPE_AGENT); }
                    break; }
                __builtin_amdgcn_s_sleep(2); }
            __builtin_amdgcn_fence(__ATOMIC_ACQUIRE, "agent");
            asm volatile("s_waitcnt vmcnt(0)" ::: "memory");
        }
#if !defined(BROKEN_HOOK_NO_BARRIER)
        asm volatile("" ::: "memory"); __builtin_amdgcn_s_barrier(); asm volatile("" ::: "memory");
#endif
    }
};

__device__ __forceinline__ unsigned cvt_pk_bf16(float lo, float hi) { unsigned r; asm volatile("v_cvt_pk_bf16_f32 %0, %1, %2" : "=v"(r) : "v"(lo), "v"(hi)); return r; }
typedef float f32x2 __attribute__((ext_vector_type(2)));
__device__ __forceinline__ f32x2 gelu_pk(f32x2 v) {
    const f32x2 av = __builtin_elementwise_abs(v), d = av * 0.2316418882f + 1.0f;
    f32x2 t; t.x = __builtin_amdgcn_rcpf(d.x); t.y = __builtin_amdgcn_rcpf(d.y);
    f32x2 q = t * 0.5307027145f + (-0.7265760135f); q = q * t + 0.7107068705f; q = q * t + (-0.142248368f); q = q * t + 0.127414796f; q = q * t;
    const f32x2 s = (v * v) * (-0.72134752044f);
    f32x2 e; e.x = __builtin_amdgcn_exp2f(s.x); e.y = __builtin_amdgcn_exp2f(s.y);
    const f32x2 m = v * (q * e), r = v - m;
    f32x2 o; o.x = v.x < 0.f ? m.x : r.x; o.y = v.y < 0.f ? m.y : r.y; return o;
}

struct EpiF32 {
    static constexpr bool PERM = false, AFTER_DRAIN = false;
    float* C; int ldc; const float* bias;
    __device__ __forceinline__ void operator()(const f32x4 (&acc)[2][2][4][2], const Unit& u, int wr, int wc, int fr, int fq) const {
        const int row0 = u.pm * BM + wr * 64 + fr, col0 = u.pn * BM + wc * 32 + 4 * fq;
        f32x4 bv[2][2];
#pragma unroll
        for (int bj = 0; bj < 2; ++bj)
#pragma unroll
            for (int n = 0; n < 2; ++n) bv[bj][n] = bias ? *(const f32x4*)(bias + col0 + bj * HALF + n * 16) : (f32x4){0.f, 0.f, 0.f, 0.f};
#pragma unroll
        for (int ai = 0; ai < 2; ++ai)
#pragma unroll
            for (int m = 0; m < 4; ++m) { float* rowp = C + (size_t)(row0 + ai * HALF + m * 16) * ldc + col0;
#pragma unroll
                for (int bj = 0; bj < 2; ++bj)
#pragma unroll
                    for (int n = 0; n < 2; ++n) *(f32x4*)(rowp + bj * HALF + n * 16) = acc[ai][bj][m][n] + bv[bj][n]; }
    }
};
template <int ACT  > struct EpiBf16 {
    static constexpr bool PERM = true, AFTER_DRAIN = false;
    bf16_t* O; int ldc; const float* bias; int split_cols; size_t split_stride;
    __device__ __forceinline__ void operator()(const f32x4 (&acc)[2][2][4][2], const Unit& u, int wr, int wc, int fr, int fq) const {
        const int row0 = u.pm * BM + wr * 64 + fr; int colt = u.pn * BM; bf16_t* base = O;
        if (split_cols) { const int t = colt / split_cols; base += (size_t)t * split_stride; colt -= t * split_cols; }
        const int col0 = colt + wc * 32 + 8 * fq, bcol0 = u.pn * BM + wc * 32 + 8 * fq;
        f32x4 bv[2][2];
#pragma unroll
        for (int bj = 0; bj < 2; ++bj)
#pragma unroll
            for (int n = 0; n < 2; ++n) bv[bj][n] = bias ? *(const f32x4*)(bias + bcol0 + bj * HALF + 4 * n) : (f32x4){0.f, 0.f, 0.f, 0.f};
#pragma unroll
        for (int ai = 0; ai < 2; ++ai)
#pragma unroll
            for (int m = 0; m < 4; ++m) { bf16_t* rowp = base + (size_t)(row0 + ai * HALF + m * 16) * ldc + col0;
#pragma unroll
                for (int bj = 0; bj < 2; ++bj) { f32x4 v0 = acc[ai][bj][m][0] + bv[bj][0], v1 = acc[ai][bj][m][1] + bv[bj][1];
                    if (ACT == 1) { f32x2 a = gelu_pk((f32x2){v0[0], v0[1]}), b = gelu_pk((f32x2){v0[2], v0[3]}), c = gelu_pk((f32x2){v1[0], v1[1]}), d = gelu_pk((f32x2){v1[2], v1[3]});
                        v0 = (f32x4){a.x, a.y, b.x, b.y}; v1 = (f32x4){c.x, c.y, d.x, d.y}; }
                    if (ACT == 2) {
#pragma unroll
                        for (int j = 0; j < 4; ++j) { v0[j] = 0.5f * v0[j] * (1.0f + erff(v0[j] * 0.70710678f)); v1[j] = 0.5f * v1[j] * (1.0f + erff(v1[j] * 0.70710678f)); } }
                    u32x4 w; w.x = cvt_pk_bf16(v0[0], v0[1]); w.y = cvt_pk_bf16(v0[2], v0[3]); w.z = cvt_pk_bf16(v1[0], v1[1]); w.w = cvt_pk_bf16(v1[2], v1[3]);
                    *(u32x4*)(rowp + bj * HALF) = w; } }
    }
};


template <class Epi, class Sched, bool STAMP = false>
__device__ __forceinline__ void gemm_phase(PG8_LAS unsigned char* lds, const Gemm g, const Sched& S, const Epi& E, unsigned long long* stamps) {
    const int tid = threadIdx.x, wid = __builtin_amdgcn_readfirstlane(tid >> 6), lane = tid & 63, wr = wid >> 2, wc = wid & 3, fr = lane & 15, fq = lane >> 4;
    const int K = g.K, nt = K / BK;
    int ts_lo = 0, ts_hi = 0, nts = 0; const unsigned long long rt_entry = STAMP ? (unsigned long long)wall_clock64() : 0ull;
#define PG8_STAMP() do { if (STAMP && wid == 0 && nts < 64) { const unsigned long long _c = (unsigned long long)clock64(); \
        ts_lo = (lane == nts) ? (int)(unsigned)_c : ts_lo; ts_hi = (lane == nts) ? (int)(unsigned)(_c >> 32) : ts_hi; ++nts; } } while (0)
    PG8_STAMP();
    unsigned voffA[2], voffB[2];
#pragma unroll
    for (int i = 0; i < 2; ++i) { int R, C; stage_rc(tid * 16 + i * 8192, R, C); const int Rb = Epi::PERM ? ((R & ~31) + perm32(R & 31)) : R;
        voffA[i] = (unsigned)(R * K + C) * 2u; voffB[i] = (unsigned)(Rb * K + C) * 2u; }
    const size_t kstep = (size_t)(BK * 2);
    const size_t hstep = (size_t)HALF * K * 2;
    const size_t tstep = 2 * hstep;
    const unsigned ldsw = (unsigned)wid * 1024u;
    const int aoff = lds_byte(wr * 64 + fr, fq * 8), boff = lds_byte(wc * 32 + fr, fq * 8);
#define PG8_SA(b, h) (((b) * 2 + (h)) * HTB)
#define PG8_SB(b, h) ((4 + (b) * 2 + (h)) * HTB)
#define PG8_STAGE(bufoff, gbase, voff) do { _Pragma("unroll") for (int _i = 0; _i < 2; ++_i) \
        __builtin_amdgcn_global_load_lds((const unsigned*)((const char*)(gbase) + (voff)[_i]), (PG8_LAS unsigned*)(lds + (bufoff) + ldsw + _i * 8192), 16, 0, 0); } while (0)
#define PG8_LDA(dst, b, h) do { _Pragma("unroll") for (int m = 0; m < 4; ++m) _Pragma("unroll") for (int k = 0; k < 2; ++k) dst[m][k] = *(const PG8_LAS bf16x8*)(lds + PG8_SA(b, h) + aoff + m * 2048 + k * 1024); } while (0)
#define PG8_LDB(dst, b, h) do { _Pragma("unroll") for (int n = 0; n < 2; ++n) _Pragma("unroll") for (int k = 0; k < 2; ++k) dst[n][k] = *(const PG8_LAS bf16x8*)(lds + PG8_SB(b, h) + boff + n * 2048 + k * 1024); } while (0)
#define PG8_MMA(ai, bj, At, Bt) do { __builtin_amdgcn_s_setprio(1); _Pragma("unroll") for (int m = 0; m < 4; ++m) _Pragma("unroll") for (int n = 0; n < 2; ++n) _Pragma("unroll") for (int k = 0; k < 2; ++k) \
        acc[ai][bj][m][n] = __builtin_amdgcn_mfma_f32_16x16x32_bf16(Bt[n][k], At[m][k], acc[ai][bj][m][n], 0, 0, 0); __builtin_amdgcn_s_setprio(0); } while (0)
#define PG8_WAIT_V(n) asm volatile("s_waitcnt vmcnt(" #n ")" ::: "memory")
#define PG8_WAIT_L(n) asm volatile("s_waitcnt lgkmcnt(" #n ")" ::: "memory")
#define PG8_BAR __builtin_amdgcn_s_barrier()
#define PG8_SCHED __builtin_amdgcn_sched_barrier(0)
    Unit cur, nxt; int ui = 0;
    if (!S.next(0, cur)) return;
    f32x4 acc[2][2][4][2];
#pragma unroll
    for (int a = 0; a < 2; ++a)
#pragma unroll
        for (int b = 0; b < 2; ++b)
#pragma unroll
            for (int m = 0; m < 4; ++m)
#pragma unroll
                for (int n = 0; n < 2; ++n) acc[a][b][m][n] = (f32x4){0.f, 0.f, 0.f, 0.f};
    bf16x8 At[4][2], B0[2][2], B1[2][2];
    const char* cA = (const char*)(cur.pn >= g.pn_split ? g.A2 : g.A) + g.rt(cur.pm) * tstep; const char* cB = (const char*)g.Bt + g.ct(cur.pn) * tstep;
    S.a_ready(cur);
    PG8_STAGE(PG8_SB(0, 0), cB, voffB); PG8_STAGE(PG8_SA(0, 0), cA, voffA); PG8_STAGE(PG8_SB(0, 1), cB + hstep, voffB); PG8_STAGE(PG8_SA(0, 1), cA + hstep, voffA);
    if (wr == 1) PG8_BAR;
    PG8_WAIT_V(4); PG8_BAR;
    PG8_STAGE(PG8_SB(1, 0), cB + kstep, voffB); PG8_STAGE(PG8_SA(1, 0), cA + kstep, voffA); PG8_STAGE(PG8_SB(1, 1), cB + hstep + kstep, voffB);
    PG8_WAIT_V(6); PG8_BAR;
    PG8_STAMP();
    for (;;) {
        const bool has_next = S.next(ui + 1, nxt);
        const char* nA = has_next ? (const char*)(nxt.pn >= g.pn_split ? g.A2 : g.A) + g.rt(nxt.pm) * tstep : cA; const char* nB = has_next ? (const char*)g.Bt + g.ct(nxt.pn) * tstep : cB;
        for (int t = 0; t < nt; t += 2) {
            const bool last = (t == nt - 2);
            const char* a1 = cA + (size_t)(t + 1) * kstep;
            const char* a2 = last ? nA : cA + (size_t)(t + 2) * kstep; const char* b2 = last ? nB : cB + (size_t)(t + 2) * kstep;
            const char* a3 = a2 + kstep; const char* b3 = b2 + kstep;
            if (last && has_next) S.a_ready(nxt);
            PG8_LDB(B0, 0, 0); PG8_SCHED; PG8_LDA(At, 0, 0); PG8_STAGE(PG8_SA(1, 1), a1 + hstep, voffA);
            PG8_WAIT_L(8); PG8_BAR; PG8_WAIT_L(0); PG8_MMA(0, 0, At, B0); PG8_BAR; PG8_SCHED;
            PG8_LDB(B1, 0, 1); PG8_STAGE(PG8_SB(0, 0), b2, voffB);
            PG8_BAR; PG8_WAIT_L(0); PG8_MMA(0, 1, At, B1); PG8_BAR;
            PG8_LDA(At, 0, 1); PG8_STAGE(PG8_SA(0, 0), a2, voffA);
            PG8_BAR; PG8_WAIT_L(0); PG8_MMA(1, 0, At, B0); PG8_BAR; PG8_SCHED;
            PG8_STAGE(PG8_SB(0, 1), b2 + hstep, voffB);
            PG8_WAIT_V(6); PG8_BAR; PG8_MMA(1, 1, At, B1); PG8_BAR;
            PG8_LDB(B0, 1, 0); PG8_SCHED; PG8_LDA(At, 1, 0); PG8_STAGE(PG8_SA(0, 1), a2 + hstep, voffA);
            PG8_WAIT_L(8); PG8_BAR; PG8_WAIT_L(0); PG8_MMA(0, 0, At, B0); PG8_BAR; PG8_SCHED;
            PG8_LDB(B1, 1, 1); PG8_STAGE(PG8_SB(1, 0), b3, voffB);
            PG8_BAR; PG8_WAIT_L(0); PG8_MMA(0, 1, At, B1); PG8_BAR;
            PG8_LDA(At, 1, 1); PG8_STAGE(PG8_SA(1, 0), a3, voffA);
            PG8_BAR; PG8_WAIT_L(0); PG8_MMA(1, 0, At, B0); PG8_BAR; PG8_SCHED;
            PG8_STAGE(PG8_SB(1, 1), b3 + hstep, voffB);
            PG8_WAIT_V(6); PG8_BAR; PG8_MMA(1, 1, At, B1); PG8_BAR;
        }
        PG8_STAMP();
        if constexpr (!Epi::AFTER_DRAIN) { E(acc, cur, wr, wc, fr, fq); S.done(cur); }
        PG8_STAMP();
        if (!has_next) break;
#pragma unroll
        for (int a = 0; a < 2; ++a)
#pragma unroll
            for (int b = 0; b < 2; ++b)
#pragma unroll
                for (int m = 0; m < 4; ++m)
#pragma unroll
                    for (int n = 0; n < 2; ++n) acc[a][b][m][n] = (f32x4){0.f, 0.f, 0.f, 0.f};
        cur = nxt; cA = nA; cB = nB; ++ui;
    }
    PG8_WAIT_V(0);
    if (wr == 0) PG8_BAR;
    PG8_BAR;
    if constexpr (Epi::AFTER_DRAIN) { E.fused(acc, cur, wr, wc, fr, fq, lds, wid, lane); S.done(cur); }
    PG8_STAMP();
    if (STAMP && wid == 0) { stamps[lane] = lane < nts ? (((unsigned long long)(unsigned)ts_hi << 32) | (unsigned)ts_lo) : 0ull;
        if (lane == 62) stamps[62] = rt_entry; if (lane == 63) stamps[63] = (unsigned long long)wall_clock64(); }
#undef PG8_STAMP
#undef PG8_SA
#undef PG8_SB
#undef PG8_STAGE
#undef PG8_LDA
#undef PG8_LDB
#undef PG8_MMA
#undef PG8_WAIT_V
#undef PG8_WAIT_L
#undef PG8_BAR
#undef PG8_SCHED
}
}

struct TileSched {
  int xcd, local, vbid, vnb, MT, NT, SM, SN, j, snc;
  bool swz;
  DEVI TileSched(int bid, int nb, int half, int MT_, int NT_, int SM_, int SN_) : MT(MT_), NT(NT_), SM(SM_), SN(SN_), j(0) {
    xcd = bid & 7;
    local = (bid >> 3) * 2 + half;
    vbid = bid * 2 + half;
    vnb = nb * 2;
    swz = (vnb == 8 * SM * SN) && ((nb & 7) == 0);
    snc = (NT + SN - 1) / SN;
  }
  DEVI int next(int& mt, int& nt) {
    if (swz) {
      const int s = j * 8 + xcd;
      ++j;
      const int sm = s / snc, sn = s - sm * snc;
      if (sm * SM >= MT) return 0;
      mt = sm * SM + local / SN;
      nt = sn * SN + local % SN;
      return (mt < MT && nt < NT) ? 1 : 2;
    } else {
      const int it = vbid + j * vnb;
      ++j;
      if (it >= MT * NT) return 0;
      mt = it / NT;
      nt = it - mt * NT;
      return 1;
    }
  }
};

struct ALoadPlain {
  typedef uint4 Raw;
  static constexpr bool kFat = false;
  static constexpr bool kConsec = false;
  const bfu* A;
  int lda;
  DEVI Raw load(int row, int k) const { return *(const uint4*)(A + (size_t)row * lda + k); }
  DEVI uint4 loadprev(int, int) const { return uint4{0u, 0u, 0u, 0u}; }
  DEVI uint4 asprev(const Raw&) const { return uint4{0u, 0u, 0u, 0u}; }
  DEVI uint4 finish(const Raw& r, const uint4&, int, int) const { return r; }
};

DEVI void transpose_tile(char* smem, const float* __restrict__ src, int Ns, bfu* __restrict__ dst, int ldd, int noff,
                         int k0, int n0) {
  float(*tile)[65] = (float(*)[65])smem;
  const int tid = TIDX;
  const int kr = tid >> 4, nc = (tid & 15) * 4;
#pragma unroll
  for (int p = 0; p < 4; ++p) {
    float4 v = *(const float4*)(src + (size_t)(k0 + kr + 16 * p) * Ns + n0 + nc);
    tile[kr + 16 * p][nc] = v.x;
    tile[kr + 16 * p][nc + 1] = v.y;
    tile[kr + 16 * p][nc + 2] = v.z;
    tile[kr + 16 * p][nc + 3] = v.w;
  }
  __syncthreads();
  const int nr = tid >> 3, kc = (tid & 7) * 8;
#pragma unroll
  for (int p = 0; p < 2; ++p) {
    const int n = nr + 32 * p;
    float f[8];
#pragma unroll
    for (int j = 0; j < 8; ++j) f[j] = tile[kc + j][n];
    *(uint4*)(dst + (size_t)(noff + n0 + n) * ldd + k0 + kc) = pack8(f);
  }
  __syncthreads();
}

DEVI void rms_row2_bf16(const float* __restrict__ src, const float* __restrict__ g, bfu* __restrict__ dst, int lane) {
  float4 v[2][4];
  float ss[2] = {0.f, 0.f};
#pragma unroll
  for (int r = 0; r < 2; ++r)
#pragma unroll
    for (int i = 0; i < 4; ++i) v[r][i] = *(const float4*)(src + r * 1024 + lane * 4 + 256 * i);
#pragma unroll
  for (int r = 0; r < 2; ++r)
#pragma unroll
    for (int i = 0; i < 4; ++i)
      ss[r] += v[r][i].x * v[r][i].x + v[r][i].y * v[r][i].y + v[r][i].z * v[r][i].z + v[r][i].w * v[r][i].w;
#pragma unroll
  for (int r = 0; r < 2; ++r) {
    const float rinv = rsqrtf(wave_sum(ss[r]) * (1.f / 1024.f) + 1e-6f);
#pragma unroll
    for (int i = 0; i < 4; ++i) {
      const float4 gg = *(const float4*)(g + lane * 4 + 256 * i);
      uint2 o;
      o.x = pkbf(v[r][i].x * rinv * gg.x, v[r][i].y * rinv * gg.y);
      o.y = pkbf(v[r][i].z * rinv * gg.z, v[r][i].w * rinv * gg.w);
      *(uint2*)(dst + r * 1024 + lane * 4 + 256 * i) = o;
    }
  }
}

DEVI void phase0(const Params& p, char* smem, int bid, int nb) {
  constexpr int NT_IN = 16 * 56, NT_SQ = 256, NT_SM = 16;
  constexpr int c0 = NT_IN, c1 = c0 + NT_SQ, c2 = c1 + 4 * NT_SQ, c3 = c2 + NT_SM, c4 = c3 + NT_SM, c5 = c4 + NT_SQ,
                c6 = c5 + NT_SM, c7 = c6 + NT_SM, c8 = c7 + 2, c9 = c8 + T_TOK / 8;
  smem += HF * HALF_SMEM;
  for (int it = bid * 2 + HF; it < c9; it += nb * 2) {
    if (it < c0) {
      transpose_tile(smem, p.w_in, 3584, p.WT_in, 1024, 0, (it / 56) * 64, (it % 56) * 64);
    } else if (it < c1) {
      int j = it - c0;
      transpose_tile(smem, p.w_out, 1024, p.WT_out, 1024, 0, (j >> 4) * 64, (j & 15) * 64);
    } else if (it < c2) {
      int j = it - c1;
      int w = j >> 8;
      j &= 255;
      const float* src = (w == 0) ? p.wr : (w == 1) ? p.wk : (w == 2) ? p.wv : p.wg;
      transpose_tile(smem, src, 1024, p.WT_3, 1024, w * 1024, (j >> 4) * 64, (j & 15) * 64);
    } else if (it < c3) {
      int j = it - c2;
      transpose_tile(smem, p.w1, 64, p.WT_3, 1024, 4096, j * 64, 0);
    } else if (it < c4) {
      int j = it - c3;
      transpose_tile(smem, p.a1, 64, p.WT_3, 1024, 4224, j * 64, 0);
    } else if (it < c5) {
      int j = it - c4;
      transpose_tile(smem, p.wo, 1024, p.WT_o, 1024, 0, (j >> 4) * 64, (j & 15) * 64);
    } else if (it < c6) {
      int j = it - c5;
      transpose_tile(smem, p.w2, 1024, p.W2T, 64, 0, 0, j * 64);
    } else if (it < c7) {
      int j = it - c6;
      transpose_tile(smem, p.a2, 1024, p.A2T, 64, 0, 0, j * 64);
    } else if (it < c8) {
      int j = it - c7;
      bfu* dst = p.WT_3 + (size_t)(j == 0 ? 4160 : 4288) * 1024;
      for (int e = TIDX; e < 64 * 1024 / 8; e += 256) *(uint4*)(dst + e * 8) = uint4{0, 0, 0, 0};
    } else {
      int row = (it - c8) * 8 + (TIDX >> 6) * 2;
      rms_row2_bf16(p.x + (size_t)row * 1024, p.ln_even, p.H + (size_t)row * 1024, TIDX & 63);
    }
  }
}

constexpr unsigned long long kCmap1 = 0xDCBA765410ull;
struct PgEpi1 {
  static constexpr bool PERM = true, AFTER_DRAIN = false;
  const Params* p;
  DEVI void operator()(const pg8::f32x4 (&acc)[2][2][4][2], const pg8::Unit& u, int wr, int wc, int fr, int fq) const {
    const int row0 = u.pm * 256 + wr * 64 + fr;
    const int seg = (int)((kCmap1 >> (4 * u.pn)) & 15ull);
#pragma unroll
    for (int ai = 0; ai < 2; ++ai)
#pragma unroll
      for (int m = 0; m < 4; ++m) {
        const int row = row0 + ai * 128 + m * 16;
#pragma unroll
        for (int bj = 0; bj < 2; ++bj) {
          const int col = seg * 256 + bj * 128 + wc * 32 + 8 * fq;
          const f32x4 v0 = acc[ai][bj][m][0], v1 = acc[ai][bj][m][1];
          uint4 w;
          if (seg < 2) {
            w.x = pkbf(gelu_(v0[0]), gelu_(v0[1])); w.y = pkbf(gelu_(v0[2]), gelu_(v0[3]));
            w.z = pkbf(gelu_(v1[0]), gelu_(v1[1])); w.w = pkbf(gelu_(v1[2]), gelu_(v1[3]));
            *(uint4*)(p->U + (size_t)row * 512 + col) = w;
          } else if (seg < 8) {
            w.x = pkbf(v0[0], v0[1]); w.y = pkbf(v0[2], v0[3]); w.z = pkbf(v1[0], v1[1]); w.w = pkbf(v1[2], v1[3]);
            bfu* dst = (seg < 6) ? p->Q + (size_t)row * 512 + (col - 1024) : p->K + (size_t)row * 512 + (col - 1536);
            *(uint4*)dst = w;
          } else {
            w.x = pkbf(silu_(v0[0]), silu_(v0[1])); w.y = pkbf(silu_(v0[2]), silu_(v0[3]));
            w.z = pkbf(silu_(v1[0]), silu_(v1[1])); w.w = pkbf(silu_(v1[2]), silu_(v1[3]));
            *(uint4*)(p->SZ + (size_t)row * 1024 + (col - 2560)) = w;
          }
        }
      }
  }
};
constexpr unsigned long long kRmap1 = 0x9832ull;
struct PgEpi1T {
  static constexpr bool PERM = true, AFTER_DRAIN = false;
  const Params* p;
  DEVI void operator()(const pg8::f32x4 (&acc)[2][2][4][2], const pg8::Unit& u, int wr, int wc, int fr, int fq) const {
    const int ch0 = (u.pm & 1) * 256 + wr * 64 + fr;
    const bool isv = u.pm >= 2;
#pragma unroll
    for (int ai = 0; ai < 2; ++ai)
#pragma unroll
      for (int m = 0; m < 4; ++m) {
        const int ch = ch0 + ai * 128 + m * 16;
#pragma unroll
        for (int bj = 0; bj < 2; ++bj) {
          const int t = u.pn * 256 + bj * 128 + wc * 32 + 8 * fq;
          const f32x4 v0 = acc[ai][bj][m][0], v1 = acc[ai][bj][m][1];
          if (!isv) {
            const int g = ch >> 7, c = ch & 127;
            uint4 w;
            w.x = pkbf(gelu_(v0[0]), gelu_(v0[1])); w.y = pkbf(gelu_(v0[2]), gelu_(v0[3]));
            w.z = pkbf(gelu_(v1[0]), gelu_(v1[1])); w.w = pkbf(gelu_(v1[2]), gelu_(v1[3]));
            *(uint4*)(p->GVT + ((size_t)(((t >> 7) * 4 + g) * 128 + c)) * 128 + (t & 127)) = w;
          } else {
            const int hh = ch >> 6, dim = ch & 63;
            const int b = t >> 14, s = t & (SEQ - 1);
            bfu* base = p->VT + ((size_t)((b * 8 + hh) * 64 + dim)) * SEQ;
            const size_t PST = (size_t)16 * 64 * SEQ;
            uint4 w;
            w.x = pkbf(v0[0], v0[1]); w.y = pkbf(v0[2], v0[3]); w.z = pkbf(v1[0], v1[1]); w.w = pkbf(v1[2], v1[3]);
            *(uint4*)(base + s) = w;
            bfu* b1 = base + PST + (s >> 2);
#pragma unroll
            for (int e = 0; e < 4; ++e) *(unsigned*)(b1 + (size_t)e * (SEQ / 4)) = pkbf(v0[e], v1[e]);
            bfu* b2 = base + 2 * PST + (size_t)(s & 15) * (SEQ / 16) + (s >> 4);
#pragma unroll
            for (int e = 0; e < 4; ++e) {
              b2[(size_t)e * (SEQ / 16)] = (bfu)f2bf(v0[e]);
              b2[(size_t)(e + 4) * (SEQ / 16)] = (bfu)f2bf(v1[e]);
            }
          }
        }
      }
  }
};
struct PgEpiRes {
  static constexpr bool PERM = false, AFTER_DRAIN = false;
  const float* base;
  float* out;
  DEVI void operator()(const pg8::f32x4 (&acc)[2][2][4][2], const pg8::Unit& u, int wr, int wc, int fr, int fq) const {
    const int row0 = u.pm * 256 + wr * 64 + fr, col0 = u.pn * 256 + wc * 32 + 4 * fq;
#pragma unroll
    for (int ai = 0; ai < 2; ++ai)
#pragma unroll
      for (int m = 0; m < 4; ++m) {
        const size_t rb = (size_t)(row0 + ai * 128 + m * 16) * 1024 + col0;
#pragma unroll
        for (int bj = 0; bj < 2; ++bj)
#pragma unroll
          for (int n = 0; n < 2; ++n) {
            const size_t idx = rb + bj * 128 + n * 16;
            const f32x4 b = *(const f32x4*)(base + idx);
            *(f32x4*)(out + idx) = acc[ai][bj][m][n] + b;
          }
      }
  }
};
template <class Epi>
DEVI void pg_gemm(char* smem, const bfu* A, const bfu* Bt, int M, int N, int K, const Epi& E, int bid, int nb) {
  pg8::Gemm g{A, Bt, M, N, K, A, 1 << 30, 0ull, 0ull};
  pg8::StaticOrder S;
  S.init(M, N, nb, bid);
  pg8::gemm_phase<Epi, pg8::StaticOrder, false>((PG8_LAS unsigned char*)smem, g, S, E, nullptr);
}
template <class Epi>
DEVI void pg_gemm2(char* smem, const bfu* A, const bfu* A2, int pn_split, const bfu* Bt, int M, int N, int K, const Epi& E,
                   int bid, int nb) {
  pg8::Gemm g{A, Bt, M, N, K, A2, pn_split, 0ull, 0ull};
  pg8::StaticOrder S;
  S.init(M, N, nb, bid);
  pg8::gemm_phase<Epi, pg8::StaticOrder, false>((PG8_LAS unsigned char*)smem, g, S, E, nullptr);
}
struct PgEpi3 {
  static constexpr bool PERM = true, AFTER_DRAIN = false;
  bfu* O0;
  bfu* O1;
  int silu1;
  DEVI void operator()(const pg8::f32x4 (&acc)[2][2][4][2], const pg8::Unit& u, int wr, int wc, int fr, int fq) const {
    const int row0 = u.pm * 256 + wr * 64 + fr;
    const int grp = u.pn >> 2;
    bfu* O = grp ? O1 : O0;
    const bool act = grp && silu1;
    const int colb = (u.pn & 3) * 256 + wc * 32 + 8 * fq;
#pragma unroll
    for (int ai = 0; ai < 2; ++ai)
#pragma unroll
      for (int m = 0; m < 4; ++m) {
        bfu* rowp = O + (size_t)(row0 + ai * 128 + m * 16) * 1024 + colb;
#pragma unroll
        for (int bj = 0; bj < 2; ++bj) {
          f32x4 v0 = acc[ai][bj][m][0], v1 = acc[ai][bj][m][1];
          if (act) {
#pragma unroll
            for (int e = 0; e < 4; ++e) {
              v0[e] = silu_(v0[e]);
              v1[e] = silu_(v1[e]);
            }
          }
          uint4 w;
          w.x = pkbf(v0[0], v0[1]); w.y = pkbf(v0[2], v0[3]); w.z = pkbf(v1[0], v1[1]); w.w = pkbf(v1[2], v1[3]);
          *(uint4*)(rowp + bj * 128) = w;
        }
      }
  }
};

DEVI void phase1(const Params& p, char* smem, int bid, int nb) {
  {
    PgEpi1 E{&p};
    pg8::Gemm g{p.H, p.WT_in, T_TOK, 2560, 1024, p.H, 1 << 30, 0ull, kCmap1};
    pg8::StaticOrder S;
    S.init(T_TOK, 2560, nb, bid);
    pg8::gemm_phase<PgEpi1, pg8::StaticOrder, false>((PG8_LAS unsigned char*)smem, g, S, E, nullptr);
  }
  {
    PgEpi1T E{&p};
    pg8::Gemm g{p.WT_in, p.H, 1024, T_TOK, 1024, p.WT_in, 1 << 30, kRmap1, 0ull};
    pg8::StaticOrder S;
    S.init(1024, T_TOK, nb, bid);
    pg8::gemm_phase<PgEpi1T, pg8::StaticOrder, false>((PG8_LAS unsigned char*)smem, g, S, E, nullptr);
  }
}

struct ALoadWs {
  struct Raw { float4 a, b; };
  static constexpr bool kFat = true;
  static constexpr bool kConsec = false;
  const float* ws;
  const float* rinv;
  DEVI Raw load(int t, int s0) const {
    Raw r;
    r.a = *(const float4*)(ws + t * 128 + s0);
    r.b = *(const float4*)(ws + t * 128 + s0 + 4);
    return r;
  }
  DEVI uint4 loadprev(int, int) const { return uint4{0u, 0u, 0u, 0u}; }
  DEVI uint4 asprev(const Raw&) const { return uint4{0u, 0u, 0u, 0u}; }
  DEVI uint4 finish(const Raw& r, const uint4&, int t, int s0) const {
    float f[8] = {r.a.x, r.a.y, r.a.z, r.a.w, r.b.x, r.b.y, r.b.z, r.b.w};
#pragma unroll
    for (int j = 0; j < 8; ++j) f[j] = (s0 + j <= t) ? f[j] * rinv[s0 + j] : 0.f;
    return pack8(f);
  }
};
struct EpiGm {
  const Params* p;
  int chunk, g;
  DEVI void operator()(int t, int c, f32x4 v) const {
    const float4 gn = *(const float4*)(p->gm_norm + g * 128 + c);
    const float bias = p->gm_b[g * 128 + t];
    const size_t tok = (size_t)chunk * 128 + t;
    float u[4], sz[4];
    unpack4(*(const uint2*)(p->U + tok * 512 + g * 128 + c), u);
    unpack4(*(const uint2*)(p->SZ + tok * 1024 + g * 128 + c), sz);
    uint2 o;
    o.x = pkbf(u[0] * (v[0] * gn.x + bias) * sz[0], u[1] * (v[1] * gn.y + bias) * sz[1]);
    o.y = pkbf(u[2] * (v[2] * gn.z + bias) * sz[2], u[3] * (v[3] * gn.w + bias) * sz[3]);
    *(uint2*)(p->Y + tok * 1024 + g * 128 + c) = o;
  }
};

DEVI void gmlp_item(const Params& p, char* smem, int item) {
  const int chunk = item >> 2, g = item & 3;
  const bfu* gv = p.GVT + (size_t)item * 128 * 128;
  float* rinv = (float*)(smem + 2 * GSTAGE_BYTES);
  const int tid = TIDX;
  {
    float* sred = rinv + 128;
    const int s4 = (tid & 31) * 4, cg = tid >> 5;
    uint2 raw[16];
#pragma unroll
    for (int i = 0; i < 16; ++i) raw[i] = *(const uint2*)(gv + (cg * 16 + i) * 128 + s4);
    float ss[4] = {0.f, 0.f, 0.f, 0.f};
#pragma unroll
    for (int i = 0; i < 16; ++i) {
      float f[4];
      unpack4(raw[i], f);
#pragma unroll
      for (int j = 0; j < 4; ++j) ss[j] += f[j] * f[j];
    }
    *(float4*)(sred + cg * 128 + s4) = float4{ss[0], ss[1], ss[2], ss[3]};
    __syncthreads();
    if (tid < 128) {
      float t = 0.f;
#pragma unroll
      for (int i = 0; i < 8; ++i) t += sred[i * 128 + tid];
      rinv[tid] = rsqrtf(t * (1.f / 128.f) + 1e-6f);
    }
  }
  __syncthreads();
  ALoadWs al{p.gm_ws + (size_t)g * 128 * 128, rinv};
  EpiGm epi{&p, chunk, g};
  gemm_tile(smem, al, gv, 128, 128, 0, 0, epi);
}

DEVI void attn_item(const Params& p, char* smem, int item) {
  const int qb = item & 63, bh = item >> 6, b = bh >> 3, h = bh & 7;
  const int q0 = qb * 256;
  bfu* Ob = (bfu*)smem;
  float* Mb = (float*)(smem + 32768);
  float* Lb = Mb + 256;
  const int tid = threadIdx.x, lane = tid & 63, wid = tid >> 6;
  const int qi = lane & 15, g = lane >> 4;
  const float slope = exp2f(-(float)(h + 1));
  const size_t tokb = (size_t)b * SEQ;
#pragma unroll 1
  for (int pi = 0; pi < 3; ++pi) {
    const int dshift = 2 * pi, d = 1 << dshift;
    const bfu* VT = p.VT + (size_t)pi * ((size_t)16 * 64 * SEQ) + (size_t)bh * 64 * SEQ;
#pragma unroll 1
    for (int u = wid; u < 16; u += 8) {
      const int r = u & (d - 1), tile = u >> dshift;
      const int sq0 = (q0 >> dshift) + tile * 16;
      const int sk0 = sq0 - 144;
      const int posq = ((sq0 + qi) << dshift) + r;
      const bfu* qp = p.Q + (tokb + posq) * 512 + h * 64 + g * 8;
      const bf16x8 qf0 = *(const bf16x8*)qp, qf1 = *(const bf16x8*)(qp + 32);
      const bfu* kbase = p.K + (tokb + r) * 512 + h * 64 + g * 8;
      const bfu* vbase = VT + (size_t)qi * SEQ + r * (SEQ >> dshift);
      bf16x8 kf[2][2];
      uint2 vf[4][2];
      auto loadkv = [&](int it) {
#pragma unroll
        for (int tt = 0; tt < 2; ++tt) {
          int sk = sk0 + (2 * it + tt) * 16 + qi;
          sk = sk < 0 ? 0 : sk;
          const bfu* kp = kbase + ((size_t)sk << dshift) * 512;
          kf[tt][0] = *(const bf16x8*)kp;
          kf[tt][1] = *(const bf16x8*)(kp + 32);
        }
        int kidx0 = sk0 + 32 * it + 4 * g, kidx1 = kidx0 + 16;
        kidx0 = kidx0 < 0 ? 0 : kidx0;
        kidx1 = kidx1 < 0 ? 0 : kidx1;
#pragma unroll
        for (int m = 0; m < 4; ++m) {
          vf[m][0] = *(const uint2*)(vbase + (size_t)(16 * m) * SEQ + kidx0);
          vf[m][1] = *(const uint2*)(vbase + (size_t)(16 * m) * SEQ + kidx1);
        }
      };
      loadkv(0);
      const int hi = 144 + qi, lo = (16 + qi > -sk0) ? 16 + qi : -sk0;
      const float sd = slope * (float)d;
      float mrun = -1e30f, l = 0.f;
      f32x4 O[4];
#pragma unroll
      for (int m = 0; m < 4; ++m) O[m] = f32x4{0.f, 0.f, 0.f, 0.f};
#pragma unroll 1
      for (int it = 0; it < 5; ++it) {
        bf16x8 ck[2][2];
        uint2 cv[4][2];
#pragma unroll
        for (int a = 0; a < 2; ++a)
#pragma unroll
          for (int c = 0; c < 2; ++c) ck[a][c] = kf[a][c];
#pragma unroll
        for (int m = 0; m < 4; ++m) {
          cv[m][0] = vf[m][0];
          cv[m][1] = vf[m][1];
        }
        if (it < 4) loadkv(it + 1);
        f32x4 S[2];
#pragma unroll
        for (int tt = 0; tt < 2; ++tt) {
          f32x4 z = {0.f, 0.f, 0.f, 0.f};
          z = __builtin_amdgcn_mfma_f32_16x16x32_bf16(ck[tt][0], qf0, z, 0, 0, 0);
          z = __builtin_amdgcn_mfma_f32_16x16x32_bf16(ck[tt][1], qf1, z, 0, 0, 0);
          S[tt] = z;
        }
        float mx = -INFINITY;
#pragma unroll
        for (int tt = 0; tt < 2; ++tt)
#pragma unroll
          for (int e = 0; e < 4; ++e) {
            const int kb = (2 * it + tt) * 16 + 4 * g;
            const bool valid = (kb >= lo - e) && (kb <= hi - e);
            const float sv = valid ? fmaf(S[tt][e], 0.125f, sd * (float)e - sd * (float)(hi - kb)) : -INFINITY;
            S[tt][e] = sv;
            mx = fmaxf(mx, sv);
          }
        mx = fmaxf(mx, __shfl_xor(mx, 16));
        mx = fmaxf(mx, __shfl_xor(mx, 32));
        const float mnew = fmaxf(mrun, mx);
        const float alpha = __expf(mrun - mnew);
        mrun = mnew;
        float ls = 0.f;
#pragma unroll
        for (int tt = 0; tt < 2; ++tt)
#pragma unroll
          for (int e = 0; e < 4; ++e) {
            const float pe = __expf(S[tt][e] - mnew);
            S[tt][e] = pe;
            ls += pe;
          }
        l = l * alpha + ls;
        uint4 pk;
        pk.x = pkbf(S[0][0], S[0][1]);
        pk.y = pkbf(S[0][2], S[0][3]);
        pk.z = pkbf(S[1][0], S[1][1]);
        pk.w = pkbf(S[1][2], S[1][3]);
        const bf16x8 pf = __builtin_bit_cast(bf16x8, pk);
#pragma unroll
        for (int m = 0; m < 4; ++m) {
          O[m] *= alpha;
          const uint4 vv = {cv[m][0].x, cv[m][0].y, cv[m][1].x, cv[m][1].y};
          O[m] = __builtin_amdgcn_mfma_f32_16x16x32_bf16(__builtin_bit_cast(bf16x8, vv), pf, O[m], 0, 0, 0);
        }
      }
      l += __shfl_xor(l, 16);
      l += __shfl_xor(l, 32);
      const float mx = mrun;
      const float il = 1.f / l;
      const int ql = ((tile * 16 + qi) << dshift) + r;
      float wo = 0.f, wn = 1.f;
      float mnew = mx, lnew = l;
      if (pi > 0) {
        const float mo = Mb[ql], lo = Lb[ql];
        mnew = fmaxf(mo, mx);
        wo = lo * __expf(mo - mnew);
        wn = l * __expf(mx - mnew);
        lnew = wo + wn;
        const float inv = 1.f / lnew;
        wo *= inv;
        wn *= inv;
      }
      wn *= il;
#pragma unroll
      for (int m = 0; m < 4; ++m) {
        bfu* op = Ob + ql * 64 + 16 * m + 4 * g;
        float o[4];
        if (pi > 0) {
          const uint2 ov = *(const uint2*)op;
          o[0] = wo * bf2f(ov.x & 0xffffu) + wn * O[m][0];
          o[1] = wo * bf2f(ov.x >> 16) + wn * O[m][1];
          o[2] = wo * bf2f(ov.y & 0xffffu) + wn * O[m][2];
          o[3] = wo * bf2f(ov.y >> 16) + wn * O[m][3];
        } else {
#pragma unroll
          for (int e = 0; e < 4; ++e) o[e] = wn * O[m][e];
        }
        if (pi < 2) {
          uint2 w;
          w.x = pkbf(o[0], o[1]);
          w.y = pkbf(o[2], o[3]);
          *(uint2*)op = w;
        } else {
          const size_t oi = (tokb + q0 + ql) * 1024 + 512 + h * 64 + 16 * m + 4 * g;
          const uint2 sz = *(const uint2*)(p.SZ + oi);
          uint2 w;
          w.x = pkbf(o[0] * bf2f(sz.x & 0xffffu), o[1] * bf2f(sz.x >> 16));
          w.y = pkbf(o[2] * bf2f(sz.y & 0xffffu), o[3] * bf2f(sz.y >> 16));
          *(uint2*)(p.Y + oi) = w;
        }
      }
      if (pi < 2 && g == 0) {
        Mb[ql] = mnew;
        Lb[ql] = lnew;
      }
    }
    __syncthreads();
  }
}

DEVI void phase2(const Params& p, char* smem, int bid, int nb) {
  for (int it = bid; it < 16 * 64; it += nb) attn_item(p, smem, it);
  char* hs = smem + HF * HALF_SMEM;
  for (int it = bid * 2 + HF; it < (T_TOK / 128) * 4; it += nb * 2) gmlp_item(p, hs, it);
}

DEVI void phase3(const Params& p, char* smem, int bid, int nb) {
  PgEpiRes E{p.x, p.out};
  pg_gemm(smem, p.Y, p.WT_out, T_TOK, 1024, 1024, E, bid, nb);
}
DEVI void phase3b(const Params& p, int bid, int nb) {
  for (int it = bid; it < T_TOK / 16; it += nb) {
    const int row = it * 16 + (threadIdx.x >> 6) * 2;
    rms_row2_bf16(p.out + (size_t)row * 1024, p.ln_odd, p.H + (size_t)row * 1024, threadIdx.x & 63);
  }
}

struct ALoadMix {
  typedef uint4 Raw;
  static constexpr bool kFat = true;
  static constexpr bool kConsec = true;
  const bfu* H;
  const float* mu;
  DEVI Raw load(int row, int k) const { return *(const uint4*)(H + (size_t)row * 1024 + k); }
  DEVI uint4 loadprev(int row, int k) const {
    const int prow = ((row & (SEQ - 1)) != 0) ? row - 1 : row;
    return *(const uint4*)(H + (size_t)prow * 1024 + k);
  }
  DEVI uint4 asprev(const Raw& r) const { return r; }
  DEVI uint4 finish(const Raw& r, const uint4& pr, int row, int k) const {
    float c[8], pv[8];
    unpack8(r, c);
    unpack8(pr, pv);
    const float first = ((row & (SEQ - 1)) != 0) ? 1.f : 0.f;
    const float4 m0 = *(const float4*)(mu + k), m1 = *(const float4*)(mu + k + 4);
    const float mm[8] = {m0.x, m0.y, m0.z, m0.w, m1.x, m1.y, m1.z, m1.w};
#pragma unroll
    for (int j = 0; j < 8; ++j) c[j] = c[j] + (pv[j] * first - c[j]) * mm[j];
    return pack8(c);
  }
};
struct Epi4 {
  const Params* p;
  int nt;
  DEVI void operator()(int row, int col, f32x4 v) const {
    uint2 o;
    if (nt < 24) {
      o.x = pkbf(v[0], v[1]);
      o.y = pkbf(v[2], v[3]);
      bfu* dst = (nt < 8) ? p->R + (size_t)row * 1024 + col
                          : (nt < 16) ? p->K1 + (size_t)row * 1024 + col - 1024 : p->V1 + (size_t)row * 1024 + col - 2048;
      *(uint2*)dst = o;
    } else if (nt < 32) {
      o.x = pkbf(silu_(v[0]), silu_(v[1]));
      o.y = pkbf(silu_(v[2]), silu_(v[3]));
      *(uint2*)(p->SG + (size_t)row * 1024 + col - 3072) = o;
    } else if (nt == 32) {
      const int c = col - 4096;
      if (c < 64) {
        o.x = pkbf(tanh_(v[0]), tanh_(v[1]));
        o.y = pkbf(tanh_(v[2]), tanh_(v[3]));
        *(uint2*)(p->TW + (size_t)row * 64 + c) = o;
      }
    } else {
      const int c = col - 4224;
      if (c < 64) {
        o.x = pkbf(v[0], v[1]);
        o.y = pkbf(v[2], v[3]);
        *(uint2*)(p->TA + (size_t)row * 64 + c) = o;
      }
    }
  }
};
DEVI void phase4_tile(const Params& p, char* smem, int mt, int nt) {
  float* smu = (float*)(smem + 2 * GSTAGE_BYTES);
  const int mi = (nt < 8) ? 0 : (nt < 16) ? 2 : (nt < 24) ? 3 : (nt < 32) ? 5 : (nt == 32) ? 1 : 4;
  *(float4*)(smu + TIDX * 4) = *(const float4*)(p.mu + mi * 1024 + TIDX * 4);
  __syncthreads();
  ALoadMix al{p.H, smu};
  Epi4 epi{&p, nt};
  gemm_tile<1>(smem, al, p.WT_3, 1024, 1024, mt * 128, nt * 128, epi);
}
DEVI void phaseM(const Params& p, char* smem, int bid, int nb) {
  char* hs = smem + HF * HALF_SMEM;
  for (int it = bid * 2 + HF; it < (T_TOK / 128) * 2; it += nb * 2) phase4_tile(p, hs, it >> 1, 32 + (it & 1));
  const int tid = threadIdx.x;
  const int cc = (tid & 127) * 8, rsub = tid >> 7;
  float mr[8], mk[8], mv[8], mg[8];
  {
    const float4 a0 = *(const float4*)(p.mu + 0 * 1024 + cc), a1 = *(const float4*)(p.mu + 0 * 1024 + cc + 4);
    const float4 b0 = *(const float4*)(p.mu + 2 * 1024 + cc), b1 = *(const float4*)(p.mu + 2 * 1024 + cc + 4);
    const float4 c0 = *(const float4*)(p.mu + 3 * 1024 + cc), c1 = *(const float4*)(p.mu + 3 * 1024 + cc + 4);
    const float4 d0 = *(const float4*)(p.mu + 5 * 1024 + cc), d1 = *(const float4*)(p.mu + 5 * 1024 + cc + 4);
    mr[0] = a0.x; mr[1] = a0.y; mr[2] = a0.z; mr[3] = a0.w; mr[4] = a1.x; mr[5] = a1.y; mr[6] = a1.z; mr[7] = a1.w;
    mk[0] = b0.x; mk[1] = b0.y; mk[2] = b0.z; mk[3] = b0.w; mk[4] = b1.x; mk[5] = b1.y; mk[6] = b1.z; mk[7] = b1.w;
    mv[0] = c0.x; mv[1] = c0.y; mv[2] = c0.z; mv[3] = c0.w; mv[4] = c1.x; mv[5] = c1.y; mv[6] = c1.z; mv[7] = c1.w;
    mg[0] = d0.x; mg[1] = d0.y; mg[2] = d0.z; mg[3] = d0.w; mg[4] = d1.x; mg[5] = d1.y; mg[6] = d1.z; mg[7] = d1.w;
  }
#pragma unroll 1
  for (int it = bid; it < T_TOK / 8; it += nb) {
    const int ra = it * 8 + rsub, rb = ra + 4;
    const size_t oa = (size_t)ra * 1024 + cc, ob = (size_t)rb * 1024 + cc;
    const uint4 ca = *(const uint4*)(p.H + oa), cb = *(const uint4*)(p.H + ob);
    const uint4 pa = *(const uint4*)(p.H + (((ra & (SEQ - 1)) != 0) ? oa - 1024 : oa));
    const uint4 pb = *(const uint4*)(p.H + ob - 1024);
    const float fa = ((ra & (SEQ - 1)) != 0) ? 1.f : 0.f;
#pragma unroll
    for (int half = 0; half < 2; ++half) {
      float c[8], d[8], o[8];
      unpack8(half ? cb : ca, c);
      unpack8(half ? pb : pa, d);
      const float f = half ? 1.f : fa;
      const size_t oo = half ? ob : oa;
#pragma unroll
      for (int j = 0; j < 8; ++j) d[j] = d[j] * f - c[j];
#pragma unroll
      for (int j = 0; j < 8; ++j) o[j] = c[j] + d[j] * mr[j];
      *(uint4*)(p.XR + oo) = pack8(o);
#pragma unroll
      for (int j = 0; j < 8; ++j) o[j] = c[j] + d[j] * mk[j];
      *(uint4*)(p.XK + oo) = pack8(o);
#pragma unroll
      for (int j = 0; j < 8; ++j) o[j] = c[j] + d[j] * mv[j];
      *(uint4*)(p.XV + oo) = pack8(o);
#pragma unroll
      for (int j = 0; j < 8; ++j) o[j] = c[j] + d[j] * mg[j];
      *(uint4*)(p.XG + oo) = pack8(o);
    }
  }
}
DEVI void phase3a(const Params& p, char* smem, int bid, int nb) {
  PgEpi3 E{p.R, p.K1, 0};
  pg_gemm2(smem, p.XR, p.XK, 4, p.WT_3, T_TOK, 2048, 1024, E, bid, nb);
}
DEVI void phase3c(const Params& p, char* smem, int bid, int nb) {
  PgEpi3 E{p.V1, p.SG, 1};
  pg_gemm2(smem, p.XV, p.XG, 4, p.WT_3 + (size_t)2048 * 1024, T_TOK, 2048, 1024, E, bid, nb);
}

struct Epi5w {
  const Params* p;
  DEVI void operator()(int row, int col, f32x4 v) const {
    const float4 w0 = *(const float4*)(p->w0 + col);
    const float k = 0.6065306597126334f;
    uint2 o;
    o.x = pkbf(k * sigmoid_(w0.x + v[0]), k * sigmoid_(w0.y + v[1]));
    o.y = pkbf(k * sigmoid_(w0.z + v[2]), k * sigmoid_(w0.w + v[3]));
    *(uint2*)(p->EW + (size_t)row * 1024 + col) = o;
  }
};
struct Epi5a {
  const Params* p;
  DEVI void operator()(int row, int col, f32x4 v) const {
    const float4 a0 = *(const float4*)(p->a0 + col);
    uint2 o;
    o.x = pkbf(sigmoid_(a0.x + v[0]), sigmoid_(a0.y + v[1]));
    o.y = pkbf(sigmoid_(a0.z + v[2]), sigmoid_(a0.w + v[3]));
    *(uint2*)(p->AA + (size_t)row * 1024 + col) = o;
  }
};
DEVI void phase5(const Params& p, char* smem, int bid, int nb) {
  constexpr int N1 = (T_TOK / 128) * 8;
  char* hs = smem + HF * HALF_SMEM;
  for (int it = bid * 2 + HF; it < 2 * N1; it += nb * 2) {
    if (it < N1) {
      ALoadPlain al{p.TW, 64};
      Epi5w epi{&p};
      gemm_tile(hs, al, p.W2T, 64, 64, (it >> 3) * 128, (it & 7) * 128, epi);
    } else {
      const int j = it - N1;
      ALoadPlain al{p.TA, 64};
      Epi5a epi{&p};
      gemm_tile(hs, al, p.A2T, 64, 64, (j >> 3) * 128, (j & 7) * 128, epi);
    }
  }
}

DEVI void scanx_item(const Params& p, char* smem, int item, int next_item, uint2& ur, uint2& uk, uint2& ue, uint2& ua, uint2& uv) {
  const int bh = item & 31, c = item >> 5;
  const int b = bh >> 4, h = bh & 15;
  const size_t rowbase = ((size_t)b * SEQ + (size_t)c * 16) * 1024 + h * 64;
  float* sA = (float*)smem;
  float* sR = sA + 16 * 68;
  float* sBt = sR + 16 * 68;
  float* sKt = sBt + 16 * 68;
  float* sE = sKt + 16 * 68;
  float* sMab = sE + 16 * 64;
  float* sMak = sMab + 256;
  float* sM2 = sMak + 256;
  float* sM4 = sM2 + 256;
  float* sT = sM4 + 256;
  float* sT2 = sT + 256;
  const int tid = TIDX;
  const int tau = tid >> 4, c4 = (tid & 15) * 4;
  const size_t o = rowbase + (size_t)tau * 1024 + c4;
  float r[4], k[4], ew[4], a[4], vv[4];
  unpack4(ur, r);
  unpack4(uk, k);
  unpack4(ue, ew);
  unpack4(ua, a);
  unpack4(uv, vv);
  {
    const int nbh = next_item & 31, nc = next_item >> 5;
    const size_t no = ((size_t)(nbh >> 4) * SEQ + (size_t)nc * 16 + tau) * 1024 + (nbh & 15) * 64 + c4;
    ur = *(const uint2*)(p.R + no);
    uk = *(const uint2*)(p.K1 + no);
    ue = *(const uint2*)(p.EW + no);
    ua = *(const uint2*)(p.AA + no);
    uv = *(const uint2*)(p.V1 + no);
  }
  float kk[4], kp[4], bb[4];
  float ss = 0.f, cf = 0.f;
#pragma unroll
  for (int j = 0; j < 4; ++j) {
    const int ch = h * 64 + c4 + j;
    kk[j] = k[j] * p.k_k[ch];
    ss += kk[j] * kk[j];
    kp[j] = k[j] * (1.f + (a[j] - 1.f) * p.k_a[ch]);
    cf += r[j] * kp[j] * p.r_k[ch];
  }
  ss = reduce16(ss);
  cf = reduce16(cf);
  const float rn = rsqrtf(fmaxf(ss, 1e-24f));
#pragma unroll
  for (int j = 0; j < 4; ++j) {
    kk[j] *= rn;
    bb[j] = kk[j] * a[j];
    sE[tau * 64 + c4 + j] = ew[j];
  }
  if ((tid & 15) == 0) p.COEF[((size_t)b * SEQ + (size_t)c * 16 + tau) * 16 + h] = cf;
  __syncthreads();
  float Li[4] = {0.f, 0.f, 0.f, 0.f}, L15[4] = {0.f, 0.f, 0.f, 0.f};
#pragma unroll
  for (int i = 0; i < 16; ++i) {
    const float4 e = *(const float4*)(sE + i * 64 + c4);
    const float m = (i <= tau) ? 1.f : 0.f;
    Li[0] += m * e.x; Li[1] += m * e.y; Li[2] += m * e.z; Li[3] += m * e.w;
    L15[0] += e.x; L15[1] += e.y; L15[2] += e.z; L15[3] += e.w;
  }
  float rt[4], bhat[4], khat[4];
#pragma unroll
  for (int j = 0; j < 4; ++j) {
    const float ep = __expf(Li[j]), em = __expf(-Li[j]), eh = __expf(-(L15[j] - Li[j]));
    const float at = -kk[j] * __expf(-(Li[j] - ew[j]));
    rt[j] = r[j] * em;
    sA[tau * 68 + c4 + j] = at;
    sR[tau * 68 + c4 + j] = rt[j];
    sBt[tau * 68 + c4 + j] = bb[j] * ep;
    sKt[tau * 68 + c4 + j] = kp[j] * ep;
    bhat[j] = bb[j] * eh;
    khat[j] = kp[j] * eh;
  }
  *(uint2*)(p.R + o) = pack4(rt);
#pragma unroll
  for (int j = 0; j < 4; ++j) {
    const int lin = (c4 + j) * 16 + tau;
    const size_t off = rowbase + (size_t)(lin >> 6) * 1024 + (lin & 63);
    p.EW[off] = (bfu)f2bf(bhat[j]);
    p.K1[off] = (bfu)f2bf(khat[j]);
    p.V1[off] = (bfu)f2bf(vv[j]);
  }
  if (tau == 0) {
    float4 gq = {__expf(-L15[0]), __expf(-L15[1]), __expf(-L15[2]), __expf(-L15[3])};
    *(float4*)(p.G15 + (size_t)item * 64 + c4) = gq;
  }
  __syncthreads();
  {
    const int i = tid >> 4, tq = tid & 15;
    float mab = 0.f, mak = 0.f, mrb = 0.f, mrk = 0.f;
#pragma unroll
    for (int kq = 0; kq < 64; kq += 4) {
      const float4 bi = *(const float4*)(sBt + i * 68 + kq);
      const float4 ki = *(const float4*)(sKt + i * 68 + kq);
      const float4 aq = *(const float4*)(sA + tq * 68 + kq);
      const float4 rq = *(const float4*)(sR + tq * 68 + kq);
      mab += bi.x * aq.x + bi.y * aq.y + bi.z * aq.z + bi.w * aq.w;
      mak += ki.x * aq.x + ki.y * aq.y + ki.z * aq.z + ki.w * aq.w;
      mrb += bi.x * rq.x + bi.y * rq.y + bi.z * rq.z + bi.w * rq.w;
      mrk += ki.x * rq.x + ki.y * rq.y + ki.z * rq.z + ki.w * rq.w;
    }
    if (!(i < tq)) { mab = 0.f; mak = 0.f; }
    if (!(i <= tq)) { mrb = 0.f; mrk = 0.f; }
    sMab[i * 16 + tq] = mab;
    sMak[i * 16 + tq] = mak;
    bfu* mr = p.MRT + (size_t)item * 512 + tq * 32 + (i >> 2) * 8 + (i & 3);
    mr[0] = (bfu)f2bf(mrb);
    mr[4] = (bfu)f2bf(mrk);
  }
  __syncthreads();
  {
    const int i = tid >> 4, j = tid & 15;
    float m2 = 0.f;
#pragma unroll
    for (int kq = 0; kq < 16; ++kq) m2 += sMab[i * 16 + kq] * sMab[kq * 16 + j];
    sM2[i * 16 + j] = m2;
    __syncthreads();
    float t1 = ((i == j) ? 1.f : 0.f) + sMab[i * 16 + j] + m2, m4 = 0.f;
#pragma unroll
    for (int kq = 0; kq < 16; ++kq) {
      t1 += sMab[i * 16 + kq] * sM2[kq * 16 + j];
      m4 += sM2[i * 16 + kq] * sM2[kq * 16 + j];
    }
    sT[i * 16 + j] = t1;
    sM4[i * 16 + j] = m4;
    __syncthreads();
    float t2 = t1, m8 = 0.f;
#pragma unroll
    for (int kq = 0; kq < 16; ++kq) {
      t2 += sT[i * 16 + kq] * sM4[kq * 16 + j];
      m8 += sM4[i * 16 + kq] * sM4[kq * 16 + j];
    }
    sT2[i * 16 + j] = t2;
    __syncthreads();
    sM2[i * 16 + j] = m8;
    __syncthreads();
    float t3 = t2;
#pragma unroll
    for (int kq = 0; kq < 16; ++kq) t3 += sT2[i * 16 + kq] * sM2[kq * 16 + j];
    sT[i * 16 + j] = t3;
    __syncthreads();
  }
  {
    const int tq = tid >> 4, k4 = (tid & 15) * 4, ii = tid & 15;
    float w0 = 0.f, w1 = 0.f, w2 = 0.f, w3 = 0.f, gt = 0.f;
#pragma unroll
    for (int jj = 0; jj < 16; ++jj) {
      const float tm = sT[jj * 16 + tq];
      const float4 av = *(const float4*)(sA + jj * 68 + k4);
      w0 += av.x * tm; w1 += av.y * tm; w2 += av.z * tm; w3 += av.w * tm;
      gt += sMak[ii * 16 + jj] * tm;
    }
    uint2 wv;
    wv.x = pkbf(w0, w1);
    wv.y = pkbf(w2, w3);
    *(uint2*)(p.AA + rowbase + (size_t)tq * 1024 + k4) = wv;
    p.GT[(size_t)item * 256 + tq * 16 + ii] = (bfu)f2bf(gt);
  }
  __syncthreads();
}
DEVI void phase6x(const Params& p, char* smem, int bid, int nb) {
  char* hs = smem + HF * HALF_SMEM;
  constexpr int NI = (SEQ / 16) * 32;
  const int vnb = nb * 2;
  int it = bid * 2 + HF;
  if (it >= NI) return;
  uint2 ur, uk, ue, ua, uv;
  {
    const int tau = TIDX >> 4, c4 = (TIDX & 15) * 4;
    const int bh = it & 31, c = it >> 5;
    const size_t o = ((size_t)(bh >> 4) * SEQ + (size_t)c * 16 + tau) * 1024 + (bh & 15) * 64 + c4;
    ur = *(const uint2*)(p.R + o);
    uk = *(const uint2*)(p.K1 + o);
    ue = *(const uint2*)(p.EW + o);
    ua = *(const uint2*)(p.AA + o);
    uv = *(const uint2*)(p.V1 + o);
  }
#pragma unroll 1
  for (; it < NI; it += vnb) scanx_item(p, hs, it, (it + vnb < NI) ? it + vnb : it, ur, uk, ue, ua, uv);
}

DEVI bf16x8 mk8(uint2 a, uint2 b) {
  const uint4 v = {a.x, a.y, b.x, b.y};
  return __builtin_bit_cast(bf16x8, v);
}
DEVI uint2 packacc(f32x4 a) {
  uint2 r;
  r.x = pkbf(a[0], a[1]);
  r.y = pkbf(a[2], a[3]);
  return r;
}
constexpr int SCH = 4;
constexpr int SROW = 136;
constexpr int SARR = 16 * SROW;
constexpr int SOFF_GT = 5 * SARR;
constexpr int SOFF_MR = SOFF_GT + 512;
constexpr int SOFF_G15 = SOFF_MR + 1024;
constexpr int SIMG = SOFF_G15 + 256;
#define SCANS_LD5(P, I, O)                       \
    P##a##I = *(const uint4*)(p.AA + (O));       \
    P##r##I = *(const uint4*)(p.R + (O));        \
    P##e##I = *(const uint4*)(p.EW + (O));       \
    P##k##I = *(const uint4*)(p.K1 + (O));       \
    P##v##I = *(const uint4*)(p.V1 + (O));
#define SCANS_ISSUE(P, SC)                                                                           \
  {                                                                                                  \
    const size_t hb_ = ((size_t)b * SEQ) * 1024 + h * 64 + c80 * 8;                                  \
    const int tk0_ = (SC) * SCH * 16 + cl0 * 16 + row0;                                              \
    const int tk1_ = tk0_ + 32;                                                                      \
    SCANS_LD5(P, 0, hb_ + (size_t)(tk0_ < SEQ ? tk0_ : SEQ - 1) * 1024)                              \
    SCANS_LD5(P, 1, hb_ + (size_t)(tk1_ < SEQ ? tk1_ : SEQ - 1) * 1024)                              \
    const int c0_ = (SC) * SCH;                                                                      \
    const size_t ib_ = (size_t)b * 16 + h;                                                           \
    const int tg_ = tid < 128 ? tid : 127;                                                           \
    const int cg_ = c0_ + (tg_ >> 5);                                                                \
    P##gm = *(const uint4*)(p.GT + ((size_t)(cg_ < SEQ / 16 ? cg_ : SEQ / 16 - 1) * 32 + ib_) * 256 + (tg_ & 31) * 8);  \
    const int t5_ = tid < 64 ? tid : 63;                                                             \
    const int c5_ = c0_ + (t5_ >> 4);                                                                \
    P##g5 = *(const uint4*)(p.G15 + ((size_t)(c5_ < SEQ / 16 ? c5_ : SEQ / 16 - 1) * 32 + ib_) * 64 + (t5_ & 15) * 4);  \
    const int cm_ = c0_ + (tid >> 6);                                                                \
    P##mr = *(const uint4*)(p.MRT + ((size_t)(cm_ < SEQ / 16 ? cm_ : SEQ / 16 - 1) * 32 + ib_) * 512 + (tid & 63) * 8); \
  }
#define SCANS_ST5(P, I, B)                                                                           \
    *(uint2*)(B) = uint2{P##a##I.x, P##a##I.y};  *(uint2*)((B) + 8) = uint2{P##a##I.z, P##a##I.w};   \
    *(uint2*)((B) + SARR) = uint2{P##r##I.x, P##r##I.y};  *(uint2*)((B) + SARR + 8) = uint2{P##r##I.z, P##r##I.w};   \
    *(uint2*)((B) + 2 * SARR) = uint2{P##e##I.x, P##e##I.y};  *(uint2*)((B) + 2 * SARR + 8) = uint2{P##e##I.z, P##e##I.w};   \
    *(uint2*)((B) + 3 * SARR) = uint2{P##k##I.x, P##k##I.y};  *(uint2*)((B) + 3 * SARR + 8) = uint2{P##k##I.z, P##k##I.w};   \
    *(uint2*)((B) + 4 * SARR) = uint2{P##v##I.x, P##v##I.y};  *(uint2*)((B) + 4 * SARR + 8) = uint2{P##v##I.z, P##v##I.w};
#define SCANS_COMMIT(P)                                                                              \
  {                                                                                                  \
    char* b0_ = cimg + cl0 * SIMG + row0 * SROW + c80 * 16;                                          \
    SCANS_ST5(P, 0, b0_)                                                                             \
    SCANS_ST5(P, 1, b0_ + 2 * SIMG)                                                                  \
    if (tid < 128) *(uint4*)(cimg + (tid >> 5) * SIMG + SOFF_GT + (tid & 31) * 16) = P##gm;          \
    if (tid < 64) *(uint4*)(cimg + (tid >> 4) * SIMG + SOFF_G15 + (tid & 15) * 16) = P##g5;          \
    *(uint4*)(cimg + (tid >> 6) * SIMG + SOFF_MR + (tid & 63) * 16) = P##mr;                         \
  }
#define SCANS_COMPUTE(SCI)                                                                           \
  _Pragma("unroll 1") for (int cl = 0; cl < SCH && (SCI) * SCH + cl < SEQ / 16; ++cl) {             \
    const char* img = cimg + cl * SIMG;                                                              \
        \
    const uint2 vb = *(const uint2*)(img + 4 * SARR + vrow * SROW + vcol * 2);                       \
    const uint2 gt = *(const uint2*)(img + SOFF_GT + (q * 16 + 4 * g) * 2);                          \
    const char* wp = img + q * SROW + (4 * g) * 2;                                                   \
    const uint2 w00 = *(const uint2*)(wp), w01 = *(const uint2*)(wp + 32);                           \
    const uint2 w10 = *(const uint2*)(wp + 64), w11 = *(const uint2*)(wp + 96);                      \
    const uint2 r00 = *(const uint2*)(wp + SARR), r01 = *(const uint2*)(wp + SARR + 32);             \
    const uint2 r10 = *(const uint2*)(wp + SARR + 64), r11 = *(const uint2*)(wp + SARR + 96);        \
    const uint4 mr = *(const uint4*)(img + SOFF_MR + (q * 32 + g * 8) * 2);                          \
    uint2 bk0[4], bk1[4];                                                                            \
    float4 g15[4];                                                                                   \
    _Pragma("unroll") for (int n = 0; n < 4; ++n) {                                                  \
      const int ch = 16 * n + q;                                                                     \
      const char* bp = img + 2 * SARR + (ch >> 2) * SROW + ((ch & 3) * 16 + 4 * g) * 2;              \
      bk0[n] = *(const uint2*)(bp);                                                                  \
      bk1[n] = *(const uint2*)(bp + SARR);                                                           \
      g15[n] = *(const float4*)(img + SOFF_G15 + (16 * n + 4 * g) * 4);                              \
    }                                                                                                \
    __builtin_amdgcn_sched_barrier(0);                                                               \
    const bf16x8 sB0 = mk8(packacc(acc[0]), packacc(acc[1]));                                        \
    const bf16x8 sB1 = mk8(packacc(acc[2]), packacc(acc[3]));                                        \
    f32x4 Z = {0.f, 0.f, 0.f, 0.f};                                                                  \
    Z = __builtin_amdgcn_mfma_f32_16x16x32_bf16(mk8(gt, zero2), mk8(vb, zero2), Z, 0, 0, 0);         \
    f32x4 Y = {0.f, 0.f, 0.f, 0.f};                                                                  \
    Z = __builtin_amdgcn_mfma_f32_16x16x32_bf16(mk8(w00, w01), sB0, Z, 0, 0, 0);                     \
    Y = __builtin_amdgcn_mfma_f32_16x16x32_bf16(mk8(r00, r01), sB0, Y, 0, 0, 0);                     \
    Z = __builtin_amdgcn_mfma_f32_16x16x32_bf16(mk8(w10, w11), sB1, Z, 0, 0, 0);                     \
    Y = __builtin_amdgcn_mfma_f32_16x16x32_bf16(mk8(r10, r11), sB1, Y, 0, 0, 0);                     \
    const bf16x8 zvB = mk8(packacc(Z), vb);                                                          \
    Y = __builtin_amdgcn_mfma_f32_16x16x32_bf16(__builtin_bit_cast(bf16x8, mr), zvB, Y, 0, 0, 0);    \
    _Pragma("unroll") for (int n = 0; n < 4; ++n) {                                                  \
      f32x4 scv = acc[n];                                                                            \
      scv[0] *= g15[n].x; scv[1] *= g15[n].y; scv[2] *= g15[n].z; scv[3] *= g15[n].w;                \
      acc[n] = __builtin_amdgcn_mfma_f32_16x16x32_bf16(mk8(bk0[n], bk1[n]), zvB, scv, 0, 0, 0);      \
    }                                                                                                \
    _Pragma("unroll") for (int e = 0; e < 4; ++e)                                                    \
        ybuf[(cl * 16 + 4 * g + e) * 16 + q] = (bfu)f2bf(Y[e]);                                      \
  }
DEVI void scans_block(const Params& p, char* smem, int bh, int vs) {
  const int b = bh >> 4, h = bh & 15;
  const int lane = threadIdx.x & 63, wv = threadIdx.x >> 6, q = lane & 15, g = lane >> 4;
  f32x4 acc[4];
#pragma unroll
  for (int n = 0; n < 4; ++n) acc[n] = f32x4{0.f, 0.f, 0.f, 0.f};
  const uint2 zero2 = {0u, 0u};
  bfu* yout = p.YS + ((size_t)b * SEQ) * 1024 + h * 64 + vs * 16;
  char* const img0 = smem;
  char* const img1 = smem + SCH * SIMG;
  bfu* const yb0 = (bfu*)(smem + 2 * SCH * SIMG);
  bfu* const yb1 = yb0 + SCH * 16 * 16;
  const int tid = TIDX;
  const bool stager = wv >= 4;
  const int cl0 = tid >> 7, row0 = (tid >> 3) & 15, c80 = tid & 7;
  uint4 Aa0, Aa1, Ar0, Ar1, Ae0, Ae1, Ak0, Ak1, Av0, Av1, Agm, Ag5, Amr;
  constexpr int NSC = (SEQ / 16) / SCH;
  const int vrow = vs * 4 + (q >> 2), vcol = (q & 3) * 16 + 4 * g;
  if (stager) {
    char* cimg = img0;
    SCANS_ISSUE(A, 0);
    SCANS_COMMIT(A);
    SCANS_ISSUE(A, 1);
  }
  __syncthreads();
#define SCANS_FLUSH(YB, S)                                                                                       \
  if (wv >= 1 && wv <= 2) {                                                                                      \
    const int idx = (int)threadIdx.x - 64, tok = (S) * SCH * 16 + (idx >> 1);                                    \
    *(uint4*)(yout + (size_t)tok * 1024 + (idx & 1) * 8) = *(const uint4*)((YB) + (idx >> 1) * 16 + (idx & 1) * 8); \
  }
#pragma unroll 1
  for (int sc = 0; sc < NSC; sc += 2) {
    if (wv == 0) {
      const char* cimg = img0;
      bfu* ybuf = yb0;
      SCANS_COMPUTE(sc);
    } else if (stager) {
      char* cimg = img1;
      SCANS_COMMIT(A);
      SCANS_ISSUE(A, (sc + 2 < NSC ? sc + 2 : NSC - 1));
    } else if (sc > 0) {
      SCANS_FLUSH(yb1, sc - 1)
    }
    __syncthreads();
    if (wv == 0) {
      const char* cimg = img1;
      bfu* ybuf = yb1;
      SCANS_COMPUTE(sc + 1);
    } else if (stager) {
      char* cimg = img0;
      SCANS_COMMIT(A);
      SCANS_ISSUE(A, (sc + 3 < NSC ? sc + 3 : NSC - 1));
    } else {
      SCANS_FLUSH(yb0, sc)
    }
    __syncthreads();
  }
  SCANS_FLUSH(yb1, NSC - 1)
#undef SCANS_FLUSH
}
DEVI void phase6(const Params& p, char* smem, int bid, int nb) {
  for (int it = bid; it < 128; it += nb) scans_block(p, smem, it >> 2, it & 3);
}

DEVI void phase6b(const Params& p, int bid, int nb) {
  const int lane = threadIdx.x & 63, wv = (threadIdx.x >> 6) & 3;
  for (int it = bid; it < T_TOK / 4; it += nb) {
    const int t0 = it * 4 + (threadIdx.x >> 8) * 2;
    float ys[8], vv[8], sg[8], bon[8];
#pragma unroll
    for (int j = 0; j < 8; ++j) {
      const int t = t0 + (j >> 2), h = wv * 4 + (j & 3);
      const int tb = t & ~15, tau = t & 15;
      const size_t idx = (size_t)t * 1024 + h * 64 + lane;
      ys[j] = bf2f(p.YS[idx]);
      sg[j] = bf2f(p.SG[idx]);
      vv[j] = bf2f(p.V1[(size_t)(tb + (lane >> 2)) * 1024 + h * 64 + (lane & 3) * 16 + tau]);
      bon[j] = p.COEF[(size_t)t * 16 + h];
    }
#pragma unroll
    for (int j = 0; j < 8; ++j) {
      const int t = t0 + (j >> 2), h = wv * 4 + (j & 3);
      const int c = h * 64 + lane;
      const float mean = wave_sum(ys[j]) * (1.f / 64.f);
      const float dv = ys[j] - mean;
      const float var = wave_sum(dv * dv) * (1.f / 64.f);
      float y = dv * rsqrtf(var + 64e-5f) * p.lnw[c] + p.lnb[c];
      y = (y + bon[j] * vv[j]) * sg[j];
      p.YS[(size_t)t * 1024 + c] = (bfu)f2bf(y);
    }
  }
}

DEVI void phase7(const Params& p, char* smem, int bid, int nb) {
  PgEpiRes E{p.out, p.out};
  pg_gemm(smem, p.YS, p.WT_o, T_TOK, 1024, 1024, E, bid, nb);
}
DEVI void phase8(const Params& p, int bid, int nb) {
  for (int it = bid; it < T_TOK / 16; it += nb) {
    const int row = it * 16 + (threadIdx.x >> 6) * 2;
    const int lane = threadIdx.x & 63;
    float* src = p.out + (size_t)row * 1024;
    float4 v[2][4];
    float ss[2] = {0.f, 0.f};
#pragma unroll
    for (int r = 0; r < 2; ++r)
#pragma unroll
      for (int i = 0; i < 4; ++i) v[r][i] = *(const float4*)(src + r * 1024 + lane * 4 + 256 * i);
#pragma unroll
    for (int r = 0; r < 2; ++r)
#pragma unroll
      for (int i = 0; i < 4; ++i)
        ss[r] += v[r][i].x * v[r][i].x + v[r][i].y * v[r][i].y + v[r][i].z * v[r][i].z + v[r][i].w * v[r][i].w;
#pragma unroll
    for (int r = 0; r < 2; ++r) {
      const float rinv = rsqrtf(wave_sum(ss[r]) * (1.f / 1024.f) + 1e-6f);
#pragma unroll
      for (int i = 0; i < 4; ++i) {
        const float4 g = *(const float4*)(p.fnorm + lane * 4 + 256 * i);
        const float4 o = {v[r][i].x * rinv * g.x, v[r][i].y * rinv * g.y, v[r][i].z * rinv * g.z, v[r][i].w * rinv * g.w};
        *(float4*)(src + r * 1024 + lane * 4 + 256 * i) = o;
      }
    }
  }
}

#define XB_TMO      128
#define XB_XCNT(j)  (256  + 64 * (j))
#define XB_XSUB(j)  (1280 + 64 * (j))
#define XB_XGEN(j)  (2304 + 64 * (j))
#define XB_TOP      3328
#define XB_TOPGEN   3392
#define XCD_BAR_WORDS 3456
#define XB_SPIN_CAP (1u << 18)
#define LAS __attribute__((address_space(3)))

__device__ __forceinline__ unsigned xb_ld(unsigned* p)              { return __hip_atomic_load(p, __ATOMIC_RELAXED, __HIP_MEMORY_SCOPE_AGENT); }
__device__ __forceinline__ unsigned xb_add(unsigned* p, unsigned v) { return __hip_atomic_fetch_add(p, v, __ATOMIC_RELAXED, __HIP_MEMORY_SCOPE_AGENT); }
__device__ __forceinline__ unsigned xb_xcc_id() { return (unsigned)__builtin_amdgcn_s_getreg((3 << 11) | 20) & 0xFu; }
#define XB_SPIN(cond, bar) do { unsigned _sp = 0; while (cond) { __builtin_amdgcn_s_sleep(1); \
    if ((++_sp & 255u) == 0u) { if (xb_ld(&(bar)[XB_TMO])) break; if (_sp > XB_SPIN_CAP) { atomicAdd(&(bar)[XB_TMO], 1u); break; } } } } while (0)

struct XcdBarrier {
    unsigned* bar; unsigned x;
    volatile LAS unsigned* st;
};

__device__ __forceinline__ XcdBarrier xcd_barrier_post(unsigned* bar, volatile LAS unsigned* st) {
    XcdBarrier b; b.bar = bar; b.x = xb_xcc_id(); b.st = st;
    if (threadIdx.x == 0) (void)xb_add(&bar[XB_XCNT(b.x)], 1u);
    return b;
}
__device__ __forceinline__ void xcd_barrier_complete(unsigned* bar, unsigned x, unsigned& nloc, unsigned& nx) {
    const unsigned G = gridDim.x * gridDim.y * gridDim.z;
    unsigned sum, cnt, mine, sp = 0u;
    for (;;) {
        sum = 0u; cnt = 0u; mine = 0u;
#pragma unroll
        for (unsigned j = 0; j < 16; ++j) { const unsigned c = xb_ld(&bar[XB_XCNT(j)]); sum += c; cnt += (c > 0u) ? 1u : 0u; mine = (j == x) ? c : mine; }
        if (sum == G) break;
        __builtin_amdgcn_s_sleep(1);
        if ((++sp & 255u) == 0u) { if (xb_ld(&bar[XB_TMO])) break; if (sp > XB_SPIN_CAP) { atomicAdd(&bar[XB_TMO], 1u); break; } }
    }
    nloc = mine > 0u ? mine : 1u; nx = cnt > 0u ? cnt : 1u;
}

__device__ __forceinline__ void xcd_barrier(const XcdBarrier& b) {
    asm volatile("s_waitcnt vmcnt(0)" ::: "memory");
    __syncthreads();
    if (threadIdx.x == 0) {
        unsigned* bar = b.bar;
        __builtin_amdgcn_s_waitcnt(0);
        unsigned nloc = b.st[0], nx = b.st[1];
        if (nloc == 0u) { xcd_barrier_complete(bar, b.x, nloc, nx); b.st[0] = nloc; b.st[1] = nx; }
        const unsigned old = xb_add(&bar[XB_XSUB(b.x)], 1u);
        const unsigned gen = old / nloc;
        if (old + 1u == (gen + 1u) * nloc) {
            __builtin_amdgcn_fence(__ATOMIC_RELEASE, "agent");
            asm volatile("s_waitcnt vmcnt(0)" ::: "memory");
            const unsigned og = xb_add(&bar[XB_TOP], 1u);
            const unsigned tg = og / nx;
            if (og + 1u == (tg + 1u) * nx) xb_add(&bar[XB_TOPGEN], 1u);
            else XB_SPIN(xb_ld(&bar[XB_TOPGEN]) == tg, bar);
            __builtin_amdgcn_fence(__ATOMIC_ACQUIRE, "agent");
            xb_add(&bar[XB_XGEN(b.x)], 1u);
            asm volatile("s_waitcnt vmcnt(0)" ::: "memory");
        } else {
            XB_SPIN(xb_ld(&bar[XB_XGEN(b.x)]) == gen, bar);
            __builtin_amdgcn_fence(__ATOMIC_ACQUIRE, "agent");
            asm volatile("s_waitcnt vmcnt(0)" ::: "memory");
        }
    }
    __syncthreads();
}


template <int PH>
DEVI void run_phase(const Params& p, char* smem, int bid, int nb) {
  if (PH == 0) phase0(p, smem, bid, nb);
  if (PH == 1) phase1(p, smem, bid, nb);
  if (PH == 2) phase2(p, smem, bid, nb);
  if (PH == 3) phase3(p, smem, bid, nb);
  if (PH == 4) phase3b(p, bid, nb);
  if (PH == 5) phaseM(p, smem, bid, nb);
  if (PH == 6) phase3a(p, smem, bid, nb);
  if (PH == 7) phase3c(p, smem, bid, nb);
  if (PH == 8) phase5(p, smem, bid, nb);
  if (PH == 9) phase6x(p, smem, bid, nb);
  if (PH == 10) phase6(p, smem, bid, nb);
  if (PH == 11) phase6b(p, bid, nb);
  if (PH == 12) phase7(p, smem, bid, nb);
  if (PH == 13) phase8(p, bid, nb);
}

#ifndef REP_MASK
#define REP_MASK 0
#endif
template <int PH>
DEVI void mega_phase(const Params& p, char* smem, cg::grid_group& grid, int bid, int nb) {
  run_phase<PH>(p, smem, bid, nb);
  if ((REP_MASK >> PH) & 1) {
    grid.sync();
    run_phase<PH>(p, smem, bid, nb);
  }
}
__global__ void __launch_bounds__(512, 2) mega_kernel(Params pk) {
  const Params& p = *(const Params*)__builtin_amdgcn_kernarg_segment_ptr();
  extern __shared__ __attribute__((aligned(16))) char smem[];
  cg::grid_group grid = cg::this_grid();
  const int bid = blockIdx.x, nb = gridDim.x;
  volatile LAS unsigned* st = (volatile LAS unsigned*)(smem + SMEM_BYTES);
  if (threadIdx.x == 0) {
    st[0] = 0u;
    st[1] = 0u;
  }
  __syncthreads();
  (void)xcd_barrier_post(p.BAR, st);
#define XBAR() do { XcdBarrier xb_; xb_.bar = p.BAR; xb_.x = xb_xcc_id(); xb_.st = (volatile LAS unsigned*)(smem + SMEM_BYTES); xcd_barrier(xb_); } while (0)
  mega_phase<0>(p, smem, grid, bid, nb); grid.sync();
  mega_phase<1>(p, smem, grid, bid, nb); XBAR();
  mega_phase<2>(p, smem, grid, bid, nb); XBAR();
  mega_phase<3>(p, smem, grid, bid, nb); XBAR();
  mega_phase<4>(p, smem, grid, bid, nb); XBAR();
  mega_phase<5>(p, smem, grid, bid, nb); XBAR();
  mega_phase<6>(p, smem, grid, bid, nb); XBAR();
  mega_phase<7>(p, smem, grid, bid, nb); XBAR();
  mega_phase<8>(p, smem, grid, bid, nb); XBAR();
  mega_phase<9>(p, smem, grid, bid, nb); XBAR();
  mega_phase<10>(p, smem, grid, bid, nb); XBAR();
  mega_phase<11>(p, smem, grid, bid, nb); XBAR();
  mega_phase<12>(p, smem, grid, bid, nb); grid.sync();
  mega_phase<13>(p, smem, grid, bid, nb);
}

extern "C" void kernel_launch(void* const* d_in, const int* in_sizes, int n_in, void* d_out, int out_size, void* d_ws,
                              size_t ws_size, hipStream_t stream) {
  Params p{};
  const float** fp = (const float**)&p;
  for (int i = 0; i < 26; ++i) fp[i] = (const float*)d_in[i];
  p.out = (float*)d_out;
  char* w = (char*)d_ws;
  size_t off = 0;
  auto take = [&](size_t bytes) {
    char* r = w + off;
    off += (bytes + 255) & ~(size_t)255;
    return (bfu*)r;
  };
  p.WT_in = take((size_t)3584 * 1024 * 2);
  p.WT_out = take((size_t)1024 * 1024 * 2);
  p.WT_3 = take((size_t)4352 * 1024 * 2);
  p.WT_o = take((size_t)1024 * 1024 * 2);
  p.W2T = take((size_t)1024 * 64 * 2);
  p.A2T = take((size_t)1024 * 64 * 2);
  p.TW = take((size_t)T_TOK * 64 * 2);
  p.TA = take((size_t)T_TOK * 64 * 2);
  const size_t SLOT = (size_t)T_TOK * 1024 * 2;
  bfu* slot0 = take(SLOT);
  bfu* slots = take(6 * SLOT);
  p.H = slot0;
  p.AA = slot0;
  p.U = slots;
  p.GVT = slots + SLOT / 4;
  p.Q = slots + 2 * (SLOT / 4);
  p.K = slots + 3 * (SLOT / 4);
  p.VT = slots + 4 * (SLOT / 4);
  p.SZ = slots + 7 * (SLOT / 4);
  p.Y = slots + 9 * (SLOT / 4);
  p.R = slots;
  p.K1 = slots + 1 * (SLOT / 2);
  p.XV = slots + 2 * (SLOT / 2);
  p.XG = slots + 3 * (SLOT / 2);
  p.XR = slots + 4 * (SLOT / 2);
  p.XK = slots + 5 * (SLOT / 2);
  p.V1 = slots + 4 * (SLOT / 2);
  p.SG = slots + 5 * (SLOT / 2);
  p.EW = slots + 2 * (SLOT / 2);
  p.YS = slots + 3 * (SLOT / 2);
  p.G15 = (float*)p.TW;
  p.GT = p.WT_in;
  p.MRT = take((size_t)(SEQ / 16) * 32 * 512 * 2);
  p.COEF = (float*)take((size_t)T_TOK * 16 * 4);
  p.BAR = (unsigned*)take((size_t)XCD_BAR_WORDS * 4);
  if (off > ws_size) {
    fprintf(stderr, "workspace too small: need %zu have %zu\n", off, ws_size);
    return;
  }
  static int grid_blocks = 0;
  if (!grid_blocks) {
    int dev = 0, cus = 0, per_cu = 0;
    (void)hipGetDevice(&dev);
    (void)hipDeviceGetAttribute(&cus, hipDeviceAttributeMultiprocessorCount, dev);
    (void)hipFuncSetAttribute((const void*)mega_kernel, hipFuncAttributeMaxDynamicSharedMemorySize, SMEM_BYTES + 16);
    (void)hipOccupancyMaxActiveBlocksPerMultiprocessor(&per_cu, mega_kernel, 512, SMEM_BYTES + 16);
    grid_blocks = cus * per_cu;
  }
  (void)hipMemsetAsync(p.BAR, 0, (size_t)XCD_BAR_WORDS * 4, stream);
  void* args[] = {&p};
  hipError_t e = hipLaunchCooperativeKernel((void*)mega_kernel, dim3(grid_blocks), dim3(512), args, SMEM_BYTES + 16, stream);
  if (e != hipSuccess) fprintf(stderr, "cooperative launch failed: %s (grid %d)\n", hipGetErrorString(e), grid_blocks);
}
```

```cpp
#include <hip/hip_runtime.h>
#include <hip/hip_cooperative_groups.h>
#include <stdint.h>
#include <cstdio>
namespace cg = cooperative_groups;

#ifndef MEGA
#define MEGA 1
#endif

typedef unsigned short bfu;
using bf16x8 = __attribute__((ext_vector_type(8))) short;
using f32x4 = __attribute__((ext_vector_type(4))) float;
#define DEVI __device__ __forceinline__
#define TIDX ((int)(threadIdx.x & 255))
#define HF ((int)(threadIdx.x >> 8))

constexpr int GSTAGE_BYTES = 2 * 128 * 72 * 2;
constexpr int T_TOK = 32768;
constexpr int SEQ = 16384;
constexpr int HALF_SMEM = 2 * GSTAGE_BYTES + 4096 + 512;
constexpr int SMEM_BYTES = 2 * HALF_SMEM;
constexpr int SMEM_UNUSED_ = 0;

struct Params {
  const float *x, *ln_even, *w_in, *gm_norm, *gm_ws, *gm_b, *w_out, *ln_odd, *mu, *wr, *wk, *wv, *wg, *w0, *w1, *w2,
      *a0, *a1, *a2, *k_k, *k_a, *r_k, *lnw, *lnb, *wo, *fnorm;
  float* out;
  bfu *WT_in, *WT_out, *WT_3, *WT_o, *W2T, *A2T;
  bfu *H, *U, *GVT, *Q, *K, *VT, *SZ, *Y, *R, *K1, *V1, *SG, *EW, *AA, *YS, *TW, *TA, *GT, *MRT, *XR, *XK, *XV, *XG;
  float *G15, *COEF;
  unsigned* BAR;
};

DEVI float bf2f(unsigned b) { return __uint_as_float(b << 16); }
DEVI unsigned f2bf(float x) {
  const __bf16 h = (__bf16)x;
  return (unsigned)__builtin_bit_cast(unsigned short, h);
}
typedef __bf16 bf16x2_t __attribute__((ext_vector_type(2)));
typedef float float2_t __attribute__((ext_vector_type(2)));
DEVI unsigned pkbf(float a, float b) {
  const float2_t f = {a, b};
  const bf16x2_t h = __builtin_convertvector(f, bf16x2_t);
  return __builtin_bit_cast(unsigned, h);
}
DEVI void unpack8(uint4 v, float* f) {
  f[0] = __uint_as_float(v.x << 16); f[1] = __uint_as_float(v.x & 0xffff0000u);
  f[2] = __uint_as_float(v.y << 16); f[3] = __uint_as_float(v.y & 0xffff0000u);
  f[4] = __uint_as_float(v.z << 16); f[5] = __uint_as_float(v.z & 0xffff0000u);
  f[6] = __uint_as_float(v.w << 16); f[7] = __uint_as_float(v.w & 0xffff0000u);
}
DEVI uint4 pack8(const float* f) {
  uint4 r;
  r.x = pkbf(f[0], f[1]);
  r.y = pkbf(f[2], f[3]);
  r.z = pkbf(f[4], f[5]);
  r.w = pkbf(f[6], f[7]);
  return r;
}
DEVI void unpack4(uint2 v, float* f) {
  f[0] = __uint_as_float(v.x << 16); f[1] = __uint_as_float(v.x & 0xffff0000u);
  f[2] = __uint_as_float(v.y << 16); f[3] = __uint_as_float(v.y & 0xffff0000u);
}
DEVI uint2 pack4(const float* f) {
  uint2 r;
  r.x = pkbf(f[0], f[1]);
  r.y = pkbf(f[2], f[3]);
  return r;
}

DEVI float sigmoid_(float x) { return __builtin_amdgcn_rcpf(1.f + __expf(-x)); }
DEVI float silu_(float x) { return x * sigmoid_(x); }
DEVI float tanh_(float y) { return 1.f - 2.f * __builtin_amdgcn_rcpf(1.f + __expf(2.f * y)); }
DEVI float gelu_(float x) {
  const float y = 0.7978845608028654f * (x + 0.044715f * x * x * x);
  return x * __builtin_amdgcn_rcpf(1.f + __expf(-2.f * y));
}
DEVI float wave_sum(float v) {
#pragma unroll
  for (int o = 32; o > 0; o >>= 1) v += __shfl_xor(v, o);
  return v;
}
DEVI float wave_max(float v) {
#pragma unroll
  for (int o = 32; o > 0; o >>= 1) v = fmaxf(v, __shfl_xor(v, o));
  return v;
}
template <int CTRL>
DEVI float dppf(float x) {
  return __int_as_float(__builtin_amdgcn_update_dpp(0, __float_as_int(x), CTRL, 0xF, 0xF, true));
}
DEVI float reduce16(float x) {
  x += dppf<0xB1>(x);
  x += dppf<0x4E>(x);
  x += dppf<0x141>(x);
  x += dppf<0x140>(x);
  return x;
}

constexpr int LROW = 72;
constexpr int GSTAGE = 2 * 128 * LROW;

template <int DIST = 2, bool SW = true, class ALoad, class Epi>
DEVI void gemm_tile(char* smem, const ALoad& aload, const bfu* __restrict__ Bt, int ldb, int K, int m0, int n0,
                    const Epi& epi) {
  bfu* sbase = (bfu*)smem;
  const int tid = TIDX, lane = tid & 63, wid = tid >> 6, wr = wid >> 1, wc = wid & 1;
  const int fr = lane & 15, fq = lane >> 4;
  f32x4 acc[4][4];
#pragma unroll
  for (int i = 0; i < 4; ++i)
#pragma unroll
    for (int j = 0; j < 4; ++j) acc[i][j] = f32x4{0.f, 0.f, 0.f, 0.f};
  const int r0 = tid >> 3, kc = (tid & 7) * 8;
  const int nk = K >> 6;
  struct GRegs { typename ALoad::Raw a0, a1, a2, a3; uint4 ap, b0, b1, b2, b3; };
  GRegs g0, g1;
  const bfu* Bp = Bt + (size_t)(n0 + r0) * ldb + kc;
  const size_t ldb32 = (size_t)ldb * 32;
  constexpr int ARS = ALoad::kConsec ? 1 : 32;
  const int ar0 = ALoad::kConsec ? 4 * r0 : r0;
#define GEMM_ISSUE(R, KT)                                   \
  {                                                         \
    const int k0_ = ((KT) << 6);                            \
    R.ap = aload.loadprev(m0 + ar0, k0_ + kc);              \
    R.a0 = aload.load(m0 + ar0, k0_ + kc);                  \
    R.a1 = aload.load(m0 + ar0 + ARS, k0_ + kc);            \
    R.a2 = aload.load(m0 + ar0 + 2 * ARS, k0_ + kc);        \
    R.a3 = aload.load(m0 + ar0 + 3 * ARS, k0_ + kc);        \
    R.b0 = *(const uint4*)(Bp + k0_);                       \
    R.b1 = *(const uint4*)(Bp + ldb32 + k0_);               \
    R.b2 = *(const uint4*)(Bp + 2 * ldb32 + k0_);           \
    R.b3 = *(const uint4*)(Bp + 3 * ldb32 + k0_);           \
  }
#define GEMM_COMMIT(R, S, KT)                               \
  {                                                         \
    const int k1_ = ((KT) << 6) + kc;                       \
    bfu* A_ = sbase + (S) * GSTAGE + ar0 * LROW + kc;       \
    bfu* B_ = sbase + (S) * GSTAGE + 128 * LROW + r0 * LROW + kc;   \
    *(uint4*)(A_) = aload.finish(R.a0, R.ap, m0 + ar0, k1_);                                 \
    *(uint4*)(A_ + ARS * LROW) = aload.finish(R.a1, aload.asprev(R.a0), m0 + ar0 + ARS, k1_);          \
    *(uint4*)(A_ + 2 * ARS * LROW) = aload.finish(R.a2, aload.asprev(R.a1), m0 + ar0 + 2 * ARS, k1_);  \
    *(uint4*)(A_ + 3 * ARS * LROW) = aload.finish(R.a3, aload.asprev(R.a2), m0 + ar0 + 3 * ARS, k1_);  \
    *(uint4*)(B_) = R.b0;                                   \
    *(uint4*)(B_ + 32 * LROW) = R.b1;                       \
    *(uint4*)(B_ + 64 * LROW) = R.b2;                       \
    *(uint4*)(B_ + 96 * LROW) = R.b3;                       \
  }
#define GEMM_COMPUTE(S)                                                                          \
  {                                                                                              \
    const bfu* cA = sbase + (S) * GSTAGE;                                                        \
    const bfu* cB = cA + 128 * LROW;                                                             \
    _Pragma("unroll") for (int ks = 0; ks < 2; ++ks) {                                           \
      bf16x8 af[4], bfv[4];                                                                      \
      _Pragma("unroll") for (int i = 0; i < 4; ++i) {                                            \
        af[i] = *(const bf16x8*)(cA + (wr * 64 + i * 16 + fr) * LROW + ks * 32 + fq * 8);        \
        bfv[i] = *(const bf16x8*)(cB + (wc * 64 + i * 16 + fr) * LROW + ks * 32 + fq * 8);       \
      }                                                                                          \
      _Pragma("unroll") for (int i = 0; i < 4; ++i) _Pragma("unroll") for (int j = 0; j < 4; ++j) \
          acc[i][j] = SW ? __builtin_amdgcn_mfma_f32_16x16x32_bf16(bfv[j], af[i], acc[i][j], 0, 0, 0)     \
                         : __builtin_amdgcn_mfma_f32_16x16x32_bf16(af[i], bfv[j], acc[i][j], 0, 0, 0);    \
    }                                                                                            \
  }
  const int nkm1 = nk - 1;
  if (DIST == 2 && nk == 1) {
    GEMM_ISSUE(g0, 0);
    GEMM_COMMIT(g0, 0, 0);
    __syncthreads();
    GEMM_COMPUTE(0);
    __syncthreads();
  } else if (DIST == 2) {
    GEMM_ISSUE(g0, 0);
    GEMM_ISSUE(g1, (1 < nkm1 ? 1 : nkm1));
    GEMM_COMMIT(g0, 0, 0);
    GEMM_ISSUE(g0, (2 < nkm1 ? 2 : nkm1));
    __syncthreads();
    {
      for (int kt = 0; kt < nk; kt += 2) {
        GEMM_COMMIT(g1, 1, (kt + 1 < nkm1 ? kt + 1 : nkm1));
        GEMM_ISSUE(g1, (kt + 3 < nkm1 ? kt + 3 : nkm1));
        GEMM_COMPUTE(0);
        __syncthreads();
        GEMM_COMMIT(g0, 0, (kt + 2 < nkm1 ? kt + 2 : nkm1));
        GEMM_ISSUE(g0, (kt + 4 < nkm1 ? kt + 4 : nkm1));
        GEMM_COMPUTE(1);
        __syncthreads();
      }
    }
  } else {
    GEMM_ISSUE(g0, 0);
    GEMM_COMMIT(g0, 0, 0);
    GEMM_ISSUE(g0, (1 < nkm1 ? 1 : nkm1));
    __syncthreads();
    for (int kt = 0; kt < nk; kt += 2) {
      GEMM_COMMIT(g0, 1, (kt + 1 < nkm1 ? kt + 1 : nkm1));
      GEMM_ISSUE(g0, (kt + 2 < nkm1 ? kt + 2 : nkm1));
      GEMM_COMPUTE(0);
      __syncthreads();
      GEMM_COMMIT(g0, 0, (kt + 2 < nkm1 ? kt + 2 : nkm1));
      GEMM_ISSUE(g0, (kt + 3 < nkm1 ? kt + 3 : nkm1));
      GEMM_COMPUTE(1);
      __syncthreads();
    }
  }
#pragma unroll
  for (int i = 0; i < 4; ++i)
#pragma unroll
    for (int j = 0; j < 4; ++j) {
      if (SW) epi(m0 + wr * 64 + i * 16 + fr, n0 + wc * 64 + j * 16 + fq * 4, acc[i][j]);
      else epi(m0 + wr * 64 + i * 16 + fq * 4, n0 + wc * 64 + j * 16 + fr, acc[i][j]);
    }
}

namespace pg8 {
#define PG8_LAS __attribute__((address_space(3)))
typedef unsigned short bf16_t;
typedef short bf16x8 __attribute__((ext_vector_type(8)));
typedef float f32x4 __attribute__((ext_vector_type(4)));
typedef unsigned u32x4 __attribute__((ext_vector_type(4)));
constexpr int BM = 256, BK = 64, HALF = 128, HTB = HALF * BK * 2  , STAGE_BYTES = 8 * HTB, NXCD = 8, WGM = 8;

__host__ __device__ __forceinline__ int lds_byte(int r, int c) { const int st = (r >> 4) * 2 + (c >> 5), rr = r & 15, cc = c & 31, ob = rr * 64 + cc * 2; return st * 1024 + (ob ^ (((ob >> 9) & 1) << 5)); }
__host__ __device__ __forceinline__ void stage_rc(int b, int& R, int& C) { const int st = b / 1024, sb = b % 1024, swz = sb ^ (((sb >> 9) & 1) << 5); R = (st >> 1) * 16 + swz / 64; C = (st & 1) * 32 + (swz % 64) / 2; }
__host__ __device__ __forceinline__ int perm32(int rho) { const int n = rho >> 4, i = rho & 15; return 8 * (i >> 2) + 4 * n + (i & 3); }

struct Unit { int pm, pn; };
struct Gemm { const bf16_t* A; const bf16_t* Bt; int M, N, K; const bf16_t* A2; int pn_split; unsigned long long rmap, cmap;
  __device__ __forceinline__ size_t rt(int pm) const { return rmap ? (size_t)((rmap >> (4 * pm)) & 15ull) : (size_t)pm; }
  __device__ __forceinline__ size_t ct(int pn) const { return cmap ? (size_t)((cmap >> (4 * pn)) & 15ull) : (size_t)pn; } };

struct StaticOrder {
    int nM, nN, nwg, G, c;
    __host__ __device__ void init(int M, int N, int G_, int c_) { nM = M / BM; nN = N / BM; nwg = nM * nN; G = G_; c = c_; }
    __host__ __device__ bool next(int i, Unit& u) const {
        const long L = (long)i * G + c; if (L >= nwg) return false;
        int wgid = (int)L; { const int q = nwg / NXCD, r = nwg % NXCD, xcd = wgid % NXCD, off = wgid / NXCD; wgid = (xcd < r ? xcd * (q + 1) : r * (q + 1) + (xcd - r) * q) + off; }
        const int nig = WGM * nN, gid = wgid / nig, fm = gid * WGM, gsz = (nM - fm) < WGM ? (nM - fm) : WGM;
        u.pm = fm + ((wgid % nig) % gsz); u.pn = (wgid % nig) / gsz; return true;
    }
    __device__ __forceinline__ void a_ready(const Unit&) const {}
    __device__ __forceinline__ void done(const Unit&) const {}
};
struct CountedOrder : StaticOrder {
    const unsigned* ready; unsigned need; unsigned* tmo;
    __device__ __forceinline__ void a_ready(const Unit& u) const {
        if (threadIdx.x < 64) {
            const unsigned long long t0 = __builtin_amdgcn_s_memrealtime(); unsigned polls = 0;
            while ((unsigned)__builtin_amdgcn_readfirstlane(__hip_atomic_load(ready + 64 * u.pm, __ATOMIC_RELAXED, __HIP_MEMORY_SCOPE_AGENT)) < need) {
                if ((++polls & 255u) == 0u && __builtin_amdgcn_readfirstlane(__hip_atomic_load(tmo, __ATOMIC_RELAXED, __HIP_MEMORY_SCOPE_AGENT)) != 0u) break;
                if (__builtin_amdgcn_s_memrealtime() - t0 > 2000000ull) {
                    if (threadIdx.x == 0) { unsigned expect = 0u; __hip_atomic_compare_exchange_strong(tmo + 1, &expect, 0x600u | (unsigned)(u.pm & 0xff), __ATOMIC_RELAXED, __ATOMIC_RELAXED, __HIP_MEMORY_SCOPE_AGENT); __hip_atomic_store(tmo, 1u, __ATOMIC_RELAXED, __HIP_MEMORY_SCOPE_AGENT); }
                    break; }
                __builtin_amdgcn_s_sleep(2); }
            __builtin_amdgcn_fence(__ATOMIC_ACQUIRE, "agent");
            asm volatile("s_waitcnt vmcnt(0)" ::: "memory");
        }
#if !defined(BROKEN_HOOK_NO_BARRIER)
        asm volatile("" ::: "memory"); __builtin_amdgcn_s_barrier(); asm volatile("" ::: "memory");
#endif
    }
};

__device__ __forceinline__ unsigned cvt_pk_bf16(float lo, float hi) { unsigned r; asm volatile("v_cvt_pk_bf16_f32 %0, %1, %2" : "=v"(r) : "v"(lo), "v"(hi)); return r; }
typedef float f32x2 __attribute__((ext_vector_type(2)));
__device__ __forceinline__ f32x2 gelu_pk(f32x2 v) {
    const f32x2 av = __builtin_elementwise_abs(v), d = av * 0.2316418882f + 1.0f;
    f32x2 t; t.x = __builtin_amdgcn_rcpf(d.x); t.y = __builtin_amdgcn_rcpf(d.y);
    f32x2 q = t * 0.5307027145f + (-0.7265760135f); q = q * t + 0.7107068705f; q = q * t + (-0.142248368f); q = q * t + 0.127414796f; q = q * t;
    const f32x2 s = (v * v) * (-0.72134752044f);
    f32x2 e; e.x = __builtin_amdgcn_exp2f(s.x); e.y = __builtin_amdgcn_exp2f(s.y);
    const f32x2 m = v * (q * e), r = v - m;
    f32x2 o; o.x = v.x < 0.f ? m.x : r.x; o.y = v.y < 0.f ? m.y : r.y; return o;
}

struct EpiF32 {
    static constexpr bool PERM = false, AFTER_DRAIN = false;
    float* C; int ldc; const float* bias;
    __device__ __forceinline__ void operator()(const f32x4 (&acc)[2][2][4][2], const Unit& u, int wr, int wc, int fr, int fq) const {
        const int row0 = u.pm * BM + wr * 64 + fr, col0 = u.pn * BM + wc * 32 + 4 * fq;
        f32x4 bv[2][2];
#pragma unroll
        for (int bj = 0; bj < 2; ++bj)
#pragma unroll
            for (int n = 0; n < 2; ++n) bv[bj][n] = bias ? *(const f32x4*)(bias + col0 + bj * HALF + n * 16) : (f32x4){0.f, 0.f, 0.f, 0.f};
#pragma unroll
        for (int ai = 0; ai < 2; ++ai)
#pragma unroll
            for (int m = 0; m < 4; ++m) { float* rowp = C + (size_t)(row0 + ai * HALF + m * 16) * ldc + col0;
#pragma unroll
                for (int bj = 0; bj < 2; ++bj)
#pragma unroll
                    for (int n = 0; n < 2; ++n) *(f32x4*)(rowp + bj * HALF + n * 16) = acc[ai][bj][m][n] + bv[bj][n]; }
    }
};
template <int ACT  > struct EpiBf16 {
    static constexpr bool PERM = true, AFTER_DRAIN = false;
    bf16_t* O; int ldc; const float* bias; int split_cols; size_t split_stride;
    __device__ __forceinline__ void operator()(const f32x4 (&acc)[2][2][4][2], const Unit& u, int wr, int wc, int fr, int fq) const {
        const int row0 = u.pm * BM + wr * 64 + fr; int colt = u.pn * BM; bf16_t* base = O;
        if (split_cols) { const int t = colt / split_cols; base += (size_t)t * split_stride; colt -= t * split_cols; }
        const int col0 = colt + wc * 32 + 8 * fq, bcol0 = u.pn * BM + wc * 32 + 8 * fq;
        f32x4 bv[2][2];
#pragma unroll
        for (int bj = 0; bj < 2; ++bj)
#pragma unroll
            for (int n = 0; n < 2; ++n) bv[bj][n] = bias ? *(const f32x4*)(bias + bcol0 + bj * HALF + 4 * n) : (f32x4){0.f, 0.f, 0.f, 0.f};
#pragma unroll
        for (int ai = 0; ai < 2; ++ai)
#pragma unroll
            for (int m = 0; m < 4; ++m) { bf16_t* rowp = base + (size_t)(row0 + ai * HALF + m * 16) * ldc + col0;
#pragma unroll
                for (int bj = 0; bj < 2; ++bj) { f32x4 v0 = acc[ai][bj][m][0] + bv[bj][0], v1 = acc[ai][bj][m][1] + bv[bj][1];
                    if (ACT == 1) { f32x2 a = gelu_pk((f32x2){v0[0], v0[1]}), b = gelu_pk((f32x2){v0[2], v0[3]}), c = gelu_pk((f32x2){v1[0], v1[1]}), d = gelu_pk((f32x2){v1[2], v1[3]});
                        v0 = (f32x4){a.x, a.y, b.x, b.y}; v1 = (f32x4){c.x, c.y, d.x, d.y}; }
                    if (ACT == 2) {
#pragma unroll
                        for (int j = 0; j < 4; ++j) { v0[j] = 0.5f * v0[j] * (1.0f + erff(v0[j] * 0.70710678f)); v1[j] = 0.5f * v1[j] * (1.0f + erff(v1[j] * 0.70710678f)); } }
                    u32x4 w; w.x = cvt_pk_bf16(v0[0], v0[1]); w.y = cvt_pk_bf16(v0[2], v0[3]); w.z = cvt_pk_bf16(v1[0], v1[1]); w.w = cvt_pk_bf16(v1[2], v1[3]);
                    *(u32x4*)(rowp + bj * HALF) = w; } }
    }
};


template <class Epi, class Sched, bool STAMP = false>
__device__ __forceinline__ void gemm_phase(PG8_LAS unsigned char* lds, const Gemm g, const Sched& S, const Epi& E, unsigned long long* stamps) {
    const int tid = threadIdx.x, wid = __builtin_amdgcn_readfirstlane(tid >> 6), lane = tid & 63, wr = wid >> 2, wc = wid & 3, fr = lane & 15, fq = lane >> 4;
    const int K = g.K, nt = K / BK;
    int ts_lo = 0, ts_hi = 0, nts = 0; const unsigned long long rt_entry = STAMP ? (unsigned long long)wall_clock64() : 0ull;
#define PG8_STAMP() do { if (STAMP && wid == 0 && nts < 64) { const unsigned long long _c = (unsigned long long)clock64(); \
        ts_lo = (lane == nts) ? (int)(unsigned)_c : ts_lo; ts_hi = (lane == nts) ? (int)(unsigned)(_c >> 32) : ts_hi; ++nts; } } while (0)
    PG8_STAMP();
    unsigned voffA[2], voffB[2];
#pragma unroll
    for (int i = 0; i < 2; ++i) { int R, C; stage_rc(tid * 16 + i * 8192, R, C); const int Rb = Epi::PERM ? ((R & ~31) + perm32(R & 31)) : R;
        voffA[i] = (unsigned)(R * K + C) * 2u; voffB[i] = (unsigned)(Rb * K + C) * 2u; }
    const size_t kstep = (size_t)(BK * 2);
    const size_t hstep = (size_t)HALF * K * 2;
    const size_t tstep = 2 * hstep;
    const unsigned ldsw = (unsigned)wid * 1024u;
    const int aoff = lds_byte(wr * 64 + fr, fq * 8), boff = lds_byte(wc * 32 + fr, fq * 8);
#define PG8_SA(b, h) (((b) * 2 + (h)) * HTB)
#define PG8_SB(b, h) ((4 + (b) * 2 + (h)) * HTB)
#define PG8_STAGE(bufoff, gbase, voff) do { _Pragma("unroll") for (int _i = 0; _i < 2; ++_i) \
        __builtin_amdgcn_global_load_lds((const unsigned*)((const char*)(gbase) + (voff)[_i]), (PG8_LAS unsigned*)(lds + (bufoff) + ldsw + _i * 8192), 16, 0, 0); } while (0)
#define PG8_LDA(dst, b, h) do { _Pragma("unroll") for (int m = 0; m < 4; ++m) _Pragma("unroll") for (int k = 0; k < 2; ++k) dst[m][k] = *(const PG8_LAS bf16x8*)(lds + PG8_SA(b, h) + aoff + m * 2048 + k * 1024); } while (0)
#define PG8_LDB(dst, b, h) do { _Pragma("unroll") for (int n = 0; n < 2; ++n) _Pragma("unroll") for (int k = 0; k < 2; ++k) dst[n][k] = *(const PG8_LAS bf16x8*)(lds + PG8_SB(b, h) + boff + n * 2048 + k * 1024); } while (0)
#define PG8_MMA(ai, bj, At, Bt) do { __builtin_amdgcn_s_setprio(1); _Pragma("unroll") for (int m = 0; m < 4; ++m) _Pragma("unroll") for (int n = 0; n < 2; ++n) _Pragma("unroll") for (int k = 0; k < 2; ++k) \
        acc[ai][bj][m][n] = __builtin_amdgcn_mfma_f32_16x16x32_bf16(Bt[n][k], At[m][k], acc[ai][bj][m][n], 0, 0, 0); __builtin_amdgcn_s_setprio(0); } while (0)
#define PG8_WAIT_V(n) asm volatile("s_waitcnt vmcnt(" #n ")" ::: "memory")
#define PG8_WAIT_L(n) asm volatile("s_waitcnt lgkmcnt(" #n ")" ::: "memory")
#define PG8_BAR __builtin_amdgcn_s_barrier()
#define PG8_SCHED __builtin_amdgcn_sched_barrier(0)
    Unit cur, nxt; int ui = 0;
    if (!S.next(0, cur)) return;
    f32x4 acc[2][2][4][2];
#pragma unroll
    for (int a = 0; a < 2; ++a)
#pragma unroll
        for (int b = 0; b < 2; ++b)
#pragma unroll
            for (int m = 0; m < 4; ++m)
#pragma unroll
                for (int n = 0; n < 2; ++n) acc[a][b][m][n] = (f32x4){0.f, 0.f, 0.f, 0.f};
    bf16x8 At[4][2], B0[2][2], B1[2][2];
    const char* cA = (const char*)(cur.pn >= g.pn_split ? g.A2 : g.A) + g.rt(cur.pm) * tstep; const char* cB = (const char*)g.Bt + g.ct(cur.pn) * tstep;
    S.a_ready(cur);
    PG8_STAGE(PG8_SB(0, 0), cB, voffB); PG8_STAGE(PG8_SA(0, 0), cA, voffA); PG8_STAGE(PG8_SB(0, 1), cB + hstep, voffB); PG8_STAGE(PG8_SA(0, 1), cA + hstep, voffA);
    if (wr == 1) PG8_BAR;
    PG8_WAIT_V(4); PG8_BAR;
    PG8_STAGE(PG8_SB(1, 0), cB + kstep, voffB); PG8_STAGE(PG8_SA(1, 0), cA + kstep, voffA); PG8_STAGE(PG8_SB(1, 1), cB + hstep + kstep, voffB);
    PG8_WAIT_V(6); PG8_BAR;
    PG8_STAMP();
    for (;;) {
        const bool has_next = S.next(ui + 1, nxt);
        const char* nA = has_next ? (const char*)(nxt.pn >= g.pn_split ? g.A2 : g.A) + g.rt(nxt.pm) * tstep : cA; const char* nB = has_next ? (const char*)g.Bt + g.ct(nxt.pn) * tstep : cB;
        for (int t = 0; t < nt; t += 2) {
            const bool last = (t == nt - 2);
            const char* a1 = cA + (size_t)(t + 1) * kstep;
            const char* a2 = last ? nA : cA + (size_t)(t + 2) * kstep; const char* b2 = last ? nB : cB + (size_t)(t + 2) * kstep;
            const char* a3 = a2 + kstep; const char* b3 = b2 + kstep;
            if (last && has_next) S.a_ready(nxt);
            PG8_LDB(B0, 0, 0); PG8_SCHED; PG8_LDA(At, 0, 0); PG8_STAGE(PG8_SA(1, 1), a1 + hstep, voffA);
            PG8_WAIT_L(8); PG8_BAR; PG8_WAIT_L(0); PG8_MMA(0, 0, At, B0); PG8_BAR; PG8_SCHED;
            PG8_LDB(B1, 0, 1); PG8_STAGE(PG8_SB(0, 0), b2, voffB);
            PG8_BAR; PG8_WAIT_L(0); PG8_MMA(0, 1, At, B1); PG8_BAR;
            PG8_LDA(At, 0, 1); PG8_STAGE(PG8_SA(0, 0), a2, voffA);
            PG8_BAR; PG8_WAIT_L(0); PG8_MMA(1, 0, At, B0); PG8_BAR; PG8_SCHED;
            PG8_STAGE(PG8_SB(0, 1), b2 + hstep, voffB);
            PG8_WAIT_V(6); PG8_BAR; PG8_MMA(1, 1, At, B1); PG8_BAR;
            PG8_LDB(B0, 1, 0); PG8_SCHED; PG8_LDA(At, 1, 0); PG8_STAGE(PG8_SA(0, 1), a2 + hstep, voffA);
            PG8_WAIT_L(8); PG8_BAR; PG8_WAIT_L(0); PG8_MMA(0, 0, At, B0); PG8_BAR; PG8_SCHED;
            PG8_LDB(B1, 1, 1); PG8_STAGE(PG8_SB(1, 0), b3, voffB);
            PG8_BAR; PG8_WAIT_L(0); PG8_MMA(0, 1, At, B1); PG8_BAR;
            PG8_LDA(At, 1, 1); PG8_STAGE(PG8_SA(1, 0), a3, voffA);
            PG8_BAR; PG8_WAIT_L(0); PG8_MMA(1, 0, At, B0); PG8_BAR; PG8_SCHED;
            PG8_STAGE(PG8_SB(1, 1), b3 + hstep, voffB);
            PG8_WAIT_V(6); PG8_BAR; PG8_MMA(1, 1, At, B1); PG8_BAR;
        }
        PG8_STAMP();
        if constexpr (!Epi::AFTER_DRAIN) { E(acc, cur, wr, wc, fr, fq); S.done(cur); }
        PG8_STAMP();
        if (!has_next) break;
#pragma unroll
        for (int a = 0; a < 2; ++a)
#pragma unroll
            for (int b = 0; b < 2; ++b)
#pragma unroll
                for (int m = 0; m < 4; ++m)
#pragma unroll
                    for (int n = 0; n < 2; ++n) acc[a][b][m][n] = (f32x4){0.f, 0.f, 0.f, 0.f};
        cur = nxt; cA = nA; cB = nB; ++ui;
    }
    PG8_WAIT_V(0);
    if (wr == 0) PG8_BAR;
    PG8_BAR;
    if constexpr (Epi::AFTER_DRAIN) { E.fused(acc, cur, wr, wc, fr, fq, lds, wid, lane); S.done(cur); }
    PG8_STAMP();
    if (STAMP && wid == 0) { stamps[lane] = lane < nts ? (((unsigned long long)(unsigned)ts_hi << 32) | (unsigned)ts_lo) : 0ull;
        if (lane == 62) stamps[62] = rt_entry; if (lane == 63) stamps[63] = (unsigned long long)wall_clock64(); }
#undef PG8_STAMP
#undef PG8_SA
#undef PG8_SB
#undef PG8_STAGE
#undef PG8_LDA
#undef PG8_LDB
#undef PG8_MMA
#undef PG8_WAIT_V
#undef PG8_WAIT_L
#undef PG8_BAR
#undef PG8_SCHED
}
}

struct TileSched {
  int xcd, local, vbid, vnb, MT, NT, SM, SN, j, snc;
  bool swz;
  DEVI TileSched(int bid, int nb, int half, int MT_, int NT_, int SM_, int SN_) : MT(MT_), NT(NT_), SM(SM_), SN(SN_), j(0) {
    xcd = bid & 7;
    local = (bid >> 3) * 2 + half;
    vbid = bid * 2 + half;
    vnb = nb * 2;
    swz = (vnb == 8 * SM * SN) && ((nb & 7) == 0);
    snc = (NT + SN - 1) / SN;
  }
  DEVI int next(int& mt, int& nt) {
    if (swz) {
      const int s = j * 8 + xcd;
      ++j;
      const int sm = s / snc, sn = s - sm * snc;
      if (sm * SM >= MT) return 0;
      mt = sm * SM + local / SN;
      nt = sn * SN + local % SN;
      return (mt < MT && nt < NT) ? 1 : 2;
    } else {
      const int it = vbid + j * vnb;
      ++j;
      if (it >= MT * NT) return 0;
      mt = it / NT;
      nt = it - mt * NT;
      return 1;
    }
  }
};

struct ALoadPlain {
  typedef uint4 Raw;
  static constexpr bool kFat = false;
  static constexpr bool kConsec = false;
  const bfu* A;
  int lda;
  DEVI Raw load(int row, int k) const { return *(const uint4*)(A + (size_t)row * lda + k); }
  DEVI uint4 loadprev(int, int) const { return uint4{0u, 0u, 0u, 0u}; }
  DEVI uint4 asprev(const Raw&) const { return uint4{0u, 0u, 0u, 0u}; }
  DEVI uint4 finish(const Raw& r, const uint4&, int, int) const { return r; }
};

DEVI void transpose_tile(char* smem, const float* __restrict__ src, int Ns, bfu* __restrict__ dst, int ldd, int noff,
                         int k0, int n0) {
  float(*tile)[65] = (float(*)[65])smem;
  const int tid = TIDX;
  const int kr = tid >> 4, nc = (tid & 15) * 4;
#pragma unroll
  for (int p = 0; p < 4; ++p) {
    float4 v = *(const float4*)(src + (size_t)(k0 + kr + 16 * p) * Ns + n0 + nc);
    tile[kr + 16 * p][nc] = v.x;
    tile[kr + 16 * p][nc + 1] = v.y;
    tile[kr + 16 * p][nc + 2] = v.z;
    tile[kr + 16 * p][nc + 3] = v.w;
  }
  __syncthreads();
  const int nr = tid >> 3, kc = (tid & 7) * 8;
#pragma unroll
  for (int p = 0; p < 2; ++p) {
    const int n = nr + 32 * p;
    float f[8];
#pragma unroll
    for (int j = 0; j < 8; ++j) f[j] = tile[kc + j][n];
    *(uint4*)(dst + (size_t)(noff + n0 + n) * ldd + k0 + kc) = pack8(f);
  }
  __syncthreads();
}

DEVI void rms_row2_bf16(const float* __restrict__ src, const float* __restrict__ g, bfu* __restrict__ dst, int lane) {
  float4 v[2][4];
  float ss[2] = {0.f, 0.f};
#pragma unroll
  for (int r = 0; r < 2; ++r)
#pragma unroll
    for (int i = 0; i < 4; ++i) v[r][i] = *(const float4*)(src + r * 1024 + lane * 4 + 256 * i);
#pragma unroll
  for (int r = 0; r < 2; ++r)
#pragma unroll
    for (int i = 0; i < 4; ++i)
      ss[r] += v[r][i].x * v[r][i].x + v[r][i].y * v[r][i].y + v[r][i].z * v[r][i].z + v[r][i].w * v[r][i].w;
#pragma unroll
  for (int r = 0; r < 2; ++r) {
    const float rinv = rsqrtf(wave_sum(ss[r]) * (1.f / 1024.f) + 1e-6f);
#pragma unroll
    for (int i = 0; i < 4; ++i) {
      const float4 gg = *(const float4*)(g + lane * 4 + 256 * i);
      uint2 o;
      o.x = pkbf(v[r][i].x * rinv * gg.x, v[r][i].y * rinv * gg.y);
      o.y = pkbf(v[r][i].z * rinv * gg.z, v[r][i].w * rinv * gg.w);
      *(uint2*)(dst + r * 1024 + lane * 4 + 256 * i) = o;
    }
  }
}

DEVI void phase0(const Params& p, char* smem, int bid, int nb) {
  constexpr int NT_IN = 16 * 56, NT_SQ = 256, NT_SM = 16;
  constexpr int c0 = NT_IN, c1 = c0 + NT_SQ, c2 = c1 + 4 * NT_SQ, c3 = c2 + NT_SM, c4 = c3 + NT_SM, c5 = c4 + NT_SQ,
                c6 = c5 + NT_SM, c7 = c6 + NT_SM, c8 = c7 + 2, c9 = c8 + T_TOK / 8;
  smem += HF * HALF_SMEM;
  for (int it = bid * 2 + HF; it < c9; it += nb * 2) {
    if (it < c0) {
      transpose_tile(smem, p.w_in, 3584, p.WT_in, 1024, 0, (it / 56) * 64, (it % 56) * 64);
    } else if (it < c1) {
      int j = it - c0;
      transpose_tile(smem, p.w_out, 1024, p.WT_out, 1024, 0, (j >> 4) * 64, (j & 15) * 64);
    } else if (it < c2) {
      int j = it - c1;
      int w = j >> 8;
      j &= 255;
      const float* src = (w == 0) ? p.wr : (w == 1) ? p.wk : (w == 2) ? p.wv : p.wg;
      transpose_tile(smem, src, 1024, p.WT_3, 1024, w * 1024, (j >> 4) * 64, (j & 15) * 64);
    } else if (it < c3) {
      int j = it - c2;
      transpose_tile(smem, p.w1, 64, p.WT_3, 1024, 4096, j * 64, 0);
    } else if (it < c4) {
      int j = it - c3;
      transpose_tile(smem, p.a1, 64, p.WT_3, 1024, 4224, j * 64, 0);
    } else if (it < c5) {
      int j = it - c4;
      transpose_tile(smem, p.wo, 1024, p.WT_o, 1024, 0, (j >> 4) * 64, (j & 15) * 64);
    } else if (it < c6) {
      int j = it - c5;
      transpose_tile(smem, p.w2, 1024, p.W2T, 64, 0, 0, j * 64);
    } else if (it < c7) {
      int j = it - c6;
      transpose_tile(smem, p.a2, 1024, p.A2T, 64, 0, 0, j * 64);
    } else if (it < c8) {
      int j = it - c7;
      bfu* dst = p.WT_3 + (size_t)(j == 0 ? 4160 : 4288) * 1024;
      for (int e = TIDX; e < 64 * 1024 / 8; e += 256) *(uint4*)(dst + e * 8) = uint4{0, 0, 0, 0};
    } else {
      int row = (it - c8) * 8 + (TIDX >> 6) * 2;
      rms_row2_bf16(p.x + (size_t)row * 1024, p.ln_even, p.H + (size_t)row * 1024, TIDX & 63);
    }
  }
}

constexpr unsigned long long kCmap1 = 0xDCBA765410ull;
struct PgEpi1 {
  static constexpr bool PERM = true, AFTER_DRAIN = false;
  const Params* p;
  DEVI void operator()(const pg8::f32x4 (&acc)[2][2][4][2], const pg8::Unit& u, int wr, int wc, int fr, int fq) const {
    const int row0 = u.pm * 256 + wr * 64 + fr;
    const int seg = (int)((kCmap1 >> (4 * u.pn)) & 15ull);
#pragma unroll
    for (int ai = 0; ai < 2; ++ai)
#pragma unroll
      for (int m = 0; m < 4; ++m) {
        const int row = row0 + ai * 128 + m * 16;
#pragma unroll
        for (int bj = 0; bj < 2; ++bj) {
          const int col = seg * 256 + bj * 128 + wc * 32 + 8 * fq;
          const f32x4 v0 = acc[ai][bj][m][0], v1 = acc[ai][bj][m][1];
          uint4 w;
          if (seg < 2) {
            w.x = pkbf(gelu_(v0[0]), gelu_(v0[1])); w.y = pkbf(gelu_(v0[2]), gelu_(v0[3]));
            w.z = pkbf(gelu_(v1[0]), gelu_(v1[1])); w.w = pkbf(gelu_(v1[2]), gelu_(v1[3]));
            *(uint4*)(p->U + (size_t)row * 512 + col) = w;
          } else if (seg < 8) {
            w.x = pkbf(v0[0], v0[1]); w.y = pkbf(v0[2], v0[3]); w.z = pkbf(v1[0], v1[1]); w.w = pkbf(v1[2], v1[3]);
            bfu* dst = (seg < 6) ? p->Q + (size_t)row * 512 + (col - 1024) : p->K + (size_t)row * 512 + (col - 1536);
            *(uint4*)dst = w;
          } else {
            w.x = pkbf(silu_(v0[0]), silu_(v0[1])); w.y = pkbf(silu_(v0[2]), silu_(v0[3]));
            w.z = pkbf(silu_(v1[0]), silu_(v1[1])); w.w = pkbf(silu_(v1[2]), silu_(v1[3]));
            *(uint4*)(p->SZ + (size_t)row * 1024 + (col - 2560)) = w;
          }
        }
      }
  }
};
constexpr unsigned long long kRmap1 = 0x9832ull;
struct PgEpi1T {
  static constexpr bool PERM = true, AFTER_DRAIN = false;
  const Params* p;
  DEVI void operator()(const pg8::f32x4 (&acc)[2][2][4][2], const pg8::Unit& u, int wr, int wc, int fr, int fq) const {
    const int ch0 = (u.pm & 1) * 256 + wr * 64 + fr;
    const bool isv = u.pm >= 2;
#pragma unroll
    for (int ai = 0; ai < 2; ++ai)
#pragma unroll
      for (int m = 0; m < 4; ++m) {
        const int ch = ch0 + ai * 128 + m * 16;
#pragma unroll
        for (int bj = 0; bj < 2; ++bj) {
          const int t = u.pn * 256 + bj * 128 + wc * 32 + 8 * fq;
          const f32x4 v0 = acc[ai][bj][m][0], v1 = acc[ai][bj][m][1];
          if (!isv) {
            const int g = ch >> 7, c = ch & 127;
            uint4 w;
            w.x = pkbf(gelu_(v0[0]), gelu_(v0[1])); w.y = pkbf(gelu_(v0[2]), gelu_(v0[3]));
            w.z = pkbf(gelu_(v1[0]), gelu_(v1[1])); w.w = pkbf(gelu_(v1[2]), gelu_(v1[3]));
            *(uint4*)(p->GVT + ((size_t)(((t >> 7) * 4 + g) * 128 + c)) * 128 + (t & 127)) = w;
          } else {
            const int hh = ch >> 6, dim = ch & 63;
            const int b = t >> 14, s = t & (SEQ - 1);
            bfu* base = p->VT + ((size_t)((b * 8 + hh) * 64 + dim)) * SEQ;
            const size_t PST = (size_t)16 * 64 * SEQ;
            uint4 w;
            w.x = pkbf(v0[0], v0[1]); w.y = pkbf(v0[2], v0[3]); w.z = pkbf(v1[0], v1[1]); w.w = pkbf(v1[2], v1[3]);
            *(uint4*)(base + s) = w;
            bfu* b1 = base + PST + (s >> 2);
#pragma unroll
            for (int e = 0; e < 4; ++e) *(unsigned*)(b1 + (size_t)e * (SEQ / 4)) = pkbf(v0[e], v1[e]);
            bfu* b2 = base + 2 * PST + (size_t)(s & 15) * (SEQ / 16) + (s >> 4);
#pragma unroll
            for (int e = 0; e < 4; ++e) {
              b2[(size_t)e * (SEQ / 16)] = (bfu)f2bf(v0[e]);
              b2[(size_t)(e + 4) * (SEQ / 16)] = (bfu)f2bf(v1[e]);
            }
          }
        }
      }
  }
};
struct PgEpiRes {
  static constexpr bool PERM = false, AFTER_DRAIN = false;
  const float* base;
  float* out;
  DEVI void operator()(const pg8::f32x4 (&acc)[2][2][4][2], const pg8::Unit& u, int wr, int wc, int fr, int fq) const {
    const int row0 = u.pm * 256 + wr * 64 + fr, col0 = u.pn * 256 + wc * 32 + 4 * fq;
#pragma unroll
    for (int ai = 0; ai < 2; ++ai)
#pragma unroll
      for (int m = 0; m < 4; ++m) {
        const size_t rb = (size_t)(row0 + ai * 128 + m * 16) * 1024 + col0;
#pragma unroll
        for (int bj = 0; bj < 2; ++bj)
#pragma unroll
          for (int n = 0; n < 2; ++n) {
            const size_t idx = rb + bj * 128 + n * 16;
            const f32x4 b = *(const f32x4*)(base + idx);
            *(f32x4*)(out + idx) = acc[ai][bj][m][n] + b;
          }
      }
  }
};
template <class Epi>
DEVI void pg_gemm(char* smem, const bfu* A, const bfu* Bt, int M, int N, int K, const Epi& E, int bid, int nb) {
  pg8::Gemm g{A, Bt, M, N, K, A, 1 << 30, 0ull, 0ull};
  pg8::StaticOrder S;
  S.init(M, N, nb, bid);
  pg8::gemm_phase<Epi, pg8::StaticOrder, false>((PG8_LAS unsigned char*)smem, g, S, E, nullptr);
}
template <class Epi>
DEVI void pg_gemm2(char* smem, const bfu* A, const bfu* A2, int pn_split, const bfu* Bt, int M, int N, int K, const Epi& E,
                   int bid, int nb) {
  pg8::Gemm g{A, Bt, M, N, K, A2, pn_split, 0ull, 0ull};
  pg8::StaticOrder S;
  S.init(M, N, nb, bid);
  pg8::gemm_phase<Epi, pg8::StaticOrder, false>((PG8_LAS unsigned char*)smem, g, S, E, nullptr);
}
struct PgEpi3 {
  static constexpr bool PERM = true, AFTER_DRAIN = false;
  bfu* O0;
  bfu* O1;
  int silu1;
  DEVI void operator()(const pg8::f32x4 (&acc)[2][2][4][2], const pg8::Unit& u, int wr, int wc, int fr, int fq) const {
    const int row0 = u.pm * 256 + wr * 64 + fr;
    const int grp = u.pn >> 2;
    bfu* O = grp ? O1 : O0;
    const bool act = grp && silu1;
    const int colb = (u.pn & 3) * 256 + wc * 32 + 8 * fq;
#pragma unroll
    for (int ai = 0; ai < 2; ++ai)
#pragma unroll
      for (int m = 0; m < 4; ++m) {
        bfu* rowp = O + (size_t)(row0 + ai * 128 + m * 16) * 1024 + colb;
#pragma unroll
        for (int bj = 0; bj < 2; ++bj) {
          f32x4 v0 = acc[ai][bj][m][0], v1 = acc[ai][bj][m][1];
          if (act) {
#pragma unroll
            for (int e = 0; e < 4; ++e) {
              v0[e] = silu_(v0[e]);
              v1[e] = silu_(v1[e]);
            }
          }
          uint4 w;
          w.x = pkbf(v0[0], v0[1]); w.y = pkbf(v0[2], v0[3]); w.z = pkbf(v1[0], v1[1]); w.w = pkbf(v1[2], v1[3]);
          *(uint4*)(rowp + bj * 128) = w;
        }
      }
  }
};

DEVI void phase1(const Params& p, char* smem, int bid, int nb) {
  {
    PgEpi1 E{&p};
    pg8::Gemm g{p.H, p.WT_in, T_TOK, 2560, 1024, p.H, 1 << 30, 0ull, kCmap1};
    pg8::StaticOrder S;
    S.init(T_TOK, 2560, nb, bid);
    pg8::gemm_phase<PgEpi1, pg8::StaticOrder, false>((PG8_LAS unsigned char*)smem, g, S, E, nullptr);
  }
  {
    PgEpi1T E{&p};
    pg8::Gemm g{p.WT_in, p.H, 1024, T_TOK, 1024, p.WT_in, 1 << 30, kRmap1, 0ull};
    pg8::StaticOrder S;
    S.init(1024, T_TOK, nb, bid);
    pg8::gemm_phase<PgEpi1T, pg8::StaticOrder, false>((PG8_LAS unsigned char*)smem, g, S, E, nullptr);
  }
}

struct ALoadWs {
  struct Raw { float4 a, b; };
  static constexpr bool kFat = true;
  static constexpr bool kConsec = false;
  const float* ws;
  const float* rinv;
  DEVI Raw load(int t, int s0) const {
    Raw r;
    r.a = *(const float4*)(ws + t * 128 + s0);
    r.b = *(const float4*)(ws + t * 128 + s0 + 4);
    return r;
  }
  DEVI uint4 loadprev(int, int) const { return uint4{0u, 0u, 0u, 0u}; }
  DEVI uint4 asprev(const Raw&) const { return uint4{0u, 0u, 0u, 0u}; }
  DEVI uint4 finish(const Raw& r, const uint4&, int t, int s0) const {
    float f[8] = {r.a.x, r.a.y, r.a.z, r.a.w, r.b.x, r.b.y, r.b.z, r.b.w};
#pragma unroll
    for (int j = 0; j < 8; ++j) f[j] = (s0 + j <= t) ? f[j] * rinv[s0 + j] : 0.f;
    return pack8(f);
  }
};
struct EpiGm {
  const Params* p;
  int chunk, g;
  DEVI void operator()(int t, int c, f32x4 v) const {
    const float4 gn = *(const float4*)(p->gm_norm + g * 128 + c);
    const float bias = p->gm_b[g * 128 + t];
    const size_t tok = (size_t)chunk * 128 + t;
    float u[4], sz[4];
    unpack4(*(const uint2*)(p->U + tok * 512 + g * 128 + c), u);
    unpack4(*(const uint2*)(p->SZ + tok * 1024 + g * 128 + c), sz);
    uint2 o;
    o.x = pkbf(u[0] * (v[0] * gn.x + bias) * sz[0], u[1] * (v[1] * gn.y + bias) * sz[1]);
    o.y = pkbf(u[2] * (v[2] * gn.z + bias) * sz[2], u[3] * (v[3] * gn.w + bias) * sz[3]);
    *(uint2*)(p->Y + tok * 1024 + g * 128 + c) = o;
  }
};

DEVI void gmlp_item(const Params& p, char* smem, int item) {
  const int chunk = item >> 2, g = item & 3;
  const bfu* gv = p.GVT + (size_t)item * 128 * 128;
  float* rinv = (float*)(smem + 2 * GSTAGE_BYTES);
  const int tid = TIDX;
  {
    float* sred = rinv + 128;
    const int s4 = (tid & 31) * 4, cg = tid >> 5;
    uint2 raw[16];
#pragma unroll
    for (int i = 0; i < 16; ++i) raw[i] = *(const uint2*)(gv + (cg * 16 + i) * 128 + s4);
    float ss[4] = {0.f, 0.f, 0.f, 0.f};
#pragma unroll
    for (int i = 0; i < 16; ++i) {
      float f[4];
      unpack4(raw[i], f);
#pragma unroll
      for (int j = 0; j < 4; ++j) ss[j] += f[j] * f[j];
    }
    *(float4*)(sred + cg * 128 + s4) = float4{ss[0], ss[1], ss[2], ss[3]};
    __syncthreads();
    if (tid < 128) {
      float t = 0.f;
#pragma unroll
      for (int i = 0; i < 8; ++i) t += sred[i * 128 + tid];
      rinv[tid] = rsqrtf(t * (1.f / 128.f) + 1e-6f);
    }
  }
  __syncthreads();
  ALoadWs al{p.gm_ws + (size_t)g * 128 * 128, rinv};
  EpiGm epi{&p, chunk, g};
  gemm_tile(smem, al, gv, 128, 128, 0, 0, epi);
}

DEVI void attn_item(const Params& p, char* smem, int item) {
  const int qb = item & 63, bh = item >> 6, b = bh >> 3, h = bh & 7;
  const int q0 = qb * 256;
  bfu* Ob = (bfu*)smem;
  float* Mb = (float*)(smem + 32768);
  float* Lb = Mb + 256;
  const int tid = threadIdx.x, lane = tid & 63, wid = tid >> 6;
  const int qi = lane & 15, g = lane >> 4;
  const float slope = exp2f(-(float)(h + 1));
  const size_t tokb = (size_t)b * SEQ;
#pragma unroll 1
  for (int pi = 0; pi < 3; ++pi) {
    const int dshift = 2 * pi, d = 1 << dshift;
    const bfu* VT = p.VT + (size_t)pi * ((size_t)16 * 64 * SEQ) + (size_t)bh * 64 * SEQ;
#pragma unroll 1
    for (int u = wid; u < 16; u += 8) {
      const int r = u & (d - 1), tile = u >> dshift;
      const int sq0 = (q0 >> dshift) + tile * 16;
      const int sk0 = sq0 - 144;
      const int posq = ((sq0 + qi) << dshift) + r;
      const bfu* qp = p.Q + (tokb + posq) * 512 + h * 64 + g * 8;
      const bf16x8 qf0 = *(const bf16x8*)qp, qf1 = *(const bf16x8*)(qp + 32);
      const bfu* kbase = p.K + (tokb + r) * 512 + h * 64 + g * 8;
      const bfu* vbase = VT + (size_t)qi * SEQ + r * (SEQ >> dshift);
      bf16x8 kf[2][2];
      uint2 vf[4][2];
      auto loadk = [&](int it) {
#pragma unroll
        for (int tt = 0; tt < 2; ++tt) {
          int sk = sk0 + (2 * it + tt) * 16 + qi;
          sk = sk < 0 ? 0 : sk;
          const bfu* kp = kbase + ((size_t)sk << dshift) * 512;
          kf[tt][0] = *(const bf16x8*)kp;
          kf[tt][1] = *(const bf16x8*)(kp + 32);
        }
      };
      auto loadv = [&](int it) {
        int kidx0 = sk0 + 32 * it + 4 * g, kidx1 = kidx0 + 16;
        kidx0 = kidx0 < 0 ? 0 : kidx0;
        kidx1 = kidx1 < 0 ? 0 : kidx1;
#pragma unroll
        for (int m = 0; m < 4; ++m) {
          vf[m][0] = *(const uint2*)(vbase + (size_t)(16 * m) * SEQ + kidx0);
          vf[m][1] = *(const uint2*)(vbase + (size_t)(16 * m) * SEQ + kidx1);
        }
      };
      loadk(0);
      loadv(0);
      const int hi = 144 + qi, lo = (16 + qi > -sk0) ? 16 + qi : -sk0;
      const float sd = slope * (float)d;
      float mrun = -1e30f, l = 0.f;
      f32x4 O[4];
#pragma unroll
      for (int m = 0; m < 4; ++m) O[m] = f32x4{0.f, 0.f, 0.f, 0.f};
#pragma unroll 1
      for (int it = 0; it < 5; ++it) {
        bf16x8 ck[2][2];
        uint2 cv[4][2];
#pragma unroll
        for (int a = 0; a < 2; ++a)
#pragma unroll
          for (int c = 0; c < 2; ++c) ck[a][c] = kf[a][c];
        const int itn = it < 4 ? it + 1 : 4;
        loadk(itn);
        f32x4 S[2];
#pragma unroll
        for (int tt = 0; tt < 2; ++tt) {
          f32x4 z = {0.f, 0.f, 0.f, 0.f};
          z = __builtin_amdgcn_mfma_f32_16x16x32_bf16(ck[tt][0], qf0, z, 0, 0, 0);
          z = __builtin_amdgcn_mfma_f32_16x16x32_bf16(ck[tt][1], qf1, z, 0, 0, 0);
          S[tt] = z;
        }
        float mx = -INFINITY;
#pragma unroll
        for (int tt = 0; tt < 2; ++tt)
#pragma unroll
          for (int e = 0; e < 4; ++e) {
            const int kb = (2 * it + tt) * 16 + 4 * g;
            const bool valid = (kb >= lo - e) && (kb <= hi - e);
            const float sv = valid ? fmaf(S[tt][e], 0.125f, sd * (float)e - sd * (float)(hi - kb)) : -INFINITY;
            S[tt][e] = sv;
            mx = fmaxf(mx, sv);
          }
        mx = fmaxf(mx, __shfl_xor(mx, 16));
        mx = fmaxf(mx, __shfl_xor(mx, 32));
        const float mnew = fmaxf(mrun, mx);
        const float alpha = __expf(mrun - mnew);
        mrun = mnew;
        float ls = 0.f;
#pragma unroll
        for (int tt = 0; tt < 2; ++tt)
#pragma unroll
          for (int e = 0; e < 4; ++e) {
            const float pe = __expf(S[tt][e] - mnew);
            S[tt][e] = pe;
            ls += pe;
          }
        l = l * alpha + ls;
        uint4 pk;
        pk.x = pkbf(S[0][0], S[0][1]);
        pk.y = pkbf(S[0][2], S[0][3]);
        pk.z = pkbf(S[1][0], S[1][1]);
        pk.w = pkbf(S[1][2], S[1][3]);
        const bf16x8 pf = __builtin_bit_cast(bf16x8, pk);
#pragma unroll
        for (int m = 0; m < 4; ++m) {
          cv[m][0] = vf[m][0];
          cv[m][1] = vf[m][1];
        }
        loadv(itn);
#pragma unroll
        for (int m = 0; m < 4; ++m) {
          O[m] *= alpha;
          const uint4 vv = {cv[m][0].x, cv[m][0].y, cv[m][1].x, cv[m][1].y};
          O[m] = __builtin_amdgcn_mfma_f32_16x16x32_bf16(__builtin_bit_cast(bf16x8, vv), pf, O[m], 0, 0, 0);
        }
      }
      l += __shfl_xor(l, 16);
      l += __shfl_xor(l, 32);
      const float mx = mrun;
      const float il = 1.f / l;
      const int ql = ((tile * 16 + qi) << dshift) + r;
      float wo = 0.f, wn = 1.f;
      float mnew = mx, lnew = l;
      if (pi > 0) {
        const float mo = Mb[ql], lo = Lb[ql];
        mnew = fmaxf(mo, mx);
        wo = lo * __expf(mo - mnew);
        wn = l * __expf(mx - mnew);
        lnew = wo + wn;
        const float inv = 1.f / lnew;
        wo *= inv;
        wn *= inv;
      }
      wn *= il;
#pragma unroll
      for (int m = 0; m < 4; ++m) {
        bfu* op = Ob + ql * 64 + 16 * m + 4 * g;
        float o[4];
        if (pi > 0) {
          const uint2 ov = *(const uint2*)op;
          o[0] = wo * bf2f(ov.x & 0xffffu) + wn * O[m][0];
          o[1] = wo * bf2f(ov.x >> 16) + wn * O[m][1];
          o[2] = wo * bf2f(ov.y & 0xffffu) + wn * O[m][2];
          o[3] = wo * bf2f(ov.y >> 16) + wn * O[m][3];
        } else {
#pragma unroll
          for (int e = 0; e < 4; ++e) o[e] = wn * O[m][e];
        }
        if (pi < 2) {
          uint2 w;
          w.x = pkbf(o[0], o[1]);
          w.y = pkbf(o[2], o[3]);
          *(uint2*)op = w;
        } else {
          const size_t oi = (tokb + q0 + ql) * 1024 + 512 + h * 64 + 16 * m + 4 * g;
          const uint2 sz = *(const uint2*)(p.SZ + oi);
          uint2 w;
          w.x = pkbf(o[0] * bf2f(sz.x & 0xffffu), o[1] * bf2f(sz.x >> 16));
          w.y = pkbf(o[2] * bf2f(sz.y & 0xffffu), o[3] * bf2f(sz.y >> 16));
          *(uint2*)(p.Y + oi) = w;
        }
      }
      if (pi < 2 && g == 0) {
        Mb[ql] = mnew;
        Lb[ql] = lnew;
      }
    }
    __syncthreads();
  }
}

DEVI void phase2(const Params& p, char* smem, int bid, int nb) {
  for (int it = bid; it < 16 * 64; it += nb) attn_item(p, smem, it);
  char* hs = smem + HF * HALF_SMEM;
  for (int it = bid * 2 + HF; it < (T_TOK / 128) * 4; it += nb * 2) gmlp_item(p, hs, it);
}

DEVI void phase3(const Params& p, char* smem, int bid, int nb) {
  PgEpiRes E{p.x, p.out};
  pg_gemm(smem, p.Y, p.WT_out, T_TOK, 1024, 1024, E, bid, nb);
}
DEVI void phase3b(const Params& p, int bid, int nb) {
  for (int it = bid; it < T_TOK / 16; it += nb) {
    const int row = it * 16 + (threadIdx.x >> 6) * 2;
    rms_row2_bf16(p.out + (size_t)row * 1024, p.ln_odd, p.H + (size_t)row * 1024, threadIdx.x & 63);
  }
}

struct ALoadMix {
  typedef uint4 Raw;
  static constexpr bool kFat = true;
  static constexpr bool kConsec = true;
  const bfu* H;
  const float* mu;
  DEVI Raw load(int row, int k) const { return *(const uint4*)(H + (size_t)row * 1024 + k); }
  DEVI uint4 loadprev(int row, int k) const {
    const int prow = ((row & (SEQ - 1)) != 0) ? row - 1 : row;
    return *(const uint4*)(H + (size_t)prow * 1024 + k);
  }
  DEVI uint4 asprev(const Raw& r) const { return r; }
  DEVI uint4 finish(const Raw& r, const uint4& pr, int row, int k) const {
    float c[8], pv[8];
    unpack8(r, c);
    unpack8(pr, pv);
    const float first = ((row & (SEQ - 1)) != 0) ? 1.f : 0.f;
    const float4 m0 = *(const float4*)(mu + k), m1 = *(const float4*)(mu + k + 4);
    const float mm[8] = {m0.x, m0.y, m0.z, m0.w, m1.x, m1.y, m1.z, m1.w};
#pragma unroll
    for (int j = 0; j < 8; ++j) c[j] = c[j] + (pv[j] * first - c[j]) * mm[j];
    return pack8(c);
  }
};
struct Epi4 {
  const Params* p;
  int nt;
  DEVI void operator()(int row, int col, f32x4 v) const {
    uint2 o;
    if (nt < 24) {
      o.x = pkbf(v[0], v[1]);
      o.y = pkbf(v[2], v[3]);
      bfu* dst = (nt < 8) ? p->R + (size_t)row * 1024 + col
                          : (nt < 16) ? p->K1 + (size_t)row * 1024 + col - 1024 : p->V1 + (size_t)row * 1024 + col - 2048;
      *(uint2*)dst = o;
    } else if (nt < 32) {
      o.x = pkbf(silu_(v[0]), silu_(v[1]));
      o.y = pkbf(silu_(v[2]), silu_(v[3]));
      *(uint2*)(p->SG + (size_t)row * 1024 + col - 3072) = o;
    } else if (nt == 32) {
      const int c = col - 4096;
      if (c < 64) {
        o.x = pkbf(tanh_(v[0]), tanh_(v[1]));
        o.y = pkbf(tanh_(v[2]), tanh_(v[3]));
        *(uint2*)(p->TW + (size_t)row * 64 + c) = o;
      }
    } else {
      const int c = col - 4224;
      if (c < 64) {
        o.x = pkbf(v[0], v[1]);
        o.y = pkbf(v[2], v[3]);
        *(uint2*)(p->TA + (size_t)row * 64 + c) = o;
      }
    }
  }
};
DEVI void phase4_tile(const Params& p, char* smem, int mt, int nt) {
  float* smu = (float*)(smem + 2 * GSTAGE_BYTES);
  const int mi = (nt < 8) ? 0 : (nt < 16) ? 2 : (nt < 24) ? 3 : (nt < 32) ? 5 : (nt == 32) ? 1 : 4;
  *(float4*)(smu + TIDX * 4) = *(const float4*)(p.mu + mi * 1024 + TIDX * 4);
  __syncthreads();
  ALoadMix al{p.H, smu};
  Epi4 epi{&p, nt};
  gemm_tile<1>(smem, al, p.WT_3, 1024, 1024, mt * 128, nt * 128, epi);
}
DEVI void phaseM(const Params& p, char* smem, int bid, int nb) {
  char* hs = smem + HF * HALF_SMEM;
  for (int it = bid * 2 + HF; it < (T_TOK / 128) * 2; it += nb * 2) phase4_tile(p, hs, it >> 1, 32 + (it & 1));
  const int tid = threadIdx.x;
  const int cc = (tid & 127) * 8, rsub = tid >> 7;
  float mr[8], mk[8], mv[8], mg[8];
  {
    const float4 a0 = *(const float4*)(p.mu + 0 * 1024 + cc), a1 = *(const float4*)(p.mu + 0 * 1024 + cc + 4);
    const float4 b0 = *(const float4*)(p.mu + 2 * 1024 + cc), b1 = *(const float4*)(p.mu + 2 * 1024 + cc + 4);
    const float4 c0 = *(const float4*)(p.mu + 3 * 1024 + cc), c1 = *(const float4*)(p.mu + 3 * 1024 + cc + 4);
    const float4 d0 = *(const float4*)(p.mu + 5 * 1024 + cc), d1 = *(const float4*)(p.mu + 5 * 1024 + cc + 4);
    mr[0] = a0.x; mr[1] = a0.y; mr[2] = a0.z; mr[3] = a0.w; mr[4] = a1.x; mr[5] = a1.y; mr[6] = a1.z; mr[7] = a1.w;
    mk[0] = b0.x; mk[1] = b0.y; mk[2] = b0.z; mk[3] = b0.w; mk[4] = b1.x; mk[5] = b1.y; mk[6] = b1.z; mk[7] = b1.w;
    mv[0] = c0.x; mv[1] = c0.y; mv[2] = c0.z; mv[3] = c0.w; mv[4] = c1.x; mv[5] = c1.y; mv[6] = c1.z; mv[7] = c1.w;
    mg[0] = d0.x; mg[1] = d0.y; mg[2] = d0.z; mg[3] = d0.w; mg[4] = d1.x; mg[5] = d1.y; mg[6] = d1.z; mg[7] = d1.w;
  }
#pragma unroll 1
  for (int it = bid; it < T_TOK / 8; it += nb) {
    const int ra = it * 8 + rsub, rb = ra + 4;
    const size_t oa = (size_t)ra * 1024 + cc, ob = (size_t)rb * 1024 + cc;
    const uint4 ca = *(const uint4*)(p.H + oa), cb = *(const uint4*)(p.H + ob);
    const uint4 pa = *(const uint4*)(p.H + (((ra & (SEQ - 1)) != 0) ? oa - 1024 : oa));
    const uint4 pb = *(const uint4*)(p.H + ob - 1024);
    const float fa = ((ra & (SEQ - 1)) != 0) ? 1.f : 0.f;
#pragma unroll
    for (int half = 0; half < 2; ++half) {
      float c[8], d[8], o[8];
      unpack8(half ? cb : ca, c);
      unpack8(half ? pb : pa, d);
      const float f = half ? 1.f : fa;
      const size_t oo = half ? ob : oa;
#pragma unroll
      for (int j = 0; j < 8; ++j) d[j] = d[j] * f - c[j];
#pragma unroll
      for (int j = 0; j < 8; ++j) o[j] = c[j] + d[j] * mr[j];
      *(uint4*)(p.XR + oo) = pack8(o);
#pragma unroll
      for (int j = 0; j < 8; ++j) o[j] = c[j] + d[j] * mk[j];
      *(uint4*)(p.XK + oo) = pack8(o);
#pragma unroll
      for (int j = 0; j < 8; ++j) o[j] = c[j] + d[j] * mv[j];
      *(uint4*)(p.XV + oo) = pack8(o);
#pragma unroll
      for (int j = 0; j < 8; ++j) o[j] = c[j] + d[j] * mg[j];
      *(uint4*)(p.XG + oo) = pack8(o);
    }
  }
}
DEVI void phase3a(const Params& p, char* smem, int bid, int nb) {
  PgEpi3 E{p.R, p.K1, 0};
  pg_gemm2(smem, p.XR, p.XK, 4, p.WT_3, T_TOK, 2048, 1024, E, bid, nb);
}
DEVI void phase3c(const Params& p, char* smem, int bid, int nb) {
  PgEpi3 E{p.V1, p.SG, 1};
  pg_gemm2(smem, p.XV, p.XG, 4, p.WT_3 + (size_t)2048 * 1024, T_TOK, 2048, 1024, E, bid, nb);
}

struct Epi5w {
  const Params* p;
  DEVI void operator()(int row, int col, f32x4 v) const {
    const float4 w0 = *(const float4*)(p->w0 + col);
    const float k = 0.6065306597126334f;
    uint2 o;
    o.x = pkbf(k * sigmoid_(w0.x + v[0]), k * sigmoid_(w0.y + v[1]));
    o.y = pkbf(k * sigmoid_(w0.z + v[2]), k * sigmoid_(w0.w + v[3]));
    *(uint2*)(p->EW + (size_t)row * 1024 + col) = o;
  }
};
struct Epi5a {
  const Params* p;
  DEVI void operator()(int row, int col, f32x4 v) const {
    const float4 a0 = *(const float4*)(p->a0 + col);
    uint2 o;
    o.x = pkbf(sigmoid_(a0.x + v[0]), sigmoid_(a0.y + v[1]));
    o.y = pkbf(sigmoid_(a0.z + v[2]), sigmoid_(a0.w + v[3]));
    *(uint2*)(p->AA + (size_t)row * 1024 + col) = o;
  }
};
DEVI void phase5(const Params& p, char* smem, int bid, int nb) {
  constexpr int N1 = (T_TOK / 128) * 8;
  char* hs = smem + HF * HALF_SMEM;
  for (int it = bid * 2 + HF; it < 2 * N1; it += nb * 2) {
    if (it < N1) {
      ALoadPlain al{p.TW, 64};
      Epi5w epi{&p};
      gemm_tile(hs, al, p.W2T, 64, 64, (it >> 3) * 128, (it & 7) * 128, epi);
    } else {
      const int j = it - N1;
      ALoadPlain al{p.TA, 64};
      Epi5a epi{&p};
      gemm_tile(hs, al, p.A2T, 64, 64, (j >> 3) * 128, (j & 7) * 128, epi);
    }
  }
}

DEVI void scanx_item(const Params& p, char* smem, int item, int next_item, uint2& ur, uint2& uk, uint2& ue, uint2& ua, uint2& uv) {
  const int bh = item & 31, c = item >> 5;
  const int b = bh >> 4, h = bh & 15;
  const size_t rowbase = ((size_t)b * SEQ + (size_t)c * 16) * 1024 + h * 64;
  float* sA = (float*)smem;
  float* sR = sA + 16 * 68;
  float* sBt = sR + 16 * 68;
  float* sKt = sBt + 16 * 68;
  float* sE = sKt + 16 * 68;
  float* sMab = sE + 16 * 64;
  float* sMak = sMab + 256;
  float* sM2 = sMak + 256;
  float* sM4 = sM2 + 256;
  float* sT = sM4 + 256;
  float* sT2 = sT + 256;
  const int tid = TIDX;
  const int tau = tid >> 4, c4 = (tid & 15) * 4;
  const size_t o = rowbase + (size_t)tau * 1024 + c4;
  float r[4], k[4], ew[4], a[4], vv[4];
  unpack4(ur, r);
  unpack4(uk, k);
  unpack4(ue, ew);
  unpack4(ua, a);
  unpack4(uv, vv);
  {
    const int nbh = next_item & 31, nc = next_item >> 5;
    const size_t no = ((size_t)(nbh >> 4) * SEQ + (size_t)nc * 16 + tau) * 1024 + (nbh & 15) * 64 + c4;
    ur = *(const uint2*)(p.R + no);
    uk = *(const uint2*)(p.K1 + no);
    ue = *(const uint2*)(p.EW + no);
    ua = *(const uint2*)(p.AA + no);
    uv = *(const uint2*)(p.V1 + no);
  }
  float kk[4], kp[4], bb[4];
  float ss = 0.f, cf = 0.f;
#pragma unroll
  for (int j = 0; j < 4; ++j) {
    const int ch = h * 64 + c4 + j;
    kk[j] = k[j] * p.k_k[ch];
    ss += kk[j] * kk[j];
    kp[j] = k[j] * (1.f + (a[j] - 1.f) * p.k_a[ch]);
    cf += r[j] * kp[j] * p.r_k[ch];
  }
  ss = reduce16(ss);
  cf = reduce16(cf);
  const float rn = rsqrtf(fmaxf(ss, 1e-24f));
#pragma unroll
  for (int j = 0; j < 4; ++j) {
    kk[j] *= rn;
    bb[j] = kk[j] * a[j];
    sE[tau * 64 + c4 + j] = ew[j];
  }
  if ((tid & 15) == 0) p.COEF[((size_t)b * SEQ + (size_t)c * 16 + tau) * 16 + h] = cf;
  __syncthreads();
  float Li[4] = {0.f, 0.f, 0.f, 0.f}, L15[4] = {0.f, 0.f, 0.f, 0.f};
#pragma unroll
  for (int i = 0; i < 16; ++i) {
    const float4 e = *(const float4*)(sE + i * 64 + c4);
    const float m = (i <= tau) ? 1.f : 0.f;
    Li[0] += m * e.x; Li[1] += m * e.y; Li[2] += m * e.z; Li[3] += m * e.w;
    L15[0] += e.x; L15[1] += e.y; L15[2] += e.z; L15[3] += e.w;
  }
  float rt[4], bhat[4], khat[4];
#pragma unroll
  for (int j = 0; j < 4; ++j) {
    const float ep = __expf(Li[j]), em = __expf(-Li[j]), eh = __expf(-(L15[j] - Li[j]));
    const float at = -kk[j] * __expf(-(Li[j] - ew[j]));
    rt[j] = r[j] * em;
    sA[tau * 68 + c4 + j] = at;
    sR[tau * 68 + c4 + j] = rt[j];
    sBt[tau * 68 + c4 + j] = bb[j] * ep;
    sKt[tau * 68 + c4 + j] = kp[j] * ep;
    bhat[j] = bb[j] * eh;
    khat[j] = kp[j] * eh;
  }
  *(uint2*)(p.R + o) = pack4(rt);
#pragma unroll
  for (int j = 0; j < 4; ++j) {
    const int lin = (c4 + j) * 16 + tau;
    const size_t off = rowbase + (size_t)(lin >> 6) * 1024 + (lin & 63);
    p.EW[off] = (bfu)f2bf(bhat[j]);
    p.K1[off] = (bfu)f2bf(khat[j]);
    p.V1[off] = (bfu)f2bf(vv[j]);
  }
  if (tau == 0) {
    float4 gq = {__expf(-L15[0]), __expf(-L15[1]), __expf(-L15[2]), __expf(-L15[3])};
    *(float4*)(p.G15 + (size_t)item * 64 + c4) = gq;
  }
  __syncthreads();
  {
    const int i = tid >> 4, tq = tid & 15;
    float mab = 0.f, mak = 0.f, mrb = 0.f, mrk = 0.f;
#pragma unroll
    for (int kq = 0; kq < 64; kq += 4) {
      const float4 bi = *(const float4*)(sBt + i * 68 + kq);
      const float4 ki = *(const float4*)(sKt + i * 68 + kq);
      const float4 aq = *(const float4*)(sA + tq * 68 + kq);
      const float4 rq = *(const float4*)(sR + tq * 68 + kq);
      mab += bi.x * aq.x + bi.y * aq.y + bi.z * aq.z + bi.w * aq.w;
      mak += ki.x * aq.x + ki.y * aq.y + ki.z * aq.z + ki.w * aq.w;
      mrb += bi.x * rq.x + bi.y * rq.y + bi.z * rq.z + bi.w * rq.w;
      mrk += ki.x * rq.x + ki.y * rq.y + ki.z * rq.z + ki.w * rq.w;
    }
    if (!(i < tq)) { mab = 0.f; mak = 0.f; }
    if (!(i <= tq)) { mrb = 0.f; mrk = 0.f; }
    sMab[i * 16 + tq] = mab;
    sMak[i * 16 + tq] = mak;
    bfu* mr = p.MRT + (size_t)item * 512 + tq * 32 + (i >> 2) * 8 + (i & 3);
    mr[0] = (bfu)f2bf(mrb);
    mr[4] = (bfu)f2bf(mrk);
  }
  __syncthreads();
  {
    const int i = tid >> 4, j = tid & 15;
    float m2 = 0.f;
#pragma unroll
    for (int kq = 0; kq < 16; ++kq) m2 += sMab[i * 16 + kq] * sMab[kq * 16 + j];
    sM2[i * 16 + j] = m2;
    __syncthreads();
    float t1 = ((i == j) ? 1.f : 0.f) + sMab[i * 16 + j] + m2, m4 = 0.f;
#pragma unroll
    for (int kq = 0; kq < 16; ++kq) {
      t1 += sMab[i * 16 + kq] * sM2[kq * 16 + j];
      m4 += sM2[i * 16 + kq] * sM2[kq * 16 + j];
    }
    sT[i * 16 + j] = t1;
    sM4[i * 16 + j] = m4;
    __syncthreads();
    float t2 = t1, m8 = 0.f;
#pragma unroll
    for (int kq = 0; kq < 16; ++kq) {
      t2 += sT[i * 16 + kq] * sM4[kq * 16 + j];
      m8 += sM4[i * 16 + kq] * sM4[kq * 16 + j];
    }
    sT2[i * 16 + j] = t2;
    __syncthreads();
    sM2[i * 16 + j] = m8;
    __syncthreads();
    float t3 = t2;
#pragma unroll
    for (int kq = 0; kq < 16; ++kq) t3 += sT2[i * 16 + kq] * sM2[kq * 16 + j];
    sT[i * 16 + j] = t3;
    __syncthreads();
  }
  {
    const int tq = tid >> 4, k4 = (tid & 15) * 4, ii = tid & 15;
    float w0 = 0.f, w1 = 0.f, w2 = 0.f, w3 = 0.f, gt = 0.f;
#pragma unroll
    for (int jj = 0; jj < 16; ++jj) {
      const float tm = sT[jj * 16 + tq];
      const float4 av = *(const float4*)(sA + jj * 68 + k4);
      w0 += av.x * tm; w1 += av.y * tm; w2 += av.z * tm; w3 += av.w * tm;
      gt += sMak[ii * 16 + jj] * tm;
    }
    uint2 wv;
    wv.x = pkbf(w0, w1);
    wv.y = pkbf(w2, w3);
    *(uint2*)(p.AA + rowbase + (size_t)tq * 1024 + k4) = wv;
    p.GT[(size_t)item * 256 + tq * 16 + ii] = (bfu)f2bf(gt);
  }
  __syncthreads();
}
DEVI void phase6x(const Params& p, char* smem, int bid, int nb) {
  char* hs = smem + HF * HALF_SMEM;
  constexpr int NI = (SEQ / 16) * 32;
  const int vnb = nb * 2;
  int it = bid * 2 + HF;
  if (it >= NI) return;
  uint2 ur, uk, ue, ua, uv;
  {
    const int tau = TIDX >> 4, c4 = (TIDX & 15) * 4;
    const int bh = it & 31, c = it >> 5;
    const size_t o = ((size_t)(bh >> 4) * SEQ + (size_t)c * 16 + tau) * 1024 + (bh & 15) * 64 + c4;
    ur = *(const uint2*)(p.R + o);
    uk = *(const uint2*)(p.K1 + o);
    ue = *(const uint2*)(p.EW + o);
    ua = *(const uint2*)(p.AA + o);
    uv = *(const uint2*)(p.V1 + o);
  }
#pragma unroll 1
  for (; it < NI; it += vnb) scanx_item(p, hs, it, (it + vnb < NI) ? it + vnb : it, ur, uk, ue, ua, uv);
}

DEVI bf16x8 mk8(uint2 a, uint2 b) {
  const uint4 v = {a.x, a.y, b.x, b.y};
  return __builtin_bit_cast(bf16x8, v);
}
DEVI uint2 packacc(f32x4 a) {
  uint2 r;
  r.x = pkbf(a[0], a[1]);
  r.y = pkbf(a[2], a[3]);
  return r;
}
constexpr int SCH = 4;
constexpr int SROW = 136;
constexpr int SARR = 16 * SROW;
constexpr int SOFF_GT = 5 * SARR;
constexpr int SOFF_MR = SOFF_GT + 512;
constexpr int SOFF_G15 = SOFF_MR + 1024;
constexpr int SIMG = SOFF_G15 + 256;
#define SCANS_LD5(P, I, O)                       \
    P##a##I = *(const uint4*)(p.AA + (O));       \
    P##r##I = *(const uint4*)(p.R + (O));        \
    P##e##I = *(const uint4*)(p.EW + (O));       \
    P##k##I = *(const uint4*)(p.K1 + (O));       \
    P##v##I = *(const uint4*)(p.V1 + (O));
#define SCANS_ISSUE(P, SC)                                                                           \
  {                                                                                                  \
    const size_t hb_ = ((size_t)b * SEQ) * 1024 + h * 64 + c80 * 8;                                  \
    const int tk0_ = (SC) * SCH * 16 + cl0 * 16 + row0;                                              \
    const int tk1_ = tk0_ + 32;                                                                      \
    SCANS_LD5(P, 0, hb_ + (size_t)(tk0_ < SEQ ? tk0_ : SEQ - 1) * 1024)                              \
    SCANS_LD5(P, 1, hb_ + (size_t)(tk1_ < SEQ ? tk1_ : SEQ - 1) * 1024)                              \
    const int c0_ = (SC) * SCH;                                                                      \
    const size_t ib_ = (size_t)b * 16 + h;                                                           \
    const int tg_ = tid < 128 ? tid : 127;                                                           \
    const int cg_ = c0_ + (tg_ >> 5);                                                                \
    P##gm = *(const uint4*)(p.GT + ((size_t)(cg_ < SEQ / 16 ? cg_ : SEQ / 16 - 1) * 32 + ib_) * 256 + (tg_ & 31) * 8);  \
    const int t5_ = tid < 64 ? tid : 63;                                                             \
    const int c5_ = c0_ + (t5_ >> 4);                                                                \
    P##g5 = *(const uint4*)(p.G15 + ((size_t)(c5_ < SEQ / 16 ? c5_ : SEQ / 16 - 1) * 32 + ib_) * 64 + (t5_ & 15) * 4);  \
    const int cm_ = c0_ + (tid >> 6);                                                                \
    P##mr = *(const uint4*)(p.MRT + ((size_t)(cm_ < SEQ / 16 ? cm_ : SEQ / 16 - 1) * 32 + ib_) * 512 + (tid & 63) * 8); \
  }
#define SCANS_ST5(P, I, B)                                                                           \
    *(uint2*)(B) = uint2{P##a##I.x, P##a##I.y};  *(uint2*)((B) + 8) = uint2{P##a##I.z, P##a##I.w};   \
    *(uint2*)((B) + SARR) = uint2{P##r##I.x, P##r##I.y};  *(uint2*)((B) + SARR + 8) = uint2{P##r##I.z, P##r##I.w};   \
    *(uint2*)((B) + 2 * SARR) = uint2{P##e##I.x, P##e##I.y};  *(uint2*)((B) + 2 * SARR + 8) = uint2{P##e##I.z, P##e##I.w};   \
    *(uint2*)((B) + 3 * SARR) = uint2{P##k##I.x, P##k##I.y};  *(uint2*)((B) + 3 * SARR + 8) = uint2{P##k##I.z, P##k##I.w};   \
    *(uint2*)((B) + 4 * SARR) = uint2{P##v##I.x, P##v##I.y};  *(uint2*)((B) + 4 * SARR + 8) = uint2{P##v##I.z, P##v##I.w};
#define SCANS_COMMIT(P)                                                                              \
  {                                                                                                  \
    char* b0_ = cimg + cl0 * SIMG + row0 * SROW + c80 * 16;                                          \
    SCANS_ST5(P, 0, b0_)                                                                             \
    SCANS_ST5(P, 1, b0_ + 2 * SIMG)                                                                  \
    if (tid < 128) *(uint4*)(cimg + (tid >> 5) * SIMG + SOFF_GT + (tid & 31) * 16) = P##gm;          \
    if (tid < 64) *(uint4*)(cimg + (tid >> 4) * SIMG + SOFF_G15 + (tid & 15) * 16) = P##g5;          \
    *(uint4*)(cimg + (tid >> 6) * SIMG + SOFF_MR + (tid & 63) * 16) = P##mr;                         \
  }
#define SCANS_COMPUTE(SCI)                                                                           \
  _Pragma("unroll 1") for (int cl = 0; cl < SCH && (SCI) * SCH + cl < SEQ / 16; ++cl) {             \
    const char* img = cimg + cl * SIMG;                                                              \
        \
    const uint2 vb = *(const uint2*)(img + 4 * SARR + vrow * SROW + vcol * 2);                       \
    const uint2 gt = *(const uint2*)(img + SOFF_GT + (q * 16 + 4 * g) * 2);                          \
    const char* wp = img + q * SROW + (4 * g) * 2;                                                   \
    const uint2 w00 = *(const uint2*)(wp), w01 = *(const uint2*)(wp + 32);                           \
    const uint2 w10 = *(const uint2*)(wp + 64), w11 = *(const uint2*)(wp + 96);                      \
    const uint2 r00 = *(const uint2*)(wp + SARR), r01 = *(const uint2*)(wp + SARR + 32);             \
    const uint2 r10 = *(const uint2*)(wp + SARR + 64), r11 = *(const uint2*)(wp + SARR + 96);        \
    const uint4 mr = *(const uint4*)(img + SOFF_MR + (q * 32 + g * 8) * 2);                          \
    uint2 bk0[4], bk1[4];                                                                            \
    float4 g15[4];                                                                                   \
    _Pragma("unroll") for (int n = 0; n < 4; ++n) {                                                  \
      const int ch = 16 * n + q;                                                                     \
      const char* bp = img + 2 * SARR + (ch >> 2) * SROW + ((ch & 3) * 16 + 4 * g) * 2;              \
      bk0[n] = *(const uint2*)(bp);                                                                  \
      bk1[n] = *(const uint2*)(bp + SARR);                                                           \
      g15[n] = *(const float4*)(img + SOFF_G15 + (16 * n + 4 * g) * 4);                              \
    }                                                                                                \
    __builtin_amdgcn_sched_barrier(0);                                                               \
    const bf16x8 sB0 = mk8(packacc(acc[0]), packacc(acc[1]));                                        \
    const bf16x8 sB1 = mk8(packacc(acc[2]), packacc(acc[3]));                                        \
    f32x4 Z = {0.f, 0.f, 0.f, 0.f};                                                                  \
    Z = __builtin_amdgcn_mfma_f32_16x16x32_bf16(mk8(gt, zero2), mk8(vb, zero2), Z, 0, 0, 0);         \
    f32x4 Y = {0.f, 0.f, 0.f, 0.f};                                                                  \
    Z = __builtin_amdgcn_mfma_f32_16x16x32_bf16(mk8(w00, w01), sB0, Z, 0, 0, 0);                     \
    Y = __builtin_amdgcn_mfma_f32_16x16x32_bf16(mk8(r00, r01), sB0, Y, 0, 0, 0);                     \
    Z = __builtin_amdgcn_mfma_f32_16x16x32_bf16(mk8(w10, w11), sB1, Z, 0, 0, 0);                     \
    Y = __builtin_amdgcn_mfma_f32_16x16x32_bf16(mk8(r10, r11), sB1, Y, 0, 0, 0);                     \
    const bf16x8 zvB = mk8(packacc(Z), vb);                                                          \
    Y = __builtin_amdgcn_mfma_f32_16x16x32_bf16(__builtin_bit_cast(bf16x8, mr), zvB, Y, 0, 0, 0);    \
    _Pragma("unroll") for (int n = 0; n < 4; ++n) {                                                  \
      f32x4 scv = acc[n];                                                                            \
      scv[0] *= g15[n].x; scv[1] *= g15[n].y; scv[2] *= g15[n].z; scv[3] *= g15[n].w;                \
      acc[n] = __builtin_amdgcn_mfma_f32_16x16x32_bf16(mk8(bk0[n], bk1[n]), zvB, scv, 0, 0, 0);      \
    }                                                                                                \
    _Pragma("unroll") for (int e = 0; e < 4; ++e)                                                    \
        ybuf[(cl * 16 + 4 * g + e) * 16 + q] = (bfu)f2bf(Y[e]);                                      \
  }
DEVI void scans_block(const Params& p, char* smem, int bh, int vs) {
  const int b = bh >> 4, h = bh & 15;
  const int lane = threadIdx.x & 63, wv = threadIdx.x >> 6, q = lane & 15, g = lane >> 4;
  f32x4 acc[4];
#pragma unroll
  for (int n = 0; n < 4; ++n) acc[n] = f32x4{0.f, 0.f, 0.f, 0.f};
  const uint2 zero2 = {0u, 0u};
  bfu* yout = p.YS + ((size_t)b * SEQ) * 1024 + h * 64 + vs * 16;
  char* const img0 = smem;
  char* const img1 = smem + SCH * SIMG;
  bfu* const yb0 = (bfu*)(smem + 2 * SCH * SIMG);
  bfu* const yb1 = yb0 + SCH * 16 * 16;
  const int tid = TIDX;
  const bool stager = wv >= 4;
  const int cl0 = tid >> 7, row0 = (tid >> 3) & 15, c80 = tid & 7;
  uint4 Aa0, Aa1, Ar0, Ar1, Ae0, Ae1, Ak0, Ak1, Av0, Av1, Agm, Ag5, Amr;
  constexpr int NSC = (SEQ / 16) / SCH;
  const int vrow = vs * 4 + (q >> 2), vcol = (q & 3) * 16 + 4 * g;
  if (stager) {
    char* cimg = img0;
    SCANS_ISSUE(A, 0);
    SCANS_COMMIT(A);
    SCANS_ISSUE(A, 1);
  }
  __syncthreads();
#define SCANS_FLUSH(YB, S)                                                                                       \
  if (wv >= 1 && wv <= 2) {                                                                                      \
    const int idx = (int)threadIdx.x - 64, tok = (S) * SCH * 16 + (idx >> 1);                                    \
    *(uint4*)(yout + (size_t)tok * 1024 + (idx & 1) * 8) = *(const uint4*)((YB) + (idx >> 1) * 16 + (idx & 1) * 8); \
  }
#pragma unroll 1
  for (int sc = 0; sc < NSC; sc += 2) {
    if (wv == 0) {
      const char* cimg = img0;
      bfu* ybuf = yb0;
      SCANS_COMPUTE(sc);
    } else if (stager) {
      char* cimg = img1;
      SCANS_COMMIT(A);
      SCANS_ISSUE(A, (sc + 2 < NSC ? sc + 2 : NSC - 1));
    } else if (sc > 0) {
      SCANS_FLUSH(yb1, sc - 1)
    }
    __syncthreads();
    if (wv == 0) {
      const char* cimg = img1;
      bfu* ybuf = yb1;
      SCANS_COMPUTE(sc + 1);
    } else if (stager) {
      char* cimg = img0;
      SCANS_COMMIT(A);
      SCANS_ISSUE(A, (sc + 3 < NSC ? sc + 3 : NSC - 1));
    } else {
      SCANS_FLUSH(yb0, sc)
    }
    __syncthreads();
  }
  SCANS_FLUSH(yb1, NSC - 1)
#undef SCANS_FLUSH
}
DEVI void phase6(const Params& p, char* smem, int bid, int nb) {
  for (int it = bid; it < 128; it += nb) scans_block(p, smem, it >> 2, it & 3);
}

DEVI void phase6b(const Params& p, int bid, int nb) {
  const int lane = threadIdx.x & 63, wv = (threadIdx.x >> 6) & 3;
  for (int it = bid; it < T_TOK / 4; it += nb) {
    const int t0 = it * 4 + (threadIdx.x >> 8) * 2;
    float ys[8], vv[8], sg[8], bon[8];
#pragma unroll
    for (int j = 0; j < 8; ++j) {
      const int t = t0 + (j >> 2), h = wv * 4 + (j & 3);
      const int tb = t & ~15, tau = t & 15;
      const size_t idx = (size_t)t * 1024 + h * 64 + lane;
      ys[j] = bf2f(p.YS[idx]);
      sg[j] = bf2f(p.SG[idx]);
      vv[j] = bf2f(p.V1[(size_t)(tb + (lane >> 2)) * 1024 + h * 64 + (lane & 3) * 16 + tau]);
      bon[j] = p.COEF[(size_t)t * 16 + h];
    }
#pragma unroll
    for (int j = 0; j < 8; ++j) {
      const int t = t0 + (j >> 2), h = wv * 4 + (j & 3);
      const int c = h * 64 + lane;
      const float mean = wave_sum(ys[j]) * (1.f / 64.f);
      const float dv = ys[j] - mean;
      const float var = wave_sum(dv * dv) * (1.f / 64.f);
      float y = dv * rsqrtf(var + 64e-5f) * p.lnw[c] + p.lnb[c];
      y = (y + bon[j] * vv[j]) * sg[j];
      p.YS[(size_t)t * 1024 + c] = (bfu)f2bf(y);
    }
  }
}

DEVI void phase7(const Params& p, char* smem, int bid, int nb) {
  PgEpiRes E{p.out, p.out};
  pg_gemm(smem, p.YS, p.WT_o, T_TOK, 1024, 1024, E, bid, nb);
}
DEVI void phase8(const Params& p, int bid, int nb) {
  for (int it = bid; it < T_TOK / 16; it += nb) {
    const int row = it * 16 + (threadIdx.x >> 6) * 2;
    const int lane = threadIdx.x & 63;
    float* src = p.out + (size_t)row * 1024;
    float4 v[2][4];
    float ss[2] = {0.f, 0.f};
#pragma unroll
    for (int r = 0; r < 2; ++r)
#pragma unroll
      for (int i = 0; i < 4; ++i) v[r][i] = *(const float4*)(src + r * 1024 + lane * 4 + 256 * i);
#pragma unroll
    for (int r = 0; r < 2; ++r)
#pragma unroll
      for (int i = 0; i < 4; ++i)
        ss[r] += v[r][i].x * v[r][i].x + v[r][i].y * v[r][i].y + v[r][i].z * v[r][i].z + v[r][i].w * v[r][i].w;
#pragma unroll
    for (int r = 0; r < 2; ++r) {
      const float rinv = rsqrtf(wave_sum(ss[r]) * (1.f / 1024.f) + 1e-6f);
#pragma unroll
      for (int i = 0; i < 4; ++i) {
        const float4 g = *(const float4*)(p.fnorm + lane * 4 + 256 * i);
        const float4 o = {v[r][i].x * rinv * g.x, v[r][i].y * rinv * g.y, v[r][i].z * rinv * g.z, v[r][i].w * rinv * g.w};
        *(float4*)(src + r * 1024 + lane * 4 + 256 * i) = o;
      }
    }
  }
}

#define XB_TMO      128
#define XB_XCNT(j)  (256  + 64 * (j))
#define XB_XSUB(j)  (1280 + 64 * (j))
#define XB_XGEN(j)  (2304 + 64 * (j))
#define XB_TOP      3328
#define XB_TOPGEN   3392
#define XCD_BAR_WORDS 3456
#define XB_SPIN_CAP (1u << 18)
#define LAS __attribute__((address_space(3)))

__device__ __forceinline__ unsigned xb_ld(unsigned* p)              { return __hip_atomic_load(p, __ATOMIC_RELAXED, __HIP_MEMORY_SCOPE_AGENT); }
__device__ __forceinline__ unsigned xb_add(unsigned* p, unsigned v) { return __hip_atomic_fetch_add(p, v, __ATOMIC_RELAXED, __HIP_MEMORY_SCOPE_AGENT); }
__device__ __forceinline__ unsigned xb_xcc_id() { return (unsigned)__builtin_amdgcn_s_getreg((3 << 11) | 20) & 0xFu; }
#define XB_SPIN(cond, bar) do { unsigned _sp = 0; while (cond) { __builtin_amdgcn_s_sleep(1); \
    if ((++_sp & 255u) == 0u) { if (xb_ld(&(bar)[XB_TMO])) break; if (_sp > XB_SPIN_CAP) { atomicAdd(&(bar)[XB_TMO], 1u); break; } } } } while (0)

struct XcdBarrier {
    unsigned* bar; unsigned x;
    volatile LAS unsigned* st;
};

__device__ __forceinline__ XcdBarrier xcd_barrier_post(unsigned* bar, volatile LAS unsigned* st) {
    XcdBarrier b; b.bar = bar; b.x = xb_xcc_id(); b.st = st;
    if (threadIdx.x == 0) (void)xb_add(&bar[XB_XCNT(b.x)], 1u);
    return b;
}
__device__ __forceinline__ void xcd_barrier_complete(unsigned* bar, unsigned x, unsigned& nloc, unsigned& nx) {
    const unsigned G = gridDim.x * gridDim.y * gridDim.z;
    unsigned sum, cnt, mine, sp = 0u;
    for (;;) {
        sum = 0u; cnt = 0u; mine = 0u;
#pragma unroll
        for (unsigned j = 0; j < 16; ++j) { const unsigned c = xb_ld(&bar[XB_XCNT(j)]); sum += c; cnt += (c > 0u) ? 1u : 0u; mine = (j == x) ? c : mine; }
        if (sum == G) break;
        __builtin_amdgcn_s_sleep(1);
        if ((++sp & 255u) == 0u) { if (xb_ld(&bar[XB_TMO])) break; if (sp > XB_SPIN_CAP) { atomicAdd(&bar[XB_TMO], 1u); break; } }
    }
    nloc = mine > 0u ? mine : 1u; nx = cnt > 0u ? cnt : 1u;
}

__device__ __forceinline__ void xcd_barrier(const XcdBarrier& b) {
    asm volatile("s_waitcnt vmcnt(0)" ::: "memory");
    __syncthreads();
    if (threadIdx.x == 0) {
        unsigned* bar = b.bar;
        __builtin_amdgcn_s_waitcnt(0);
        unsigned nloc = b.st[0], nx = b.st[1];
        if (nloc == 0u) { xcd_barrier_complete(bar, b.x, nloc, nx); b.st[0] = nloc; b.st[1] = nx; }
        const unsigned old = xb_add(&bar[XB_XSUB(b.x)], 1u);
        const unsigned gen = old / nloc;
        if (old + 1u == (gen + 1u) * nloc) {
            __builtin_amdgcn_fence(__ATOMIC_RELEASE, "agent");
            asm volatile("s_waitcnt vmcnt(0)" ::: "memory");
            const unsigned og = xb_add(&bar[XB_TOP], 1u);
            const unsigned tg = og / nx;
            if (og + 1u == (tg + 1u) * nx) xb_add(&bar[XB_TOPGEN], 1u);
            else XB_SPIN(xb_ld(&bar[XB_TOPGEN]) == tg, bar);
            __builtin_amdgcn_fence(__ATOMIC_ACQUIRE, "agent");
            xb_add(&bar[XB_XGEN(b.x)], 1u);
            asm volatile("s_waitcnt vmcnt(0)" ::: "memory");
        } else {
            XB_SPIN(xb_ld(&bar[XB_XGEN(b.x)]) == gen, bar);
            __builtin_amdgcn_fence(__ATOMIC_ACQUIRE, "agent");
            asm volatile("s_waitcnt vmcnt(0)" ::: "memory");
        }
    }
    __syncthreads();
}


template <int PH>
DEVI void run_phase(const Params& p, char* smem, int bid, int nb) {
  if (PH == 0) phase0(p, smem, bid, nb);
  if (PH == 1) phase1(p, smem, bid, nb);
  if (PH == 2) phase2(p, smem, bid, nb);
  if (PH == 3) phase3(p, smem, bid, nb);
  if (PH == 4) phase3b(p, bid, nb);
  if (PH == 5) phaseM(p, smem, bid, nb);
  if (PH == 6) phase3a(p, smem, bid, nb);
  if (PH == 7) phase3c(p, smem, bid, nb);
  if (PH == 8) phase5(p, smem, bid, nb);
  if (PH == 9) phase6x(p, smem, bid, nb);
  if (PH == 10) phase6(p, smem, bid, nb);
  if (PH == 11) phase6b(p, bid, nb);
  if (PH == 12) phase7(p, smem, bid, nb);
  if (PH == 13) phase8(p, bid, nb);
}

#ifndef REP_MASK
#define REP_MASK 0
#endif
template <int PH>
DEVI void mega_phase(const Params& p, char* smem, cg::grid_group& grid, int bid, int nb) {
  run_phase<PH>(p, smem, bid, nb);
  if ((REP_MASK >> PH) & 1) {
    grid.sync();
    run_phase<PH>(p, smem, bid, nb);
  }
}
__global__ void __launch_bounds__(512, 2) mega_kernel(Params pk) {
  const Params& p = *(const Params*)__builtin_amdgcn_kernarg_segment_ptr();
  extern __shared__ __attribute__((aligned(16))) char smem[];
  cg::grid_group grid = cg::this_grid();
  const int bid = blockIdx.x, nb = gridDim.x;
  volatile LAS unsigned* st = (volatile LAS unsigned*)(smem + SMEM_BYTES);
  if (threadIdx.x == 0) {
    st[0] = 0u;
    st[1] = 0u;
  }
  __syncthreads();
  (void)xcd_barrier_post(p.BAR, st);
#define XBAR() do { XcdBarrier xb_; xb_.bar = p.BAR; xb_.x = xb_xcc_id(); xb_.st = (volatile LAS unsigned*)(smem + SMEM_BYTES); xcd_barrier(xb_); } while (0)
  mega_phase<0>(p, smem, grid, bid, nb); grid.sync();
  mega_phase<1>(p, smem, grid, bid, nb); XBAR();
  mega_phase<2>(p, smem, grid, bid, nb); XBAR();
  mega_phase<3>(p, smem, grid, bid, nb); XBAR();
  mega_phase<4>(p, smem, grid, bid, nb); XBAR();
  mega_phase<5>(p, smem, grid, bid, nb); XBAR();
  mega_phase<6>(p, smem, grid, bid, nb); XBAR();
  mega_phase<7>(p, smem, grid, bid, nb); XBAR();
  mega_phase<8>(p, smem, grid, bid, nb); XBAR();
  mega_phase<9>(p, smem, grid, bid, nb); XBAR();
  mega_phase<10>(p, smem, grid, bid, nb); XBAR();
  mega_phase<11>(p, smem, grid, bid, nb); XBAR();
  mega_phase<12>(p, smem, grid, bid, nb); grid.sync();
  mega_phase<13>(p, smem, grid, bid, nb);
}

extern "C" void kernel_launch(void* const* d_in, const int* in_sizes, int n_in, void* d_out, int out_size, void* d_ws,
                              size_t ws_size, hipStream_t stream) {
  Params p{};
  const float** fp = (const float**)&p;
  for (int i = 0; i < 26; ++i) fp[i] = (const float*)d_in[i];
  p.out = (float*)d_out;
  char* w = (char*)d_ws;
  size_t off = 0;
  auto take = [&](size_t bytes) {
    char* r = w + off;
    off += (bytes + 255) & ~(size_t)255;
    return (bfu*)r;
  };
  p.WT_in = take((size_t)3584 * 1024 * 2);
  p.WT_out = take((size_t)1024 * 1024 * 2);
  p.WT_3 = take((size_t)4352 * 1024 * 2);
  p.WT_o = take((size_t)1024 * 1024 * 2);
  p.W2T = take((size_t)1024 * 64 * 2);
  p.A2T = take((size_t)1024 * 64 * 2);
  p.TW = take((size_t)T_TOK * 64 * 2);
  p.TA = take((size_t)T_TOK * 64 * 2);
  const size_t SLOT = (size_t)T_TOK * 1024 * 2;
  bfu* slot0 = take(SLOT);
  bfu* slots = take(6 * SLOT);
  p.H = slot0;
  p.AA = slot0;
  p.U = slots;
  p.GVT = slots + SLOT / 4;
  p.Q = slots + 2 * (SLOT / 4);
  p.K = slots + 3 * (SLOT / 4);
  p.VT = slots + 4 * (SLOT / 4);
  p.SZ = slots + 7 * (SLOT / 4);
  p.Y = slots + 9 * (SLOT / 4);
  p.R = slots;
  p.K1 = slots + 1 * (SLOT / 2);
  p.XV = slots + 2 * (SLOT / 2);
  p.XG = slots + 3 * (SLOT / 2);
  p.XR = slots + 4 * (SLOT / 2);
  p.XK = slots + 5 * (SLOT / 2);
  p.V1 = slots + 4 * (SLOT / 2);
  p.SG = slots + 5 * (SLOT / 2);
  p.EW = slots + 2 * (SLOT / 2);
  p.YS = slots + 3 * (SLOT / 2);
  p.G15 = (float*)p.TW;
  p.GT = p.WT_in;
  p.MRT = take((size_t)(SEQ / 16) * 32 * 512 * 2);
  p.COEF = (float*)take((size_t)T_TOK * 16 * 4);
  p.BAR = (unsigned*)take((size_t)XCD_BAR_WORDS * 4);
  if (off > ws_size) {
    fprintf(stderr, "workspace too small: need %zu have %zu\n", off, ws_size);
    return;
  }
  static int grid_blocks = 0;
  if (!grid_blocks) {
    int dev = 0, cus = 0, per_cu = 0;
    (void)hipGetDevice(&dev);
    (void)hipDeviceGetAttribute(&cus, hipDeviceAttributeMultiprocessorCount, dev);
    (void)hipFuncSetAttribute((const void*)mega_kernel, hipFuncAttributeMaxDynamicSharedMemorySize, SMEM_BYTES + 16);
    (void)hipOccupancyMaxActiveBlocksPerMultiprocessor(&per_cu, mega_kernel, 512, SMEM_BYTES + 16);
    grid_blocks = cus * per_cu;
  }
  (void)hipMemsetAsync(p.BAR, 0, (size_t)XCD_BAR_WORDS * 4, stream);
  void* args[] = {&p};
  hipError_t e = hipLaunchCooperativeKernel((void*)mega_kernel, dim3(grid_blocks), dim3(512), args, SMEM_BYTES + 16, stream);
  if (e != hipSuccess) fprintf(stderr, "cooperative launch failed: %s (grid %d)\n", hipGetErrorString(e), grid_blocks);
}
```

```cpp
#include <hip/hip_runtime.h>
#include <hip/hip_cooperative_groups.h>
#include <stdint.h>
#include <cstdio>
namespace cg = cooperative_groups;

#ifndef MEGA
#define MEGA 1
#endif

typedef unsigned short bfu;
using bf16x8 = __attribute__((ext_vector_type(8))) short;
using f32x4 = __attribute__((ext_vector_type(4))) float;
#define DEVI __device__ __forceinline__
#define TIDX ((int)(threadIdx.x & 255))
#define HF ((int)(threadIdx.x >> 8))

constexpr int GSTAGE_BYTES = 2 * 128 * 72 * 2;
constexpr int T_TOK = 32768;
constexpr int SEQ = 16384;
constexpr int HALF_SMEM = 2 * GSTAGE_BYTES + 4096 + 512;
constexpr int SMEM_BYTES = 2 * HALF_SMEM;
constexpr int SMEM_UNUSED_ = 0;

struct Params {
  const float *x, *ln_even, *w_in, *gm_norm, *gm_ws, *gm_b, *w_out, *ln_odd, *mu, *wr, *wk, *wv, *wg, *w0, *w1, *w2,
      *a0, *a1, *a2, *k_k, *k_a, *r_k, *lnw, *lnb, *wo, *fnorm;
  float* out;
  bfu *WT_in, *WT_out, *WT_3, *WT_o, *W2T, *A2T;
  bfu *H, *U, *GVT, *Q, *K, *VT, *SZ, *Y, *R, *K1, *V1, *SG, *EW, *AA, *YS, *TW, *TA, *GT, *MRT, *XR, *XK, *XV, *XG;
  float *G15, *COEF;
  unsigned* BAR;
};

DEVI float bf2f(unsigned b) { return __uint_as_float(b << 16); }
DEVI unsigned f2bf(float x) {
  const __bf16 h = (__bf16)x;
  return (unsigned)__builtin_bit_cast(unsigned short, h);
}
typedef __bf16 bf16x2_t __attribute__((ext_vector_type(2)));
typedef float float2_t __attribute__((ext_vector_type(2)));
DEVI unsigned pkbf(float a, float b) {
  const float2_t f = {a, b};
  const bf16x2_t h = __builtin_convertvector(f, bf16x2_t);
  return __builtin_bit_cast(unsigned, h);
}
DEVI void unpack8(uint4 v, float* f) {
  f[0] = __uint_as_float(v.x << 16); f[1] = __uint_as_float(v.x & 0xffff0000u);
  f[2] = __uint_as_float(v.y << 16); f[3] = __uint_as_float(v.y & 0xffff0000u);
  f[4] = __uint_as_float(v.z << 16); f[5] = __uint_as_float(v.z & 0xffff0000u);
  f[6] = __uint_as_float(v.w << 16); f[7] = __uint_as_float(v.w & 0xffff0000u);
}
DEVI uint4 pack8(const float* f) {
  uint4 r;
  r.x = pkbf(f[0], f[1]);
  r.y = pkbf(f[2], f[3]);
  r.z = pkbf(f[4], f[5]);
  r.w = pkbf(f[6], f[7]);
  return r;
}
DEVI void unpack4(uint2 v, float* f) {
  f[0] = __uint_as_float(v.x << 16); f[1] = __uint_as_float(v.x & 0xffff0000u);
  f[2] = __uint_as_float(v.y << 16); f[3] = __uint_as_float(v.y & 0xffff0000u);
}
DEVI uint2 pack4(const float* f) {
  uint2 r;
  r.x = pkbf(f[0], f[1]);
  r.y = pkbf(f[2], f[3]);
  return r;
}

DEVI float sigmoid_(float x) { return __builtin_amdgcn_rcpf(1.f + __expf(-x)); }
DEVI float silu_(float x) { return x * sigmoid_(x); }
DEVI float tanh_(float y) { return 1.f - 2.f * __builtin_amdgcn_rcpf(1.f + __expf(2.f * y)); }
DEVI float gelu_(float x) {
  const float y = 0.7978845608028654f * (x + 0.044715f * x * x * x);
  return x * __builtin_amdgcn_rcpf(1.f + __expf(-2.f * y));
}
DEVI float wave_sum(float v) {
#pragma unroll
  for (int o = 32; o > 0; o >>= 1) v += __shfl_xor(v, o);
  return v;
}
DEVI float wave_max(float v) {
#pragma unroll
  for (int o = 32; o > 0; o >>= 1) v = fmaxf(v, __shfl_xor(v, o));
  return v;
}
template <int CTRL>
DEVI float dppf(float x) {
  return __int_as_float(__builtin_amdgcn_update_dpp(0, __float_as_int(x), CTRL, 0xF, 0xF, true));
}
DEVI float reduce16(float x) {
  x += dppf<0xB1>(x);
  x += dppf<0x4E>(x);
  x += dppf<0x141>(x);
  x += dppf<0x140>(x);
  return x;
}

constexpr int LROW = 72;
constexpr int GSTAGE = 2 * 128 * LROW;

template <int DIST = 2, bool SW = true, class ALoad, class Epi>
DEVI void gemm_tile(char* smem, const ALoad& aload, const bfu* __restrict__ Bt, int ldb, int K, int m0, int n0,
                    const Epi& epi) {
  bfu* sbase = (bfu*)smem;
  const int tid = TIDX, lane = tid & 63, wid = tid >> 6, wr = wid >> 1, wc = wid & 1;
  const int fr = lane & 15, fq = lane >> 4;
  f32x4 acc[4][4];
#pragma unroll
  for (int i = 0; i < 4; ++i)
#pragma unroll
    for (int j = 0; j < 4; ++j) acc[i][j] = f32x4{0.f, 0.f, 0.f, 0.f};
  const int r0 = tid >> 3, kc = (tid & 7) * 8;
  const int nk = K >> 6;
  struct GRegs { typename ALoad::Raw a0, a1, a2, a3; uint4 ap, b0, b1, b2, b3; };
  GRegs g0, g1;
  const bfu* Bp = Bt + (size_t)(n0 + r0) * ldb + kc;
  const size_t ldb32 = (size_t)ldb * 32;
  constexpr int ARS = ALoad::kConsec ? 1 : 32;
  const int ar0 = ALoad::kConsec ? 4 * r0 : r0;
#define GEMM_ISSUE(R, KT)                                   \
  {                                                         \
    const int k0_ = ((KT) << 6);                            \
    R.ap = aload.loadprev(m0 + ar0, k0_ + kc);              \
    R.a0 = aload.load(m0 + ar0, k0_ + kc);                  \
    R.a1 = aload.load(m0 + ar0 + ARS, k0_ + kc);            \
    R.a2 = aload.load(m0 + ar0 + 2 * ARS, k0_ + kc);        \
    R.a3 = aload.load(m0 + ar0 + 3 * ARS, k0_ + kc);        \
    R.b0 = *(const uint4*)(Bp + k0_);                       \
    R.b1 = *(const uint4*)(Bp + ldb32 + k0_);               \
    R.b2 = *(const uint4*)(Bp + 2 * ldb32 + k0_);           \
    R.b3 = *(const uint4*)(Bp + 3 * ldb32 + k0_);           \
  }
#define GEMM_COMMIT(R, S, KT)                               \
  {                                                         \
    const int k1_ = ((KT) << 6) + kc;                       \
    bfu* A_ = sbase + (S) * GSTAGE + ar0 * LROW + kc;       \
    bfu* B_ = sbase + (S) * GSTAGE + 128 * LROW + r0 * LROW + kc;   \
    *(uint4*)(A_) = aload.finish(R.a0, R.ap, m0 + ar0, k1_);                                 \
    *(uint4*)(A_ + ARS * LROW) = aload.finish(R.a1, aload.asprev(R.a0), m0 + ar0 + ARS, k1_);          \
    *(uint4*)(A_ + 2 * ARS * LROW) = aload.finish(R.a2, aload.asprev(R.a1), m0 + ar0 + 2 * ARS, k1_);  \
    *(uint4*)(A_ + 3 * ARS * LROW) = aload.finish(R.a3, aload.asprev(R.a2), m0 + ar0 + 3 * ARS, k1_);  \
    *(uint4*)(B_) = R.b0;                                   \
    *(uint4*)(B_ + 32 * LROW) = R.b1;                       \
    *(uint4*)(B_ + 64 * LROW) = R.b2;                       \
    *(uint4*)(B_ + 96 * LROW) = R.b3;                       \
  }
#define GEMM_COMPUTE(S)                                                                          \
  {                                                                                              \
    const bfu* cA = sbase + (S) * GSTAGE;                                                        \
    const bfu* cB = cA + 128 * LROW;                                                             \
    _Pragma("unroll") for (int ks = 0; ks < 2; ++ks) {                                           \
      bf16x8 af[4], bfv[4];                                                                      \
      _Pragma("unroll") for (int i = 0; i < 4; ++i) {                                            \
        af[i] = *(const bf16x8*)(cA + (wr * 64 + i * 16 + fr) * LROW + ks * 32 + fq * 8);        \
        bfv[i] = *(const bf16x8*)(cB + (wc * 64 + i * 16 + fr) * LROW + ks * 32 + fq * 8);       \
      }                                                                                          \
      _Pragma("unroll") for (int i = 0; i < 4; ++i) _Pragma("unroll") for (int j = 0; j < 4; ++j) \
          acc[i][j] = SW ? __builtin_amdgcn_mfma_f32_16x16x32_bf16(bfv[j], af[i], acc[i][j], 0, 0, 0)     \
                         : __builtin_amdgcn_mfma_f32_16x16x32_bf16(af[i], bfv[j], acc[i][j], 0, 0, 0);    \
    }                                                                                            \
  }
  const int nkm1 = nk - 1;
  if (DIST == 2 && nk == 1) {
    GEMM_ISSUE(g0, 0);
    GEMM_COMMIT(g0, 0, 0);
    __syncthreads();
    GEMM_COMPUTE(0);
    __syncthreads();
  } else if (DIST == 2) {
    GEMM_ISSUE(g0, 0);
    GEMM_ISSUE(g1, (1 < nkm1 ? 1 : nkm1));
    GEMM_COMMIT(g0, 0, 0);
    GEMM_ISSUE(g0, (2 < nkm1 ? 2 : nkm1));
    __syncthreads();
    {
      for (int kt = 0; kt < nk; kt += 2) {
        GEMM_COMMIT(g1, 1, (kt + 1 < nkm1 ? kt + 1 : nkm1));
        GEMM_ISSUE(g1, (kt + 3 < nkm1 ? kt + 3 : nkm1));
        GEMM_COMPUTE(0);
        __syncthreads();
        GEMM_COMMIT(g0, 0, (kt + 2 < nkm1 ? kt + 2 : nkm1));
        GEMM_ISSUE(g0, (kt + 4 < nkm1 ? kt + 4 : nkm1));
        GEMM_COMPUTE(1);
        __syncthreads();
      }
    }
  } else {
    GEMM_ISSUE(g0, 0);
    GEMM_COMMIT(g0, 0, 0);
    GEMM_ISSUE(g0, (1 < nkm1 ? 1 : nkm1));
    __syncthreads();
    for (int kt = 0; kt < nk; kt += 2) {
      GEMM_COMMIT(g0, 1, (kt + 1 < nkm1 ? kt + 1 : nkm1));
      GEMM_ISSUE(g0, (kt + 2 < nkm1 ? kt + 2 : nkm1));
      GEMM_COMPUTE(0);
      __syncthreads();
      GEMM_COMMIT(g0, 0, (kt + 2 < nkm1 ? kt + 2 : nkm1));
      GEMM_ISSUE(g0, (kt + 3 < nkm1 ? kt + 3 : nkm1));
      GEMM_COMPUTE(1);
      __syncthreads();
    }
  }
#pragma unroll
  for (int i = 0; i < 4; ++i)
#pragma unroll
    for (int j = 0; j < 4; ++j) {
      if (SW) epi(m0 + wr * 64 + i * 16 + fr, n0 + wc * 64 + j * 16 + fq * 4, acc[i][j]);
      else epi(m0 + wr * 64 + i * 16 + fq * 4, n0 + wc * 64 + j * 16 + fr, acc[i][j]);
    }
}

namespace pg8 {
#define PG8_LAS __attribute__((address_space(3)))
typedef unsigned short bf16_t;
typedef short bf16x8 __attribute__((ext_vector_type(8)));
typedef float f32x4 __attribute__((ext_vector_type(4)));
typedef unsigned u32x4 __attribute__((ext_vector_type(4)));
constexpr int BM = 256, BK = 64, HALF = 128, HTB = HALF * BK * 2  , STAGE_BYTES = 8 * HTB, NXCD = 8, WGM = 8;

__host__ __device__ __forceinline__ int lds_byte(int r, int c) { const int st = (r >> 4) * 2 + (c >> 5), rr = r & 15, cc = c & 31, ob = rr * 64 + cc * 2; return st * 1024 + (ob ^ (((ob >> 9) & 1) << 5)); }
__host__ __device__ __forceinline__ void stage_rc(int b, int& R, int& C) { const int st = b / 1024, sb = b % 1024, swz = sb ^ (((sb >> 9) & 1) << 5); R = (st >> 1) * 16 + swz / 64; C = (st & 1) * 32 + (swz % 64) / 2; }
__host__ __device__ __forceinline__ int perm32(int rho) { const int n = rho >> 4, i = rho & 15; return 8 * (i >> 2) + 4 * n + (i & 3); }

struct Unit { int pm, pn; };
struct Gemm { const bf16_t* A; const bf16_t* Bt; int M, N, K; const bf16_t* A2; int pn_split; unsigned long long rmap, cmap;
  __device__ __forceinline__ size_t rt(int pm) const { return rmap ? (size_t)((rmap >> (4 * pm)) & 15ull) : (size_t)pm; }
  __device__ __forceinline__ size_t ct(int pn) const { return cmap ? (size_t)((cmap >> (4 * pn)) & 15ull) : (size_t)pn; } };

struct StaticOrder {
    int nM, nN, nwg, G, c;
    __host__ __device__ void init(int M, int N, int G_, int c_) { nM = M / BM; nN = N / BM; nwg = nM * nN; G = G_; c = c_; }
    __host__ __device__ bool next(int i, Unit& u) const {
        const long L = (long)i * G + c; if (L >= nwg) return false;
        int wgid = (int)L; { const int q = nwg / NXCD, r = nwg % NXCD, xcd = wgid % NXCD, off = wgid / NXCD; wgid = (xcd < r ? xcd * (q + 1) : r * (q + 1) + (xcd - r) * q) + off; }
        const int nig = WGM * nN, gid = wgid / nig, fm = gid * WGM, gsz = (nM - fm) < WGM ? (nM - fm) : WGM;
        u.pm = fm + ((wgid % nig) % gsz); u.pn = (wgid % nig) / gsz; return true;
    }
    __device__ __forceinline__ void a_ready(const Unit&) const {}
    __device__ __forceinline__ void done(const Unit&) const {}
};
struct CountedOrder : StaticOrder {
    const unsigned* ready; unsigned need; unsigned* tmo;
    __device__ __forceinline__ void a_ready(const Unit& u) const {
        if (threadIdx.x < 64) {
            const unsigned long long t0 = __builtin_amdgcn_s_memrealtime(); unsigned polls = 0;
            while ((unsigned)__builtin_amdgcn_readfirstlane(__hip_atomic_load(ready + 64 * u.pm, __ATOMIC_RELAXED, __HIP_MEMORY_SCOPE_AGENT)) < need) {
                if ((++polls & 255u) == 0u && __builtin_amdgcn_readfirstlane(__hip_atomic_load(tmo, __ATOMIC_RELAXED, __HIP_MEMORY_SCOPE_AGENT)) != 0u) break;
                if (__builtin_amdgcn_s_memrealtime() - t0 > 2000000ull) {
                    if (threadIdx.x == 0) { unsigned expect = 0u; __hip_atomic_compare_exchange_strong(tmo + 1, &expect, 0x600u | (unsigned)(u.pm & 0xff), __ATOMIC_RELAXED, __ATOMIC_RELAXED, __HIP_MEMORY_SCOPE_AGENT); __hip_atomic_store(tmo, 1u, __ATOMIC_RELAXED, __HIP_MEMORY_SCOPE_AGENT); }
                    break; }
                __builtin_amdgcn_s_sleep(2); }
            __builtin_amdgcn_fence(__ATOMIC_ACQUIRE, "agent");
            asm volatile("s_waitcnt vmcnt(0)" ::: "memory");
        }
#if !defined(BROKEN_HOOK_NO_BARRIER)
        asm volatile("" ::: "memory"); __builtin_amdgcn_s_barrier(); asm volatile("" ::: "memory");
#endif
    }
};

__device__ __forceinline__ unsigned cvt_pk_bf16(float lo, float hi) { unsigned r; asm volatile("v_cvt_pk_bf16_f32 %0, %1, %2" : "=v"(r) : "v"(lo), "v"(hi)); return r; }
typedef float f32x2 __attribute__((ext_vector_type(2)));
__device__ __forceinline__ f32x2 gelu_pk(f32x2 v) {
    const f32x2 av = __builtin_elementwise_abs(v), d = av * 0.2316418882f + 1.0f;
    f32x2 t; t.x = __builtin_amdgcn_rcpf(d.x); t.y = __builtin_amdgcn_rcpf(d.y);
    f32x2 q = t * 0.5307027145f + (-0.7265760135f); q = q * t + 0.7107068705f; q = q * t + (-0.142248368f); q = q * t + 0.127414796f; q = q * t;
    const f32x2 s = (v * v) * (-0.72134752044f);
    f32x2 e; e.x = __builtin_amdgcn_exp2f(s.x); e.y = __builtin_amdgcn_exp2f(s.y);
    const f32x2 m = v * (q * e), r = v - m;
    f32x2 o; o.x = v.x < 0.f ? m.x : r.x; o.y = v.y < 0.f ? m.y : r.y; return o;
}

struct EpiF32 {
    static constexpr bool PERM = false, AFTER_DRAIN = false;
    float* C; int ldc; const float* bias;
    __device__ __forceinline__ void operator()(const f32x4 (&acc)[2][2][4][2], const Unit& u, int wr, int wc, int fr, int fq) const {
        const int row0 = u.pm * BM + wr * 64 + fr, col0 = u.pn * BM + wc * 32 + 4 * fq;
        f32x4 bv[2][2];
#pragma unroll
        for (int bj = 0; bj < 2; ++bj)
#pragma unroll
            for (int n = 0; n < 2; ++n) bv[bj][n] = bias ? *(const f32x4*)(bias + col0 + bj * HALF + n * 16) : (f32x4){0.f, 0.f, 0.f, 0.f};
#pragma unroll
        for (int ai = 0; ai < 2; ++ai)
#pragma unroll
            for (int m = 0; m < 4; ++m) { float* rowp = C + (size_t)(row0 + ai * HALF + m * 16) * ldc + col0;
#pragma unroll
                for (int bj = 0; bj < 2; ++bj)
#pragma unroll
                    for (int n = 0; n < 2; ++n) *(f32x4*)(rowp + bj * HALF + n * 16) = acc[ai][bj][m][n] + bv[bj][n]; }
    }
};
template <int ACT  > struct EpiBf16 {
    static constexpr bool PERM = true, AFTER_DRAIN = false;
    bf16_t* O; int ldc; const float* bias; int split_cols; size_t split_stride;
    __device__ __forceinline__ void operator()(const f32x4 (&acc)[2][2][4][2], const Unit& u, int wr, int wc, int fr, int fq) const {
        const int row0 = u.pm * BM + wr * 64 + fr; int colt = u.pn * BM; bf16_t* base = O;
        if (split_cols) { const int t = colt / split_cols; base += (size_t)t * split_stride; colt -= t * split_cols; }
        const int col0 = colt + wc * 32 + 8 * fq, bcol0 = u.pn * BM + wc * 32 + 8 * fq;
        f32x4 bv[2][2];
#pragma unroll
        for (int bj = 0; bj < 2; ++bj)
#pragma unroll
            for (int n = 0; n < 2; ++n) bv[bj][n] = bias ? *(const f32x4*)(bias + bcol0 + bj * HALF + 4 * n) : (f32x4){0.f, 0.f, 0.f, 0.f};
#pragma unroll
        for (int ai = 0; ai < 2; ++ai)
#pragma unroll
            for (int m = 0; m < 4; ++m) { bf16_t* rowp = base + (size_t)(row0 + ai * HALF + m * 16) * ldc + col0;
#pragma unroll
                for (int bj = 0; bj < 2; ++bj) { f32x4 v0 = acc[ai][bj][m][0] + bv[bj][0], v1 = acc[ai][bj][m][1] + bv[bj][1];
                    if (ACT == 1) { f32x2 a = gelu_pk((f32x2){v0[0], v0[1]}), b = gelu_pk((f32x2){v0[2], v0[3]}), c = gelu_pk((f32x2){v1[0], v1[1]}), d = gelu_pk((f32x2){v1[2], v1[3]});
                        v0 = (f32x4){a.x, a.y, b.x, b.y}; v1 = (f32x4){c.x, c.y, d.x, d.y}; }
                    if (ACT == 2) {
#pragma unroll
                        for (int j = 0; j < 4; ++j) { v0[j] = 0.5f * v0[j] * (1.0f + erff(v0[j] * 0.70710678f)); v1[j] = 0.5f * v1[j] * (1.0f + erff(v1[j] * 0.70710678f)); } }
                    u32x4 w; w.x = cvt_pk_bf16(v0[0], v0[1]); w.y = cvt_pk_bf16(v0[2], v0[3]); w.z = cvt_pk_bf16(v1[0], v1[1]); w.w = cvt_pk_bf16(v1[2], v1[3]);
                    *(u32x4*)(rowp + bj * HALF) = w; } }
    }
};


template <class Epi, class Sched, bool STAMP = false>
__device__ __forceinline__ void gemm_phase(PG8_LAS unsigned char* lds, const Gemm g, const Sched& S, const Epi& E, unsigned long long* stamps) {
    const int tid = threadIdx.x, wid = __builtin_amdgcn_readfirstlane(tid >> 6), lane = tid & 63, wr = wid >> 2, wc = wid & 3, fr = lane & 15, fq = lane >> 4;
    const int K = g.K, nt = K / BK;
    int ts_lo = 0, ts_hi = 0, nts = 0; const unsigned long long rt_entry = STAMP ? (unsigned long long)wall_clock64() : 0ull;
#define PG8_STAMP() do { if (STAMP && wid == 0 && nts < 64) { const unsigned long long _c = (unsigned long long)clock64(); \
        ts_lo = (lane == nts) ? (int)(unsigned)_c : ts_lo; ts_hi = (lane == nts) ? (int)(unsigned)(_c >> 32) : ts_hi; ++nts; } } while (0)
    PG8_STAMP();
    unsigned voffA[2], voffB[2];
#pragma unroll
    for (int i = 0; i < 2; ++i) { int R, C; stage_rc(tid * 16 + i * 8192, R, C); const int Rb = Epi::PERM ? ((R & ~31) + perm32(R & 31)) : R;
        voffA[i] = (unsigned)(R * K + C) * 2u; voffB[i] = (unsigned)(Rb * K + C) * 2u; }
    const size_t kstep = (size_t)(BK * 2);
    const size_t hstep = (size_t)HALF * K * 2;
    const size_t tstep = 2 * hstep;
    const unsigned ldsw = (unsigned)wid * 1024u;
    const int aoff = lds_byte(wr * 64 + fr, fq * 8), boff = lds_byte(wc * 32 + fr, fq * 8);
#define PG8_SA(b, h) (((b) * 2 + (h)) * HTB)
#define PG8_SB(b, h) ((4 + (b) * 2 + (h)) * HTB)
#define PG8_STAGE(bufoff, gbase, voff) do { _Pragma("unroll") for (int _i = 0; _i < 2; ++_i) \
        __builtin_amdgcn_global_load_lds((const unsigned*)((const char*)(gbase) + (voff)[_i]), (PG8_LAS unsigned*)(lds + (bufoff) + ldsw + _i * 8192), 16, 0, 0); } while (0)
#define PG8_LDA(dst, b, h) do { _Pragma("unroll") for (int m = 0; m < 4; ++m) _Pragma("unroll") for (int k = 0; k < 2; ++k) dst[m][k] = *(const PG8_LAS bf16x8*)(lds + PG8_SA(b, h) + aoff + m * 2048 + k * 1024); } while (0)
#define PG8_LDB(dst, b, h) do { _Pragma("unroll") for (int n = 0; n < 2; ++n) _Pragma("unroll") for (int k = 0; k < 2; ++k) dst[n][k] = *(const PG8_LAS bf16x8*)(lds + PG8_SB(b, h) + boff + n * 2048 + k * 1024); } while (0)
#define PG8_MMA(ai, bj, At, Bt) do { __builtin_amdgcn_s_setprio(1); _Pragma("unroll") for (int m = 0; m < 4; ++m) _Pragma("unroll") for (int n = 0; n < 2; ++n) _Pragma("unroll") for (int k = 0; k < 2; ++k) \
        acc[ai][bj][m][n] = __builtin_amdgcn_mfma_f32_16x16x32_bf16(Bt[n][k], At[m][k], acc[ai][bj][m][n], 0, 0, 0); __builtin_amdgcn_s_setprio(0); } while (0)
#define PG8_WAIT_V(n) asm volatile("s_waitcnt vmcnt(" #n ")" ::: "memory")
#define PG8_WAIT_L(n) asm volatile("s_waitcnt lgkmcnt(" #n ")" ::: "memory")
#define PG8_BAR __builtin_amdgcn_s_barrier()
#define PG8_SCHED __builtin_amdgcn_sched_barrier(0)
    Unit cur, nxt; int ui = 0;
    if (!S.next(0, cur)) return;
    f32x4 acc[2][2][4][2];
#pragma unroll
    for (int a = 0; a < 2; ++a)
#pragma unroll
        for (int b = 0; b < 2; ++b)
#pragma unroll
            for (int m = 0; m < 4; ++m)
#pragma unroll
                for (int n = 0; n < 2; ++n) acc[a][b][m][n] = (f32x4){0.f, 0.f, 0.f, 0.f};
    bf16x8 At[4][2], B0[2][2], B1[2][2];
    const char* cA = (const char*)(cur.pn >= g.pn_split ? g.A2 : g.A) + g.rt(cur.pm) * tstep; const char* cB = (const char*)g.Bt + g.ct(cur.pn) * tstep;
    S.a_ready(cur);
    PG8_STAGE(PG8_SB(0, 0), cB, voffB); PG8_STAGE(PG8_SA(0, 0), cA, voffA); PG8_STAGE(PG8_SB(0, 1), cB + hstep, voffB); PG8_STAGE(PG8_SA(0, 1), cA + hstep, voffA);
    if (wr == 1) PG8_BAR;
    PG8_WAIT_V(4); PG8_BAR;
    PG8_STAGE(PG8_SB(1, 0), cB + kstep, voffB); PG8_STAGE(PG8_SA(1, 0), cA + kstep, voffA); PG8_STAGE(PG8_SB(1, 1), cB + hstep + kstep, voffB);
    PG8_WAIT_V(6); PG8_BAR;
    PG8_STAMP();
    for (;;) {
        const bool has_next = S.next(ui + 1, nxt);
        const char* nA = has_next ? (const char*)(nxt.pn >= g.pn_split ? g.A2 : g.A) + g.rt(nxt.pm) * tstep : cA; const char* nB = has_next ? (const char*)g.Bt + g.ct(nxt.pn) * tstep : cB;
        for (int t = 0; t < nt; t += 2) {
            const bool last = (t == nt - 2);
            const char* a1 = cA + (size_t)(t + 1) * kstep;
            const char* a2 = last ? nA : cA + (size_t)(t + 2) * kstep; const char* b2 = last ? nB : cB + (size_t)(t + 2) * kstep;
            const char* a3 = a2 + kstep; const char* b3 = b2 + kstep;
            if (last && has_next) S.a_ready(nxt);
            PG8_LDB(B0, 0, 0); PG8_SCHED; PG8_LDA(At, 0, 0); PG8_STAGE(PG8_SA(1, 1), a1 + hstep, voffA);
            PG8_WAIT_L(8); PG8_BAR; PG8_WAIT_L(0); PG8_MMA(0, 0, At, B0); PG8_BAR; PG8_SCHED;
            PG8_LDB(B1, 0, 1); PG8_STAGE(PG8_SB(0, 0), b2, voffB);
            PG8_BAR; PG8_WAIT_L(0); PG8_MMA(0, 1, At, B1); PG8_BAR;
            PG8_LDA(At, 0, 1); PG8_STAGE(PG8_SA(0, 0), a2, voffA);
            PG8_BAR; PG8_WAIT_L(0); PG8_MMA(1, 0, At, B0); PG8_BAR; PG8_SCHED;
            PG8_STAGE(PG8_SB(0, 1), b2 + hstep, voffB);
            PG8_WAIT_V(6); PG8_BAR; PG8_MMA(1, 1, At, B1); PG8_BAR;
            PG8_LDB(B0, 1, 0); PG8_SCHED; PG8_LDA(At, 1, 0); PG8_STAGE(PG8_SA(0, 1), a2 + hstep, voffA);
            PG8_WAIT_L(8); PG8_BAR; PG8_WAIT_L(0); PG8_MMA(0, 0, At, B0); PG8_BAR; PG8_SCHED;
            PG8_LDB(B1, 1, 1); PG8_STAGE(PG8_SB(1, 0), b3, voffB);
            PG8_BAR; PG8_WAIT_L(0); PG8_MMA(0, 1, At, B1); PG8_BAR;
            PG8_LDA(At, 1, 1); PG8_STAGE(PG8_SA(1, 0), a3, voffA);
            PG8_BAR; PG8_WAIT_L(0); PG8_MMA(1, 0, At, B0); PG8_BAR; PG8_SCHED;
            PG8_STAGE(PG8_SB(1, 1), b3 + hstep, voffB);
            PG8_WAIT_V(6); PG8_BAR; PG8_MMA(1, 1, At, B1); PG8_BAR;
        }
        PG8_STAMP();
        if constexpr (!Epi::AFTER_DRAIN) { E(acc, cur, wr, wc, fr, fq); S.done(cur); }
        PG8_STAMP();
        if (!has_next) break;
#pragma unroll
        for (int a = 0; a < 2; ++a)
#pragma unroll
            for (int b = 0; b < 2; ++b)
#pragma unroll
                for (int m = 0; m < 4; ++m)
#pragma unroll
                    for (int n = 0; n < 2; ++n) acc[a][b][m][n] = (f32x4){0.f, 0.f, 0.f, 0.f};
        cur = nxt; cA = nA; cB = nB; ++ui;
    }
    PG8_WAIT_V(0);
    if (wr == 0) PG8_BAR;
    PG8_BAR;
    if constexpr (Epi::AFTER_DRAIN) { E.fused(acc, cur, wr, wc, fr, fq, lds, wid, lane); S.done(cur); }
    PG8_STAMP();
    if (STAMP && wid == 0) { stamps[lane] = lane < nts ? (((unsigned long long)(unsigned)ts_hi << 32) | (unsigned)ts_lo) : 0ull;
        if (lane == 62) stamps[62] = rt_entry; if (lane == 63) stamps[63] = (unsigned long long)wall_clock64(); }
#undef PG8_STAMP
#undef PG8_SA
#undef PG8_SB
#undef PG8_STAGE
#undef PG8_LDA
#undef PG8_LDB
#undef PG8_MMA
#undef PG8_WAIT_V
#undef PG8_WAIT_L
#undef PG8_BAR
#undef PG8_SCHED
}
}

struct TileSched {
  int xcd, local, vbid, vnb, MT, NT, SM, SN, j, snc;
  bool swz;
  DEVI TileSched(int bid, int nb, int half, int MT_, int NT_, int SM_, int SN_) : MT(MT_), NT(NT_), SM(SM_), SN(SN_), j(0) {
    xcd = bid & 7;
    local = (bid >> 3) * 2 + half;
    vbid = bid * 2 + half;
    vnb = nb * 2;
    swz = (vnb == 8 * SM * SN) && ((nb & 7) == 0);
    snc = (NT + SN - 1) / SN;
  }
  DEVI int next(int& mt, int& nt) {
    if (swz) {
      const int s = j * 8 + xcd;
      ++j;
      const int sm = s / snc, sn = s - sm * snc;
      if (sm * SM >= MT) return 0;
      mt = sm * SM + local / SN;
      nt = sn * SN + local % SN;
      return (mt < MT && nt < NT) ? 1 : 2;
    } else {
      const int it = vbid + j * vnb;
      ++j;
      if (it >= MT * NT) return 0;
      mt = it / NT;
      nt = it - mt * NT;
      return 1;
    }
  }
};

struct ALoadPlain {
  typedef uint4 Raw;
  static constexpr bool kFat = false;
  static constexpr bool kConsec = false;
  const bfu* A;
  int lda;
  DEVI Raw load(int row, int k) const { return *(const uint4*)(A + (size_t)row * lda + k); }
  DEVI uint4 loadprev(int, int) const { return uint4{0u, 0u, 0u, 0u}; }
  DEVI uint4 asprev(const Raw&) const { return uint4{0u, 0u, 0u, 0u}; }
  DEVI uint4 finish(const Raw& r, const uint4&, int, int) const { return r; }
};

DEVI void transpose_tile(char* smem, const float* __restrict__ src, int Ns, bfu* __restrict__ dst, int ldd, int noff,
                         int k0, int n0) {
  float(*tile)[65] = (float(*)[65])smem;
  const int tid = TIDX;
  const int kr = tid >> 4, nc = (tid & 15) * 4;
#pragma unroll
  for (int p = 0; p < 4; ++p) {
    float4 v = *(const float4*)(src + (size_t)(k0 + kr + 16 * p) * Ns + n0 + nc);
    tile[kr + 16 * p][nc] = v.x;
    tile[kr + 16 * p][nc + 1] = v.y;
    tile[kr + 16 * p][nc + 2] = v.z;
    tile[kr + 16 * p][nc + 3] = v.w;
  }
  __syncthreads();
  const int nr = tid >> 3, kc = (tid & 7) * 8;
#pragma unroll
  for (int p = 0; p < 2; ++p) {
    const int n = nr + 32 * p;
    float f[8];
#pragma unroll
    for (int j = 0; j < 8; ++j) f[j] = tile[kc + j][n];
    *(uint4*)(dst + (size_t)(noff + n0 + n) * ldd + k0 + kc) = pack8(f);
  }
  __syncthreads();
}

DEVI void rms_row2_bf16(const float* __restrict__ src, const float* __restrict__ g, bfu* __restrict__ dst, int lane) {
  float4 v[2][4];
  float ss[2] = {0.f, 0.f};
#pragma unroll
  for (int r = 0; r < 2; ++r)
#pragma unroll
    for (int i = 0; i < 4; ++i) v[r][i] = *(const float4*)(src + r * 1024 + lane * 4 + 256 * i);
#pragma unroll
  for (int r = 0; r < 2; ++r)
#pragma unroll
    for (int i = 0; i < 4; ++i)
      ss[r] += v[r][i].x * v[r][i].x + v[r][i].y * v[r][i].y + v[r][i].z * v[r][i].z + v[r][i].w * v[r][i].w;
#pragma unroll
  for (int r = 0; r < 2; ++r) {
    const float rinv = rsqrtf(wave_sum(ss[r]) * (1.f / 1024.f) + 1e-6f);
#pragma unroll
    for (int i = 0; i < 4; ++i) {
      const float4 gg = *(const float4*)(g + lane * 4 + 256 * i);
      uint2 o;
      o.x = pkbf(v[r][i].x * rinv * gg.x, v[r][i].y * rinv * gg.y);
      o.y = pkbf(v[r][i].z * rinv * gg.z, v[r][i].w * rinv * gg.w);
      *(uint2*)(dst + r * 1024 + lane * 4 + 256 * i) = o;
    }
  }
}

DEVI void phase0(const Params& p, char* smem, int bid, int nb) {
  constexpr int NT_IN = 16 * 56, NT_SQ = 256, NT_SM = 16;
  constexpr int c0 = NT_IN, c1 = c0 + NT_SQ, c2 = c1 + 4 * NT_SQ, c3 = c2 + NT_SM, c4 = c3 + NT_SM, c5 = c4 + NT_SQ,
                c6 = c5 + NT_SM, c7 = c6 + NT_SM, c8 = c7 + 2, c9 = c8 + T_TOK / 8;
  smem += HF * HALF_SMEM;
  for (int it = bid * 2 + HF; it < c9; it += nb * 2) {
    if (it < c0) {
      transpose_tile(smem, p.w_in, 3584, p.WT_in, 1024, 0, (it / 56) * 64, (it % 56) * 64);
    } else if (it < c1) {
      int j = it - c0;
      transpose_tile(smem, p.w_out, 1024, p.WT_out, 1024, 0, (j >> 4) * 64, (j & 15) * 64);
    } else if (it < c2) {
      int j = it - c1;
      int w = j >> 8;
      j &= 255;
      const float* src = (w == 0) ? p.wr : (w == 1) ? p.wk : (w == 2) ? p.wv : p.wg;
      transpose_tile(smem, src, 1024, p.WT_3, 1024, w * 1024, (j >> 4) * 64, (j & 15) * 64);
    } else if (it < c3) {
      int j = it - c2;
      transpose_tile(smem, p.w1, 64, p.WT_3, 1024, 4096, j * 64, 0);
    } else if (it < c4) {
      int j = it - c3;
      transpose_tile(smem, p.a1, 64, p.WT_3, 1024, 4224, j * 64, 0);
    } else if (it < c5) {
      int j = it - c4;
      transpose_tile(smem, p.wo, 1024, p.WT_o, 1024, 0, (j >> 4) * 64, (j & 15) * 64);
    } else if (it < c6) {
      int j = it - c5;
      transpose_tile(smem, p.w2, 1024, p.W2T, 64, 0, 0, j * 64);
    } else if (it < c7) {
      int j = it - c6;
      transpose_tile(smem, p.a2, 1024, p.A2T, 64, 0, 0, j * 64);
    } else if (it < c8) {
      int j = it - c7;
      bfu* dst = p.WT_3 + (size_t)(j == 0 ? 4160 : 4288) * 1024;
      for (int e = TIDX; e < 64 * 1024 / 8; e += 256) *(uint4*)(dst + e * 8) = uint4{0, 0, 0, 0};
    } else {
      int row = (it - c8) * 8 + (TIDX >> 6) * 2;
      rms_row2_bf16(p.x + (size_t)row * 1024, p.ln_even, p.H + (size_t)row * 1024, TIDX & 63);
    }
  }
}

constexpr unsigned long long kCmap1 = 0xDCBA765410ull;
struct PgEpi1 {
  static constexpr bool PERM = true, AFTER_DRAIN = false;
  const Params* p;
  DEVI void operator()(const pg8::f32x4 (&acc)[2][2][4][2], const pg8::Unit& u, int wr, int wc, int fr, int fq) const {
    const int row0 = u.pm * 256 + wr * 64 + fr;
    const int seg = (int)((kCmap1 >> (4 * u.pn)) & 15ull);
#pragma unroll
    for (int ai = 0; ai < 2; ++ai)
#pragma unroll
      for (int m = 0; m < 4; ++m) {
        const int row = row0 + ai * 128 + m * 16;
#pragma unroll
        for (int bj = 0; bj < 2; ++bj) {
          const int col = seg * 256 + bj * 128 + wc * 32 + 8 * fq;
          const f32x4 v0 = acc[ai][bj][m][0], v1 = acc[ai][bj][m][1];
          uint4 w;
          if (seg < 2) {
            w.x = pkbf(gelu_(v0[0]), gelu_(v0[1])); w.y = pkbf(gelu_(v0[2]), gelu_(v0[3]));
            w.z = pkbf(gelu_(v1[0]), gelu_(v1[1])); w.w = pkbf(gelu_(v1[2]), gelu_(v1[3]));
            *(uint4*)(p->U + (size_t)row * 512 + col) = w;
          } else if (seg < 8) {
            w.x = pkbf(v0[0], v0[1]); w.y = pkbf(v0[2], v0[3]); w.z = pkbf(v1[0], v1[1]); w.w = pkbf(v1[2], v1[3]);
            bfu* dst = (seg < 6) ? p->Q + (size_t)row * 512 + (col - 1024) : p->K + (size_t)row * 512 + (col - 1536);
            *(uint4*)dst = w;
          } else {
            w.x = pkbf(silu_(v0[0]), silu_(v0[1])); w.y = pkbf(silu_(v0[2]), silu_(v0[3]));
            w.z = pkbf(silu_(v1[0]), silu_(v1[1])); w.w = pkbf(silu_(v1[2]), silu_(v1[3]));
            *(uint4*)(p->SZ + (size_t)row * 1024 + (col - 2560)) = w;
          }
        }
      }
  }
};
constexpr unsigned long long kRmap1 = 0x9832ull;
struct PgEpi1T {
  static constexpr bool PERM = true, AFTER_DRAIN = false;
  const Params* p;
  DEVI void operator()(const pg8::f32x4 (&acc)[2][2][4][2], const pg8::Unit& u, int wr, int wc, int fr, int fq) const {
    const int ch0 = (u.pm & 1) * 256 + wr * 64 + fr;
    const bool isv = u.pm >= 2;
#pragma unroll
    for (int ai = 0; ai < 2; ++ai)
#pragma unroll
      for (int m = 0; m < 4; ++m) {
        const int ch = ch0 + ai * 128 + m * 16;
#pragma unroll
        for (int bj = 0; bj < 2; ++bj) {
          const int t = u.pn * 256 + bj * 128 + wc * 32 + 8 * fq;
          const f32x4 v0 = acc[ai][bj][m][0], v1 = acc[ai][bj][m][1];
          if (!isv) {
            const int g = ch >> 7, c = ch & 127;
            uint4 w;
            w.x = pkbf(gelu_(v0[0]), gelu_(v0[1])); w.y = pkbf(gelu_(v0[2]), gelu_(v0[3]));
            w.z = pkbf(gelu_(v1[0]), gelu_(v1[1])); w.w = pkbf(gelu_(v1[2]), gelu_(v1[3]));
            *(uint4*)(p->GVT + ((size_t)(((t >> 7) * 4 + g) * 128 + c)) * 128 + (t & 127)) = w;
          } else {
            const int hh = ch >> 6, dim = ch & 63;
            const int b = t >> 14, s = t & (SEQ - 1);
            bfu* base = p->VT + ((size_t)((b * 8 + hh) * 64 + dim)) * SEQ;
            const size_t PST = (size_t)16 * 64 * SEQ;
            uint4 w;
            w.x = pkbf(v0[0], v0[1]); w.y = pkbf(v0[2], v0[3]); w.z = pkbf(v1[0], v1[1]); w.w = pkbf(v1[2], v1[3]);
            *(uint4*)(base + s) = w;
            bfu* b1 = base + PST + (s >> 2);
#pragma unroll
            for (int e = 0; e < 4; ++e) *(unsigned*)(b1 + (size_t)e * (SEQ / 4)) = pkbf(v0[e], v1[e]);
            bfu* b2 = base + 2 * PST + (size_t)(s & 15) * (SEQ / 16) + (s >> 4);
#pragma unroll
            for (int e = 0; e < 4; ++e) {
              b2[(size_t)e * (SEQ / 16)] = (bfu)f2bf(v0[e]);
              b2[(size_t)(e + 4) * (SEQ / 16)] = (bfu)f2bf(v1[e]);
            }
          }
        }
      }
  }
};
struct PgEpiRes {
  static constexpr bool PERM = false, AFTER_DRAIN = false;
  const float* base;
  float* out;
  DEVI void operator()(const pg8::f32x4 (&acc)[2][2][4][2], const pg8::Unit& u, int wr, int wc, int fr, int fq) const {
    const int row0 = u.pm * 256 + wr * 64 + fr, col0 = u.pn * 256 + wc * 32 + 4 * fq;
#pragma unroll
    for (int ai = 0; ai < 2; ++ai)
#pragma unroll
      for (int m = 0; m < 4; ++m) {
        const size_t rb = (size_t)(row0 + ai * 128 + m * 16) * 1024 + col0;
#pragma unroll
        for (int bj = 0; bj < 2; ++bj)
#pragma unroll
          for (int n = 0; n < 2; ++n) {
            const size_t idx = rb + bj * 128 + n * 16;
            const f32x4 b = *(const f32x4*)(base + idx);
            *(f32x4*)(out + idx) = acc[ai][bj][m][n] + b;
          }
      }
  }
};
template <class Epi>
DEVI void pg_gemm(char* smem, const bfu* A, const bfu* Bt, int M, int N, int K, const Epi& E, int bid, int nb) {
  pg8::Gemm g{A, Bt, M, N, K, A, 1 << 30, 0ull, 0ull};
  pg8::StaticOrder S;
  S.init(M, N, nb, bid);
  pg8::gemm_phase<Epi, pg8::StaticOrder, false>((PG8_LAS unsigned char*)smem, g, S, E, nullptr);
}
template <class Epi>
DEVI void pg_gemm2(char* smem, const bfu* A, const bfu* A2, int pn_split, const bfu* Bt, int M, int N, int K, const Epi& E,
                   int bid, int nb) {
  pg8::Gemm g{A, Bt, M, N, K, A2, pn_split, 0ull, 0ull};
  pg8::StaticOrder S;
  S.init(M, N, nb, bid);
  pg8::gemm_phase<Epi, pg8::StaticOrder, false>((PG8_LAS unsigned char*)smem, g, S, E, nullptr);
}
struct PgEpi3 {
  static constexpr bool PERM = true, AFTER_DRAIN = false;
  bfu* O0;
  bfu* O1;
  int silu1;
  DEVI void operator()(const pg8::f32x4 (&acc)[2][2][4][2], const pg8::Unit& u, int wr, int wc, int fr, int fq) const {
    const int row0 = u.pm * 256 + wr * 64 + fr;
    const int grp = u.pn >> 2;
    bfu* O = grp ? O1 : O0;
    const bool act = grp && silu1;
    const int colb = (u.pn & 3) * 256 + wc * 32 + 8 * fq;
#pragma unroll
    for (int ai = 0; ai < 2; ++ai)
#pragma unroll
      for (int m = 0; m < 4; ++m) {
        bfu* rowp = O + (size_t)(row0 + ai * 128 + m * 16) * 1024 + colb;
#pragma unroll
        for (int bj = 0; bj < 2; ++bj) {
          f32x4 v0 = acc[ai][bj][m][0], v1 = acc[ai][bj][m][1];
          if (act) {
#pragma unroll
            for (int e = 0; e < 4; ++e) {
              v0[e] = silu_(v0[e]);
              v1[e] = silu_(v1[e]);
            }
          }
          uint4 w;
          w.x = pkbf(v0[0], v0[1]); w.y = pkbf(v0[2], v0[3]); w.z = pkbf(v1[0], v1[1]); w.w = pkbf(v1[2], v1[3]);
          *(uint4*)(rowp + bj * 128) = w;
        }
      }
  }
};

DEVI void phase1(const Params& p, char* smem, int bid, int nb) {
  {
    PgEpi1 E{&p};
    pg8::Gemm g{p.H, p.WT_in, T_TOK, 2560, 1024, p.H, 1 << 30, 0ull, kCmap1};
    pg8::StaticOrder S;
    S.init(T_TOK, 2560, nb, bid);
    pg8::gemm_phase<PgEpi1, pg8::StaticOrder, false>((PG8_LAS unsigned char*)smem, g, S, E, nullptr);
  }
  {
    PgEpi1T E{&p};
    pg8::Gemm g{p.WT_in, p.H, 1024, T_TOK, 1024, p.WT_in, 1 << 30, kRmap1, 0ull};
    pg8::StaticOrder S;
    S.init(1024, T_TOK, nb, bid);
    pg8::gemm_phase<PgEpi1T, pg8::StaticOrder, false>((PG8_LAS unsigned char*)smem, g, S, E, nullptr);
  }
}

struct ALoadWs {
  struct Raw { float4 a, b; };
  static constexpr bool kFat = true;
  static constexpr bool kConsec = false;
  const float* ws;
  const float* rinv;
  DEVI Raw load(int t, int s0) const {
    Raw r;
    r.a = *(const float4*)(ws + t * 128 + s0);
    r.b = *(const float4*)(ws + t * 128 + s0 + 4);
    return r;
  }
  DEVI uint4 loadprev(int, int) const { return uint4{0u, 0u, 0u, 0u}; }
  DEVI uint4 asprev(const Raw&) const { return uint4{0u, 0u, 0u, 0u}; }
  DEVI uint4 finish(const Raw& r, const uint4&, int t, int s0) const {
    float f[8] = {r.a.x, r.a.y, r.a.z, r.a.w, r.b.x, r.b.y, r.b.z, r.b.w};
#pragma unroll
    for (int j = 0; j < 8; ++j) f[j] = (s0 + j <= t) ? f[j] * rinv[s0 + j] : 0.f;
    return pack8(f);
  }
};
struct EpiGm {
  const Params* p;
  int chunk, g;
  DEVI void operator()(int t, int c, f32x4 v) const {
    const float4 gn = *(const float4*)(p->gm_norm + g * 128 + c);
    const float bias = p->gm_b[g * 128 + t];
    const size_t tok = (size_t)chunk * 128 + t;
    float u[4], sz[4];
    unpack4(*(const uint2*)(p->U + tok * 512 + g * 128 + c), u);
    unpack4(*(const uint2*)(p->SZ + tok * 1024 + g * 128 + c), sz);
    uint2 o;
    o.x = pkbf(u[0] * (v[0] * gn.x + bias) * sz[0], u[1] * (v[1] * gn.y + bias) * sz[1]);
    o.y = pkbf(u[2] * (v[2] * gn.z + bias) * sz[2], u[3] * (v[3] * gn.w + bias) * sz[3]);
    *(uint2*)(p->Y + tok * 1024 + g * 128 + c) = o;
  }
};

DEVI void gmlp_item(const Params& p, char* smem, int item) {
  const int chunk = item >> 2, g = item & 3;
  const bfu* gv = p.GVT + (size_t)item * 128 * 128;
  float* rinv = (float*)(smem + 2 * GSTAGE_BYTES);
  const int tid = TIDX;
  {
    float* sred = rinv + 128;
    const int s4 = (tid & 31) * 4, cg = tid >> 5;
    uint2 raw[16];
#pragma unroll
    for (int i = 0; i < 16; ++i) raw[i] = *(const uint2*)(gv + (cg * 16 + i) * 128 + s4);
    float ss[4] = {0.f, 0.f, 0.f, 0.f};
#pragma unroll
    for (int i = 0; i < 16; ++i) {
      float f[4];
      unpack4(raw[i], f);
#pragma unroll
      for (int j = 0; j < 4; ++j) ss[j] += f[j] * f[j];
    }
    *(float4*)(sred + cg * 128 + s4) = float4{ss[0], ss[1], ss[2], ss[3]};
    __syncthreads();
    if (tid < 128) {
      float t = 0.f;
#pragma unroll
      for (int i = 0; i < 8; ++i) t += sred[i * 128 + tid];
      rinv[tid] = rsqrtf(t * (1.f / 128.f) + 1e-6f);
    }
  }
  __syncthreads();
  ALoadWs al{p.gm_ws + (size_t)g * 128 * 128, rinv};
  EpiGm epi{&p, chunk, g};
  gemm_tile(smem, al, gv, 128, 128, 0, 0, epi);
}

DEVI void attn_item(const Params& p, char* smem, int item) {
  const int qb = item & 63, bh = item >> 6, b = bh >> 3, h = bh & 7;
  const int q0 = qb * 256;
  bfu* Ob = (bfu*)smem;
  float* Mb = (float*)(smem + 32768);
  float* Lb = Mb + 256;
  const int tid = threadIdx.x, lane = tid & 63, wid = tid >> 6;
  const int qi = lane & 15, g = lane >> 4;
  const float slope = exp2f(-(float)(h + 1));
  const size_t tokb = (size_t)b * SEQ;
#pragma unroll 1
  for (int pi = 0; pi < 3; ++pi) {
    const int dshift = 2 * pi, d = 1 << dshift;
    const bfu* VT = p.VT + (size_t)pi * ((size_t)16 * 64 * SEQ) + (size_t)bh * 64 * SEQ;
#pragma unroll 1
    for (int u = wid; u < 16; u += 8) {
      const int r = u & (d - 1), tile = u >> dshift;
      const int sq0 = (q0 >> dshift) + tile * 16;
      const int sk0 = sq0 - 144;
      const int posq = ((sq0 + qi) << dshift) + r;
      const bfu* qp = p.Q + (tokb + posq) * 512 + h * 64 + g * 8;
      const bf16x8 qf0 = *(const bf16x8*)qp, qf1 = *(const bf16x8*)(qp + 32);
      const bfu* kbase = p.K + (tokb + r) * 512 + h * 64 + g * 8;
      const bfu* vbase = VT + (size_t)qi * SEQ + r * (SEQ >> dshift);
      bf16x8 kf[2][2];
      uint2 vf[4][2];
      auto loadk = [&](int it) {
#pragma unroll
        for (int tt = 0; tt < 2; ++tt) {
          int sk = sk0 + (2 * it + tt) * 16 + qi;
          sk = sk < 0 ? 0 : sk;
          const bfu* kp = kbase + ((size_t)sk << dshift) * 512;
          kf[tt][0] = *(const bf16x8*)kp;
          kf[tt][1] = *(const bf16x8*)(kp + 32);
        }
      };
      auto loadv = [&](int it) {
        int kidx0 = sk0 + 32 * it + 4 * g, kidx1 = kidx0 + 16;
        kidx0 = kidx0 < 0 ? 0 : kidx0;
        kidx1 = kidx1 < 0 ? 0 : kidx1;
#pragma unroll
        for (int m = 0; m < 4; ++m) {
          vf[m][0] = *(const uint2*)(vbase + (size_t)(16 * m) * SEQ + kidx0);
          vf[m][1] = *(const uint2*)(vbase + (size_t)(16 * m) * SEQ + kidx1);
        }
      };
      loadk(0);
      loadv(0);
      const int hi = 144 + qi, lo = (16 + qi > -sk0) ? 16 + qi : -sk0;
      const float sd = slope * (float)d;
      float mrun = -1e30f, l = 0.f;
      f32x4 O[4];
#pragma unroll
      for (int m = 0; m < 4; ++m) O[m] = f32x4{0.f, 0.f, 0.f, 0.f};
#pragma unroll 1
      for (int it = 0; it < 5; ++it) {
        bf16x8 ck[2][2];
        uint2 cv[4][2];
#pragma unroll
        for (int a = 0; a < 2; ++a)
#pragma unroll
          for (int c = 0; c < 2; ++c) ck[a][c] = kf[a][c];
        const int itn = it < 4 ? it + 1 : 4;
        loadk(itn);
        f32x4 S[2];
#pragma unroll
        for (int tt = 0; tt < 2; ++tt) {
          f32x4 z = {0.f, 0.f, 0.f, 0.f};
          z = __builtin_amdgcn_mfma_f32_16x16x32_bf16(ck[tt][0], qf0, z, 0, 0, 0);
          z = __builtin_amdgcn_mfma_f32_16x16x32_bf16(ck[tt][1], qf1, z, 0, 0, 0);
          S[tt] = z;
        }
        float mx = -INFINITY;
#pragma unroll
        for (int tt = 0; tt < 2; ++tt)
#pragma unroll
          for (int e = 0; e < 4; ++e) {
            const int kb = (2 * it + tt) * 16 + 4 * g;
            const bool valid = (kb >= lo - e) && (kb <= hi - e);
            const float sv = valid ? fmaf(S[tt][e], 0.125f, sd * (float)e - sd * (float)(hi - kb)) : -INFINITY;
            S[tt][e] = sv;
            mx = fmaxf(mx, sv);
          }
        mx = fmaxf(mx, __shfl_xor(mx, 16));
        mx = fmaxf(mx, __shfl_xor(mx, 32));
        const float mnew = fmaxf(mrun, mx);
        const float alpha = __expf(mrun - mnew);
        mrun = mnew;
        float ls = 0.f;
#pragma unroll
        for (int tt = 0; tt < 2; ++tt)
#pragma unroll
          for (int e = 0; e < 4; ++e) {
            const float pe = __expf(S[tt][e] - mnew);
            S[tt][e] = pe;
            ls += pe;
          }
        l = l * alpha + ls;
        uint4 pk;
        pk.x = pkbf(S[0][0], S[0][1]);
        pk.y = pkbf(S[0][2], S[0][3]);
        pk.z = pkbf(S[1][0], S[1][1]);
        pk.w = pkbf(S[1][2], S[1][3]);
        const bf16x8 pf = __builtin_bit_cast(bf16x8, pk);
#pragma unroll
        for (int m = 0; m < 4; ++m) {
          cv[m][0] = vf[m][0];
          cv[m][1] = vf[m][1];
        }
        loadv(itn);
#pragma unroll
        for (int m = 0; m < 4; ++m) {
          O[m] *= alpha;
          const uint4 vv = {cv[m][0].x, cv[m][0].y, cv[m][1].x, cv[m][1].y};
          O[m] = __builtin_amdgcn_mfma_f32_16x16x32_bf16(__builtin_bit_cast(bf16x8, vv), pf, O[m], 0, 0, 0);
        }
      }
      l += __shfl_xor(l, 16);
      l += __shfl_xor(l, 32);
      const float mx = mrun;
      const float il = 1.f / l;
      const int ql = ((tile * 16 + qi) << dshift) + r;
      float wo = 0.f, wn = 1.f;
      float mnew = mx, lnew = l;
      if (pi > 0) {
        const float mo = Mb[ql], lo = Lb[ql];
        mnew = fmaxf(mo, mx);
        wo = lo * __expf(mo - mnew);
        wn = l * __expf(mx - mnew);
        lnew = wo + wn;
        const float inv = 1.f / lnew;
        wo *= inv;
        wn *= inv;
      }
      wn *= il;
#pragma unroll
      for (int m = 0; m < 4; ++m) {
        bfu* op = Ob + ql * 64 + 16 * m + 4 * g;
        float o[4];
        if (pi > 0) {
          const uint2 ov = *(const uint2*)op;
          o[0] = wo * bf2f(ov.x & 0xffffu) + wn * O[m][0];
          o[1] = wo * bf2f(ov.x >> 16) + wn * O[m][1];
          o[2] = wo * bf2f(ov.y & 0xffffu) + wn * O[m][2];
          o[3] = wo * bf2f(ov.y >> 16) + wn * O[m][3];
        } else {
#pragma unroll
          for (int e = 0; e < 4; ++e) o[e] = wn * O[m][e];
        }
        if (pi < 2) {
          uint2 w;
          w.x = pkbf(o[0], o[1]);
          w.y = pkbf(o[2], o[3]);
          *(uint2*)op = w;
        } else {
          const size_t oi = (tokb + q0 + ql) * 1024 + 512 + h * 64 + 16 * m + 4 * g;
          const uint2 sz = *(const uint2*)(p.SZ + oi);
          uint2 w;
          w.x = pkbf(o[0] * bf2f(sz.x & 0xffffu), o[1] * bf2f(sz.x >> 16));
          w.y = pkbf(o[2] * bf2f(sz.y & 0xffffu), o[3] * bf2f(sz.y >> 16));
          *(uint2*)(p.Y + oi) = w;
        }
      }
      if (pi < 2 && g == 0) {
        Mb[ql] = mnew;
        Lb[ql] = lnew;
      }
    }
    __syncthreads();
  }
}

DEVI void phase2(const Params& p, char* smem, int bid, int nb) {
  for (int it = bid; it < 16 * 64; it += nb) attn_item(p, smem, it);
  char* hs = smem + HF * HALF_SMEM;
  for (int it = bid * 2 + HF; it < (T_TOK / 128) * 4; it += nb * 2) gmlp_item(p, hs, it);
}

DEVI void phase3(const Params& p, char* smem, int bid, int nb) {
  PgEpiRes E{p.x, p.out};
  pg_gemm(smem, p.Y, p.WT_out, T_TOK, 1024, 1024, E, bid, nb);
}
DEVI void phase3b(const Params& p, int bid, int nb) {
  for (int it = bid; it < T_TOK / 16; it += nb) {
    const int row = it * 16 + (threadIdx.x >> 6) * 2;
    rms_row2_bf16(p.out + (size_t)row * 1024, p.ln_odd, p.H + (size_t)row * 1024, threadIdx.x & 63);
  }
}

struct ALoadMix {
  typedef uint4 Raw;
  static constexpr bool kFat = true;
  static constexpr bool kConsec = true;
  const bfu* H;
  const float* mu;
  DEVI Raw load(int row, int k) const { return *(const uint4*)(H + (size_t)row * 1024 + k); }
  DEVI uint4 loadprev(int row, int k) const {
    const int prow = ((row & (SEQ - 1)) != 0) ? row - 1 : row;
    return *(const uint4*)(H + (size_t)prow * 1024 + k);
  }
  DEVI uint4 asprev(const Raw& r) const { return r; }
  DEVI uint4 finish(const Raw& r, const uint4& pr, int row, int k) const {
    float c[8], pv[8];
    unpack8(r, c);
    unpack8(pr, pv);
    const float first = ((row & (SEQ - 1)) != 0) ? 1.f : 0.f;
    const float4 m0 = *(const float4*)(mu + k), m1 = *(const float4*)(mu + k + 4);
    const float mm[8] = {m0.x, m0.y, m0.z, m0.w, m1.x, m1.y, m1.z, m1.w};
#pragma unroll
    for (int j = 0; j < 8; ++j) c[j] = c[j] + (pv[j] * first - c[j]) * mm[j];
    return pack8(c);
  }
};
struct Epi4 {
  const Params* p;
  int nt;
  DEVI void operator()(int row, int col, f32x4 v) const {
    uint2 o;
    if (nt < 24) {
      o.x = pkbf(v[0], v[1]);
      o.y = pkbf(v[2], v[3]);
      bfu* dst = (nt < 8) ? p->R + (size_t)row * 1024 + col
                          : (nt < 16) ? p->K1 + (size_t)row * 1024 + col - 1024 : p->V1 + (size_t)row * 1024 + col - 2048;
      *(uint2*)dst = o;
    } else if (nt < 32) {
      o.x = pkbf(silu_(v[0]), silu_(v[1]));
      o.y = pkbf(silu_(v[2]), silu_(v[3]));
      *(uint2*)(p->SG + (size_t)row * 1024 + col - 3072) = o;
    } else if (nt == 32) {
      const int c = col - 4096;
      if (c < 64) {
        o.x = pkbf(tanh_(v[0]), tanh_(v[1]));
        o.y = pkbf(tanh_(v[2]), tanh_(v[3]));
        *(uint2*)(p->TW + (size_t)row * 64 + c) = o;
      }
    } else {
      const int c = col - 4224;
      if (c < 64) {
        o.x = pkbf(v[0], v[1]);
        o.y = pkbf(v[2], v[3]);
        *(uint2*)(p->TA + (size_t)row * 64 + c) = o;
      }
    }
  }
};
DEVI void phase4_tile(const Params& p, char* smem, int mt, int nt) {
  float* smu = (float*)(smem + 2 * GSTAGE_BYTES);
  const int mi = (nt < 8) ? 0 : (nt < 16) ? 2 : (nt < 24) ? 3 : (nt < 32) ? 5 : (nt == 32) ? 1 : 4;
  *(float4*)(smu + TIDX * 4) = *(const float4*)(p.mu + mi * 1024 + TIDX * 4);
  __syncthreads();
  ALoadMix al{p.H, smu};
  Epi4 epi{&p, nt};
  gemm_tile<1>(smem, al, p.WT_3, 1024, 1024, mt * 128, nt * 128, epi);
}
DEVI void phaseM(const Params& p, char* smem, int bid, int nb) {
  char* hs = smem + HF * HALF_SMEM;
  for (int it = bid * 2 + HF; it < (T_TOK / 128) * 2; it += nb * 2) phase4_tile(p, hs, it >> 1, 32 + (it & 1));
  const int tid = threadIdx.x;
  const int cc = (tid & 127) * 8, rsub = tid >> 7;
  float mr[8], mk[8], mv[8], mg[8];
  {
    const float4 a0 = *(const float4*)(p.mu + 0 * 1024 + cc), a1 = *(const float4*)(p.mu + 0 * 1024 + cc + 4);
    const float4 b0 = *(const float4*)(p.mu + 2 * 1024 + cc), b1 = *(const float4*)(p.mu + 2 * 1024 + cc + 4);
    const float4 c0 = *(const float4*)(p.mu + 3 * 1024 + cc), c1 = *(const float4*)(p.mu + 3 * 1024 + cc + 4);
    const float4 d0 = *(const float4*)(p.mu + 5 * 1024 + cc), d1 = *(const float4*)(p.mu + 5 * 1024 + cc + 4);
    mr[0] = a0.x; mr[1] = a0.y; mr[2] = a0.z; mr[3] = a0.w; mr[4] = a1.x; mr[5] = a1.y; mr[6] = a1.z; mr[7] = a1.w;
    mk[0] = b0.x; mk[1] = b0.y; mk[2] = b0.z; mk[3] = b0.w; mk[4] = b1.x; mk[5] = b1.y; mk[6] = b1.z; mk[7] = b1.w;
    mv[0] = c0.x; mv[1] = c0.y; mv[2] = c0.z; mv[3] = c0.w; mv[4] = c1.x; mv[5] = c1.y; mv[6] = c1.z; mv[7] = c1.w;
    mg[0] = d0.x; mg[1] = d0.y; mg[2] = d0.z; mg[3] = d0.w; mg[4] = d1.x; mg[5] = d1.y; mg[6] = d1.z; mg[7] = d1.w;
  }
#pragma unroll 1
  for (int it = bid; it < T_TOK / 8; it += nb) {
    const int ra = it * 8 + rsub, rb = ra + 4;
    const size_t oa = (size_t)ra * 1024 + cc, ob = (size_t)rb * 1024 + cc;
    const uint4 ca = *(const uint4*)(p.H + oa), cb = *(const uint4*)(p.H + ob);
    const uint4 pa = *(const uint4*)(p.H + (((ra & (SEQ - 1)) != 0) ? oa - 1024 : oa));
    const uint4 pb = *(const uint4*)(p.H + ob - 1024);
    const float fa = ((ra & (SEQ - 1)) != 0) ? 1.f : 0.f;
#pragma unroll
    for (int half = 0; half < 2; ++half) {
      float c[8], d[8], o[8];
      unpack8(half ? cb : ca, c);
      unpack8(half ? pb : pa, d);
      const float f = half ? 1.f : fa;
      const size_t oo = half ? ob : oa;
#pragma unroll
      for (int j = 0; j < 8; ++j) d[j] = d[j] * f - c[j];
#pragma unroll
      for (int j = 0; j < 8; ++j) o[j] = c[j] + d[j] * mr[j];
      *(uint4*)(p.XR + oo) = pack8(o);
#pragma unroll
      for (int j = 0; j < 8; ++j) o[j] = c[j] + d[j] * mk[j];
      *(uint4*)(p.XK + oo) = pack8(o);
#pragma unroll
      for (int j = 0; j < 8; ++j) o[j] = c[j] + d[j] * mv[j];
      *(uint4*)(p.XV + oo) = pack8(o);
#pragma unroll
      for (int j = 0; j < 8; ++j) o[j] = c[j] + d[j] * mg[j];
      *(uint4*)(p.XG + oo) = pack8(o);
    }
  }
}
DEVI void phase3a(const Params& p, char* smem, int bid, int nb) {
  PgEpi3 E{p.R, p.K1, 0};
  pg_gemm2(smem, p.XR, p.XK, 4, p.WT_3, T_TOK, 2048, 1024, E, bid, nb);
}
DEVI void phase3c(const Params& p, char* smem, int bid, int nb) {
  PgEpi3 E{p.V1, p.SG, 1};
  pg_gemm2(smem, p.XV, p.XG, 4, p.WT_3 + (size_t)2048 * 1024, T_TOK, 2048, 1024, E, bid, nb);
}

struct Epi5w {
  const Params* p;
  DEVI void operator()(int row, int col, f32x4 v) const {
    const float4 w0 = *(const float4*)(p->w0 + col);
    const float k = 0.6065306597126334f;
    uint2 o;
    o.x = pkbf(k * sigmoid_(w0.x + v[0]), k * sigmoid_(w0.y + v[1]));
    o.y = pkbf(k * sigmoid_(w0.z + v[2]), k * sigmoid_(w0.w + v[3]));
    *(uint2*)(p->EW + (size_t)row * 1024 + col) = o;
  }
};
struct Epi5a {
  const Params* p;
  DEVI void operator()(int row, int col, f32x4 v) const {
    const float4 a0 = *(const float4*)(p->a0 + col);
    uint2 o;
    o.x = pkbf(sigmoid_(a0.x + v[0]), sigmoid_(a0.y + v[1]));
    o.y = pkbf(sigmoid_(a0.z + v[2]), sigmoid_(a0.w + v[3]));
    *(uint2*)(p->AA + (size_t)row * 1024 + col) = o;
  }
};
DEVI void phase5(const Params& p, char* smem, int bid, int nb) {
  constexpr int N1 = (T_TOK / 128) * 8;
  char* hs = smem + HF * HALF_SMEM;
  for (int it = bid * 2 + HF; it < 2 * N1; it += nb * 2) {
    if (it < N1) {
      ALoadPlain al{p.TW, 64};
      Epi5w epi{&p};
      gemm_tile(hs, al, p.W2T, 64, 64, (it >> 3) * 128, (it & 7) * 128, epi);
    } else {
      const int j = it - N1;
      ALoadPlain al{p.TA, 64};
      Epi5a epi{&p};
      gemm_tile(hs, al, p.A2T, 64, 64, (j >> 3) * 128, (j & 7) * 128, epi);
    }
  }
}

DEVI void scanx_item(const Params& p, char* smem, int item, int next_item, uint2& ur, uint2& uk, uint2& ue, uint2& ua, uint2& uv) {
  const int bh = item & 31, c = item >> 5;
  const int b = bh >> 4, h = bh & 15;
  const size_t rowbase = ((size_t)b * SEQ + (size_t)c * 16) * 1024 + h * 64;
  float* sA = (float*)smem;
  float* sR = sA + 16 * 68;
  float* sBt = sR + 16 * 68;
  float* sKt = sBt + 16 * 68;
  float* sE = sKt + 16 * 68;
  float* sMab = sE + 16 * 64;
  float* sMak = sMab + 256;
  float* sM2 = sMak + 256;
  float* sM4 = sM2 + 256;
  float* sT = sM4 + 256;
  float* sT2 = sT + 256;
  const int tid = TIDX;
  const int tau = tid >> 4, c4 = (tid & 15) * 4;
  const size_t o = rowbase + (size_t)tau * 1024 + c4;
  float r[4], k[4], ew[4], a[4], vv[4];
  unpack4(ur, r);
  unpack4(uk, k);
  unpack4(ue, ew);
  unpack4(ua, a);
  unpack4(uv, vv);
  {
    const int nbh = next_item & 31, nc = next_item >> 5;
    const size_t no = ((size_t)(nbh >> 4) * SEQ + (size_t)nc * 16 + tau) * 1024 + (nbh & 15) * 64 + c4;
    ur = *(const uint2*)(p.R + no);
    uk = *(const uint2*)(p.K1 + no);
    ue = *(const uint2*)(p.EW + no);
    ua = *(const uint2*)(p.AA + no);
    uv = *(const uint2*)(p.V1 + no);
  }
  float kk[4], kp[4], bb[4];
  float ss = 0.f, cf = 0.f;
#pragma unroll
  for (int j = 0; j < 4; ++j) {
    const int ch = h * 64 + c4 + j;
    kk[j] = k[j] * p.k_k[ch];
    ss += kk[j] * kk[j];
    kp[j] = k[j] * (1.f + (a[j] - 1.f) * p.k_a[ch]);
    cf += r[j] * kp[j] * p.r_k[ch];
  }
  ss = reduce16(ss);
  cf = reduce16(cf);
  const float rn = rsqrtf(fmaxf(ss, 1e-24f));
#pragma unroll
  for (int j = 0; j < 4; ++j) {
    kk[j] *= rn;
    bb[j] = kk[j] * a[j];
    sE[tau * 64 + c4 + j] = ew[j];
  }
  if ((tid & 15) == 0) p.COEF[((size_t)b * SEQ + (size_t)c * 16 + tau) * 16 + h] = cf;
  __syncthreads();
  float Li[4] = {0.f, 0.f, 0.f, 0.f}, L15[4] = {0.f, 0.f, 0.f, 0.f};
#pragma unroll
  for (int i = 0; i < 16; ++i) {
    const float4 e = *(const float4*)(sE + i * 64 + c4);
    const float m = (i <= tau) ? 1.f : 0.f;
    Li[0] += m * e.x; Li[1] += m * e.y; Li[2] += m * e.z; Li[3] += m * e.w;
    L15[0] += e.x; L15[1] += e.y; L15[2] += e.z; L15[3] += e.w;
  }
  float rt[4], bhat[4], khat[4];
#pragma unroll
  for (int j = 0; j < 4; ++j) {
    const float ep = __expf(Li[j]), em = __expf(-Li[j]), eh = __expf(-(L15[j] - Li[j]));
    const float at = -kk[j] * __expf(-(Li[j] - ew[j]));
    rt[j] = r[j] * em;
    sA[tau * 68 + c4 + j] = at;
    sR[tau * 68 + c4 + j] = rt[j];
    sBt[tau * 68 + c4 + j] = bb[j] * ep;
    sKt[tau * 68 + c4 + j] = kp[j] * ep;
    bhat[j] = bb[j] * eh;
    khat[j] = kp[j] * eh;
  }
  *(uint2*)(p.R + o) = pack4(rt);
#pragma unroll
  for (int j = 0; j < 4; ++j) {
    const int lin = (c4 + j) * 16 + tau;
    const size_t off = rowbase + (size_t)(lin >> 6) * 1024 + (lin & 63);
    p.EW[off] = (bfu)f2bf(bhat[j]);
    p.K1[off] = (bfu)f2bf(khat[j]);
    p.V1[off] = (bfu)f2bf(vv[j]);
  }
  if (tau == 0) {
    float4 gq = {__expf(-L15[0]), __expf(-L15[1]), __expf(-L15[2]), __expf(-L15[3])};
    *(float4*)(p.G15 + (size_t)item * 64 + c4) = gq;
  }
  __syncthreads();
  {
    const int wv = tid >> 6, ln = tid & 63, rw = ln & 15, gq = ln >> 4;
    const float* rowsrc = ((wv >> 1) ? sKt : sBt) + rw * 68 + 16 * gq;
    const float* colsrc = ((wv & 1) ? sR : sA) + rw * 68 + 16 * gq;
    f32x4 m = {0.f, 0.f, 0.f, 0.f};
#pragma unroll
    for (int s4 = 0; s4 < 16; s4 += 4) {
      const float4 av = *(const float4*)(rowsrc + s4), bv = *(const float4*)(colsrc + s4);
      m = __builtin_amdgcn_mfma_f32_16x16x4f32(av.x, bv.x, m, 0, 0, 0);
      m = __builtin_amdgcn_mfma_f32_16x16x4f32(av.y, bv.y, m, 0, 0, 0);
      m = __builtin_amdgcn_mfma_f32_16x16x4f32(av.z, bv.z, m, 0, 0, 0);
      m = __builtin_amdgcn_mfma_f32_16x16x4f32(av.w, bv.w, m, 0, 0, 0);
    }
    const int tq = rw;
    if (wv & 1) {
      float v4[4];
#pragma unroll
      for (int e = 0; e < 4; ++e) v4[e] = (4 * gq + e <= tq) ? m[e] : 0.f;
      *(uint2*)(p.MRT + (size_t)item * 512 + tq * 32 + gq * 8 + (wv >> 1) * 4) = pack4(v4);
    } else {
      float* dst = (wv >> 1) ? sMak : sMab;
#pragma unroll
      for (int e = 0; e < 4; ++e) dst[(4 * gq + e) * 16 + tq] = (4 * gq + e < tq) ? m[e] : 0.f;
    }
  }
  __syncthreads();
  {
    const int i = tid >> 4, j = tid & 15;
    float m2 = 0.f;
#pragma unroll
    for (int kq = 0; kq < 16; ++kq) m2 += sMab[i * 16 + kq] * sMab[kq * 16 + j];
    sM2[i * 16 + j] = m2;
    __syncthreads();
    float t1 = ((i == j) ? 1.f : 0.f) + sMab[i * 16 + j] + m2, m4 = 0.f;
#pragma unroll
    for (int kq = 0; kq < 16; ++kq) {
      t1 += sMab[i * 16 + kq] * sM2[kq * 16 + j];
      m4 += sM2[i * 16 + kq] * sM2[kq * 16 + j];
    }
    sT[i * 16 + j] = t1;
    sM4[i * 16 + j] = m4;
    __syncthreads();
    float t2 = t1, m8 = 0.f;
#pragma unroll
    for (int kq = 0; kq < 16; ++kq) {
      t2 += sT[i * 16 + kq] * sM4[kq * 16 + j];
      m8 += sM4[i * 16 + kq] * sM4[kq * 16 + j];
    }
    sT2[i * 16 + j] = t2;
    __syncthreads();
    sM2[i * 16 + j] = m8;
    __syncthreads();
    float t3 = t2;
#pragma unroll
    for (int kq = 0; kq < 16; ++kq) t3 += sT2[i * 16 + kq] * sM2[kq * 16 + j];
    sT[i * 16 + j] = t3;
    __syncthreads();
  }
  {
    const int tq = tid >> 4, k4 = (tid & 15) * 4, ii = tid & 15;
    float w0 = 0.f, w1 = 0.f, w2 = 0.f, w3 = 0.f, gt = 0.f;
#pragma unroll
    for (int jj = 0; jj < 16; ++jj) {
      const float tm = sT[jj * 16 + tq];
      const float4 av = *(const float4*)(sA + jj * 68 + k4);
      w0 += av.x * tm; w1 += av.y * tm; w2 += av.z * tm; w3 += av.w * tm;
      gt += sMak[ii * 16 + jj] * tm;
    }
    uint2 wv;
    wv.x = pkbf(w0, w1);
    wv.y = pkbf(w2, w3);
    *(uint2*)(p.AA + rowbase + (size_t)tq * 1024 + k4) = wv;
    p.GT[(size_t)item * 256 + tq * 16 + ii] = (bfu)f2bf(gt);
  }
  __syncthreads();
}
DEVI void phase6x(const Params& p, char* smem, int bid, int nb) {
  char* hs = smem + HF * HALF_SMEM;
  constexpr int NI = (SEQ / 16) * 32;
  const int vnb = nb * 2;
  int it = bid * 2 + HF;
  if (it >= NI) return;
  uint2 ur, uk, ue, ua, uv;
  {
    const int tau = TIDX >> 4, c4 = (TIDX & 15) * 4;
    const int bh = it & 31, c = it >> 5;
    const size_t o = ((size_t)(bh >> 4) * SEQ + (size_t)c * 16 + tau) * 1024 + (bh & 15) * 64 + c4;
    ur = *(const uint2*)(p.R + o);
    uk = *(const uint2*)(p.K1 + o);
    ue = *(const uint2*)(p.EW + o);
    ua = *(const uint2*)(p.AA + o);
    uv = *(const uint2*)(p.V1 + o);
  }
#pragma unroll 1
  for (; it < NI; it += vnb) scanx_item(p, hs, it, (it + vnb < NI) ? it + vnb : it, ur, uk, ue, ua, uv);
}

DEVI bf16x8 mk8(uint2 a, uint2 b) {
  const uint4 v = {a.x, a.y, b.x, b.y};
  return __builtin_bit_cast(bf16x8, v);
}
DEVI uint2 packacc(f32x4 a) {
  uint2 r;
  r.x = pkbf(a[0], a[1]);
  r.y = pkbf(a[2], a[3]);
  return r;
}
constexpr int SCH = 4;
constexpr int SROW = 136;
constexpr int SARR = 16 * SROW;
constexpr int SOFF_GT = 5 * SARR;
constexpr int SOFF_MR = SOFF_GT + 512;
constexpr int SOFF_G15 = SOFF_MR + 1024;
constexpr int SIMG = SOFF_G15 + 256;
#define SCANS_LD5(P, I, O)                       \
    P##a##I = *(const uint4*)(p.AA + (O));       \
    P##r##I = *(const uint4*)(p.R + (O));        \
    P##e##I = *(const uint4*)(p.EW + (O));       \
    P##k##I = *(const uint4*)(p.K1 + (O));       \
    P##v##I = *(const uint4*)(p.V1 + (O));
#define SCANS_ISSUE(P, SC)                                                                           \
  {                                                                                                  \
    const size_t hb_ = ((size_t)b * SEQ) * 1024 + h * 64 + c80 * 8;                                  \
    const int tk0_ = (SC) * SCH * 16 + cl0 * 16 + row0;                                              \
    const int tk1_ = tk0_ + 32;                                                                      \
    SCANS_LD5(P, 0, hb_ + (size_t)(tk0_ < SEQ ? tk0_ : SEQ - 1) * 1024)                              \
    SCANS_LD5(P, 1, hb_ + (size_t)(tk1_ < SEQ ? tk1_ : SEQ - 1) * 1024)                              \
    const int c0_ = (SC) * SCH;                                                                      \
    const size_t ib_ = (size_t)b * 16 + h;                                                           \
    const int tg_ = tid < 128 ? tid : 127;                                                           \
    const int cg_ = c0_ + (tg_ >> 5);                                                                \
    P##gm = *(const uint4*)(p.GT + ((size_t)(cg_ < SEQ / 16 ? cg_ : SEQ / 16 - 1) * 32 + ib_) * 256 + (tg_ & 31) * 8);  \
    const int t5_ = tid < 64 ? tid : 63;                                                             \
    const int c5_ = c0_ + (t5_ >> 4);                                                                \
    P##g5 = *(const uint4*)(p.G15 + ((size_t)(c5_ < SEQ / 16 ? c5_ : SEQ / 16 - 1) * 32 + ib_) * 64 + (t5_ & 15) * 4);  \
    const int cm_ = c0_ + (tid >> 6);                                                                \
    P##mr = *(const uint4*)(p.MRT + ((size_t)(cm_ < SEQ / 16 ? cm_ : SEQ / 16 - 1) * 32 + ib_) * 512 + (tid & 63) * 8); \
  }
#define SCANS_ST5(P, I, B)                                                                           \
    *(uint2*)(B) = uint2{P##a##I.x, P##a##I.y};  *(uint2*)((B) + 8) = uint2{P##a##I.z, P##a##I.w};   \
    *(uint2*)((B) + SARR) = uint2{P##r##I.x, P##r##I.y};  *(uint2*)((B) + SARR + 8) = uint2{P##r##I.z, P##r##I.w};   \
    *(uint2*)((B) + 2 * SARR) = uint2{P##e##I.x, P##e##I.y};  *(uint2*)((B) + 2 * SARR + 8) = uint2{P##e##I.z, P##e##I.w};   \
    *(uint2*)((B) + 3 * SARR) = uint2{P##k##I.x, P##k##I.y};  *(uint2*)((B) + 3 * SARR + 8) = uint2{P##k##I.z, P##k##I.w};   \
    *(uint2*)((B) + 4 * SARR) = uint2{P##v##I.x, P##v##I.y};  *(uint2*)((B) + 4 * SARR + 8) = uint2{P##v##I.z, P##v##I.w};
#define SCANS_COMMIT(P)                                                                              \
  {                                                                                                  \
    char* b0_ = cimg + cl0 * SIMG + row0 * SROW + c80 * 16;                                          \
    SCANS_ST5(P, 0, b0_)                                                                             \
    SCANS_ST5(P, 1, b0_ + 2 * SIMG)                                                                  \
    if (tid < 128) *(uint4*)(cimg + (tid >> 5) * SIMG + SOFF_GT + (tid & 31) * 16) = P##gm;          \
    if (tid < 64) *(uint4*)(cimg + (tid >> 4) * SIMG + SOFF_G15 + (tid & 15) * 16) = P##g5;          \
    *(uint4*)(cimg + (tid >> 6) * SIMG + SOFF_MR + (tid & 63) * 16) = P##mr;                         \
  }
#define SCANS_COMPUTE(SCI)                                                                           \
  _Pragma("unroll 1") for (int cl = 0; cl < SCH && (SCI) * SCH + cl < SEQ / 16; ++cl) {             \
    const char* img = cimg + cl * SIMG;                                                              \
        \
    const uint2 vb = *(const uint2*)(img + 4 * SARR + vrow * SROW + vcol * 2);                       \
    const uint2 gt = *(const uint2*)(img + SOFF_GT + (q * 16 + 4 * g) * 2);                          \
    const char* wp = img + q * SROW + (4 * g) * 2;                                                   \
    const uint2 w00 = *(const uint2*)(wp), w01 = *(const uint2*)(wp + 32);                           \
    const uint2 w10 = *(const uint2*)(wp + 64), w11 = *(const uint2*)(wp + 96);                      \
    const uint2 r00 = *(const uint2*)(wp + SARR), r01 = *(const uint2*)(wp + SARR + 32);             \
    const uint2 r10 = *(const uint2*)(wp + SARR + 64), r11 = *(const uint2*)(wp + SARR + 96);        \
    const uint4 mr = *(const uint4*)(img + SOFF_MR + (q * 32 + g * 8) * 2);                          \
    uint2 bk0[4], bk1[4];                                                                            \
    float4 g15[4];                                                                                   \
    _Pragma("unroll") for (int n = 0; n < 4; ++n) {                                                  \
      const int ch = 16 * n + q;                                                                     \
      const char* bp = img + 2 * SARR + (ch >> 2) * SROW + ((ch & 3) * 16 + 4 * g) * 2;              \
      bk0[n] = *(const uint2*)(bp);                                                                  \
      bk1[n] = *(const uint2*)(bp + SARR);                                                           \
      g15[n] = *(const float4*)(img + SOFF_G15 + (16 * n + 4 * g) * 4);                              \
    }                                                                                                \
    __builtin_amdgcn_sched_barrier(0);                                                               \
    const bf16x8 sB0 = mk8(packacc(acc[0]), packacc(acc[1]));                                        \
    const bf16x8 sB1 = mk8(packacc(acc[2]), packacc(acc[3]));                                        \
    f32x4 Z = {0.f, 0.f, 0.f, 0.f};                                                                  \
    Z = __builtin_amdgcn_mfma_f32_16x16x32_bf16(mk8(gt, zero2), mk8(vb, zero2), Z, 0, 0, 0);         \
    f32x4 Y = {0.f, 0.f, 0.f, 0.f};                                                                  \
    Z = __builtin_amdgcn_mfma_f32_16x16x32_bf16(mk8(w00, w01), sB0, Z, 0, 0, 0);                     \
    Y = __builtin_amdgcn_mfma_f32_16x16x32_bf16(mk8(r00, r01), sB0, Y, 0, 0, 0);                     \
    Z = __builtin_amdgcn_mfma_f32_16x16x32_bf16(mk8(w10, w11), sB1, Z, 0, 0, 0);                     \
    Y = __builtin_amdgcn_mfma_f32_16x16x32_bf16(mk8(r10, r11), sB1, Y, 0, 0, 0);                     \
    const bf16x8 zvB = mk8(packacc(Z), vb);                                                          \
    Y = __builtin_amdgcn_mfma_f32_16x16x32_bf16(__builtin_bit_cast(bf16x8, mr), zvB, Y, 0, 0, 0);    \
    _Pragma("unroll") for (int n = 0; n < 4; ++n) {                                                  \
      f32x4 scv = acc[n];                                                                            \
      scv[0] *= g15[n].x; scv[1] *= g15[n].y; scv[2] *= g15[n].z; scv[3] *= g15[n].w;                \
      acc[n] = __builtin_amdgcn_mfma_f32_16x16x32_bf16(mk8(bk0[n], bk1[n]), zvB, scv, 0, 0, 0);      \
    }                                                                                                \
    _Pragma("unroll") for (int e = 0; e < 4; ++e)                                                    \
        ybuf[(cl * 16 + 4 * g + e) * 16 + q] = (bfu)f2bf(Y[e]);                                      \
  }
DEVI void scans_block(const Params& p, char* smem, int bh, int vs) {
  const int b = bh >> 4, h = bh & 15;
  const int lane = threadIdx.x & 63, wv = threadIdx.x >> 6, q = lane & 15, g = lane >> 4;
  f32x4 acc[4];
#pragma unroll
  for (int n = 0; n < 4; ++n) acc[n] = f32x4{0.f, 0.f, 0.f, 0.f};
  const uint2 zero2 = {0u, 0u};
  bfu* yout = p.YS + ((size_t)b * SEQ) * 1024 + h * 64 + vs * 16;
  char* const img0 = smem;
  char* const img1 = smem + SCH * SIMG;
  bfu* const yb0 = (bfu*)(smem + 2 * SCH * SIMG);
  bfu* const yb1 = yb0 + SCH * 16 * 16;
  const int tid = TIDX;
  const bool stager = wv >= 4;
  const int cl0 = tid >> 7, row0 = (tid >> 3) & 15, c80 = tid & 7;
  uint4 Aa0, Aa1, Ar0, Ar1, Ae0, Ae1, Ak0, Ak1, Av0, Av1, Agm, Ag5, Amr;
  constexpr int NSC = (SEQ / 16) / SCH;
  const int vrow = vs * 4 + (q >> 2), vcol = (q & 3) * 16 + 4 * g;
  if (stager) {
    char* cimg = img0;
    SCANS_ISSUE(A, 0);
    SCANS_COMMIT(A);
    SCANS_ISSUE(A, 1);
  }
  __syncthreads();
#define SCANS_FLUSH(YB, S)                                                                                       \
  if (wv >= 1 && wv <= 2) {                                                                                      \
    const int idx = (int)threadIdx.x - 64, tok = (S) * SCH * 16 + (idx >> 1);                                    \
    *(uint4*)(yout + (size_t)tok * 1024 + (idx & 1) * 8) = *(const uint4*)((YB) + (idx >> 1) * 16 + (idx & 1) * 8); \
  }
#pragma unroll 1
  for (int sc = 0; sc < NSC; sc += 2) {
    if (wv == 0) {
      const char* cimg = img0;
      bfu* ybuf = yb0;
      SCANS_COMPUTE(sc);
    } else if (stager) {
      char* cimg = img1;
      SCANS_COMMIT(A);
      SCANS_ISSUE(A, (sc + 2 < NSC ? sc + 2 : NSC - 1));
    } else if (sc > 0) {
      SCANS_FLUSH(yb1, sc - 1)
    }
    __syncthreads();
    if (wv == 0) {
      const char* cimg = img1;
      bfu* ybuf = yb1;
      SCANS_COMPUTE(sc + 1);
    } else if (stager) {
      char* cimg = img0;
      SCANS_COMMIT(A);
      SCANS_ISSUE(A, (sc + 3 < NSC ? sc + 3 : NSC - 1));
    } else {
      SCANS_FLUSH(yb0, sc)
    }
    __syncthreads();
  }
  SCANS_FLUSH(yb1, NSC - 1)
#undef SCANS_FLUSH
}
DEVI void phase6(const Params& p, char* smem, int bid, int nb) {
  for (int it = bid; it < 128; it += nb) scans_block(p, smem, it >> 2, it & 3);
}

DEVI void phase6b(const Params& p, int bid, int nb) {
  const int lane = threadIdx.x & 63, wv = (threadIdx.x >> 6) & 3;
  for (int it = bid; it < T_TOK / 4; it += nb) {
    const int t0 = it * 4 + (threadIdx.x >> 8) * 2;
    float ys[8], vv[8], sg[8], bon[8];
#pragma unroll
    for (int j = 0; j < 8; ++j) {
      const int t = t0 + (j >> 2), h = wv * 4 + (j & 3);
      const int tb = t & ~15, tau = t & 15;
      const size_t idx = (size_t)t * 1024 + h * 64 + lane;
      ys[j] = bf2f(p.YS[idx]);
      sg[j] = bf2f(p.SG[idx]);
      vv[j] = bf2f(p.V1[(size_t)(tb + (lane >> 2)) * 1024 + h * 64 + (lane & 3) * 16 + tau]);
      bon[j] = p.COEF[(size_t)t * 16 + h];
    }
#pragma unroll
    for (int j = 0; j < 8; ++j) {
      const int t = t0 + (j >> 2), h = wv * 4 + (j & 3);
      const int c = h * 64 + lane;
      const float mean = wave_sum(ys[j]) * (1.f / 64.f);
      const float dv = ys[j] - mean;
      const float var = wave_sum(dv * dv) * (1.f / 64.f);
      float y = dv * rsqrtf(var + 64e-5f) * p.lnw[c] + p.lnb[c];
      y = (y + bon[j] * vv[j]) * sg[j];
      p.YS[(size_t)t * 1024 + c] = (bfu)f2bf(y);
    }
  }
}

DEVI void phase7(const Params& p, char* smem, int bid, int nb) {
  PgEpiRes E{p.out, p.out};
  pg_gemm(smem, p.YS, p.WT_o, T_TOK, 1024, 1024, E, bid, nb);
}
DEVI void phase8(const Params& p, int bid, int nb) {
  for (int it = bid; it < T_TOK / 16; it += nb) {
    const int row = it * 16 + (threadIdx.x >> 6) * 2;
    const int lane = threadIdx.x & 63;
    float* src = p.out + (size_t)row * 1024;
    float4 v[2][4];
    float ss[2] = {0.f, 0.f};
#pragma unroll
    for (int r = 0; r < 2; ++r)
#pragma unroll
      for (int i = 0; i < 4; ++i) v[r][i] = *(const float4*)(src + r * 1024 + lane * 4 + 256 * i);
#pragma unroll
    for (int r = 0; r < 2; ++r)
#pragma unroll
      for (int i = 0; i < 4; ++i)
        ss[r] += v[r][i].x * v[r][i].x + v[r][i].y * v[r][i].y + v[r][i].z * v[r][i].z + v[r][i].w * v[r][i].w;
#pragma unroll
    for (int r = 0; r < 2; ++r) {
      const float rinv = rsqrtf(wave_sum(ss[r]) * (1.f / 1024.f) + 1e-6f);
#pragma unroll
      for (int i = 0; i < 4; ++i) {
        const float4 g = *(const float4*)(p.fnorm + lane * 4 + 256 * i);
        const float4 o = {v[r][i].x * rinv * g.x, v[r][i].y * rinv * g.y, v[r][i].z * rinv * g.z, v[r][i].w * rinv * g.w};
        *(float4*)(src + r * 1024 + lane * 4 + 256 * i) = o;
      }
    }
  }
}

#define XB_TMO      128
#define XB_XCNT(j)  (256  + 64 * (j))
#define XB_XSUB(j)  (1280 + 64 * (j))
#define XB_XGEN(j)  (2304 + 64 * (j))
#define XB_TOP      3328
#define XB_TOPGEN   3392
#define XCD_BAR_WORDS 3456
#define XB_SPIN_CAP (1u << 18)
#define LAS __attribute__((address_space(3)))

__device__ __forceinline__ unsigned xb_ld(unsigned* p)              { return __hip_atomic_load(p, __ATOMIC_RELAXED, __HIP_MEMORY_SCOPE_AGENT); }
__device__ __forceinline__ unsigned xb_add(unsigned* p, unsigned v) { return __hip_atomic_fetch_add(p, v, __ATOMIC_RELAXED, __HIP_MEMORY_SCOPE_AGENT); }
__device__ __forceinline__ unsigned xb_xcc_id() { return (unsigned)__builtin_amdgcn_s_getreg((3 << 11) | 20) & 0xFu; }
#define XB_SPIN(cond, bar) do { unsigned _sp = 0; while (cond) { __builtin_amdgcn_s_sleep(1); \
    if ((++_sp & 255u) == 0u) { if (xb_ld(&(bar)[XB_TMO])) break; if (_sp > XB_SPIN_CAP) { atomicAdd(&(bar)[XB_TMO], 1u); break; } } } } while (0)

struct XcdBarrier {
    unsigned* bar; unsigned x;
    volatile LAS unsigned* st;
};

__device__ __forceinline__ XcdBarrier xcd_barrier_post(unsigned* bar, volatile LAS unsigned* st) {
    XcdBarrier b; b.bar = bar; b.x = xb_xcc_id(); b.st = st;
    if (threadIdx.x == 0) (void)xb_add(&bar[XB_XCNT(b.x)], 1u);
    return b;
}
__device__ __forceinline__ void xcd_barrier_complete(unsigned* bar, unsigned x, unsigned& nloc, unsigned& nx) {
    const unsigned G = gridDim.x * gridDim.y * gridDim.z;
    unsigned sum, cnt, mine, sp = 0u;
    for (;;) {
        sum = 0u; cnt = 0u; mine = 0u;
#pragma unroll
        for (unsigned j = 0; j < 16; ++j) { const unsigned c = xb_ld(&bar[XB_XCNT(j)]); sum += c; cnt += (c > 0u) ? 1u : 0u; mine = (j == x) ? c : mine; }
        if (sum == G) break;
        __builtin_amdgcn_s_sleep(1);
        if ((++sp & 255u) == 0u) { if (xb_ld(&bar[XB_TMO])) break; if (sp > XB_SPIN_CAP) { atomicAdd(&bar[XB_TMO], 1u); break; } }
    }
    nloc = mine > 0u ? mine : 1u; nx = cnt > 0u ? cnt : 1u;
}

__device__ __forceinline__ void xcd_barrier(const XcdBarrier& b) {
    asm volatile("s_waitcnt vmcnt(0)" ::: "memory");
    __syncthreads();
    if (threadIdx.x == 0) {
        unsigned* bar = b.bar;
        __builtin_amdgcn_s_waitcnt(0);
        unsigned nloc = b.st[0], nx = b.st[1];
        if (nloc == 0u) { xcd_barrier_complete(bar, b.x, nloc, nx); b.st[0] = nloc; b.st[1] = nx; }
        const unsigned old = xb_add(&bar[XB_XSUB(b.x)], 1u);
        const unsigned gen = old / nloc;
        if (old + 1u == (gen + 1u) * nloc) {
            __builtin_amdgcn_fence(__ATOMIC_RELEASE, "agent");
            asm volatile("s_waitcnt vmcnt(0)" ::: "memory");
            const unsigned og = xb_add(&bar[XB_TOP], 1u);
            const unsigned tg = og / nx;
            if (og + 1u == (tg + 1u) * nx) xb_add(&bar[XB_TOPGEN], 1u);
            else XB_SPIN(xb_ld(&bar[XB_TOPGEN]) == tg, bar);
            __builtin_amdgcn_fence(__ATOMIC_ACQUIRE, "agent");
            xb_add(&bar[XB_XGEN(b.x)], 1u);
            asm volatile("s_waitcnt vmcnt(0)" ::: "memory");
        } else {
            XB_SPIN(xb_ld(&bar[XB_XGEN(b.x)]) == gen, bar);
            __builtin_amdgcn_fence(__ATOMIC_ACQUIRE, "agent");
            asm volatile("s_waitcnt vmcnt(0)" ::: "memory");
        }
    }
    __syncthreads();
}


template <int PH>
DEVI void run_phase(const Params& p, char* smem, int bid, int nb) {
  if (PH == 0) phase0(p, smem, bid, nb);
  if (PH == 1) phase1(p, smem, bid, nb);
  if (PH == 2) phase2(p, smem, bid, nb);
  if (PH == 3) phase3(p, smem, bid, nb);
  if (PH == 4) phase3b(p, bid, nb);
  if (PH == 5) phaseM(p, smem, bid, nb);
  if (PH == 6) phase3a(p, smem, bid, nb);
  if (PH == 7) phase3c(p, smem, bid, nb);
  if (PH == 8) phase5(p, smem, bid, nb);
  if (PH == 9) phase6x(p, smem, bid, nb);
  if (PH == 10) phase6(p, smem, bid, nb);
  if (PH == 11) phase6b(p, bid, nb);
  if (PH == 12) phase7(p, smem, bid, nb);
  if (PH == 13) phase8(p, bid, nb);
}

#ifndef REP_MASK
#define REP_MASK 0
#endif
template <int PH>
DEVI void mega_phase(const Params& p, char* smem, cg::grid_group& grid, int bid, int nb) {
  run_phase<PH>(p, smem, bid, nb);
  if ((REP_MASK >> PH) & 1) {
    grid.sync();
    run_phase<PH>(p, smem, bid, nb);
  }
}
__global__ void __launch_bounds__(512, 2) mega_kernel(Params pk) {
  const Params& p = *(const Params*)__builtin_amdgcn_kernarg_segment_ptr();
  extern __shared__ __attribute__((aligned(16))) char smem[];
  cg::grid_group grid = cg::this_grid();
  const int bid = blockIdx.x, nb = gridDim.x;
  volatile LAS unsigned* st = (volatile LAS unsigned*)(smem + SMEM_BYTES);
  if (threadIdx.x == 0) {
    st[0] = 0u;
    st[1] = 0u;
  }
  __syncthreads();
  (void)xcd_barrier_post(p.BAR, st);
#define XBAR() do { XcdBarrier xb_; xb_.bar = p.BAR; xb_.x = xb_xcc_id(); xb_.st = (volatile LAS unsigned*)(smem + SMEM_BYTES); xcd_barrier(xb_); } while (0)
  mega_phase<0>(p, smem, grid, bid, nb); grid.sync();
  mega_phase<1>(p, smem, grid, bid, nb); XBAR();
  mega_phase<2>(p, smem, grid, bid, nb); XBAR();
  mega_phase<3>(p, smem, grid, bid, nb); XBAR();
  mega_phase<4>(p, smem, grid, bid, nb); XBAR();
  mega_phase<5>(p, smem, grid, bid, nb); XBAR();
  mega_phase<6>(p, smem, grid, bid, nb); XBAR();
  mega_phase<7>(p, smem, grid, bid, nb); XBAR();
  mega_phase<8>(p, smem, grid, bid, nb); XBAR();
  mega_phase<9>(p, smem, grid, bid, nb); XBAR();
  mega_phase<10>(p, smem, grid, bid, nb); XBAR();
  mega_phase<11>(p, smem, grid, bid, nb); XBAR();
  mega_phase<12>(p, smem, grid, bid, nb); grid.sync();
  mega_phase<13>(p, smem, grid, bid, nb);
}

extern "C" void kernel_launch(void* const* d_in, const int* in_sizes, int n_in, void* d_out, int out_size, void* d_ws,
                              size_t ws_size, hipStream_t stream) {
  Params p{};
  const float** fp = (const float**)&p;
  for (int i = 0; i < 26; ++i) fp[i] = (const float*)d_in[i];
  p.out = (float*)d_out;
  char* w = (char*)d_ws;
  size_t off = 0;
  auto take = [&](size_t bytes) {
    char* r = w + off;
    off += (bytes + 255) & ~(size_t)255;
    return (bfu*)r;
  };
  p.WT_in = take((size_t)3584 * 1024 * 2);
  p.WT_out = take((size_t)1024 * 1024 * 2);
  p.WT_3 = take((size_t)4352 * 1024 * 2);
  p.WT_o = take((size_t)1024 * 1024 * 2);
  p.W2T = take((size_t)1024 * 64 * 2);
  p.A2T = take((size_t)1024 * 64 * 2);
  p.TW = take((size_t)T_TOK * 64 * 2);
  p.TA = take((size_t)T_TOK * 64 * 2);
  const size_t SLOT = (size_t)T_TOK * 1024 * 2;
  bfu* slot0 = take(SLOT);
  bfu* slots = take(6 * SLOT);
  p.H = slot0;
  p.AA = slot0;
  p.U = slots;
  p.GVT = slots + SLOT / 4;
  p.Q = slots + 2 * (SLOT / 4);
  p.K = slots + 3 * (SLOT / 4);
  p.VT = slots + 4 * (SLOT / 4);
  p.SZ = slots + 7 * (SLOT / 4);
  p.Y = slots + 9 * (SLOT / 4);
  p.R = slots;
  p.K1 = slots + 1 * (SLOT / 2);
  p.XV = slots + 2 * (SLOT / 2);
  p.XG = slots + 3 * (SLOT / 2);
  p.XR = slots + 4 * (SLOT / 2);
  p.XK = slots + 5 * (SLOT / 2);
  p.V1 = slots + 4 * (SLOT / 2);
  p.SG = slots + 5 * (SLOT / 2);
  p.EW = slots + 2 * (SLOT / 2);
  p.YS = slots + 3 * (SLOT / 2);
  p.G15 = (float*)p.TW;
  p.GT = p.WT_in;
  p.MRT = take((size_t)(SEQ / 16) * 32 * 512 * 2);
  p.COEF = (float*)take((size_t)T_TOK * 16 * 4);
  p.BAR = (unsigned*)take((size_t)XCD_BAR_WORDS * 4);
  if (off > ws_size) {
    fprintf(stderr, "workspace too small: need %zu have %zu\n", off, ws_size);
    return;
  }
  static int grid_blocks = 0;
  if (!grid_blocks) {
    int dev = 0, cus = 0, per_cu = 0;
    (void)hipGetDevice(&dev);
    (void)hipDeviceGetAttribute(&cus, hipDeviceAttributeMultiprocessorCount, dev);
    (void)hipFuncSetAttribute((const void*)mega_kernel, hipFuncAttributeMaxDynamicSharedMemorySize, SMEM_BYTES + 16);
    (void)hipOccupancyMaxActiveBlocksPerMultiprocessor(&per_cu, mega_kernel, 512, SMEM_BYTES + 16);
    grid_blocks = cus * per_cu;
  }
  (void)hipMemsetAsync(p.BAR, 0, (size_t)XCD_BAR_WORDS * 4, stream);
  void* args[] = {&p};
  hipError_t e = hipLaunchCooperativeKernel((void*)mega_kernel, dim3(grid_blocks), dim3(512), args, SMEM_BYTES + 16, stream);
  if (e != hipSuccess) fprintf(stderr, "cooperative launch failed: %s (grid %d)\n", hipGetErrorString(e), grid_blocks);
}
```

```cpp
#include <hip/hip_runtime.h>
#include <hip/hip_cooperative_groups.h>
#include <stdint.h>
#include <cstdio>
namespace cg = cooperative_groups;

#ifndef MEGA
#define MEGA 1
#endif

typedef unsigned short bfu;
using bf16x8 = __attribute__((ext_vector_type(8))) short;
using f32x4 = __attribute__((ext_vector_type(4))) float;
#define DEVI __device__ __forceinline__
#define TIDX ((int)(threadIdx.x & 255))
#define HF ((int)(threadIdx.x >> 8))

constexpr int GSTAGE_BYTES = 2 * 128 * 72 * 2;
constexpr int T_TOK = 32768;
constexpr int SEQ = 16384;
constexpr int HALF_SMEM = 2 * GSTAGE_BYTES + 4096 + 512;
constexpr int SMEM_BYTES = 2 * HALF_SMEM;
constexpr int SMEM_UNUSED_ = 0;

struct Params {
  const float *x, *ln_even, *w_in, *gm_norm, *gm_ws, *gm_b, *w_out, *ln_odd, *mu, *wr, *wk, *wv, *wg, *w0, *w1, *w2,
      *a0, *a1, *a2, *k_k, *k_a, *r_k, *lnw, *lnb, *wo, *fnorm;
  float* out;
  bfu *WT_in, *WT_out, *WT_3, *WT_o, *W2T, *A2T;
  bfu *H, *U, *GVT, *Q, *K, *VT, *SZ, *Y, *R, *K1, *V1, *SG, *EW, *AA, *YS, *TW, *TA, *GT, *MRT, *XR, *XK, *XV, *XG;
  float *G15, *COEF;
  unsigned* BAR;
};

DEVI float bf2f(unsigned b) { return __uint_as_float(b << 16); }
DEVI unsigned f2bf(float x) {
  const __bf16 h = (__bf16)x;
  return (unsigned)__builtin_bit_cast(unsigned short, h);
}
typedef __bf16 bf16x2_t __attribute__((ext_vector_type(2)));
typedef float float2_t __attribute__((ext_vector_type(2)));
DEVI unsigned pkbf(float a, float b) {
  const float2_t f = {a, b};
  const bf16x2_t h = __builtin_convertvector(f, bf16x2_t);
  return __builtin_bit_cast(unsigned, h);
}
DEVI void unpack8(uint4 v, float* f) {
  f[0] = __uint_as_float(v.x << 16); f[1] = __uint_as_float(v.x & 0xffff0000u);
  f[2] = __uint_as_float(v.y << 16); f[3] = __uint_as_float(v.y & 0xffff0000u);
  f[4] = __uint_as_float(v.z << 16); f[5] = __uint_as_float(v.z & 0xffff0000u);
  f[6] = __uint_as_float(v.w << 16); f[7] = __uint_as_float(v.w & 0xffff0000u);
}
DEVI uint4 pack8(const float* f) {
  uint4 r;
  r.x = pkbf(f[0], f[1]);
  r.y = pkbf(f[2], f[3]);
  r.z = pkbf(f[4], f[5]);
  r.w = pkbf(f[6], f[7]);
  return r;
}
DEVI void unpack4(uint2 v, float* f) {
  f[0] = __uint_as_float(v.x << 16); f[1] = __uint_as_float(v.x & 0xffff0000u);
  f[2] = __uint_as_float(v.y << 16); f[3] = __uint_as_float(v.y & 0xffff0000u);
}
DEVI uint2 pack4(const float* f) {
  uint2 r;
  r.x = pkbf(f[0], f[1]);
  r.y = pkbf(f[2], f[3]);
  return r;
}

DEVI float sigmoid_(float x) { return __builtin_amdgcn_rcpf(1.f + __expf(-x)); }
DEVI float silu_(float x) { return x * sigmoid_(x); }
DEVI float tanh_(float y) { return 1.f - 2.f * __builtin_amdgcn_rcpf(1.f + __expf(2.f * y)); }
DEVI float gelu_(float x) {
  const float y = 0.7978845608028654f * (x + 0.044715f * x * x * x);
  return x * __builtin_amdgcn_rcpf(1.f + __expf(-2.f * y));
}
DEVI float wave_sum(float v) {
#pragma unroll
  for (int o = 32; o > 0; o >>= 1) v += __shfl_xor(v, o);
  return v;
}
DEVI float wave_max(float v) {
#pragma unroll
  for (int o = 32; o > 0; o >>= 1) v = fmaxf(v, __shfl_xor(v, o));
  return v;
}
template <int CTRL>
DEVI float dppf(float x) {
  return __int_as_float(__builtin_amdgcn_update_dpp(0, __float_as_int(x), CTRL, 0xF, 0xF, true));
}
DEVI float reduce16(float x) {
  x += dppf<0xB1>(x);
  x += dppf<0x4E>(x);
  x += dppf<0x141>(x);
  x += dppf<0x140>(x);
  return x;
}

constexpr int LROW = 72;
constexpr int GSTAGE = 2 * 128 * LROW;

template <int DIST = 2, bool SW = true, class ALoad, class Epi>
DEVI void gemm_tile(char* smem, const ALoad& aload, const bfu* __restrict__ Bt, int ldb, int K, int m0, int n0,
                    const Epi& epi) {
  bfu* sbase = (bfu*)smem;
  const int tid = TIDX, lane = tid & 63, wid = tid >> 6, wr = wid >> 1, wc = wid & 1;
  const int fr = lane & 15, fq = lane >> 4;
  f32x4 acc[4][4];
#pragma unroll
  for (int i = 0; i < 4; ++i)
#pragma unroll
    for (int j = 0; j < 4; ++j) acc[i][j] = f32x4{0.f, 0.f, 0.f, 0.f};
  const int r0 = tid >> 3, kc = (tid & 7) * 8;
  const int nk = K >> 6;
  struct GRegs { typename ALoad::Raw a0, a1, a2, a3; uint4 ap, b0, b1, b2, b3; };
  GRegs g0, g1;
  const bfu* Bp = Bt + (size_t)(n0 + r0) * ldb + kc;
  const size_t ldb32 = (size_t)ldb * 32;
  constexpr int ARS = ALoad::kConsec ? 1 : 32;
  const int ar0 = ALoad::kConsec ? 4 * r0 : r0;
#define GEMM_ISSUE(R, KT)                                   \
  {                                                         \
    const int k0_ = ((KT) << 6);                            \
    R.ap = aload.loadprev(m0 + ar0, k0_ + kc);              \
    R.a0 = aload.load(m0 + ar0, k0_ + kc);                  \
    R.a1 = aload.load(m0 + ar0 + ARS, k0_ + kc);            \
    R.a2 = aload.load(m0 + ar0 + 2 * ARS, k0_ + kc);        \
    R.a3 = aload.load(m0 + ar0 + 3 * ARS, k0_ + kc);        \
    R.b0 = *(const uint4*)(Bp + k0_);                       \
    R.b1 = *(const uint4*)(Bp + ldb32 + k0_);               \
    R.b2 = *(const uint4*)(Bp + 2 * ldb32 + k0_);           \
    R.b3 = *(const uint4*)(Bp + 3 * ldb32 + k0_);           \
  }
#define GEMM_COMMIT(R, S, KT)                               \
  {                                                         \
    const int k1_ = ((KT) << 6) + kc;                       \
    bfu* A_ = sbase + (S) * GSTAGE + ar0 * LROW + kc;       \
    bfu* B_ = sbase + (S) * GSTAGE + 128 * LROW + r0 * LROW + kc;   \
    *(uint4*)(A_) = aload.finish(R.a0, R.ap, m0 + ar0, k1_);                                 \
    *(uint4*)(A_ + ARS * LROW) = aload.finish(R.a1, aload.asprev(R.a0), m0 + ar0 + ARS, k1_);          \
    *(uint4*)(A_ + 2 * ARS * LROW) = aload.finish(R.a2, aload.asprev(R.a1), m0 + ar0 + 2 * ARS, k1_);  \
    *(uint4*)(A_ + 3 * ARS * LROW) = aload.finish(R.a3, aload.asprev(R.a2), m0 + ar0 + 3 * ARS, k1_);  \
    *(uint4*)(B_) = R.b0;                                   \
    *(uint4*)(B_ + 32 * LROW) = R.b1;                       \
    *(uint4*)(B_ + 64 * LROW) = R.b2;                       \
    *(uint4*)(B_ + 96 * LROW) = R.b3;                       \
  }
#define GEMM_COMPUTE(S)                                                                          \
  {                                                                                              \
    const bfu* cA = sbase + (S) * GSTAGE;                                                        \
    const bfu* cB = cA + 128 * LROW;                                                             \
    _Pragma("unroll") for (int ks = 0; ks < 2; ++ks) {                                           \
      bf16x8 af[4], bfv[4];                                                                      \
      _Pragma("unroll") for (int i = 0; i < 4; ++i) {                                            \
        af[i] = *(const bf16x8*)(cA + (wr * 64 + i * 16 + fr) * LROW + ks * 32 + fq * 8);        \
        bfv[i] = *(const bf16x8*)(cB + (wc * 64 + i * 16 + fr) * LROW + ks * 32 + fq * 8);       \
      }                                                                                          \
      _Pragma("unroll") for (int i = 0; i < 4; ++i) _Pragma("unroll") for (int j = 0; j < 4; ++j) \
          acc[i][j] = SW ? __builtin_amdgcn_mfma_f32_16x16x32_bf16(bfv[j], af[i], acc[i][j], 0, 0, 0)     \
                         : __builtin_amdgcn_mfma_f32_16x16x32_bf16(af[i], bfv[j], acc[i][j], 0, 0, 0);    \
    }                                                                                            \
  }
  const int nkm1 = nk - 1;
  if (DIST == 2 && nk == 1) {
    GEMM_ISSUE(g0, 0);
    GEMM_COMMIT(g0, 0, 0);
    __syncthreads();
    GEMM_COMPUTE(0);
    __syncthreads();
  } else if (DIST == 2) {
    GEMM_ISSUE(g0, 0);
    GEMM_ISSUE(g1, (1 < nkm1 ? 1 : nkm1));
    GEMM_COMMIT(g0, 0, 0);
    GEMM_ISSUE(g0, (2 < nkm1 ? 2 : nkm1));
    __syncthreads();
    {
      for (int kt = 0; kt < nk; kt += 2) {
        GEMM_COMMIT(g1, 1, (kt + 1 < nkm1 ? kt + 1 : nkm1));
        GEMM_ISSUE(g1, (kt + 3 < nkm1 ? kt + 3 : nkm1));
        GEMM_COMPUTE(0);
        __syncthreads();
        GEMM_COMMIT(g0, 0, (kt + 2 < nkm1 ? kt + 2 : nkm1));
        GEMM_ISSUE(g0, (kt + 4 < nkm1 ? kt + 4 : nkm1));
        GEMM_COMPUTE(1);
        __syncthreads();
      }
    }
  } else {
    GEMM_ISSUE(g0, 0);
    GEMM_COMMIT(g0, 0, 0);
    GEMM_ISSUE(g0, (1 < nkm1 ? 1 : nkm1));
    __syncthreads();
    for (int kt = 0; kt < nk; kt += 2) {
      GEMM_COMMIT(g0, 1, (kt + 1 < nkm1 ? kt + 1 : nkm1));
      GEMM_ISSUE(g0, (kt + 2 < nkm1 ? kt + 2 : nkm1));
      GEMM_COMPUTE(0);
      __syncthreads();
      GEMM_COMMIT(g0, 0, (kt + 2 < nkm1 ? kt + 2 : nkm1));
      GEMM_ISSUE(g0, (kt + 3 < nkm1 ? kt + 3 : nkm1));
      GEMM_COMPUTE(1);
      __syncthreads();
    }
  }
#pragma unroll
  for (int i = 0; i < 4; ++i)
#pragma unroll
    for (int j = 0; j < 4; ++j) {
      if (SW) epi(m0 + wr * 64 + i * 16 + fr, n0 + wc * 64 + j * 16 + fq * 4, acc[i][j]);
      else epi(m0 + wr * 64 + i * 16 + fq * 4, n0 + wc * 64 + j * 16 + fr, acc[i][j]);
    }
}

namespace pg8 {
#define PG8_LAS __attribute__((address_space(3)))
typedef unsigned short bf16_t;
typedef short bf16x8 __attribute__((ext_vector_type(8)));
typedef float f32x4 __attribute__((ext_vector_type(4)));
typedef unsigned u32x4 __attribute__((ext_vector_type(4)));
constexpr int BM = 256, BK = 64, HALF = 128, HTB = HALF * BK * 2  , STAGE_BYTES = 8 * HTB, NXCD = 8, WGM = 8;

__host__ __device__ __forceinline__ int lds_byte(int r, int c) { const int st = (r >> 4) * 2 + (c >> 5), rr = r & 15, cc = c & 31, ob = rr * 64 + cc * 2; return st * 1024 + (ob ^ (((ob >> 9) & 1) << 5)); }
__host__ __device__ __forceinline__ void stage_rc(int b, int& R, int& C) { const int st = b / 1024, sb = b % 1024, swz = sb ^ (((sb >> 9) & 1) << 5); R = (st >> 1) * 16 + swz / 64; C = (st & 1) * 32 + (swz % 64) / 2; }
__host__ __device__ __forceinline__ int perm32(int rho) { const int n = rho >> 4, i = rho & 15; return 8 * (i >> 2) + 4 * n + (i & 3); }

struct Unit { int pm, pn; };
struct Gemm { const bf16_t* A; const bf16_t* Bt; int M, N, K; const bf16_t* A2; int pn_split; unsigned long long rmap, cmap;
  __device__ __forceinline__ size_t rt(int pm) const { return rmap ? (size_t)((rmap >> (4 * pm)) & 15ull) : (size_t)pm; }
  __device__ __forceinline__ size_t ct(int pn) const { return cmap ? (size_t)((cmap >> (4 * pn)) & 15ull) : (size_t)pn; } };

struct StaticOrder {
    int nM, nN, nwg, G, c;
    __host__ __device__ void init(int M, int N, int G_, int c_) { nM = M / BM; nN = N / BM; nwg = nM * nN; G = G_; c = c_; }
    __host__ __device__ bool next(int i, Unit& u) const {
        const long L = (long)i * G + c; if (L >= nwg) return false;
        int wgid = (int)L; { const int q = nwg / NXCD, r = nwg % NXCD, xcd = wgid % NXCD, off = wgid / NXCD; wgid = (xcd < r ? xcd * (q + 1) : r * (q + 1) + (xcd - r) * q) + off; }
        const int nig = WGM * nN, gid = wgid / nig, fm = gid * WGM, gsz = (nM - fm) < WGM ? (nM - fm) : WGM;
        u.pm = fm + ((wgid % nig) % gsz); u.pn = (wgid % nig) / gsz; return true;
    }
    __device__ __forceinline__ void a_ready(const Unit&) const {}
    __device__ __forceinline__ void done(const Unit&) const {}
};
struct CountedOrder : StaticOrder {
    const unsigned* ready; unsigned need; unsigned* tmo;
    __device__ __forceinline__ void a_ready(const Unit& u) const {
        if (threadIdx.x < 64) {
            const unsigned long long t0 = __builtin_amdgcn_s_memrealtime(); unsigned polls = 0;
            while ((unsigned)__builtin_amdgcn_readfirstlane(__hip_atomic_load(ready + 64 * u.pm, __ATOMIC_RELAXED, __HIP_MEMORY_SCOPE_AGENT)) < need) {
                if ((++polls & 255u) == 0u && __builtin_amdgcn_readfirstlane(__hip_atomic_load(tmo, __ATOMIC_RELAXED, __HIP_MEMORY_SCOPE_AGENT)) != 0u) break;
                if (__builtin_amdgcn_s_memrealtime() - t0 > 2000000ull) {
                    if (threadIdx.x == 0) { unsigned expect = 0u; __hip_atomic_compare_exchange_strong(tmo + 1, &expect, 0x600u | (unsigned)(u.pm & 0xff), __ATOMIC_RELAXED, __ATOMIC_RELAXED, __HIP_MEMORY_SCOPE_AGENT); __hip_atomic_store(tmo, 1u, __ATOMIC_RELAXED, __HIP_MEMORY_SCOPE_AGENT); }
                    break; }
                __builtin_amdgcn_s_sleep(2); }
            __builtin_amdgcn_fence(__ATOMIC_ACQUIRE, "agent");
            asm volatile("s_waitcnt vmcnt(0)" ::: "memory");
        }
#if !defined(BROKEN_HOOK_NO_BARRIER)
        asm volatile("" ::: "memory"); __builtin_amdgcn_s_barrier(); asm volatile("" ::: "memory");
#endif
    }
};

__device__ __forceinline__ unsigned cvt_pk_bf16(float lo, float hi) { unsigned r; asm volatile("v_cvt_pk_bf16_f32 %0, %1, %2" : "=v"(r) : "v"(lo), "v"(hi)); return r; }
typedef float f32x2 __attribute__((ext_vector_type(2)));
__device__ __forceinline__ f32x2 gelu_pk(f32x2 v) {
    const f32x2 av = __builtin_elementwise_abs(v), d = av * 0.2316418882f + 1.0f;
    f32x2 t; t.x = __builtin_amdgcn_rcpf(d.x); t.y = __builtin_amdgcn_rcpf(d.y);
    f32x2 q = t * 0.5307027145f + (-0.7265760135f); q = q * t + 0.7107068705f; q = q * t + (-0.142248368f); q = q * t + 0.127414796f; q = q * t;
    const f32x2 s = (v * v) * (-0.72134752044f);
    f32x2 e; e.x = __builtin_amdgcn_exp2f(s.x); e.y = __builtin_amdgcn_exp2f(s.y);
    const f32x2 m = v * (q * e), r = v - m;
    f32x2 o; o.x = v.x < 0.f ? m.x : r.x; o.y = v.y < 0.f ? m.y : r.y; return o;
}

struct EpiF32 {
    static constexpr bool PERM = false, AFTER_DRAIN = false;
    float* C; int ldc; const float* bias;
    __device__ __forceinline__ void operator()(const f32x4 (&acc)[2][2][4][2], const Unit& u, int wr, int wc, int fr, int fq) const {
        const int row0 = u.pm * BM + wr * 64 + fr, col0 = u.pn * BM + wc * 32 + 4 * fq;
        f32x4 bv[2][2];
#pragma unroll
        for (int bj = 0; bj < 2; ++bj)
#pragma unroll
            for (int n = 0; n < 2; ++n) bv[bj][n] = bias ? *(const f32x4*)(bias + col0 + bj * HALF + n * 16) : (f32x4){0.f, 0.f, 0.f, 0.f};
#pragma unroll
        for (int ai = 0; ai < 2; ++ai)
#pragma unroll
            for (int m = 0; m < 4; ++m) { float* rowp = C + (size_t)(row0 + ai * HALF + m * 16) * ldc + col0;
#pragma unroll
                for (int bj = 0; bj < 2; ++bj)
#pragma unroll
                    for (int n = 0; n < 2; ++n) *(f32x4*)(rowp + bj * HALF + n * 16) = acc[ai][bj][m][n] + bv[bj][n]; }
    }
};
template <int ACT  > struct EpiBf16 {
    static constexpr bool PERM = true, AFTER_DRAIN = false;
    bf16_t* O; int ldc; const float* bias; int split_cols; size_t split_stride;
    __device__ __forceinline__ void operator()(const f32x4 (&acc)[2][2][4][2], const Unit& u, int wr, int wc, int fr, int fq) const {
        const int row0 = u.pm * BM + wr * 64 + fr; int colt = u.pn * BM; bf16_t* base = O;
        if (split_cols) { const int t = colt / split_cols; base += (size_t)t * split_stride; colt -= t * split_cols; }
        const int col0 = colt + wc * 32 + 8 * fq, bcol0 = u.pn * BM + wc * 32 + 8 * fq;
        f32x4 bv[2][2];
#pragma unroll
        for (int bj = 0; bj < 2; ++bj)
#pragma unroll
            for (int n = 0; n < 2; ++n) bv[bj][n] = bias ? *(const f32x4*)(bias + bcol0 + bj * HALF + 4 * n) : (f32x4){0.f, 0.f, 0.f, 0.f};
#pragma unroll
        for (int ai = 0; ai < 2; ++ai)
#pragma unroll
            for (int m = 0; m < 4; ++m) { bf16_t* rowp = base + (size_t)(row0 + ai * HALF + m * 16) * ldc + col0;
#pragma unroll
                for (int bj = 0; bj < 2; ++bj) { f32x4 v0 = acc[ai][bj][m][0] + bv[bj][0], v1 = acc[ai][bj][m][1] + bv[bj][1];
                    if (ACT == 1) { f32x2 a = gelu_pk((f32x2){v0[0], v0[1]}), b = gelu_pk((f32x2){v0[2], v0[3]}), c = gelu_pk((f32x2){v1[0], v1[1]}), d = gelu_pk((f32x2){v1[2], v1[3]});
                        v0 = (f32x4){a.x, a.y, b.x, b.y}; v1 = (f32x4){c.x, c.y, d.x, d.y}; }
                    if (ACT == 2) {
#pragma unroll
                        for (int j = 0; j < 4; ++j) { v0[j] = 0.5f * v0[j] * (1.0f + erff(v0[j] * 0.70710678f)); v1[j] = 0.5f * v1[j] * (1.0f + erff(v1[j] * 0.70710678f)); } }
                    u32x4 w; w.x = cvt_pk_bf16(v0[0], v0[1]); w.y = cvt_pk_bf16(v0[2], v0[3]); w.z = cvt_pk_bf16(v1[0], v1[1]); w.w = cvt_pk_bf16(v1[2], v1[3]);
                    *(u32x4*)(rowp + bj * HALF) = w; } }
    }
};


template <class Epi, class Sched, bool STAMP = false>
__device__ __forceinline__ void gemm_phase(PG8_LAS unsigned char* lds, const Gemm g, const Sched& S, const Epi& E, unsigned long long* stamps) {
    const int tid = threadIdx.x, wid = __builtin_amdgcn_readfirstlane(tid >> 6), lane = tid & 63, wr = wid >> 2, wc = wid & 3, fr = lane & 15, fq = lane >> 4;
    const int K = g.K, nt = K / BK;
    int ts_lo = 0, ts_hi = 0, nts = 0; const unsigned long long rt_entry = STAMP ? (unsigned long long)wall_clock64() : 0ull;
#define PG8_STAMP() do { if (STAMP && wid == 0 && nts < 64) { const unsigned long long _c = (unsigned long long)clock64(); \
        ts_lo = (lane == nts) ? (int)(unsigned)_c : ts_lo; ts_hi = (lane == nts) ? (int)(unsigned)(_c >> 32) : ts_hi; ++nts; } } while (0)
    PG8_STAMP();
    unsigned voffA[2], voffB[2];
#pragma unroll
    for (int i = 0; i < 2; ++i) { int R, C; stage_rc(tid * 16 + i * 8192, R, C); const int Rb = Epi::PERM ? ((R & ~31) + perm32(R & 31)) : R;
        voffA[i] = (unsigned)(R * K + C) * 2u; voffB[i] = (unsigned)(Rb * K + C) * 2u; }
    const size_t kstep = (size_t)(BK * 2);
    const size_t hstep = (size_t)HALF * K * 2;
    const size_t tstep = 2 * hstep;
    const unsigned ldsw = (unsigned)wid * 1024u;
    const int aoff = lds_byte(wr * 64 + fr, fq * 8), boff = lds_byte(wc * 32 + fr, fq * 8);
#define PG8_SA(b, h) (((b) * 2 + (h)) * HTB)
#define PG8_SB(b, h) ((4 + (b) * 2 + (h)) * HTB)
#define PG8_STAGE(bufoff, gbase, voff) do { _Pragma("unroll") for (int _i = 0; _i < 2; ++_i) \
        __builtin_amdgcn_global_load_lds((const unsigned*)((const char*)(gbase) + (voff)[_i]), (PG8_LAS unsigned*)(lds + (bufoff) + ldsw + _i * 8192), 16, 0, 0); } while (0)
#define PG8_LDA(dst, b, h) do { _Pragma("unroll") for (int m = 0; m < 4; ++m) _Pragma("unroll") for (int k = 0; k < 2; ++k) dst[m][k] = *(const PG8_LAS bf16x8*)(lds + PG8_SA(b, h) + aoff + m * 2048 + k * 1024); } while (0)
#define PG8_LDB(dst, b, h) do { _Pragma("unroll") for (int n = 0; n < 2; ++n) _Pragma("unroll") for (int k = 0; k < 2; ++k) dst[n][k] = *(const PG8_LAS bf16x8*)(lds + PG8_SB(b, h) + boff + n * 2048 + k * 1024); } while (0)
#define PG8_MMA(ai, bj, At, Bt) do { __builtin_amdgcn_s_setprio(1); _Pragma("unroll") for (int m = 0; m < 4; ++m) _Pragma("unroll") for (int n = 0; n < 2; ++n) _Pragma("unroll") for (int k = 0; k < 2; ++k) \
        acc[ai][bj][m][n] = __builtin_amdgcn_mfma_f32_16x16x32_bf16(Bt[n][k], At[m][k], acc[ai][bj][m][n], 0, 0, 0); __builtin_amdgcn_s_setprio(0); } while (0)
#define PG8_WAIT_V(n) asm volatile("s_waitcnt vmcnt(" #n ")" ::: "memory")
#define PG8_WAIT_L(n) asm volatile("s_waitcnt lgkmcnt(" #n ")" ::: "memory")
#define PG8_BAR __builtin_amdgcn_s_barrier()
#define PG8_SCHED __builtin_amdgcn_sched_barrier(0)
    Unit cur, nxt; int ui = 0;
    if (!S.next(0, cur)) return;
    f32x4 acc[2][2][4][2];
#pragma unroll
    for (int a = 0; a < 2; ++a)
#pragma unroll
        for (int b = 0; b < 2; ++b)
#pragma unroll
            for (int m = 0; m < 4; ++m)
#pragma unroll
                for (int n = 0; n < 2; ++n) acc[a][b][m][n] = (f32x4){0.f, 0.f, 0.f, 0.f};
    bf16x8 At[4][2], B0[2][2], B1[2][2];
    const char* cA = (const char*)(cur.pn >= g.pn_split ? g.A2 : g.A) + g.rt(cur.pm) * tstep; const char* cB = (const char*)g.Bt + g.ct(cur.pn) * tstep;
    S.a_ready(cur);
    PG8_STAGE(PG8_SB(0, 0), cB, voffB); PG8_STAGE(PG8_SA(0, 0), cA, voffA); PG8_STAGE(PG8_SB(0, 1), cB + hstep, voffB); PG8_STAGE(PG8_SA(0, 1), cA + hstep, voffA);
    if (wr == 1) PG8_BAR;
    PG8_WAIT_V(4); PG8_BAR;
    PG8_STAGE(PG8_SB(1, 0), cB + kstep, voffB); PG8_STAGE(PG8_SA(1, 0), cA + kstep, voffA); PG8_STAGE(PG8_SB(1, 1), cB + hstep + kstep, voffB);
    PG8_WAIT_V(6); PG8_BAR;
    PG8_STAMP();
    for (;;) {
        const bool has_next = S.next(ui + 1, nxt);
        const char* nA = has_next ? (const char*)(nxt.pn >= g.pn_split ? g.A2 : g.A) + g.rt(nxt.pm) * tstep : cA; const char* nB = has_next ? (const char*)g.Bt + g.ct(nxt.pn) * tstep : cB;
        for (int t = 0; t < nt; t += 2) {
            const bool last = (t == nt - 2);
            const char* a1 = cA + (size_t)(t + 1) * kstep;
            const char* a2 = last ? nA : cA + (size_t)(t + 2) * kstep; const char* b2 = last ? nB : cB + (size_t)(t + 2) * kstep;
            const char* a3 = a2 + kstep; const char* b3 = b2 + kstep;
            if (last && has_next) S.a_ready(nxt);
            PG8_LDB(B0, 0, 0); PG8_SCHED; PG8_LDA(At, 0, 0); PG8_STAGE(PG8_SA(1, 1), a1 + hstep, voffA);
            PG8_WAIT_L(8); PG8_BAR; PG8_WAIT_L(0); PG8_MMA(0, 0, At, B0); PG8_BAR; PG8_SCHED;
            PG8_LDB(B1, 0, 1); PG8_STAGE(PG8_SB(0, 0), b2, voffB);
            PG8_BAR; PG8_WAIT_L(0); PG8_MMA(0, 1, At, B1); PG8_BAR;
            PG8_LDA(At, 0, 1); PG8_STAGE(PG8_SA(0, 0), a2, voffA);
            PG8_BAR; PG8_WAIT_L(0); PG8_MMA(1, 0, At, B0); PG8_BAR; PG8_SCHED;
            PG8_STAGE(PG8_SB(0, 1), b2 + hstep, voffB);
            PG8_WAIT_V(6); PG8_BAR; PG8_MMA(1, 1, At, B1); PG8_BAR;
            PG8_LDB(B0, 1, 0); PG8_SCHED; PG8_LDA(At, 1, 0); PG8_STAGE(PG8_SA(0, 1), a2 + hstep, voffA);
            PG8_WAIT_L(8); PG8_BAR; PG8_WAIT_L(0); PG8_MMA(0, 0, At, B0); PG8_BAR; PG8_SCHED;
            PG8_LDB(B1, 1, 1); PG8_STAGE(PG8_SB(1, 0), b3, voffB);
            PG8_BAR; PG8_WAIT_L(0); PG8_MMA(0, 1, At, B1); PG8_BAR;
            PG8_LDA(At, 1, 1); PG8_STAGE(PG8_SA(1, 0), a3, voffA);
            PG8_BAR; PG8_WAIT_L(0); PG8_MMA(1, 0, At, B0); PG8_BAR; PG8_SCHED;
            PG8_STAGE(PG8_SB(1, 1), b3 + hstep, voffB);
            PG8_WAIT_V(6); PG8_BAR; PG8_MMA(1, 1, At, B1); PG8_BAR;
        }
        PG8_STAMP();
        if constexpr (!Epi::AFTER_DRAIN) { E(acc, cur, wr, wc, fr, fq); S.done(cur); }
        PG8_STAMP();
        if (!has_next) break;
#pragma unroll
        for (int a = 0; a < 2; ++a)
#pragma unroll
            for (int b = 0; b < 2; ++b)
#pragma unroll
                for (int m = 0; m < 4; ++m)
#pragma unroll
                    for (int n = 0; n < 2; ++n) acc[a][b][m][n] = (f32x4){0.f, 0.f, 0.f, 0.f};
        cur = nxt; cA = nA; cB = nB; ++ui;
    }
    PG8_WAIT_V(0);
    if (wr == 0) PG8_BAR;
    PG8_BAR;
    if constexpr (Epi::AFTER_DRAIN) { E.fused(acc, cur, wr, wc, fr, fq, lds, wid, lane); S.done(cur); }
    PG8_STAMP();
    if (STAMP && wid == 0) { stamps[lane] = lane < nts ? (((unsigned long long)(unsigned)ts_hi << 32) | (unsigned)ts_lo) : 0ull;
        if (lane == 62) stamps[62] = rt_entry; if (lane == 63) stamps[63] = (unsigned long long)wall_clock64(); }
#undef PG8_STAMP
#undef PG8_SA
#undef PG8_SB
#undef PG8_STAGE
#undef PG8_LDA
#undef PG8_LDB
#undef PG8_MMA
#undef PG8_WAIT_V
#undef PG8_WAIT_L
#undef PG8_BAR
#undef PG8_SCHED
}
}

struct TileSched {
  int xcd, local, vbid, vnb, MT, NT, SM, SN, j, snc;
  bool swz;
  DEVI TileSched(int bid, int nb, int half, int MT_, int NT_, int SM_, int SN_) : MT(MT_), NT(NT_), SM(SM_), SN(SN_), j(0) {
    xcd = bid & 7;
    local = (bid >> 3) * 2 + half;
    vbid = bid * 2 + half;
    vnb = nb * 2;
    swz = (vnb == 8 * SM * SN) && ((nb & 7) == 0);
    snc = (NT + SN - 1) / SN;
  }
  DEVI int next(int& mt, int& nt) {
    if (swz) {
      const int s = j * 8 + xcd;
      ++j;
      const int sm = s / snc, sn = s - sm * snc;
      if (sm * SM >= MT) return 0;
      mt = sm * SM + local / SN;
      nt = sn * SN + local % SN;
      return (mt < MT && nt < NT) ? 1 : 2;
    } else {
      const int it = vbid + j * vnb;
      ++j;
      if (it >= MT * NT) return 0;
      mt = it / NT;
      nt = it - mt * NT;
      return 1;
    }
  }
};

struct ALoadPlain {
  typedef uint4 Raw;
  static constexpr bool kFat = false;
  static constexpr bool kConsec = false;
  const bfu* A;
  int lda;
  DEVI Raw load(int row, int k) const { return *(const uint4*)(A + (size_t)row * lda + k); }
  DEVI uint4 loadprev(int, int) const { return uint4{0u, 0u, 0u, 0u}; }
  DEVI uint4 asprev(const Raw&) const { return uint4{0u, 0u, 0u, 0u}; }
  DEVI uint4 finish(const Raw& r, const uint4&, int, int) const { return r; }
};

DEVI void transpose_tile(char* smem, const float* __restrict__ src, int Ns, bfu* __restrict__ dst, int ldd, int noff,
                         int k0, int n0) {
  float(*tile)[65] = (float(*)[65])smem;
  const int tid = TIDX;
  const int kr = tid >> 4, nc = (tid & 15) * 4;
#pragma unroll
  for (int p = 0; p < 4; ++p) {
    float4 v = *(const float4*)(src + (size_t)(k0 + kr + 16 * p) * Ns + n0 + nc);
    tile[kr + 16 * p][nc] = v.x;
    tile[kr + 16 * p][nc + 1] = v.y;
    tile[kr + 16 * p][nc + 2] = v.z;
    tile[kr + 16 * p][nc + 3] = v.w;
  }
  __syncthreads();
  const int nr = tid >> 3, kc = (tid & 7) * 8;
#pragma unroll
  for (int p = 0; p < 2; ++p) {
    const int n = nr + 32 * p;
    float f[8];
#pragma unroll
    for (int j = 0; j < 8; ++j) f[j] = tile[kc + j][n];
    *(uint4*)(dst + (size_t)(noff + n0 + n) * ldd + k0 + kc) = pack8(f);
  }
  __syncthreads();
}

DEVI void rms_row2_bf16(const float* __restrict__ src, const float* __restrict__ g, bfu* __restrict__ dst, int lane) {
  float4 v[2][4];
  float ss[2] = {0.f, 0.f};
#pragma unroll
  for (int r = 0; r < 2; ++r)
#pragma unroll
    for (int i = 0; i < 4; ++i) v[r][i] = *(const float4*)(src + r * 1024 + lane * 4 + 256 * i);
#pragma unroll
  for (int r = 0; r < 2; ++r)
#pragma unroll
    for (int i = 0; i < 4; ++i)
      ss[r] += v[r][i].x * v[r][i].x + v[r][i].y * v[r][i].y + v[r][i].z * v[r][i].z + v[r][i].w * v[r][i].w;
#pragma unroll
  for (int r = 0; r < 2; ++r) {
    const float rinv = rsqrtf(wave_sum(ss[r]) * (1.f / 1024.f) + 1e-6f);
#pragma unroll
    for (int i = 0; i < 4; ++i) {
      const float4 gg = *(const float4*)(g + lane * 4 + 256 * i);
      uint2 o;
      o.x = pkbf(v[r][i].x * rinv * gg.x, v[r][i].y * rinv * gg.y);
      o.y = pkbf(v[r][i].z * rinv * gg.z, v[r][i].w * rinv * gg.w);
      *(uint2*)(dst + r * 1024 + lane * 4 + 256 * i) = o;
    }
  }
}

DEVI void phase0(const Params& p, char* smem, int bid, int nb) {
  constexpr int NT_IN = 16 * 56, NT_SQ = 256, NT_SM = 16;
  constexpr int c0 = NT_IN, c1 = c0 + NT_SQ, c2 = c1 + 4 * NT_SQ, c3 = c2 + NT_SM, c4 = c3 + NT_SM, c5 = c4 + NT_SQ,
                c6 = c5 + NT_SM, c7 = c6 + NT_SM, c8 = c7 + 2, c9 = c8 + T_TOK / 8;
  smem += HF * HALF_SMEM;
  for (int it = bid * 2 + HF; it < c9; it += nb * 2) {
    if (it < c0) {
      transpose_tile(smem, p.w_in, 3584, p.WT_in, 1024, 0, (it / 56) * 64, (it % 56) * 64);
    } else if (it < c1) {
      int j = it - c0;
      transpose_tile(smem, p.w_out, 1024, p.WT_out, 1024, 0, (j >> 4) * 64, (j & 15) * 64);
    } else if (it < c2) {
      int j = it - c1;
      int w = j >> 8;
      j &= 255;
      const float* src = (w == 0) ? p.wr : (w == 1) ? p.wk : (w == 2) ? p.wv : p.wg;
      transpose_tile(smem, src, 1024, p.WT_3, 1024, w * 1024, (j >> 4) * 64, (j & 15) * 64);
    } else if (it < c3) {
      int j = it - c2;
      transpose_tile(smem, p.w1, 64, p.WT_3, 1024, 4096, j * 64, 0);
    } else if (it < c4) {
      int j = it - c3;
      transpose_tile(smem, p.a1, 64, p.WT_3, 1024, 4224, j * 64, 0);
    } else if (it < c5) {
      int j = it - c4;
      transpose_tile(smem, p.wo, 1024, p.WT_o, 1024, 0, (j >> 4) * 64, (j & 15) * 64);
    } else if (it < c6) {
      int j = it - c5;
      transpose_tile(smem, p.w2, 1024, p.W2T, 64, 0, 0, j * 64);
    } else if (it < c7) {
      int j = it - c6;
      transpose_tile(smem, p.a2, 1024, p.A2T, 64, 0, 0, j * 64);
    } else if (it < c8) {
      int j = it - c7;
      bfu* dst = p.WT_3 + (size_t)(j == 0 ? 4160 : 4288) * 1024;
      for (int e = TIDX; e < 64 * 1024 / 8; e += 256) *(uint4*)(dst + e * 8) = uint4{0, 0, 0, 0};
    } else {
      int row = (it - c8) * 8 + (TIDX >> 6) * 2;
      rms_row2_bf16(p.x + (size_t)row * 1024, p.ln_even, p.H + (size_t)row * 1024, TIDX & 63);
    }
  }
}

constexpr unsigned long long kCmap1 = 0xDCBA765410ull;
struct PgEpi1 {
  static constexpr bool PERM = true, AFTER_DRAIN = false;
  const Params* p;
  DEVI void operator()(const pg8::f32x4 (&acc)[2][2][4][2], const pg8::Unit& u, int wr, int wc, int fr, int fq) const {
    const int row0 = u.pm * 256 + wr * 64 + fr;
    const int seg = (int)((kCmap1 >> (4 * u.pn)) & 15ull);
#pragma unroll
    for (int ai = 0; ai < 2; ++ai)
#pragma unroll
      for (int m = 0; m < 4; ++m) {
        const int row = row0 + ai * 128 + m * 16;
#pragma unroll
        for (int bj = 0; bj < 2; ++bj) {
          const int col = seg * 256 + bj * 128 + wc * 32 + 8 * fq;
          const f32x4 v0 = acc[ai][bj][m][0], v1 = acc[ai][bj][m][1];
          uint4 w;
          if (seg < 2) {
            w.x = pkbf(gelu_(v0[0]), gelu_(v0[1])); w.y = pkbf(gelu_(v0[2]), gelu_(v0[3]));
            w.z = pkbf(gelu_(v1[0]), gelu_(v1[1])); w.w = pkbf(gelu_(v1[2]), gelu_(v1[3]));
            *(uint4*)(p->U + (size_t)row * 512 + col) = w;
          } else if (seg < 8) {
            w.x = pkbf(v0[0], v0[1]); w.y = pkbf(v0[2], v0[3]); w.z = pkbf(v1[0], v1[1]); w.w = pkbf(v1[2], v1[3]);
            bfu* dst = (seg < 6) ? p->Q + (size_t)row * 512 + (col - 1024) : p->K + (size_t)row * 512 + (col - 1536);
            *(uint4*)dst = w;
          } else {
            w.x = pkbf(silu_(v0[0]), silu_(v0[1])); w.y = pkbf(silu_(v0[2]), silu_(v0[3]));
            w.z = pkbf(silu_(v1[0]), silu_(v1[1])); w.w = pkbf(silu_(v1[2]), silu_(v1[3]));
            *(uint4*)(p->SZ + (size_t)row * 1024 + (col - 2560)) = w;
          }
        }
      }
  }
};
constexpr unsigned long long kRmap1 = 0x9832ull;
struct PgEpi1T {
  static constexpr bool PERM = true, AFTER_DRAIN = false;
  const Params* p;
  DEVI void operator()(const pg8::f32x4 (&acc)[2][2][4][2], const pg8::Unit& u, int wr, int wc, int fr, int fq) const {
    const int ch0 = (u.pm & 1) * 256 + wr * 64 + fr;
    const bool isv = u.pm >= 2;
#pragma unroll
    for (int ai = 0; ai < 2; ++ai)
#pragma unroll
      for (int m = 0; m < 4; ++m) {
        const int ch = ch0 + ai * 128 + m * 16;
#pragma unroll
        for (int bj = 0; bj < 2; ++bj) {
          const int t = u.pn * 256 + bj * 128 + wc * 32 + 8 * fq;
          const f32x4 v0 = acc[ai][bj][m][0], v1 = acc[ai][bj][m][1];
          if (!isv) {
            const int g = ch >> 7, c = ch & 127;
            uint4 w;
            w.x = pkbf(gelu_(v0[0]), gelu_(v0[1])); w.y = pkbf(gelu_(v0[2]), gelu_(v0[3]));
            w.z = pkbf(gelu_(v1[0]), gelu_(v1[1])); w.w = pkbf(gelu_(v1[2]), gelu_(v1[3]));
            *(uint4*)(p->GVT + ((size_t)(((t >> 7) * 4 + g) * 128 + c)) * 128 + (t & 127)) = w;
          } else {
            const int hh = ch >> 6, dim = ch & 63;
            const int b = t >> 14, s = t & (SEQ - 1);
            bfu* base = p->VT + ((size_t)((b * 8 + hh) * 64 + dim)) * SEQ;
            const size_t PST = (size_t)16 * 64 * SEQ;
            uint4 w;
            w.x = pkbf(v0[0], v0[1]); w.y = pkbf(v0[2], v0[3]); w.z = pkbf(v1[0], v1[1]); w.w = pkbf(v1[2], v1[3]);
            *(uint4*)(base + s) = w;
            bfu* b1 = base + PST + (s >> 2);
#pragma unroll
            for (int e = 0; e < 4; ++e) *(unsigned*)(b1 + (size_t)e * (SEQ / 4)) = pkbf(v0[e], v1[e]);
            bfu* b2 = base + 2 * PST + (size_t)(s & 15) * (SEQ / 16) + (s >> 4);
#pragma unroll
            for (int e = 0; e < 4; ++e) {
              b2[(size_t)e * (SEQ / 16)] = (bfu)f2bf(v0[e]);
              b2[(size_t)(e + 4) * (SEQ / 16)] = (bfu)f2bf(v1[e]);
            }
          }
        }
      }
  }
};
struct PgEpiRes {
  static constexpr bool PERM = false, AFTER_DRAIN = false;
  const float* base;
  float* out;
  DEVI void operator()(const pg8::f32x4 (&acc)[2][2][4][2], const pg8::Unit& u, int wr, int wc, int fr, int fq) const {
    const int row0 = u.pm * 256 + wr * 64 + fr, col0 = u.pn * 256 + wc * 32 + 4 * fq;
#pragma unroll
    for (int ai = 0; ai < 2; ++ai)
#pragma unroll
      for (int m = 0; m < 4; ++m) {
        const size_t rb = (size_t)(row0 + ai * 128 + m * 16) * 1024 + col0;
#pragma unroll
        for (int bj = 0; bj < 2; ++bj)
#pragma unroll
          for (int n = 0; n < 2; ++n) {
            const size_t idx = rb + bj * 128 + n * 16;
            const f32x4 b = *(const f32x4*)(base + idx);
            *(f32x4*)(out + idx) = acc[ai][bj][m][n] + b;
          }
      }
  }
};
template <class Epi>
DEVI void pg_gemm(char* smem, const bfu* A, const bfu* Bt, int M, int N, int K, const Epi& E, int bid, int nb) {
  pg8::Gemm g{A, Bt, M, N, K, A, 1 << 30, 0ull, 0ull};
  pg8::StaticOrder S;
  S.init(M, N, nb, bid);
  pg8::gemm_phase<Epi, pg8::StaticOrder, false>((PG8_LAS unsigned char*)smem, g, S, E, nullptr);
}
template <class Epi>
DEVI void pg_gemm2(char* smem, const bfu* A, const bfu* A2, int pn_split, const bfu* Bt, int M, int N, int K, const Epi& E,
                   int bid, int nb) {
  pg8::Gemm g{A, Bt, M, N, K, A2, pn_split, 0ull, 0ull};
  pg8::StaticOrder S;
  S.init(M, N, nb, bid);
  pg8::gemm_phase<Epi, pg8::StaticOrder, false>((PG8_LAS unsigned char*)smem, g, S, E, nullptr);
}
struct PgEpi3 {
  static constexpr bool PERM = true, AFTER_DRAIN = false;
  bfu* O0;
  bfu* O1;
  int silu1;
  DEVI void operator()(const pg8::f32x4 (&acc)[2][2][4][2], const pg8::Unit& u, int wr, int wc, int fr, int fq) const {
    const int row0 = u.pm * 256 + wr * 64 + fr;
    const int grp = u.pn >> 2;
    bfu* O = grp ? O1 : O0;
    const bool act = grp && silu1;
    const int colb = (u.pn & 3) * 256 + wc * 32 + 8 * fq;
#pragma unroll
    for (int ai = 0; ai < 2; ++ai)
#pragma unroll
      for (int m = 0; m < 4; ++m) {
        bfu* rowp = O + (size_t)(row0 + ai * 128 + m * 16) * 1024 + colb;
#pragma unroll
        for (int bj = 0; bj < 2; ++bj) {
          f32x4 v0 = acc[ai][bj][m][0], v1 = acc[ai][bj][m][1];
          if (act) {
#pragma unroll
            for (int e = 0; e < 4; ++e) {
              v0[e] = silu_(v0[e]);
              v1[e] = silu_(v1[e]);
            }
          }
          uint4 w;
          w.x = pkbf(v0[0], v0[1]); w.y = pkbf(v0[2], v0[3]); w.z = pkbf(v1[0], v1[1]); w.w = pkbf(v1[2], v1[3]);
          *(uint4*)(rowp + bj * 128) = w;
        }
      }
  }
};

DEVI void phase1(const Params& p, char* smem, int bid, int nb) {
  {
    PgEpi1 E{&p};
    pg8::Gemm g{p.H, p.WT_in, T_TOK, 2560, 1024, p.H, 1 << 30, 0ull, kCmap1};
    pg8::StaticOrder S;
    S.init(T_TOK, 2560, nb, bid);
    pg8::gemm_phase<PgEpi1, pg8::StaticOrder, false>((PG8_LAS unsigned char*)smem, g, S, E, nullptr);
  }
  {
    PgEpi1T E{&p};
    pg8::Gemm g{p.WT_in, p.H, 1024, T_TOK, 1024, p.WT_in, 1 << 30, kRmap1, 0ull};
    pg8::StaticOrder S;
    S.init(1024, T_TOK, nb, bid);
    pg8::gemm_phase<PgEpi1T, pg8::StaticOrder, false>((PG8_LAS unsigned char*)smem, g, S, E, nullptr);
  }
}

struct ALoadWs {
  struct Raw { float4 a, b; };
  static constexpr bool kFat = true;
  static constexpr bool kConsec = false;
  const float* ws;
  const float* rinv;
  DEVI Raw load(int t, int s0) const {
    Raw r;
    r.a = *(const float4*)(ws + t * 128 + s0);
    r.b = *(const float4*)(ws + t * 128 + s0 + 4);
    return r;
  }
  DEVI uint4 loadprev(int, int) const { return uint4{0u, 0u, 0u, 0u}; }
  DEVI uint4 asprev(const Raw&) const { return uint4{0u, 0u, 0u, 0u}; }
  DEVI uint4 finish(const Raw& r, const uint4&, int t, int s0) const {
    float f[8] = {r.a.x, r.a.y, r.a.z, r.a.w, r.b.x, r.b.y, r.b.z, r.b.w};
#pragma unroll
    for (int j = 0; j < 8; ++j) f[j] = (s0 + j <= t) ? f[j] * rinv[s0 + j] : 0.f;
    return pack8(f);
  }
};
struct EpiGm {
  const Params* p;
  int chunk, g;
  DEVI void operator()(int t, int c, f32x4 v) const {
    const float4 gn = *(const float4*)(p->gm_norm + g * 128 + c);
    const float bias = p->gm_b[g * 128 + t];
    const size_t tok = (size_t)chunk * 128 + t;
    float u[4], sz[4];
    unpack4(*(const uint2*)(p->U + tok * 512 + g * 128 + c), u);
    unpack4(*(const uint2*)(p->SZ + tok * 1024 + g * 128 + c), sz);
    uint2 o;
    o.x = pkbf(u[0] * (v[0] * gn.x + bias) * sz[0], u[1] * (v[1] * gn.y + bias) * sz[1]);
    o.y = pkbf(u[2] * (v[2] * gn.z + bias) * sz[2], u[3] * (v[3] * gn.w + bias) * sz[3]);
    *(uint2*)(p->Y + tok * 1024 + g * 128 + c) = o;
  }
};

DEVI void gmlp_item(const Params& p, char* smem, int item) {
  const int chunk = item >> 2, g = item & 3;
  const bfu* gv = p.GVT + (size_t)item * 128 * 128;
  float* rinv = (float*)(smem + 2 * GSTAGE_BYTES);
  const int tid = TIDX;
  {
    float* sred = rinv + 128;
    const int s4 = (tid & 31) * 4, cg = tid >> 5;
    uint2 raw[16];
#pragma unroll
    for (int i = 0; i < 16; ++i) raw[i] = *(const uint2*)(gv + (cg * 16 + i) * 128 + s4);
    float ss[4] = {0.f, 0.f, 0.f, 0.f};
#pragma unroll
    for (int i = 0; i < 16; ++i) {
      float f[4];
      unpack4(raw[i], f);
#pragma unroll
      for (int j = 0; j < 4; ++j) ss[j] += f[j] * f[j];
    }
    *(float4*)(sred + cg * 128 + s4) = float4{ss[0], ss[1], ss[2], ss[3]};
    __syncthreads();
    if (tid < 128) {
      float t = 0.f;
#pragma unroll
      for (int i = 0; i < 8; ++i) t += sred[i * 128 + tid];
      rinv[tid] = rsqrtf(t * (1.f / 128.f) + 1e-6f);
    }
  }
  __syncthreads();
  ALoadWs al{p.gm_ws + (size_t)g * 128 * 128, rinv};
  EpiGm epi{&p, chunk, g};
  gemm_tile(smem, al, gv, 128, 128, 0, 0, epi);
}

DEVI void attn_item(const Params& p, char* smem, int item) {
  const int qb = item & 63, bh = item >> 6, b = bh >> 3, h = bh & 7;
  const int q0 = qb * 256;
  bfu* Ob = (bfu*)smem;
  float* Mb = (float*)(smem + 32768);
  float* Lb = Mb + 256;
  const int tid = threadIdx.x, lane = tid & 63, wid = tid >> 6;
  const int qi = lane & 15, g = lane >> 4;
  const float slope = exp2f(-(float)(h + 1));
  const size_t tokb = (size_t)b * SEQ;
#pragma unroll 1
  for (int pi = 0; pi < 3; ++pi) {
    const int dshift = 2 * pi, d = 1 << dshift;
    const bfu* VT = p.VT + (size_t)pi * ((size_t)16 * 64 * SEQ) + (size_t)bh * 64 * SEQ;
#pragma unroll 1
    for (int u = wid; u < 16; u += 8) {
      const int r = u & (d - 1), tile = u >> dshift;
      const int sq0 = (q0 >> dshift) + tile * 16;
      const int sk0 = sq0 - 144;
      const int posq = ((sq0 + qi) << dshift) + r;
      const bfu* qp = p.Q + (tokb + posq) * 512 + h * 64 + g * 8;
      const bf16x8 qf0 = *(const bf16x8*)qp, qf1 = *(const bf16x8*)(qp + 32);
      const bfu* kbase = p.K + (tokb + r) * 512 + h * 64 + g * 8;
      const bfu* vbase = VT + (size_t)qi * SEQ + r * (SEQ >> dshift);
      bf16x8 kf[2][2];
      uint2 vf[4][2];
      auto loadk = [&](int it) {
#pragma unroll
        for (int tt = 0; tt < 2; ++tt) {
          int sk = sk0 + (2 * it + tt) * 16 + qi;
          sk = sk < 0 ? 0 : sk;
          const bfu* kp = kbase + ((size_t)sk << dshift) * 512;
          kf[tt][0] = *(const bf16x8*)kp;
          kf[tt][1] = *(const bf16x8*)(kp + 32);
        }
      };
      auto loadv = [&](int it) {
        int kidx0 = sk0 + 32 * it + 4 * g, kidx1 = kidx0 + 16;
        kidx0 = kidx0 < 0 ? 0 : kidx0;
        kidx1 = kidx1 < 0 ? 0 : kidx1;
#pragma unroll
        for (int m = 0; m < 4; ++m) {
          vf[m][0] = *(const uint2*)(vbase + (size_t)(16 * m) * SEQ + kidx0);
          vf[m][1] = *(const uint2*)(vbase + (size_t)(16 * m) * SEQ + kidx1);
        }
      };
      loadk(0);
      loadv(0);
      const int hi = 144 + qi, lo = (16 + qi > -sk0) ? 16 + qi : -sk0;
      const float sd = slope * (float)d;
      float mrun = -1e30f, l = 0.f;
      f32x4 O[4];
#pragma unroll
      for (int m = 0; m < 4; ++m) O[m] = f32x4{0.f, 0.f, 0.f, 0.f};
#pragma unroll 1
      for (int it = 0; it < 5; ++it) {
        bf16x8 ck[2][2];
        uint2 cv[4][2];
#pragma unroll
        for (int a = 0; a < 2; ++a)
#pragma unroll
          for (int c = 0; c < 2; ++c) ck[a][c] = kf[a][c];
        const int itn = it < 4 ? it + 1 : 4;
        loadk(itn);
        f32x4 S[2];
#pragma unroll
        for (int tt = 0; tt < 2; ++tt) {
          f32x4 z = {0.f, 0.f, 0.f, 0.f};
          z = __builtin_amdgcn_mfma_f32_16x16x32_bf16(ck[tt][0], qf0, z, 0, 0, 0);
          z = __builtin_amdgcn_mfma_f32_16x16x32_bf16(ck[tt][1], qf1, z, 0, 0, 0);
          S[tt] = z;
        }
        float mx = -INFINITY;
#pragma unroll
        for (int tt = 0; tt < 2; ++tt)
#pragma unroll
          for (int e = 0; e < 4; ++e) {
            const int kb = (2 * it + tt) * 16 + 4 * g;
            const bool valid = (kb >= lo - e) && (kb <= hi - e);
            const float sv = valid ? fmaf(S[tt][e], 0.125f, sd * (float)e - sd * (float)(hi - kb)) : -INFINITY;
            S[tt][e] = sv;
            mx = fmaxf(mx, sv);
          }
        mx = fmaxf(mx, __shfl_xor(mx, 16));
        mx = fmaxf(mx, __shfl_xor(mx, 32));
        const float mnew = fmaxf(mrun, mx);
        const float alpha = __expf(mrun - mnew);
        mrun = mnew;
        float ls = 0.f;
#pragma unroll
        for (int tt = 0; tt < 2; ++tt)
#pragma unroll
          for (int e = 0; e < 4; ++e) {
            const float pe = __expf(S[tt][e] - mnew);
            S[tt][e] = pe;
            ls += pe;
          }
        l = l * alpha + ls;
        uint4 pk;
        pk.x = pkbf(S[0][0], S[0][1]);
        pk.y = pkbf(S[0][2], S[0][3]);
        pk.z = pkbf(S[1][0], S[1][1]);
        pk.w = pkbf(S[1][2], S[1][3]);
        const bf16x8 pf = __builtin_bit_cast(bf16x8, pk);
#pragma unroll
        for (int m = 0; m < 4; ++m) {
          cv[m][0] = vf[m][0];
          cv[m][1] = vf[m][1];
        }
        loadv(itn);
#pragma unroll
        for (int m = 0; m < 4; ++m) {
          O[m] *= alpha;
          const uint4 vv = {cv[m][0].x, cv[m][0].y, cv[m][1].x, cv[m][1].y};
          O[m] = __builtin_amdgcn_mfma_f32_16x16x32_bf16(__builtin_bit_cast(bf16x8, vv), pf, O[m], 0, 0, 0);
        }
      }
      l += __shfl_xor(l, 16);
      l += __shfl_xor(l, 32);
      const float mx = mrun;
      const float il = 1.f / l;
      const int ql = ((tile * 16 + qi) << dshift) + r;
      float wo = 0.f, wn = 1.f;
      float mnew = mx, lnew = l;
      if (pi > 0) {
        const float mo = Mb[ql], lo = Lb[ql];
        mnew = fmaxf(mo, mx);
        wo = lo * __expf(mo - mnew);
        wn = l * __expf(mx - mnew);
        lnew = wo + wn;
        const float inv = 1.f / lnew;
        wo *= inv;
        wn *= inv;
      }
      wn *= il;
#pragma unroll
      for (int m = 0; m < 4; ++m) {
        bfu* op = Ob + ql * 64 + 16 * m + 4 * g;
        float o[4];
        if (pi > 0) {
          const uint2 ov = *(const uint2*)op;
          o[0] = wo * bf2f(ov.x & 0xffffu) + wn * O[m][0];
          o[1] = wo * bf2f(ov.x >> 16) + wn * O[m][1];
          o[2] = wo * bf2f(ov.y & 0xffffu) + wn * O[m][2];
          o[3] = wo * bf2f(ov.y >> 16) + wn * O[m][3];
        } else {
#pragma unroll
          for (int e = 0; e < 4; ++e) o[e] = wn * O[m][e];
        }
        if (pi < 2) {
          uint2 w;
          w.x = pkbf(o[0], o[1]);
          w.y = pkbf(o[2], o[3]);
          *(uint2*)op = w;
        } else {
          const size_t oi = (tokb + q0 + ql) * 1024 + 512 + h * 64 + 16 * m + 4 * g;
          const uint2 sz = *(const uint2*)(p.SZ + oi);
          uint2 w;
          w.x = pkbf(o[0] * bf2f(sz.x & 0xffffu), o[1] * bf2f(sz.x >> 16));
          w.y = pkbf(o[2] * bf2f(sz.y & 0xffffu), o[3] * bf2f(sz.y >> 16));
          *(uint2*)(p.Y + oi) = w;
        }
      }
      if (pi < 2 && g == 0) {
        Mb[ql] = mnew;
        Lb[ql] = lnew;
      }
    }
    __syncthreads();
  }
}

DEVI void phase2(const Params& p, char* smem, int bid, int nb) {
  for (int it = bid; it < 16 * 64; it += nb) attn_item(p, smem, it);
  char* hs = smem + HF * HALF_SMEM;
  for (int it = bid * 2 + HF; it < (T_TOK / 128) * 4; it += nb * 2) gmlp_item(p, hs, it);
}

DEVI void phase3(const Params& p, char* smem, int bid, int nb) {
  PgEpiRes E{p.x, p.out};
  pg_gemm(smem, p.Y, p.WT_out, T_TOK, 1024, 1024, E, bid, nb);
}
DEVI void phase3b(const Params& p, int bid, int nb) {
  for (int it = bid; it < T_TOK / 16; it += nb) {
    const int row = it * 16 + (threadIdx.x >> 6) * 2;
    rms_row2_bf16(p.out + (size_t)row * 1024, p.ln_odd, p.H + (size_t)row * 1024, threadIdx.x & 63);
  }
}

struct ALoadMix {
  typedef uint4 Raw;
  static constexpr bool kFat = true;
  static constexpr bool kConsec = true;
  const bfu* H;
  const float* mu;
  DEVI Raw load(int row, int k) const { return *(const uint4*)(H + (size_t)row * 1024 + k); }
  DEVI uint4 loadprev(int row, int k) const {
    const int prow = ((row & (SEQ - 1)) != 0) ? row - 1 : row;
    return *(const uint4*)(H + (size_t)prow * 1024 + k);
  }
  DEVI uint4 asprev(const Raw& r) const { return r; }
  DEVI uint4 finish(const Raw& r, const uint4& pr, int row, int k) const {
    float c[8], pv[8];
    unpack8(r, c);
    unpack8(pr, pv);
    const float first = ((row & (SEQ - 1)) != 0) ? 1.f : 0.f;
    const float4 m0 = *(const float4*)(mu + k), m1 = *(const float4*)(mu + k + 4);
    const float mm[8] = {m0.x, m0.y, m0.z, m0.w, m1.x, m1.y, m1.z, m1.w};
#pragma unroll
    for (int j = 0; j < 8; ++j) c[j] = c[j] + (pv[j] * first - c[j]) * mm[j];
    return pack8(c);
  }
};
struct Epi4 {
  const Params* p;
  int nt;
  DEVI void operator()(int row, int col, f32x4 v) const {
    uint2 o;
    if (nt < 24) {
      o.x = pkbf(v[0], v[1]);
      o.y = pkbf(v[2], v[3]);
      bfu* dst = (nt < 8) ? p->R + (size_t)row * 1024 + col
                          : (nt < 16) ? p->K1 + (size_t)row * 1024 + col - 1024 : p->V1 + (size_t)row * 1024 + col - 2048;
      *(uint2*)dst = o;
    } else if (nt < 32) {
      o.x = pkbf(silu_(v[0]), silu_(v[1]));
      o.y = pkbf(silu_(v[2]), silu_(v[3]));
      *(uint2*)(p->SG + (size_t)row * 1024 + col - 3072) = o;
    } else if (nt == 32) {
      const int c = col - 4096;
      if (c < 64) {
        o.x = pkbf(tanh_(v[0]), tanh_(v[1]));
        o.y = pkbf(tanh_(v[2]), tanh_(v[3]));
        *(uint2*)(p->TW + (size_t)row * 64 + c) = o;
      }
    } else {
      const int c = col - 4224;
      if (c < 64) {
        o.x = pkbf(v[0], v[1]);
        o.y = pkbf(v[2], v[3]);
        *(uint2*)(p->TA + (size_t)row * 64 + c) = o;
      }
    }
  }
};
DEVI void phase4_tile(const Params& p, char* smem, int mt, int nt) {
  float* smu = (float*)(smem + 2 * GSTAGE_BYTES);
  const int mi = (nt < 8) ? 0 : (nt < 16) ? 2 : (nt < 24) ? 3 : (nt < 32) ? 5 : (nt == 32) ? 1 : 4;
  *(float4*)(smu + TIDX * 4) = *(const float4*)(p.mu + mi * 1024 + TIDX * 4);
  __syncthreads();
  ALoadMix al{p.H, smu};
  Epi4 epi{&p, nt};
  gemm_tile<1>(smem, al, p.WT_3, 1024, 1024, mt * 128, nt * 128, epi);
}
DEVI void phaseM(const Params& p, char* smem, int bid, int nb) {
  char* hs = smem + HF * HALF_SMEM;
  for (int it = bid * 2 + HF; it < (T_TOK / 128) * 2; it += nb * 2) phase4_tile(p, hs, it >> 1, 32 + (it & 1));
  const int tid = threadIdx.x;
  const int cc = (tid & 127) * 8, rsub = tid >> 7;
  float mr[8], mk[8], mv[8], mg[8];
  {
    const float4 a0 = *(const float4*)(p.mu + 0 * 1024 + cc), a1 = *(const float4*)(p.mu + 0 * 1024 + cc + 4);
    const float4 b0 = *(const float4*)(p.mu + 2 * 1024 + cc), b1 = *(const float4*)(p.mu + 2 * 1024 + cc + 4);
    const float4 c0 = *(const float4*)(p.mu + 3 * 1024 + cc), c1 = *(const float4*)(p.mu + 3 * 1024 + cc + 4);
    const float4 d0 = *(const float4*)(p.mu + 5 * 1024 + cc), d1 = *(const float4*)(p.mu + 5 * 1024 + cc + 4);
    mr[0] = a0.x; mr[1] = a0.y; mr[2] = a0.z; mr[3] = a0.w; mr[4] = a1.x; mr[5] = a1.y; mr[6] = a1.z; mr[7] = a1.w;
    mk[0] = b0.x; mk[1] = b0.y; mk[2] = b0.z; mk[3] = b0.w; mk[4] = b1.x; mk[5] = b1.y; mk[6] = b1.z; mk[7] = b1.w;
    mv[0] = c0.x; mv[1] = c0.y; mv[2] = c0.z; mv[3] = c0.w; mv[4] = c1.x; mv[5] = c1.y; mv[6] = c1.z; mv[7] = c1.w;
    mg[0] = d0.x; mg[1] = d0.y; mg[2] = d0.z; mg[3] = d0.w; mg[4] = d1.x; mg[5] = d1.y; mg[6] = d1.z; mg[7] = d1.w;
  }
#pragma unroll 1
  for (int it = bid; it < T_TOK / 8; it += nb) {
    const int ra = it * 8 + rsub, rb = ra + 4;
    const size_t oa = (size_t)ra * 1024 + cc, ob = (size_t)rb * 1024 + cc;
    const uint4 ca = *(const uint4*)(p.H + oa), cb = *(const uint4*)(p.H + ob);
    const uint4 pa = *(const uint4*)(p.H + (((ra & (SEQ - 1)) != 0) ? oa - 1024 : oa));
    const uint4 pb = *(const uint4*)(p.H + ob - 1024);
    const float fa = ((ra & (SEQ - 1)) != 0) ? 1.f : 0.f;
#pragma unroll
    for (int half = 0; half < 2; ++half) {
      float c[8], d[8], o[8];
      unpack8(half ? cb : ca, c);
      unpack8(half ? pb : pa, d);
      const float f = half ? 1.f : fa;
      const size_t oo = half ? ob : oa;
#pragma unroll
      for (int j = 0; j < 8; ++j) d[j] = d[j] * f - c[j];
#pragma unroll
      for (int j = 0; j < 8; ++j) o[j] = c[j] + d[j] * mr[j];
      *(uint4*)(p.XR + oo) = pack8(o);
#pragma unroll
      for (int j = 0; j < 8; ++j) o[j] = c[j] + d[j] * mk[j];
      *(uint4*)(p.XK + oo) = pack8(o);
#pragma unroll
      for (int j = 0; j < 8; ++j) o[j] = c[j] + d[j] * mv[j];
      *(uint4*)(p.XV + oo) = pack8(o);
#pragma unroll
      for (int j = 0; j < 8; ++j) o[j] = c[j] + d[j] * mg[j];
      *(uint4*)(p.XG + oo) = pack8(o);
    }
  }
}
DEVI void phase3a(const Params& p, char* smem, int bid, int nb) {
  PgEpi3 E{p.R, p.K1, 0};
  pg_gemm2(smem, p.XR, p.XK, 4, p.WT_3, T_TOK, 2048, 1024, E, bid, nb);
}
DEVI void phase3c(const Params& p, char* smem, int bid, int nb) {
  PgEpi3 E{p.V1, p.SG, 1};
  pg_gemm2(smem, p.XV, p.XG, 4, p.WT_3 + (size_t)2048 * 1024, T_TOK, 2048, 1024, E, bid, nb);
}

struct Epi5w {
  const Params* p;
  DEVI void operator()(int row, int col, f32x4 v) const {
    const float4 w0 = *(const float4*)(p->w0 + col);
    const float k = 0.6065306597126334f;
    uint2 o;
    o.x = pkbf(k * sigmoid_(w0.x + v[0]), k * sigmoid_(w0.y + v[1]));
    o.y = pkbf(k * sigmoid_(w0.z + v[2]), k * sigmoid_(w0.w + v[3]));
    *(uint2*)(p->EW + (size_t)row * 1024 + col) = o;
  }
};
struct Epi5a {
  const Params* p;
  DEVI void operator()(int row, int col, f32x4 v) const {
    const float4 a0 = *(const float4*)(p->a0 + col);
    uint2 o;
    o.x = pkbf(sigmoid_(a0.x + v[0]), sigmoid_(a0.y + v[1]));
    o.y = pkbf(sigmoid_(a0.z + v[2]), sigmoid_(a0.w + v[3]));
    *(uint2*)(p->AA + (size_t)row * 1024 + col) = o;
  }
};
DEVI void phase5(const Params& p, char* smem, int bid, int nb) {
  constexpr int N1 = (T_TOK / 128) * 8;
  char* hs = smem + HF * HALF_SMEM;
  for (int it = bid * 2 + HF; it < 2 * N1; it += nb * 2) {
    if (it < N1) {
      ALoadPlain al{p.TW, 64};
      Epi5w epi{&p};
      gemm_tile(hs, al, p.W2T, 64, 64, (it >> 3) * 128, (it & 7) * 128, epi);
    } else {
      const int j = it - N1;
      ALoadPlain al{p.TA, 64};
      Epi5a epi{&p};
      gemm_tile(hs, al, p.A2T, 64, 64, (j >> 3) * 128, (j & 7) * 128, epi);
    }
  }
}

DEVI void scanx_item(const Params& p, char* smem, int item, int next_item, uint2& ur, uint2& uk, uint2& ue, uint2& ua, uint2& uv) {
  const int bh = item & 31, c = item >> 5;
  const int b = bh >> 4, h = bh & 15;
  const size_t rowbase = ((size_t)b * SEQ + (size_t)c * 16) * 1024 + h * 64;
  float* sA = (float*)smem;
  float* sR = sA + 16 * 68;
  float* sBt = sR + 16 * 68;
  float* sKt = sBt + 16 * 68;
  float* sE = sKt + 16 * 68;
  float* sMab = sE + 16 * 64;
  float* sMak = sMab + 256;
  float* sM2 = sMak + 256;
  float* sM4 = sM2 + 256;
  float* sT = sM4 + 256;
  float* sT2 = sT + 256;
  const int tid = TIDX;
  const int tau = tid >> 4, c4 = (tid & 15) * 4;
  const size_t o = rowbase + (size_t)tau * 1024 + c4;
  float r[4], k[4], ew[4], a[4], vv[4];
  unpack4(ur, r);
  unpack4(uk, k);
  unpack4(ue, ew);
  unpack4(ua, a);
  unpack4(uv, vv);
  {
    const int nbh = next_item & 31, nc = next_item >> 5;
    const size_t no = ((size_t)(nbh >> 4) * SEQ + (size_t)nc * 16 + tau) * 1024 + (nbh & 15) * 64 + c4;
    ur = *(const uint2*)(p.R + no);
    uk = *(const uint2*)(p.K1 + no);
    ue = *(const uint2*)(p.EW + no);
    ua = *(const uint2*)(p.AA + no);
    uv = *(const uint2*)(p.V1 + no);
  }
  float kk[4], kp[4], bb[4];
  float ss = 0.f, cf = 0.f;
#pragma unroll
  for (int j = 0; j < 4; ++j) {
    const int ch = h * 64 + c4 + j;
    kk[j] = k[j] * p.k_k[ch];
    ss += kk[j] * kk[j];
    kp[j] = k[j] * (1.f + (a[j] - 1.f) * p.k_a[ch]);
    cf += r[j] * kp[j] * p.r_k[ch];
  }
  ss = reduce16(ss);
  cf = reduce16(cf);
  const float rn = rsqrtf(fmaxf(ss, 1e-24f));
#pragma unroll
  for (int j = 0; j < 4; ++j) {
    kk[j] *= rn;
    bb[j] = kk[j] * a[j];
    sE[tau * 64 + c4 + j] = ew[j];
  }
  if ((tid & 15) == 0) p.COEF[((size_t)b * SEQ + (size_t)c * 16 + tau) * 16 + h] = cf;
  __syncthreads();
  float Li[4], L15[4];
  {
    const int wv = tid >> 6, ln = tid & 63, rw = ln & 15, gq = ln >> 4;
    f32x4 cl = {0.f, 0.f, 0.f, 0.f};
#pragma unroll
    for (int s = 0; s < 4; ++s) {
      const int i = 4 * gq + s;
      const float a = (i <= rw) ? 1.f : 0.f;
      const float bv = sE[i * 64 + 16 * wv + rw];
      cl = __builtin_amdgcn_mfma_f32_16x16x4f32(a, bv, cl, 0, 0, 0);
    }
    float* sL = sM2;
#pragma unroll
    for (int e = 0; e < 4; ++e) sL[(4 * gq + e) * 64 + 16 * wv + rw] = cl[e];
    __syncthreads();
    const float4 l4 = *(const float4*)(sL + tau * 64 + c4), l15 = *(const float4*)(sL + 15 * 64 + c4);
    Li[0] = l4.x; Li[1] = l4.y; Li[2] = l4.z; Li[3] = l4.w;
    L15[0] = l15.x; L15[1] = l15.y; L15[2] = l15.z; L15[3] = l15.w;
  }
  float rt[4], bhat[4], khat[4];
#pragma unroll
  for (int j = 0; j < 4; ++j) {
    const float ep = __expf(Li[j]), em = __expf(-Li[j]), eh = __expf(-(L15[j] - Li[j]));
    const float at = -kk[j] * __expf(-(Li[j] - ew[j]));
    rt[j] = r[j] * em;
    sA[tau * 68 + c4 + j] = at;
    sR[tau * 68 + c4 + j] = rt[j];
    sBt[tau * 68 + c4 + j] = bb[j] * ep;
    sKt[tau * 68 + c4 + j] = kp[j] * ep;
    bhat[j] = bb[j] * eh;
    khat[j] = kp[j] * eh;
  }
  *(uint2*)(p.R + o) = pack4(rt);
#pragma unroll
  for (int j = 0; j < 4; ++j) {
    const int lin = (c4 + j) * 16 + tau;
    const size_t off = rowbase + (size_t)(lin >> 6) * 1024 + (lin & 63);
    p.EW[off] = (bfu)f2bf(bhat[j]);
    p.K1[off] = (bfu)f2bf(khat[j]);
    p.V1[off] = (bfu)f2bf(vv[j]);
  }
  if (tau == 0) {
    float4 gq = {__expf(-L15[0]), __expf(-L15[1]), __expf(-L15[2]), __expf(-L15[3])};
    *(float4*)(p.G15 + (size_t)item * 64 + c4) = gq;
  }
  __syncthreads();
  {
    const int wv = tid >> 6, ln = tid & 63, rw = ln & 15, gq = ln >> 4;
    const float* rowsrc = ((wv >> 1) ? sKt : sBt) + rw * 68 + 16 * gq;
    const float* colsrc = ((wv & 1) ? sR : sA) + rw * 68 + 16 * gq;
    f32x4 m = {0.f, 0.f, 0.f, 0.f};
#pragma unroll
    for (int s4 = 0; s4 < 16; s4 += 4) {
      const float4 av = *(const float4*)(rowsrc + s4), bv = *(const float4*)(colsrc + s4);
      m = __builtin_amdgcn_mfma_f32_16x16x4f32(av.x, bv.x, m, 0, 0, 0);
      m = __builtin_amdgcn_mfma_f32_16x16x4f32(av.y, bv.y, m, 0, 0, 0);
      m = __builtin_amdgcn_mfma_f32_16x16x4f32(av.z, bv.z, m, 0, 0, 0);
      m = __builtin_amdgcn_mfma_f32_16x16x4f32(av.w, bv.w, m, 0, 0, 0);
    }
    const int tq = rw;
    if (wv & 1) {
      float v4[4];
#pragma unroll
      for (int e = 0; e < 4; ++e) v4[e] = (4 * gq + e <= tq) ? m[e] : 0.f;
      *(uint2*)(p.MRT + (size_t)item * 512 + tq * 32 + gq * 8 + (wv >> 1) * 4) = pack4(v4);
    } else {
      float* dst = (wv >> 1) ? sMak : sMab;
#pragma unroll
      for (int e = 0; e < 4; ++e) dst[(4 * gq + e) * 16 + tq] = (4 * gq + e < tq) ? m[e] : 0.f;
    }
  }
  __syncthreads();
  {
    const int i = tid >> 4, j = tid & 15;
    float m2 = 0.f;
#pragma unroll
    for (int kq = 0; kq < 16; ++kq) m2 += sMab[i * 16 + kq] * sMab[kq * 16 + j];
    sM2[i * 16 + j] = m2;
    __syncthreads();
    float t1 = ((i == j) ? 1.f : 0.f) + sMab[i * 16 + j] + m2, m4 = 0.f;
#pragma unroll
    for (int kq = 0; kq < 16; ++kq) {
      t1 += sMab[i * 16 + kq] * sM2[kq * 16 + j];
      m4 += sM2[i * 16 + kq] * sM2[kq * 16 + j];
    }
    sT[i * 16 + j] = t1;
    sM4[i * 16 + j] = m4;
    __syncthreads();
    float t2 = t1, m8 = 0.f;
#pragma unroll
    for (int kq = 0; kq < 16; ++kq) {
      t2 += sT[i * 16 + kq] * sM4[kq * 16 + j];
      m8 += sM4[i * 16 + kq] * sM4[kq * 16 + j];
    }
    sT2[i * 16 + j] = t2;
    __syncthreads();
    sM2[i * 16 + j] = m8;
    __syncthreads();
    float t3 = t2;
#pragma unroll
    for (int kq = 0; kq < 16; ++kq) t3 += sT2[i * 16 + kq] * sM2[kq * 16 + j];
    sT[i * 16 + j] = t3;
    __syncthreads();
  }
  {
    const int wv = tid >> 6, ln = tid & 63, rw = ln & 15, gq = ln >> 4;
    float tmv[4], av[4];
#pragma unroll
    for (int s = 0; s < 4; ++s) {
      tmv[s] = sT[(4 * gq + s) * 16 + rw];
      av[s] = sA[(4 * gq + s) * 68 + 16 * wv + rw];
    }
    f32x4 cw = {0.f, 0.f, 0.f, 0.f};
#pragma unroll
    for (int s = 0; s < 4; ++s) cw = __builtin_amdgcn_mfma_f32_16x16x4f32(av[s], tmv[s], cw, 0, 0, 0);
    {
      float w4[4] = {cw[0], cw[1], cw[2], cw[3]};
      *(uint2*)(p.AA + rowbase + (size_t)rw * 1024 + 16 * wv + 4 * gq) = pack4(w4);
    }
    if (wv == 3) {
      const float4 mk = *(const float4*)(sMak + rw * 16 + 4 * gq);
      f32x4 cg = {0.f, 0.f, 0.f, 0.f};
      cg = __builtin_amdgcn_mfma_f32_16x16x4f32(mk.x, tmv[0], cg, 0, 0, 0);
      cg = __builtin_amdgcn_mfma_f32_16x16x4f32(mk.y, tmv[1], cg, 0, 0, 0);
      cg = __builtin_amdgcn_mfma_f32_16x16x4f32(mk.z, tmv[2], cg, 0, 0, 0);
      cg = __builtin_amdgcn_mfma_f32_16x16x4f32(mk.w, tmv[3], cg, 0, 0, 0);
      float g4[4] = {cg[0], cg[1], cg[2], cg[3]};
      *(uint2*)(p.GT + (size_t)item * 256 + rw * 16 + 4 * gq) = pack4(g4);
    }
  }
  __syncthreads();
}
DEVI void phase6x(const Params& p, char* smem, int bid, int nb) {
  char* hs = smem + HF * HALF_SMEM;
  constexpr int NI = (SEQ / 16) * 32;
  const int vnb = nb * 2;
  int it = bid * 2 + HF;
  if (it >= NI) return;
  uint2 ur, uk, ue, ua, uv;
  {
    const int tau = TIDX >> 4, c4 = (TIDX & 15) * 4;
    const int bh = it & 31, c = it >> 5;
    const size_t o = ((size_t)(bh >> 4) * SEQ + (size_t)c * 16 + tau) * 1024 + (bh & 15) * 64 + c4;
    ur = *(const uint2*)(p.R + o);
    uk = *(const uint2*)(p.K1 + o);
    ue = *(const uint2*)(p.EW + o);
    ua = *(const uint2*)(p.AA + o);
    uv = *(const uint2*)(p.V1 + o);
  }
#pragma unroll 1
  for (; it < NI; it += vnb) scanx_item(p, hs, it, (it + vnb < NI) ? it + vnb : it, ur, uk, ue, ua, uv);
}

DEVI bf16x8 mk8(uint2 a, uint2 b) {
  const uint4 v = {a.x, a.y, b.x, b.y};
  return __builtin_bit_cast(bf16x8, v);
}
DEVI uint2 packacc(f32x4 a) {
  uint2 r;
  r.x = pkbf(a[0], a[1]);
  r.y = pkbf(a[2], a[3]);
  return r;
}
constexpr int SCH = 4;
constexpr int SROW = 136;
constexpr int SARR = 16 * SROW;
constexpr int SOFF_GT = 5 * SARR;
constexpr int SOFF_MR = SOFF_GT + 512;
constexpr int SOFF_G15 = SOFF_MR + 1024;
constexpr int SIMG = SOFF_G15 + 256;
#define SCANS_LD5(P, I, O)                       \
    P##a##I = *(const uint4*)(p.AA + (O));       \
    P##r##I = *(const uint4*)(p.R + (O));        \
    P##e##I = *(const uint4*)(p.EW + (O));       \
    P##k##I = *(const uint4*)(p.K1 + (O));       \
    P##v##I = *(const uint4*)(p.V1 + (O));
#define SCANS_ISSUE(P, SC)                                                                           \
  {                                                                                                  \
    const size_t hb_ = ((size_t)b * SEQ) * 1024 + h * 64 + c80 * 8;                                  \
    const int tk0_ = (SC) * SCH * 16 + cl0 * 16 + row0;                                              \
    const int tk1_ = tk0_ + 32;                                                                      \
    SCANS_LD5(P, 0, hb_ + (size_t)(tk0_ < SEQ ? tk0_ : SEQ - 1) * 1024)                              \
    SCANS_LD5(P, 1, hb_ + (size_t)(tk1_ < SEQ ? tk1_ : SEQ - 1) * 1024)                              \
    const int c0_ = (SC) * SCH;                                                                      \
    const size_t ib_ = (size_t)b * 16 + h;                                                           \
    const int tg_ = tid < 128 ? tid : 127;                                                           \
    const int cg_ = c0_ + (tg_ >> 5);                                                                \
    P##gm = *(const uint4*)(p.GT + ((size_t)(cg_ < SEQ / 16 ? cg_ : SEQ / 16 - 1) * 32 + ib_) * 256 + (tg_ & 31) * 8);  \
    const int t5_ = tid < 64 ? tid : 63;                                                             \
    const int c5_ = c0_ + (t5_ >> 4);                                                                \
    P##g5 = *(const uint4*)(p.G15 + ((size_t)(c5_ < SEQ / 16 ? c5_ : SEQ / 16 - 1) * 32 + ib_) * 64 + (t5_ & 15) * 4);  \
    const int cm_ = c0_ + (tid >> 6);                                                                \
    P##mr = *(const uint4*)(p.MRT + ((size_t)(cm_ < SEQ / 16 ? cm_ : SEQ / 16 - 1) * 32 + ib_) * 512 + (tid & 63) * 8); \
  }
#define SCANS_ST5(P, I, B)                                                                           \
    *(uint2*)(B) = uint2{P##a##I.x, P##a##I.y};  *(uint2*)((B) + 8) = uint2{P##a##I.z, P##a##I.w};   \
    *(uint2*)((B) + SARR) = uint2{P##r##I.x, P##r##I.y};  *(uint2*)((B) + SARR + 8) = uint2{P##r##I.z, P##r##I.w};   \
    *(uint2*)((B) + 2 * SARR) = uint2{P##e##I.x, P##e##I.y};  *(uint2*)((B) + 2 * SARR + 8) = uint2{P##e##I.z, P##e##I.w};   \
    *(uint2*)((B) + 3 * SARR) = uint2{P##k##I.x, P##k##I.y};  *(uint2*)((B) + 3 * SARR + 8) = uint2{P##k##I.z, P##k##I.w};   \
    *(uint2*)((B) + 4 * SARR) = uint2{P##v##I.x, P##v##I.y};  *(uint2*)((B) + 4 * SARR + 8) = uint2{P##v##I.z, P##v##I.w};
#define SCANS_COMMIT(P)                                                                              \
  {                                                                                                  \
    char* b0_ = cimg + cl0 * SIMG + row0 * SROW + c80 * 16;                                          \
    SCANS_ST5(P, 0, b0_)                                                                             \
    SCANS_ST5(P, 1, b0_ + 2 * SIMG)                                                                  \
    if (tid < 128) *(uint4*)(cimg + (tid >> 5) * SIMG + SOFF_GT + (tid & 31) * 16) = P##gm;          \
    if (tid < 64) *(uint4*)(cimg + (tid >> 4) * SIMG + SOFF_G15 + (tid & 15) * 16) = P##g5;          \
    *(uint4*)(cimg + (tid >> 6) * SIMG + SOFF_MR + (tid & 63) * 16) = P##mr;                         \
  }
#define SCANS_COMPUTE(SCI)                                                                           \
  _Pragma("unroll 1") for (int cl = 0; cl < SCH && (SCI) * SCH + cl < SEQ / 16; ++cl) {             \
    const char* img = cimg + cl * SIMG;                                                              \
        \
    const uint2 vb = *(const uint2*)(img + 4 * SARR + vrow * SROW + vcol * 2);                       \
    const uint2 gt = *(const uint2*)(img + SOFF_GT + (q * 16 + 4 * g) * 2);                          \
    const char* wp = img + q * SROW + (4 * g) * 2;                                                   \
    const uint2 w00 = *(const uint2*)(wp), w01 = *(const uint2*)(wp + 32);                           \
    const uint2 w10 = *(const uint2*)(wp + 64), w11 = *(const uint2*)(wp + 96);                      \
    const uint2 r00 = *(const uint2*)(wp + SARR), r01 = *(const uint2*)(wp + SARR + 32);             \
    const uint2 r10 = *(const uint2*)(wp + SARR + 64), r11 = *(const uint2*)(wp + SARR + 96);        \
    const uint4 mr = *(const uint4*)(img + SOFF_MR + (q * 32 + g * 8) * 2);                          \
    uint2 bk0[4], bk1[4];                                                                            \
    float4 g15[4];                                                                                   \
    _Pragma("unroll") for (int n = 0; n < 4; ++n) {                                                  \
      const int ch = 16 * n + q;                                                                     \
      const char* bp = img + 2 * SARR + (ch >> 2) * SROW + ((ch & 3) * 16 + 4 * g) * 2;              \
      bk0[n] = *(const uint2*)(bp);                                                                  \
      bk1[n] = *(const uint2*)(bp + SARR);                                                           \
      g15[n] = *(const float4*)(img + SOFF_G15 + (16 * n + 4 * g) * 4);                              \
    }                                                                                                \
    __builtin_amdgcn_sched_barrier(0);                                                               \
    const bf16x8 sB0 = mk8(packacc(acc[0]), packacc(acc[1]));                                        \
    const bf16x8 sB1 = mk8(packacc(acc[2]), packacc(acc[3]));                                        \
    f32x4 Z = {0.f, 0.f, 0.f, 0.f};                                                                  \
    Z = __builtin_amdgcn_mfma_f32_16x16x32_bf16(mk8(gt, zero2), mk8(vb, zero2), Z, 0, 0, 0);         \
    f32x4 Y = {0.f, 0.f, 0.f, 0.f};                                                                  \
    Z = __builtin_amdgcn_mfma_f32_16x16x32_bf16(mk8(w00, w01), sB0, Z, 0, 0, 0);                     \
    Y = __builtin_amdgcn_mfma_f32_16x16x32_bf16(mk8(r00, r01), sB0, Y, 0, 0, 0);                     \
    Z = __builtin_amdgcn_mfma_f32_16x16x32_bf16(mk8(w10, w11), sB1, Z, 0, 0, 0);                     \
    Y = __builtin_amdgcn_mfma_f32_16x16x32_bf16(mk8(r10, r11), sB1, Y, 0, 0, 0);                     \
    const bf16x8 zvB = mk8(packacc(Z), vb);                                                          \
    Y = __builtin_amdgcn_mfma_f32_16x16x32_bf16(__builtin_bit_cast(bf16x8, mr), zvB, Y, 0, 0, 0);    \
    _Pragma("unroll") for (int n = 0; n < 4; ++n) {                                                  \
      f32x4 scv = acc[n];                                                                            \
      scv[0] *= g15[n].x; scv[1] *= g15[n].y; scv[2] *= g15[n].z; scv[3] *= g15[n].w;                \
      acc[n] = __builtin_amdgcn_mfma_f32_16x16x32_bf16(mk8(bk0[n], bk1[n]), zvB, scv, 0, 0, 0);      \
    }                                                                                                \
    _Pragma("unroll") for (int e = 0; e < 4; ++e)                                                    \
        ybuf[(cl * 16 + 4 * g + e) * 16 + q] = (bfu)f2bf(Y[e]);                                      \
  }
DEVI void scans_block(const Params& p, char* smem, int bh, int vs) {
  const int b = bh >> 4, h = bh & 15;
  const int lane = threadIdx.x & 63, wv = threadIdx.x >> 6, q = lane & 15, g = lane >> 4;
  f32x4 acc[4];
#pragma unroll
  for (int n = 0; n < 4; ++n) acc[n] = f32x4{0.f, 0.f, 0.f, 0.f};
  const uint2 zero2 = {0u, 0u};
  bfu* yout = p.YS + ((size_t)b * SEQ) * 1024 + h * 64 + vs * 16;
  char* const img0 = smem;
  char* const img1 = smem + SCH * SIMG;
  bfu* const yb0 = (bfu*)(smem + 2 * SCH * SIMG);
  bfu* const yb1 = yb0 + SCH * 16 * 16;
  const int tid = TIDX;
  const bool stager = wv >= 4;
  const int cl0 = tid >> 7, row0 = (tid >> 3) & 15, c80 = tid & 7;
  uint4 Aa0, Aa1, Ar0, Ar1, Ae0, Ae1, Ak0, Ak1, Av0, Av1, Agm, Ag5, Amr;
  constexpr int NSC = (SEQ / 16) / SCH;
  const int vrow = vs * 4 + (q >> 2), vcol = (q & 3) * 16 + 4 * g;
  if (stager) {
    char* cimg = img0;
    SCANS_ISSUE(A, 0);
    SCANS_COMMIT(A);
    SCANS_ISSUE(A, 1);
  }
  __syncthreads();
#define SCANS_FLUSH(YB, S)                                                                                       \
  if (wv >= 1 && wv <= 2) {                                                                                      \
    const int idx = (int)threadIdx.x - 64, tok = (S) * SCH * 16 + (idx >> 1);                                    \
    *(uint4*)(yout + (size_t)tok * 1024 + (idx & 1) * 8) = *(const uint4*)((YB) + (idx >> 1) * 16 + (idx & 1) * 8); \
  }
#pragma unroll 1
  for (int sc = 0; sc < NSC; sc += 2) {
    if (wv == 0) {
      const char* cimg = img0;
      bfu* ybuf = yb0;
      SCANS_COMPUTE(sc);
    } else if (stager) {
      char* cimg = img1;
      SCANS_COMMIT(A);
      SCANS_ISSUE(A, (sc + 2 < NSC ? sc + 2 : NSC - 1));
    } else if (sc > 0) {
      SCANS_FLUSH(yb1, sc - 1)
    }
    __syncthreads();
    if (wv == 0) {
      const char* cimg = img1;
      bfu* ybuf = yb1;
      SCANS_COMPUTE(sc + 1);
    } else if (stager) {
      char* cimg = img0;
      SCANS_COMMIT(A);
      SCANS_ISSUE(A, (sc + 3 < NSC ? sc + 3 : NSC - 1));
    } else {
      SCANS_FLUSH(yb0, sc)
    }
    __syncthreads();
  }
  SCANS_FLUSH(yb1, NSC - 1)
#undef SCANS_FLUSH
}
DEVI void phase6(const Params& p, char* smem, int bid, int nb) {
  for (int it = bid; it < 128; it += nb) scans_block(p, smem, it >> 2, it & 3);
}

DEVI void phase6b(const Params& p, int bid, int nb) {
  const int lane = threadIdx.x & 63, wv = (threadIdx.x >> 6) & 3;
  for (int it = bid; it < T_TOK / 4; it += nb) {
    const int t0 = it * 4 + (threadIdx.x >> 8) * 2;
    float ys[8], vv[8], sg[8], bon[8];
#pragma unroll
    for (int j = 0; j < 8; ++j) {
      const int t = t0 + (j >> 2), h = wv * 4 + (j & 3);
      const int tb = t & ~15, tau = t & 15;
      const size_t idx = (size_t)t * 1024 + h * 64 + lane;
      ys[j] = bf2f(p.YS[idx]);
      sg[j] = bf2f(p.SG[idx]);
      vv[j] = bf2f(p.V1[(size_t)(tb + (lane >> 2)) * 1024 + h * 64 + (lane & 3) * 16 + tau]);
      bon[j] = p.COEF[(size_t)t * 16 + h];
    }
#pragma unroll
    for (int j = 0; j < 8; ++j) {
      const int t = t0 + (j >> 2), h = wv * 4 + (j & 3);
      const int c = h * 64 + lane;
      const float mean = wave_sum(ys[j]) * (1.f / 64.f);
      const float dv = ys[j] - mean;
      const float var = wave_sum(dv * dv) * (1.f / 64.f);
      float y = dv * rsqrtf(var + 64e-5f) * p.lnw[c] + p.lnb[c];
      y = (y + bon[j] * vv[j]) * sg[j];
      p.YS[(size_t)t * 1024 + c] = (bfu)f2bf(y);
    }
  }
}

DEVI void phase7(const Params& p, char* smem, int bid, int nb) {
  PgEpiRes E{p.out, p.out};
  pg_gemm(smem, p.YS, p.WT_o, T_TOK, 1024, 1024, E, bid, nb);
}
DEVI void phase8(const Params& p, int bid, int nb) {
  for (int it = bid; it < T_TOK / 16; it += nb) {
    const int row = it * 16 + (threadIdx.x >> 6) * 2;
    const int lane = threadIdx.x & 63;
    float* src = p.out + (size_t)row * 1024;
    float4 v[2][4];
    float ss[2] = {0.f, 0.f};
#pragma unroll
    for (int r = 0; r < 2; ++r)
#pragma unroll
      for (int i = 0; i < 4; ++i) v[r][i] = *(const float4*)(src + r * 1024 + lane * 4 + 256 * i);
#pragma unroll
    for (int r = 0; r < 2; ++r)
#pragma unroll
      for (int i = 0; i < 4; ++i)
        ss[r] += v[r][i].x * v[r][i].x + v[r][i].y * v[r][i].y + v[r][i].z * v[r][i].z + v[r][i].w * v[r][i].w;
#pragma unroll
    for (int r = 0; r < 2; ++r) {
      const float rinv = rsqrtf(wave_sum(ss[r]) * (1.f / 1024.f) + 1e-6f);
#pragma unroll
      for (int i = 0; i < 4; ++i) {
        const float4 g = *(const float4*)(p.fnorm + lane * 4 + 256 * i);
        const float4 o = {v[r][i].x * rinv * g.x, v[r][i].y * rinv * g.y, v[r][i].z * rinv * g.z, v[r][i].w * rinv * g.w};
        *(float4*)(src + r * 1024 + lane * 4 + 256 * i) = o;
      }
    }
  }
}

#define XB_TMO      128
#define XB_XCNT(j)  (256  + 64 * (j))
#define XB_XSUB(j)  (1280 + 64 * (j))
#define XB_XGEN(j)  (2304 + 64 * (j))
#define XB_TOP      3328
#define XB_TOPGEN   3392
#define XCD_BAR_WORDS 3456
#define XB_SPIN_CAP (1u << 18)
#define LAS __attribute__((address_space(3)))

__device__ __forceinline__ unsigned xb_ld(unsigned* p)              { return __hip_atomic_load(p, __ATOMIC_RELAXED, __HIP_MEMORY_SCOPE_AGENT); }
__device__ __forceinline__ unsigned xb_add(unsigned* p, unsigned v) { return __hip_atomic_fetch_add(p, v, __ATOMIC_RELAXED, __HIP_MEMORY_SCOPE_AGENT); }
__device__ __forceinline__ unsigned xb_xcc_id() { return (unsigned)__builtin_amdgcn_s_getreg((3 << 11) | 20) & 0xFu; }
#define XB_SPIN(cond, bar) do { unsigned _sp = 0; while (cond) { __builtin_amdgcn_s_sleep(1); \
    if ((++_sp & 255u) == 0u) { if (xb_ld(&(bar)[XB_TMO])) break; if (_sp > XB_SPIN_CAP) { atomicAdd(&(bar)[XB_TMO], 1u); break; } } } } while (0)

struct XcdBarrier {
    unsigned* bar; unsigned x;
    volatile LAS unsigned* st;
};

__device__ __forceinline__ XcdBarrier xcd_barrier_post(unsigned* bar, volatile LAS unsigned* st) {
    XcdBarrier b; b.bar = bar; b.x = xb_xcc_id(); b.st = st;
    if (threadIdx.x == 0) (void)xb_add(&bar[XB_XCNT(b.x)], 1u);
    return b;
}
__device__ __forceinline__ void xcd_barrier_complete(unsigned* bar, unsigned x, unsigned& nloc, unsigned& nx) {
    const unsigned G = gridDim.x * gridDim.y * gridDim.z;
    unsigned sum, cnt, mine, sp = 0u;
    for (;;) {
        sum = 0u; cnt = 0u; mine = 0u;
#pragma unroll
        for (unsigned j = 0; j < 16; ++j) { const unsigned c = xb_ld(&bar[XB_XCNT(j)]); sum += c; cnt += (c > 0u) ? 1u : 0u; mine = (j == x) ? c : mine; }
        if (sum == G) break;
        __builtin_amdgcn_s_sleep(1);
        if ((++sp & 255u) == 0u) { if (xb_ld(&bar[XB_TMO])) break; if (sp > XB_SPIN_CAP) { atomicAdd(&bar[XB_TMO], 1u); break; } }
    }
    nloc = mine > 0u ? mine : 1u; nx = cnt > 0u ? cnt : 1u;
}

__device__ __forceinline__ void xcd_barrier(const XcdBarrier& b) {
    asm volatile("s_waitcnt vmcnt(0)" ::: "memory");
    __syncthreads();
    if (threadIdx.x == 0) {
        unsigned* bar = b.bar;
        __builtin_amdgcn_s_waitcnt(0);
        unsigned nloc = b.st[0], nx = b.st[1];
        if (nloc == 0u) { xcd_barrier_complete(bar, b.x, nloc, nx); b.st[0] = nloc; b.st[1] = nx; }
        const unsigned old = xb_add(&bar[XB_XSUB(b.x)], 1u);
        const unsigned gen = old / nloc;
        if (old + 1u == (gen + 1u) * nloc) {
            __builtin_amdgcn_fence(__ATOMIC_RELEASE, "agent");
            asm volatile("s_waitcnt vmcnt(0)" ::: "memory");
            const unsigned og = xb_add(&bar[XB_TOP], 1u);
            const unsigned tg = og / nx;
            if (og + 1u == (tg + 1u) * nx) xb_add(&bar[XB_TOPGEN], 1u);
            else XB_SPIN(xb_ld(&bar[XB_TOPGEN]) == tg, bar);
            __builtin_amdgcn_fence(__ATOMIC_ACQUIRE, "agent");
            xb_add(&bar[XB_XGEN(b.x)], 1u);
            asm volatile("s_waitcnt vmcnt(0)" ::: "memory");
        } else {
            XB_SPIN(xb_ld(&bar[XB_XGEN(b.x)]) == gen, bar);
            __builtin_amdgcn_fence(__ATOMIC_ACQUIRE, "agent");
            asm volatile("s_waitcnt vmcnt(0)" ::: "memory");
        }
    }
    __syncthreads();
}


template <int PH>
DEVI void run_phase(const Params& p, char* smem, int bid, int nb) {
  if (PH == 0) phase0(p, smem, bid, nb);
  if (PH == 1) phase1(p, smem, bid, nb);
  if (PH == 2) phase2(p, smem, bid, nb);
  if (PH == 3) phase3(p, smem, bid, nb);
  if (PH == 4) phase3b(p, bid, nb);
  if (PH == 5) phaseM(p, smem, bid, nb);
  if (PH == 6) phase3a(p, smem, bid, nb);
  if (PH == 7) phase3c(p, smem, bid, nb);
  if (PH == 8) phase5(p, smem, bid, nb);
  if (PH == 9) phase6x(p, smem, bid, nb);
  if (PH == 10) phase6(p, smem, bid, nb);
  if (PH == 11) phase6b(p, bid, nb);
  if (PH == 12) phase7(p, smem, bid, nb);
  if (PH == 13) phase8(p, bid, nb);
}

#ifndef REP_MASK
#define REP_MASK 0
#endif
template <int PH>
DEVI void mega_phase(const Params& p, char* smem, cg::grid_group& grid, int bid, int nb) {
  run_phase<PH>(p, smem, bid, nb);
  if ((REP_MASK >> PH) & 1) {
    grid.sync();
    run_phase<PH>(p, smem, bid, nb);
  }
}
__global__ void __launch_bounds__(512, 2) mega_kernel(Params pk) {
  const Params& p = *(const Params*)__builtin_amdgcn_kernarg_segment_ptr();
  extern __shared__ __attribute__((aligned(16))) char smem[];
  cg::grid_group grid = cg::this_grid();
  const int bid = blockIdx.x, nb = gridDim.x;
  volatile LAS unsigned* st = (volatile LAS unsigned*)(smem + SMEM_BYTES);
  if (threadIdx.x == 0) {
    st[0] = 0u;
    st[1] = 0u;
  }
  __syncthreads();
  (void)xcd_barrier_post(p.BAR, st);
#define XBAR() do { XcdBarrier xb_; xb_.bar = p.BAR; xb_.x = xb_xcc_id(); xb_.st = (volatile LAS unsigned*)(smem + SMEM_BYTES); xcd_barrier(xb_); } while (0)
  mega_phase<0>(p, smem, grid, bid, nb); grid.sync();
  mega_phase<1>(p, smem, grid, bid, nb); XBAR();
  mega_phase<2>(p, smem, grid, bid, nb); XBAR();
  mega_phase<3>(p, smem, grid, bid, nb); XBAR();
  mega_phase<4>(p, smem, grid, bid, nb); XBAR();
  mega_phase<5>(p, smem, grid, bid, nb); XBAR();
  mega_phase<6>(p, smem, grid, bid, nb); XBAR();
  mega_phase<7>(p, smem, grid, bid, nb); XBAR();
  mega_phase<8>(p, smem, grid, bid, nb); XBAR();
  mega_phase<9>(p, smem, grid, bid, nb); XBAR();
  mega_phase<10>(p, smem, grid, bid, nb); XBAR();
  mega_phase<11>(p, smem, grid, bid, nb); XBAR();
  mega_phase<12>(p, smem, grid, bid, nb); grid.sync();
  mega_phase<13>(p, smem, grid, bid, nb);
}

extern "C" void kernel_launch(void* const* d_in, const int* in_sizes, int n_in, void* d_out, int out_size, void* d_ws,
                              size_t ws_size, hipStream_t stream) {
  Params p{};
  const float** fp = (const float**)&p;
  for (int i = 0; i < 26; ++i) fp[i] = (const float*)d_in[i];
  p.out = (float*)d_out;
  char* w = (char*)d_ws;
  size_t off = 0;
  auto take = [&](size_t bytes) {
    char* r = w + off;
    off += (bytes + 255) & ~(size_t)255;
    return (bfu*)r;
  };
  p.WT_in = take((size_t)3584 * 1024 * 2);
  p.WT_out = take((size_t)1024 * 1024 * 2);
  p.WT_3 = take((size_t)4352 * 1024 * 2);
  p.WT_o = take((size_t)1024 * 1024 * 2);
  p.W2T = take((size_t)1024 * 64 * 2);
  p.A2T = take((size_t)1024 * 64 * 2);
  p.TW = take((size_t)T_TOK * 64 * 2);
  p.TA = take((size_t)T_TOK * 64 * 2);
  const size_t SLOT = (size_t)T_TOK * 1024 * 2;
  bfu* slot0 = take(SLOT);
  bfu* slots = take(6 * SLOT);
  p.H = slot0;
  p.AA = slot0;
  p.U = slots;
  p.GVT = slots + SLOT / 4;
  p.Q = slots + 2 * (SLOT / 4);
  p.K = slots + 3 * (SLOT / 4);
  p.VT = slots + 4 * (SLOT / 4);
  p.SZ = slots + 7 * (SLOT / 4);
  p.Y = slots + 9 * (SLOT / 4);
  p.R = slots;
  p.K1 = slots + 1 * (SLOT / 2);
  p.XV = slots + 2 * (SLOT / 2);
  p.XG = slots + 3 * (SLOT / 2);
  p.XR = slots + 4 * (SLOT / 2);
  p.XK = slots + 5 * (SLOT / 2);
  p.V1 = slots + 4 * (SLOT / 2);
  p.SG = slots + 5 * (SLOT / 2);
  p.EW = slots + 2 * (SLOT / 2);
  p.YS = slots + 3 * (SLOT / 2);
  p.G15 = (float*)p.TW;
  p.GT = p.WT_in;
  p.MRT = take((size_t)(SEQ / 16) * 32 * 512 * 2);
  p.COEF = (float*)take((size_t)T_TOK * 16 * 4);
  p.BAR = (unsigned*)take((size_t)XCD_BAR_WORDS * 4);
  if (off > ws_size) {
    fprintf(stderr, "workspace too small: need %zu have %zu\n", off, ws_size);
    return;
  }
  static int grid_blocks = 0;
  if (!grid_blocks) {
    int dev = 0, cus = 0, per_cu = 0;
    (void)hipGetDevice(&dev);
    (void)hipDeviceGetAttribute(&cus, hipDeviceAttributeMultiprocessorCount, dev);
    (void)hipFuncSetAttribute((const void*)mega_kernel, hipFuncAttributeMaxDynamicSharedMemorySize, SMEM_BYTES + 16);
    (void)hipOccupancyMaxActiveBlocksPerMultiprocessor(&per_cu, mega_kernel, 512, SMEM_BYTES + 16);
    grid_blocks = cus * per_cu;
  }
  (void)hipMemsetAsync(p.BAR, 0, (size_t)XCD_BAR_WORDS * 4, stream);
  void* args[] = {&p};
  hipError_t e = hipLaunchCooperativeKernel((void*)mega_kernel, dim3(grid_blocks), dim3(512), args, SMEM_BYTES + 16, stream);
  if (e != hipSuccess) fprintf(stderr, "cooperative launch failed: %s (grid %d)\n", hipGetErrorString(e), grid_blocks);
}
```

```cpp
#include <hip/hip_runtime.h>
#include <hip/hip_cooperative_groups.h>
#include <stdint.h>
#include <cstdio>
namespace cg = cooperative_groups;

#ifndef MEGA
#define MEGA 1
#endif

typedef unsigned short bfu;
using bf16x8 = __attribute__((ext_vector_type(8))) short;
using f32x4 = __attribute__((ext_vector_type(4))) float;
#define DEVI __device__ __forceinline__
#define TIDX ((int)(threadIdx.x & 255))
#define HF ((int)(threadIdx.x >> 8))

constexpr int GSTAGE_BYTES = 2 * 128 * 72 * 2;
constexpr int T_TOK = 32768;
constexpr int SEQ = 16384;
constexpr int HALF_SMEM = 2 * GSTAGE_BYTES + 4096 + 512;
constexpr int SMEM_BYTES = 2 * HALF_SMEM;
constexpr int SMEM_UNUSED_ = 0;

struct Params {
  const float *x, *ln_even, *w_in, *gm_norm, *gm_ws, *gm_b, *w_out, *ln_odd, *mu, *wr, *wk, *wv, *wg, *w0, *w1, *w2,
      *a0, *a1, *a2, *k_k, *k_a, *r_k, *lnw, *lnb, *wo, *fnorm;
  float* out;
  bfu *WT_in, *WT_out, *WT_3, *WT_o, *W2T, *A2T;
  bfu *H, *U, *GVT, *Q, *K, *VT, *SZ, *Y, *R, *K1, *V1, *SG, *EW, *AA, *YS, *TW, *TA, *GT, *MRT, *XR, *XK, *XV, *XG;
  float *G15, *COEF;
  unsigned* BAR;
};

DEVI float bf2f(unsigned b) { return __uint_as_float(b << 16); }
DEVI unsigned f2bf(float x) {
  const __bf16 h = (__bf16)x;
  return (unsigned)__builtin_bit_cast(unsigned short, h);
}
typedef __bf16 bf16x2_t __attribute__((ext_vector_type(2)));
typedef float float2_t __attribute__((ext_vector_type(2)));
DEVI unsigned pkbf(float a, float b) {
  const float2_t f = {a, b};
  const bf16x2_t h = __builtin_convertvector(f, bf16x2_t);
  return __builtin_bit_cast(unsigned, h);
}
DEVI void unpack8(uint4 v, float* f) {
  f[0] = __uint_as_float(v.x << 16); f[1] = __uint_as_float(v.x & 0xffff0000u);
  f[2] = __uint_as_float(v.y << 16); f[3] = __uint_as_float(v.y & 0xffff0000u);
  f[4] = __uint_as_float(v.z << 16); f[5] = __uint_as_float(v.z & 0xffff0000u);
  f[6] = __uint_as_float(v.w << 16); f[7] = __uint_as_float(v.w & 0xffff0000u);
}
DEVI uint4 pack8(const float* f) {
  uint4 r;
  r.x = pkbf(f[0], f[1]);
  r.y = pkbf(f[2], f[3]);
  r.z = pkbf(f[4], f[5]);
  r.w = pkbf(f[6], f[7]);
  return r;
}
DEVI void unpack4(uint2 v, float* f) {
  f[0] = __uint_as_float(v.x << 16); f[1] = __uint_as_float(v.x & 0xffff0000u);
  f[2] = __uint_as_float(v.y << 16); f[3] = __uint_as_float(v.y & 0xffff0000u);
}
DEVI uint2 pack4(const float* f) {
  uint2 r;
  r.x = pkbf(f[0], f[1]);
  r.y = pkbf(f[2], f[3]);
  return r;
}

DEVI float sigmoid_(float x) { return __builtin_amdgcn_rcpf(1.f + __expf(-x)); }
DEVI float silu_(float x) { return x * sigmoid_(x); }
DEVI float tanh_(float y) { return 1.f - 2.f * __builtin_amdgcn_rcpf(1.f + __expf(2.f * y)); }
DEVI float gelu_(float x) {
  const float y = 0.7978845608028654f * (x + 0.044715f * x * x * x);
  return x * __builtin_amdgcn_rcpf(1.f + __expf(-2.f * y));
}
DEVI float wave_sum(float v) {
#pragma unroll
  for (int o = 32; o > 0; o >>= 1) v += __shfl_xor(v, o);
  return v;
}
DEVI float wave_max(float v) {
#pragma unroll
  for (int o = 32; o > 0; o >>= 1) v = fmaxf(v, __shfl_xor(v, o));
  return v;
}
template <int CTRL>
DEVI float dppf(float x) {
  return __int_as_float(__builtin_amdgcn_update_dpp(0, __float_as_int(x), CTRL, 0xF, 0xF, true));
}
DEVI float reduce16(float x) {
  x += dppf<0xB1>(x);
  x += dppf<0x4E>(x);
  x += dppf<0x141>(x);
  x += dppf<0x140>(x);
  return x;
}

constexpr int LROW = 72;
constexpr int GSTAGE = 2 * 128 * LROW;

template <int DIST = 2, bool SW = true, class ALoad, class Epi>
DEVI void gemm_tile(char* smem, const ALoad& aload, const bfu* __restrict__ Bt, int ldb, int K, int m0, int n0,
                    const Epi& epi) {
  bfu* sbase = (bfu*)smem;
  const int tid = TIDX, lane = tid & 63, wid = tid >> 6, wr = wid >> 1, wc = wid & 1;
  const int fr = lane & 15, fq = lane >> 4;
  f32x4 acc[4][4];
#pragma unroll
  for (int i = 0; i < 4; ++i)
#pragma unroll
    for (int j = 0; j < 4; ++j) acc[i][j] = f32x4{0.f, 0.f, 0.f, 0.f};
  const int r0 = tid >> 3, kc = (tid & 7) * 8;
  const int nk = K >> 6;
  struct GRegs { typename ALoad::Raw a0, a1, a2, a3; uint4 ap, b0, b1, b2, b3; };
  GRegs g0, g1;
  const bfu* Bp = Bt + (size_t)(n0 + r0) * ldb + kc;
  const size_t ldb32 = (size_t)ldb * 32;
  constexpr int ARS = ALoad::kConsec ? 1 : 32;
  const int ar0 = ALoad::kConsec ? 4 * r0 : r0;
#define GEMM_ISSUE(R, KT)                                   \
  {                                                         \
    const int k0_ = ((KT) << 6);                            \
    R.ap = aload.loadprev(m0 + ar0, k0_ + kc);              \
    R.a0 = aload.load(m0 + ar0, k0_ + kc);                  \
    R.a1 = aload.load(m0 + ar0 + ARS, k0_ + kc);            \
    R.a2 = aload.load(m0 + ar0 + 2 * ARS, k0_ + kc);        \
    R.a3 = aload.load(m0 + ar0 + 3 * ARS, k0_ + kc);        \
    R.b0 = *(const uint4*)(Bp + k0_);                       \
    R.b1 = *(const uint4*)(Bp + ldb32 + k0_);               \
    R.b2 = *(const uint4*)(Bp + 2 * ldb32 + k0_);           \
    R.b3 = *(const uint4*)(Bp + 3 * ldb32 + k0_);           \
  }
#define GEMM_COMMIT(R, S, KT)                               \
  {                                                         \
    const int k1_ = ((KT) << 6) + kc;                       \
    bfu* A_ = sbase + (S) * GSTAGE + ar0 * LROW + kc;       \
    bfu* B_ = sbase + (S) * GSTAGE + 128 * LROW + r0 * LROW + kc;   \
    *(uint4*)(A_) = aload.finish(R.a0, R.ap, m0 + ar0, k1_);                                 \
    *(uint4*)(A_ + ARS * LROW) = aload.finish(R.a1, aload.asprev(R.a0), m0 + ar0 + ARS, k1_);          \
    *(uint4*)(A_ + 2 * ARS * LROW) = aload.finish(R.a2, aload.asprev(R.a1), m0 + ar0 + 2 * ARS, k1_);  \
    *(uint4*)(A_ + 3 * ARS * LROW) = aload.finish(R.a3, aload.asprev(R.a2), m0 + ar0 + 3 * ARS, k1_);  \
    *(uint4*)(B_) = R.b0;                                   \
    *(uint4*)(B_ + 32 * LROW) = R.b1;                       \
    *(uint4*)(B_ + 64 * LROW) = R.b2;                       \
    *(uint4*)(B_ + 96 * LROW) = R.b3;                       \
  }
#define GEMM_COMPUTE(S)                                                                          \
  {                                                                                              \
    const bfu* cA = sbase + (S) * GSTAGE;                                                        \
    const bfu* cB = cA + 128 * LROW;                                                             \
    _Pragma("unroll") for (int ks = 0; ks < 2; ++ks) {                                           \
      bf16x8 af[4], bfv[4];                                                                      \
      _Pragma("unroll") for (int i = 0; i < 4; ++i) {                                            \
        af[i] = *(const bf16x8*)(cA + (wr * 64 + i * 16 + fr) * LROW + ks * 32 + fq * 8);        \
        bfv[i] = *(const bf16x8*)(cB + (wc * 64 + i * 16 + fr) * LROW + ks * 32 + fq * 8);       \
      }                                                                                          \
      _Pragma("unroll") for (int i = 0; i < 4; ++i) _Pragma("unroll") for (int j = 0; j < 4; ++j) \
          acc[i][j] = SW ? __builtin_amdgcn_mfma_f32_16x16x32_bf16(bfv[j], af[i], acc[i][j], 0, 0, 0)     \
                         : __builtin_amdgcn_mfma_f32_16x16x32_bf16(af[i], bfv[j], acc[i][j], 0, 0, 0);    \
    }                                                                                            \
  }
  const int nkm1 = nk - 1;
  if (DIST == 2 && nk == 1) {
    GEMM_ISSUE(g0, 0);
    GEMM_COMMIT(g0, 0, 0);
    __syncthreads();
    GEMM_COMPUTE(0);
    __syncthreads();
  } else if (DIST == 2) {
    GEMM_ISSUE(g0, 0);
    GEMM_ISSUE(g1, (1 < nkm1 ? 1 : nkm1));
    GEMM_COMMIT(g0, 0, 0);
    GEMM_ISSUE(g0, (2 < nkm1 ? 2 : nkm1));
    __syncthreads();
    {
      for (int kt = 0; kt < nk; kt += 2) {
        GEMM_COMMIT(g1, 1, (kt + 1 < nkm1 ? kt + 1 : nkm1));
        GEMM_ISSUE(g1, (kt + 3 < nkm1 ? kt + 3 : nkm1));
        GEMM_COMPUTE(0);
        __syncthreads();
        GEMM_COMMIT(g0, 0, (kt + 2 < nkm1 ? kt + 2 : nkm1));
        GEMM_ISSUE(g0, (kt + 4 < nkm1 ? kt + 4 : nkm1));
        GEMM_COMPUTE(1);
        __syncthreads();
      }
    }
  } else {
    GEMM_ISSUE(g0, 0);
    GEMM_COMMIT(g0, 0, 0);
    GEMM_ISSUE(g0, (1 < nkm1 ? 1 : nkm1));
    __syncthreads();
    for (int kt = 0; kt < nk; kt += 2) {
      GEMM_COMMIT(g0, 1, (kt + 1 < nkm1 ? kt + 1 : nkm1));
      GEMM_ISSUE(g0, (kt + 2 < nkm1 ? kt + 2 : nkm1));
      GEMM_COMPUTE(0);
      __syncthreads();
      GEMM_COMMIT(g0, 0, (kt + 2 < nkm1 ? kt + 2 : nkm1));
      GEMM_ISSUE(g0, (kt + 3 < nkm1 ? kt + 3 : nkm1));
      GEMM_COMPUTE(1);
      __syncthreads();
    }
  }
#pragma unroll
  for (int i = 0; i < 4; ++i)
#pragma unroll
    for (int j = 0; j < 4; ++j) {
      if (SW) epi(m0 + wr * 64 + i * 16 + fr, n0 + wc * 64 + j * 16 + fq * 4, acc[i][j]);
      else epi(m0 + wr * 64 + i * 16 + fq * 4, n0 + wc * 64 + j * 16 + fr, acc[i][j]);
    }
}

namespace pg8 {
#define PG8_LAS __attribute__((address_space(3)))
typedef unsigned short bf16_t;
typedef short bf16x8 __attribute__((ext_vector_type(8)));
typedef float f32x4 __attribute__((ext_vector_type(4)));
typedef unsigned u32x4 __attribute__((ext_vector_type(4)));
constexpr int BM = 256, BK = 64, HALF = 128, HTB = HALF * BK * 2  , STAGE_BYTES = 8 * HTB, NXCD = 8, WGM = 8;

__host__ __device__ __forceinline__ int lds_byte(int r, int c) { const int st = (r >> 4) * 2 + (c >> 5), rr = r & 15, cc = c & 31, ob = rr * 64 + cc * 2; return st * 1024 + (ob ^ (((ob >> 9) & 1) << 5)); }
__host__ __device__ __forceinline__ void stage_rc(int b, int& R, int& C) { const int st = b / 1024, sb = b % 1024, swz = sb ^ (((sb >> 9) & 1) << 5); R = (st >> 1) * 16 + swz / 64; C = (st & 1) * 32 + (swz % 64) / 2; }
__host__ __device__ __forceinline__ int perm32(int rho) { const int n = rho >> 4, i = rho & 15; return 8 * (i >> 2) + 4 * n + (i & 3); }

struct Unit { int pm, pn; };
struct Gemm { const bf16_t* A; const bf16_t* Bt; int M, N, K; const bf16_t* A2; int pn_split; unsigned long long rmap, cmap;
  __device__ __forceinline__ size_t rt(int pm) const { return rmap ? (size_t)((rmap >> (4 * pm)) & 15ull) : (size_t)pm; }
  __device__ __forceinline__ size_t ct(int pn) const { return cmap ? (size_t)((cmap >> (4 * pn)) & 15ull) : (size_t)pn; } };

struct StaticOrder {
    int nM, nN, nwg, G, c;
    __host__ __device__ void init(int M, int N, int G_, int c_) { nM = M / BM; nN = N / BM; nwg = nM * nN; G = G_; c = c_; }
    __host__ __device__ bool next(int i, Unit& u) const {
        const long L = (long)i * G + c; if (L >= nwg) return false;
        int wgid = (int)L; { const int q = nwg / NXCD, r = nwg % NXCD, xcd = wgid % NXCD, off = wgid / NXCD; wgid = (xcd < r ? xcd * (q + 1) : r * (q + 1) + (xcd - r) * q) + off; }
        const int nig = WGM * nN, gid = wgid / nig, fm = gid * WGM, gsz = (nM - fm) < WGM ? (nM - fm) : WGM;
        u.pm = fm + ((wgid % nig) % gsz); u.pn = (wgid % nig) / gsz; return true;
    }
    __device__ __forceinline__ void a_ready(const Unit&) const {}
    __device__ __forceinline__ void done(const Unit&) const {}
};
struct CountedOrder : StaticOrder {
    const unsigned* ready; unsigned need; unsigned* tmo;
    __device__ __forceinline__ void a_ready(const Unit& u) const {
        if (threadIdx.x < 64) {
            const unsigned long long t0 = __builtin_amdgcn_s_memrealtime(); unsigned polls = 0;
            while ((unsigned)__builtin_amdgcn_readfirstlane(__hip_atomic_load(ready + 64 * u.pm, __ATOMIC_RELAXED, __HIP_MEMORY_SCOPE_AGENT)) < need) {
                if ((++polls & 255u) == 0u && __builtin_amdgcn_readfirstlane(__hip_atomic_load(tmo, __ATOMIC_RELAXED, __HIP_MEMORY_SCOPE_AGENT)) != 0u) break;
                if (__builtin_amdgcn_s_memrealtime() - t0 > 2000000ull) {
                    if (threadIdx.x == 0) { unsigned expect = 0u; __hip_atomic_compare_exchange_strong(tmo + 1, &expect, 0x600u | (unsigned)(u.pm & 0xff), __ATOMIC_RELAXED, __ATOMIC_RELAXED, __HIP_MEMORY_SCOPE_AGENT); __hip_atomic_store(tmo, 1u, __ATOMIC_RELAXED, __HIP_MEMORY_SCOPE_AGENT); }
                    break; }
                __builtin_amdgcn_s_sleep(2); }
            __builtin_amdgcn_fence(__ATOMIC_ACQUIRE, "agent");
            asm volatile("s_waitcnt vmcnt(0)" ::: "memory");
        }
#if !defined(BROKEN_HOOK_NO_BARRIER)
        asm volatile("" ::: "memory"); __builtin_amdgcn_s_barrier(); asm volatile("" ::: "memory");
#endif
    }
};

__device__ __forceinline__ unsigned cvt_pk_bf16(float lo, float hi) { unsigned r; asm volatile("v_cvt_pk_bf16_f32 %0, %1, %2" : "=v"(r) : "v"(lo), "v"(hi)); return r; }
typedef float f32x2 __attribute__((ext_vector_type(2)));
__device__ __forceinline__ f32x2 gelu_pk(f32x2 v) {
    const f32x2 av = __builtin_elementwise_abs(v), d = av * 0.2316418882f + 1.0f;
    f32x2 t; t.x = __builtin_amdgcn_rcpf(d.x); t.y = __builtin_amdgcn_rcpf(d.y);
    f32x2 q = t * 0.5307027145f + (-0.7265760135f); q = q * t + 0.7107068705f; q = q * t + (-0.142248368f); q = q * t + 0.127414796f; q = q * t;
    const f32x2 s = (v * v) * (-0.72134752044f);
    f32x2 e; e.x = __builtin_amdgcn_exp2f(s.x); e.y = __builtin_amdgcn_exp2f(s.y);
    const f32x2 m = v * (q * e), r = v - m;
    f32x2 o; o.x = v.x < 0.f ? m.x : r.x; o.y = v.y < 0.f ? m.y : r.y; return o;
}

struct EpiF32 {
    static constexpr bool PERM = false, AFTER_DRAIN = false;
    float* C; int ldc; const float* bias;
    __device__ __forceinline__ void operator()(const f32x4 (&acc)[2][2][4][2], const Unit& u, int wr, int wc, int fr, int fq) const {
        const int row0 = u.pm * BM + wr * 64 + fr, col0 = u.pn * BM + wc * 32 + 4 * fq;
        f32x4 bv[2][2];
#pragma unroll
        for (int bj = 0; bj < 2; ++bj)
#pragma unroll
            for (int n = 0; n < 2; ++n) bv[bj][n] = bias ? *(const f32x4*)(bias + col0 + bj * HALF + n * 16) : (f32x4){0.f, 0.f, 0.f, 0.f};
#pragma unroll
        for (int ai = 0; ai < 2; ++ai)
#pragma unroll
            for (int m = 0; m < 4; ++m) { float* rowp = C + (size_t)(row0 + ai * HALF + m * 16) * ldc + col0;
#pragma unroll
                for (int bj = 0; bj < 2; ++bj)
#pragma unroll
                    for (int n = 0; n < 2; ++n) *(f32x4*)(rowp + bj * HALF + n * 16) = acc[ai][bj][m][n] + bv[bj][n]; }
    }
};
template <int ACT  > struct EpiBf16 {
    static constexpr bool PERM = true, AFTER_DRAIN = false;
    bf16_t* O; int ldc; const float* bias; int split_cols; size_t split_stride;
    __device__ __forceinline__ void operator()(const f32x4 (&acc)[2][2][4][2], const Unit& u, int wr, int wc, int fr, int fq) const {
        const int row0 = u.pm * BM + wr * 64 + fr; int colt = u.pn * BM; bf16_t* base = O;
        if (split_cols) { const int t = colt / split_cols; base += (size_t)t * split_stride; colt -= t * split_cols; }
        const int col0 = colt + wc * 32 + 8 * fq, bcol0 = u.pn * BM + wc * 32 + 8 * fq;
        f32x4 bv[2][2];
#pragma unroll
        for (int bj = 0; bj < 2; ++bj)
#pragma unroll
            for (int n = 0; n < 2; ++n) bv[bj][n] = bias ? *(const f32x4*)(bias + bcol0 + bj * HALF + 4 * n) : (f32x4){0.f, 0.f, 0.f, 0.f};
#pragma unroll
        for (int ai = 0; ai < 2; ++ai)
#pragma unroll
            for (int m = 0; m < 4; ++m) { bf16_t* rowp = base + (size_t)(row0 + ai * HALF + m * 16) * ldc + col0;
#pragma unroll
                for (int bj = 0; bj < 2; ++bj) { f32x4 v0 = acc[ai][bj][m][0] + bv[bj][0], v1 = acc[ai][bj][m][1] + bv[bj][1];
                    if (ACT == 1) { f32x2 a = gelu_pk((f32x2){v0[0], v0[1]}), b = gelu_pk((f32x2){v0[2], v0[3]}), c = gelu_pk((f32x2){v1[0], v1[1]}), d = gelu_pk((f32x2){v1[2], v1[3]});
                        v0 = (f32x4){a.x, a.y, b.x, b.y}; v1 = (f32x4){c.x, c.y, d.x, d.y}; }
                    if (ACT == 2) {
#pragma unroll
                        for (int j = 0; j < 4; ++j) { v0[j] = 0.5f * v0[j] * (1.0f + erff(v0[j] * 0.70710678f)); v1[j] = 0.5f * v1[j] * (1.0f + erff(v1[j] * 0.70710678f)); } }
                    u32x4 w; w.x = cvt_pk_bf16(v0[0], v0[1]); w.y = cvt_pk_bf16(v0[2], v0[3]); w.z = cvt_pk_bf16(v1[0], v1[1]); w.w = cvt_pk_bf16(v1[2], v1[3]);
                    *(u32x4*)(rowp + bj * HALF) = w; } }
    }
};


template <class Epi, class Sched, bool STAMP = false>
__device__ __forceinline__ void gemm_phase(PG8_LAS unsigned char* lds, const Gemm g, const Sched& S, const Epi& E, unsigned long long* stamps) {
    const int tid = threadIdx.x, wid = __builtin_amdgcn_readfirstlane(tid >> 6), lane = tid & 63, wr = wid >> 2, wc = wid & 3, fr = lane & 15, fq = lane >> 4;
    const int K = g.K, nt = K / BK;
    int ts_lo = 0, ts_hi = 0, nts = 0; const unsigned long long rt_entry = STAMP ? (unsigned long long)wall_clock64() : 0ull;
#define PG8_STAMP() do { if (STAMP && wid == 0 && nts < 64) { const unsigned long long _c = (unsigned long long)clock64(); \
        ts_lo = (lane == nts) ? (int)(unsigned)_c : ts_lo; ts_hi = (lane == nts) ? (int)(unsigned)(_c >> 32) : ts_hi; ++nts; } } while (0)
    PG8_STAMP();
    unsigned voffA[2], voffB[2];
#pragma unroll
    for (int i = 0; i < 2; ++i) { int R, C; stage_rc(tid * 16 + i * 8192, R, C); const int Rb = Epi::PERM ? ((R & ~31) + perm32(R & 31)) : R;
        voffA[i] = (unsigned)(R * K + C) * 2u; voffB[i] = (unsigned)(Rb * K + C) * 2u; }
    const size_t kstep = (size_t)(BK * 2);
    const size_t hstep = (size_t)HALF * K * 2;
    const size_t tstep = 2 * hstep;
    const unsigned ldsw = (unsigned)wid * 1024u;
    const int aoff = lds_byte(wr * 64 + fr, fq * 8), boff = lds_byte(wc * 32 + fr, fq * 8);
#define PG8_SA(b, h) (((b) * 2 + (h)) * HTB)
#define PG8_SB(b, h) ((4 + (b) * 2 + (h)) * HTB)
#define PG8_STAGE(bufoff, gbase, voff) do { _Pragma("unroll") for (int _i = 0; _i < 2; ++_i) \
        __builtin_amdgcn_global_load_lds((const unsigned*)((const char*)(gbase) + (voff)[_i]), (PG8_LAS unsigned*)(lds + (bufoff) + ldsw + _i * 8192), 16, 0, 0); } while (0)
#define PG8_LDA(dst, b, h) do { _Pragma("unroll") for (int m = 0; m < 4; ++m) _Pragma("unroll") for (int k = 0; k < 2; ++k) dst[m][k] = *(const PG8_LAS bf16x8*)(lds + PG8_SA(b, h) + aoff + m * 2048 + k * 1024); } while (0)
#define PG8_LDB(dst, b, h) do { _Pragma("unroll") for (int n = 0; n < 2; ++n) _Pragma("unroll") for (int k = 0; k < 2; ++k) dst[n][k] = *(const PG8_LAS bf16x8*)(lds + PG8_SB(b, h) + boff + n * 2048 + k * 1024); } while (0)
#define PG8_MMA(ai, bj, At, Bt) do { __builtin_amdgcn_s_setprio(1); _Pragma("unroll") for (int m = 0; m < 4; ++m) _Pragma("unroll") for (int n = 0; n < 2; ++n) _Pragma("unroll") for (int k = 0; k < 2; ++k) \
        acc[ai][bj][m][n] = __builtin_amdgcn_mfma_f32_16x16x32_bf16(Bt[n][k], At[m][k], acc[ai][bj][m][n], 0, 0, 0); __builtin_amdgcn_s_setprio(0); } while (0)
#define PG8_WAIT_V(n) asm volatile("s_waitcnt vmcnt(" #n ")" ::: "memory")
#define PG8_WAIT_L(n) asm volatile("s_waitcnt lgkmcnt(" #n ")" ::: "memory")
#define PG8_BAR __builtin_amdgcn_s_barrier()
#define PG8_SCHED __builtin_amdgcn_sched_barrier(0)
    Unit cur, nxt; int ui = 0;
    if (!S.next(0, cur)) return;
    f32x4 acc[2][2][4][2];
#pragma unroll
    for (int a = 0; a < 2; ++a)
#pragma unroll
        for (int b = 0; b < 2; ++b)
#pragma unroll
            for (int m = 0; m < 4; ++m)
#pragma unroll
                for (int n = 0; n < 2; ++n) acc[a][b][m][n] = (f32x4){0.f, 0.f, 0.f, 0.f};
    bf16x8 At[4][2], B0[2][2], B1[2][2];
    const char* cA = (const char*)(cur.pn >= g.pn_split ? g.A2 : g.A) + g.rt(cur.pm) * tstep; const char* cB = (const char*)g.Bt + g.ct(cur.pn) * tstep;
    S.a_ready(cur);
    PG8_STAGE(PG8_SB(0, 0), cB, voffB); PG8_STAGE(PG8_SA(0, 0), cA, voffA); PG8_STAGE(PG8_SB(0, 1), cB + hstep, voffB); PG8_STAGE(PG8_SA(0, 1), cA + hstep, voffA);
    if (wr == 1) PG8_BAR;
    PG8_WAIT_V(4); PG8_BAR;
    PG8_STAGE(PG8_SB(1, 0), cB + kstep, voffB); PG8_STAGE(PG8_SA(1, 0), cA + kstep, voffA); PG8_STAGE(PG8_SB(1, 1), cB + hstep + kstep, voffB);
    PG8_WAIT_V(6); PG8_BAR;
    PG8_STAMP();
    for (;;) {
        const bool has_next = S.next(ui + 1, nxt);
        const char* nA = has_next ? (const char*)(nxt.pn >= g.pn_split ? g.A2 : g.A) + g.rt(nxt.pm) * tstep : cA; const char* nB = has_next ? (const char*)g.Bt + g.ct(nxt.pn) * tstep : cB;
        for (int t = 0; t < nt; t += 2) {
            const bool last = (t == nt - 2);
            const char* a1 = cA + (size_t)(t + 1) * kstep;
            const char* a2 = last ? nA : cA + (size_t)(t + 2) * kstep; const char* b2 = last ? nB : cB + (size_t)(t + 2) * kstep;
            const char* a3 = a2 + kstep; const char* b3 = b2 + kstep;
            if (last && has_next) S.a_ready(nxt);
            PG8_LDB(B0, 0, 0); PG8_SCHED; PG8_LDA(At, 0, 0); PG8_STAGE(PG8_SA(1, 1), a1 + hstep, voffA);
            PG8_WAIT_L(8); PG8_BAR; PG8_WAIT_L(0); PG8_MMA(0, 0, At, B0); PG8_BAR; PG8_SCHED;
            PG8_LDB(B1, 0, 1); PG8_STAGE(PG8_SB(0, 0), b2, voffB);
            PG8_BAR; PG8_WAIT_L(0); PG8_MMA(0, 1, At, B1); PG8_BAR;
            PG8_LDA(At, 0, 1); PG8_STAGE(PG8_SA(0, 0), a2, voffA);
            PG8_BAR; PG8_WAIT_L(0); PG8_MMA(1, 0, At, B0); PG8_BAR; PG8_SCHED;
            PG8_STAGE(PG8_SB(0, 1), b2 + hstep, voffB);
            PG8_WAIT_V(6); PG8_BAR; PG8_MMA(1, 1, At, B1); PG8_BAR;
            PG8_LDB(B0, 1, 0); PG8_SCHED; PG8_LDA(At, 1, 0); PG8_STAGE(PG8_SA(0, 1), a2 + hstep, voffA);
            PG8_WAIT_L(8); PG8_BAR; PG8_WAIT_L(0); PG8_MMA(0, 0, At, B0); PG8_BAR; PG8_SCHED;
            PG8_LDB(B1, 1, 1); PG8_STAGE(PG8_SB(1, 0), b3, voffB);
            PG8_BAR; PG8_WAIT_L(0); PG8_MMA(0, 1, At, B1); PG8_BAR;
            PG8_LDA(At, 1, 1); PG8_STAGE(PG8_SA(1, 0), a3, voffA);
            PG8_BAR; PG8_WAIT_L(0); PG8_MMA(1, 0, At, B0); PG8_BAR; PG8_SCHED;
            PG8_STAGE(PG8_SB(1, 1), b3 + hstep, voffB);
            PG8_WAIT_V(6); PG8_BAR; PG8_MMA(1, 1, At, B1); PG8_BAR;
        }
        PG8_STAMP();
        if constexpr (!Epi::AFTER_DRAIN) { E(acc, cur, wr, wc, fr, fq); S.done(cur); }
        PG8_STAMP();
        if (!has_next) break;
#pragma unroll
        for (int a = 0; a < 2; ++a)
#pragma unroll
            for (int b = 0; b < 2; ++b)
#pragma unroll
                for (int m = 0; m < 4; ++m)
#pragma unroll
                    for (int n = 0; n < 2; ++n) acc[a][b][m][n] = (f32x4){0.f, 0.f, 0.f, 0.f};
        cur = nxt; cA = nA; cB = nB; ++ui;
    }
    PG8_WAIT_V(0);
    if (wr == 0) PG8_BAR;
    PG8_BAR;
    if constexpr (Epi::AFTER_DRAIN) { E.fused(acc, cur, wr, wc, fr, fq, lds, wid, lane); S.done(cur); }
    PG8_STAMP();
    if (STAMP && wid == 0) { stamps[lane] = lane < nts ? (((unsigned long long)(unsigned)ts_hi << 32) | (unsigned)ts_lo) : 0ull;
        if (lane == 62) stamps[62] = rt_entry; if (lane == 63) stamps[63] = (unsigned long long)wall_clock64(); }
#undef PG8_STAMP
#undef PG8_SA
#undef PG8_SB
#undef PG8_STAGE
#undef PG8_LDA
#undef PG8_LDB
#undef PG8_MMA
#undef PG8_WAIT_V
#undef PG8_WAIT_L
#undef PG8_BAR
#undef PG8_SCHED
}
}

struct TileSched {
  int xcd, local, vbid, vnb, MT, NT, SM, SN, j, snc;
  bool swz;
  DEVI TileSched(int bid, int nb, int half, int MT_, int NT_, int SM_, int SN_) : MT(MT_), NT(NT_), SM(SM_), SN(SN_), j(0) {
    xcd = bid & 7;
    local = (bid >> 3) * 2 + half;
    vbid = bid * 2 + half;
    vnb = nb * 2;
    swz = (vnb == 8 * SM * SN) && ((nb & 7) == 0);
    snc = (NT + SN - 1) / SN;
  }
  DEVI int next(int& mt, int& nt) {
    if (swz) {
      const int s = j * 8 + xcd;
      ++j;
      const int sm = s / snc, sn = s - sm * snc;
      if (sm * SM >= MT) return 0;
      mt = sm * SM + local / SN;
      nt = sn * SN + local % SN;
      return (mt < MT && nt < NT) ? 1 : 2;
    } else {
      const int it = vbid + j * vnb;
      ++j;
      if (it >= MT * NT) return 0;
      mt = it / NT;
      nt = it - mt * NT;
      return 1;
    }
  }
};

struct ALoadPlain {
  typedef uint4 Raw;
  static constexpr bool kFat = false;
  static constexpr bool kConsec = false;
  const bfu* A;
  int lda;
  DEVI Raw load(int row, int k) const { return *(const uint4*)(A + (size_t)row * lda + k); }
  DEVI uint4 loadprev(int, int) const { return uint4{0u, 0u, 0u, 0u}; }
  DEVI uint4 asprev(const Raw&) const { return uint4{0u, 0u, 0u, 0u}; }
  DEVI uint4 finish(const Raw& r, const uint4&, int, int) const { return r; }
};

DEVI void transpose_tile(char* smem, const float* __restrict__ src, int Ns, bfu* __restrict__ dst, int ldd, int noff,
                         int k0, int n0) {
  float(*tile)[65] = (float(*)[65])smem;
  const int tid = TIDX;
  const int kr = tid >> 4, nc = (tid & 15) * 4;
#pragma unroll
  for (int p = 0; p < 4; ++p) {
    float4 v = *(const float4*)(src + (size_t)(k0 + kr + 16 * p) * Ns + n0 + nc);
    tile[kr + 16 * p][nc] = v.x;
    tile[kr + 16 * p][nc + 1] = v.y;
    tile[kr + 16 * p][nc + 2] = v.z;
    tile[kr + 16 * p][nc + 3] = v.w;
  }
  __syncthreads();
  const int nr = tid >> 3, kc = (tid & 7) * 8;
#pragma unroll
  for (int p = 0; p < 2; ++p) {
    const int n = nr + 32 * p;
    float f[8];
#pragma unroll
    for (int j = 0; j < 8; ++j) f[j] = tile[kc + j][n];
    *(uint4*)(dst + (size_t)(noff + n0 + n) * ldd + k0 + kc) = pack8(f);
  }
  __syncthreads();
}

template <int R>
DEVI void rms_rows_bf16(const float* __restrict__ src, const float* __restrict__ g, bfu* __restrict__ dst, int lane) {
  float4 v[R][4];
  float ss[R];
#pragma unroll
  for (int r = 0; r < R; ++r) {
    ss[r] = 0.f;
#pragma unroll
    for (int i = 0; i < 4; ++i) v[r][i] = *(const float4*)(src + r * 1024 + lane * 4 + 256 * i);
  }
#pragma unroll
  for (int r = 0; r < R; ++r)
#pragma unroll
    for (int i = 0; i < 4; ++i)
      ss[r] += v[r][i].x * v[r][i].x + v[r][i].y * v[r][i].y + v[r][i].z * v[r][i].z + v[r][i].w * v[r][i].w;
#pragma unroll
  for (int r = 0; r < R; ++r) {
    const float rinv = rsqrtf(wave_sum(ss[r]) * (1.f / 1024.f) + 1e-6f);
#pragma unroll
    for (int i = 0; i < 4; ++i) {
      const float4 gg = *(const float4*)(g + lane * 4 + 256 * i);
      uint2 o;
      o.x = pkbf(v[r][i].x * rinv * gg.x, v[r][i].y * rinv * gg.y);
      o.y = pkbf(v[r][i].z * rinv * gg.z, v[r][i].w * rinv * gg.w);
      *(uint2*)(dst + r * 1024 + lane * 4 + 256 * i) = o;
    }
  }
}
DEVI void rms_row2_bf16(const float* __restrict__ src, const float* __restrict__ g, bfu* __restrict__ dst, int lane) {
  rms_rows_bf16<2>(src, g, dst, lane);
}

DEVI void phase0(const Params& p, char* smem, int bid, int nb) {
  constexpr int NT_IN = 16 * 56, NT_SQ = 256, NT_SM = 16;
  constexpr int c0 = NT_IN, c1 = c0 + NT_SQ, c2 = c1 + 4 * NT_SQ, c3 = c2 + NT_SM, c4 = c3 + NT_SM, c5 = c4 + NT_SQ,
                c6 = c5 + NT_SM, c7 = c6 + NT_SM, c8 = c7 + 2, c9 = c8 + T_TOK / 8;
  smem += HF * HALF_SMEM;
  for (int it = bid * 2 + HF; it < c9; it += nb * 2) {
    if (it < c0) {
      transpose_tile(smem, p.w_in, 3584, p.WT_in, 1024, 0, (it / 56) * 64, (it % 56) * 64);
    } else if (it < c1) {
      int j = it - c0;
      transpose_tile(smem, p.w_out, 1024, p.WT_out, 1024, 0, (j >> 4) * 64, (j & 15) * 64);
    } else if (it < c2) {
      int j = it - c1;
      int w = j >> 8;
      j &= 255;
      const float* src = (w == 0) ? p.wr : (w == 1) ? p.wk : (w == 2) ? p.wv : p.wg;
      transpose_tile(smem, src, 1024, p.WT_3, 1024, w * 1024, (j >> 4) * 64, (j & 15) * 64);
    } else if (it < c3) {
      int j = it - c2;
      transpose_tile(smem, p.w1, 64, p.WT_3, 1024, 4096, j * 64, 0);
    } else if (it < c4) {
      int j = it - c3;
      transpose_tile(smem, p.a1, 64, p.WT_3, 1024, 4224, j * 64, 0);
    } else if (it < c5) {
      int j = it - c4;
      transpose_tile(smem, p.wo, 1024, p.WT_o, 1024, 0, (j >> 4) * 64, (j & 15) * 64);
    } else if (it < c6) {
      int j = it - c5;
      transpose_tile(smem, p.w2, 1024, p.W2T, 64, 0, 0, j * 64);
    } else if (it < c7) {
      int j = it - c6;
      transpose_tile(smem, p.a2, 1024, p.A2T, 64, 0, 0, j * 64);
    } else if (it < c8) {
      int j = it - c7;
      bfu* dst = p.WT_3 + (size_t)(j == 0 ? 4160 : 4288) * 1024;
      for (int e = TIDX; e < 64 * 1024 / 8; e += 256) *(uint4*)(dst + e * 8) = uint4{0, 0, 0, 0};
    } else {
      int row = (it - c8) * 8 + (TIDX >> 6) * 2;
      rms_row2_bf16(p.x + (size_t)row * 1024, p.ln_even, p.H + (size_t)row * 1024, TIDX & 63);
    }
  }
}

constexpr unsigned long long kCmap1 = 0xDCBA765410ull;
struct PgEpi1 {
  static constexpr bool PERM = true, AFTER_DRAIN = false;
  const Params* p;
  DEVI void operator()(const pg8::f32x4 (&acc)[2][2][4][2], const pg8::Unit& u, int wr, int wc, int fr, int fq) const {
    const int row0 = u.pm * 256 + wr * 64 + fr;
    const int seg = (int)((kCmap1 >> (4 * u.pn)) & 15ull);
#pragma unroll
    for (int ai = 0; ai < 2; ++ai)
#pragma unroll
      for (int m = 0; m < 4; ++m) {
        const int row = row0 + ai * 128 + m * 16;
#pragma unroll
        for (int bj = 0; bj < 2; ++bj) {
          const int col = seg * 256 + bj * 128 + wc * 32 + 8 * fq;
          const f32x4 v0 = acc[ai][bj][m][0], v1 = acc[ai][bj][m][1];
          uint4 w;
          if (seg < 2) {
            w.x = pkbf(gelu_(v0[0]), gelu_(v0[1])); w.y = pkbf(gelu_(v0[2]), gelu_(v0[3]));
            w.z = pkbf(gelu_(v1[0]), gelu_(v1[1])); w.w = pkbf(gelu_(v1[2]), gelu_(v1[3]));
            *(uint4*)(p->U + (size_t)row * 512 + col) = w;
          } else if (seg < 8) {
            w.x = pkbf(v0[0], v0[1]); w.y = pkbf(v0[2], v0[3]); w.z = pkbf(v1[0], v1[1]); w.w = pkbf(v1[2], v1[3]);
            bfu* dst = (seg < 6) ? p->Q + (size_t)row * 512 + (col - 1024) : p->K + (size_t)row * 512 + (col - 1536);
            *(uint4*)dst = w;
          } else {
            w.x = pkbf(silu_(v0[0]), silu_(v0[1])); w.y = pkbf(silu_(v0[2]), silu_(v0[3]));
            w.z = pkbf(silu_(v1[0]), silu_(v1[1])); w.w = pkbf(silu_(v1[2]), silu_(v1[3]));
            *(uint4*)(p->SZ + (size_t)row * 1024 + (col - 2560)) = w;
          }
        }
      }
  }
};
constexpr unsigned long long kRmap1 = 0x9832ull;
struct PgEpi1T {
  static constexpr bool PERM = true, AFTER_DRAIN = false;
  const Params* p;
  DEVI void operator()(const pg8::f32x4 (&acc)[2][2][4][2], const pg8::Unit& u, int wr, int wc, int fr, int fq) const {
    const int ch0 = (u.pm & 1) * 256 + wr * 64 + fr;
    const bool isv = u.pm >= 2;
#pragma unroll
    for (int ai = 0; ai < 2; ++ai)
#pragma unroll
      for (int m = 0; m < 4; ++m) {
        const int ch = ch0 + ai * 128 + m * 16;
#pragma unroll
        for (int bj = 0; bj < 2; ++bj) {
          const int t = u.pn * 256 + bj * 128 + wc * 32 + 8 * fq;
          const f32x4 v0 = acc[ai][bj][m][0], v1 = acc[ai][bj][m][1];
          if (!isv) {
            const int g = ch >> 7, c = ch & 127;
            uint4 w;
            w.x = pkbf(gelu_(v0[0]), gelu_(v0[1])); w.y = pkbf(gelu_(v0[2]), gelu_(v0[3]));
            w.z = pkbf(gelu_(v1[0]), gelu_(v1[1])); w.w = pkbf(gelu_(v1[2]), gelu_(v1[3]));
            *(uint4*)(p->GVT + ((size_t)(((t >> 7) * 4 + g) * 128 + c)) * 128 + (t & 127)) = w;
          } else {
            const int hh = ch >> 6, dim = ch & 63;
            const int b = t >> 14, s = t & (SEQ - 1);
            bfu* base = p->VT + ((size_t)((b * 8 + hh) * 64 + dim)) * SEQ;
            const size_t PST = (size_t)16 * 64 * SEQ;
            uint4 w;
            w.x = pkbf(v0[0], v0[1]); w.y = pkbf(v0[2], v0[3]); w.z = pkbf(v1[0], v1[1]); w.w = pkbf(v1[2], v1[3]);
            *(uint4*)(base + s) = w;
            bfu* b1 = base + PST + (s >> 2);
#pragma unroll
            for (int e = 0; e < 4; ++e) *(unsigned*)(b1 + (size_t)e * (SEQ / 4)) = pkbf(v0[e], v1[e]);
            bfu* b2 = base + 2 * PST + (size_t)(s & 15) * (SEQ / 16) + (s >> 4);
#pragma unroll
            for (int e = 0; e < 4; ++e) {
              b2[(size_t)e * (SEQ / 16)] = (bfu)f2bf(v0[e]);
              b2[(size_t)(e + 4) * (SEQ / 16)] = (bfu)f2bf(v1[e]);
            }
          }
        }
      }
  }
};
struct PgEpiRes {
  static constexpr bool PERM = false, AFTER_DRAIN = false;
  const float* base;
  float* out;
  DEVI void operator()(const pg8::f32x4 (&acc)[2][2][4][2], const pg8::Unit& u, int wr, int wc, int fr, int fq) const {
    const int row0 = u.pm * 256 + wr * 64 + fr, col0 = u.pn * 256 + wc * 32 + 4 * fq;
#pragma unroll
    for (int ai = 0; ai < 2; ++ai)
#pragma unroll
      for (int m = 0; m < 4; ++m) {
        const size_t rb = (size_t)(row0 + ai * 128 + m * 16) * 1024 + col0;
#pragma unroll
        for (int bj = 0; bj < 2; ++bj)
#pragma unroll
          for (int n = 0; n < 2; ++n) {
            const size_t idx = rb + bj * 128 + n * 16;
            const f32x4 b = *(const f32x4*)(base + idx);
            *(f32x4*)(out + idx) = acc[ai][bj][m][n] + b;
          }
      }
  }
};
template <class Epi>
DEVI void pg_gemm(char* smem, const bfu* A, const bfu* Bt, int M, int N, int K, const Epi& E, int bid, int nb) {
  pg8::Gemm g{A, Bt, M, N, K, A, 1 << 30, 0ull, 0ull};
  pg8::StaticOrder S;
  S.init(M, N, nb, bid);
  pg8::gemm_phase<Epi, pg8::StaticOrder, false>((PG8_LAS unsigned char*)smem, g, S, E, nullptr);
}
template <class Epi>
DEVI void pg_gemm2(char* smem, const bfu* A, const bfu* A2, int pn_split, const bfu* Bt, int M, int N, int K, const Epi& E,
                   int bid, int nb) {
  pg8::Gemm g{A, Bt, M, N, K, A2, pn_split, 0ull, 0ull};
  pg8::StaticOrder S;
  S.init(M, N, nb, bid);
  pg8::gemm_phase<Epi, pg8::StaticOrder, false>((PG8_LAS unsigned char*)smem, g, S, E, nullptr);
}
struct PgEpi3 {
  static constexpr bool PERM = true, AFTER_DRAIN = false;
  bfu* O0;
  bfu* O1;
  int silu1;
  DEVI void operator()(const pg8::f32x4 (&acc)[2][2][4][2], const pg8::Unit& u, int wr, int wc, int fr, int fq) const {
    const int row0 = u.pm * 256 + wr * 64 + fr;
    const int grp = u.pn >> 2;
    bfu* O = grp ? O1 : O0;
    const bool act = grp && silu1;
    const int colb = (u.pn & 3) * 256 + wc * 32 + 8 * fq;
#pragma unroll
    for (int ai = 0; ai < 2; ++ai)
#pragma unroll
      for (int m = 0; m < 4; ++m) {
        bfu* rowp = O + (size_t)(row0 + ai * 128 + m * 16) * 1024 + colb;
#pragma unroll
        for (int bj = 0; bj < 2; ++bj) {
          f32x4 v0 = acc[ai][bj][m][0], v1 = acc[ai][bj][m][1];
          if (act) {
#pragma unroll
            for (int e = 0; e < 4; ++e) {
              v0[e] = silu_(v0[e]);
              v1[e] = silu_(v1[e]);
            }
          }
          uint4 w;
          w.x = pkbf(v0[0], v0[1]); w.y = pkbf(v0[2], v0[3]); w.z = pkbf(v1[0], v1[1]); w.w = pkbf(v1[2], v1[3]);
          *(uint4*)(rowp + bj * 128) = w;
        }
      }
  }
};

DEVI void phase1(const Params& p, char* smem, int bid, int nb) {
  {
    PgEpi1 E{&p};
    pg8::Gemm g{p.H, p.WT_in, T_TOK, 2560, 1024, p.H, 1 << 30, 0ull, kCmap1};
    pg8::StaticOrder S;
    S.init(T_TOK, 2560, nb, bid);
    pg8::gemm_phase<PgEpi1, pg8::StaticOrder, false>((PG8_LAS unsigned char*)smem, g, S, E, nullptr);
  }
  {
    PgEpi1T E{&p};
    pg8::Gemm g{p.WT_in, p.H, 1024, T_TOK, 1024, p.WT_in, 1 << 30, kRmap1, 0ull};
    pg8::StaticOrder S;
    S.init(1024, T_TOK, nb, bid);
    pg8::gemm_phase<PgEpi1T, pg8::StaticOrder, false>((PG8_LAS unsigned char*)smem, g, S, E, nullptr);
  }
}

struct ALoadWs {
  struct Raw { float4 a, b; };
  static constexpr bool kFat = true;
  static constexpr bool kConsec = false;
  const float* ws;
  const float* rinv;
  DEVI Raw load(int t, int s0) const {
    Raw r;
    r.a = *(const float4*)(ws + t * 128 + s0);
    r.b = *(const float4*)(ws + t * 128 + s0 + 4);
    return r;
  }
  DEVI uint4 loadprev(int, int) const { return uint4{0u, 0u, 0u, 0u}; }
  DEVI uint4 asprev(const Raw&) const { return uint4{0u, 0u, 0u, 0u}; }
  DEVI uint4 finish(const Raw& r, const uint4&, int t, int s0) const {
    float f[8] = {r.a.x, r.a.y, r.a.z, r.a.w, r.b.x, r.b.y, r.b.z, r.b.w};
#pragma unroll
    for (int j = 0; j < 8; ++j) f[j] = (s0 + j <= t) ? f[j] * rinv[s0 + j] : 0.f;
    return pack8(f);
  }
};
struct EpiGm {
  const Params* p;
  int chunk, g;
  DEVI void operator()(int t, int c, f32x4 v) const {
    const float4 gn = *(const float4*)(p->gm_norm + g * 128 + c);
    const float bias = p->gm_b[g * 128 + t];
    const size_t tok = (size_t)chunk * 128 + t;
    float u[4], sz[4];
    unpack4(*(const uint2*)(p->U + tok * 512 + g * 128 + c), u);
    unpack4(*(const uint2*)(p->SZ + tok * 1024 + g * 128 + c), sz);
    uint2 o;
    o.x = pkbf(u[0] * (v[0] * gn.x + bias) * sz[0], u[1] * (v[1] * gn.y + bias) * sz[1]);
    o.y = pkbf(u[2] * (v[2] * gn.z + bias) * sz[2], u[3] * (v[3] * gn.w + bias) * sz[3]);
    *(uint2*)(p->Y + tok * 1024 + g * 128 + c) = o;
  }
};

DEVI void gmlp_item(const Params& p, char* smem, int item) {
  const int chunk = item >> 2, g = item & 3;
  const bfu* gv = p.GVT + (size_t)item * 128 * 128;
  float* rinv = (float*)(smem + 2 * GSTAGE_BYTES);
  const int tid = TIDX;
  {
    float* sred = rinv + 128;
    const int s4 = (tid & 31) * 4, cg = tid >> 5;
    uint2 raw[16];
#pragma unroll
    for (int i = 0; i < 16; ++i) raw[i] = *(const uint2*)(gv + (cg * 16 + i) * 128 + s4);
    float ss[4] = {0.f, 0.f, 0.f, 0.f};
#pragma unroll
    for (int i = 0; i < 16; ++i) {
      float f[4];
      unpack4(raw[i], f);
#pragma unroll
      for (int j = 0; j < 4; ++j) ss[j] += f[j] * f[j];
    }
    *(float4*)(sred + cg * 128 + s4) = float4{ss[0], ss[1], ss[2], ss[3]};
    __syncthreads();
    if (tid < 128) {
      float t = 0.f;
#pragma unroll
      for (int i = 0; i < 8; ++i) t += sred[i * 128 + tid];
      rinv[tid] = rsqrtf(t * (1.f / 128.f) + 1e-6f);
    }
  }
  __syncthreads();
  ALoadWs al{p.gm_ws + (size_t)g * 128 * 128, rinv};
  EpiGm epi{&p, chunk, g};
  gemm_tile(smem, al, gv, 128, 128, 0, 0, epi);
}

DEVI void attn_item(const Params& p, char* smem, int item) {
  const int qb = item & 63, bh = item >> 6, b = bh >> 3, h = bh & 7;
  const int q0 = qb * 256;
  bfu* Ob = (bfu*)smem;
  float* Mb = (float*)(smem + 32768);
  float* Lb = Mb + 256;
  const int tid = threadIdx.x, lane = tid & 63, wid = tid >> 6;
  const int qi = lane & 15, g = lane >> 4;
  const float slope = exp2f(-(float)(h + 1));
  const size_t tokb = (size_t)b * SEQ;
#pragma unroll 1
  for (int pi = 0; pi < 3; ++pi) {
    const int dshift = 2 * pi, d = 1 << dshift;
    const bfu* VT = p.VT + (size_t)pi * ((size_t)16 * 64 * SEQ) + (size_t)bh * 64 * SEQ;
#pragma unroll 1
    for (int u = wid; u < 16; u += 8) {
      const int r = u & (d - 1), tile = u >> dshift;
      const int sq0 = (q0 >> dshift) + tile * 16;
      const int sk0 = sq0 - 144;
      const int posq = ((sq0 + qi) << dshift) + r;
      const bfu* qp = p.Q + (tokb + posq) * 512 + h * 64 + g * 8;
      const bf16x8 qf0 = *(const bf16x8*)qp, qf1 = *(const bf16x8*)(qp + 32);
      const bfu* kbase = p.K + (tokb + r) * 512 + h * 64 + g * 8;
      const bfu* vbase = VT + (size_t)qi * SEQ + r * (SEQ >> dshift);
      bf16x8 kf[2][2];
      uint2 vf[4][2];
      auto loadk = [&](int it) {
#pragma unroll
        for (int tt = 0; tt < 2; ++tt) {
          int sk = sk0 + (2 * it + tt) * 16 + qi;
          sk = sk < 0 ? 0 : sk;
          const bfu* kp = kbase + ((size_t)sk << dshift) * 512;
          kf[tt][0] = *(const bf16x8*)kp;
          kf[tt][1] = *(const bf16x8*)(kp + 32);
        }
      };
      auto loadv = [&](int it) {
        int kidx0 = sk0 + 32 * it + 4 * g, kidx1 = kidx0 + 16;
        kidx0 = kidx0 < 0 ? 0 : kidx0;
        kidx1 = kidx1 < 0 ? 0 : kidx1;
#pragma unroll
        for (int m = 0; m < 4; ++m) {
          vf[m][0] = *(const uint2*)(vbase + (size_t)(16 * m) * SEQ + kidx0);
          vf[m][1] = *(const uint2*)(vbase + (size_t)(16 * m) * SEQ + kidx1);
        }
      };
      loadk(0);
      loadv(0);
      const int hi = 144 + qi, lo = (16 + qi > -sk0) ? 16 + qi : -sk0;
      const float sd = slope * (float)d;
      float mrun = -1e30f, l = 0.f;
      f32x4 O[4];
#pragma unroll
      for (int m = 0; m < 4; ++m) O[m] = f32x4{0.f, 0.f, 0.f, 0.f};
#pragma unroll 1
      for (int it = 0; it < 5; ++it) {
        bf16x8 ck[2][2];
        uint2 cv[4][2];
#pragma unroll
        for (int a = 0; a < 2; ++a)
#pragma unroll
          for (int c = 0; c < 2; ++c) ck[a][c] = kf[a][c];
        const int itn = it < 4 ? it + 1 : 4;
        loadk(itn);
        f32x4 S[2];
#pragma unroll
        for (int tt = 0; tt < 2; ++tt) {
          f32x4 z = {0.f, 0.f, 0.f, 0.f};
          z = __builtin_amdgcn_mfma_f32_16x16x32_bf16(ck[tt][0], qf0, z, 0, 0, 0);
          z = __builtin_amdgcn_mfma_f32_16x16x32_bf16(ck[tt][1], qf1, z, 0, 0, 0);
          S[tt] = z;
        }
        float mx = -INFINITY;
#pragma unroll
        for (int tt = 0; tt < 2; ++tt)
#pragma unroll
          for (int e = 0; e < 4; ++e) {
            const int kb = (2 * it + tt) * 16 + 4 * g;
            const bool valid = (kb >= lo - e) && (kb <= hi - e);
            const float sv = valid ? fmaf(S[tt][e], 0.125f, sd * (float)e - sd * (float)(hi - kb)) : -INFINITY;
            S[tt][e] = sv;
            mx = fmaxf(mx, sv);
          }
        mx = fmaxf(mx, __shfl_xor(mx, 16));
        mx = fmaxf(mx, __shfl_xor(mx, 32));
        const float mnew = fmaxf(mrun, mx);
        const float alpha = __expf(mrun - mnew);
        mrun = mnew;
        float ls = 0.f;
#pragma unroll
        for (int tt = 0; tt < 2; ++tt)
#pragma unroll
          for (int e = 0; e < 4; ++e) {
            const float pe = __expf(S[tt][e] - mnew);
            S[tt][e] = pe;
            ls += pe;
          }
        l = l * alpha + ls;
        uint4 pk;
        pk.x = pkbf(S[0][0], S[0][1]);
        pk.y = pkbf(S[0][2], S[0][3]);
        pk.z = pkbf(S[1][0], S[1][1]);
        pk.w = pkbf(S[1][2], S[1][3]);
        const bf16x8 pf = __builtin_bit_cast(bf16x8, pk);
#pragma unroll
        for (int m = 0; m < 4; ++m) {
          cv[m][0] = vf[m][0];
          cv[m][1] = vf[m][1];
        }
        loadv(itn);
#pragma unroll
        for (int m = 0; m < 4; ++m) {
          O[m] *= alpha;
          const uint4 vv = {cv[m][0].x, cv[m][0].y, cv[m][1].x, cv[m][1].y};
          O[m] = __builtin_amdgcn_mfma_f32_16x16x32_bf16(__builtin_bit_cast(bf16x8, vv), pf, O[m], 0, 0, 0);
        }
      }
      l += __shfl_xor(l, 16);
      l += __shfl_xor(l, 32);
      const float mx = mrun;
      const float il = 1.f / l;
      const int ql = ((tile * 16 + qi) << dshift) + r;
      float wo = 0.f, wn = 1.f;
      float mnew = mx, lnew = l;
      if (pi > 0) {
        const float mo = Mb[ql], lo = Lb[ql];
        mnew = fmaxf(mo, mx);
        wo = lo * __expf(mo - mnew);
        wn = l * __expf(mx - mnew);
        lnew = wo + wn;
        const float inv = 1.f / lnew;
        wo *= inv;
        wn *= inv;
      }
      wn *= il;
#pragma unroll
      for (int m = 0; m < 4; ++m) {
        bfu* op = Ob + ql * 64 + 16 * m + 4 * g;
        float o[4];
        if (pi > 0) {
          const uint2 ov = *(const uint2*)op;
          o[0] = wo * bf2f(ov.x & 0xffffu) + wn * O[m][0];
          o[1] = wo * bf2f(ov.x >> 16) + wn * O[m][1];
          o[2] = wo * bf2f(ov.y & 0xffffu) + wn * O[m][2];
          o[3] = wo * bf2f(ov.y >> 16) + wn * O[m][3];
        } else {
#pragma unroll
          for (int e = 0; e < 4; ++e) o[e] = wn * O[m][e];
        }
        if (pi < 2) {
          uint2 w;
          w.x = pkbf(o[0], o[1]);
          w.y = pkbf(o[2], o[3]);
          *(uint2*)op = w;
        } else {
          const size_t oi = (tokb + q0 + ql) * 1024 + 512 + h * 64 + 16 * m + 4 * g;
          const uint2 sz = *(const uint2*)(p.SZ + oi);
          uint2 w;
          w.x = pkbf(o[0] * bf2f(sz.x & 0xffffu), o[1] * bf2f(sz.x >> 16));
          w.y = pkbf(o[2] * bf2f(sz.y & 0xffffu), o[3] * bf2f(sz.y >> 16));
          *(uint2*)(p.Y + oi) = w;
        }
      }
      if (pi < 2 && g == 0) {
        Mb[ql] = mnew;
        Lb[ql] = lnew;
      }
    }
    __syncthreads();
  }
}

DEVI void phase2(const Params& p, char* smem, int bid, int nb) {
  for (int it = bid; it < 16 * 64; it += nb) attn_item(p, smem, it);
  char* hs = smem + HF * HALF_SMEM;
  for (int it = bid * 2 + HF; it < (T_TOK / 128) * 4; it += nb * 2) gmlp_item(p, hs, it);
}

DEVI void phase3(const Params& p, char* smem, int bid, int nb) {
  PgEpiRes E{p.x, p.out};
  pg_gemm(smem, p.Y, p.WT_out, T_TOK, 1024, 1024, E, bid, nb);
}
DEVI void phase3b(const Params& p, int bid, int nb) {
  for (int it = bid; it < T_TOK / 32; it += nb) {
    const int row = it * 32 + (threadIdx.x >> 6) * 4;
    rms_rows_bf16<4>(p.out + (size_t)row * 1024, p.ln_odd, p.H + (size_t)row * 1024, threadIdx.x & 63);
  }
}

struct ALoadMix {
  typedef uint4 Raw;
  static constexpr bool kFat = true;
  static constexpr bool kConsec = true;
  const bfu* H;
  const float* mu;
  DEVI Raw load(int row, int k) const { return *(const uint4*)(H + (size_t)row * 1024 + k); }
  DEVI uint4 loadprev(int row, int k) const {
    const int prow = ((row & (SEQ - 1)) != 0) ? row - 1 : row;
    return *(const uint4*)(H + (size_t)prow * 1024 + k);
  }
  DEVI uint4 asprev(const Raw& r) const { return r; }
  DEVI uint4 finish(const Raw& r, const uint4& pr, int row, int k) const {
    float c[8], pv[8];
    unpack8(r, c);
    unpack8(pr, pv);
    const float first = ((row & (SEQ - 1)) != 0) ? 1.f : 0.f;
    const float4 m0 = *(const float4*)(mu + k), m1 = *(const float4*)(mu + k + 4);
    const float mm[8] = {m0.x, m0.y, m0.z, m0.w, m1.x, m1.y, m1.z, m1.w};
#pragma unroll
    for (int j = 0; j < 8; ++j) c[j] = c[j] + (pv[j] * first - c[j]) * mm[j];
    return pack8(c);
  }
};
struct Epi4 {
  const Params* p;
  int nt;
  DEVI void operator()(int row, int col, f32x4 v) const {
    uint2 o;
    if (nt < 24) {
      o.x = pkbf(v[0], v[1]);
      o.y = pkbf(v[2], v[3]);
      bfu* dst = (nt < 8) ? p->R + (size_t)row * 1024 + col
                          : (nt < 16) ? p->K1 + (size_t)row * 1024 + col - 1024 : p->V1 + (size_t)row * 1024 + col - 2048;
      *(uint2*)dst = o;
    } else if (nt < 32) {
      o.x = pkbf(silu_(v[0]), silu_(v[1]));
      o.y = pkbf(silu_(v[2]), silu_(v[3]));
      *(uint2*)(p->SG + (size_t)row * 1024 + col - 3072) = o;
    } else if (nt == 32) {
      const int c = col - 4096;
      if (c < 64) {
        o.x = pkbf(tanh_(v[0]), tanh_(v[1]));
        o.y = pkbf(tanh_(v[2]), tanh_(v[3]));
        *(uint2*)(p->TW + (size_t)row * 64 + c) = o;
      }
    } else {
      const int c = col - 4224;
      if (c < 64) {
        o.x = pkbf(v[0], v[1]);
        o.y = pkbf(v[2], v[3]);
        *(uint2*)(p->TA + (size_t)row * 64 + c) = o;
      }
    }
  }
};
DEVI void phase4_tile(const Params& p, char* smem, int mt, int nt) {
  float* smu = (float*)(smem + 2 * GSTAGE_BYTES);
  const int mi = (nt < 8) ? 0 : (nt < 16) ? 2 : (nt < 24) ? 3 : (nt < 32) ? 5 : (nt == 32) ? 1 : 4;
  *(float4*)(smu + TIDX * 4) = *(const float4*)(p.mu + mi * 1024 + TIDX * 4);
  __syncthreads();
  ALoadMix al{p.H, smu};
  Epi4 epi{&p, nt};
  gemm_tile<1>(smem, al, p.WT_3, 1024, 1024, mt * 128, nt * 128, epi);
}
DEVI void phaseM(const Params& p, char* smem, int bid, int nb) {
  char* hs = smem + HF * HALF_SMEM;
  for (int it = bid * 2 + HF; it < (T_TOK / 128) * 2; it += nb * 2) phase4_tile(p, hs, it >> 1, 32 + (it & 1));
  const int tid = threadIdx.x;
  const int cc = (tid & 127) * 8, rsub = tid >> 7;
  float mr[8], mk[8], mv[8], mg[8];
  {
    const float4 a0 = *(const float4*)(p.mu + 0 * 1024 + cc), a1 = *(const float4*)(p.mu + 0 * 1024 + cc + 4);
    const float4 b0 = *(const float4*)(p.mu + 2 * 1024 + cc), b1 = *(const float4*)(p.mu + 2 * 1024 + cc + 4);
    const float4 c0 = *(const float4*)(p.mu + 3 * 1024 + cc), c1 = *(const float4*)(p.mu + 3 * 1024 + cc + 4);
    const float4 d0 = *(const float4*)(p.mu + 5 * 1024 + cc), d1 = *(const float4*)(p.mu + 5 * 1024 + cc + 4);
    mr[0] = a0.x; mr[1] = a0.y; mr[2] = a0.z; mr[3] = a0.w; mr[4] = a1.x; mr[5] = a1.y; mr[6] = a1.z; mr[7] = a1.w;
    mk[0] = b0.x; mk[1] = b0.y; mk[2] = b0.z; mk[3] = b0.w; mk[4] = b1.x; mk[5] = b1.y; mk[6] = b1.z; mk[7] = b1.w;
    mv[0] = c0.x; mv[1] = c0.y; mv[2] = c0.z; mv[3] = c0.w; mv[4] = c1.x; mv[5] = c1.y; mv[6] = c1.z; mv[7] = c1.w;
    mg[0] = d0.x; mg[1] = d0.y; mg[2] = d0.z; mg[3] = d0.w; mg[4] = d1.x; mg[5] = d1.y; mg[6] = d1.z; mg[7] = d1.w;
  }
#pragma unroll 1
  for (int it = bid; it < T_TOK / 8; it += nb) {
    const int ra = it * 8 + rsub, rb = ra + 4;
    const size_t oa = (size_t)ra * 1024 + cc, ob = (size_t)rb * 1024 + cc;
    const uint4 ca = *(const uint4*)(p.H + oa), cb = *(const uint4*)(p.H + ob);
    const uint4 pa = *(const uint4*)(p.H + (((ra & (SEQ - 1)) != 0) ? oa - 1024 : oa));
    const uint4 pb = *(const uint4*)(p.H + ob - 1024);
    const float fa = ((ra & (SEQ - 1)) != 0) ? 1.f : 0.f;
#pragma unroll
    for (int half = 0; half < 2; ++half) {
      float c[8], d[8], o[8];
      unpack8(half ? cb : ca, c);
      unpack8(half ? pb : pa, d);
      const float f = half ? 1.f : fa;
      const size_t oo = half ? ob : oa;
#pragma unroll
      for (int j = 0; j < 8; ++j) d[j] = d[j] * f - c[j];
#pragma unroll
      for (int j = 0; j < 8; ++j) o[j] = c[j] + d[j] * mr[j];
      *(uint4*)(p.XR + oo) = pack8(o);
#pragma unroll
      for (int j = 0; j < 8; ++j) o[j] = c[j] + d[j] * mk[j];
      *(uint4*)(p.XK + oo) = pack8(o);
#pragma unroll
      for (int j = 0; j < 8; ++j) o[j] = c[j] + d[j] * mv[j];
      *(uint4*)(p.XV + oo) = pack8(o);
#pragma unroll
      for (int j = 0; j < 8; ++j) o[j] = c[j] + d[j] * mg[j];
      *(uint4*)(p.XG + oo) = pack8(o);
    }
  }
}
DEVI void phase3a(const Params& p, char* smem, int bid, int nb) {
  PgEpi3 E{p.R, p.K1, 0};
  pg_gemm2(smem, p.XR, p.XK, 4, p.WT_3, T_TOK, 2048, 1024, E, bid, nb);
}
DEVI void phase3c(const Params& p, char* smem, int bid, int nb) {
  PgEpi3 E{p.V1, p.SG, 1};
  pg_gemm2(smem, p.XV, p.XG, 4, p.WT_3 + (size_t)2048 * 1024, T_TOK, 2048, 1024, E, bid, nb);
}

struct Epi5w {
  const Params* p;
  DEVI void operator()(int row, int col, f32x4 v) const {
    const float4 w0 = *(const float4*)(p->w0 + col);
    const float k = 0.6065306597126334f;
    uint2 o;
    o.x = pkbf(k * sigmoid_(w0.x + v[0]), k * sigmoid_(w0.y + v[1]));
    o.y = pkbf(k * sigmoid_(w0.z + v[2]), k * sigmoid_(w0.w + v[3]));
    *(uint2*)(p->EW + (size_t)row * 1024 + col) = o;
  }
};
struct Epi5a {
  const Params* p;
  DEVI void operator()(int row, int col, f32x4 v) const {
    const float4 a0 = *(const float4*)(p->a0 + col);
    uint2 o;
    o.x = pkbf(sigmoid_(a0.x + v[0]), sigmoid_(a0.y + v[1]));
    o.y = pkbf(sigmoid_(a0.z + v[2]), sigmoid_(a0.w + v[3]));
    *(uint2*)(p->AA + (size_t)row * 1024 + col) = o;
  }
};
DEVI void phase5(const Params& p, char* smem, int bid, int nb) {
  constexpr int N1 = (T_TOK / 128) * 8;
  char* hs = smem + HF * HALF_SMEM;
  for (int it = bid * 2 + HF; it < 2 * N1; it += nb * 2) {
    if (it < N1) {
      ALoadPlain al{p.TW, 64};
      Epi5w epi{&p};
      gemm_tile(hs, al, p.W2T, 64, 64, (it >> 3) * 128, (it & 7) * 128, epi);
    } else {
      const int j = it - N1;
      ALoadPlain al{p.TA, 64};
      Epi5a epi{&p};
      gemm_tile(hs, al, p.A2T, 64, 64, (j >> 3) * 128, (j & 7) * 128, epi);
    }
  }
}

DEVI void scanx_item(const Params& p, char* smem, int item, int next_item, uint2& ur, uint2& uk, uint2& ue, uint2& ua, uint2& uv) {
  const int bh = item & 31, c = item >> 5;
  const int b = bh >> 4, h = bh & 15;
  const size_t rowbase = ((size_t)b * SEQ + (size_t)c * 16) * 1024 + h * 64;
  float* sA = (float*)smem;
  float* sR = sA + 16 * 68;
  float* sBt = sR + 16 * 68;
  float* sKt = sBt + 16 * 68;
  float* sE = sKt + 16 * 68;
  float* sMab = sE + 16 * 64;
  float* sMak = sMab + 256;
  float* sM2 = sMak + 256;
  float* sM4 = sM2 + 256;
  float* sT = sM4 + 256;
  float* sT2 = sT + 256;
  const int tid = TIDX;
  const int tau = tid >> 4, c4 = (tid & 15) * 4;
  const size_t o = rowbase + (size_t)tau * 1024 + c4;
  float r[4], k[4], ew[4], a[4], vv[4];
  unpack4(ur, r);
  unpack4(uk, k);
  unpack4(ue, ew);
  unpack4(ua, a);
  unpack4(uv, vv);
  {
    const int nbh = next_item & 31, nc = next_item >> 5;
    const size_t no = ((size_t)(nbh >> 4) * SEQ + (size_t)nc * 16 + tau) * 1024 + (nbh & 15) * 64 + c4;
    ur = *(const uint2*)(p.R + no);
    uk = *(const uint2*)(p.K1 + no);
    ue = *(const uint2*)(p.EW + no);
    ua = *(const uint2*)(p.AA + no);
    uv = *(const uint2*)(p.V1 + no);
  }
  float kk[4], kp[4], bb[4];
  float ss = 0.f, cf = 0.f;
#pragma unroll
  for (int j = 0; j < 4; ++j) {
    const int ch = h * 64 + c4 + j;
    kk[j] = k[j] * p.k_k[ch];
    ss += kk[j] * kk[j];
    kp[j] = k[j] * (1.f + (a[j] - 1.f) * p.k_a[ch]);
    cf += r[j] * kp[j] * p.r_k[ch];
  }
  ss = reduce16(ss);
  cf = reduce16(cf);
  const float rn = rsqrtf(fmaxf(ss, 1e-24f));
#pragma unroll
  for (int j = 0; j < 4; ++j) {
    kk[j] *= rn;
    bb[j] = kk[j] * a[j];
    sE[tau * 64 + c4 + j] = ew[j];
  }
  if ((tid & 15) == 0) p.COEF[((size_t)b * SEQ + (size_t)c * 16 + tau) * 16 + h] = cf;
  __syncthreads();
  float Li[4], L15[4];
  {
    const int wv = tid >> 6, ln = tid & 63, rw = ln & 15, gq = ln >> 4;
    f32x4 cl = {0.f, 0.f, 0.f, 0.f};
#pragma unroll
    for (int s = 0; s < 4; ++s) {
      const int i = 4 * gq + s;
      const float a = (i <= rw) ? 1.f : 0.f;
      const float bv = sE[i * 64 + 16 * wv + rw];
      cl = __builtin_amdgcn_mfma_f32_16x16x4f32(a, bv, cl, 0, 0, 0);
    }
    float* sL = sM2;
#pragma unroll
    for (int e = 0; e < 4; ++e) sL[(4 * gq + e) * 64 + 16 * wv + rw] = cl[e];
    __syncthreads();
    const float4 l4 = *(const float4*)(sL + tau * 64 + c4), l15 = *(const float4*)(sL + 15 * 64 + c4);
    Li[0] = l4.x; Li[1] = l4.y; Li[2] = l4.z; Li[3] = l4.w;
    L15[0] = l15.x; L15[1] = l15.y; L15[2] = l15.z; L15[3] = l15.w;
  }
  float rt[4], bhat[4], khat[4];
#pragma unroll
  for (int j = 0; j < 4; ++j) {
    const float ep = __expf(Li[j]), em = __expf(-Li[j]), eh = __expf(-(L15[j] - Li[j]));
    const float at = -kk[j] * __expf(-(Li[j] - ew[j]));
    rt[j] = r[j] * em;
    sA[tau * 68 + c4 + j] = at;
    sR[tau * 68 + c4 + j] = rt[j];
    sBt[tau * 68 + c4 + j] = bb[j] * ep;
    sKt[tau * 68 + c4 + j] = kp[j] * ep;
    bhat[j] = bb[j] * eh;
    khat[j] = kp[j] * eh;
  }
  *(uint2*)(p.R + o) = pack4(rt);
#pragma unroll
  for (int j = 0; j < 4; ++j) {
    const int lin = (c4 + j) * 16 + tau;
    const size_t off = rowbase + (size_t)(lin >> 6) * 1024 + (lin & 63);
    p.EW[off] = (bfu)f2bf(bhat[j]);
    p.K1[off] = (bfu)f2bf(khat[j]);
    p.V1[off] = (bfu)f2bf(vv[j]);
  }
  if (tau == 0) {
    float4 gq = {__expf(-L15[0]), __expf(-L15[1]), __expf(-L15[2]), __expf(-L15[3])};
    *(float4*)(p.G15 + (size_t)item * 64 + c4) = gq;
  }
  __syncthreads();
  {
    const int wv = tid >> 6, ln = tid & 63, rw = ln & 15, gq = ln >> 4;
    const float* rowsrc = ((wv >> 1) ? sKt : sBt) + rw * 68 + 16 * gq;
    const float* colsrc = ((wv & 1) ? sR : sA) + rw * 68 + 16 * gq;
    f32x4 m = {0.f, 0.f, 0.f, 0.f};
#pragma unroll
    for (int s4 = 0; s4 < 16; s4 += 4) {
      const float4 av = *(const float4*)(rowsrc + s4), bv = *(const float4*)(colsrc + s4);
      m = __builtin_amdgcn_mfma_f32_16x16x4f32(av.x, bv.x, m, 0, 0, 0);
      m = __builtin_amdgcn_mfma_f32_16x16x4f32(av.y, bv.y, m, 0, 0, 0);
      m = __builtin_amdgcn_mfma_f32_16x16x4f32(av.z, bv.z, m, 0, 0, 0);
      m = __builtin_amdgcn_mfma_f32_16x16x4f32(av.w, bv.w, m, 0, 0, 0);
    }
    const int tq = rw;
    if (wv & 1) {
      float v4[4];
#pragma unroll
      for (int e = 0; e < 4; ++e) v4[e] = (4 * gq + e <= tq) ? m[e] : 0.f;
      *(uint2*)(p.MRT + (size_t)item * 512 + tq * 32 + gq * 8 + (wv >> 1) * 4) = pack4(v4);
    } else {
      float* dst = (wv >> 1) ? sMak : sMab;
#pragma unroll
      for (int e = 0; e < 4; ++e) dst[(4 * gq + e) * 16 + tq] = (4 * gq + e < tq) ? m[e] : 0.f;
    }
  }
  __syncthreads();
  {
    const int i = tid >> 4, j = tid & 15;
    float m2 = 0.f;
#pragma unroll
    for (int kq = 0; kq < 16; ++kq) m2 += sMab[i * 16 + kq] * sMab[kq * 16 + j];
    sM2[i * 16 + j] = m2;
    __syncthreads();
    float t1 = ((i == j) ? 1.f : 0.f) + sMab[i * 16 + j] + m2, m4 = 0.f;
#pragma unroll
    for (int kq = 0; kq < 16; ++kq) {
      t1 += sMab[i * 16 + kq] * sM2[kq * 16 + j];
      m4 += sM2[i * 16 + kq] * sM2[kq * 16 + j];
    }
    sT[i * 16 + j] = t1;
    sM4[i * 16 + j] = m4;
    __syncthreads();
    float t2 = t1, m8 = 0.f;
#pragma unroll
    for (int kq = 0; kq < 16; ++kq) {
      t2 += sT[i * 16 + kq] * sM4[kq * 16 + j];
      m8 += sM4[i * 16 + kq] * sM4[kq * 16 + j];
    }
    sT2[i * 16 + j] = t2;
    __syncthreads();
    sM2[i * 16 + j] = m8;
    __syncthreads();
    float t3 = t2;
#pragma unroll
    for (int kq = 0; kq < 16; ++kq) t3 += sT2[i * 16 + kq] * sM2[kq * 16 + j];
    sT[i * 16 + j] = t3;
    __syncthreads();
  }
  {
    const int wv = tid >> 6, ln = tid & 63, rw = ln & 15, gq = ln >> 4;
    float tmv[4], av[4];
#pragma unroll
    for (int s = 0; s < 4; ++s) {
      tmv[s] = sT[(4 * gq + s) * 16 + rw];
      av[s] = sA[(4 * gq + s) * 68 + 16 * wv + rw];
    }
    f32x4 cw = {0.f, 0.f, 0.f, 0.f};
#pragma unroll
    for (int s = 0; s < 4; ++s) cw = __builtin_amdgcn_mfma_f32_16x16x4f32(av[s], tmv[s], cw, 0, 0, 0);
    {
      float w4[4] = {cw[0], cw[1], cw[2], cw[3]};
      *(uint2*)(p.AA + rowbase + (size_t)rw * 1024 + 16 * wv + 4 * gq) = pack4(w4);
    }
    if (wv == 3) {
      const float4 mk = *(const float4*)(sMak + rw * 16 + 4 * gq);
      f32x4 cg = {0.f, 0.f, 0.f, 0.f};
      cg = __builtin_amdgcn_mfma_f32_16x16x4f32(mk.x, tmv[0], cg, 0, 0, 0);
      cg = __builtin_amdgcn_mfma_f32_16x16x4f32(mk.y, tmv[1], cg, 0, 0, 0);
      cg = __builtin_amdgcn_mfma_f32_16x16x4f32(mk.z, tmv[2], cg, 0, 0, 0);
      cg = __builtin_amdgcn_mfma_f32_16x16x4f32(mk.w, tmv[3], cg, 0, 0, 0);
      float g4[4] = {cg[0], cg[1], cg[2], cg[3]};
      *(uint2*)(p.GT + (size_t)item * 256 + rw * 16 + 4 * gq) = pack4(g4);
    }
  }
  __syncthreads();
}
DEVI void phase6x(const Params& p, char* smem, int bid, int nb) {
  char* hs = smem + HF * HALF_SMEM;
  constexpr int NI = (SEQ / 16) * 32;
  const int vnb = nb * 2;
  int it = bid * 2 + HF;
  if (it >= NI) return;
  uint2 ur, uk, ue, ua, uv;
  {
    const int tau = TIDX >> 4, c4 = (TIDX & 15) * 4;
    const int bh = it & 31, c = it >> 5;
    const size_t o = ((size_t)(bh >> 4) * SEQ + (size_t)c * 16 + tau) * 1024 + (bh & 15) * 64 + c4;
    ur = *(const uint2*)(p.R + o);
    uk = *(const uint2*)(p.K1 + o);
    ue = *(const uint2*)(p.EW + o);
    ua = *(const uint2*)(p.AA + o);
    uv = *(const uint2*)(p.V1 + o);
  }
#pragma unroll 1
  for (; it < NI; it += vnb) scanx_item(p, hs, it, (it + vnb < NI) ? it + vnb : it, ur, uk, ue, ua, uv);
}

DEVI bf16x8 mk8(uint2 a, uint2 b) {
  const uint4 v = {a.x, a.y, b.x, b.y};
  return __builtin_bit_cast(bf16x8, v);
}
DEVI uint2 packacc(f32x4 a) {
  uint2 r;
  r.x = pkbf(a[0], a[1]);
  r.y = pkbf(a[2], a[3]);
  return r;
}
constexpr int SCH = 4;
constexpr int SROW = 136;
constexpr int SARR = 16 * SROW;
constexpr int SOFF_GT = 5 * SARR;
constexpr int SOFF_MR = SOFF_GT + 512;
constexpr int SOFF_G15 = SOFF_MR + 1024;
constexpr int SIMG = SOFF_G15 + 256;
#define SCANS_LD5(P, I, O)                       \
    P##a##I = *(const uint4*)(p.AA + (O));       \
    P##r##I = *(const uint4*)(p.R + (O));        \
    P##e##I = *(const uint4*)(p.EW + (O));       \
    P##k##I = *(const uint4*)(p.K1 + (O));       \
    P##v##I = *(const uint4*)(p.V1 + (O));
#define SCANS_ISSUE(P, SC)                                                                           \
  {                                                                                                  \
    const size_t hb_ = ((size_t)b * SEQ) * 1024 + h * 64 + c80 * 8;                                  \
    const int tk0_ = (SC) * SCH * 16 + cl0 * 16 + row0;                                              \
    const int tk1_ = tk0_ + 32;                                                                      \
    SCANS_LD5(P, 0, hb_ + (size_t)(tk0_ < SEQ ? tk0_ : SEQ - 1) * 1024)                              \
    SCANS_LD5(P, 1, hb_ + (size_t)(tk1_ < SEQ ? tk1_ : SEQ - 1) * 1024)                              \
    const int c0_ = (SC) * SCH;                                                                      \
    const size_t ib_ = (size_t)b * 16 + h;                                                           \
    const int tg_ = tid < 128 ? tid : 127;                                                           \
    const int cg_ = c0_ + (tg_ >> 5);                                                                \
    P##gm = *(const uint4*)(p.GT + ((size_t)(cg_ < SEQ / 16 ? cg_ : SEQ / 16 - 1) * 32 + ib_) * 256 + (tg_ & 31) * 8);  \
    const int t5_ = tid < 64 ? tid : 63;                                                             \
    const int c5_ = c0_ + (t5_ >> 4);                                                                \
    P##g5 = *(const uint4*)(p.G15 + ((size_t)(c5_ < SEQ / 16 ? c5_ : SEQ / 16 - 1) * 32 + ib_) * 64 + (t5_ & 15) * 4);  \
    const int cm_ = c0_ + (tid >> 6);                                                                \
    P##mr = *(const uint4*)(p.MRT + ((size_t)(cm_ < SEQ / 16 ? cm_ : SEQ / 16 - 1) * 32 + ib_) * 512 + (tid & 63) * 8); \
  }
#define SCANS_ST5(P, I, B)                                                                           \
    *(uint2*)(B) = uint2{P##a##I.x, P##a##I.y};  *(uint2*)((B) + 8) = uint2{P##a##I.z, P##a##I.w};   \
    *(uint2*)((B) + SARR) = uint2{P##r##I.x, P##r##I.y};  *(uint2*)((B) + SARR + 8) = uint2{P##r##I.z, P##r##I.w};   \
    *(uint2*)((B) + 2 * SARR) = uint2{P##e##I.x, P##e##I.y};  *(uint2*)((B) + 2 * SARR + 8) = uint2{P##e##I.z, P##e##I.w};   \
    *(uint2*)((B) + 3 * SARR) = uint2{P##k##I.x, P##k##I.y};  *(uint2*)((B) + 3 * SARR + 8) = uint2{P##k##I.z, P##k##I.w};   \
    *(uint2*)((B) + 4 * SARR) = uint2{P##v##I.x, P##v##I.y};  *(uint2*)((B) + 4 * SARR + 8) = uint2{P##v##I.z, P##v##I.w};
#define SCANS_COMMIT(P)                                                                              \
  {                                                                                                  \
    char* b0_ = cimg + cl0 * SIMG + row0 * SROW + c80 * 16;                                          \
    SCANS_ST5(P, 0, b0_)                                                                             \
    SCANS_ST5(P, 1, b0_ + 2 * SIMG)                                                                  \
    if (tid < 128) *(uint4*)(cimg + (tid >> 5) * SIMG + SOFF_GT + (tid & 31) * 16) = P##gm;          \
    if (tid < 64) *(uint4*)(cimg + (tid >> 4) * SIMG + SOFF_G15 + (tid & 15) * 16) = P##g5;          \
    *(uint4*)(cimg + (tid >> 6) * SIMG + SOFF_MR + (tid & 63) * 16) = P##mr;                         \
  }
#define SCANS_COMPUTE(SCI)                                                                           \
  _Pragma("unroll 1") for (int cl = 0; cl < SCH && (SCI) * SCH + cl < SEQ / 16; ++cl) {             \
    const char* img = cimg + cl * SIMG;                                                              \
        \
    const uint2 vb = *(const uint2*)(img + 4 * SARR + vrow * SROW + vcol * 2);                       \
    const uint2 gt = *(const uint2*)(img + SOFF_GT + (q * 16 + 4 * g) * 2);                          \
    const char* wp = img + q * SROW + (4 * g) * 2;                                                   \
    const uint2 w00 = *(const uint2*)(wp), w01 = *(const uint2*)(wp + 32);                           \
    const uint2 w10 = *(const uint2*)(wp + 64), w11 = *(const uint2*)(wp + 96);                      \
    const uint2 r00 = *(const uint2*)(wp + SARR), r01 = *(const uint2*)(wp + SARR + 32);             \
    const uint2 r10 = *(const uint2*)(wp + SARR + 64), r11 = *(const uint2*)(wp + SARR + 96);        \
    const uint4 mr = *(const uint4*)(img + SOFF_MR + (q * 32 + g * 8) * 2);                          \
    uint2 bk0[4], bk1[4];                                                                            \
    float4 g15[4];                                                                                   \
    _Pragma("unroll") for (int n = 0; n < 4; ++n) {                                                  \
      const int ch = 16 * n + q;                                                                     \
      const char* bp = img + 2 * SARR + (ch >> 2) * SROW + ((ch & 3) * 16 + 4 * g) * 2;              \
      bk0[n] = *(const uint2*)(bp);                                                                  \
      bk1[n] = *(const uint2*)(bp + SARR);                                                           \
      g15[n] = *(const float4*)(img + SOFF_G15 + (16 * n + 4 * g) * 4);                              \
    }                                                                                                \
    __builtin_amdgcn_sched_barrier(0);                                                               \
    const bf16x8 sB0 = mk8(packacc(acc[0]), packacc(acc[1]));                                        \
    const bf16x8 sB1 = mk8(packacc(acc[2]), packacc(acc[3]));                                        \
    f32x4 Z = {0.f, 0.f, 0.f, 0.f};                                                                  \
    Z = __builtin_amdgcn_mfma_f32_16x16x32_bf16(mk8(gt, zero2), mk8(vb, zero2), Z, 0, 0, 0);         \
    f32x4 Y = {0.f, 0.f, 0.f, 0.f};                                                                  \
    Z = __builtin_amdgcn_mfma_f32_16x16x32_bf16(mk8(w00, w01), sB0, Z, 0, 0, 0);                     \
    Y = __builtin_amdgcn_mfma_f32_16x16x32_bf16(mk8(r00, r01), sB0, Y, 0, 0, 0);                     \
    Z = __builtin_amdgcn_mfma_f32_16x16x32_bf16(mk8(w10, w11), sB1, Z, 0, 0, 0);                     \
    Y = __builtin_amdgcn_mfma_f32_16x16x32_bf16(mk8(r10, r11), sB1, Y, 0, 0, 0);                     \
    const bf16x8 zvB = mk8(packacc(Z), vb);                                                          \
    Y = __builtin_amdgcn_mfma_f32_16x16x32_bf16(__builtin_bit_cast(bf16x8, mr), zvB, Y, 0, 0, 0);    \
    _Pragma("unroll") for (int n = 0; n < 4; ++n) {                                                  \
      f32x4 scv = acc[n];                                                                            \
      scv[0] *= g15[n].x; scv[1] *= g15[n].y; scv[2] *= g15[n].z; scv[3] *= g15[n].w;                \
      acc[n] = __builtin_amdgcn_mfma_f32_16x16x32_bf16(mk8(bk0[n], bk1[n]), zvB, scv, 0, 0, 0);      \
    }                                                                                                \
    _Pragma("unroll") for (int e = 0; e < 4; ++e)                                                    \
        ybuf[(cl * 16 + 4 * g + e) * 16 + q] = (bfu)f2bf(Y[e]);                                      \
  }
DEVI void scans_block(const Params& p, char* smem, int bh, int vs) {
  const int b = bh >> 4, h = bh & 15;
  const int lane = threadIdx.x & 63, wv = threadIdx.x >> 6, q = lane & 15, g = lane >> 4;
  f32x4 acc[4];
#pragma unroll
  for (int n = 0; n < 4; ++n) acc[n] = f32x4{0.f, 0.f, 0.f, 0.f};
  const uint2 zero2 = {0u, 0u};
  bfu* yout = p.YS + ((size_t)b * SEQ) * 1024 + h * 64 + vs * 16;
  char* const img0 = smem;
  char* const img1 = smem + SCH * SIMG;
  bfu* const yb0 = (bfu*)(smem + 2 * SCH * SIMG);
  bfu* const yb1 = yb0 + SCH * 16 * 16;
  const int tid = TIDX;
  const bool stager = wv >= 4;
  const int cl0 = tid >> 7, row0 = (tid >> 3) & 15, c80 = tid & 7;
  uint4 Aa0, Aa1, Ar0, Ar1, Ae0, Ae1, Ak0, Ak1, Av0, Av1, Agm, Ag5, Amr;
  constexpr int NSC = (SEQ / 16) / SCH;
  const int vrow = vs * 4 + (q >> 2), vcol = (q & 3) * 16 + 4 * g;
  if (stager) {
    char* cimg = img0;
    SCANS_ISSUE(A, 0);
    SCANS_COMMIT(A);
    SCANS_ISSUE(A, 1);
  }
  __syncthreads();
#define SCANS_FLUSH(YB, S)                                                                                       \
  if (wv >= 1 && wv <= 2) {                                                                                      \
    const int idx = (int)threadIdx.x - 64, tok = (S) * SCH * 16 + (idx >> 1);                                    \
    *(uint4*)(yout + (size_t)tok * 1024 + (idx & 1) * 8) = *(const uint4*)((YB) + (idx >> 1) * 16 + (idx & 1) * 8); \
  }
#pragma unroll 1
  for (int sc = 0; sc < NSC; sc += 2) {
    if (wv == 0) {
      const char* cimg = img0;
      bfu* ybuf = yb0;
      SCANS_COMPUTE(sc);
    } else if (stager) {
      char* cimg = img1;
      SCANS_COMMIT(A);
      SCANS_ISSUE(A, (sc + 2 < NSC ? sc + 2 : NSC - 1));
    } else if (sc > 0) {
      SCANS_FLUSH(yb1, sc - 1)
    }
    __syncthreads();
    if (wv == 0) {
      const char* cimg = img1;
      bfu* ybuf = yb1;
      SCANS_COMPUTE(sc + 1);
    } else if (stager) {
      char* cimg = img0;
      SCANS_COMMIT(A);
      SCANS_ISSUE(A, (sc + 3 < NSC ? sc + 3 : NSC - 1));
    } else {
      SCANS_FLUSH(yb0, sc)
    }
    __syncthreads();
  }
  SCANS_FLUSH(yb1, NSC - 1)
#undef SCANS_FLUSH
}
DEVI void phase6(const Params& p, char* smem, int bid, int nb) {
  for (int it = bid; it < 128; it += nb) scans_block(p, smem, it >> 2, it & 3);
}

DEVI void phase6b(const Params& p, int bid, int nb) {
  const int lane = threadIdx.x & 63, wv = (threadIdx.x >> 6) & 3;
  for (int it = bid; it < T_TOK / 4; it += nb) {
    const int t0 = it * 4 + (threadIdx.x >> 8) * 2;
    float ys[8], vv[8], sg[8], bon[8];
#pragma unroll
    for (int j = 0; j < 8; ++j) {
      const int t = t0 + (j >> 2), h = wv * 4 + (j & 3);
      const int tb = t & ~15, tau = t & 15;
      const size_t idx = (size_t)t * 1024 + h * 64 + lane;
      ys[j] = bf2f(p.YS[idx]);
      sg[j] = bf2f(p.SG[idx]);
      vv[j] = bf2f(p.V1[(size_t)(tb + (lane >> 2)) * 1024 + h * 64 + (lane & 3) * 16 + tau]);
      bon[j] = p.COEF[(size_t)t * 16 + h];
    }
#pragma unroll
    for (int j = 0; j < 8; ++j) {
      const int t = t0 + (j >> 2), h = wv * 4 + (j & 3);
      const int c = h * 64 + lane;
      const float mean = wave_sum(ys[j]) * (1.f / 64.f);
      const float dv = ys[j] - mean;
      const float var = wave_sum(dv * dv) * (1.f / 64.f);
      float y = dv * rsqrtf(var + 64e-5f) * p.lnw[c] + p.lnb[c];
      y = (y + bon[j] * vv[j]) * sg[j];
      p.YS[(size_t)t * 1024 + c] = (bfu)f2bf(y);
    }
  }
}

DEVI void phase7(const Params& p, char* smem, int bid, int nb) {
  PgEpiRes E{p.out, p.out};
  pg_gemm(smem, p.YS, p.WT_o, T_TOK, 1024, 1024, E, bid, nb);
}
DEVI void phase8(const Params& p, int bid, int nb) {
  for (int it = bid; it < T_TOK / 16; it += nb) {
    const int row = it * 16 + (threadIdx.x >> 6) * 2;
    const int lane = threadIdx.x & 63;
    float* src = p.out + (size_t)row * 1024;
    float4 v[2][4];
    float ss[2] = {0.f, 0.f};
#pragma unroll
    for (int r = 0; r < 2; ++r)
#pragma unroll
      for (int i = 0; i < 4; ++i) v[r][i] = *(const float4*)(src + r * 1024 + lane * 4 + 256 * i);
#pragma unroll
    for (int r = 0; r < 2; ++r)
#pragma unroll
      for (int i = 0; i < 4; ++i)
        ss[r] += v[r][i].x * v[r][i].x + v[r][i].y * v[r][i].y + v[r][i].z * v[r][i].z + v[r][i].w * v[r][i].w;
#pragma unroll
    for (int r = 0; r < 2; ++r) {
      const float rinv = rsqrtf(wave_sum(ss[r]) * (1.f / 1024.f) + 1e-6f);
#pragma unroll
      for (int i = 0; i < 4; ++i) {
        const float4 g = *(const float4*)(p.fnorm + lane * 4 + 256 * i);
        const float4 o = {v[r][i].x * rinv * g.x, v[r][i].y * rinv * g.y, v[r][i].z * rinv * g.z, v[r][i].w * rinv * g.w};
        *(float4*)(src + r * 1024 + lane * 4 + 256 * i) = o;
      }
    }
  }
}

#define XB_TMO      128
#define XB_XCNT(j)  (256  + 64 * (j))
#define XB_XSUB(j)  (1280 + 64 * (j))
#define XB_XGEN(j)  (2304 + 64 * (j))
#define XB_TOP      3328
#define XB_TOPGEN   3392
#define XCD_BAR_WORDS 3456
#define XB_SPIN_CAP (1u << 18)
#define LAS __attribute__((address_space(3)))

__device__ __forceinline__ unsigned xb_ld(unsigned* p)              { return __hip_atomic_load(p, __ATOMIC_RELAXED, __HIP_MEMORY_SCOPE_AGENT); }
__device__ __forceinline__ unsigned xb_add(unsigned* p, unsigned v) { return __hip_atomic_fetch_add(p, v, __ATOMIC_RELAXED, __HIP_MEMORY_SCOPE_AGENT); }
__device__ __forceinline__ unsigned xb_xcc_id() { return (unsigned)__builtin_amdgcn_s_getreg((3 << 11) | 20) & 0xFu; }
#define XB_SPIN(cond, bar) do { unsigned _sp = 0; while (cond) { __builtin_amdgcn_s_sleep(1); \
    if ((++_sp & 255u) == 0u) { if (xb_ld(&(bar)[XB_TMO])) break; if (_sp > XB_SPIN_CAP) { atomicAdd(&(bar)[XB_TMO], 1u); break; } } } } while (0)

struct XcdBarrier {
    unsigned* bar; unsigned x;
    volatile LAS unsigned* st;
};

__device__ __forceinline__ XcdBarrier xcd_barrier_post(unsigned* bar, volatile LAS unsigned* st) {
    XcdBarrier b; b.bar = bar; b.x = xb_xcc_id(); b.st = st;
    if (threadIdx.x == 0) (void)xb_add(&bar[XB_XCNT(b.x)], 1u);
    return b;
}
__device__ __forceinline__ void xcd_barrier_complete(unsigned* bar, unsigned x, unsigned& nloc, unsigned& nx) {
    const unsigned G = gridDim.x * gridDim.y * gridDim.z;
    unsigned sum, cnt, mine, sp = 0u;
    for (;;) {
        sum = 0u; cnt = 0u; mine = 0u;
#pragma unroll
        for (unsigned j = 0; j < 16; ++j) { const unsigned c = xb_ld(&bar[XB_XCNT(j)]); sum += c; cnt += (c > 0u) ? 1u : 0u; mine = (j == x) ? c : mine; }
        if (sum == G) break;
        __builtin_amdgcn_s_sleep(1);
        if ((++sp & 255u) == 0u) { if (xb_ld(&bar[XB_TMO])) break; if (sp > XB_SPIN_CAP) { atomicAdd(&bar[XB_TMO], 1u); break; } }
    }
    nloc = mine > 0u ? mine : 1u; nx = cnt > 0u ? cnt : 1u;
}

__device__ __forceinline__ void xcd_barrier(const XcdBarrier& b) {
    asm volatile("s_waitcnt vmcnt(0)" ::: "memory");
    __syncthreads();
    if (threadIdx.x == 0) {
        unsigned* bar = b.bar;
        __builtin_amdgcn_s_waitcnt(0);
        unsigned nloc = b.st[0], nx = b.st[1];
        if (nloc == 0u) { xcd_barrier_complete(bar, b.x, nloc, nx); b.st[0] = nloc; b.st[1] = nx; }
        const unsigned old = xb_add(&bar[XB_XSUB(b.x)], 1u);
        const unsigned gen = old / nloc;
        if (old + 1u == (gen + 1u) * nloc) {
            __builtin_amdgcn_fence(__ATOMIC_RELEASE, "agent");
            asm volatile("s_waitcnt vmcnt(0)" ::: "memory");
            const unsigned og = xb_add(&bar[XB_TOP], 1u);
            const unsigned tg = og / nx;
            if (og + 1u == (tg + 1u) * nx) xb_add(&bar[XB_TOPGEN], 1u);
            else XB_SPIN(xb_ld(&bar[XB_TOPGEN]) == tg, bar);
            __builtin_amdgcn_fence(__ATOMIC_ACQUIRE, "agent");
            xb_add(&bar[XB_XGEN(b.x)], 1u);
            asm volatile("s_waitcnt vmcnt(0)" ::: "memory");
        } else {
            XB_SPIN(xb_ld(&bar[XB_XGEN(b.x)]) == gen, bar);
            __builtin_amdgcn_fence(__ATOMIC_ACQUIRE, "agent");
            asm volatile("s_waitcnt vmcnt(0)" ::: "memory");
        }
    }
    __syncthreads();
}


template <int PH>
DEVI void run_phase(const Params& p, char* smem, int bid, int nb) {
  if (PH == 0) phase0(p, smem, bid, nb);
  if (PH == 1) phase1(p, smem, bid, nb);
  if (PH == 2) phase2(p, smem, bid, nb);
  if (PH == 3) phase3(p, smem, bid, nb);
  if (PH == 4) phase3b(p, bid, nb);
  if (PH == 5) phaseM(p, smem, bid, nb);
  if (PH == 6) phase3a(p, smem, bid, nb);
  if (PH == 7) phase3c(p, smem, bid, nb);
  if (PH == 8) phase5(p, smem, bid, nb);
  if (PH == 9) phase6x(p, smem, bid, nb);
  if (PH == 10) phase6(p, smem, bid, nb);
  if (PH == 11) phase6b(p, bid, nb);
  if (PH == 12) phase7(p, smem, bid, nb);
  if (PH == 13) phase8(p, bid, nb);
}

#ifndef REP_MASK
#define REP_MASK 0
#endif
template <int PH>
DEVI void mega_phase(const Params& p, char* smem, cg::grid_group& grid, int bid, int nb) {
  run_phase<PH>(p, smem, bid, nb);
  if ((REP_MASK >> PH) & 1) {
    grid.sync();
    run_phase<PH>(p, smem, bid, nb);
  }
}
__global__ void __launch_bounds__(512, 2) mega_kernel(Params pk) {
  const Params& p = *(const Params*)__builtin_amdgcn_kernarg_segment_ptr();
  extern __shared__ __attribute__((aligned(16))) char smem[];
  cg::grid_group grid = cg::this_grid();
  const int bid = blockIdx.x, nb = gridDim.x;
  volatile LAS unsigned* st = (volatile LAS unsigned*)(smem + SMEM_BYTES);
  if (threadIdx.x == 0) {
    st[0] = 0u;
    st[1] = 0u;
  }
  __syncthreads();
  (void)xcd_barrier_post(p.BAR, st);
#define XBAR() do { XcdBarrier xb_; xb_.bar = p.BAR; xb_.x = xb_xcc_id(); xb_.st = (volatile LAS unsigned*)(smem + SMEM_BYTES); xcd_barrier(xb_); } while (0)
  mega_phase<0>(p, smem, grid, bid, nb); grid.sync();
  mega_phase<1>(p, smem, grid, bid, nb); XBAR();
  mega_phase<2>(p, smem, grid, bid, nb); XBAR();
  mega_phase<3>(p, smem, grid, bid, nb); XBAR();
  mega_phase<4>(p, smem, grid, bid, nb); XBAR();
  mega_phase<5>(p, smem, grid, bid, nb); XBAR();
  mega_phase<6>(p, smem, grid, bid, nb); XBAR();
  mega_phase<7>(p, smem, grid, bid, nb); XBAR();
  mega_phase<8>(p, smem, grid, bid, nb); XBAR();
  mega_phase<9>(p, smem, grid, bid, nb); XBAR();
  mega_phase<10>(p, smem, grid, bid, nb); XBAR();
  mega_phase<11>(p, smem, grid, bid, nb); XBAR();
  mega_phase<12>(p, smem, grid, bid, nb); grid.sync();
  mega_phase<13>(p, smem, grid, bid, nb);
}

extern "C" void kernel_launch(void* const* d_in, const int* in_sizes, int n_in, void* d_out, int out_size, void* d_ws,
                              size_t ws_size, hipStream_t stream) {
  Params p{};
  const float** fp = (const float**)&p;
  for (int i = 0; i < 26; ++i) fp[i] = (const float*)d_in[i];
  p.out = (float*)d_out;
  char* w = (char*)d_ws;
  size_t off = 0;
  auto take = [&](size_t bytes) {
    char* r = w + off;
    off += (bytes + 255) & ~(size_t)255;
    return (bfu*)r;
  };
  p.WT_in = take((size_t)3584 * 1024 * 2);
  p.WT_out = take((size_t)1024 * 1024 * 2);
  p.WT_3 = take((size_t)4352 * 1024 * 2);
  p.WT_o = take((size_t)1024 * 1024 * 2);
  p.W2T = take((size_t)1024 * 64 * 2);
  p.A2T = take((size_t)1024 * 64 * 2);
  p.TW = take((size_t)T_TOK * 64 * 2);
  p.TA = take((size_t)T_TOK * 64 * 2);
  const size_t SLOT = (size_t)T_TOK * 1024 * 2;
  bfu* slot0 = take(SLOT);
  bfu* slots = take(6 * SLOT);
  p.H = slot0;
  p.AA = slot0;
  p.U = slots;
  p.GVT = slots + SLOT / 4;
  p.Q = slots + 2 * (SLOT / 4);
  p.K = slots + 3 * (SLOT / 4);
  p.VT = slots + 4 * (SLOT / 4);
  p.SZ = slots + 7 * (SLOT / 4);
  p.Y = slots + 9 * (SLOT / 4);
  p.R = slots;
  p.K1 = slots + 1 * (SLOT / 2);
  p.XV = slots + 2 * (SLOT / 2);
  p.XG = slots + 3 * (SLOT / 2);
  p.XR = slots + 4 * (SLOT / 2);
  p.XK = slots + 5 * (SLOT / 2);
  p.V1 = slots + 4 * (SLOT / 2);
  p.SG = slots + 5 * (SLOT / 2);
  p.EW = slots + 2 * (SLOT / 2);
  p.YS = slots + 3 * (SLOT / 2);
  p.G15 = (float*)p.TW;
  p.GT = p.WT_in;
  p.MRT = take((size_t)(SEQ / 16) * 32 * 512 * 2);
  p.COEF = (float*)take((size_t)T_TOK * 16 * 4);
  p.BAR = (unsigned*)take((size_t)XCD_BAR_WORDS * 4);
  if (off > ws_size) {
    fprintf(stderr, "workspace too small: need %zu have %zu\n", off, ws_size);
    return;
  }
  static int grid_blocks = 0;
  if (!grid_blocks) {
    int dev = 0, cus = 0, per_cu = 0;
    (void)hipGetDevice(&dev);
    (void)hipDeviceGetAttribute(&cus, hipDeviceAttributeMultiprocessorCount, dev);
    (void)hipFuncSetAttribute((const void*)mega_kernel, hipFuncAttributeMaxDynamicSharedMemorySize, SMEM_BYTES + 16);
    (void)hipOccupancyMaxActiveBlocksPerMultiprocessor(&per_cu, mega_kernel, 512, SMEM_BYTES + 16);
    grid_blocks = cus * per_cu;
  }
  (void)hipMemsetAsync(p.BAR, 0, (size_t)XCD_BAR_WORDS * 4, stream);
  void* args[] = {&p};
  hipError_t e = hipLaunchCooperativeKernel((void*)mega_kernel, dim3(grid_blocks), dim3(512), args, SMEM_BYTES + 16, stream);
  if (e != hipSuccess) fprintf(stderr, "cooperative launch failed: %s (grid %d)\n", hipGetErrorString(e), grid_blocks);
}
```

```cpp
#include <hip/hip_runtime.h>
#include <hip/hip_cooperative_groups.h>
#include <stdint.h>
#include <cstdio>
namespace cg = cooperative_groups;

#ifndef MEGA
#define MEGA 1
#endif

typedef unsigned short bfu;
using bf16x8 = __attribute__((ext_vector_type(8))) short;
using f32x4 = __attribute__((ext_vector_type(4))) float;
#define DEVI __device__ __forceinline__
#define TIDX ((int)(threadIdx.x & 255))
#define HF ((int)(threadIdx.x >> 8))

constexpr int GSTAGE_BYTES = 2 * 128 * 72 * 2;
constexpr int T_TOK = 32768;
constexpr int SEQ = 16384;
constexpr int HALF_SMEM = 2 * GSTAGE_BYTES + 4096 + 512;
constexpr int SMEM_BYTES = 2 * HALF_SMEM;
constexpr int SMEM_UNUSED_ = 0;

struct Params {
  const float *x, *ln_even, *w_in, *gm_norm, *gm_ws, *gm_b, *w_out, *ln_odd, *mu, *wr, *wk, *wv, *wg, *w0, *w1, *w2,
      *a0, *a1, *a2, *k_k, *k_a, *r_k, *lnw, *lnb, *wo, *fnorm;
  float* out;
  bfu *WT_in, *WT_out, *WT_3, *WT_o, *W2T, *A2T;
  bfu *H, *U, *GVT, *Q, *K, *VT, *SZ, *Y, *R, *K1, *V1, *SG, *EW, *AA, *YS, *TW, *TA, *GT, *MRT, *XR, *XK, *XV, *XG;
  float *G15, *COEF;
  unsigned* BAR;
};

DEVI float bf2f(unsigned b) { return __uint_as_float(b << 16); }
DEVI unsigned f2bf(float x) {
  const __bf16 h = (__bf16)x;
  return (unsigned)__builtin_bit_cast(unsigned short, h);
}
typedef __bf16 bf16x2_t __attribute__((ext_vector_type(2)));
typedef float float2_t __attribute__((ext_vector_type(2)));
DEVI unsigned pkbf(float a, float b) {
  const float2_t f = {a, b};
  const bf16x2_t h = __builtin_convertvector(f, bf16x2_t);
  return __builtin_bit_cast(unsigned, h);
}
DEVI void unpack8(uint4 v, float* f) {
  f[0] = __uint_as_float(v.x << 16); f[1] = __uint_as_float(v.x & 0xffff0000u);
  f[2] = __uint_as_float(v.y << 16); f[3] = __uint_as_float(v.y & 0xffff0000u);
  f[4] = __uint_as_float(v.z << 16); f[5] = __uint_as_float(v.z & 0xffff0000u);
  f[6] = __uint_as_float(v.w << 16); f[7] = __uint_as_float(v.w & 0xffff0000u);
}
DEVI uint4 pack8(const float* f) {
  uint4 r;
  r.x = pkbf(f[0], f[1]);
  r.y = pkbf(f[2], f[3]);
  r.z = pkbf(f[4], f[5]);
  r.w = pkbf(f[6], f[7]);
  return r;
}
DEVI void unpack4(uint2 v, float* f) {
  f[0] = __uint_as_float(v.x << 16); f[1] = __uint_as_float(v.x & 0xffff0000u);
  f[2] = __uint_as_float(v.y << 16); f[3] = __uint_as_float(v.y & 0xffff0000u);
}
DEVI uint2 pack4(const float* f) {
  uint2 r;
  r.x = pkbf(f[0], f[1]);
  r.y = pkbf(f[2], f[3]);
  return r;
}

DEVI float sigmoid_(float x) { return __builtin_amdgcn_rcpf(1.f + __expf(-x)); }
DEVI float silu_(float x) { return x * sigmoid_(x); }
DEVI float tanh_(float y) { return 1.f - 2.f * __builtin_amdgcn_rcpf(1.f + __expf(2.f * y)); }
DEVI float gelu_(float x) {
  const float y = 0.7978845608028654f * (x + 0.044715f * x * x * x);
  return x * __builtin_amdgcn_rcpf(1.f + __expf(-2.f * y));
}
DEVI float wave_sum(float v) {
#pragma unroll
  for (int o = 32; o > 0; o >>= 1) v += __shfl_xor(v, o);
  return v;
}
DEVI float wave_max(float v) {
#pragma unroll
  for (int o = 32; o > 0; o >>= 1) v = fmaxf(v, __shfl_xor(v, o));
  return v;
}
template <int CTRL>
DEVI float dppf(float x) {
  return __int_as_float(__builtin_amdgcn_update_dpp(0, __float_as_int(x), CTRL, 0xF, 0xF, true));
}
DEVI float reduce16(float x) {
  x += dppf<0xB1>(x);
  x += dppf<0x4E>(x);
  x += dppf<0x141>(x);
  x += dppf<0x140>(x);
  return x;
}

constexpr int LROW = 72;
constexpr int GSTAGE = 2 * 128 * LROW;

template <int DIST = 2, bool SW = true, class ALoad, class Epi>
DEVI void gemm_tile(char* smem, const ALoad& aload, const bfu* __restrict__ Bt, int ldb, int K, int m0, int n0,
                    const Epi& epi) {
  bfu* sbase = (bfu*)smem;
  const int tid = TIDX, lane = tid & 63, wid = tid >> 6, wr = wid >> 1, wc = wid & 1;
  const int fr = lane & 15, fq = lane >> 4;
  f32x4 acc[4][4];
#pragma unroll
  for (int i = 0; i < 4; ++i)
#pragma unroll
    for (int j = 0; j < 4; ++j) acc[i][j] = f32x4{0.f, 0.f, 0.f, 0.f};
  const int r0 = tid >> 3, kc = (tid & 7) * 8;
  const int nk = K >> 6;
  struct GRegs { typename ALoad::Raw a0, a1, a2, a3; uint4 ap, b0, b1, b2, b3; };
  GRegs g0, g1;
  const bfu* Bp = Bt + (size_t)(n0 + r0) * ldb + kc;
  const size_t ldb32 = (size_t)ldb * 32;
  constexpr int ARS = ALoad::kConsec ? 1 : 32;
  const int ar0 = ALoad::kConsec ? 4 * r0 : r0;
#define GEMM_ISSUE(R, KT)                                   \
  {                                                         \
    const int k0_ = ((KT) << 6);                            \
    R.ap = aload.loadprev(m0 + ar0, k0_ + kc);              \
    R.a0 = aload.load(m0 + ar0, k0_ + kc);                  \
    R.a1 = aload.load(m0 + ar0 + ARS, k0_ + kc);            \
    R.a2 = aload.load(m0 + ar0 + 2 * ARS, k0_ + kc);        \
    R.a3 = aload.load(m0 + ar0 + 3 * ARS, k0_ + kc);        \
    R.b0 = *(const uint4*)(Bp + k0_);                       \
    R.b1 = *(const uint4*)(Bp + ldb32 + k0_);               \
    R.b2 = *(const uint4*)(Bp + 2 * ldb32 + k0_);           \
    R.b3 = *(const uint4*)(Bp + 3 * ldb32 + k0_);           \
  }
#define GEMM_COMMIT(R, S, KT)                               \
  {                                                         \
    const int k1_ = ((KT) << 6) + kc;                       \
    bfu* A_ = sbase + (S) * GSTAGE + ar0 * LROW + kc;       \
    bfu* B_ = sbase + (S) * GSTAGE + 128 * LROW + r0 * LROW + kc;   \
    *(uint4*)(A_) = aload.finish(R.a0, R.ap, m0 + ar0, k1_);                                 \
    *(uint4*)(A_ + ARS * LROW) = aload.finish(R.a1, aload.asprev(R.a0), m0 + ar0 + ARS, k1_);          \
    *(uint4*)(A_ + 2 * ARS * LROW) = aload.finish(R.a2, aload.asprev(R.a1), m0 + ar0 + 2 * ARS, k1_);  \
    *(uint4*)(A_ + 3 * ARS * LROW) = aload.finish(R.a3, aload.asprev(R.a2), m0 + ar0 + 3 * ARS, k1_);  \
    *(uint4*)(B_) = R.b0;                                   \
    *(uint4*)(B_ + 32 * LROW) = R.b1;                       \
    *(uint4*)(B_ + 64 * LROW) = R.b2;                       \
    *(uint4*)(B_ + 96 * LROW) = R.b3;                       \
  }
#define GEMM_COMPUTE(S)                                                                          \
  {                                                                                              \
    const bfu* cA = sbase + (S) * GSTAGE;                                                        \
    const bfu* cB = cA + 128 * LROW;                                                             \
    _Pragma("unroll") for (int ks = 0; ks < 2; ++ks) {                                           \
      bf16x8 af[4], bfv[4];                                                                      \
      _Pragma("unroll") for (int i = 0; i < 4; ++i) {                                            \
        af[i] = *(const bf16x8*)(cA + (wr * 64 + i * 16 + fr) * LROW + ks * 32 + fq * 8);        \
        bfv[i] = *(const bf16x8*)(cB + (wc * 64 + i * 16 + fr) * LROW + ks * 32 + fq * 8);       \
      }                                                                                          \
      _Pragma("unroll") for (int i = 0; i < 4; ++i) _Pragma("unroll") for (int j = 0; j < 4; ++j) \
          acc[i][j] = SW ? __builtin_amdgcn_mfma_f32_16x16x32_bf16(bfv[j], af[i], acc[i][j], 0, 0, 0)     \
                         : __builtin_amdgcn_mfma_f32_16x16x32_bf16(af[i], bfv[j], acc[i][j], 0, 0, 0);    \
    }                                                                                            \
  }
  const int nkm1 = nk - 1;
  if (DIST == 2 && nk == 1) {
    GEMM_ISSUE(g0, 0);
    GEMM_COMMIT(g0, 0, 0);
    __syncthreads();
    GEMM_COMPUTE(0);
    __syncthreads();
  } else if (DIST == 2) {
    GEMM_ISSUE(g0, 0);
    GEMM_ISSUE(g1, (1 < nkm1 ? 1 : nkm1));
    GEMM_COMMIT(g0, 0, 0);
    GEMM_ISSUE(g0, (2 < nkm1 ? 2 : nkm1));
    __syncthreads();
    {
      for (int kt = 0; kt < nk; kt += 2) {
        GEMM_COMMIT(g1, 1, (kt + 1 < nkm1 ? kt + 1 : nkm1));
        GEMM_ISSUE(g1, (kt + 3 < nkm1 ? kt + 3 : nkm1));
        GEMM_COMPUTE(0);
        __syncthreads();
        GEMM_COMMIT(g0, 0, (kt + 2 < nkm1 ? kt + 2 : nkm1));
        GEMM_ISSUE(g0, (kt + 4 < nkm1 ? kt + 4 : nkm1));
        GEMM_COMPUTE(1);
        __syncthreads();
      }
    }
  } else {
    GEMM_ISSUE(g0, 0);
    GEMM_COMMIT(g0, 0, 0);
    GEMM_ISSUE(g0, (1 < nkm1 ? 1 : nkm1));
    __syncthreads();
    for (int kt = 0; kt < nk; kt += 2) {
      GEMM_COMMIT(g0, 1, (kt + 1 < nkm1 ? kt + 1 : nkm1));
      GEMM_ISSUE(g0, (kt + 2 < nkm1 ? kt + 2 : nkm1));
      GEMM_COMPUTE(0);
      __syncthreads();
      GEMM_COMMIT(g0, 0, (kt + 2 < nkm1 ? kt + 2 : nkm1));
      GEMM_ISSUE(g0, (kt + 3 < nkm1 ? kt + 3 : nkm1));
      GEMM_COMPUTE(1);
      __syncthreads();
    }
  }
#pragma unroll
  for (int i = 0; i < 4; ++i)
#pragma unroll
    for (int j = 0; j < 4; ++j) {
      if (SW) epi(m0 + wr * 64 + i * 16 + fr, n0 + wc * 64 + j * 16 + fq * 4, acc[i][j]);
      else epi(m0 + wr * 64 + i * 16 + fq * 4, n0 + wc * 64 + j * 16 + fr, acc[i][j]);
    }
}

namespace pg8 {
#define PG8_LAS __attribute__((address_space(3)))
typedef unsigned short bf16_t;
typedef short bf16x8 __attribute__((ext_vector_type(8)));
typedef float f32x4 __attribute__((ext_vector_type(4)));
typedef unsigned u32x4 __attribute__((ext_vector_type(4)));
constexpr int BM = 256, BK = 64, HALF = 128, HTB = HALF * BK * 2  , STAGE_BYTES = 8 * HTB, NXCD = 8, WGM = 8;

__host__ __device__ __forceinline__ int lds_byte(int r, int c) { const int st = (r >> 4) * 2 + (c >> 5), rr = r & 15, cc = c & 31, ob = rr * 64 + cc * 2; return st * 1024 + (ob ^ (((ob >> 9) & 1) << 5)); }
__host__ __device__ __forceinline__ void stage_rc(int b, int& R, int& C) { const int st = b / 1024, sb = b % 1024, swz = sb ^ (((sb >> 9) & 1) << 5); R = (st >> 1) * 16 + swz / 64; C = (st & 1) * 32 + (swz % 64) / 2; }
__host__ __device__ __forceinline__ int perm32(int rho) { const int n = rho >> 4, i = rho & 15; return 8 * (i >> 2) + 4 * n + (i & 3); }

struct Unit { int pm, pn; };
struct Gemm { const bf16_t* A; const bf16_t* Bt; int M, N, K; const bf16_t* A2; int pn_split; unsigned long long rmap, cmap;
  __device__ __forceinline__ size_t rt(int pm) const { return rmap ? (size_t)((rmap >> (4 * pm)) & 15ull) : (size_t)pm; }
  __device__ __forceinline__ size_t ct(int pn) const { return cmap ? (size_t)((cmap >> (4 * pn)) & 15ull) : (size_t)pn; } };

struct StaticOrder {
    int nM, nN, nwg, G, c;
    __host__ __device__ void init(int M, int N, int G_, int c_) { nM = M / BM; nN = N / BM; nwg = nM * nN; G = G_; c = c_; }
    __host__ __device__ bool next(int i, Unit& u) const {
        const long L = (long)i * G + c; if (L >= nwg) return false;
        int wgid = (int)L; { const int q = nwg / NXCD, r = nwg % NXCD, xcd = wgid % NXCD, off = wgid / NXCD; wgid = (xcd < r ? xcd * (q + 1) : r * (q + 1) + (xcd - r) * q) + off; }
        const int nig = WGM * nN, gid = wgid / nig, fm = gid * WGM, gsz = (nM - fm) < WGM ? (nM - fm) : WGM;
        u.pm = fm + ((wgid % nig) % gsz); u.pn = (wgid % nig) / gsz; return true;
    }
    __device__ __forceinline__ void a_ready(const Unit&) const {}
    __device__ __forceinline__ void done(const Unit&) const {}
};
struct CountedOrder : StaticOrder {
    const unsigned* ready; unsigned need; unsigned* tmo;
    __device__ __forceinline__ void a_ready(const Unit& u) const {
        if (threadIdx.x < 64) {
            const unsigned long long t0 = __builtin_amdgcn_s_memrealtime(); unsigned polls = 0;
            while ((unsigned)__builtin_amdgcn_readfirstlane(__hip_atomic_load(ready + 64 * u.pm, __ATOMIC_RELAXED, __HIP_MEMORY_SCOPE_AGENT)) < need) {
                if ((++polls & 255u) == 0u && __builtin_amdgcn_readfirstlane(__hip_atomic_load(tmo, __ATOMIC_RELAXED, __HIP_MEMORY_SCOPE_AGENT)) != 0u) break;
                if (__builtin_amdgcn_s_memrealtime() - t0 > 2000000ull) {
                    if (threadIdx.x == 0) { unsigned expect = 0u; __hip_atomic_compare_exchange_strong(tmo + 1, &expect, 0x600u | (unsigned)(u.pm & 0xff), __ATOMIC_RELAXED, __ATOMIC_RELAXED, __HIP_MEMORY_SCOPE_AGENT); __hip_atomic_store(tmo, 1u, __ATOMIC_RELAXED, __HIP_MEMORY_SCOPE_AGENT); }
                    break; }
                __builtin_amdgcn_s_sleep(2); }
            __builtin_amdgcn_fence(__ATOMIC_ACQUIRE, "agent");
            asm volatile("s_waitcnt vmcnt(0)" ::: "memory");
        }
#if !defined(BROKEN_HOOK_NO_BARRIER)
        asm volatile("" ::: "memory"); __builtin_amdgcn_s_barrier(); asm volatile("" ::: "memory");
#endif
    }
};

__device__ __forceinline__ unsigned cvt_pk_bf16(float lo, float hi) { unsigned r; asm volatile("v_cvt_pk_bf16_f32 %0, %1, %2" : "=v"(r) : "v"(lo), "v"(hi)); return r; }
typedef float f32x2 __attribute__((ext_vector_type(2)));
__device__ __forceinline__ f32x2 gelu_pk(f32x2 v) {
    const f32x2 av = __builtin_elementwise_abs(v), d = av * 0.2316418882f + 1.0f;
    f32x2 t; t.x = __builtin_amdgcn_rcpf(d.x); t.y = __builtin_amdgcn_rcpf(d.y);
    f32x2 q = t * 0.5307027145f + (-0.7265760135f); q = q * t + 0.7107068705f; q = q * t + (-0.142248368f); q = q * t + 0.127414796f; q = q * t;
    const f32x2 s = (v * v) * (-0.72134752044f);
    f32x2 e; e.x = __builtin_amdgcn_exp2f(s.x); e.y = __builtin_amdgcn_exp2f(s.y);
    const f32x2 m = v * (q * e), r = v - m;
    f32x2 o; o.x = v.x < 0.f ? m.x : r.x; o.y = v.y < 0.f ? m.y : r.y; return o;
}

struct EpiF32 {
    static constexpr bool PERM = false, AFTER_DRAIN = false;
    float* C; int ldc; const float* bias;
    __device__ __forceinline__ void operator()(const f32x4 (&acc)[2][2][4][2], const Unit& u, int wr, int wc, int fr, int fq) const {
        const int row0 = u.pm * BM + wr * 64 + fr, col0 = u.pn * BM + wc * 32 + 4 * fq;
        f32x4 bv[2][2];
#pragma unroll
        for (int bj = 0; bj < 2; ++bj)
#pragma unroll
            for (int n = 0; n < 2; ++n) bv[bj][n] = bias ? *(const f32x4*)(bias + col0 + bj * HALF + n * 16) : (f32x4){0.f, 0.f, 0.f, 0.f};
#pragma unroll
        for (int ai = 0; ai < 2; ++ai)
#pragma unroll
            for (int m = 0; m < 4; ++m) { float* rowp = C + (size_t)(row0 + ai * HALF + m * 16) * ldc + col0;
#pragma unroll
                for (int bj = 0; bj < 2; ++bj)
#pragma unroll
                    for (int n = 0; n < 2; ++n) *(f32x4*)(rowp + bj * HALF + n * 16) = acc[ai][bj][m][n] + bv[bj][n]; }
    }
};
template <int ACT  > struct EpiBf16 {
    static constexpr bool PERM = true, AFTER_DRAIN = false;
    bf16_t* O; int ldc; const float* bias; int split_cols; size_t split_stride;
    __device__ __forceinline__ void operator()(const f32x4 (&acc)[2][2][4][2], const Unit& u, int wr, int wc, int fr, int fq) const {
        const int row0 = u.pm * BM + wr * 64 + fr; int colt = u.pn * BM; bf16_t* base = O;
        if (split_cols) { const int t = colt / split_cols; base += (size_t)t * split_stride; colt -= t * split_cols; }
        const int col0 = colt + wc * 32 + 8 * fq, bcol0 = u.pn * BM + wc * 32 + 8 * fq;
        f32x4 bv[2][2];
#pragma unroll
        for (int bj = 0; bj < 2; ++bj)
#pragma unroll
            for (int n = 0; n < 2; ++n) bv[bj][n] = bias ? *(const f32x4*)(bias + bcol0 + bj * HALF + 4 * n) : (f32x4){0.f, 0.f, 0.f, 0.f};
#pragma unroll
        for (int ai = 0; ai < 2; ++ai)
#pragma unroll
            for (int m = 0; m < 4; ++m) { bf16_t* rowp = base + (size_t)(row0 + ai * HALF + m * 16) * ldc + col0;
#pragma unroll
                for (int bj = 0; bj < 2; ++bj) { f32x4 v0 = acc[ai][bj][m][0] + bv[bj][0], v1 = acc[ai][bj][m][1] + bv[bj][1];
                    if (ACT == 1) { f32x2 a = gelu_pk((f32x2){v0[0], v0[1]}), b = gelu_pk((f32x2){v0[2], v0[3]}), c = gelu_pk((f32x2){v1[0], v1[1]}), d = gelu_pk((f32x2){v1[2], v1[3]});
                        v0 = (f32x4){a.x, a.y, b.x, b.y}; v1 = (f32x4){c.x, c.y, d.x, d.y}; }
                    if (ACT == 2) {
#pragma unroll
                        for (int j = 0; j < 4; ++j) { v0[j] = 0.5f * v0[j] * (1.0f + erff(v0[j] * 0.70710678f)); v1[j] = 0.5f * v1[j] * (1.0f + erff(v1[j] * 0.70710678f)); } }
                    u32x4 w; w.x = cvt_pk_bf16(v0[0], v0[1]); w.y = cvt_pk_bf16(v0[2], v0[3]); w.z = cvt_pk_bf16(v1[0], v1[1]); w.w = cvt_pk_bf16(v1[2], v1[3]);
                    *(u32x4*)(rowp + bj * HALF) = w; } }
    }
};


template <class Epi, class Sched, bool STAMP = false>
__device__ __forceinline__ void gemm_phase(PG8_LAS unsigned char* lds, const Gemm g, const Sched& S, const Epi& E, unsigned long long* stamps) {
    const int tid = threadIdx.x, wid = __builtin_amdgcn_readfirstlane(tid >> 6), lane = tid & 63, wr = wid >> 2, wc = wid & 3, fr = lane & 15, fq = lane >> 4;
    const int K = g.K, nt = K / BK;
    int ts_lo = 0, ts_hi = 0, nts = 0; const unsigned long long rt_entry = STAMP ? (unsigned long long)wall_clock64() : 0ull;
#define PG8_STAMP() do { if (STAMP && wid == 0 && nts < 64) { const unsigned long long _c = (unsigned long long)clock64(); \
        ts_lo = (lane == nts) ? (int)(unsigned)_c : ts_lo; ts_hi = (lane == nts) ? (int)(unsigned)(_c >> 32) : ts_hi; ++nts; } } while (0)
    PG8_STAMP();
    unsigned voffA[2], voffB[2];
#pragma unroll
    for (int i = 0; i < 2; ++i) { int R, C; stage_rc(tid * 16 + i * 8192, R, C); const int Rb = Epi::PERM ? ((R & ~31) + perm32(R & 31)) : R;
        voffA[i] = (unsigned)(R * K + C) * 2u; voffB[i] = (unsigned)(Rb * K + C) * 2u; }
    const size_t kstep = (size_t)(BK * 2);
    const size_t hstep = (size_t)HALF * K * 2;
    const size_t tstep = 2 * hstep;
    const unsigned ldsw = (unsigned)wid * 1024u;
    const int aoff = lds_byte(wr * 64 + fr, fq * 8), boff = lds_byte(wc * 32 + fr, fq * 8);
#define PG8_SA(b, h) (((b) * 2 + (h)) * HTB)
#define PG8_SB(b, h) ((4 + (b) * 2 + (h)) * HTB)
#define PG8_STAGE(bufoff, gbase, voff) do { _Pragma("unroll") for (int _i = 0; _i < 2; ++_i) \
        __builtin_amdgcn_global_load_lds((const unsigned*)((const char*)(gbase) + (voff)[_i]), (PG8_LAS unsigned*)(lds + (bufoff) + ldsw + _i * 8192), 16, 0, 0); } while (0)
#define PG8_LDA(dst, b, h) do { _Pragma("unroll") for (int m = 0; m < 4; ++m) _Pragma("unroll") for (int k = 0; k < 2; ++k) dst[m][k] = *(const PG8_LAS bf16x8*)(lds + PG8_SA(b, h) + aoff + m * 2048 + k * 1024); } while (0)
#define PG8_LDB(dst, b, h) do { _Pragma("unroll") for (int n = 0; n < 2; ++n) _Pragma("unroll") for (int k = 0; k < 2; ++k) dst[n][k] = *(const PG8_LAS bf16x8*)(lds + PG8_SB(b, h) + boff + n * 2048 + k * 1024); } while (0)
#define PG8_MMA(ai, bj, At, Bt) do { __builtin_amdgcn_s_setprio(1); _Pragma("unroll") for (int m = 0; m < 4; ++m) _Pragma("unroll") for (int n = 0; n < 2; ++n) _Pragma("unroll") for (int k = 0; k < 2; ++k) \
        acc[ai][bj][m][n] = __builtin_amdgcn_mfma_f32_16x16x32_bf16(Bt[n][k], At[m][k], acc[ai][bj][m][n], 0, 0, 0); __builtin_amdgcn_s_setprio(0); } while (0)
#define PG8_WAIT_V(n) asm volatile("s_waitcnt vmcnt(" #n ")" ::: "memory")
#define PG8_WAIT_L(n) asm volatile("s_waitcnt lgkmcnt(" #n ")" ::: "memory")
#define PG8_BAR __builtin_amdgcn_s_barrier()
#define PG8_SCHED __builtin_amdgcn_sched_barrier(0)
    Unit cur, nxt; int ui = 0;
    if (!S.next(0, cur)) return;
    f32x4 acc[2][2][4][2];
#pragma unroll
    for (int a = 0; a < 2; ++a)
#pragma unroll
        for (int b = 0; b < 2; ++b)
#pragma unroll
            for (int m = 0; m < 4; ++m)
#pragma unroll
                for (int n = 0; n < 2; ++n) acc[a][b][m][n] = (f32x4){0.f, 0.f, 0.f, 0.f};
    bf16x8 At[4][2], B0[2][2], B1[2][2];
    const char* cA = (const char*)(cur.pn >= g.pn_split ? g.A2 : g.A) + g.rt(cur.pm) * tstep; const char* cB = (const char*)g.Bt + g.ct(cur.pn) * tstep;
    S.a_ready(cur);
    PG8_STAGE(PG8_SB(0, 0), cB, voffB); PG8_STAGE(PG8_SA(0, 0), cA, voffA); PG8_STAGE(PG8_SB(0, 1), cB + hstep, voffB); PG8_STAGE(PG8_SA(0, 1), cA + hstep, voffA);
    if (wr == 1) PG8_BAR;
    PG8_WAIT_V(4); PG8_BAR;
    PG8_STAGE(PG8_SB(1, 0), cB + kstep, voffB); PG8_STAGE(PG8_SA(1, 0), cA + kstep, voffA); PG8_STAGE(PG8_SB(1, 1), cB + hstep + kstep, voffB);
    PG8_WAIT_V(6); PG8_BAR;
    PG8_STAMP();
    for (;;) {
        const bool has_next = S.next(ui + 1, nxt);
        const char* nA = has_next ? (const char*)(nxt.pn >= g.pn_split ? g.A2 : g.A) + g.rt(nxt.pm) * tstep : cA; const char* nB = has_next ? (const char*)g.Bt + g.ct(nxt.pn) * tstep : cB;
        for (int t = 0; t < nt; t += 2) {
            const bool last = (t == nt - 2);
            const char* a1 = cA + (size_t)(t + 1) * kstep;
            const char* a2 = last ? nA : cA + (size_t)(t + 2) * kstep; const char* b2 = last ? nB : cB + (size_t)(t + 2) * kstep;
            const char* a3 = a2 + kstep; const char* b3 = b2 + kstep;
            if (last && has_next) S.a_ready(nxt);
            PG8_LDB(B0, 0, 0); PG8_SCHED; PG8_LDA(At, 0, 0); PG8_STAGE(PG8_SA(1, 1), a1 + hstep, voffA);
            PG8_WAIT_L(8); PG8_BAR; PG8_WAIT_L(0); PG8_MMA(0, 0, At, B0); PG8_BAR; PG8_SCHED;
            PG8_LDB(B1, 0, 1); PG8_STAGE(PG8_SB(0, 0), b2, voffB);
            PG8_BAR; PG8_WAIT_L(0); PG8_MMA(0, 1, At, B1); PG8_BAR;
            PG8_LDA(At, 0, 1); PG8_STAGE(PG8_SA(0, 0), a2, voffA);
            PG8_BAR; PG8_WAIT_L(0); PG8_MMA(1, 0, At, B0); PG8_BAR; PG8_SCHED;
            PG8_STAGE(PG8_SB(0, 1), b2 + hstep, voffB);
            PG8_WAIT_V(6); PG8_BAR; PG8_MMA(1, 1, At, B1); PG8_BAR;
            PG8_LDB(B0, 1, 0); PG8_SCHED; PG8_LDA(At, 1, 0); PG8_STAGE(PG8_SA(0, 1), a2 + hstep, voffA);
            PG8_WAIT_L(8); PG8_BAR; PG8_WAIT_L(0); PG8_MMA(0, 0, At, B0); PG8_BAR; PG8_SCHED;
            PG8_LDB(B1, 1, 1); PG8_STAGE(PG8_SB(1, 0), b3, voffB);
            PG8_BAR; PG8_WAIT_L(0); PG8_MMA(0, 1, At, B1); PG8_BAR;
            PG8_LDA(At, 1, 1); PG8_STAGE(PG8_SA(1, 0), a3, voffA);
            PG8_BAR; PG8_WAIT_L(0); PG8_MMA(1, 0, At, B0); PG8_BAR; PG8_SCHED;
            PG8_STAGE(PG8_SB(1, 1), b3 + hstep, voffB);
            PG8_WAIT_V(6); PG8_BAR; PG8_MMA(1, 1, At, B1); PG8_BAR;
        }
        PG8_STAMP();
        if constexpr (!Epi::AFTER_DRAIN) { E(acc, cur, wr, wc, fr, fq); S.done(cur); }
        PG8_STAMP();
        if (!has_next) break;
#pragma unroll
        for (int a = 0; a < 2; ++a)
#pragma unroll
            for (int b = 0; b < 2; ++b)
#pragma unroll
                for (int m = 0; m < 4; ++m)
#pragma unroll
                    for (int n = 0; n < 2; ++n) acc[a][b][m][n] = (f32x4){0.f, 0.f, 0.f, 0.f};
        cur = nxt; cA = nA; cB = nB; ++ui;
    }
    PG8_WAIT_V(0);
    if (wr == 0) PG8_BAR;
    PG8_BAR;
    if constexpr (Epi::AFTER_DRAIN) { E.fused(acc, cur, wr, wc, fr, fq, lds, wid, lane); S.done(cur); }
    PG8_STAMP();
    if (STAMP && wid == 0) { stamps[lane] = lane < nts ? (((unsigned long long)(unsigned)ts_hi << 32) | (unsigned)ts_lo) : 0ull;
        if (lane == 62) stamps[62] = rt_entry; if (lane == 63) stamps[63] = (unsigned long long)wall_clock64(); }
#undef PG8_STAMP
#undef PG8_SA
#undef PG8_SB
#undef PG8_STAGE
#undef PG8_LDA
#undef PG8_LDB
#undef PG8_MMA
#undef PG8_WAIT_V
#undef PG8_WAIT_L
#undef PG8_BAR
#undef PG8_SCHED
}
}

struct TileSched {
  int xcd, local, vbid, vnb, MT, NT, SM, SN, j, snc;
  bool swz;
  DEVI TileSched(int bid, int nb, int half, int MT_, int NT_, int SM_, int SN_) : MT(MT_), NT(NT_), SM(SM_), SN(SN_), j(0) {
    xcd = bid & 7;
    local = (bid >> 3) * 2 + half;
    vbid = bid * 2 + half;
    vnb = nb * 2;
    swz = (vnb == 8 * SM * SN) && ((nb & 7) == 0);
    snc = (NT + SN - 1) / SN;
  }
  DEVI int next(int& mt, int& nt) {
    if (swz) {
      const int s = j * 8 + xcd;
      ++j;
      const int sm = s / snc, sn = s - sm * snc;
      if (sm * SM >= MT) return 0;
      mt = sm * SM + local / SN;
      nt = sn * SN + local % SN;
      return (mt < MT && nt < NT) ? 1 : 2;
    } else {
      const int it = vbid + j * vnb;
      ++j;
      if (it >= MT * NT) return 0;
      mt = it / NT;
      nt = it - mt * NT;
      return 1;
    }
  }
};

struct ALoadPlain {
  typedef uint4 Raw;
  static constexpr bool kFat = false;
  static constexpr bool kConsec = false;
  const bfu* A;
  int lda;
  DEVI Raw load(int row, int k) const { return *(const uint4*)(A + (size_t)row * lda + k); }
  DEVI uint4 loadprev(int, int) const { return uint4{0u, 0u, 0u, 0u}; }
  DEVI uint4 asprev(const Raw&) const { return uint4{0u, 0u, 0u, 0u}; }
  DEVI uint4 finish(const Raw& r, const uint4&, int, int) const { return r; }
};

DEVI void transpose_tile(char* smem, const float* __restrict__ src, int Ns, bfu* __restrict__ dst, int ldd, int noff,
                         int k0, int n0) {
  float(*tile)[65] = (float(*)[65])smem;
  const int tid = TIDX;
  const int kr = tid >> 4, nc = (tid & 15) * 4;
#pragma unroll
  for (int p = 0; p < 4; ++p) {
    float4 v = *(const float4*)(src + (size_t)(k0 + kr + 16 * p) * Ns + n0 + nc);
    tile[kr + 16 * p][nc] = v.x;
    tile[kr + 16 * p][nc + 1] = v.y;
    tile[kr + 16 * p][nc + 2] = v.z;
    tile[kr + 16 * p][nc + 3] = v.w;
  }
  __syncthreads();
  const int nr = tid >> 3, kc = (tid & 7) * 8;
#pragma unroll
  for (int p = 0; p < 2; ++p) {
    const int n = nr + 32 * p;
    float f[8];
#pragma unroll
    for (int j = 0; j < 8; ++j) f[j] = tile[kc + j][n];
    *(uint4*)(dst + (size_t)(noff + n0 + n) * ldd + k0 + kc) = pack8(f);
  }
  __syncthreads();
}

template <int R>
DEVI void rms_rows_bf16(const float* __restrict__ src, const float* __restrict__ g, bfu* __restrict__ dst, int lane) {
  float4 v[R][4];
  float ss[R];
#pragma unroll
  for (int r = 0; r < R; ++r) {
    ss[r] = 0.f;
#pragma unroll
    for (int i = 0; i < 4; ++i) v[r][i] = *(const float4*)(src + r * 1024 + lane * 4 + 256 * i);
  }
#pragma unroll
  for (int r = 0; r < R; ++r)
#pragma unroll
    for (int i = 0; i < 4; ++i)
      ss[r] += v[r][i].x * v[r][i].x + v[r][i].y * v[r][i].y + v[r][i].z * v[r][i].z + v[r][i].w * v[r][i].w;
#pragma unroll
  for (int r = 0; r < R; ++r) {
    const float rinv = rsqrtf(wave_sum(ss[r]) * (1.f / 1024.f) + 1e-6f);
#pragma unroll
    for (int i = 0; i < 4; ++i) {
      const float4 gg = *(const float4*)(g + lane * 4 + 256 * i);
      uint2 o;
      o.x = pkbf(v[r][i].x * rinv * gg.x, v[r][i].y * rinv * gg.y);
      o.y = pkbf(v[r][i].z * rinv * gg.z, v[r][i].w * rinv * gg.w);
      *(uint2*)(dst + r * 1024 + lane * 4 + 256 * i) = o;
    }
  }
}
DEVI void rms_row2_bf16(const float* __restrict__ src, const float* __restrict__ g, bfu* __restrict__ dst, int lane) {
  rms_rows_bf16<2>(src, g, dst, lane);
}

DEVI void phase0(const Params& p, char* smem, int bid, int nb) {
  constexpr int NT_IN = 16 * 56, NT_SQ = 256, NT_SM = 16;
  constexpr int c0 = NT_IN, c1 = c0 + NT_SQ, c2 = c1 + 4 * NT_SQ, c3 = c2 + NT_SM, c4 = c3 + NT_SM, c5 = c4 + NT_SQ,
                c6 = c5 + NT_SM, c7 = c6 + NT_SM, c8 = c7 + 2, c9 = c8 + T_TOK / 8;
  smem += HF * HALF_SMEM;
  for (int it = bid * 2 + HF; it < c9; it += nb * 2) {
    if (it < c0) {
      transpose_tile(smem, p.w_in, 3584, p.WT_in, 1024, 0, (it / 56) * 64, (it % 56) * 64);
    } else if (it < c1) {
      int j = it - c0;
      transpose_tile(smem, p.w_out, 1024, p.WT_out, 1024, 0, (j >> 4) * 64, (j & 15) * 64);
    } else if (it < c2) {
      int j = it - c1;
      int w = j >> 8;
      j &= 255;
      const float* src = (w == 0) ? p.wr : (w == 1) ? p.wk : (w == 2) ? p.wv : p.wg;
      transpose_tile(smem, src, 1024, p.WT_3, 1024, w * 1024, (j >> 4) * 64, (j & 15) * 64);
    } else if (it < c3) {
      int j = it - c2;
      transpose_tile(smem, p.w1, 64, p.WT_3, 1024, 4096, j * 64, 0);
    } else if (it < c4) {
      int j = it - c3;
      transpose_tile(smem, p.a1, 64, p.WT_3, 1024, 4224, j * 64, 0);
    } else if (it < c5) {
      int j = it - c4;
      transpose_tile(smem, p.wo, 1024, p.WT_o, 1024, 0, (j >> 4) * 64, (j & 15) * 64);
    } else if (it < c6) {
      int j = it - c5;
      transpose_tile(smem, p.w2, 1024, p.W2T, 64, 0, 0, j * 64);
    } else if (it < c7) {
      int j = it - c6;
      transpose_tile(smem, p.a2, 1024, p.A2T, 64, 0, 0, j * 64);
    } else if (it < c8) {
      int j = it - c7;
      bfu* dst = p.WT_3 + (size_t)(j == 0 ? 4160 : 4288) * 1024;
      for (int e = TIDX; e < 64 * 1024 / 8; e += 256) *(uint4*)(dst + e * 8) = uint4{0, 0, 0, 0};
    } else {
      int row = (it - c8) * 8 + (TIDX >> 6) * 2;
      rms_row2_bf16(p.x + (size_t)row * 1024, p.ln_even, p.H + (size_t)row * 1024, TIDX & 63);
    }
  }
}

constexpr unsigned long long kCmap1 = 0xDCBA765410ull;
struct PgEpi1 {
  static constexpr bool PERM = true, AFTER_DRAIN = false;
  const Params* p;
  DEVI void operator()(const pg8::f32x4 (&acc)[2][2][4][2], const pg8::Unit& u, int wr, int wc, int fr, int fq) const {
    const int row0 = u.pm * 256 + wr * 64 + fr;
    const int seg = (int)((kCmap1 >> (4 * u.pn)) & 15ull);
#pragma unroll
    for (int ai = 0; ai < 2; ++ai)
#pragma unroll
      for (int m = 0; m < 4; ++m) {
        const int row = row0 + ai * 128 + m * 16;
#pragma unroll
        for (int bj = 0; bj < 2; ++bj) {
          const int col = seg * 256 + bj * 128 + wc * 32 + 8 * fq;
          const f32x4 v0 = acc[ai][bj][m][0], v1 = acc[ai][bj][m][1];
          uint4 w;
          if (seg < 2) {
            w.x = pkbf(gelu_(v0[0]), gelu_(v0[1])); w.y = pkbf(gelu_(v0[2]), gelu_(v0[3]));
            w.z = pkbf(gelu_(v1[0]), gelu_(v1[1])); w.w = pkbf(gelu_(v1[2]), gelu_(v1[3]));
            *(uint4*)(p->U + (size_t)row * 512 + col) = w;
          } else if (seg < 8) {
            w.x = pkbf(v0[0], v0[1]); w.y = pkbf(v0[2], v0[3]); w.z = pkbf(v1[0], v1[1]); w.w = pkbf(v1[2], v1[3]);
            bfu* dst = (seg < 6) ? p->Q + (size_t)row * 512 + (col - 1024) : p->K + (size_t)row * 512 + (col - 1536);
            *(uint4*)dst = w;
          } else {
            w.x = pkbf(silu_(v0[0]), silu_(v0[1])); w.y = pkbf(silu_(v0[2]), silu_(v0[3]));
            w.z = pkbf(silu_(v1[0]), silu_(v1[1])); w.w = pkbf(silu_(v1[2]), silu_(v1[3]));
            *(uint4*)(p->SZ + (size_t)row * 1024 + (col - 2560)) = w;
          }
        }
      }
  }
};
constexpr unsigned long long kRmap1 = 0x9832ull;
struct PgEpi1T {
  static constexpr bool PERM = true, AFTER_DRAIN = false;
  const Params* p;
  DEVI void operator()(const pg8::f32x4 (&acc)[2][2][4][2], const pg8::Unit& u, int wr, int wc, int fr, int fq) const {
    const int ch0 = (u.pm & 1) * 256 + wr * 64 + fr;
    const bool isv = u.pm >= 2;
#pragma unroll
    for (int ai = 0; ai < 2; ++ai)
#pragma unroll
      for (int m = 0; m < 4; ++m) {
        const int ch = ch0 + ai * 128 + m * 16;
#pragma unroll
        for (int bj = 0; bj < 2; ++bj) {
          const int t = u.pn * 256 + bj * 128 + wc * 32 + 8 * fq;
          const f32x4 v0 = acc[ai][bj][m][0], v1 = acc[ai][bj][m][1];
          if (!isv) {
            const int g = ch >> 7, c = ch & 127;
            uint4 w;
            w.x = pkbf(gelu_(v0[0]), gelu_(v0[1])); w.y = pkbf(gelu_(v0[2]), gelu_(v0[3]));
            w.z = pkbf(gelu_(v1[0]), gelu_(v1[1])); w.w = pkbf(gelu_(v1[2]), gelu_(v1[3]));
            *(uint4*)(p->GVT + ((size_t)(((t >> 7) * 4 + g) * 128 + c)) * 128 + (t & 127)) = w;
          } else {
            const int hh = ch >> 6, dim = ch & 63;
            const int b = t >> 14, s = t & (SEQ - 1);
            bfu* base = p->VT + ((size_t)((b * 8 + hh) * 64 + dim)) * SEQ;
            const size_t PST = (size_t)16 * 64 * SEQ;
            uint4 w;
            w.x = pkbf(v0[0], v0[1]); w.y = pkbf(v0[2], v0[3]); w.z = pkbf(v1[0], v1[1]); w.w = pkbf(v1[2], v1[3]);
            *(uint4*)(base + s) = w;
            bfu* b1 = base + PST + (s >> 2);
#pragma unroll
            for (int e = 0; e < 4; ++e) *(unsigned*)(b1 + (size_t)e * (SEQ / 4)) = pkbf(v0[e], v1[e]);
            bfu* b2 = base + 2 * PST + (size_t)(s & 15) * (SEQ / 16) + (s >> 4);
#pragma unroll
            for (int e = 0; e < 4; ++e) {
              b2[(size_t)e * (SEQ / 16)] = (bfu)f2bf(v0[e]);
              b2[(size_t)(e + 4) * (SEQ / 16)] = (bfu)f2bf(v1[e]);
            }
          }
        }
      }
  }
};
struct PgEpiRes {
  static constexpr bool PERM = false, AFTER_DRAIN = false;
  const float* base;
  float* out;
  DEVI void operator()(const pg8::f32x4 (&acc)[2][2][4][2], const pg8::Unit& u, int wr, int wc, int fr, int fq) const {
    const int row0 = u.pm * 256 + wr * 64 + fr, col0 = u.pn * 256 + wc * 32 + 4 * fq;
#pragma unroll
    for (int ai = 0; ai < 2; ++ai)
#pragma unroll
      for (int m = 0; m < 4; ++m) {
        const size_t rb = (size_t)(row0 + ai * 128 + m * 16) * 1024 + col0;
#pragma unroll
        for (int bj = 0; bj < 2; ++bj)
#pragma unroll
          for (int n = 0; n < 2; ++n) {
            const size_t idx = rb + bj * 128 + n * 16;
            const f32x4 b = *(const f32x4*)(base + idx);
            *(f32x4*)(out + idx) = acc[ai][bj][m][n] + b;
          }
      }
  }
};
template <class Epi>
DEVI void pg_gemm(char* smem, const bfu* A, const bfu* Bt, int M, int N, int K, const Epi& E, int bid, int nb) {
  pg8::Gemm g{A, Bt, M, N, K, A, 1 << 30, 0ull, 0ull};
  pg8::StaticOrder S;
  S.init(M, N, nb, bid);
  pg8::gemm_phase<Epi, pg8::StaticOrder, false>((PG8_LAS unsigned char*)smem, g, S, E, nullptr);
}
template <class Epi>
DEVI void pg_gemm2(char* smem, const bfu* A, const bfu* A2, int pn_split, const bfu* Bt, int M, int N, int K, const Epi& E,
                   int bid, int nb) {
  pg8::Gemm g{A, Bt, M, N, K, A2, pn_split, 0ull, 0ull};
  pg8::StaticOrder S;
  S.init(M, N, nb, bid);
  pg8::gemm_phase<Epi, pg8::StaticOrder, false>((PG8_LAS unsigned char*)smem, g, S, E, nullptr);
}
struct PgEpi3 {
  static constexpr bool PERM = true, AFTER_DRAIN = false;
  bfu* O0;
  bfu* O1;
  int silu1;
  DEVI void operator()(const pg8::f32x4 (&acc)[2][2][4][2], const pg8::Unit& u, int wr, int wc, int fr, int fq) const {
    const int row0 = u.pm * 256 + wr * 64 + fr;
    const int grp = u.pn >> 2;
    bfu* O = grp ? O1 : O0;
    const bool act = grp && silu1;
    const int colb = (u.pn & 3) * 256 + wc * 32 + 8 * fq;
#pragma unroll
    for (int ai = 0; ai < 2; ++ai)
#pragma unroll
      for (int m = 0; m < 4; ++m) {
        bfu* rowp = O + (size_t)(row0 + ai * 128 + m * 16) * 1024 + colb;
#pragma unroll
        for (int bj = 0; bj < 2; ++bj) {
          f32x4 v0 = acc[ai][bj][m][0], v1 = acc[ai][bj][m][1];
          if (act) {
#pragma unroll
            for (int e = 0; e < 4; ++e) {
              v0[e] = silu_(v0[e]);
              v1[e] = silu_(v1[e]);
            }
          }
          uint4 w;
          w.x = pkbf(v0[0], v0[1]); w.y = pkbf(v0[2], v0[3]); w.z = pkbf(v1[0], v1[1]); w.w = pkbf(v1[2], v1[3]);
          *(uint4*)(rowp + bj * 128) = w;
        }
      }
  }
};

DEVI void phase1(const Params& p, char* smem, int bid, int nb) {
  {
    PgEpi1 E{&p};
    pg8::Gemm g{p.H, p.WT_in, T_TOK, 2560, 1024, p.H, 1 << 30, 0ull, kCmap1};
    pg8::StaticOrder S;
    S.init(T_TOK, 2560, nb, bid);
    pg8::gemm_phase<PgEpi1, pg8::StaticOrder, false>((PG8_LAS unsigned char*)smem, g, S, E, nullptr);
  }
  {
    PgEpi1T E{&p};
    pg8::Gemm g{p.WT_in, p.H, 1024, T_TOK, 1024, p.WT_in, 1 << 30, kRmap1, 0ull};
    pg8::StaticOrder S;
    S.init(1024, T_TOK, nb, bid);
    pg8::gemm_phase<PgEpi1T, pg8::StaticOrder, false>((PG8_LAS unsigned char*)smem, g, S, E, nullptr);
  }
}

struct ALoadWs {
  struct Raw { float4 a, b; };
  static constexpr bool kFat = true;
  static constexpr bool kConsec = false;
  const float* ws;
  const float* rinv;
  DEVI Raw load(int t, int s0) const {
    Raw r;
    r.a = *(const float4*)(ws + t * 128 + s0);
    r.b = *(const float4*)(ws + t * 128 + s0 + 4);
    return r;
  }
  DEVI uint4 loadprev(int, int) const { return uint4{0u, 0u, 0u, 0u}; }
  DEVI uint4 asprev(const Raw&) const { return uint4{0u, 0u, 0u, 0u}; }
  DEVI uint4 finish(const Raw& r, const uint4&, int t, int s0) const {
    float f[8] = {r.a.x, r.a.y, r.a.z, r.a.w, r.b.x, r.b.y, r.b.z, r.b.w};
#pragma unroll
    for (int j = 0; j < 8; ++j) f[j] = (s0 + j <= t) ? f[j] * rinv[s0 + j] : 0.f;
    return pack8(f);
  }
};
struct EpiGm {
  const Params* p;
  int chunk, g;
  DEVI void operator()(int t, int c, f32x4 v) const {
    const float4 gn = *(const float4*)(p->gm_norm + g * 128 + c);
    const float bias = p->gm_b[g * 128 + t];
    const size_t tok = (size_t)chunk * 128 + t;
    float u[4], sz[4];
    unpack4(*(const uint2*)(p->U + tok * 512 + g * 128 + c), u);
    unpack4(*(const uint2*)(p->SZ + tok * 1024 + g * 128 + c), sz);
    uint2 o;
    o.x = pkbf(u[0] * (v[0] * gn.x + bias) * sz[0], u[1] * (v[1] * gn.y + bias) * sz[1]);
    o.y = pkbf(u[2] * (v[2] * gn.z + bias) * sz[2], u[3] * (v[3] * gn.w + bias) * sz[3]);
    *(uint2*)(p->Y + tok * 1024 + g * 128 + c) = o;
  }
};

DEVI void gmlp_item(const Params& p, char* smem, int item) {
  const int chunk = item >> 2, g = item & 3;
  const bfu* gv = p.GVT + (size_t)item * 128 * 128;
  float* rinv = (float*)(smem + 2 * GSTAGE_BYTES);
  const int tid = TIDX;
  {
    float* sred = rinv + 128;
    const int s4 = (tid & 31) * 4, cg = tid >> 5;
    uint2 raw[16];
#pragma unroll
    for (int i = 0; i < 16; ++i) raw[i] = *(const uint2*)(gv + (cg * 16 + i) * 128 + s4);
    float ss[4] = {0.f, 0.f, 0.f, 0.f};
#pragma unroll
    for (int i = 0; i < 16; ++i) {
      float f[4];
      unpack4(raw[i], f);
#pragma unroll
      for (int j = 0; j < 4; ++j) ss[j] += f[j] * f[j];
    }
    *(float4*)(sred + cg * 128 + s4) = float4{ss[0], ss[1], ss[2], ss[3]};
    __syncthreads();
    if (tid < 128) {
      float t = 0.f;
#pragma unroll
      for (int i = 0; i < 8; ++i) t += sred[i * 128 + tid];
      rinv[tid] = rsqrtf(t * (1.f / 128.f) + 1e-6f);
    }
  }
  __syncthreads();
  ALoadWs al{p.gm_ws + (size_t)g * 128 * 128, rinv};
  EpiGm epi{&p, chunk, g};
  gemm_tile(smem, al, gv, 128, 128, 0, 0, epi);
}

DEVI void attn_item(const Params& p, char* smem, int item) {
  const int qb = item & 63, bh = item >> 6, b = bh >> 3, h = bh & 7;
  const int q0 = qb * 256;
  bfu* Ob = (bfu*)smem;
  float* Mb = (float*)(smem + 32768);
  float* Lb = Mb + 256;
  const int tid = threadIdx.x, lane = tid & 63, wid = tid >> 6;
  const int qi = lane & 15, g = lane >> 4;
  const float slope = exp2f(-(float)(h + 1));
  const size_t tokb = (size_t)b * SEQ;
#pragma unroll 1
  for (int pi = 0; pi < 3; ++pi) {
    const int dshift = 2 * pi, d = 1 << dshift;
    const bfu* VT = p.VT + (size_t)pi * ((size_t)16 * 64 * SEQ) + (size_t)bh * 64 * SEQ;
#pragma unroll 1
    for (int u = wid; u < 16; u += 8) {
      const int r = u & (d - 1), tile = u >> dshift;
      const int sq0 = (q0 >> dshift) + tile * 16;
      const int sk0 = sq0 - 144;
      const int posq = ((sq0 + qi) << dshift) + r;
      const bfu* qp = p.Q + (tokb + posq) * 512 + h * 64 + g * 8;
      const bf16x8 qf0 = *(const bf16x8*)qp, qf1 = *(const bf16x8*)(qp + 32);
      const bfu* kbase = p.K + (tokb + r) * 512 + h * 64 + g * 8;
      const bfu* vbase = VT + (size_t)qi * SEQ + r * (SEQ >> dshift);
      bf16x8 kf[2][2];
      uint2 vf[4][2];
      auto loadk = [&](int it) {
#pragma unroll
        for (int tt = 0; tt < 2; ++tt) {
          int sk = sk0 + (2 * it + tt) * 16 + qi;
          sk = sk < 0 ? 0 : sk;
          const bfu* kp = kbase + ((size_t)sk << dshift) * 512;
          kf[tt][0] = *(const bf16x8*)kp;
          kf[tt][1] = *(const bf16x8*)(kp + 32);
        }
      };
      auto loadv = [&](int it) {
        int kidx0 = sk0 + 32 * it + 4 * g, kidx1 = kidx0 + 16;
        kidx0 = kidx0 < 0 ? 0 : kidx0;
        kidx1 = kidx1 < 0 ? 0 : kidx1;
#pragma unroll
        for (int m = 0; m < 4; ++m) {
          vf[m][0] = *(const uint2*)(vbase + (size_t)(16 * m) * SEQ + kidx0);
          vf[m][1] = *(const uint2*)(vbase + (size_t)(16 * m) * SEQ + kidx1);
        }
      };
      loadk(0);
      loadv(0);
      const int hi = 144 + qi, lo = (16 + qi > -sk0) ? 16 + qi : -sk0;
      const float sd = slope * (float)d;
      float mrun = -1e30f, l = 0.f;
      f32x4 O[4];
#pragma unroll
      for (int m = 0; m < 4; ++m) O[m] = f32x4{0.f, 0.f, 0.f, 0.f};
#pragma unroll 1
      for (int it = 0; it < 5; ++it) {
        bf16x8 ck[2][2];
        uint2 cv[4][2];
#pragma unroll
        for (int a = 0; a < 2; ++a)
#pragma unroll
          for (int c = 0; c < 2; ++c) ck[a][c] = kf[a][c];
        const int itn = it < 4 ? it + 1 : 4;
        loadk(itn);
        f32x4 S[2];
#pragma unroll
        for (int tt = 0; tt < 2; ++tt) {
          f32x4 z = {0.f, 0.f, 0.f, 0.f};
          z = __builtin_amdgcn_mfma_f32_16x16x32_bf16(ck[tt][0], qf0, z, 0, 0, 0);
          z = __builtin_amdgcn_mfma_f32_16x16x32_bf16(ck[tt][1], qf1, z, 0, 0, 0);
          S[tt] = z;
        }
        float mx = -INFINITY;
#pragma unroll
        for (int tt = 0; tt < 2; ++tt)
#pragma unroll
          for (int e = 0; e < 4; ++e) {
            const int kb = (2 * it + tt) * 16 + 4 * g;
            const bool valid = (kb >= lo - e) && (kb <= hi - e);
            const float sv = valid ? fmaf(S[tt][e], 0.125f, sd * (float)e - sd * (float)(hi - kb)) : -INFINITY;
            S[tt][e] = sv;
            mx = fmaxf(mx, sv);
          }
        mx = fmaxf(mx, __shfl_xor(mx, 16));
        mx = fmaxf(mx, __shfl_xor(mx, 32));
        const float mnew = fmaxf(mrun, mx);
        const float alpha = __expf(mrun - mnew);
        mrun = mnew;
        float ls = 0.f;
#pragma unroll
        for (int tt = 0; tt < 2; ++tt)
#pragma unroll
          for (int e = 0; e < 4; ++e) {
            const float pe = __expf(S[tt][e] - mnew);
            S[tt][e] = pe;
            ls += pe;
          }
        l = l * alpha + ls;
        uint4 pk;
        pk.x = pkbf(S[0][0], S[0][1]);
        pk.y = pkbf(S[0][2], S[0][3]);
        pk.z = pkbf(S[1][0], S[1][1]);
        pk.w = pkbf(S[1][2], S[1][3]);
        const bf16x8 pf = __builtin_bit_cast(bf16x8, pk);
#pragma unroll
        for (int m = 0; m < 4; ++m) {
          cv[m][0] = vf[m][0];
          cv[m][1] = vf[m][1];
        }
        loadv(itn);
#pragma unroll
        for (int m = 0; m < 4; ++m) {
          O[m] *= alpha;
          const uint4 vv = {cv[m][0].x, cv[m][0].y, cv[m][1].x, cv[m][1].y};
          O[m] = __builtin_amdgcn_mfma_f32_16x16x32_bf16(__builtin_bit_cast(bf16x8, vv), pf, O[m], 0, 0, 0);
        }
      }
      l += __shfl_xor(l, 16);
      l += __shfl_xor(l, 32);
      const float mx = mrun;
      const float il = 1.f / l;
      const int ql = ((tile * 16 + qi) << dshift) + r;
      float wo = 0.f, wn = 1.f;
      float mnew = mx, lnew = l;
      if (pi > 0) {
        const float mo = Mb[ql], lo = Lb[ql];
        mnew = fmaxf(mo, mx);
        wo = lo * __expf(mo - mnew);
        wn = l * __expf(mx - mnew);
        lnew = wo + wn;
        const float inv = 1.f / lnew;
        wo *= inv;
        wn *= inv;
      }
      wn *= il;
#pragma unroll
      for (int m = 0; m < 4; ++m) {
        bfu* op = Ob + ql * 64 + 16 * m + 4 * g;
        float o[4];
        if (pi > 0) {
          const uint2 ov = *(const uint2*)op;
          o[0] = wo * bf2f(ov.x & 0xffffu) + wn * O[m][0];
          o[1] = wo * bf2f(ov.x >> 16) + wn * O[m][1];
          o[2] = wo * bf2f(ov.y & 0xffffu) + wn * O[m][2];
          o[3] = wo * bf2f(ov.y >> 16) + wn * O[m][3];
        } else {
#pragma unroll
          for (int e = 0; e < 4; ++e) o[e] = wn * O[m][e];
        }
        if (pi < 2) {
          uint2 w;
          w.x = pkbf(o[0], o[1]);
          w.y = pkbf(o[2], o[3]);
          *(uint2*)op = w;
        } else {
          const size_t oi = (tokb + q0 + ql) * 1024 + 512 + h * 64 + 16 * m + 4 * g;
          const uint2 sz = *(const uint2*)(p.SZ + oi);
          uint2 w;
          w.x = pkbf(o[0] * bf2f(sz.x & 0xffffu), o[1] * bf2f(sz.x >> 16));
          w.y = pkbf(o[2] * bf2f(sz.y & 0xffffu), o[3] * bf2f(sz.y >> 16));
          *(uint2*)(p.Y + oi) = w;
        }
      }
      if (pi < 2 && g == 0) {
        Mb[ql] = mnew;
        Lb[ql] = lnew;
      }
    }
    __syncthreads();
  }
}

DEVI void phase2(const Params& p, char* smem, int bid, int nb) {
  for (int it = bid; it < 16 * 64; it += nb) attn_item(p, smem, it);
  char* hs = smem + HF * HALF_SMEM;
  for (int it = bid * 2 + HF; it < (T_TOK / 128) * 4; it += nb * 2) gmlp_item(p, hs, it);
}

DEVI void phase3(const Params& p, char* smem, int bid, int nb) {
  PgEpiRes E{p.x, p.out};
  pg_gemm(smem, p.Y, p.WT_out, T_TOK, 1024, 1024, E, bid, nb);
}
DEVI void phase3b(const Params& p, int bid, int nb) {
  for (int it = bid; it < T_TOK / 32; it += nb) {
    const int row = it * 32 + (threadIdx.x >> 6) * 4;
    rms_rows_bf16<4>(p.out + (size_t)row * 1024, p.ln_odd, p.H + (size_t)row * 1024, threadIdx.x & 63);
  }
}

struct ALoadMix {
  typedef uint4 Raw;
  static constexpr bool kFat = true;
  static constexpr bool kConsec = true;
  const bfu* H;
  const float* mu;
  DEVI Raw load(int row, int k) const { return *(const uint4*)(H + (size_t)row * 1024 + k); }
  DEVI uint4 loadprev(int row, int k) const {
    const int prow = ((row & (SEQ - 1)) != 0) ? row - 1 : row;
    return *(const uint4*)(H + (size_t)prow * 1024 + k);
  }
  DEVI uint4 asprev(const Raw& r) const { return r; }
  DEVI uint4 finish(const Raw& r, const uint4& pr, int row, int k) const {
    float c[8], pv[8];
    unpack8(r, c);
    unpack8(pr, pv);
    const float first = ((row & (SEQ - 1)) != 0) ? 1.f : 0.f;
    const float4 m0 = *(const float4*)(mu + k), m1 = *(const float4*)(mu + k + 4);
    const float mm[8] = {m0.x, m0.y, m0.z, m0.w, m1.x, m1.y, m1.z, m1.w};
#pragma unroll
    for (int j = 0; j < 8; ++j) c[j] = c[j] + (pv[j] * first - c[j]) * mm[j];
    return pack8(c);
  }
};
struct Epi4 {
  const Params* p;
  int nt;
  DEVI void operator()(int row, int col, f32x4 v) const {
    uint2 o;
    if (nt < 24) {
      o.x = pkbf(v[0], v[1]);
      o.y = pkbf(v[2], v[3]);
      bfu* dst = (nt < 8) ? p->R + (size_t)row * 1024 + col
                          : (nt < 16) ? p->K1 + (size_t)row * 1024 + col - 1024 : p->V1 + (size_t)row * 1024 + col - 2048;
      *(uint2*)dst = o;
    } else if (nt < 32) {
      o.x = pkbf(silu_(v[0]), silu_(v[1]));
      o.y = pkbf(silu_(v[2]), silu_(v[3]));
      *(uint2*)(p->SG + (size_t)row * 1024 + col - 3072) = o;
    } else if (nt == 32) {
      const int c = col - 4096;
      if (c < 64) {
        o.x = pkbf(tanh_(v[0]), tanh_(v[1]));
        o.y = pkbf(tanh_(v[2]), tanh_(v[3]));
        *(uint2*)(p->TW + (size_t)row * 64 + c) = o;
      }
    } else {
      const int c = col - 4224;
      if (c < 64) {
        o.x = pkbf(v[0], v[1]);
        o.y = pkbf(v[2], v[3]);
        *(uint2*)(p->TA + (size_t)row * 64 + c) = o;
      }
    }
  }
};
DEVI void phase4_tile(const Params& p, char* smem, int mt, int nt) {
  float* smu = (float*)(smem + 2 * GSTAGE_BYTES);
  const int mi = (nt < 8) ? 0 : (nt < 16) ? 2 : (nt < 24) ? 3 : (nt < 32) ? 5 : (nt == 32) ? 1 : 4;
  *(float4*)(smu + TIDX * 4) = *(const float4*)(p.mu + mi * 1024 + TIDX * 4);
  __syncthreads();
  ALoadMix al{p.H, smu};
  Epi4 epi{&p, nt};
  gemm_tile<1>(smem, al, p.WT_3, 1024, 1024, mt * 128, nt * 128, epi);
}
DEVI void phaseM(const Params& p, char* smem, int bid, int nb) {
  char* hs = smem + HF * HALF_SMEM;
  for (int it = bid * 2 + HF; it < (T_TOK / 128) * 2; it += nb * 2) phase4_tile(p, hs, it >> 1, 32 + (it & 1));
  const int tid = threadIdx.x;
  const int cc = (tid & 127) * 8, rsub = tid >> 7;
  float mr[8], mk[8], mv[8], mg[8];
  {
    const float4 a0 = *(const float4*)(p.mu + 0 * 1024 + cc), a1 = *(const float4*)(p.mu + 0 * 1024 + cc + 4);
    const float4 b0 = *(const float4*)(p.mu + 2 * 1024 + cc), b1 = *(const float4*)(p.mu + 2 * 1024 + cc + 4);
    const float4 c0 = *(const float4*)(p.mu + 3 * 1024 + cc), c1 = *(const float4*)(p.mu + 3 * 1024 + cc + 4);
    const float4 d0 = *(const float4*)(p.mu + 5 * 1024 + cc), d1 = *(const float4*)(p.mu + 5 * 1024 + cc + 4);
    mr[0] = a0.x; mr[1] = a0.y; mr[2] = a0.z; mr[3] = a0.w; mr[4] = a1.x; mr[5] = a1.y; mr[6] = a1.z; mr[7] = a1.w;
    mk[0] = b0.x; mk[1] = b0.y; mk[2] = b0.z; mk[3] = b0.w; mk[4] = b1.x; mk[5] = b1.y; mk[6] = b1.z; mk[7] = b1.w;
    mv[0] = c0.x; mv[1] = c0.y; mv[2] = c0.z; mv[3] = c0.w; mv[4] = c1.x; mv[5] = c1.y; mv[6] = c1.z; mv[7] = c1.w;
    mg[0] = d0.x; mg[1] = d0.y; mg[2] = d0.z; mg[3] = d0.w; mg[4] = d1.x; mg[5] = d1.y; mg[6] = d1.z; mg[7] = d1.w;
  }
#pragma unroll 1
  for (int it = bid; it < T_TOK / 8; it += nb) {
    const int ra = it * 8 + rsub, rb = ra + 4;
    const size_t oa = (size_t)ra * 1024 + cc, ob = (size_t)rb * 1024 + cc;
    const uint4 ca = *(const uint4*)(p.H + oa), cb = *(const uint4*)(p.H + ob);
    const uint4 pa = *(const uint4*)(p.H + (((ra & (SEQ - 1)) != 0) ? oa - 1024 : oa));
    const uint4 pb = *(const uint4*)(p.H + ob - 1024);
    const float fa = ((ra & (SEQ - 1)) != 0) ? 1.f : 0.f;
#pragma unroll
    for (int half = 0; half < 2; ++half) {
      float c[8], d[8], o[8];
      unpack8(half ? cb : ca, c);
      unpack8(half ? pb : pa, d);
      const float f = half ? 1.f : fa;
      const size_t oo = half ? ob : oa;
#pragma unroll
      for (int j = 0; j < 8; ++j) d[j] = d[j] * f - c[j];
#pragma unroll
      for (int j = 0; j < 8; ++j) o[j] = c[j] + d[j] * mr[j];
      *(uint4*)(p.XR + oo) = pack8(o);
#pragma unroll
      for (int j = 0; j < 8; ++j) o[j] = c[j] + d[j] * mk[j];
      *(uint4*)(p.XK + oo) = pack8(o);
#pragma unroll
      for (int j = 0; j < 8; ++j) o[j] = c[j] + d[j] * mv[j];
      *(uint4*)(p.XV + oo) = pack8(o);
#pragma unroll
      for (int j = 0; j < 8; ++j) o[j] = c[j] + d[j] * mg[j];
      *(uint4*)(p.XG + oo) = pack8(o);
    }
  }
}
DEVI void phase3a(const Params& p, char* smem, int bid, int nb) {
  PgEpi3 E{p.R, p.K1, 0};
  pg_gemm2(smem, p.XR, p.XK, 4, p.WT_3, T_TOK, 2048, 1024, E, bid, nb);
}
DEVI void phase3c(const Params& p, char* smem, int bid, int nb) {
  PgEpi3 E{p.V1, p.SG, 1};
  pg_gemm2(smem, p.XV, p.XG, 4, p.WT_3 + (size_t)2048 * 1024, T_TOK, 2048, 1024, E, bid, nb);
}

struct Epi5w {
  const Params* p;
  DEVI void operator()(int row, int col, f32x4 v) const {
    const float4 w0 = *(const float4*)(p->w0 + col);
    const float k = 0.6065306597126334f;
    uint2 o;
    o.x = pkbf(k * sigmoid_(w0.x + v[0]), k * sigmoid_(w0.y + v[1]));
    o.y = pkbf(k * sigmoid_(w0.z + v[2]), k * sigmoid_(w0.w + v[3]));
    *(uint2*)(p->EW + (size_t)row * 1024 + col) = o;
  }
};
struct Epi5a {
  const Params* p;
  DEVI void operator()(int row, int col, f32x4 v) const {
    const float4 a0 = *(const float4*)(p->a0 + col);
    uint2 o;
    o.x = pkbf(sigmoid_(a0.x + v[0]), sigmoid_(a0.y + v[1]));
    o.y = pkbf(sigmoid_(a0.z + v[2]), sigmoid_(a0.w + v[3]));
    *(uint2*)(p->AA + (size_t)row * 1024 + col) = o;
  }
};
DEVI void phase5(const Params& p, char* smem, int bid, int nb) {
  constexpr int N1 = (T_TOK / 128) * 8;
  char* hs = smem + HF * HALF_SMEM;
  for (int it = bid * 2 + HF; it < 2 * N1; it += nb * 2) {
    if (it < N1) {
      ALoadPlain al{p.TW, 64};
      Epi5w epi{&p};
      gemm_tile(hs, al, p.W2T, 64, 64, (it >> 3) * 128, (it & 7) * 128, epi);
    } else {
      const int j = it - N1;
      ALoadPlain al{p.TA, 64};
      Epi5a epi{&p};
      gemm_tile(hs, al, p.A2T, 64, 64, (j >> 3) * 128, (j & 7) * 128, epi);
    }
  }
}

DEVI void scanx_item(const Params& p, char* smem, int item, int next_item, uint2& ur, uint2& uk, uint2& ue, uint2& ua, uint2& uv) {
  const int bh = item & 31, c = item >> 5;
  const int b = bh >> 4, h = bh & 15;
  const size_t rowbase = ((size_t)b * SEQ + (size_t)c * 16) * 1024 + h * 64;
  float* sA = (float*)smem;
  float* sR = sA + 16 * 68;
  float* sBt = sR + 16 * 68;
  float* sKt = sBt + 16 * 68;
  float* sE = sKt + 16 * 68;
  float* sMab = sE + 16 * 64;
  float* sMak = sMab + 256;
  float* sM2 = sMak + 256;
  float* sM4 = sM2 + 256;
  float* sT = sM4 + 256;
  float* sT2 = sT + 256;
  const int tid = TIDX;
  const int tau = tid >> 4, c4 = (tid & 15) * 4;
  const size_t o = rowbase + (size_t)tau * 1024 + c4;
  float r[4], k[4], ew[4], a[4], vv[4];
  unpack4(ur, r);
  unpack4(uk, k);
  unpack4(ue, ew);
  unpack4(ua, a);
  unpack4(uv, vv);
  {
    const int nbh = next_item & 31, nc = next_item >> 5;
    const size_t no = ((size_t)(nbh >> 4) * SEQ + (size_t)nc * 16 + tau) * 1024 + (nbh & 15) * 64 + c4;
    ur = *(const uint2*)(p.R + no);
    uk = *(const uint2*)(p.K1 + no);
    ue = *(const uint2*)(p.EW + no);
    ua = *(const uint2*)(p.AA + no);
    uv = *(const uint2*)(p.V1 + no);
  }
  float kk[4], kp[4], bb[4];
  float ss = 0.f, cf = 0.f;
#pragma unroll
  for (int j = 0; j < 4; ++j) {
    const int ch = h * 64 + c4 + j;
    kk[j] = k[j] * p.k_k[ch];
    ss += kk[j] * kk[j];
    kp[j] = k[j] * (1.f + (a[j] - 1.f) * p.k_a[ch]);
    cf += r[j] * kp[j] * p.r_k[ch];
  }
  ss = reduce16(ss);
  cf = reduce16(cf);
  const float rn = rsqrtf(fmaxf(ss, 1e-24f));
#pragma unroll
  for (int j = 0; j < 4; ++j) {
    kk[j] *= rn;
    bb[j] = kk[j] * a[j];
    sE[tau * 64 + c4 + j] = ew[j];
  }
  if ((tid & 15) == 0) p.COEF[((size_t)b * SEQ + (size_t)c * 16 + tau) * 16 + h] = cf;
  __syncthreads();
  float Li[4], L15[4];
  {
    const int wv = tid >> 6, ln = tid & 63, rw = ln & 15, gq = ln >> 4;
    f32x4 cl = {0.f, 0.f, 0.f, 0.f};
#pragma unroll
    for (int s = 0; s < 4; ++s) {
      const int i = 4 * gq + s;
      const float a = (i <= rw) ? 1.f : 0.f;
      const float bv = sE[i * 64 + 16 * wv + rw];
      cl = __builtin_amdgcn_mfma_f32_16x16x4f32(a, bv, cl, 0, 0, 0);
    }
    float* sL = sM2;
#pragma unroll
    for (int e = 0; e < 4; ++e) sL[(4 * gq + e) * 64 + 16 * wv + rw] = cl[e];
    __syncthreads();
    const float4 l4 = *(const float4*)(sL + tau * 64 + c4), l15 = *(const float4*)(sL + 15 * 64 + c4);
    Li[0] = l4.x; Li[1] = l4.y; Li[2] = l4.z; Li[3] = l4.w;
    L15[0] = l15.x; L15[1] = l15.y; L15[2] = l15.z; L15[3] = l15.w;
  }
  float rt[4], bhat[4], khat[4];
#pragma unroll
  for (int j = 0; j < 4; ++j) {
    const float ep = __expf(Li[j]), em = __expf(-Li[j]), eh = __expf(-(L15[j] - Li[j]));
    const float at = -kk[j] * __expf(-(Li[j] - ew[j]));
    rt[j] = r[j] * em;
    sA[tau * 68 + c4 + j] = at;
    sR[tau * 68 + c4 + j] = rt[j];
    sBt[tau * 68 + c4 + j] = bb[j] * ep;
    sKt[tau * 68 + c4 + j] = kp[j] * ep;
    bhat[j] = bb[j] * eh;
    khat[j] = kp[j] * eh;
  }
  *(uint2*)(p.R + o) = pack4(rt);
#pragma unroll
  for (int j = 0; j < 4; ++j) {
    const int lin = (c4 + j) * 16 + tau;
    const size_t off = rowbase + (size_t)(lin >> 6) * 1024 + (lin & 63);
    p.EW[off] = (bfu)f2bf(bhat[j]);
    p.K1[off] = (bfu)f2bf(khat[j]);
    p.V1[off] = (bfu)f2bf(vv[j]);
  }
  if (tau == 0) {
    float4 gq = {__expf(-L15[0]), __expf(-L15[1]), __expf(-L15[2]), __expf(-L15[3])};
    *(float4*)(p.G15 + (size_t)item * 64 + c4) = gq;
  }
  __syncthreads();
  {
    const int wv = tid >> 6, ln = tid & 63, rw = ln & 15, gq = ln >> 4;
    const float* rowsrc = ((wv >> 1) ? sKt : sBt) + rw * 68 + 16 * gq;
    const float* colsrc = ((wv & 1) ? sR : sA) + rw * 68 + 16 * gq;
    f32x4 m = {0.f, 0.f, 0.f, 0.f};
#pragma unroll
    for (int s4 = 0; s4 < 16; s4 += 4) {
      const float4 av = *(const float4*)(rowsrc + s4), bv = *(const float4*)(colsrc + s4);
      m = __builtin_amdgcn_mfma_f32_16x16x4f32(av.x, bv.x, m, 0, 0, 0);
      m = __builtin_amdgcn_mfma_f32_16x16x4f32(av.y, bv.y, m, 0, 0, 0);
      m = __builtin_amdgcn_mfma_f32_16x16x4f32(av.z, bv.z, m, 0, 0, 0);
      m = __builtin_amdgcn_mfma_f32_16x16x4f32(av.w, bv.w, m, 0, 0, 0);
    }
    const int tq = rw;
    if (wv & 1) {
      float v4[4];
#pragma unroll
      for (int e = 0; e < 4; ++e) v4[e] = (4 * gq + e <= tq) ? m[e] : 0.f;
      *(uint2*)(p.MRT + (size_t)item * 512 + tq * 32 + gq * 8 + (wv >> 1) * 4) = pack4(v4);
    } else {
      float* dst = (wv >> 1) ? sMak : sMab;
#pragma unroll
      for (int e = 0; e < 4; ++e) dst[(4 * gq + e) * 16 + tq] = (4 * gq + e < tq) ? m[e] : 0.f;
    }
  }
  __syncthreads();
  {
    const int i = tid >> 4, j = tid & 15;
    float m2 = 0.f;
#pragma unroll
    for (int kq = 0; kq < 16; ++kq) m2 += sMab[i * 16 + kq] * sMab[kq * 16 + j];
    sM2[i * 16 + j] = m2;
    __syncthreads();
    float t1 = ((i == j) ? 1.f : 0.f) + sMab[i * 16 + j] + m2, m4 = 0.f;
#pragma unroll
    for (int kq = 0; kq < 16; ++kq) {
      t1 += sMab[i * 16 + kq] * sM2[kq * 16 + j];
      m4 += sM2[i * 16 + kq] * sM2[kq * 16 + j];
    }
    sT[i * 16 + j] = t1;
    sM4[i * 16 + j] = m4;
    __syncthreads();
    float t2 = t1, m8 = 0.f;
#pragma unroll
    for (int kq = 0; kq < 16; ++kq) {
      t2 += sT[i * 16 + kq] * sM4[kq * 16 + j];
      m8 += sM4[i * 16 + kq] * sM4[kq * 16 + j];
    }
    sT2[i * 16 + j] = t2;
    __syncthreads();
    sM2[i * 16 + j] = m8;
    __syncthreads();
    float t3 = t2;
#pragma unroll
    for (int kq = 0; kq < 16; ++kq) t3 += sT2[i * 16 + kq] * sM2[kq * 16 + j];
    sT[i * 16 + j] = t3;
    __syncthreads();
  }
  {
    const int wv = tid >> 6, ln = tid & 63, rw = ln & 15, gq = ln >> 4;
    float tmv[4], av[4];
#pragma unroll
    for (int s = 0; s < 4; ++s) {
      tmv[s] = sT[(4 * gq + s) * 16 + rw];
      av[s] = sA[(4 * gq + s) * 68 + 16 * wv + rw];
    }
    f32x4 cw = {0.f, 0.f, 0.f, 0.f};
#pragma unroll
    for (int s = 0; s < 4; ++s) cw = __builtin_amdgcn_mfma_f32_16x16x4f32(av[s], tmv[s], cw, 0, 0, 0);
    {
      float w4[4] = {cw[0], cw[1], cw[2], cw[3]};
      *(uint2*)(p.AA + rowbase + (size_t)rw * 1024 + 16 * wv + 4 * gq) = pack4(w4);
    }
    if (wv == 3) {
      const float4 mk = *(const float4*)(sMak + rw * 16 + 4 * gq);
      f32x4 cg = {0.f, 0.f, 0.f, 0.f};
      cg = __builtin_amdgcn_mfma_f32_16x16x4f32(mk.x, tmv[0], cg, 0, 0, 0);
      cg = __builtin_amdgcn_mfma_f32_16x16x4f32(mk.y, tmv[1], cg, 0, 0, 0);
      cg = __builtin_amdgcn_mfma_f32_16x16x4f32(mk.z, tmv[2], cg, 0, 0, 0);
      cg = __builtin_amdgcn_mfma_f32_16x16x4f32(mk.w, tmv[3], cg, 0, 0, 0);
      float g4[4] = {cg[0], cg[1], cg[2], cg[3]};
      *(uint2*)(p.GT + (size_t)item * 256 + rw * 16 + 4 * gq) = pack4(g4);
    }
  }
  __syncthreads();
}
DEVI void phase6x(const Params& p, char* smem, int bid, int nb) {
  char* hs = smem + HF * HALF_SMEM;
  constexpr int NI = (SEQ / 16) * 32;
  const int vnb = nb * 2;
  int it = bid * 2 + HF;
  if (it >= NI) return;
  uint2 ur, uk, ue, ua, uv;
  {
    const int tau = TIDX >> 4, c4 = (TIDX & 15) * 4;
    const int bh = it & 31, c = it >> 5;
    const size_t o = ((size_t)(bh >> 4) * SEQ + (size_t)c * 16 + tau) * 1024 + (bh & 15) * 64 + c4;
    ur = *(const uint2*)(p.R + o);
    uk = *(const uint2*)(p.K1 + o);
    ue = *(const uint2*)(p.EW + o);
    ua = *(const uint2*)(p.AA + o);
    uv = *(const uint2*)(p.V1 + o);
  }
#pragma unroll 1
  for (; it < NI; it += vnb) scanx_item(p, hs, it, (it + vnb < NI) ? it + vnb : it, ur, uk, ue, ua, uv);
}

DEVI bf16x8 mk8(uint2 a, uint2 b) {
  const uint4 v = {a.x, a.y, b.x, b.y};
  return __builtin_bit_cast(bf16x8, v);
}
DEVI uint2 packacc(f32x4 a) {
  uint2 r;
  r.x = pkbf(a[0], a[1]);
  r.y = pkbf(a[2], a[3]);
  return r;
}
constexpr int SCH = 4;
constexpr int SROW = 136;
constexpr int SARR = 16 * SROW;
constexpr int SOFF_GT = 5 * SARR;
constexpr int SOFF_MR = SOFF_GT + 512;
constexpr int SOFF_G15 = SOFF_MR + 1024;
constexpr int SIMG = SOFF_G15 + 256;
#define SCANS_LD5(P, I, O)                       \
    P##a##I = *(const uint4*)(p.AA + (O));       \
    P##r##I = *(const uint4*)(p.R + (O));        \
    P##e##I = *(const uint4*)(p.EW + (O));       \
    P##k##I = *(const uint4*)(p.K1 + (O));       \
    P##v##I = *(const uint4*)(p.V1 + (O));
#define SCANS_ISSUE(P, SC)                                                                           \
  {                                                                                                  \
    const size_t hb_ = ((size_t)b * SEQ) * 1024 + h * 64 + c80 * 8;                                  \
    const int tk0_ = (SC) * SCH * 16 + cl0 * 16 + row0;                                              \
    const int tk1_ = tk0_ + 32;                                                                      \
    SCANS_LD5(P, 0, hb_ + (size_t)(tk0_ < SEQ ? tk0_ : SEQ - 1) * 1024)                              \
    SCANS_LD5(P, 1, hb_ + (size_t)(tk1_ < SEQ ? tk1_ : SEQ - 1) * 1024)                              \
    const int c0_ = (SC) * SCH;                                                                      \
    const size_t ib_ = (size_t)b * 16 + h;                                                           \
    const int tg_ = tid < 128 ? tid : 127;                                                           \
    const int cg_ = c0_ + (tg_ >> 5);                                                                \
    P##gm = *(const uint4*)(p.GT + ((size_t)(cg_ < SEQ / 16 ? cg_ : SEQ / 16 - 1) * 32 + ib_) * 256 + (tg_ & 31) * 8);  \
    const int t5_ = tid < 64 ? tid : 63;                                                             \
    const int c5_ = c0_ + (t5_ >> 4);                                                                \
    P##g5 = *(const uint4*)(p.G15 + ((size_t)(c5_ < SEQ / 16 ? c5_ : SEQ / 16 - 1) * 32 + ib_) * 64 + (t5_ & 15) * 4);  \
    const int cm_ = c0_ + (tid >> 6);                                                                \
    P##mr = *(const uint4*)(p.MRT + ((size_t)(cm_ < SEQ / 16 ? cm_ : SEQ / 16 - 1) * 32 + ib_) * 512 + (tid & 63) * 8); \
  }
#define SCANS_ST5(P, I, B)                                                                           \
    *(uint2*)(B) = uint2{P##a##I.x, P##a##I.y};  *(uint2*)((B) + 8) = uint2{P##a##I.z, P##a##I.w};   \
    *(uint2*)((B) + SARR) = uint2{P##r##I.x, P##r##I.y};  *(uint2*)((B) + SARR + 8) = uint2{P##r##I.z, P##r##I.w};   \
    *(uint2*)((B) + 2 * SARR) = uint2{P##e##I.x, P##e##I.y};  *(uint2*)((B) + 2 * SARR + 8) = uint2{P##e##I.z, P##e##I.w};   \
    *(uint2*)((B) + 3 * SARR) = uint2{P##k##I.x, P##k##I.y};  *(uint2*)((B) + 3 * SARR + 8) = uint2{P##k##I.z, P##k##I.w};   \
    *(uint2*)((B) + 4 * SARR) = uint2{P##v##I.x, P##v##I.y};  *(uint2*)((B) + 4 * SARR + 8) = uint2{P##v##I.z, P##v##I.w};
#define SCANS_COMMIT(P)                                                                              \
  {                                                                                                  \
    char* b0_ = cimg + cl0 * SIMG + row0 * SROW + c80 * 16;                                          \
    SCANS_ST5(P, 0, b0_)                                                                             \
    SCANS_ST5(P, 1, b0_ + 2 * SIMG)                                                                  \
    if (tid < 128) *(uint4*)(cimg + (tid >> 5) * SIMG + SOFF_GT + (tid & 31) * 16) = P##gm;          \
    if (tid < 64) *(uint4*)(cimg + (tid >> 4) * SIMG + SOFF_G15 + (tid & 15) * 16) = P##g5;          \
    *(uint4*)(cimg + (tid >> 6) * SIMG + SOFF_MR + (tid & 63) * 16) = P##mr;                         \
  }
#define SCANS_COMPUTE(SCI)                                                                           \
  _Pragma("unroll 1") for (int cl = 0; cl < SCH && (SCI) * SCH + cl < SEQ / 16; ++cl) {             \
    const char* img = cimg + cl * SIMG;                                                              \
        \
    const uint2 vb = *(const uint2*)(img + 4 * SARR + vrow * SROW + vcol * 2);                       \
    const uint2 gt = *(const uint2*)(img + SOFF_GT + (q * 16 + 4 * g) * 2);                          \
    const char* wp = img + q * SROW + (4 * g) * 2;                                                   \
    const uint2 w00 = *(const uint2*)(wp), w01 = *(const uint2*)(wp + 32);                           \
    const uint2 w10 = *(const uint2*)(wp + 64), w11 = *(const uint2*)(wp + 96);                      \
    const uint2 r00 = *(const uint2*)(wp + SARR), r01 = *(const uint2*)(wp + SARR + 32);             \
    const uint2 r10 = *(const uint2*)(wp + SARR + 64), r11 = *(const uint2*)(wp + SARR + 96);        \
    const uint4 mr = *(const uint4*)(img + SOFF_MR + (q * 32 + g * 8) * 2);                          \
    uint2 bk0[4], bk1[4];                                                                            \
    float4 g15[4];                                                                                   \
    _Pragma("unroll") for (int n = 0; n < 4; ++n) {                                                  \
      const int ch = 16 * n + q;                                                                     \
      const char* bp = img + 2 * SARR + (ch >> 2) * SROW + ((ch & 3) * 16 + 4 * g) * 2;              \
      bk0[n] = *(const uint2*)(bp);                                                                  \
      bk1[n] = *(const uint2*)(bp + SARR);                                                           \
      g15[n] = *(const float4*)(img + SOFF_G15 + (16 * n + 4 * g) * 4);                              \
    }                                                                                                \
    __builtin_amdgcn_sched_barrier(0);                                                               \
    const bf16x8 sB0 = mk8(packacc(acc[0]), packacc(acc[1]));                                        \
    const bf16x8 sB1 = mk8(packacc(acc[2]), packacc(acc[3]));                                        \
    f32x4 Z = {0.f, 0.f, 0.f, 0.f};                                                                  \
    Z = __builtin_amdgcn_mfma_f32_16x16x32_bf16(mk8(gt, zero2), mk8(vb, zero2), Z, 0, 0, 0);         \
    f32x4 Y = {0.f, 0.f, 0.f, 0.f};                                                                  \
    Z = __builtin_amdgcn_mfma_f32_16x16x32_bf16(mk8(w00, w01), sB0, Z, 0, 0, 0);                     \
    Y = __builtin_amdgcn_mfma_f32_16x16x32_bf16(mk8(r00, r01), sB0, Y, 0, 0, 0);                     \
    Z = __builtin_amdgcn_mfma_f32_16x16x32_bf16(mk8(w10, w11), sB1, Z, 0, 0, 0);                     \
    Y = __builtin_amdgcn_mfma_f32_16x16x32_bf16(mk8(r10, r11), sB1, Y, 0, 0, 0);                     \
    const bf16x8 zvB = mk8(packacc(Z), vb);                                                          \
    Y = __builtin_amdgcn_mfma_f32_16x16x32_bf16(__builtin_bit_cast(bf16x8, mr), zvB, Y, 0, 0, 0);    \
    _Pragma("unroll") for (int n = 0; n < 4; ++n) {                                                  \
      f32x4 scv = acc[n];                                                                            \
      scv[0] *= g15[n].x; scv[1] *= g15[n].y; scv[2] *= g15[n].z; scv[3] *= g15[n].w;                \
      acc[n] = __builtin_amdgcn_mfma_f32_16x16x32_bf16(mk8(bk0[n], bk1[n]), zvB, scv, 0, 0, 0);      \
    }                                                                                                \
    _Pragma("unroll") for (int e = 0; e < 4; ++e)                                                    \
        ybuf[(cl * 16 + 4 * g + e) * 16 + q] = (bfu)f2bf(Y[e]);                                      \
  }
DEVI void scans_block(const Params& p, char* smem, int bh, int vs) {
  const int b = bh >> 4, h = bh & 15;
  const int lane = threadIdx.x & 63, wv = threadIdx.x >> 6, q = lane & 15, g = lane >> 4;
  f32x4 acc[4];
#pragma unroll
  for (int n = 0; n < 4; ++n) acc[n] = f32x4{0.f, 0.f, 0.f, 0.f};
  const uint2 zero2 = {0u, 0u};
  bfu* yout = p.YS + ((size_t)b * SEQ) * 1024 + h * 64 + vs * 16;
  char* const img0 = smem;
  char* const img1 = smem + SCH * SIMG;
  bfu* const yb0 = (bfu*)(smem + 2 * SCH * SIMG);
  bfu* const yb1 = yb0 + SCH * 16 * 16;
  const int tid = TIDX;
  const bool stager = wv >= 4;
  const int cl0 = tid >> 7, row0 = (tid >> 3) & 15, c80 = tid & 7;
  uint4 Aa0, Aa1, Ar0, Ar1, Ae0, Ae1, Ak0, Ak1, Av0, Av1, Agm, Ag5, Amr;
  constexpr int NSC = (SEQ / 16) / SCH;
  const int vrow = vs * 4 + (q >> 2), vcol = (q & 3) * 16 + 4 * g;
  if (stager) {
    char* cimg = img0;
    SCANS_ISSUE(A, 0);
    SCANS_COMMIT(A);
    SCANS_ISSUE(A, 1);
  }
  __syncthreads();
#define SCANS_FLUSH(YB, S)                                                                                       \
  if (wv >= 1 && wv <= 2) {                                                                                      \
    const int idx = (int)threadIdx.x - 64, tok = (S) * SCH * 16 + (idx >> 1);                                    \
    *(uint4*)(yout + (size_t)tok * 1024 + (idx & 1) * 8) = *(const uint4*)((YB) + (idx >> 1) * 16 + (idx & 1) * 8); \
  }
#pragma unroll 1
  for (int sc = 0; sc < NSC; sc += 2) {
    if (wv == 0) {
      const char* cimg = img0;
      bfu* ybuf = yb0;
      SCANS_COMPUTE(sc);
    } else if (stager) {
      char* cimg = img1;
      SCANS_COMMIT(A);
      SCANS_ISSUE(A, (sc + 2 < NSC ? sc + 2 : NSC - 1));
    } else if (sc > 0) {
      SCANS_FLUSH(yb1, sc - 1)
    }
    __syncthreads();
    if (wv == 0) {
      const char* cimg = img1;
      bfu* ybuf = yb1;
      SCANS_COMPUTE(sc + 1);
    } else if (stager) {
      char* cimg = img0;
      SCANS_COMMIT(A);
      SCANS_ISSUE(A, (sc + 3 < NSC ? sc + 3 : NSC - 1));
    } else {
      SCANS_FLUSH(yb0, sc)
    }
    __syncthreads();
  }
  SCANS_FLUSH(yb1, NSC - 1)
#undef SCANS_FLUSH
}
DEVI void phase6(const Params& p, char* smem, int bid, int nb) {
  for (int it = bid; it < 128; it += nb) scans_block(p, smem, it >> 2, it & 3);
}

DEVI void phase6b(const Params& p, int bid, int nb) {
  const int lane = threadIdx.x & 63, wv = (threadIdx.x >> 6) & 3;
  for (int it = bid; it < T_TOK / 4; it += nb) {
    const int t0 = it * 4 + (threadIdx.x >> 8) * 2;
    float ys[8], vv[8], sg[8], bon[8];
#pragma unroll
    for (int j = 0; j < 8; ++j) {
      const int t = t0 + (j >> 2), h = wv * 4 + (j & 3);
      const int tb = t & ~15, tau = t & 15;
      const size_t idx = (size_t)t * 1024 + h * 64 + lane;
      ys[j] = bf2f(p.YS[idx]);
      sg[j] = bf2f(p.SG[idx]);
      vv[j] = bf2f(p.V1[(size_t)(tb + (lane >> 2)) * 1024 + h * 64 + (lane & 3) * 16 + tau]);
      bon[j] = p.COEF[(size_t)t * 16 + h];
    }
#pragma unroll
    for (int j = 0; j < 8; ++j) {
      const int t = t0 + (j >> 2), h = wv * 4 + (j & 3);
      const int c = h * 64 + lane;
      const float mean = wave_sum(ys[j]) * (1.f / 64.f);
      const float dv = ys[j] - mean;
      const float var = wave_sum(dv * dv) * (1.f / 64.f);
      float y = dv * rsqrtf(var + 64e-5f) * p.lnw[c] + p.lnb[c];
      y = (y + bon[j] * vv[j]) * sg[j];
      p.YS[(size_t)t * 1024 + c] = (bfu)f2bf(y);
    }
  }
}

DEVI void phase7(const Params& p, char* smem, int bid, int nb) {
  PgEpiRes E{p.out, p.out};
  pg_gemm(smem, p.YS, p.WT_o, T_TOK, 1024, 1024, E, bid, nb);
}
DEVI void phase8(const Params& p, int bid, int nb) {
  for (int it = bid; it < T_TOK / 16; it += nb) {
    const int row = it * 16 + (threadIdx.x >> 6) * 2;
    const int lane = threadIdx.x & 63;
    float* src = p.out + (size_t)row * 1024;
    float4 v[2][4];
    float ss[2] = {0.f, 0.f};
#pragma unroll
    for (int r = 0; r < 2; ++r)
#pragma unroll
      for (int i = 0; i < 4; ++i) v[r][i] = *(const float4*)(src + r * 1024 + lane * 4 + 256 * i);
#pragma unroll
    for (int r = 0; r < 2; ++r)
#pragma unroll
      for (int i = 0; i < 4; ++i)
        ss[r] += v[r][i].x * v[r][i].x + v[r][i].y * v[r][i].y + v[r][i].z * v[r][i].z + v[r][i].w * v[r][i].w;
#pragma unroll
    for (int r = 0; r < 2; ++r) {
      const float rinv = rsqrtf(wave_sum(ss[r]) * (1.f / 1024.f) + 1e-6f);
#pragma unroll
      for (int i = 0; i < 4; ++i) {
        const float4 g = *(const float4*)(p.fnorm + lane * 4 + 256 * i);
        const float4 o = {v[r][i].x * rinv * g.x, v[r][i].y * rinv * g.y, v[r][i].z * rinv * g.z, v[r][i].w * rinv * g.w};
        *(float4*)(src + r * 1024 + lane * 4 + 256 * i) = o;
      }
    }
  }
}

#define XB_TMO      128
#define XB_XCNT(j)  (256  + 64 * (j))
#define XB_XSUB(j)  (1280 + 64 * (j))
#define XB_XGEN(j)  (2304 + 64 * (j))
#define XB_TOP      3328
#define XB_TOPGEN   3392
#define XCD_BAR_WORDS 3456
#define XB_SPIN_CAP (1u << 18)
#define LAS __attribute__((address_space(3)))

__device__ __forceinline__ unsigned xb_ld(unsigned* p)              { return __hip_atomic_load(p, __ATOMIC_RELAXED, __HIP_MEMORY_SCOPE_AGENT); }
__device__ __forceinline__ unsigned xb_add(unsigned* p, unsigned v) { return __hip_atomic_fetch_add(p, v, __ATOMIC_RELAXED, __HIP_MEMORY_SCOPE_AGENT); }
__device__ __forceinline__ unsigned xb_xcc_id() { return (unsigned)__builtin_amdgcn_s_getreg((3 << 11) | 20) & 0xFu; }
#define XB_SPIN(cond, bar) do { unsigned _sp = 0; while (cond) { __builtin_amdgcn_s_sleep(1); \
    if ((++_sp & 255u) == 0u) { if (xb_ld(&(bar)[XB_TMO])) break; if (_sp > XB_SPIN_CAP) { atomicAdd(&(bar)[XB_TMO], 1u); break; } } } } while (0)

struct XcdBarrier {
    unsigned* bar; unsigned x;
    volatile LAS unsigned* st;
};

__device__ __forceinline__ XcdBarrier xcd_barrier_post(unsigned* bar, volatile LAS unsigned* st) {
    XcdBarrier b; b.bar = bar; b.x = xb_xcc_id(); b.st = st;
    if (threadIdx.x == 0) (void)xb_add(&bar[XB_XCNT(b.x)], 1u);
    return b;
}
__device__ __forceinline__ void xcd_barrier_complete(unsigned* bar, unsigned x, unsigned& nloc, unsigned& nx) {
    const unsigned G = gridDim.x * gridDim.y * gridDim.z;
    unsigned sum, cnt, mine, sp = 0u;
    for (;;) {
        sum = 0u; cnt = 0u; mine = 0u;
#pragma unroll
        for (unsigned j = 0; j < 16; ++j) { const unsigned c = xb_ld(&bar[XB_XCNT(j)]); sum += c; cnt += (c > 0u) ? 1u : 0u; mine = (j == x) ? c : mine; }
        if (sum == G) break;
        __builtin_amdgcn_s_sleep(1);
        if ((++sp & 255u) == 0u) { if (xb_ld(&bar[XB_TMO])) break; if (sp > XB_SPIN_CAP) { atomicAdd(&bar[XB_TMO], 1u); break; } }
    }
    nloc = mine > 0u ? mine : 1u; nx = cnt > 0u ? cnt : 1u;
}

__device__ __forceinline__ void xcd_barrier(const XcdBarrier& b) {
    asm volatile("s_waitcnt vmcnt(0)" ::: "memory");
    __syncthreads();
    if (threadIdx.x == 0) {
        unsigned* bar = b.bar;
        __builtin_amdgcn_s_waitcnt(0);
        unsigned nloc = b.st[0], nx = b.st[1];
        if (nloc == 0u) { xcd_barrier_complete(bar, b.x, nloc, nx); b.st[0] = nloc; b.st[1] = nx; }
        const unsigned old = xb_add(&bar[XB_XSUB(b.x)], 1u);
        const unsigned gen = old / nloc;
        if (old + 1u == (gen + 1u) * nloc) {
            __builtin_amdgcn_fence(__ATOMIC_RELEASE, "agent");
            asm volatile("s_waitcnt vmcnt(0)" ::: "memory");
            const unsigned og = xb_add(&bar[XB_TOP], 1u);
            const unsigned tg = og / nx;
            if (og + 1u == (tg + 1u) * nx) xb_add(&bar[XB_TOPGEN], 1u);
            else XB_SPIN(xb_ld(&bar[XB_TOPGEN]) == tg, bar);
            __builtin_amdgcn_fence(__ATOMIC_ACQUIRE, "agent");
            xb_add(&bar[XB_XGEN(b.x)], 1u);
            asm volatile("s_waitcnt vmcnt(0)" ::: "memory");
        } else {
            XB_SPIN(xb_ld(&bar[XB_XGEN(b.x)]) == gen, bar);
            __builtin_amdgcn_fence(__ATOMIC_ACQUIRE, "agent");
            asm volatile("s_waitcnt vmcnt(0)" ::: "memory");
        }
    }
    __syncthreads();
}


template <int PH>
DEVI void run_phase(const Params& p, char* smem, int bid, int nb) {
  if (PH == 0) phase0(p, smem, bid, nb);
  if (PH == 1) phase1(p, smem, bid, nb);
  if (PH == 2) phase2(p, smem, bid, nb);
  if (PH == 3) phase3(p, smem, bid, nb);
  if (PH == 4) phase3b(p, bid, nb);
  if (PH == 5) phaseM(p, smem, bid, nb);
  if (PH == 6) phase3a(p, smem, bid, nb);
  if (PH == 7) phase3c(p, smem, bid, nb);
  if (PH == 8) phase5(p, smem, bid, nb);
  if (PH == 9) phase6x(p, smem, bid, nb);
  if (PH == 10) phase6(p, smem, bid, nb);
  if (PH == 11) phase6b(p, bid, nb);
  if (PH == 12) phase7(p, smem, bid, nb);
  if (PH == 13) phase8(p, bid, nb);
}

#ifndef REP_MASK
#define REP_MASK 0
#endif
template <int PH>
DEVI void mega_phase(const Params& p, char* smem, cg::grid_group& grid, int bid, int nb) {
  run_phase<PH>(p, smem, bid, nb);
  if ((REP_MASK >> PH) & 1) {
    grid.sync();
    run_phase<PH>(p, smem, bid, nb);
  }
}
__global__ void __launch_bounds__(512, 2) mega_kernel(Params pk) {
  const Params& p = *(const Params*)__builtin_amdgcn_kernarg_segment_ptr();
  extern __shared__ __attribute__((aligned(16))) char smem[];
  cg::grid_group grid = cg::this_grid();
  const int bid = blockIdx.x, nb = gridDim.x;
  volatile LAS unsigned* st = (volatile LAS unsigned*)(smem + SMEM_BYTES);
  if (threadIdx.x == 0) {
    st[0] = 0u;
    st[1] = 0u;
  }
  __syncthreads();
  if (bid == 0)
    for (int i = threadIdx.x; i < XCD_BAR_WORDS; i += 512) p.BAR[i] = 0u;
#define XBAR() do { XcdBarrier xb_; xb_.bar = p.BAR; xb_.x = xb_xcc_id(); xb_.st = (volatile LAS unsigned*)(smem + SMEM_BYTES); xcd_barrier(xb_); } while (0)
  mega_phase<0>(p, smem, grid, bid, nb); grid.sync();
  (void)xcd_barrier_post(p.BAR, st);
  mega_phase<1>(p, smem, grid, bid, nb); XBAR();
  mega_phase<2>(p, smem, grid, bid, nb); XBAR();
  mega_phase<3>(p, smem, grid, bid, nb); XBAR();
  mega_phase<4>(p, smem, grid, bid, nb); XBAR();
  mega_phase<5>(p, smem, grid, bid, nb); XBAR();
  mega_phase<6>(p, smem, grid, bid, nb); XBAR();
  mega_phase<7>(p, smem, grid, bid, nb); XBAR();
  mega_phase<8>(p, smem, grid, bid, nb); XBAR();
  mega_phase<9>(p, smem, grid, bid, nb); XBAR();
  mega_phase<10>(p, smem, grid, bid, nb); XBAR();
  mega_phase<11>(p, smem, grid, bid, nb); XBAR();
  mega_phase<12>(p, smem, grid, bid, nb); grid.sync();
  mega_phase<13>(p, smem, grid, bid, nb);
}

extern "C" void kernel_launch(void* const* d_in, const int* in_sizes, int n_in, void* d_out, int out_size, void* d_ws,
                              size_t ws_size, hipStream_t stream) {
  Params p{};
  const float** fp = (const float**)&p;
  for (int i = 0; i < 26; ++i) fp[i] = (const float*)d_in[i];
  p.out = (float*)d_out;
  char* w = (char*)d_ws;
  size_t off = 0;
  auto take = [&](size_t bytes) {
    char* r = w + off;
    off += (bytes + 255) & ~(size_t)255;
    return (bfu*)r;
  };
  p.WT_in = take((size_t)3584 * 1024 * 2);
  p.WT_out = take((size_t)1024 * 1024 * 2);
  p.WT_3 = take((size_t)4352 * 1024 * 2);
  p.WT_o = take((size_t)1024 * 1024 * 2);
  p.W2T = take((size_t)1024 * 64 * 2);
  p.A2T = take((size_t)1024 * 64 * 2);
  p.TW = take((size_t)T_TOK * 64 * 2);
  p.TA = take((size_t)T_TOK * 64 * 2);
  const size_t SLOT = (size_t)T_TOK * 1024 * 2;
  bfu* slot0 = take(SLOT);
  bfu* slots = take(6 * SLOT);
  p.H = slot0;
  p.AA = slot0;
  p.U = slots;
  p.GVT = slots + SLOT / 4;
  p.Q = slots + 2 * (SLOT / 4);
  p.K = slots + 3 * (SLOT / 4);
  p.VT = slots + 4 * (SLOT / 4);
  p.SZ = slots + 7 * (SLOT / 4);
  p.Y = slots + 9 * (SLOT / 4);
  p.R = slots;
  p.K1 = slots + 1 * (SLOT / 2);
  p.XV = slots + 2 * (SLOT / 2);
  p.XG = slots + 3 * (SLOT / 2);
  p.XR = slots + 4 * (SLOT / 2);
  p.XK = slots + 5 * (SLOT / 2);
  p.V1 = slots + 4 * (SLOT / 2);
  p.SG = slots + 5 * (SLOT / 2);
  p.EW = slots + 2 * (SLOT / 2);
  p.YS = slots + 3 * (SLOT / 2);
  p.G15 = (float*)p.TW;
  p.GT = p.WT_in;
  p.MRT = take((size_t)(SEQ / 16) * 32 * 512 * 2);
  p.COEF = (float*)take((size_t)T_TOK * 16 * 4);
  p.BAR = (unsigned*)take((size_t)XCD_BAR_WORDS * 4);
  if (off > ws_size) {
    fprintf(stderr, "workspace too small: need %zu have %zu\n", off, ws_size);
    return;
  }
  static int grid_blocks = 0;
  if (!grid_blocks) {
    int dev = 0, cus = 0, per_cu = 0;
    (void)hipGetDevice(&dev);
    (void)hipDeviceGetAttribute(&cus, hipDeviceAttributeMultiprocessorCount, dev);
    (void)hipFuncSetAttribute((const void*)mega_kernel, hipFuncAttributeMaxDynamicSharedMemorySize, SMEM_BYTES + 16);
    (void)hipOccupancyMaxActiveBlocksPerMultiprocessor(&per_cu, mega_kernel, 512, SMEM_BYTES + 16);
    grid_blocks = cus * per_cu;
  }
  void* args[] = {&p};
  hipError_t e = hipLaunchCooperativeKernel((void*)mega_kernel, dim3(grid_blocks), dim3(512), args, SMEM_BYTES + 16, stream);
  if (e != hipSuccess) fprintf(stderr, "cooperative launch failed: %s (grid %d)\n", hipGetErrorString(e), grid_blocks);
}
```
